# Optimizing an MI355X kernel written in HIP

```python
import math
import jax
import jax.numpy as jnp
from jax import lax
import numpy as np

D_MODEL = 1024
BATCH = 16
SEQ = 4096
DEPTH = 2

N_HEADS = 4
HEAD_DIM = 64
MIX_W = N_HEADS * HEAD_DIM
N_BRANCH = 4
Q_BLOCK = 128
GDN_CHUNK = 64
CONV_K = 4
RET_CHUNK = 128
ROPE_BASE = 10000.0
NSA_CMP_LEN = 32
NSA_CMP_STRIDE = 16
NSA_CMP_HIDDEN = 256
NSA_SEL_LEN = 64
NSA_TOP_N = 16
NSA_WINDOW = 512
NSA_Q_BLOCK = 64
NSA_FORCE_SCORE = 1.0e4
N_EXPERTS = 16
N_GROUPS = 4
EXPERTS_PER_GROUP = N_EXPERTS // N_GROUPS
TOP_K = 2
D_EXPERT = 512
DN_ALPHA = (2.0 * DEPTH) ** 0.25
DN_BETA = (8.0 * DEPTH) ** -0.25
LN_EPS = 1e-5

IN_WIDTHS = (
    MIX_W, MIX_W, MIX_W, N_HEADS, N_HEADS, MIX_W,
    MIX_W, MIX_W, MIX_W, MIX_W,
    MIX_W, HEAD_DIM, HEAD_DIM, HEAD_DIM, HEAD_DIM, HEAD_DIM, HEAD_DIM, 3 * N_HEADS,
    MIX_W, MIX_W, MIX_W, N_HEADS,
)
IN_WIDTH = int(sum(IN_WIDTHS))
IN_SPLITS = tuple(int(v) for v in np.cumsum(IN_WIDTHS)[:-1])

kernel_name = 'hybrid_gdn_ret_nsa_fox_moe_block'


def layer_norm(x, g, b):
    xf = x.astype(jnp.float32)
    mu = xf.mean(-1, keepdims=True)
    var = jnp.square(xf - mu).mean(-1, keepdims=True)
    return ((xf - mu) * lax.rsqrt(var + LN_EPS)).astype(x.dtype) * g + b


def rms_normalize(x):
    xf = x.astype(jnp.float32)
    return xf * lax.rsqrt(jnp.mean(jnp.square(xf), -1, keepdims=True) + 1e-6)


def l2_normalize(x):
    xf = x.astype(jnp.float32)
    return (xf * lax.rsqrt(jnp.sum(jnp.square(xf), -1, keepdims=True) + 1e-6)).astype(x.dtype)


def split_heads(x):
    b, s, _ = x.shape
    return x.reshape(b, s, N_HEADS, HEAD_DIM).transpose(0, 2, 1, 3)


def merge_heads(x):
    b, h, s, d = x.shape
    return x.transpose(0, 2, 1, 3).reshape(b, s, h * d)


def to_chunks(t, size):
    return t.reshape(t.shape[:2] + (t.shape[2] // size, size) + t.shape[3:])


def masked_softmax(s, mask):
    s = jnp.where(mask, s.astype(jnp.float32), -jnp.inf)
    m = jnp.max(s, -1, keepdims=True)
    m = jnp.where(jnp.isfinite(m), m, 0.0)
    e = jnp.exp(s - m)
    den = e.sum(-1, keepdims=True)
    return e / jnp.where(den > 0, den, 1.0)


def causal_depthwise_conv(x, w):
    k, ch = w.shape
    return lax.conv_general_dilated(x, w[:, None, :].astype(x.dtype), window_strides=(1,), padding=[(k - 1, 0)],
                                    dimension_numbers=('NWC', 'WIO', 'NWC'), feature_group_count=ch)


def rope(x, positions):
    half = HEAD_DIM // 2
    inv_freq = ROPE_BASE ** (-jnp.arange(half, dtype=jnp.float32) / half)
    ang = positions.astype(jnp.float32)[:, None, :, None] * inv_freq
    cos, sin = jnp.cos(ang), jnp.sin(ang)
    x1, x2 = x[..., :half], x[..., half:]
    return jnp.concatenate([x1 * cos - x2 * sin, x1 * sin + x2 * cos], -1).astype(x.dtype)


def ada_modulation(c, w, b):
    mod = jax.nn.silu(c) @ w + b
    shift, scale, gate = jnp.split(mod[:, None, :], 3, axis=-1)
    return shift, scale, gate


def gated_deltanet(q, k, v, a, b, z, conv_w, a_log, dt_bias, norm_w):
    bsz, s, _ = q.shape
    qkv = jax.nn.silu(causal_depthwise_conv(jnp.concatenate([q, k, v], -1), conv_w))
    q, k, v = jnp.split(qkv, 3, axis=-1)
    q = l2_normalize(split_heads(q)) * HEAD_DIM ** -0.5
    k = l2_normalize(split_heads(k))
    v = split_heads(v)
    beta = jax.nn.sigmoid(b.astype(jnp.float32)).transpose(0, 2, 1)
    log_a = (-jnp.exp(a_log.astype(jnp.float32)) * jax.nn.softplus(a.astype(jnp.float32) + dt_bias)).transpose(0, 2, 1)
    C = GDN_CHUNK
    q, k, v, beta, log_a = (to_chunks(t, C) for t in (q, k, v, beta, log_a))
    bcum = jnp.cumsum(log_a, -1)
    incl = jnp.tril(jnp.ones((C, C), bool))
    strict = jnp.tril(jnp.ones((C, C), bool), -1)
    decay_incl = jnp.exp(jnp.where(incl, bcum[..., :, None] - bcum[..., None, :], -jnp.inf))
    decay_strict = jnp.where(strict, decay_incl, 0.0)
    lower = beta[..., :, None] * jnp.einsum('bhnid,bhnjd->bhnij', k, k) * decay_strict
    rhs = jnp.concatenate([beta[..., None] * v, (beta * jnp.exp(bcum))[..., None] * k], -1)
    sol = lax.linalg.triangular_solve(lower, rhs, left_side=True, lower=True, unit_diagonal=True)
    u0, w = jnp.split(sol, 2, axis=-1)
    attn = jnp.einsum('bhnid,bhnjd->bhnij', q, k) * decay_incl
    q_dec = q * jnp.exp(bcum)[..., None]
    k_dec = k * jnp.exp(bcum[..., -1:] - bcum)[..., None]
    chunk_decay = jnp.exp(bcum[..., -1])

    def step(state, xs):
        u0_n, w_n, attn_n, q_n, k_n, g_n = xs
        u = u0_n - jnp.einsum('bhck,bhkv->bhcv', w_n, state)
        o = jnp.einsum('bhck,bhkv->bhcv', q_n, state) + jnp.einsum('bhcs,bhsv->bhcv', attn_n, u)
        state = g_n[..., None, None] * state + jnp.einsum('bhck,bhcv->bhkv', k_n, u)
        return state, o

    xs = tuple(jnp.moveaxis(t, 2, 0) for t in (u0, w, attn, q_dec, k_dec, chunk_decay))
    state0 = jnp.zeros((bsz, N_HEADS, HEAD_DIM, HEAD_DIM), jnp.float32)
    _, o = lax.scan(step, state0, xs)
    o = jnp.moveaxis(o, 0, 2).reshape(bsz, N_HEADS, s, HEAD_DIM)
    o = merge_heads(rms_normalize(o) * norm_w) * jax.nn.silu(z)
    return o.astype(z.dtype)


def retention(q, k, v, g, positions, gn_w):
    bsz, s, _ = q.shape
    q = rope(split_heads(q), positions)
    k = rope(split_heads(k), positions) * HEAD_DIM ** -0.5
    v = split_heads(v)
    C = RET_CHUNK
    log_gamma = jnp.log1p(-(2.0 ** (-5.0 - jnp.arange(N_HEADS, dtype=jnp.float32))))
    idx = jnp.arange(C, dtype=jnp.float32)
    rel = idx[:, None] - idx[None, :]
    inner_decay = jnp.where(rel >= 0, jnp.exp(jnp.maximum(rel, 0.0) * log_gamma[:, None, None]), 0.0)
    xi = jnp.exp((idx + 1.0) * log_gamma[:, None])
    zeta = jnp.exp((C - 1.0 - idx) * log_gamma[:, None])
    chunk_decay = jnp.exp(C * log_gamma)
    qc, kc, vc = (to_chunks(t, C) for t in (q, k, v))
    scores = jnp.einsum('bhnid,bhnjd->bhnij', qc, kc) * inner_decay[:, None]
    inner = jnp.einsum('bhnij,bhnjd->bhnid', scores, vc)
    kv = jnp.einsum('bhnck,bhncv->bhnkv', kc * zeta[:, None, :, None], vc)

    def step(state, kv_n):
        return chunk_decay[None, :, None, None] * state + kv_n, state

    state0 = jnp.zeros((bsz, N_HEADS, HEAD_DIM, HEAD_DIM), jnp.float32)
    _, r_prev = lax.scan(step, state0, jnp.moveaxis(kv, 2, 0))
    r_prev = jnp.moveaxis(r_prev, 0, 2)
    cross = jnp.einsum('bhnck,bhnkv->bhncv', qc, r_prev) * xi[:, None, :, None]
    o = (inner + cross).reshape(bsz, N_HEADS, s, HEAD_DIM).astype(jnp.float32)
    mu = o.mean(-1, keepdims=True)
    var = jnp.square(o - mu).mean(-1, keepdims=True)
    o = merge_heads((o - mu) * lax.rsqrt(var + LN_EPS)) * gn_w
    return (jax.nn.silu(g) * o).astype(g.dtype)


def native_sparse_attention(q, k_cmp_in, v_cmp_in, k_sel_in, v_sel_in, k_win_in, v_win_in, gate_logits,
                            cmp_pe, ck_w1, ck_w2, cv_w1, cv_w2):
    bsz, s, _ = q.shape
    q = split_heads(q)
    scale = HEAD_DIM ** -0.5
    n_cmp = (s - NSA_CMP_LEN) // NSA_CMP_STRIDE + 1
    cmp_start = jnp.arange(n_cmp) * NSA_CMP_STRIDE
    cmp_tok = cmp_start[:, None] + jnp.arange(NSA_CMP_LEN)[None, :]

    def compress(t, w1, w2):
        blocks = (t[:, cmp_tok] + cmp_pe).reshape(bsz, n_cmp, NSA_CMP_LEN * HEAD_DIM)
        return jax.nn.silu(blocks @ w1) @ w2

    k_cmp = compress(k_cmp_in, ck_w1, ck_w2)
    v_cmp = compress(v_cmp_in, cv_w1, cv_w2)
    cmp_end = cmp_start + NSA_CMP_LEN - 1
    n_sel = s // NSA_SEL_LEN
    sel_start = jnp.arange(n_sel) * NSA_SEL_LEN
    overlap = jnp.clip(jnp.minimum(cmp_start[:, None] + NSA_CMP_LEN, sel_start[None, :] + NSA_SEL_LEN)
                       - jnp.maximum(cmp_start[:, None], sel_start[None, :]), 0, NSA_CMP_LEN).astype(jnp.float32) / NSA_CMP_LEN
    n_top = min(NSA_TOP_N, n_sel)
    k_blk = k_sel_in.reshape(bsz, n_sel, NSA_SEL_LEN, HEAD_DIM)
    v_blk = v_sel_in.reshape(bsz, n_sel, NSA_SEL_LEN, HEAD_DIM)
    k_win = jnp.pad(k_win_in, ((0, 0), (NSA_WINDOW, 0), (0, 0)))
    v_win = jnp.pad(v_win_in, ((0, 0), (NSA_WINDOW, 0), (0, 0)))
    gates = jax.nn.sigmoid(gate_logits.astype(jnp.float32)).reshape(bsz, s, N_HEADS, 3)
    blk_ids = jnp.arange(n_sel)
    blk_off = jnp.arange(NSA_SEL_LEN)
    win_off = jnp.arange(NSA_WINDOW + NSA_Q_BLOCK)
    gather = jax.vmap(lambda blocks, idx: blocks[idx])

    def block(i):
        t0 = i * NSA_Q_BLOCK
        tpos = t0 + jnp.arange(NSA_Q_BLOCK)
        qb = lax.dynamic_slice_in_dim(q, t0, NSA_Q_BLOCK, axis=2)
        p_cmp = masked_softmax(jnp.einsum('bhqd,bnd->bhqn', qb, k_cmp) * scale, cmp_end[None, :] <= tpos[:, None])
        o_cmp = jnp.einsum('bhqn,bnd->bhqd', p_cmp, v_cmp)
        importance = jnp.einsum('bhqn,nj->bqj', p_cmp, overlap)
        cur = tpos // NSA_SEL_LEN
        forced = (blk_ids[None, :] == 0) | (blk_ids[None, :] == cur[:, None]) | (blk_ids[None, :] == cur[:, None] - 1)
        causal_blk = sel_start[None, :] <= tpos[:, None]
        score = jnp.where(forced, NSA_FORCE_SCORE, jnp.where(causal_blk, importance, -1.0))
        _, sel = lax.top_k(score, n_top)
        k_g = gather(k_blk, sel).reshape(bsz, NSA_Q_BLOCK, n_top * NSA_SEL_LEN, HEAD_DIM)
        v_g = gather(v_blk, sel).reshape(bsz, NSA_Q_BLOCK, n_top * NSA_SEL_LEN, HEAD_DIM)
        kpos = (sel[..., None] * NSA_SEL_LEN + blk_off).reshape(bsz, NSA_Q_BLOCK, n_top * NSA_SEL_LEN)
        p_sel = masked_softmax(jnp.einsum('bhqd,bqkd->bhqk', qb, k_g) * scale, (kpos <= tpos[None, :, None])[:, None])
        o_sel = jnp.einsum('bhqk,bqkd->bhqd', p_sel, v_g)
        kw = lax.dynamic_slice_in_dim(k_win, t0, NSA_WINDOW + NSA_Q_BLOCK, axis=1)
        vw = lax.dynamic_slice_in_dim(v_win, t0, NSA_WINDOW + NSA_Q_BLOCK, axis=1)
        wpos = t0 - NSA_WINDOW + win_off
        wmask = (wpos[None, :] >= 0) & (wpos[None, :] <= tpos[:, None]) & (wpos[None, :] > tpos[:, None] - NSA_WINDOW)
        p_win = masked_softmax(jnp.einsum('bhqd,bkd->bhqk', qb, kw) * scale, wmask)
        o_win = jnp.einsum('bhqk,bkd->bhqd', p_win, vw)
        g = lax.dynamic_slice_in_dim(gates, t0, NSA_Q_BLOCK, axis=1).transpose(0, 2, 1, 3)
        return g[..., 0:1] * o_cmp + g[..., 1:2] * o_sel + g[..., 2:3] * o_win

    o = lax.map(block, jnp.arange(s // NSA_Q_BLOCK))
    return o.transpose(1, 0, 3, 2, 4).reshape(bsz, s, MIX_W).astype(k_cmp_in.dtype)


def forgetting_attention(q, k, v, f_logit, f_bias):
    bsz, s, _ = q.shape
    q, k, v = split_heads(q), split_heads(k), split_heads(v)
    scale = HEAD_DIM ** -0.5
    log_f = jax.nn.log_sigmoid(f_logit.astype(jnp.float32) + f_bias).transpose(0, 2, 1)
    cum = jnp.cumsum(log_f, -1)
    kpos = jnp.arange(s)

    def block(i):
        t0 = i * Q_BLOCK
        tpos = t0 + jnp.arange(Q_BLOCK)
        qb = lax.dynamic_slice_in_dim(q, t0, Q_BLOCK, axis=2)
        cb = lax.dynamic_slice_in_dim(cum, t0, Q_BLOCK, axis=2)
        logits = jnp.einsum('bhqd,bhkd->bhqk', qb, k) * scale + (cb[..., :, None] - cum[..., None, :])
        p = masked_softmax(logits, kpos[None, :] <= tpos[:, None])
        return jnp.einsum('bhqk,bhkd->bhqd', p, v)

    o = lax.map(block, jnp.arange(s // Q_BLOCK))
    return o.transpose(1, 0, 3, 2, 4).reshape(bsz, s, MIX_W).astype(v.dtype)


def hybrid_mixer(h, positions, w_in, gdn_conv_w, gdn_a_log, gdn_dt_bias, gdn_norm_w, ret_gn_w,
                 nsa_cmp_pe, nsa_ck_w1, nsa_ck_w2, nsa_cv_w1, nsa_cv_w2, fox_f_bias, branch_proj, w_gate, w_out):
    proj = jnp.einsum('bsd,de->bse', h, w_in)
    (gq, gk, gv, ga, gb, gz, rq, rk, rv, rg, nq, nkc, nvc, nks, nvs, nkw, nvw, ngate,
     fq, fk, fv, ff) = jnp.split(proj, IN_SPLITS, axis=-1)
    o_gdn = gated_deltanet(gq, gk, gv, ga, gb, gz, gdn_conv_w, gdn_a_log, gdn_dt_bias, gdn_norm_w)
    o_ret = retention(rq, rk, rv, rg, positions, ret_gn_w)
    o_nsa = native_sparse_attention(nq, nkc, nvc, nks, nvs, nkw, nvw, ngate, nsa_cmp_pe,
                                    nsa_ck_w1, nsa_ck_w2, nsa_cv_w1, nsa_cv_w2)
    o_fox = forgetting_attention(fq, fk, fv, ff, fox_f_bias)
    merged = [jax.nn.sigmoid(h @ w_gate[i]) * (o.astype(h.dtype) @ branch_proj[i])
              for i, o in enumerate((o_gdn, o_ret, o_nsa, o_fox))]
    y = merged[0] + merged[1] + merged[2] + merged[3]
    return y @ w_out


def moe(h, router_w, router_b, w1, w3, w2):
    bsz, s, _ = h.shape
    scores = jax.nn.sigmoid(jnp.einsum('bsd,de->bse', h, router_w).astype(jnp.float32))
    biased = scores + router_b.astype(jnp.float32)
    group_score = lax.top_k(biased.reshape(bsz, s, N_GROUPS, EXPERTS_PER_GROUP), TOP_K)[0].sum(-1)
    group = jnp.argmax(group_score, axis=-1)
    in_group = (jnp.arange(N_EXPERTS) // EXPERTS_PER_GROUP) == group[..., None]
    _, top_idx = lax.top_k(jnp.where(in_group, biased, -jnp.inf), TOP_K)
    top_w = jnp.take_along_axis(scores, top_idx, axis=-1)
    top_w = top_w / top_w.sum(-1, keepdims=True)
    combine = jnp.sum(jax.nn.one_hot(top_idx, N_EXPERTS, dtype=jnp.float32) * top_w[..., None], axis=-2).astype(h.dtype)

    def per_sequence(args):
        hs, cs = args
        hidden = jax.nn.silu(jnp.einsum('sd,edf->sef', hs, w1)) * jnp.einsum('sd,edf->sef', hs, w3)
        return jnp.einsum('sef,efd->sd', hidden * cs[..., None], w2)

    return lax.map(per_sequence, (h, combine))


def setup_inputs(seed: int = 0) -> dict:
    key = jax.random.key(seed)
    ks = jax.random.split(key, 32)
    f32 = jnp.float32

    def nrm(k, shape, scale):
        return jax.random.normal(k, shape, f32) * scale

    dt = jnp.exp(jax.random.uniform(ks[7], (DEPTH, N_HEADS), f32, math.log(1e-3), math.log(1e-1)))
    return {
        'x': nrm(ks[0], (BATCH, SEQ, D_MODEL), 1.0),
        'c': nrm(ks[1], (BATCH, D_MODEL), 1.0),
        'positions': jnp.tile(jnp.arange(SEQ, dtype=jnp.int32)[None, :], (BATCH, 1)),
        'ada_w': nrm(ks[2], (DEPTH, 2, D_MODEL, 3 * D_MODEL), 0.5 * D_MODEL ** -0.5),
        'ada_b': nrm(ks[3], (DEPTH, 2, 3 * D_MODEL), 0.02),
        'w_in': nrm(ks[4], (DEPTH, D_MODEL, IN_WIDTH), D_MODEL ** -0.5),
        'gdn_conv_w': nrm(ks[5], (DEPTH, CONV_K, 3 * MIX_W), CONV_K ** -0.5),
        'gdn_a_log': jnp.log(jax.random.uniform(ks[6], (DEPTH, N_HEADS), f32, 1.0, 16.0)),
        'gdn_dt_bias': dt + jnp.log(-jnp.expm1(-dt)),
        'gdn_norm_w': 1.0 + nrm(ks[8], (DEPTH, HEAD_DIM), 0.02),
        'ret_gn_w': 1.0 + nrm(ks[9], (DEPTH, MIX_W), 0.02),
        'nsa_cmp_pe': nrm(ks[10], (DEPTH, NSA_CMP_LEN, HEAD_DIM), 0.02),
        'nsa_ck_w1': nrm(ks[11], (DEPTH, NSA_CMP_LEN * HEAD_DIM, NSA_CMP_HIDDEN), (NSA_CMP_LEN * HEAD_DIM) ** -0.5),
        'nsa_ck_w2': nrm(ks[12], (DEPTH, NSA_CMP_HIDDEN, HEAD_DIM), NSA_CMP_HIDDEN ** -0.5),
        'nsa_cv_w1': nrm(ks[13], (DEPTH, NSA_CMP_LEN * HEAD_DIM, NSA_CMP_HIDDEN), (NSA_CMP_LEN * HEAD_DIM) ** -0.5),
        'nsa_cv_w2': nrm(ks[14], (DEPTH, NSA_CMP_HIDDEN, HEAD_DIM), NSA_CMP_HIDDEN ** -0.5),
        'fox_f_bias': jnp.linspace(3.0, 6.0, N_HEADS, dtype=f32)[None, :] + nrm(ks[15], (DEPTH, N_HEADS), 0.1),
        'branch_proj': nrm(ks[16], (DEPTH, N_BRANCH, MIX_W, D_MODEL), DN_BETA * MIX_W ** -0.5),
        'w_gate': nrm(ks[17], (DEPTH, N_BRANCH, D_MODEL, D_MODEL), D_MODEL ** -0.5),
        'w_out': nrm(ks[18], (DEPTH, D_MODEL, D_MODEL), DN_BETA * D_MODEL ** -0.5),
        'ln_g': 1.0 + nrm(ks[19], (DEPTH, 2, D_MODEL), 0.02),
        'ln_b': nrm(ks[20], (DEPTH, 2, D_MODEL), 0.02),
        'router_w': nrm(ks[21], (D_MODEL, N_EXPERTS), D_MODEL ** -0.5),
        'router_b': nrm(ks[22], (N_EXPERTS,), 0.01),
        'exp_w1': nrm(ks[23], (DEPTH, N_EXPERTS, D_MODEL, D_EXPERT), D_MODEL ** -0.5),
        'exp_w3': nrm(ks[24], (DEPTH, N_EXPERTS, D_MODEL, D_EXPERT), D_MODEL ** -0.5),
        'exp_w2': nrm(ks[25], (DEPTH, N_EXPERTS, D_EXPERT, D_MODEL), DN_BETA * D_EXPERT ** -0.5),
    }


def reference(x, c, positions, ada_w, ada_b, w_in, gdn_conv_w, gdn_a_log, gdn_dt_bias, gdn_norm_w,
              ret_gn_w, nsa_cmp_pe, nsa_ck_w1, nsa_ck_w2, nsa_cv_w1, nsa_cv_w2, fox_f_bias,
              branch_proj, w_gate, w_out, ln_g, ln_b, router_w, router_b, exp_w1, exp_w3, exp_w2):
    for l in range(DEPTH):
        shift, scale, gate = ada_modulation(c, ada_w[l, 0], ada_b[l, 0])
        h = x * (1.0 + scale) + shift
        y = hybrid_mixer(h, positions, w_in[l], gdn_conv_w[l], gdn_a_log[l], gdn_dt_bias[l], gdn_norm_w[l],
                         ret_gn_w[l], nsa_cmp_pe[l], nsa_ck_w1[l], nsa_ck_w2[l], nsa_cv_w1[l], nsa_cv_w2[l],
                         fox_f_bias[l], branch_proj[l], w_gate[l], w_out[l])
        x = layer_norm(DN_ALPHA * x + gate * y, ln_g[l, 0], ln_b[l, 0])
        shift, scale, gate = ada_modulation(c, ada_w[l, 1], ada_b[l, 1])
        h = x * (1.0 + scale) + shift
        y = moe(h, router_w, router_b, exp_w1[l], exp_w3[l], exp_w2[l])
        x = layer_norm(DN_ALPHA * x + gate * y, ln_g[l, 1], ln_b[l, 1])
    return x
```

```cpp
#include <hip/hip_runtime.h>
#include <stdint.h>
#include <stdio.h>

#define GAS __attribute__((address_space(1)))
#define LAS __attribute__((address_space(3)))
typedef unsigned short bf16_t;
typedef short bf16x8 __attribute__((ext_vector_type(8)));
typedef short s16x4 __attribute__((ext_vector_type(4)));
typedef float f32x2 __attribute__((ext_vector_type(2)));
typedef float f32x4 __attribute__((ext_vector_type(4)));
typedef float f32x16 __attribute__((ext_vector_type(16)));
typedef unsigned u32x2 __attribute__((ext_vector_type(2)));
typedef unsigned u32x4 __attribute__((ext_vector_type(4)));
typedef __bf16 bf16x2_t __attribute__((ext_vector_type(2)));

constexpr int D_MODEL = 1024, BATCH = 16, SEQ = 4096, DEPTH = 2, MTOK = BATCH * SEQ;
constexpr int NCHUNK = 2, BC = BATCH / NCHUNK, MC = BC * SEQ;
constexpr int NPROJ = 3584, PROJW = 3072;
constexpr float DN_ALPHA = 1.4142135623730951f;
constexpr float LN_EPS = 1e-5f;
constexpr float LOG2E = 1.4426950408889634f;
constexpr float QSCALE = 0.125f * 1.4426950408889634f;
constexpr int NWG = 256, NTHR = 512;
constexpr int LDS_BYTES = 163840;

constexpr int PC_GQ = 0, PC_GK = 256, PC_GV = 512, PC_GZ = 768, PC_RQ = 1024, PC_RK = 1280, PC_RV = 1536, PC_RG = 1792, PC_NQ = 2048, PC_FQ = 2304, PC_FK = 2560, PC_FV = 2816;

constexpr size_t MiB = 1ull << 20;
constexpr size_t WS_CTL = 0;
constexpr size_t CTL_BYTES = 1 * MiB;
constexpr size_t WS_MOD = 1 * MiB;
constexpr size_t WS_ROPE = 2 * MiB;
constexpr size_t WS_STATS = 18 * MiB;
constexpr size_t WS_CBIAS = 19 * MiB;
constexpr size_t WS_W = 20 * MiB;
constexpr size_t LW_WIN = 0;
constexpr size_t LW_WGV = LW_WIN + (size_t)NPROJ * 1024 * 2;
constexpr size_t LW_BPT = LW_WGV + (size_t)4096 * 1024 * 2;
constexpr size_t LW_WOT = LW_BPT + (size_t)4096 * 256 * 2;
constexpr size_t LW_W13 = LW_WOT + (size_t)1024 * 1024 * 2;
constexpr size_t LW_W2 = LW_W13 + (size_t)16 * 1024 * 1024 * 2;
constexpr size_t LW_CW1 = LW_W2 + (size_t)16 * 1024 * 512 * 2;
constexpr size_t LW_CW2 = LW_CW1 + (size_t)2 * 256 * 2048 * 2;
constexpr size_t LW_BYTES = LW_CW2 + (size_t)2 * 256 * 256 * 2;
constexpr size_t WS_H = WS_W + 2 * ((LW_BYTES + MiB - 1) / MiB) * MiB;
constexpr size_t WS_R = WS_H + 128 * MiB;
constexpr size_t R_PROJ = 0;
constexpr size_t R_GDN = R_PROJ + (size_t)MC * PROJW * 2;
constexpr size_t GDN_UNIT_BYTES = 5 * 8192;
constexpr size_t R_P = 0;
constexpr size_t R_NKV = R_GDN + (size_t)BC * 4 * 64 * GDN_UNIT_BYTES;
constexpr size_t NKV_SEG = (size_t)(MC + 64) * 64 * 2;
constexpr size_t R_SM = R_NKV + 6 * NKV_SEG;
constexpr size_t R_CUM = R_SM + (size_t)MC * 32 * 4;
constexpr size_t R_GG = R_CUM + (size_t)BC * 4 * 4096 * 4;
constexpr size_t R_KCMP = R_GG + (size_t)BC * 4 * 64 * 4 + 768;
constexpr size_t R_H1 = R_KCMP + (size_t)2 * BC * 256 * 64 * 2;
constexpr size_t R_O = R_H1 + (size_t)2 * BC * 256 * 256 * 2;
constexpr size_t R_Y = R_O + (size_t)4 * MC * 256 * 2;
constexpr size_t R_MIX_END = R_Y + (size_t)MC * 1024 * 2;
static_assert(R_NKV >= (size_t)MC * 4096 * 2, "P overlay fits under PROJ+GDN");
constexpr size_t R_LIST = 0;
constexpr size_t R_CW = R_LIST + (size_t)16 * MTOK * 4;
constexpr size_t R_HID = R_CW + (size_t)16 * MTOK * 4;
constexpr size_t R_OUT2 = R_HID + (size_t)(2 * MTOK + 4096) * 512 * 2;
constexpr size_t R_MOE_END = R_OUT2 + (size_t)2 * MTOK * 1024 * 2;
constexpr size_t WS_END = WS_R + (R_MIX_END > R_MOE_END ? R_MIX_END : R_MOE_END);

constexpr int CW_BAR = 4096;
constexpr int CW_CNT = 8192;
constexpr int CW_Q = 8448;

__device__ __forceinline__ float bf2f(bf16_t v) { return __uint_as_float(((unsigned)v) << 16); }
__device__ __forceinline__ unsigned pk2(float lo, float hi) { f32x2 v = {lo, hi}; bf16x2_t b = __builtin_convertvector(v, bf16x2_t); return __builtin_bit_cast(unsigned, b); }
__device__ __forceinline__ bf16_t f2bf(float f) { return (bf16_t)(pk2(f, 0.f) & 0xffffu); }
__device__ __forceinline__ float ex2(float x) { return __builtin_amdgcn_exp2f(x); }
__device__ __forceinline__ float sigmoidf_(float x) { return __builtin_amdgcn_rcpf(1.0f + __expf(-x)); }
__device__ __forceinline__ float siluf_(float x) { return x * __builtin_amdgcn_rcpf(1.0f + __expf(-x)); }
__device__ __forceinline__ int crow(int r, int hi) { return (r & 3) + 8 * (r >> 2) + 4 * hi; }
__device__ __forceinline__ float wave_sum(float v) {
#pragma unroll
    for (int o = 32; o >= 1; o >>= 1) v += __shfl_xor(v, o);
    return v;
}
#define VM_WAIT() asm volatile("s_waitcnt vmcnt(0)" ::: "memory")

#define XB_TMO      128
#define XB_XCNT(j)  (256  + 64 * (j))
#define XB_XSUB(j)  (1280 + 64 * (j))
#define XB_XGEN(j)  (2304 + 64 * (j))
#define XB_TOP      3328
#define XB_TOPGEN   3392
#define XCD_BAR_WORDS 3456
#define XB_SPIN_CAP (1u << 22)

__device__ __forceinline__ unsigned xb_ld(unsigned* p)              { return __hip_atomic_load(p, __ATOMIC_RELAXED, __HIP_MEMORY_SCOPE_AGENT); }
__device__ __forceinline__ unsigned xb_add(unsigned* p, unsigned v) { return __hip_atomic_fetch_add(p, v, __ATOMIC_RELAXED, __HIP_MEMORY_SCOPE_AGENT); }
__device__ __forceinline__ unsigned xb_xcc_id() { return (unsigned)__builtin_amdgcn_s_getreg((3 << 11) | 20) & 0xFu; }
#define XB_SPIN(cond, bar) do { unsigned _sp = 0; while (cond) { __builtin_amdgcn_s_sleep(1); \
    if ((++_sp & 255u) == 0u) { if (xb_ld(&(bar)[XB_TMO])) break; if (_sp > XB_SPIN_CAP) { atomicAdd(&(bar)[XB_TMO], 1u); break; } } } } while (0)

struct XcdBarrier { unsigned* bar; unsigned x; volatile LAS unsigned* st; };

__device__ __forceinline__ XcdBarrier xcd_barrier_post(unsigned* bar, volatile LAS unsigned* st, int tid) {
    XcdBarrier b; b.bar = bar; b.x = xb_xcc_id(); b.st = st;
    if (tid == 0) (void)xb_add(&bar[XB_XCNT(b.x)], 1u);
    return b;
}
__device__ __forceinline__ void xcd_barrier_complete(unsigned* bar, unsigned x, unsigned& nloc, unsigned& nx) {
    const unsigned G = NWG;
    unsigned sum, cnt, mine, sp = 0u;
    for (;;) {
        sum = 0u; cnt = 0u; mine = 0u;
#pragma unroll
        for (unsigned j = 0; j < 16; ++j) { const unsigned c = xb_ld(&bar[XB_XCNT(j)]); sum += c; cnt += (c > 0u) ? 1u : 0u; mine = (j == x) ? c : mine; }
        if (sum == G) break;
        __builtin_amdgcn_s_sleep(1);
        if ((++sp & 255u) == 0u) { if (xb_ld(&bar[XB_TMO])) break; if (sp > XB_SPIN_CAP) { atomicAdd(&bar[XB_TMO], 1u); break; } }
    }
    nloc = mine > 0u ? mine : 1u; nx = cnt > 0u ? cnt : 1u;
}
__device__ __forceinline__ void xcd_barrier(const XcdBarrier& b, int tid) {
    asm volatile("s_waitcnt vmcnt(0)" ::: "memory");
    __syncthreads();
    if (tid == 0) {
        unsigned* bar = b.bar;
        __builtin_amdgcn_s_waitcnt(0);
        unsigned nloc = b.st[0], nx = b.st[1];
        if (nloc == 0u) { xcd_barrier_complete(bar, b.x, nloc, nx); b.st[0] = nloc; b.st[1] = nx; }
        const unsigned old = xb_add(&bar[XB_XSUB(b.x)], 1u);
        const unsigned gen = old / nloc;
        if (old + 1u == (gen + 1u) * nloc) {
            __builtin_amdgcn_fence(__ATOMIC_RELEASE, "agent");
            asm volatile("s_waitcnt vmcnt(0)" ::: "memory");
            const unsigned og = xb_add(&bar[XB_TOP], 1u);
            const unsigned tg = og / nx;
            if (og + 1u == (tg + 1u) * nx) xb_add(&bar[XB_TOPGEN], 1u);
            else XB_SPIN(xb_ld(&bar[XB_TOPGEN]) == tg, bar);
            __builtin_amdgcn_fence(__ATOMIC_ACQUIRE, "agent");
            xb_add(&bar[XB_XGEN(b.x)], 1u);
            asm volatile("s_waitcnt vmcnt(0)" ::: "memory");
        } else {
            XB_SPIN(xb_ld(&bar[XB_XGEN(b.x)]) == gen, bar);
            __builtin_amdgcn_fence(__ATOMIC_ACQUIRE, "agent");
            asm volatile("s_waitcnt vmcnt(0)" ::: "memory");
        }
    }
    __syncthreads();
}

struct Params {
    const float* in[27];
    float* out;
    unsigned char* ws;
    int ph_lo, ph_hi;
};
__device__ __forceinline__ LAS unsigned char* lds_at(int off) { asm volatile("" : "+s"(off)); return (LAS unsigned char*)(unsigned)off; }
constexpr int LDS_PTAB = LDS_BYTES - 512;
__device__ __forceinline__ void ptab_store(const Params& p, int tid) {
    LAS unsigned long long* t = (LAS unsigned long long*)lds_at(LDS_PTAB);
    if (tid == 0) {
#pragma unroll
        for (int i = 0; i < 27; ++i) t[i] = (unsigned long long)p.in[i];
        t[27] = (unsigned long long)p.out; t[28] = (unsigned long long)p.ws; }
}
__device__ __forceinline__ unsigned long long ptab_get(int i) {
    const LAS unsigned* t = (const LAS unsigned*)lds_at(LDS_PTAB) + 2 * i;
    const unsigned lo = __builtin_amdgcn_readfirstlane(t[0]), hi = __builtin_amdgcn_readfirstlane(t[1]);
    return ((unsigned long long)hi << 32) | lo;
}
__device__ __forceinline__ unsigned char* ws_late() { return (unsigned char*)ptab_get(28); }
#define PIN(i) ((const float*)ptab_get(i))
__device__ __forceinline__ void ptab_load(Params& q) {
    asm volatile("" ::: "memory");
#pragma unroll
    for (int i = 0; i < 27; ++i) q.in[i] = (const float*)ptab_get(i);
    q.out = (float*)ptab_get(27); q.ws = (unsigned char*)ptab_get(28); q.ph_lo = 0; q.ph_hi = 0;
}

namespace pg8 {
constexpr int BM = 256, BK = 64, HALF = 128, HTB = HALF * BK * 2, NXCD = 8, WGM = 8;
__device__ __forceinline__ int lds_byte(int r, int c) { const int st = (r >> 4) * 2 + (c >> 5), rr = r & 15, cc = c & 31, ob = rr * 64 + cc * 2; return st * 1024 + (ob ^ (((ob >> 9) & 1) << 5)); }
__device__ __forceinline__ void stage_rc(int b, int& R, int& C) { const int st = b / 1024, sb = b % 1024, swz = sb ^ (((sb >> 9) & 1) << 5); R = (st >> 1) * 16 + swz / 64; C = (st & 1) * 32 + (swz % 64) / 2; }
__device__ __forceinline__ int perm32(int rho) { const int n = rho >> 4, i = rho & 15; return 8 * (i >> 2) + 4 * n + (i & 3); }

struct Unit { unsigned a, b, rows; int pm, pn, aux, nvalid; };

__device__ __forceinline__ bool dense_unit(int i, int G, int c, int nM, int nN, int& pm, int& pn) {
    const int nwg = nM * nN; const long L = (long)i * G + c; if (L >= nwg) return false;
    int wgid = (int)L; { const int q = nwg / NXCD, r = nwg % NXCD, xcd = wgid % NXCD, off = wgid / NXCD; wgid = (xcd < r ? xcd * (q + 1) : r * (q + 1) + (xcd - r) * q) + off; }
    const int nig = WGM * nN, gid = wgid / nig, fm = gid * WGM, gsz = (nM - fm) < WGM ? (nM - fm) : WGM;
    pm = fm + ((wgid % nig) % gsz); pn = (wgid % nig) / gsz; return true;
}

template <class Epi, class Sched, bool ALIGN_EPI, bool GATHER>
__device__ __forceinline__ void gemm_phase(LAS unsigned char* lds, const int K, const int lda, const int ldb, const Sched& S, const Epi& E, const int tid, const char* wsb) {
    const int wid = __builtin_amdgcn_readfirstlane(tid >> 6), lane = tid & 63, wr = wid >> 2, wc = wid & 3, fr = lane & 15, fq = lane >> 4;
    const int nt = K / BK;
    unsigned voffA[2], voffB[2]; int rA[2], cA2[2];
#pragma unroll
    for (int i = 0; i < 2; ++i) { int R, C; stage_rc(tid * 16 + i * 8192, R, C); const int Rb = Epi::PERM ? ((R & ~31) + perm32(R & 31)) : R;
        rA[i] = R; cA2[i] = C * 2; voffA[i] = (unsigned)(R * lda + C) * 2u; voffB[i] = (unsigned)(Rb * ldb + C) * 2u; }
    const unsigned kstep = (unsigned)(BK * 2);
    const unsigned hstepA = GATHER ? 0u : (unsigned)(HALF * lda * 2), hstepB = (unsigned)(HALF * ldb * 2);
    const unsigned ldsw = (unsigned)wid * 1024u;
    const int aoff = lds_byte(wr * 64 + fr, fq * 8), boff = lds_byte(wc * 32 + fr, fq * 8);
#define PG8_SA(b, h) (((b) * 2 + (h)) * HTB)
#define PG8_SB(b, h) ((4 + (b) * 2 + (h)) * HTB)
#define PG8_STAGE(bufoff, gbase, voff) do { _Pragma("unroll") for (int _i = 0; _i < 2; ++_i) \
        __builtin_amdgcn_global_load_lds((const unsigned*)(wsb + (size_t)(unsigned)((gbase) + (voff)[_i])), (LAS unsigned*)(lds + (bufoff) + ldsw + _i * 8192), 16, 0, 0); } while (0)
#define PG8_LDA(dst, b, h) do { _Pragma("unroll") for (int m = 0; m < 4; ++m) _Pragma("unroll") for (int k = 0; k < 2; ++k) dst[m][k] = *(const LAS bf16x8*)(lds + PG8_SA(b, h) + aoff + m * 2048 + k * 1024); } while (0)
#define PG8_LDB(dst, b, h) do { _Pragma("unroll") for (int n = 0; n < 2; ++n) _Pragma("unroll") for (int k = 0; k < 2; ++k) dst[n][k] = *(const LAS bf16x8*)(lds + PG8_SB(b, h) + boff + n * 2048 + k * 1024); } while (0)
#define PG8_MMA(ai, bj, At, Bt) do { __builtin_amdgcn_s_setprio(1); _Pragma("unroll") for (int m = 0; m < 4; ++m) _Pragma("unroll") for (int n = 0; n < 2; ++n) _Pragma("unroll") for (int k = 0; k < 2; ++k) \
        acc[ai][bj][m][n] = __builtin_amdgcn_mfma_f32_16x16x32_bf16(Bt[n][k], At[m][k], acc[ai][bj][m][n], 0, 0, 0); __builtin_amdgcn_s_setprio(0); } while (0)
#define PG8_WAIT_V(n) asm volatile("s_waitcnt vmcnt(" #n ")" ::: "memory")
#define PG8_WAIT_L(n) asm volatile("s_waitcnt lgkmcnt(" #n ")" ::: "memory")
#define PG8_BAR __builtin_amdgcn_s_barrier()
#define PG8_SCHED __builtin_amdgcn_sched_barrier(0)
    Unit cur, nxt; int ui = 0;
    if (!S.next(0, cur)) return;
    f32x4 acc[2][2][4][2];
#pragma unroll
    for (int a = 0; a < 2; ++a)
#pragma unroll
        for (int b = 0; b < 2; ++b)
#pragma unroll
            for (int m = 0; m < 4; ++m)
#pragma unroll
                for (int n = 0; n < 2; ++n) acc[a][b][m][n] = (f32x4){0.f, 0.f, 0.f, 0.f};
    bf16x8 At[4][2], B0[2][2], B1[2][2];
    unsigned cA = cur.a, cB = cur.b;
    LAS unsigned* grec = (LAS unsigned*)(lds + 131072) + tid * 8;
    if constexpr (GATHER) {
#pragma unroll
        for (int i = 0; i < 2; ++i) { const unsigned o0 = (unsigned)S.row(cur, rA[i]) * (unsigned)(lda * 2) + cA2[i], o1 = (unsigned)S.row(cur, HALF + rA[i]) * (unsigned)(lda * 2) + cA2[i];
            grec[i] = o0; grec[2 + i] = o1; grec[4 + i] = o0; grec[6 + i] = o1; }
    }
#define PG8_STAGE_A(bufoff, kptr, h, usenext) do { if constexpr (GATHER) { const u32x2 _w = *(const LAS u32x2*)(grec + ((usenext) ? 4 : 0) + 2 * (h)); unsigned _v[2]; _v[0] = _w.x; _v[1] = _w.y; PG8_STAGE(bufoff, kptr, _v); } \
        else { PG8_STAGE(bufoff, (kptr) + (h) * hstepA, voffA); } } while (0)
    PG8_STAGE(PG8_SB(0, 0), cB, voffB); PG8_STAGE(PG8_SB(0, 1), cB + hstepB, voffB); PG8_STAGE_A(PG8_SA(0, 0), cA, 0, false); PG8_STAGE_A(PG8_SA(0, 1), cA, 1, false);
    if (wr == 1) PG8_BAR;
    PG8_WAIT_V(2); PG8_BAR;
    PG8_STAGE(PG8_SB(1, 0), cB + kstep, voffB); PG8_STAGE_A(PG8_SA(1, 0), cA + kstep, 0, false); PG8_STAGE(PG8_SB(1, 1), cB + hstepB + kstep, voffB);
    PG8_WAIT_V(6); PG8_BAR;
    for (;;) {
        const bool has_next = S.next(ui + 1, nxt);
        const unsigned nA = has_next ? nxt.a : cA, nB = has_next ? nxt.b : cB;
        for (int t = 0; t < nt; t += 2) {
            const bool last = (t == nt - 2);
            const unsigned a1 = cA + (unsigned)(t + 1) * kstep;
            const unsigned a2 = last ? nA : cA + (unsigned)(t + 2) * kstep, b2 = last ? nB : cB + (unsigned)(t + 2) * kstep;
            const unsigned a3 = a2 + kstep, b3 = b2 + kstep;
            if constexpr (GATHER) { if (last && has_next) {
#pragma unroll
                for (int i = 0; i < 2; ++i) { grec[4 + i] = (unsigned)S.row(nxt, rA[i]) * (unsigned)(lda * 2) + cA2[i]; grec[6 + i] = (unsigned)S.row(nxt, HALF + rA[i]) * (unsigned)(lda * 2) + cA2[i]; } } }
            PG8_LDB(B0, 0, 0); PG8_LDB(B1, 0, 1); PG8_SCHED; PG8_LDA(At, 0, 0); PG8_STAGE_A(PG8_SA(1, 1), a1, 1, false);
            PG8_WAIT_V(8); PG8_WAIT_L(0); PG8_BAR; PG8_MMA(0, 0, At, B0); PG8_MMA(0, 1, At, B1); PG8_BAR; PG8_SCHED;
            PG8_LDA(At, 0, 1); PG8_STAGE(PG8_SB(0, 0), b2, voffB); PG8_STAGE(PG8_SB(0, 1), b2 + hstepB, voffB); PG8_STAGE_A(PG8_SA(0, 0), a2, 0, last);
            PG8_WAIT_V(8); PG8_WAIT_L(0); PG8_BAR; PG8_MMA(1, 0, At, B0); PG8_MMA(1, 1, At, B1); PG8_BAR; PG8_SCHED;
            PG8_LDB(B0, 1, 0); PG8_LDB(B1, 1, 1); PG8_SCHED; PG8_LDA(At, 1, 0); PG8_STAGE_A(PG8_SA(0, 1), a2, 1, last);
            PG8_WAIT_V(8); PG8_WAIT_L(0); PG8_BAR; PG8_MMA(0, 0, At, B0); PG8_MMA(0, 1, At, B1); PG8_BAR; PG8_SCHED;
            PG8_LDA(At, 1, 1); PG8_STAGE(PG8_SB(1, 0), b3, voffB); PG8_STAGE(PG8_SB(1, 1), b3 + hstepB, voffB); PG8_STAGE_A(PG8_SA(1, 0), a3, 0, last);
            PG8_WAIT_V(8); PG8_WAIT_L(0); PG8_BAR; PG8_MMA(1, 0, At, B0); PG8_MMA(1, 1, At, B1); PG8_BAR; PG8_SCHED;
        }
        if constexpr (ALIGN_EPI) { if (wr == 0) PG8_BAR; }
        { int tz = tid; asm volatile("" : "+v"(tz)); const int ew = __builtin_amdgcn_readfirstlane(tz >> 6), el = tz & 63;
          E(acc, cur, ew >> 2, ew & 3, el & 15, el >> 4); }
        if (!has_next) break;
#pragma unroll
        for (int a = 0; a < 2; ++a)
#pragma unroll
            for (int b = 0; b < 2; ++b)
#pragma unroll
                for (int m = 0; m < 4; ++m)
#pragma unroll
                    for (int n = 0; n < 2; ++n) acc[a][b][m][n] = (f32x4){0.f, 0.f, 0.f, 0.f};
        cur = nxt; cA = nA; cB = nB; ++ui;
        if constexpr (GATHER) { const u32x4 _n = *(const LAS u32x4*)(grec + 4); *(LAS u32x4*)grec = _n; }
        if constexpr (ALIGN_EPI) { if (wr == 1) PG8_BAR; }
    }
    PG8_WAIT_V(0);
    if constexpr (!ALIGN_EPI) { if (wr == 0) PG8_BAR; }
    PG8_BAR;
#undef PG8_SA
#undef PG8_SB
#undef PG8_STAGE
#undef PG8_STAGE_A
#undef PG8_LDA
#undef PG8_LDB
#undef PG8_MMA
#undef PG8_WAIT_V
#undef PG8_WAIT_L
#undef PG8_BAR
#undef PG8_SCHED
}
}
using pg8::Unit;

struct DenseSched {
    unsigned A, Bt, tA, tB, aBr; int nM, nN, G, c, pnShift;
    __device__ __forceinline__ bool next(int i, Unit& u) const {
        int pm, pn; if (!pg8::dense_unit(i, G, c, nM, nN, pm, pn)) return false;
        u.pm = pm; u.pn = pn; u.aux = 0; u.nvalid = 256; u.rows = 0u;
        u.a = A + (unsigned)(pn >> pnShift) * aBr + (unsigned)pm * tA; u.b = Bt + (unsigned)pn * tB; return true;
    }
    __device__ __forceinline__ int row(const Unit&, int) const { return 0; }
};
struct OneSched {
    Unit u0; bool has;
    __device__ __forceinline__ bool next(int i, Unit& u) const { if (i > 0 || !has) return false; u = u0; return true; }
    __device__ __forceinline__ int row(const Unit&, int) const { return 0; }
};
struct MoeSched {
    const LAS int* pre;
    const LAS int* cnt;
    const char* wsb;
    unsigned A, W, wE, wT, aT; int G, c; bool gatherA;
    __device__ __forceinline__ bool next(int i, Unit& u) const {
        const long L = (long)i * G + c; const int total = pre[16] * 4; if (L >= total) return false;
        const int t = (int)(L >> 2), pn = (int)(L & 3); int e = 0;
#pragma unroll
        for (int j = 1; j < 16; ++j) e += (pre[j] <= t) ? 1 : 0;
        const int pm = t - pre[e];
        u.aux = e; u.pm = t; u.pn = pn; u.nvalid = min(256, cnt[e] - 256 * pm); u.rows = (unsigned)(WS_R + R_LIST) + (unsigned)(e * MTOK + 256 * pm) * 4u;
        u.a = gatherA ? A : A + (unsigned)t * aT; u.b = W + (unsigned)e * wE + (unsigned)pn * wT; return true;
    }
    __device__ __forceinline__ int row(const Unit& u, int R) const { return (R < u.nvalid) ? (((const int*)(wsb + u.rows))[R] >> 1) : 0; }
};

typedef f32x4 Acc[2][2][4][2];
#define EPI_LOOP_AIM _Pragma("unroll") for (int ai = 0; ai < 2; ++ai) _Pragma("unroll") for (int m = 0; m < 4; ++m)
__device__ __forceinline__ u32x4 pack8(const f32x4& a, const f32x4& b) { u32x4 w; w.x = pk2(a[0], a[1]); w.y = pk2(a[2], a[3]); w.z = pk2(b[0], b[1]); w.w = pk2(b[2], b[3]); return w; }

struct EpiProj {
    static constexpr bool PERM = true;
    __device__ __forceinline__ void operator()(const Acc& acc, const Unit& u, int wr, int wc, int fr, int fq) const {
        unsigned char* ws = ws_late(); bf16_t* proj = (bf16_t*)(ws + WS_R + R_PROJ); bf16_t* nkv = (bf16_t*)(ws + WS_R + R_NKV); float* sm = (float*)(ws + WS_R + R_SM);
        const int row0 = u.pm * 256 + wr * 64 + fr;
        if (u.pn < 12) {
            const float sc = (u.pn == 8 || u.pn == 9) ? QSCALE : (u.pn == 5 ? 0.125f : 1.0f);
            const int col0 = u.pn * 256 + wc * 32 + 8 * fq;
            EPI_LOOP_AIM { bf16_t* rp = proj + (size_t)(row0 + ai * 128 + m * 16) * PROJW + col0;
#pragma unroll
                for (int bj = 0; bj < 2; ++bj) *(u32x4*)(rp + bj * 128) = pack8(acc[ai][bj][m][0] * sc, acc[ai][bj][m][1] * sc); }
        } else {
#pragma unroll
            for (int bj = 0; bj < 2; ++bj) {
                if (u.pn == 12 || bj == 0) {
                    const int seg = (u.pn - 12) * 4 + bj * 2 + (wc >> 1), col = 32 * (wc & 1) + 8 * fq;
                    bf16_t* base = nkv + (size_t)seg * (NKV_SEG / 2) + col;
                    EPI_LOOP_AIM { *(u32x4*)(base + (size_t)(row0 + ai * 128 + m * 16) * 64) = pack8(acc[ai][bj][m][0], acc[ai][bj][m][1]); }
                } else if (wc == 0 && fq < 3) {
                    EPI_LOOP_AIM { float* sp = sm + (size_t)(row0 + ai * 128 + m * 16) * 32 + 8 * fq; *(f32x4*)sp = acc[ai][bj][m][0]; *(f32x4*)(sp + 4) = acc[ai][bj][m][1]; }
                }
            }
        }
    }
};
struct EpiH1 {
    static constexpr bool PERM = true;
    bf16_t* h1; const float* cbias;
    __device__ __forceinline__ void operator()(const Acc& acc, const Unit& u, int wr, int wc, int fr, int fq) const {
        const int which = u.aux, rl0 = wr * 64 + fr;
        bf16_t* base = h1 + ((size_t)which * BC * 256 + (size_t)u.pm * 256) * 256;
        const float* bp = cbias + which * 256;
#pragma unroll
        for (int bj = 0; bj < 2; ++bj) { const int col = bj * 128 + wc * 32 + 8 * fq; const f32x4 b0 = *(const f32x4*)(bp + col), b1 = *(const f32x4*)(bp + col + 4);
            EPI_LOOP_AIM { const int rl = rl0 + ai * 128 + m * 16; f32x4 v0 = acc[ai][bj][m][0] + b0, v1 = acc[ai][bj][m][1] + b1;
#pragma unroll
                for (int e = 0; e < 4; ++e) { v0[e] = (rl < 255) ? siluf_(v0[e]) : 0.f; v1[e] = (rl < 255) ? siluf_(v1[e]) : 0.f; }
                *(u32x4*)(base + (size_t)rl * 256 + col) = pack8(v0, v1); } }
    }
};
struct EpiCmp2 {
    static constexpr bool PERM = true;
    bf16_t* kc;
    __device__ __forceinline__ void operator()(const Acc& acc, const Unit& u, int wr, int wc, int fr, int fq) const {
        if (wc >= 2) return;
        const int col = wc * 32 + 8 * fq; bf16_t* base = kc + ((size_t)u.aux * BC + u.pm) * 256 * 64 + col;
        EPI_LOOP_AIM { const int rl = wr * 64 + fr + ai * 128 + m * 16; *(u32x4*)(base + (size_t)rl * 64) = pack8(acc[ai][0][m][0], acc[ai][0][m][1]); }
    }
};
struct EpiP {
    static constexpr bool PERM = true;
    __device__ __forceinline__ void operator()(const Acc& acc, const Unit& u, int wr, int wc, int fr, int fq) const {
        bf16_t* P = (bf16_t*)(ws_late() + WS_R + R_P);
        const int i = u.pn >> 2, pt = u.pn & 3, row0 = u.pm * 256 + wr * 64 + fr;
#pragma unroll
        for (int bj = 0; bj < 2; ++bj)
#pragma unroll
            for (int n = 0; n < 2; ++n) {
                const int png = 4 * pt + 2 * bj + (wc >> 1), wcg = 2 * (wc & 1) + (fq >> 1), fqg = 2 * (fq & 1) + n;
                const int vcol = 256 * png + 128 * (i >> 1) + 32 * wcg + 8 * fqg + 4 * (i & 1);
                EPI_LOOP_AIM { const f32x4 v = acc[ai][bj][m][n]; u32x2 w; w.x = pk2(v[0], v[1]); w.y = pk2(v[2], v[3]);
                    *(u32x2*)(P + (unsigned)((row0 + ai * 128 + m * 16) * 4096 + vcol)) = w; }
            }
    }
};
struct EpiGate {
    static constexpr bool PERM = true;
    __device__ __forceinline__ void operator()(const Acc& acc, const Unit& u, int wr, int wc, int fr, int fq) const {
        unsigned char* ws = ws_late(); const bf16_t* P = (const bf16_t*)(ws + WS_R + R_P); bf16_t* y = (bf16_t*)(ws + WS_R + R_Y);
        const int row0 = u.pm * 256 + wr * 64 + fr, vc = 256 * u.pn + 32 * wc + 8 * fq, oc = 64 * u.pn + 16 * wc + 4 * fq;
        EPI_LOOP_AIM { const size_t r = (size_t)(row0 + ai * 128 + m * 16);
            f32x4 s = {0.f, 0.f, 0.f, 0.f};
#pragma unroll
            for (int bj = 0; bj < 2; ++bj) { const u32x4 pw = *(const u32x4*)(P + r * 4096 + vc + 128 * bj);
#pragma unroll
                for (int n = 0; n < 2; ++n) { const unsigned w0 = n ? pw.z : pw.x, w1 = n ? pw.w : pw.y; const f32x4 a = acc[ai][bj][m][n];
                    s[0] += sigmoidf_(a[0]) * __uint_as_float(w0 << 16); s[1] += sigmoidf_(a[1]) * __uint_as_float(w0 & 0xffff0000u);
                    s[2] += sigmoidf_(a[2]) * __uint_as_float(w1 << 16); s[3] += sigmoidf_(a[3]) * __uint_as_float(w1 & 0xffff0000u); } }
            u32x2 w; w.x = pk2(s[0], s[1]); w.y = pk2(s[2], s[3]); *(u32x2*)(y + r * 1024 + oc) = w; }
    }
};
struct EpiOut {
    static constexpr bool PERM = false;
    const float* xin; float* zout; const float* stats; const float* lng; const float* lnb; const float* gate; int row_base; bool first;
    __device__ __forceinline__ void operator()(const Acc& acc, const Unit& u, int wr, int wc, int fr, int fq) const {
        const int rg0 = row_base + u.pm * 256 + wr * 64 + fr; const int b = rg0 >> 12;
        const float* gp = gate + (size_t)b * 3072 + 2048;
#pragma unroll
        for (int bj = 0; bj < 2; ++bj)
#pragma unroll
            for (int n = 0; n < 2; ++n) {
                const int col = u.pn * 256 + bj * 128 + wc * 32 + 16 * n + 4 * fq;
                const f32x4 g4 = *(const f32x4*)(gp + col);
                f32x4 lg = {1.f, 1.f, 1.f, 1.f}, lb = {0.f, 0.f, 0.f, 0.f};
                if (!first) { lg = *(const f32x4*)(lng + col); lb = *(const f32x4*)(lnb + col); }
                EPI_LOOP_AIM { const size_t r = (size_t)(rg0 + ai * 128 + m * 16);
                    f32x4 x = *(const f32x4*)(xin + r * 1024 + col);
                    if (!first) { const f32x2 st = *(const f32x2*)(stats + r * 2); x = (x - st.x) * st.y * lg + lb; }
                    *(f32x4*)(zout + r * 1024 + col) = x * DN_ALPHA + g4 * acc[ai][bj][m][n]; }
            }
    }
};
struct EpiMoe1 {
    static constexpr bool PERM = true;
    __device__ __forceinline__ void operator()(const Acc& acc, const Unit& u, int wr, int wc, int fr, int fq) const {
        const int rl0 = wr * 64 + fr, f0 = 128 * u.pn + 32 * wc + 8 * fq;
        bf16_t* hid = (bf16_t*)(ws_late() + WS_R + R_HID);
        EPI_LOOP_AIM { const int rl = rl0 + ai * 128 + m * 16;
            f32x4 a0 = acc[ai][0][m][0], a1 = acc[ai][0][m][1]; const f32x4 b0 = acc[ai][1][m][0], b1 = acc[ai][1][m][1];
#pragma unroll
            for (int e = 0; e < 4; ++e) { a0[e] = siluf_(a0[e]) * b0[e]; a1[e] = siluf_(a1[e]) * b1[e]; }
            *(u32x4*)(hid + (unsigned)((u.pm * 256 + rl) * 512 + f0)) = pack8(a0, a1); __builtin_amdgcn_sched_barrier(0); }
    }
};
struct EpiMoe2 {
    static constexpr bool PERM = true;
    __device__ __forceinline__ void operator()(const Acc& acc, const Unit& u, int wr, int wc, int fr, int fq) const {
        unsigned char* ws = ws_late(); bf16_t* out2 = (bf16_t*)(ws + WS_R + R_OUT2);
        const float* cwb = (const float*)(ws + (R_CW - R_LIST) + u.rows); const int* rws = (const int*)(ws + u.rows);
        const int rl0 = wr * 64 + fr, c0 = 256 * u.pn + 32 * wc + 8 * fq;
        EPI_LOOP_AIM { const int rl = rl0 + ai * 128 + m * 16;
            if (rl < u.nvalid) { const unsigned v = (unsigned)rws[rl]; const float wgt = cwb[rl]; bf16_t* rp = out2 + (size_t)v * 1024 + c0;
#pragma unroll
                for (int bj = 0; bj < 2; ++bj) *(u32x4*)(rp + bj * 128) = pack8(acc[ai][bj][m][0] * wgt, acc[ai][bj][m][1] * wgt); } }
    }
};

enum { IN_X = 0, IN_C, IN_POS, IN_ADAW, IN_ADAB, IN_WIN, IN_CONVW, IN_ALOG, IN_DTB, IN_GNORM, IN_RETGN, IN_PE, IN_CKW1, IN_CKW2, IN_CVW1, IN_CVW2, IN_FBIAS,
       IN_BP, IN_WG, IN_WO, IN_LNG, IN_LNB, IN_RW, IN_RB, IN_EW1, IN_EW3, IN_EW2 };

__device__ __forceinline__ void p0_ada(const Params& p, int item, LAS float* lf, const int tid) {
    LAS float* sc = lf; LAS float* red = lf + 16384;
    const float* c = PIN(IN_C);
    for (int i = tid; i < 16384; i += NTHR) sc[i] = siluf_(c[i]);
    __syncthreads();
    const int ls = item / 48, cb = item % 48, col = cb * 64 + (tid & 63), ks = tid >> 6;
    const float* w = PIN(IN_ADAW) + (size_t)ls * 1024 * 3072 + col;
    float acc[16];
#pragma unroll
    for (int b = 0; b < 16; ++b) acc[b] = 0.f;
    for (int k = ks * 128; k < ks * 128 + 128; ++k) { const float wv = w[(size_t)k * 3072];
#pragma unroll
        for (int b = 0; b < 16; ++b) acc[b] += sc[b * 1024 + k] * wv; }
#pragma unroll
    for (int b = 0; b < 16; ++b) red[(ks * 16 + b) * 64 + (tid & 63)] = acc[b];
    __syncthreads();
    float* mod = (float*)(p.ws + WS_MOD);
    for (int o = tid; o < 1024; o += NTHR) { const int b = o >> 6, cc = o & 63; float s = 0.f;
#pragma unroll
        for (int q = 0; q < 8; ++q) s += red[(q * 16 + b) * 64 + cc];
        mod[((size_t)ls * 16 + b) * 3072 + cb * 64 + cc] = s + PIN(IN_ADAB)[ls * 3072 + cb * 64 + cc]; }
    __syncthreads();
}
__device__ __forceinline__ void p0_rope(const Params& p, int item, const int tid) {
    const int* pos = (const int*)PIN(IN_POS); f32x2* tab = (f32x2*)(p.ws + WS_ROPE);
#pragma unroll
    for (int j = 0; j < 8; ++j) { const int idx = item * 4096 + j * 512 + tid; const int m = idx >> 5, i = idx & 31;
        const float inv = powf(10000.0f, -(float)i / 32.0f); const float ang = (float)pos[m] * inv;
        const float n = rintf(ang * 0.6366197723675814f);
        float r = fmaf(n, -1.5703125f, ang); r = fmaf(n, -4.837512969970703125e-4f, r); r = fmaf(n, -7.54978995489188e-8f, r);
        const float s = sinf(r), cs = cosf(r); const int q = ((int)n) & 3;
        float so, co; if (q == 0) { so = s; co = cs; } else if (q == 1) { so = cs; co = -s; } else if (q == 2) { so = -s; co = -cs; } else { so = -cs; co = s; }
        tab[idx] = (f32x2){co, so}; }
}
__device__ __forceinline__ void p0_cbias(const Params& p, int item, const int tid) {
    const int l = item >> 1, which = item & 1;
    if (tid < 256) { const float* pe = PIN(IN_PE) + (size_t)l * 2048; const float* w1 = PIN(which ? IN_CVW1 : IN_CKW1) + (size_t)l * 2048 * 256 + tid;
        float s = 0.f; for (int k = 0; k < 2048; ++k) s += pe[k] * w1[(size_t)k * 256];
        ((float*)(p.ws + WS_CBIAS))[item * 256 + tid] = s; }
}
struct TJob { bf16_t* dst; int K, nrt, nkt; };
constexpr int TJ_TILES[8] = {56 * 16, 64 * 16, 64 * 4, 16 * 16, 256 * 16, 256 * 8, 8 * 32, 8 * 4};
constexpr int TJ_TOTAL = 56 * 16 + 64 * 16 + 64 * 4 + 16 * 16 + 256 * 16 + 256 * 8 + 8 * 32 + 8 * 4;
__device__ __forceinline__ int win_src_col(int pc) {
    if (pc < 768) return pc;
    if (pc < 1024) return pc - 768 + 776;
    if (pc < 2048) return pc - 1024 + 1032;
    if (pc < 2304) return pc - 2048 + 2056;
    if (pc < 3072) return pc - 2304 + 2708;
    if (pc < 3456) return pc - 3072 + 2312;
    if (pc < 3464) return pc - 3456 + 768;
    if (pc < 3476) return pc - 3464 + 2696;
    if (pc < 3480) return pc - 3476 + 3476;
    return -1;
}
__device__ __forceinline__ const float* tj_src(const Params& p, int l, int job, int n, int& pitch) {
    switch (job) {
    case 0: { pitch = 3480; const int c = win_src_col(n); return c < 0 ? nullptr : PIN(IN_WIN) + (size_t)l * 1024 * 3480 + c; }
    case 1: { pitch = 1024; const int i = 2 * ((n >> 7) & 1) + ((n >> 2) & 1), c = 64 * (n >> 8) + 16 * ((n >> 5) & 3) + 4 * ((n >> 3) & 3) + (n & 3);
              return PIN(IN_WG) + ((size_t)l * 4 + i) * 1024 * 1024 + c; }
    case 2: { pitch = 1024; const int i = n >> 10, c = n & 1023; return PIN(IN_BP) + ((size_t)l * 4 + i) * 256 * 1024 + c; }
    case 3: { pitch = 1024; return PIN(IN_WO) + (size_t)l * 1024 * 1024 + n; }
    case 4: { pitch = 512; const int e = n >> 10, vr = n & 1023, f = 128 * (vr >> 8) + (vr & 127); return PIN(((vr >> 7) & 1) ? IN_EW3 : IN_EW1) + ((size_t)l * 16 + e) * 1024 * 512 + f; }
    case 5: { pitch = 1024; const int e = n >> 10, c = n & 1023; return PIN(IN_EW2) + ((size_t)l * 16 + e) * 512 * 1024 + c; }
    case 6: { pitch = 256; const int which = n >> 8, c = n & 255; return PIN(which ? IN_CVW1 : IN_CKW1) + (size_t)l * 2048 * 256 + c; }
    default: { pitch = 64; const int which = n >> 8, r = n & 255; return r < 64 ? PIN(which ? IN_CVW2 : IN_CKW2) + (size_t)l * 256 * 64 + r : nullptr; }
    }
}
__device__ __forceinline__ void p0_transpose(const Params& p, int item, LAS float* tile, const int tid) {
    const int l = item / TJ_TOTAL; int t = item % TJ_TOTAL, job = 0;
#pragma unroll
    for (int j = 0; j < 8; ++j) { if (job == j && t >= TJ_TILES[j]) { t -= TJ_TILES[j]; job = j + 1; } }
    const size_t lw = WS_W + (size_t)l * ((LW_BYTES + MiB - 1) / MiB) * MiB;
    const size_t offs[8] = {LW_WIN, LW_WGV, LW_BPT, LW_WOT, LW_W13, LW_W2, LW_CW1, LW_CW2};
    const int Ks[8] = {1024, 1024, 256, 1024, 1024, 512, 2048, 256};
    size_t off = 0; int K = 0;
#pragma unroll
    for (int j = 0; j < 8; ++j) if (job == j) { off = offs[j]; K = Ks[j]; }
    bf16_t* dst = (bf16_t*)(p.ws + lw + off);
    const int nkt = K / 64, rt = t / nkt, kt = t % nkt;
    { const int tx = tid & 63, ty = tid >> 6; int pitch; const float* src = tj_src(p, l, job, rt * 64 + tx, pitch);
#pragma unroll
      for (int kk = 0; kk < 8; ++kk) { const int k = ty + 8 * kk; tile[k * 65 + tx] = src ? src[(size_t)(kt * 64 + k) * pitch] : 0.f; } }
    __syncthreads();
    { const int r = tid >> 3, sg = tid & 7; f32x4 a, b;
#pragma unroll
      for (int j = 0; j < 4; ++j) { a[j] = tile[(sg * 8 + j) * 65 + r]; b[j] = tile[(sg * 8 + 4 + j) * 65 + r]; }
      *(u32x4*)(dst + (size_t)(rt * 64 + r) * K + kt * 64 + sg * 8) = pack8(a, b); }
    __syncthreads();
}

struct RowV { f32x4 v[4]; };
__device__ __forceinline__ void row_load(RowV& r, const float* src, int lane) {
#pragma unroll
    for (int j = 0; j < 4; ++j) r.v[j] = *(const f32x4*)(src + 4 * lane + 256 * j);
}
__device__ __forceinline__ void row_stats(const RowV& r, float& mean, float& rstd) {
    float s = 0.f;
#pragma unroll
    for (int j = 0; j < 4; ++j) s += (r.v[j][0] + r.v[j][1]) + (r.v[j][2] + r.v[j][3]);
    mean = wave_sum(s) * (1.0f / 1024.0f);
    float q = 0.f;
#pragma unroll
    for (int j = 0; j < 4; ++j) { const f32x4 d = r.v[j] - mean; q += (d[0] * d[0] + d[1] * d[1]) + (d[2] * d[2] + d[3] * d[3]); }
    rstd = 1.0f / sqrtf(wave_sum(q) * (1.0f / 1024.0f) + LN_EPS);
}
__device__ __forceinline__ void row_ln(RowV& r, float mean, float rstd, const float* g, const float* b, int lane) {
#pragma unroll
    for (int j = 0; j < 4; ++j) { const f32x4 gg = *(const f32x4*)(g + 4 * lane + 256 * j), bb = *(const f32x4*)(b + 4 * lane + 256 * j); r.v[j] = (r.v[j] - mean) * rstd * gg + bb; }
}
__device__ __forceinline__ void row_mod(RowV& h, const RowV& x, const float* mod, int lane) {
#pragma unroll
    for (int j = 0; j < 4; ++j) { const f32x4 sh = *(const f32x4*)(mod + 4 * lane + 256 * j), sc = *(const f32x4*)(mod + 1024 + 4 * lane + 256 * j); h.v[j] = x.v[j] * (sc + 1.0f) + sh; }
}
__device__ __forceinline__ void row_store_bf16(const RowV& h, bf16_t* dst, int lane) {
#pragma unroll
    for (int j = 0; j < 4; ++j) { u32x2 w; w.x = pk2(h.v[j][0], h.v[j][1]); w.y = pk2(h.v[j][2], h.v[j][3]); *(u32x2*)(dst + 4 * lane + 256 * j) = w; }
}
__device__ __forceinline__ void prep_first(const Params& p, const int tid, const int blk) {
    const int lane = tid & 63, wv = tid >> 6; const float* x = p.in[IN_X]; bf16_t* H = (bf16_t*)(p.ws + WS_H); const float* mod = (const float*)(p.ws + WS_MOD);
    for (int row = blk * 8 + wv; row < MTOK; row += NWG * 8) {
        RowV r, h; row_load(r, x + (size_t)row * 1024, lane); row_mod(h, r, mod + (size_t)(row >> 12) * 3072, lane); row_store_bf16(h, H + (size_t)row * 1024, lane); }
}
__device__ __forceinline__ void prep_moe(const Params& p, int l, LAS float* rwl, const int tid, const int blk) {
    const int lane = tid & 63, wv = tid >> 6;
    { const float* rw = p.in[IN_RW]; for (int i = tid; i < 16384; i += NTHR) rwl[i] = rw[i]; }
    __syncthreads();
    const float* z = p.out; bf16_t* H = (bf16_t*)(p.ws + WS_H); const float* mod = (const float*)(p.ws + WS_MOD) + (size_t)(l * 2 + 1) * 16 * 3072;
    f32x2* stats = (f32x2*)(p.ws + WS_STATS); const float* g = p.in[IN_LNG] + (size_t)(l * 2) * 1024; const float* bb = p.in[IN_LNB] + (size_t)(l * 2) * 1024;
    unsigned* cnt = (unsigned*)(p.ws + WS_CTL) + CW_CNT + l * 64; int* list = (int*)(p.ws + WS_R + R_LIST); float* cw = (float*)(p.ws + WS_R + R_CW);
    const float* rb = p.in[IN_RB];
    for (int row = blk * 8 + wv; row < MTOK; row += NWG * 8) {
        RowV r, h; row_load(r, z + (size_t)row * 1024, lane);
        float mean, rstd; row_stats(r, mean, rstd); if (lane == 0) stats[row] = (f32x2){mean, rstd};
        row_ln(r, mean, rstd, g, bb, lane); row_mod(h, r, mod + (size_t)(row >> 12) * 3072, lane); row_store_bf16(h, H + (size_t)row * 1024, lane);
        float a[16];
#pragma unroll
        for (int e = 0; e < 16; ++e) a[e] = 0.f;
#pragma unroll
        for (int j = 0; j < 4; ++j)
#pragma unroll
            for (int q = 0; q < 4; ++q) { const float hv = h.v[j][q]; const LAS float* wp = rwl + (4 * lane + 256 * j + q) * 16;
                const f32x4 w0 = *(const LAS f32x4*)wp, w1 = *(const LAS f32x4*)(wp + 4), w2 = *(const LAS f32x4*)(wp + 8), w3 = *(const LAS f32x4*)(wp + 12);
#pragma unroll
                for (int e = 0; e < 4; ++e) { a[e] += hv * w0[e]; a[4 + e] += hv * w1[e]; a[8 + e] += hv * w2[e]; a[12 + e] += hv * w3[e]; }
                __builtin_amdgcn_sched_barrier(0); }
#pragma unroll
        for (int e = 0; e < 16; ++e) a[e] = wave_sum(a[e]);
        float sc[16], bi[16];
#pragma unroll
        for (int e = 0; e < 16; ++e) { sc[e] = sigmoidf_(a[e]); bi[e] = sc[e] + rb[e]; }
        int grp = 0; float best = -INFINITY;
#pragma unroll
        for (int gI = 0; gI < 4; ++gI) { float m1 = -INFINITY, m2 = -INFINITY;
#pragma unroll
            for (int q = 0; q < 4; ++q) { const float v = bi[4 * gI + q]; if (v > m1) { m2 = m1; m1 = v; } else if (v > m2) m2 = v; }
            const float gs = m1 + m2; if (gs > best) { best = gs; grp = gI; } }
        int e0 = 0, e1 = 0; float b0 = -INFINITY, b1 = -INFINITY, s0 = 0.f, s1 = 0.f;
#pragma unroll
        for (int gI = 0; gI < 4; ++gI)
#pragma unroll
            for (int q = 0; q < 4; ++q) { const int e = 4 * gI + q; if (gI == grp) { const float v = bi[e];
                if (v > b0) { b1 = b0; e1 = e0; s1 = s0; b0 = v; e0 = e; s0 = sc[e]; } else if (v > b1) { b1 = v; e1 = e; s1 = sc[e]; } } }
        const float inv = 1.0f / (s0 + s1);
        if (lane == 0) { const unsigned q0 = atomicAdd(cnt + e0, 1u); list[(size_t)e0 * MTOK + q0] = row * 2; cw[(size_t)e0 * MTOK + q0] = s0 * inv;
                         const unsigned q1 = atomicAdd(cnt + e1, 1u); list[(size_t)e1 * MTOK + q1] = row * 2 + 1; cw[(size_t)e1 * MTOK + q1] = s1 * inv; }
    }
}
__device__ __forceinline__ void prep_next(const Params& p, int l, bool final_, const int tid, const int blk) {
    const int lane = tid & 63, wv = tid >> 6;
    float* z = p.out; bf16_t* H = (bf16_t*)(p.ws + WS_H); const float* modm = (const float*)(p.ws + WS_MOD) + (size_t)(l * 2 + 1) * 16 * 3072;
    const float* modn = (const float*)(p.ws + WS_MOD) + (size_t)((l + 1) * 2) * 16 * 3072;
    f32x2* stats = (f32x2*)(p.ws + WS_STATS);
    const float* g0 = p.in[IN_LNG] + (size_t)(l * 2) * 1024; const float* b0 = p.in[IN_LNB] + (size_t)(l * 2) * 1024;
    const float* g1 = p.in[IN_LNG] + (size_t)(l * 2 + 1) * 1024; const float* b1 = p.in[IN_LNB] + (size_t)(l * 2 + 1) * 1024;
    const bf16_t* out2 = (const bf16_t*)(p.ws + WS_R + R_OUT2);
    for (int row = blk * 8 + wv; row < MTOK; row += NWG * 8) {
        RowV r; row_load(r, z + (size_t)row * 1024, lane);
        const f32x2 st = stats[row]; row_ln(r, st.x, st.y, g0, b0, lane);
        const float* gate = modm + (size_t)(row >> 12) * 3072 + 2048;
#pragma unroll
        for (int j = 0; j < 4; ++j) { const u32x2 oa = *(const u32x2*)(out2 + (size_t)(row * 2) * 1024 + 4 * lane + 256 * j), ob = *(const u32x2*)(out2 + (size_t)(row * 2 + 1) * 1024 + 4 * lane + 256 * j);
            const f32x4 gt = *(const f32x4*)(gate + 4 * lane + 256 * j);
            f32x4 y; y[0] = __uint_as_float(oa.x << 16) + __uint_as_float(ob.x << 16); y[1] = __uint_as_float(oa.x & 0xffff0000u) + __uint_as_float(ob.x & 0xffff0000u);
            y[2] = __uint_as_float(oa.y << 16) + __uint_as_float(ob.y << 16); y[3] = __uint_as_float(oa.y & 0xffff0000u) + __uint_as_float(ob.y & 0xffff0000u);
            r.v[j] = r.v[j] * DN_ALPHA + gt * y; }
        float mean, rstd; row_stats(r, mean, rstd);
        if (final_) { row_ln(r, mean, rstd, g1, b1, lane);
#pragma unroll
            for (int j = 0; j < 4; ++j) *(f32x4*)(z + (size_t)row * 1024 + 4 * lane + 256 * j) = r.v[j];
        } else {
#pragma unroll
            for (int j = 0; j < 4; ++j) *(f32x4*)(z + (size_t)row * 1024 + 4 * lane + 256 * j) = r.v[j];
            if (lane == 0) stats[row] = (f32x2){mean, rstd};
            RowV h; row_ln(r, mean, rstd, g1, b1, lane); row_mod(h, r, modn + (size_t)(row >> 12) * 3072, lane); row_store_bf16(h, H + (size_t)row * 1024, lane); }
    }
}

__device__ __forceinline__ int q_next(unsigned* ctr, volatile LAS int* slot, const int tid) {
    __syncthreads();
    if (tid == 0) *slot = (int)__hip_atomic_fetch_add(ctr, 1u, __ATOMIC_RELAXED, __HIP_MEMORY_SCOPE_AGENT);
    __syncthreads();
    return *slot;
}

__device__ __forceinline__ void gdn_prep_unit(const Params& p, int l, int unit, LAS unsigned char* lds, const int tid_in_) {
    int tid = tid_in_; asm volatile("" : "+v"(tid)); unsigned char* wsl_ = ws_late();
    const int lane = tid & 63;
    const int n = unit & 63, h = (unit >> 6) & 3, bl = unit >> 8;
    const int tok0 = bl * SEQ + n * 64;
    const bf16_t* proj = (const bf16_t*)(wsl_ + WS_R + R_PROJ); const float* sm = (const float*)(wsl_ + WS_R + R_SM);
    LAS bf16_t* raw = (LAS bf16_t*)lds;
    LAS float* qs = (LAS float*)(lds + 26112); LAS float* ks = qs + 64 * 65; LAS float* vs = ks + 64 * 65;
    LAS float* Lm = vs + 64 * 65;
    LAS float* bc = Lm + 4096; LAS float* eb = bc + 64; LAS float* be = eb + 64; LAS float* cwt = be + 64;
    __syncthreads();
    for (int idx = tid; idx < 67 * 24; idx += NTHR) { const int row = idx / 24, ch = idx % 24, seg = ch >> 3, c8 = ch & 7;
        u32x4 v = {0u, 0u, 0u, 0u};
        if (n > 0 || row >= 3) v = *(const u32x4*)(proj + (size_t)(tok0 + row - 3) * PROJW + seg * 256 + h * 64 + c8 * 8);
        *(LAS u32x4*)(raw + row * 192 + seg * 64 + c8 * 8) = v; }
    for (int idx = tid; idx < 768; idx += NTHR) { const int k = idx / 192, ch = idx % 192; cwt[idx] = PIN(IN_CONVW)[(size_t)l * 4 * 768 + k * 768 + (ch >> 6) * 256 + h * 64 + (ch & 63)]; }
    __syncthreads();
    for (int idx = tid; idx < 64 * 192; idx += NTHR) { const int t = idx / 192, ch = idx % 192; float s = 0.f;
#pragma unroll
        for (int k = 0; k < 4; ++k) s += cwt[k * 192 + ch] * bf2f(raw[(t + k) * 192 + ch]);
        s = siluf_(s); const int seg = ch >> 6, d = ch & 63; (seg == 0 ? qs : seg == 1 ? ks : vs)[t * 65 + d] = s; }
    __syncthreads();
    if (tid < 128) { LAS float* mt = (tid < 64) ? qs : ks; const int row = tid & 63; float ss = 0.f;
        for (int d = 0; d < 64; ++d) { const float x = mt[row * 65 + d]; ss += x * x; }
        const float sc = (1.0f / sqrtf(ss + 1e-6f)) * ((tid < 64) ? 0.125f : 1.0f);
        for (int d = 0; d < 64; ++d) mt[row * 65 + d] *= sc;
    } else if (tid < 192) { const int i = tid - 128;
        const float a = sm[(size_t)(tok0 + i) * 32 + h], bg = sm[(size_t)(tok0 + i) * 32 + 4 + h];
        const float x = a + PIN(IN_DTB)[l * 4 + h]; const float sp = fmaxf(x, 0.f) + log1pf(__expf(-fabsf(x)));
        float la = -__expf(PIN(IN_ALOG)[l * 4 + h]) * sp;
#pragma unroll
        for (int o = 1; o < 64; o <<= 1) { const float v = __shfl_up(la, o); if (lane >= o) la += v; }
        bc[i] = la; eb[i] = __expf(la); be[i] = sigmoidf_(bg); }
    __syncthreads();
    const size_t ub = WS_R + R_GDN + (size_t)unit * GDN_UNIT_BYTES;
    bf16_t* gW = (bf16_t*)(wsl_ + ub); bf16_t* gATT = gW + 4096; bf16_t* gQD = gW + 8192; bf16_t* gKDT = gW + 12288; bf16_t* gU0 = gW + 16384;
    { const int i = tid >> 3, jg = tid & 7; float kk[8], qk[8];
#pragma unroll
      for (int jj = 0; jj < 8; ++jj) { kk[jj] = 0.f; qk[jj] = 0.f; }
      for (int d = 0; d < 64; ++d) { const float ki = ks[i * 65 + d], qi = qs[i * 65 + d];
#pragma unroll
          for (int jj = 0; jj < 8; ++jj) { const float kj = ks[(jg * 8 + jj) * 65 + d]; kk[jj] += ki * kj; qk[jj] += qi * kj; } }
      const float bi = bc[i], bt = be[i]; float at[8];
#pragma unroll
      for (int jj = 0; jj < 8; ++jj) { const int j = jg * 8 + jj; const float dc = __expf(bi - bc[j]);
          Lm[i * 64 + j] = (j < i) ? bt * kk[jj] * dc : 0.f; at[jj] = (j <= i) ? qk[jj] * dc : 0.f; }
      u32x4 w; w.x = pk2(at[0], at[1]); w.y = pk2(at[2], at[3]); w.z = pk2(at[4], at[5]); w.w = pk2(at[6], at[7]);
      *(u32x4*)(gATT + i * 64 + jg * 8) = w; }
    __syncthreads();
    if (tid < 128) {
        const int c = tid & 63; const bool isw = tid >= 64; LAS float* Xs = cwt + 768 + tid;
        for (int i = 0; i < 64; ++i) {
            float r = isw ? be[i] * eb[i] * ks[i * 65 + c] : be[i] * vs[i * 65 + c];
#pragma unroll 8
            for (int j = 0; j < i; ++j) r -= Lm[i * 64 + j] * Xs[j * 128];
            Xs[i * 128] = r;
            (isw ? gW : gU0)[i * 64 + c] = f2bf(r);
        }
    } else {
        const float bl_ = bc[63];
        for (int task = tid - 128; task < 1024; task += 384) {
            if (task < 512) { const int c = task >> 3, sg = task & 7; const float e = eb[c]; float v[8];
#pragma unroll
                for (int j = 0; j < 8; ++j) v[j] = qs[c * 65 + sg * 8 + j] * e;
                u32x4 w; w.x = pk2(v[0], v[1]); w.y = pk2(v[2], v[3]); w.z = pk2(v[4], v[5]); w.w = pk2(v[6], v[7]); *(u32x4*)(gQD + c * 64 + sg * 8) = w;
            } else { const int k = (task - 512) >> 3, sg = task & 7; float v[8];
#pragma unroll
                for (int j = 0; j < 8; ++j) { const int c = sg * 8 + j; v[j] = ks[c * 65 + k] * __expf(bl_ - bc[c]); }
                u32x4 w; w.x = pk2(v[0], v[1]); w.y = pk2(v[2], v[3]); w.z = pk2(v[4], v[5]); w.w = pk2(v[6], v[7]); *(u32x4*)(gKDT + k * 64 + sg * 8) = w; }
        }
        if (tid == 128) ((float*)(wsl_ + WS_R + R_GG))[unit] = __expf(bl_);
    }
    __syncthreads();
}

__device__ __forceinline__ bf16x8 afrag_perm(const LAS unsigned char* M, int row, int ks, int hi) {
    const LAS unsigned char* q = M + row * 144 + (16 * ks + 4 * hi) * 2;
    const s16x4 lo = *(const LAS s16x4*)q, hi4 = *(const LAS s16x4*)(q + 16);
    return (bf16x8){lo[0], lo[1], lo[2], lo[3], hi4[0], hi4[1], hi4[2], hi4[3]};
}
__device__ __forceinline__ bf16x8 pack_acc8(const f32x16& a, int s) {
    u32x4 w; w.x = pk2(a[8 * s + 0], a[8 * s + 1]); w.y = pk2(a[8 * s + 2], a[8 * s + 3]); w.z = pk2(a[8 * s + 4], a[8 * s + 5]); w.w = pk2(a[8 * s + 6], a[8 * s + 7]);
    return __builtin_bit_cast(bf16x8, w);
}
__device__ __forceinline__ void gdn_scan_item(const Params& p, int l, int chunk, int item, LAS unsigned char* lds, const int tid) {
    const int lane = tid & 63, wid = tid >> 6, vl = lane & 31, hi = lane >> 5;
    const int h = item & 3, bl = item >> 2;
    const unsigned char* ubase = p.ws + WS_R + R_GDN + (size_t)item * 64 * GDN_UNIT_BYTES;
    const float* gg = (const float*)(p.ws + WS_R + R_GG) + item * 64;
    const bf16_t* proj = (const bf16_t*)(p.ws + WS_R + R_PROJ); bf16_t* og = (bf16_t*)(p.ws + WS_R + R_O);
    const float* nw = PIN(IN_GNORM) + l * 64;
    constexpr int BUF = 5 * 9216;
    LAS unsigned char* buf0 = lds; LAS float* ob0 = (LAS float*)(lds + 2 * BUF);
    __syncthreads();
    for (int q = tid; q < 2560; q += NTHR) { const int mat = q >> 9, r = (q >> 3) & 63, sg = q & 7;
        *(LAS u32x4*)(buf0 + mat * 9216 + r * 144 + sg * 16) = *(const u32x4*)(ubase + mat * 8192 + r * 128 + sg * 16); }
    __syncthreads();
    f32x16 S[2]; S[0] = (f32x16){}; S[1] = (f32x16){};
    for (int n = 0; n < 64; ++n) {
        LAS unsigned char* bf = buf0 + (n & 1) * BUF; LAS float* ob = ob0 + (n & 1) * 4096;
        if (wid < 2) {
            const LAS unsigned char* Wm = bf; const LAS unsigned char* ATT = bf + 9216; const LAS unsigned char* QD = bf + 18432; const LAS unsigned char* KDT = bf + 27648; const LAS bf16_t* U0 = (const LAS bf16_t*)(bf + 36864);
            const float G = gg[n];
            bf16x8 Sb[4]; Sb[0] = pack_acc8(S[0], 0); Sb[1] = pack_acc8(S[0], 1); Sb[2] = pack_acc8(S[1], 0); Sb[3] = pack_acc8(S[1], 1);
            f32x16 u[2];
#pragma unroll
            for (int ct = 0; ct < 2; ++ct) { f32x16 a = (f32x16){};
#pragma unroll
                for (int ks = 0; ks < 4; ++ks) a = __builtin_amdgcn_mfma_f32_32x32x16_bf16(afrag_perm(Wm, 32 * ct + vl, ks, hi), Sb[ks], a, 0, 0, 0);
#pragma unroll
                for (int r = 0; r < 16; ++r) u[ct][r] = bf2f(U0[(32 * ct + crow(r, hi)) * 72 + 32 * wid + vl]) - a[r]; }
            bf16x8 ub[4]; ub[0] = pack_acc8(u[0], 0); ub[1] = pack_acc8(u[0], 1); ub[2] = pack_acc8(u[1], 0); ub[3] = pack_acc8(u[1], 1);
#pragma unroll
            for (int ct = 0; ct < 2; ++ct) { f32x16 a = (f32x16){};
#pragma unroll
                for (int ks = 0; ks < 4; ++ks) a = __builtin_amdgcn_mfma_f32_32x32x16_bf16(afrag_perm(QD, 32 * ct + vl, ks, hi), Sb[ks], a, 0, 0, 0);
#pragma unroll
                for (int cs = 0; cs < 4; ++cs) a = __builtin_amdgcn_mfma_f32_32x32x16_bf16(afrag_perm(ATT, 32 * ct + vl, cs, hi), ub[cs], a, 0, 0, 0);
#pragma unroll
                for (int r = 0; r < 16; ++r) ob[(32 * ct + crow(r, hi)) * 64 + 32 * wid + vl] = a[r]; }
#pragma unroll
            for (int kt = 0; kt < 2; ++kt) { f32x16 a = S[kt] * G;
#pragma unroll
                for (int cs = 0; cs < 4; ++cs) a = __builtin_amdgcn_mfma_f32_32x32x16_bf16(afrag_perm(KDT, 32 * kt + vl, cs, hi), ub[cs], a, 0, 0, 0);
                S[kt] = a; }
        } else {
            if (n + 1 < 64) { LAS unsigned char* nb = buf0 + ((n + 1) & 1) * BUF; const unsigned char* src = ubase + (size_t)(n + 1) * GDN_UNIT_BYTES;
                for (int q = tid - 128; q < 2560; q += 384) { const int mat = q >> 9, r = (q >> 3) & 63, sg = q & 7;
                    *(LAS u32x4*)(nb + mat * 9216 + r * 144 + sg * 16) = *(const u32x4*)(src + mat * 8192 + r * 128 + sg * 16); } }
        }
        if (wid >= 2 && n >= 1) { const LAS float* po = ob0 + ((n - 1) & 1) * 4096; const int tokb = bl * SEQ + (n - 1) * 64;
            for (int task = tid - 128; task < 512; task += 384) { const int c = task >> 3, sg = task & 7; float v[8], ss = 0.f;
#pragma unroll
                for (int j = 0; j < 8; ++j) { v[j] = po[c * 64 + sg * 8 + j]; ss += v[j] * v[j]; }
                ss += __shfl_xor(ss, 1); ss += __shfl_xor(ss, 2); ss += __shfl_xor(ss, 4);
                const float rs = 1.0f / sqrtf(ss * (1.0f / 64.0f) + 1e-6f);
                const u32x4 zw = *(const u32x4*)(proj + (size_t)(tokb + c) * PROJW + PC_GZ + h * 64 + sg * 8); const unsigned zz[4] = {zw.x, zw.y, zw.z, zw.w};
#pragma unroll
                for (int j = 0; j < 8; ++j) { const float zf = (j & 1) ? __uint_as_float(zz[j >> 1] & 0xffff0000u) : __uint_as_float(zz[j >> 1] << 16); v[j] = v[j] * rs * nw[sg * 8 + j] * siluf_(zf); }
                u32x4 w; w.x = pk2(v[0], v[1]); w.y = pk2(v[2], v[3]); w.z = pk2(v[4], v[5]); w.w = pk2(v[6], v[7]);
                *(u32x4*)(og + (size_t)(tokb + c) * 256 + h * 64 + sg * 8) = w; } }
        __syncthreads();
    }
    { const LAS float* po = ob0 + 4096; const int tokb = bl * SEQ + 63 * 64;
        for (int task = tid; task < 512; task += NTHR) { const int c = task >> 3, sg = task & 7; float v[8], ss = 0.f;
#pragma unroll
            for (int j = 0; j < 8; ++j) { v[j] = po[c * 64 + sg * 8 + j]; ss += v[j] * v[j]; }
            ss += __shfl_xor(ss, 1); ss += __shfl_xor(ss, 2); ss += __shfl_xor(ss, 4);
            const float rs = 1.0f / sqrtf(ss * (1.0f / 64.0f) + 1e-6f);
            const u32x4 zw = *(const u32x4*)(proj + (size_t)(tokb + c) * PROJW + PC_GZ + h * 64 + sg * 8); const unsigned zz[4] = {zw.x, zw.y, zw.z, zw.w};
#pragma unroll
            for (int j = 0; j < 8; ++j) { const float zf = (j & 1) ? __uint_as_float(zz[j >> 1] & 0xffff0000u) : __uint_as_float(zz[j >> 1] << 16); v[j] = v[j] * rs * nw[sg * 8 + j] * siluf_(zf); }
            u32x4 w; w.x = pk2(v[0], v[1]); w.y = pk2(v[2], v[3]); w.z = pk2(v[4], v[5]); w.w = pk2(v[6], v[7]);
            *(u32x4*)(og + (size_t)(tokb + c) * 256 + h * 64 + sg * 8) = w; } }
    __syncthreads();
}

__device__ __forceinline__ void fox_cum_item(const Params& p, int l, int item, LAS float* lf, const int tid) {
    const int lane = tid & 63, wid = tid >> 6, h = item & 3, bl = item >> 2;
    const float* sm = (const float*)(p.ws + WS_R + R_SM); float* nb = (float*)(p.ws + WS_R + R_CUM) + (size_t)item * SEQ;
    const float fb = PIN(IN_FBIAS)[l * 4 + h];
    float v[8], run = 0.f;
#pragma unroll
    for (int j = 0; j < 8; ++j) { const float x = sm[(size_t)(bl * SEQ + tid * 8 + j) * 32 + 20 + h] + fb; run += fminf(x, 0.f) - log1pf(__expf(-fabsf(x))); v[j] = run; }
    float inc = run;
#pragma unroll
    for (int o = 1; o < 64; o <<= 1) { const float t = __shfl_up(inc, o); if (lane >= o) inc += t; }
    __syncthreads();
    if (lane == 63) lf[wid] = inc;
    __syncthreads();
    float base = inc - run;
    for (int w = 0; w < wid; ++w) base += lf[w];
#pragma unroll
    for (int j = 0; j < 8; ++j) nb[tid * 8 + j] = -(base + v[j]) * LOG2E;
    __syncthreads();
}
__device__ __forceinline__ void ret_rope_pass(const Params& p, int chunk, const int tid, const int blk) {
    bf16_t* proj = (bf16_t*)(p.ws + WS_R + R_PROJ); const f32x2* tab = (const f32x2*)(p.ws + WS_ROPE);
    for (int task = blk * NTHR + tid; task < MC * 32; task += NWG * NTHR) {
        const int row = task >> 5, which = (task >> 4) & 1, h = (task >> 2) & 3, i8 = task & 3;
        bf16_t* q1 = proj + (size_t)row * PROJW + (which ? PC_RK : PC_RQ) + h * 64 + i8 * 8; bf16_t* q2 = q1 + 32;
        const u32x4 a = *(const u32x4*)q1, b = *(const u32x4*)q2; const unsigned aa[4] = {a.x, a.y, a.z, a.w}, bb[4] = {b.x, b.y, b.z, b.w};
        const f32x2* tp = tab + (size_t)(chunk * MC + row) * 32 + i8 * 8; float o1[8], o2[8];
#pragma unroll
        for (int j = 0; j < 8; ++j) { const float x1 = (j & 1) ? __uint_as_float(aa[j >> 1] & 0xffff0000u) : __uint_as_float(aa[j >> 1] << 16);
            const float x2 = (j & 1) ? __uint_as_float(bb[j >> 1] & 0xffff0000u) : __uint_as_float(bb[j >> 1] << 16);
            const f32x2 cs = tp[j]; o1[j] = x1 * cs.x - x2 * cs.y; o2[j] = x1 * cs.y + x2 * cs.x; }
        u32x4 w1, w2; w1.x = pk2(o1[0], o1[1]); w1.y = pk2(o1[2], o1[3]); w1.z = pk2(o1[4], o1[5]); w1.w = pk2(o1[6], o1[7]);
        w2.x = pk2(o2[0], o2[1]); w2.y = pk2(o2[2], o2[3]); w2.z = pk2(o2[4], o2[5]); w2.w = pk2(o2[6], o2[7]);
        *(u32x4*)q1 = w1; *(u32x4*)q2 = w2; }
}

#define MF32(a, b, c) __builtin_amdgcn_mfma_f32_32x32x16_bf16(a, b, c, 0, 0, 0)
constexpr int AL_K0 = 0, AL_V0 = 16384, AL_B0 = 32768;
__device__ __forceinline__ s16x4 vtr(const LAS unsigned char* q) {
    typedef short v4i16_t __attribute__((ext_vector_type(4)));
    return __builtin_bit_cast(s16x4, __builtin_amdgcn_ds_read_tr16_b64_v4i16((LAS v4i16_t*)q));
}
__device__ __forceinline__ void attn_qkt(f32x16& p0, f32x16& p1, const LAS unsigned char* kslot, const bf16x8 (&qf)[4], int r32, int hi) {
    p0 = (f32x16){}; p1 = (f32x16){};
#pragma unroll
    for (int d0 = 0; d0 < 4; ++d0) { const LAS unsigned char* kb = kslot + (2 * d0 + hi) * 1024 + r32 * 16;
        const bf16x8 b0 = *(const LAS bf16x8*)kb, b1 = *(const LAS bf16x8*)(kb + 512);
        p0 = MF32(b0, qf[d0], p0); p1 = MF32(b1, qf[d0], p1); }
}
__device__ __forceinline__ void attn_pv(f32x16 (&o)[2], const LAS unsigned char* vslot, const bf16x8 (&pw)[4], int lane, int hi) {
    const LAS unsigned char* vb = vslot + ((lane >> 4) & 1) * 32 + (lane & 3) * 8 + (4 * hi + ((lane & 15) >> 2)) * 64;
#pragma unroll
    for (int d0 = 0; d0 < 2; ++d0)
#pragma unroll
        for (int ks = 0; ks < 4; ++ks) { const s16x4 lo = vtr(vb + d0 * 4096 + ks * 1024), h4 = vtr(vb + d0 * 4096 + ks * 1024 + 512);
            const bf16x8 vf = (bf16x8){lo[0], lo[1], lo[2], lo[3], h4[0], h4[1], h4[2], h4[3]};
            o[d0] = MF32(vf, pw[ks], o[d0]); }
}
__device__ __forceinline__ void attn_softmax_step(f32x16& p0, f32x16& p1, f32x16 (&o)[2], float& m, float& l) {
    float mt = p0[0];
#pragma unroll
    for (int r = 1; r < 16; ++r) mt = fmaxf(mt, p0[r]);
#pragma unroll
    for (int r = 0; r < 16; ++r) mt = fmaxf(mt, p1[r]);
    mt = fmaxf(mt, __shfl_xor(mt, 32));
    const float mn = fmaxf(m, mt), ms = (mn == -INFINITY) ? 0.f : mn, alpha = ex2(m - ms);
    float s = 0.f;
#pragma unroll
    for (int r = 0; r < 16; ++r) { p0[r] = ex2(p0[r] - ms); p1[r] = ex2(p1[r] - ms); s += p0[r] + p1[r]; }
    l = l * alpha + s; o[0] *= alpha; o[1] *= alpha; m = mn;
}
template <class F>
__device__ __forceinline__ void flash_loop(const F& f, int tlo, int thi, const bf16_t* Kg, const bf16_t* Vg, int pitch, const float* biasg,
                                           const bf16x8 (&qf)[4], f32x16 (&o)[2], float& m, float& l, LAS unsigned char* lds, const int tid) {
    const int lane = tid & 63, wid = tid >> 6, r32 = lane & 31, hi = lane >> 5;
    int t = tlo; while (t < thi && f.skip(t)) ++t;
    __syncthreads();
    if (t >= thi) return;
    const bf16_t* ksrc = Kg + (size_t)lane * pitch + wid * 8;
    const bf16_t* vsrc = Vg + (size_t)(16 * (wid & 3) + (lane >> 2)) * pitch + (wid >> 2) * 32 + (lane & 3) * 8;
    const int sdst = wid * 1024 + lane * 16;
    u32x4 kr = *(const u32x4*)(ksrc + (size_t)t * 64 * pitch), vr = *(const u32x4*)(vsrc + (size_t)t * 64 * pitch); float br = 0.f;
    const int btid = tid & 63;
    if (F::HAS_BIAS) br = biasg[t * 64 + btid];
    *(LAS u32x4*)(lds + AL_K0 + sdst) = kr; *(LAS u32x4*)(lds + AL_V0 + sdst) = vr; if (F::HAS_BIAS) ((LAS float*)(lds + AL_B0))[btid] = br;
    __syncthreads();
    int cur = 0;
    for (;;) {
        int tn = t + 1; while (tn < thi && f.skip(tn)) ++tn;
        if (tn < thi) { kr = *(const u32x4*)(ksrc + (size_t)tn * 64 * pitch); vr = *(const u32x4*)(vsrc + (size_t)tn * 64 * pitch); if (F::HAS_BIAS) br = biasg[tn * 64 + btid]; }
        f32x16 p0, p1;
        attn_qkt(p0, p1, lds + AL_K0 + cur * 8192, qf, r32, hi);
        if (F::HAS_BIAS) { const LAS float* bp = (const LAS float*)(lds + AL_B0 + cur * 256);
#pragma unroll
            for (int g = 0; g < 4; ++g) { const f32x4 b0 = *(const LAS f32x4*)(bp + 8 * g + 4 * hi), b1 = *(const LAS f32x4*)(bp + 32 + 8 * g + 4 * hi);
#pragma unroll
                for (int e = 0; e < 4; ++e) { p0[4 * g + e] += b0[e]; p1[4 * g + e] += b1[e]; } } }
        f.apply(p0, p1, t);
        if (F::MODE == 0) attn_softmax_step(p0, p1, o, m, l);
        bf16x8 pw[4]; pw[0] = pack_acc8(p0, 0); pw[1] = pack_acc8(p0, 1); pw[2] = pack_acc8(p1, 0); pw[3] = pack_acc8(p1, 1);
        attn_pv(o, lds + AL_V0 + cur * 8192, pw, lane, hi);
        if (tn >= thi) break;
        cur ^= 1;
        *(LAS u32x4*)(lds + AL_K0 + cur * 8192 + sdst) = kr; *(LAS u32x4*)(lds + AL_V0 + cur * 8192 + sdst) = vr; if (F::HAS_BIAS) ((LAS float*)(lds + AL_B0 + cur * 256))[btid] = br;
        __syncthreads();
        t = tn;
    }
    __syncthreads();
}
__device__ __forceinline__ void load_qf(bf16x8 (&qf)[4], const bf16_t* qrow, int hi) {
#pragma unroll
    for (int d0 = 0; d0 < 4; ++d0) qf[d0] = *(const bf16x8*)(qrow + d0 * 16 + hi * 8);
}
__device__ __forceinline__ void store_ot(const f32x16 (&o)[2], bf16_t* orow, int hi) {
#pragma unroll
    for (int d0 = 0; d0 < 2; ++d0)
#pragma unroll
        for (int g = 0; g < 4; ++g) { u32x2 w; w.x = pk2(o[d0][4 * g], o[d0][4 * g + 1]); w.y = pk2(o[d0][4 * g + 2], o[d0][4 * g + 3]); *(u32x2*)(orow + 32 * d0 + 8 * g + 4 * hi) = w; }
}

struct FoxF { static constexpr int MODE = 0; static constexpr bool HAS_BIAS = true; int tq, qmin, hi;
    __device__ __forceinline__ bool skip(int) const { return false; }
    __device__ __forceinline__ void apply(f32x16& p0, f32x16& p1, int t) const {
        if (64 * t + 63 > qmin) {
#pragma unroll
            for (int r = 0; r < 16; ++r) { const int key = 64 * t + crow(r, hi); if (key > tq) p0[r] = -INFINITY; if (key + 32 > tq) p1[r] = -INFINITY; } } } };
struct RetF { static constexpr int MODE = 1; static constexpr bool HAS_BIAS = false; int tq, hi; float lg;
    __device__ __forceinline__ bool skip(int) const { return false; }
    __device__ __forceinline__ void apply(f32x16& p0, f32x16& p1, int t) const {
#pragma unroll
        for (int r = 0; r < 16; ++r) { const int key = 64 * t + crow(r, hi);
            p0[r] = (key <= tq) ? p0[r] * ex2((float)(tq - key) * lg) : 0.f; p1[r] = (key + 32 <= tq) ? p1[r] * ex2((float)(tq - key - 32) * lg) : 0.f; } } };
struct SelF { static constexpr int MODE = 0; static constexpr bool HAS_BIAS = false; unsigned long long umask, mymask; int tq, klo, hi;
    __device__ __forceinline__ bool skip(int t) const { return ((umask >> t) & 1ull) == 0ull; }
    __device__ __forceinline__ void apply(f32x16& p0, f32x16& p1, int t) const { const bool on = ((mymask >> t) & 1ull) != 0ull;
#pragma unroll
        for (int r = 0; r < 16; ++r) { const int key = 64 * t + crow(r, hi); if (!on || key > tq || key <= klo) p0[r] = -INFINITY; if (!on || key + 32 > tq || key + 32 <= klo) p1[r] = -INFINITY; } } };
__device__ __forceinline__ void fox_unit(const Params& p, int idx, LAS unsigned char* lds, const int tid_in_) {
    int tid = tid_in_; asm volatile("" : "+v"(tid)); unsigned char* wsl_ = ws_late();
    const int lane = tid & 63, wid = tid >> 6, r32 = lane & 31, hi = lane >> 5;
    const int qb = 15 - (idx >> 5), bh = idx & 31, h = bh & 3, bl = bh >> 2;
    const bf16_t* proj = (const bf16_t*)(wsl_ + WS_R + R_PROJ);
    const int tq = qb * 256 + wid * 32 + r32; const size_t rowc = (size_t)bl * SEQ + tq;
    bf16x8 qf[4]; load_qf(qf, proj + rowc * PROJW + PC_FQ + h * 64, hi);
    f32x16 o[2]; o[0] = (f32x16){}; o[1] = (f32x16){}; float m = -INFINITY, l = 0.f;
    FoxF f; f.tq = tq; f.qmin = qb * 256; f.hi = hi;
    flash_loop(f, 0, 4 * qb + 4, proj + (size_t)bl * SEQ * PROJW + PC_FK + h * 64, proj + (size_t)bl * SEQ * PROJW + PC_FV + h * 64, PROJW,
               (const float*)(wsl_ + WS_R + R_CUM) + (size_t)bh * SEQ, qf, o, m, l, lds, tid);
    l += __shfl_xor(l, 32); const float inv = 1.0f / l; o[0] *= inv; o[1] *= inv;
    store_ot(o, (bf16_t*)(wsl_ + WS_R + R_O) + (size_t)3 * MC * 256 + rowc * 256 + h * 64, hi);
}
__device__ __forceinline__ void ret_unit(const Params& p, int l_, int idx, LAS unsigned char* lds, const int tid_in_) {
    int tid = tid_in_; asm volatile("" : "+v"(tid)); unsigned char* wsl_ = ws_late();
    const int lane = tid & 63, wid = tid >> 6, r32 = lane & 31, hi = lane >> 5;
    const int qb = 15 - (idx >> 5), bh = idx & 31, h = bh & 3, bl = bh >> 2;
    const bf16_t* proj = (const bf16_t*)(wsl_ + WS_R + R_PROJ);
    const int tq = qb * 256 + wid * 32 + r32; const size_t rowc = (size_t)bl * SEQ + tq;
    bf16x8 qf[4]; load_qf(qf, proj + rowc * PROJW + PC_RQ + h * 64, hi);
    f32x16 o[2]; o[0] = (f32x16){}; o[1] = (f32x16){}; float m = 0.f, l = 0.f;
    RetF f; f.tq = tq; f.hi = hi; f.lg = log2f(1.0f - exp2f(-5.0f - (float)h));
    flash_loop(f, 0, 4 * qb + 4, proj + (size_t)bl * SEQ * PROJW + PC_RK + h * 64, proj + (size_t)bl * SEQ * PROJW + PC_RV + h * 64, PROJW, nullptr, qf, o, m, l, lds, tid);
    float s = 0.f;
#pragma unroll
    for (int r = 0; r < 16; ++r) s += o[0][r] + o[1][r];
    s += __shfl_xor(s, 32); const float mu = s * (1.0f / 64.0f); float q = 0.f;
#pragma unroll
    for (int r = 0; r < 16; ++r) { const float a = o[0][r] - mu, b = o[1][r] - mu; q += a * a + b * b; }
    q += __shfl_xor(q, 32); const float rs = 1.0f / sqrtf(q * (1.0f / 64.0f) + LN_EPS);
    const float* gw = PIN(IN_RETGN) + l_ * 256 + h * 64; const bf16_t* grow = proj + rowc * PROJW + PC_RG + h * 64;
#pragma unroll
    for (int d0 = 0; d0 < 2; ++d0)
#pragma unroll
        for (int g = 0; g < 4; ++g) { const int d = 32 * d0 + 8 * g + 4 * hi; const u32x2 gz = *(const u32x2*)(grow + d); const f32x4 w4 = *(const f32x4*)(gw + d);
            const float gg[4] = {__uint_as_float(gz.x << 16), __uint_as_float(gz.x & 0xffff0000u), __uint_as_float(gz.y << 16), __uint_as_float(gz.y & 0xffff0000u)};
#pragma unroll
            for (int e = 0; e < 4; ++e) o[d0][4 * g + e] = (o[d0][4 * g + e] - mu) * rs * w4[e] * siluf_(gg[e]); }
    store_ot(o, (bf16_t*)(wsl_ + WS_R + R_O) + (size_t)1 * MC * 256 + rowc * 256 + h * 64, hi);
}
constexpr int NL_KC = 36864, NL_VC = 69632, NL_IMPM = 102400, NL_IMPS = 118784, NL_SELM = 135424;
__device__ __forceinline__ void nsa_unit(const Params& p, int idx, LAS unsigned char* lds, const int tid_in_) {
    int tid = tid_in_; asm volatile("" : "+v"(tid)); unsigned char* wsl_ = ws_late();
    const int lane = tid & 63, wid = tid >> 6, r32 = lane & 31, hi = lane >> 5, tl = r32 >> 2, hd = r32 & 3;
    const int ib = 63 - (idx >> 3), bl = idx & 7;
    const bf16_t* proj = (const bf16_t*)(wsl_ + WS_R + R_PROJ); const float* sm = (const float*)(wsl_ + WS_R + R_SM);
    const int tokl = 8 * wid + tl, tq = ib * 64 + tokl; const size_t rowc = (size_t)bl * SEQ + tq;
    bf16x8 qf[4]; load_qf(qf, proj + rowc * PROJW + PC_NQ + hd * 64, hi);
    const float g0 = sigmoidf_(sm[rowc * 32 + 8 + hd * 3 + 0]), g1 = sigmoidf_(sm[rowc * 32 + 8 + hd * 3 + 1]), g2 = sigmoidf_(sm[rowc * 32 + 8 + hd * 3 + 2]);
    f32x16 of[2];
    const int ntc = min(3, (4 * ib + 2) >> 6) + 1;
    {
        const bf16_t* kc = (const bf16_t*)(wsl_ + WS_R + R_KCMP) + (size_t)bl * 256 * 64; const bf16_t* vc = kc + (size_t)BC * 256 * 64;
        __syncthreads();
        for (int tt = 0; tt < ntc; ++tt) {
            *(LAS u32x4*)(lds + NL_KC + tt * 8192 + wid * 1024 + lane * 16) = *(const u32x4*)(kc + (size_t)(tt * 64 + lane) * 64 + wid * 8);
            *(LAS u32x4*)(lds + NL_VC + tt * 8192 + wid * 1024 + lane * 16) = *(const u32x4*)(vc + (size_t)(tt * 64 + 16 * (wid & 3) + (lane >> 2)) * 64 + (wid >> 2) * 32 + (lane & 3) * 8); }
        __syncthreads();
        float m = -INFINITY, l = 0.f;
        for (int tt = 0; tt < ntc; ++tt) { f32x16 p0, p1; attn_qkt(p0, p1, lds + NL_KC + tt * 8192, qf, r32, hi);
#pragma unroll
            for (int r = 0; r < 16; ++r) { const int n0 = 64 * tt + crow(r, hi), n1 = n0 + 32; if (n0 >= 255 || 16 * n0 + 31 > tq) p0[r] = -INFINITY; if (n1 >= 255 || 16 * n1 + 31 > tq) p1[r] = -INFINITY; }
            float mt = p0[0];
#pragma unroll
            for (int r = 1; r < 16; ++r) mt = fmaxf(mt, p0[r]);
#pragma unroll
            for (int r = 0; r < 16; ++r) mt = fmaxf(mt, p1[r]);
            mt = fmaxf(mt, __shfl_xor(mt, 32));
            const float mn = fmaxf(m, mt), ms = (mn == -INFINITY) ? 0.f : mn; float s = 0.f;
#pragma unroll
            for (int r = 0; r < 16; ++r) s += ex2(p0[r] - ms) + ex2(p1[r] - ms);
            l = l * ex2(m - ms) + s; m = mn; }
        l += __shfl_xor(l, 32);
        const float inv = (l > 0.f) ? 1.0f / l : 0.f, ms = (m == -INFINITY) ? 0.f : m;
        LAS float* impm = (LAS float*)(lds + NL_IMPM); LAS float* imps = (LAS float*)(lds + NL_IMPS);
        f32x16 oc[2]; oc[0] = (f32x16){}; oc[1] = (f32x16){};
        for (int tt = 0; tt < ntc; ++tt) { f32x16 p0, p1; attn_qkt(p0, p1, lds + NL_KC + tt * 8192, qf, r32, hi);
#pragma unroll
            for (int r = 0; r < 16; ++r) { const int n0 = 64 * tt + crow(r, hi), n1 = n0 + 32;
                p0[r] = (n0 >= 255 || 16 * n0 + 31 > tq) ? 0.f : ex2(p0[r] - ms) * inv; p1[r] = (n1 >= 255 || 16 * n1 + 31 > tq) ? 0.f : ex2(p1[r] - ms) * inv; }
#pragma unroll
            for (int g = 0; g < 4; ++g) {
                float ma = p0[4 * g] + p0[4 * g + 1] + p0[4 * g + 2] + 0.5f * p0[4 * g + 3], sa = 0.5f * p0[4 * g + 3];
                float mb = p1[4 * g] + p1[4 * g + 1] + p1[4 * g + 2] + 0.5f * p1[4 * g + 3], sb = 0.5f * p1[4 * g + 3];
                ma += __shfl_xor(ma, 1); ma += __shfl_xor(ma, 2); sa += __shfl_xor(sa, 1); sa += __shfl_xor(sa, 2);
                mb += __shfl_xor(mb, 1); mb += __shfl_xor(mb, 2); sb += __shfl_xor(sb, 1); sb += __shfl_xor(sb, 2);
                if (hd == 0) { const int ja = 16 * tt + 2 * g + hi, jb = ja + 8;
                    impm[tokl * 64 + ja] = ma; imps[tokl * 65 + ja + 1] = sa; impm[tokl * 64 + jb] = mb; imps[tokl * 65 + jb + 1] = sb; } }
            bf16x8 pw[4]; pw[0] = pack_acc8(p0, 0); pw[1] = pack_acc8(p0, 1); pw[2] = pack_acc8(p1, 0); pw[3] = pack_acc8(p1, 1);
            attn_pv(oc, lds + NL_VC + tt * 8192, pw, lane, hi); }
        of[0] = oc[0] * g0; of[1] = oc[1] * g0;
        LAS unsigned long long* selm = (LAS unsigned long long*)(lds + NL_SELM);
        for (int t8 = 0; t8 < 8; ++t8) { const int tk = 8 * wid + t8; const int j = lane;
            float imp = (j < 16 * ntc) ? impm[tk * 64 + j] + ((j > 0) ? imps[tk * 65 + j] : 0.f) : 0.f;
            const bool forced = (j == 0) || (j == ib) || (j == ib - 1);
            const float score = forced ? 1.0e4f : ((j <= ib) ? imp : -1.0f);
            int rank = 0;
#pragma unroll
            for (int jj = 0; jj < 64; ++jj) { const float sj = __uint_as_float(__builtin_amdgcn_readlane(__float_as_uint(score), jj)); rank += ((sj > score) || (sj == score && jj < j)) ? 1 : 0; }
            const unsigned long long mk = __ballot((rank < 16) && (j <= ib));
            if (lane == 0) selm[tk] = mk; }
    }
    __syncthreads();
    unsigned long long mymask, umask;
    { const LAS unsigned long long* selm = (const LAS unsigned long long*)(lds + NL_SELM); mymask = selm[tokl];
      unsigned long long u = selm[lane]; unsigned lo = (unsigned)u, hi32 = (unsigned)(u >> 32);
#pragma unroll
      for (int o = 32; o >= 1; o >>= 1) { lo |= __shfl_xor(lo, o); hi32 |= __shfl_xor(hi32, o); }
      umask = ((unsigned long long)hi32 << 32) | lo; umask = __builtin_amdgcn_readfirstlane((unsigned)umask) | ((unsigned long long)__builtin_amdgcn_readfirstlane((unsigned)(umask >> 32)) << 32); }
    for (int br = 0; br < 2; ++br) {
        f32x16 o[2]; o[0] = (f32x16){}; o[1] = (f32x16){}; float m = -INFINITY, l = 0.f;
        SelF f; f.umask = br ? ~0ull : umask; f.mymask = br ? ~0ull : mymask; f.tq = tq; f.klo = br ? tq - 512 : -1; f.hi = hi;
        const bf16_t* nkv2 = (const bf16_t*)(ws_late() + WS_R + R_NKV);
        flash_loop(f, br ? max(0, ib - 8) : 0, ib + 1, nkv2 + (size_t)(2 + 2 * br) * (NKV_SEG / 2) + (size_t)bl * SEQ * 64, nkv2 + (size_t)(3 + 2 * br) * (NKV_SEG / 2) + (size_t)bl * SEQ * 64, 64, nullptr, qf, o, m, l, lds, tid);
        l += __shfl_xor(l, 32); const float sc = (l > 0.f) ? (br ? g2 : g1) / l : 0.f; of[0] += o[0] * sc; of[1] += o[1] * sc;
    }
    store_ot(of, (bf16_t*)(ws_late() + WS_R + R_O) + (size_t)2 * MC * 256 + rowc * 256 + hd * 64, hi);
}

constexpr int LDS_MISC = LDS_BYTES - 256;
constexpr size_t LWS = ((LW_BYTES + MiB - 1) / MiB) * MiB;
#define PHASE_PRE const int tid = fresh_tid(); int l, ch; { int k_; bool b_; step_decode(__builtin_amdgcn_readfirstlane(((volatile LAS int*)lds_at(LDS_MISC + 176))[0]), k_, l, ch, b_); } \
    Params p; ptab_load(p); LAS unsigned char* lds = lds_at(0); const int G = NWG; \
    const int c = __builtin_amdgcn_readfirstlane(((volatile LAS int*)(lds + LDS_MISC + 176))[2]); (void)lds; (void)G; (void)c; (void)l; (void)ch; \
    volatile LAS int* qslot = (volatile LAS int*)(lds + LDS_MISC + 16); (void)qslot;
#define LW_ (p.ws + WS_W + (size_t)l * LWS)
#define LWO_ ((unsigned)(WS_W + (size_t)l * LWS))
#define HC_ ((unsigned)(WS_H + (size_t)ch * MC * 1024 * 2))
#define QCTR_ ((unsigned*)(p.ws + WS_CTL) + CW_Q + 64 * ((l * NCHUNK + ch) * 8))
__device__ __forceinline__ int tid_out(int t) { asm volatile("" : "+v"(t)); return t; }
__device__ __forceinline__ int fresh_tid() {
    LAS unsigned* ctr = (LAS unsigned*)lds_at(LDS_MISC + 192);
    unsigned z = 0u; asm volatile("" : "+v"(z));
    const int lane = (int)__builtin_amdgcn_mbcnt_hi(~0u, __builtin_amdgcn_mbcnt_lo(~0u, z));
    unsigned t = 0u; if (lane == 0) t = __hip_atomic_fetch_add(ctr, 1u, __ATOMIC_RELAXED, __HIP_MEMORY_SCOPE_WORKGROUP);
    t = (unsigned)__builtin_amdgcn_readfirstlane((int)t);
    __syncthreads();
    return (int)(((t & 7u) << 6) | (unsigned)lane);
}
__device__ __forceinline__ void step_decode(int s, int& k, int& l, int& ch, bool& bar);
#define PHFN(name) static __device__ __noinline__ void name()
#define PHFI(name) static __device__ __forceinline__ void name()

PHFI(ph_p0) { PHASE_PRE
    constexpr int N_ADA = 192, N_CB = 4, N_ROPE = MTOK * 32 / 4096, N_T = 2 * TJ_TOTAL;
    for (int it = c; it < N_ADA + N_CB + N_ROPE + N_T; it += G) {
        if (it < N_ADA) p0_ada(p, it, (LAS float*)lds, tid);
        else if (it < N_ADA + N_CB) p0_cbias(p, it - N_ADA, tid);
        else if (it < N_ADA + N_CB + N_ROPE) p0_rope(p, it - N_ADA - N_CB, tid);
        else p0_transpose(p, it - N_ADA - N_CB - N_ROPE, (LAS float*)lds, tid);
    }
}
PHFN(ph_p1) { PHASE_PRE prep_first(p, tid, c); }
PHFN(ph_a1) { PHASE_PRE
    DenseSched S; S.A = HC_; S.Bt = LWO_ + (unsigned)LW_WIN; S.tA = 256u * 1024 * 2; S.tB = 256u * 1024 * 2; S.aBr = 0; S.nM = MC / 256; S.nN = NPROJ / 256; S.G = G; S.c = c; S.pnShift = 0;
    EpiProj E;
    pg8::gemm_phase<EpiProj, DenseSched, true, false>(lds, 1024, 1024, 1024, S, E, tid, (const char*)p.ws);
}
PHFN(ph_a2a) { PHASE_PRE
    if (c < 2 * BC) {
        const int which = c & 1, bl = c >> 1;
        OneSched S; S.has = true; S.u0.pm = bl; S.u0.pn = 0; S.u0.aux = which; S.u0.nvalid = 256; S.u0.rows = 0u;
        S.u0.a = (unsigned)(WS_R + R_NKV + (size_t)which * NKV_SEG + (size_t)bl * SEQ * 64 * 2); S.u0.b = LWO_ + (unsigned)(LW_CW1 + (size_t)which * 256 * 2048 * 2);
        EpiH1 E; E.h1 = (bf16_t*)(p.ws + WS_R + R_H1); E.cbias = (const float*)(p.ws + WS_CBIAS) + l * 512;
        pg8::gemm_phase<EpiH1, OneSched, true, false>(lds, 2048, 1024, 2048, S, E, tid, (const char*)p.ws);
        VM_WAIT(); __syncthreads(); __builtin_amdgcn_fence(__ATOMIC_ACQUIRE, "agent"); VM_WAIT(); __syncthreads();
    }
}
PHFN(ph_a2b) { PHASE_PRE
    if (c < 2 * BC) {
        const int which = c & 1, bl = c >> 1;
        OneSched S2; S2.has = true; S2.u0.pm = bl; S2.u0.pn = 0; S2.u0.aux = which; S2.u0.nvalid = 256; S2.u0.rows = 0u;
        S2.u0.a = (unsigned)(WS_R + R_H1 + ((size_t)which * BC * 256 + (size_t)bl * 256) * 256 * 2); S2.u0.b = LWO_ + (unsigned)(LW_CW2 + (size_t)which * 256 * 256 * 2);
        EpiCmp2 E2; E2.kc = (bf16_t*)(p.ws + WS_R + R_KCMP);
        pg8::gemm_phase<EpiCmp2, OneSched, true, false>(lds, 256, 256, 256, S2, E2, tid, (const char*)p.ws);
    }
}
PHFI(ph_a2c) { PHASE_PRE
    for (;;) { const int u = q_next(QCTR_ + 0, qslot, tid); if (u >= BC * 4 * 64) break; gdn_prep_unit(p, l, u, lds, tid); }
}
PHFN(ph_a2d) { PHASE_PRE
    for (;;) { const int u = q_next(QCTR_ + 64, qslot, tid); if (u >= BC * 4) break; fox_cum_item(p, l, u, (LAS float*)lds, tid); }
    ret_rope_pass(p, ch, tid, c);
}
PHFN(ph_a3a) { PHASE_PRE if (c < BC * 4) gdn_scan_item(p, l, ch, c, lds, tid); }
PHFI(ph_a3b) { PHASE_PRE for (;;) { const int u = q_next(QCTR_ + 128, qslot, tid); if (u >= 512) break; fox_unit(p, u, lds, tid); } }
PHFN(ph_a3c) { PHASE_PRE for (;;) { const int u = q_next(QCTR_ + 192, qslot, tid); if (u >= 512) break; ret_unit(p, l, u, lds, tid); } }
PHFI(ph_a3d) { PHASE_PRE for (;;) { const int u = q_next(QCTR_ + 256, qslot, tid); if (u >= 512) break; nsa_unit(p, u, lds, tid); } }
PHFN(ph_a5) { PHASE_PRE
    DenseSched S; S.A = (unsigned)(WS_R + R_O); S.Bt = LWO_ + (unsigned)LW_BPT; S.tA = 256u * 256 * 2; S.tB = 256u * 256 * 2; S.aBr = (unsigned)((size_t)MC * 256 * 2); S.nM = MC / 256; S.nN = 16; S.G = G; S.c = c; S.pnShift = 2;
    EpiP E;
    pg8::gemm_phase<EpiP, DenseSched, true, false>(lds, 256, 256, 256, S, E, tid, (const char*)p.ws);
}
PHFN(ph_a6) { PHASE_PRE
    DenseSched S; S.A = HC_; S.Bt = LWO_ + (unsigned)LW_WGV; S.tA = 256u * 1024 * 2; S.tB = 256u * 1024 * 2; S.aBr = 0; S.nM = MC / 256; S.nN = 16; S.G = G; S.c = c; S.pnShift = 0;
    EpiGate E;
    pg8::gemm_phase<EpiGate, DenseSched, true, false>(lds, 1024, 1024, 1024, S, E, tid, (const char*)p.ws);
}
PHFN(ph_a7) { PHASE_PRE
    DenseSched S; S.A = (unsigned)(WS_R + R_Y); S.Bt = LWO_ + (unsigned)LW_WOT; S.tA = 256u * 1024 * 2; S.tB = 256u * 1024 * 2; S.aBr = 0; S.nM = MC / 256; S.nN = 4; S.G = G; S.c = c; S.pnShift = 0;
    EpiOut E; E.first = (l == 0); E.xin = (l == 0) ? p.in[IN_X] : p.out; E.zout = p.out; E.stats = (const float*)(p.ws + WS_STATS);
    E.lng = p.in[IN_LNG] + (size_t)((l > 0 ? l - 1 : 0) * 2 + 1) * 1024; E.lnb = p.in[IN_LNB] + (size_t)((l > 0 ? l - 1 : 0) * 2 + 1) * 1024;
    E.gate = (const float*)(p.ws + WS_MOD) + (size_t)(l * 2) * 16 * 3072; E.row_base = ch * MC;
    pg8::gemm_phase<EpiOut, DenseSched, true, false>(lds, 1024, 1024, 1024, S, E, tid, (const char*)p.ws);
}
PHFN(ph_b0) { PHASE_PRE prep_moe(p, l, (LAS float*)lds, tid, c); }
__device__ __forceinline__ void moe_tables(const Params& p, int l, LAS int* mcnt, LAS int* mpre, const int tid) {
    __syncthreads();
    if (tid < 16) mcnt[tid] = (int)((unsigned*)(p.ws + WS_CTL))[CW_CNT + l * 64 + tid];
    __syncthreads();
    if (tid == 0) { int s = 0; for (int e = 0; e < 16; ++e) { mpre[e] = s; s += (mcnt[e] + 255) >> 8; } mpre[16] = s; }
    __syncthreads();
}
PHFN(ph_b1) { PHASE_PRE
    LAS int* mcnt = (LAS int*)(lds + LDS_MISC + 32); LAS int* mpre = mcnt + 16; moe_tables(p, l, mcnt, mpre, tid);
    MoeSched S; S.pre = mpre; S.cnt = mcnt; S.wsb = (const char*)p.ws; S.A = (unsigned)WS_H; S.W = LWO_ + (unsigned)LW_W13;
    S.wE = 1024u * 1024 * 2; S.wT = 256u * 1024 * 2; S.aT = 0; S.G = G; S.c = c; S.gatherA = true;
    EpiMoe1 E;
    pg8::gemm_phase<EpiMoe1, MoeSched, true, true>(lds, 1024, 1024, 1024, S, E, tid, (const char*)p.ws);
}
PHFN(ph_b2) { PHASE_PRE
    LAS int* mcnt = (LAS int*)(lds + LDS_MISC + 32); LAS int* mpre = mcnt + 16; moe_tables(p, l, mcnt, mpre, tid);
    MoeSched S; S.pre = mpre; S.cnt = mcnt; S.wsb = (const char*)p.ws; S.A = (unsigned)(WS_R + R_HID); S.W = LWO_ + (unsigned)LW_W2;
    S.wE = 1024u * 512 * 2; S.wT = 256u * 512 * 2; S.aT = 256u * 512 * 2; S.G = G; S.c = c; S.gatherA = false;
    EpiMoe2 E;
    pg8::gemm_phase<EpiMoe2, MoeSched, true, false>(lds, 512, 512, 512, S, E, tid, (const char*)p.ws);
}
PHFN(ph_b3) { PHASE_PRE prep_next(p, l, l == DEPTH - 1, tid, c); }

constexpr int STEPS_CHUNK = 12, STEPS_LAYER = 2 * STEPS_CHUNK + 4, N_STEPS = 2 + DEPTH * STEPS_LAYER;
__device__ __forceinline__ void step_decode(int s, int& k, int& l, int& ch, bool& bar) {
    if (s < 2) { k = s; l = 0; ch = 0; bar = true; return; }
    const int t = s - 2; l = t / STEPS_LAYER; const int r = t % STEPS_LAYER;
    if (r < 2 * STEPS_CHUNK) { ch = r / STEPS_CHUNK; const int q = r % STEPS_CHUNK; k = 2 + q; bar = !(q == 1 || q == 2 || q == 3 || q == 5 || q == 6 || q == 7); }
    else { ch = 0; k = 14 + (r - 2 * STEPS_CHUNK); bar = true; }
}
__global__ void __launch_bounds__(NTHR, 2) __attribute__((disable_tail_calls)) mega_fwd(Params p0_) {
    LAS unsigned char* lds = lds_at(0);
    const int tid = threadIdx.x;
    volatile LAS unsigned* xbw = (volatile LAS unsigned*)(lds + LDS_MISC);
    volatile LAS int* st = (volatile LAS int*)(lds + LDS_MISC + 176);
    if (tid == 0) { xbw[0] = 0u; xbw[1] = 0u; xbw[2] = 0u; xbw[3] = 0u; st[0] = p0_.ph_lo; st[1] = p0_.ph_hi; st[2] = blockIdx.x; *(volatile LAS unsigned*)(lds + LDS_MISC + 192) = 0u; }
    ptab_store(p0_, tid);
    __syncthreads();
    (void)xcd_barrier_post((unsigned*)(p0_.ws + WS_CTL) + CW_BAR, xbw, tid);
    for (;;) {
        {
          LAS unsigned char* mb_ = lds_at(LDS_MISC); volatile LAS int* st_ = (volatile LAS int*)(mb_ + 176);
          const int s = __builtin_amdgcn_readfirstlane(st_[0]), e = __builtin_amdgcn_readfirstlane(st_[1]);
          if (s >= e) break;
          int k, l, ch; bool bar; step_decode(s, k, l, ch, bar);
          switch (k) {
          case 0: ph_p0(); break;
          case 1: ph_p1(); break;
          case 2: ph_a1(); break;
          case 3: ph_a2a(); break;
          case 4: ph_a2b(); break;
          case 5: ph_a2c(); break;
          case 6: ph_a2d(); break;
          case 7: ph_a3a(); break;
          case 8: ph_a3b(); break;
          case 9: ph_a3c(); break;
          case 10: ph_a3d(); break;
          case 11: ph_a5(); break;
          case 12: ph_a6(); break;
          case 13: ph_a7(); break;
          case 14: ph_b0(); break;
          case 15: ph_b1(); break;
          case 16: ph_b2(); break;
          default: ph_b3(); break;
          } }
        { const int tid = fresh_tid(); LAS unsigned char* mb_ = lds_at(LDS_MISC); volatile LAS int* st_ = (volatile LAS int*)(mb_ + 176);
          volatile LAS unsigned* xbw_ = (volatile LAS unsigned*)mb_;
          const int s = __builtin_amdgcn_readfirstlane(st_[0]), e = __builtin_amdgcn_readfirstlane(st_[1]);
          int k, l, ch; bool bar; step_decode(s, k, l, ch, bar);
          if (bar && s + 1 < e) { XcdBarrier b; b.bar = (unsigned*)((unsigned char*)ptab_get(28) + WS_CTL) + CW_BAR; b.x = xb_xcc_id(); b.st = xbw_; xcd_barrier(b, tid); }
          __syncthreads();
          if (tid == 0) st_[0] = s + 1;
          __syncthreads(); }
    }
}

extern "C" void kernel_launch(void* const* d_in, const int* in_sizes, int n_in, void* d_out, int out_size, void* d_ws, size_t ws_size, hipStream_t stream) {
    (void)in_sizes; (void)out_size;
    if (n_in < 27 || ws_size < WS_END) { fprintf(stderr, "kernel_launch: unexpected inputs (n_in %d, ws %zu < %zu)\n", n_in, ws_size, (size_t)WS_END); return; }
    static bool attr_set = false;
    if (!attr_set) { (void)hipFuncSetAttribute((const void*)mega_fwd, hipFuncAttributeMaxDynamicSharedMemorySize, LDS_BYTES); attr_set = true; }
    Params p{};
    for (int i = 0; i < 27; ++i) p.in[i] = (const float*)d_in[i];
    p.out = (float*)d_out; p.ws = (unsigned char*)d_ws;
    (void)hipMemsetAsync((unsigned char*)d_ws + WS_CTL, 0, CTL_BYTES, stream);
#ifndef MK_CUTS
    p.ph_lo = 0; p.ph_hi = N_STEPS;
    hipLaunchKernelGGL(mega_fwd, dim3(NWG), dim3(NTHR), LDS_BYTES, stream, p);
#else
    { static const int cuts[] = {MK_CUTS, N_STEPS}; int lo = 0;
      for (unsigned i = 0; i < sizeof(cuts) / sizeof(cuts[0]); ++i) { p.ph_lo = lo; p.ph_hi = cuts[i]; lo = cuts[i]; hipLaunchKernelGGL(mega_fwd, dim3(NWG), dim3(NTHR), LDS_BYTES, stream, p); } }
#endif
}
```

```cpp
#include <hip/hip_runtime.h>
#include <stdint.h>
#include <stdio.h>

#define GAS __attribute__((address_space(1)))
#define LAS __attribute__((address_space(3)))
typedef unsigned short bf16_t;
typedef short bf16x8 __attribute__((ext_vector_type(8)));
typedef short s16x4 __attribute__((ext_vector_type(4)));
typedef float f32x2 __attribute__((ext_vector_type(2)));
typedef float f32x4 __attribute__((ext_vector_type(4)));
typedef float f32x16 __attribute__((ext_vector_type(16)));
typedef unsigned u32x2 __attribute__((ext_vector_type(2)));
typedef unsigned u32x4 __attribute__((ext_vector_type(4)));
typedef __bf16 bf16x2_t __attribute__((ext_vector_type(2)));

constexpr int D_MODEL = 1024, BATCH = 16, SEQ = 4096, DEPTH = 2, MTOK = BATCH * SEQ;
constexpr int NCHUNK = 2, BC = BATCH / NCHUNK, MC = BC * SEQ;
constexpr int NPROJ = 3584, PROJW = 3072;
constexpr float DN_ALPHA = 1.4142135623730951f;
constexpr float LN_EPS = 1e-5f;
constexpr float LOG2E = 1.4426950408889634f;
constexpr float QSCALE = 0.125f * 1.4426950408889634f;
constexpr int NWG = 256, NTHR = 512;
constexpr int LDS_BYTES = 163840;

constexpr int PC_GQ = 0, PC_GK = 256, PC_GV = 512, PC_GZ = 768, PC_RQ = 1024, PC_RK = 1280, PC_RV = 1536, PC_RG = 1792, PC_NQ = 2048, PC_FQ = 2304, PC_FK = 2560, PC_FV = 2816;

constexpr size_t MiB = 1ull << 20;
constexpr size_t WS_CTL = 0;
constexpr size_t CTL_BYTES = 1 * MiB;
constexpr size_t WS_MOD = 1 * MiB;
constexpr size_t WS_ROPE = 2 * MiB;
constexpr size_t WS_STATS = 18 * MiB;
constexpr size_t WS_CBIAS = 19 * MiB;
constexpr size_t WS_W = 20 * MiB;
constexpr size_t LW_WIN = 0;
constexpr size_t LW_WGV = LW_WIN + (size_t)NPROJ * 1024 * 2;
constexpr size_t LW_BPT = LW_WGV + (size_t)4096 * 1024 * 2;
constexpr size_t LW_WOT = LW_BPT + (size_t)4096 * 256 * 2;
constexpr size_t LW_W13 = LW_WOT + (size_t)1024 * 1024 * 2;
constexpr size_t LW_W2 = LW_W13 + (size_t)16 * 1024 * 1024 * 2;
constexpr size_t LW_CW1 = LW_W2 + (size_t)16 * 1024 * 512 * 2;
constexpr size_t LW_CW2 = LW_CW1 + (size_t)2 * 256 * 2048 * 2;
constexpr size_t LW_BYTES = LW_CW2 + (size_t)2 * 256 * 256 * 2;
constexpr size_t WS_H = WS_W + 2 * ((LW_BYTES + MiB - 1) / MiB) * MiB;
constexpr size_t WS_R = WS_H + 128 * MiB;
constexpr size_t R_PROJ = 0;
constexpr size_t R_GDN = R_PROJ + (size_t)MC * PROJW * 2;
constexpr size_t GDN_UNIT_BYTES = 5 * 8192;
constexpr size_t R_P = 0;
constexpr size_t R_NKV = R_GDN + (size_t)BC * 4 * 64 * GDN_UNIT_BYTES;
constexpr size_t NKV_SEG = (size_t)(MC + 64) * 64 * 2;
constexpr size_t R_SM = R_NKV + 6 * NKV_SEG;
constexpr size_t R_CUM = R_SM + (size_t)MC * 32 * 4;
constexpr size_t R_GG = R_CUM + (size_t)BC * 4 * 4096 * 4;
constexpr size_t R_KCMP = R_GG + (size_t)BC * 4 * 64 * 4 + 768;
constexpr size_t R_H1 = R_KCMP + (size_t)2 * BC * 256 * 64 * 2;
constexpr size_t R_O = R_H1 + (size_t)2 * BC * 256 * 256 * 2;
constexpr size_t R_Y = R_O + (size_t)4 * MC * 256 * 2;
constexpr size_t R_MIX_END = R_Y + (size_t)MC * 1024 * 2;
static_assert(R_NKV >= (size_t)MC * 4096 * 2, "P overlay fits under PROJ+GDN");
constexpr size_t R_LIST = 0;
constexpr size_t R_CW = R_LIST + (size_t)16 * MTOK * 4;
constexpr size_t R_HID = R_CW + (size_t)16 * MTOK * 4;
constexpr size_t R_OUT2 = R_HID + (size_t)(2 * MTOK + 4096) * 512 * 2;
constexpr size_t R_MOE_END = R_OUT2 + (size_t)2 * MTOK * 1024 * 2;
constexpr size_t WS_T = WS_R + (((R_MIX_END > R_MOE_END ? R_MIX_END : R_MOE_END) + MiB - 1) / MiB) * MiB;
constexpr size_t WS_END = WS_T + (size_t)MTOK * 1024 * 2;

constexpr int CW_BAR = 4096;
constexpr int CW_CNT = 8192;
constexpr int CW_Q = 8448;

__device__ __forceinline__ float bf2f(bf16_t v) { return __uint_as_float(((unsigned)v) << 16); }
__device__ __forceinline__ unsigned pk2(float lo, float hi) { f32x2 v = {lo, hi}; bf16x2_t b = __builtin_convertvector(v, bf16x2_t); return __builtin_bit_cast(unsigned, b); }
__device__ __forceinline__ bf16_t f2bf(float f) { return (bf16_t)(pk2(f, 0.f) & 0xffffu); }
__device__ __forceinline__ float ex2(float x) { return __builtin_amdgcn_exp2f(x); }
__device__ __forceinline__ float sigmoidf_(float x) { return __builtin_amdgcn_rcpf(1.0f + __expf(-x)); }
__device__ __forceinline__ float siluf_(float x) { return x * __builtin_amdgcn_rcpf(1.0f + __expf(-x)); }
__device__ __forceinline__ int crow(int r, int hi) { return (r & 3) + 8 * (r >> 2) + 4 * hi; }
__device__ __forceinline__ float wave_sum(float v) {
#pragma unroll
    for (int o = 32; o >= 1; o >>= 1) v += __shfl_xor(v, o);
    return v;
}
#define VM_WAIT() asm volatile("s_waitcnt vmcnt(0)" ::: "memory")
#define MF32(a, b, c) __builtin_amdgcn_mfma_f32_32x32x16_bf16(a, b, c, 0, 0, 0)

#define XB_TMO      128
#define XB_XCNT(j)  (256  + 64 * (j))
#define XB_XSUB(j)  (1280 + 64 * (j))
#define XB_XGEN(j)  (2304 + 64 * (j))
#define XB_TOP      3328
#define XB_TOPGEN   3392
#define XCD_BAR_WORDS 3456
#define XB_SPIN_CAP (1u << 22)

__device__ __forceinline__ unsigned xb_ld(unsigned* p)              { return __hip_atomic_load(p, __ATOMIC_RELAXED, __HIP_MEMORY_SCOPE_AGENT); }
__device__ __forceinline__ unsigned xb_add(unsigned* p, unsigned v) { return __hip_atomic_fetch_add(p, v, __ATOMIC_RELAXED, __HIP_MEMORY_SCOPE_AGENT); }
__device__ __forceinline__ unsigned xb_xcc_id() { return (unsigned)__builtin_amdgcn_s_getreg((3 << 11) | 20) & 0xFu; }
#define XB_SPIN(cond, bar) do { unsigned _sp = 0; while (cond) { __builtin_amdgcn_s_sleep(1); \
    if ((++_sp & 255u) == 0u) { if (xb_ld(&(bar)[XB_TMO])) break; if (_sp > XB_SPIN_CAP) { atomicAdd(&(bar)[XB_TMO], 1u); break; } } } } while (0)

struct XcdBarrier { unsigned* bar; unsigned x; volatile LAS unsigned* st; };

__device__ __forceinline__ XcdBarrier xcd_barrier_post(unsigned* bar, volatile LAS unsigned* st, int tid) {
    XcdBarrier b; b.bar = bar; b.x = xb_xcc_id(); b.st = st;
    if (tid == 0) (void)xb_add(&bar[XB_XCNT(b.x)], 1u);
    return b;
}
__device__ __forceinline__ void xcd_barrier_complete(unsigned* bar, unsigned x, unsigned& nloc, unsigned& nx) {
    const unsigned G = NWG;
    unsigned sum, cnt, mine, sp = 0u;
    for (;;) {
        sum = 0u; cnt = 0u; mine = 0u;
#pragma unroll
        for (unsigned j = 0; j < 16; ++j) { const unsigned c = xb_ld(&bar[XB_XCNT(j)]); sum += c; cnt += (c > 0u) ? 1u : 0u; mine = (j == x) ? c : mine; }
        if (sum == G) break;
        __builtin_amdgcn_s_sleep(1);
        if ((++sp & 255u) == 0u) { if (xb_ld(&bar[XB_TMO])) break; if (sp > XB_SPIN_CAP) { atomicAdd(&bar[XB_TMO], 1u); break; } }
    }
    nloc = mine > 0u ? mine : 1u; nx = cnt > 0u ? cnt : 1u;
}
__device__ __forceinline__ void xcd_barrier(const XcdBarrier& b, int tid) {
    asm volatile("s_waitcnt vmcnt(0)" ::: "memory");
    __syncthreads();
    if (tid == 0) {
        unsigned* bar = b.bar;
        __builtin_amdgcn_s_waitcnt(0);
        unsigned nloc = b.st[0], nx = b.st[1];
        if (nloc == 0u) { xcd_barrier_complete(bar, b.x, nloc, nx); b.st[0] = nloc; b.st[1] = nx; }
        const unsigned old = xb_add(&bar[XB_XSUB(b.x)], 1u);
        const unsigned gen = old / nloc;
        if (old + 1u == (gen + 1u) * nloc) {
            __builtin_amdgcn_fence(__ATOMIC_RELEASE, "agent");
            asm volatile("s_waitcnt vmcnt(0)" ::: "memory");
            const unsigned og = xb_add(&bar[XB_TOP], 1u);
            const unsigned tg = og / nx;
            if (og + 1u == (tg + 1u) * nx) xb_add(&bar[XB_TOPGEN], 1u);
            else XB_SPIN(xb_ld(&bar[XB_TOPGEN]) == tg, bar);
            __builtin_amdgcn_fence(__ATOMIC_ACQUIRE, "agent");
            xb_add(&bar[XB_XGEN(b.x)], 1u);
            asm volatile("s_waitcnt vmcnt(0)" ::: "memory");
        } else {
            XB_SPIN(xb_ld(&bar[XB_XGEN(b.x)]) == gen, bar);
            __builtin_amdgcn_fence(__ATOMIC_ACQUIRE, "agent");
            asm volatile("s_waitcnt vmcnt(0)" ::: "memory");
        }
    }
    __syncthreads();
}

struct Params {
    const float* in[27];
    float* out;
    unsigned char* ws;
    int ph_lo, ph_hi;
};
__device__ __forceinline__ LAS unsigned char* lds_at(int off) { asm volatile("" : "+s"(off)); return (LAS unsigned char*)(unsigned)off; }
constexpr int LDS_PTAB = LDS_BYTES - 512;
__device__ __forceinline__ void ptab_store(const Params& p, int tid) {
    LAS unsigned long long* t = (LAS unsigned long long*)lds_at(LDS_PTAB);
    if (tid == 0) {
#pragma unroll
        for (int i = 0; i < 27; ++i) t[i] = (unsigned long long)p.in[i];
        t[27] = (unsigned long long)p.out; t[28] = (unsigned long long)p.ws; }
}
__device__ __forceinline__ unsigned long long ptab_get(int i) {
    const LAS unsigned* t = (const LAS unsigned*)lds_at(LDS_PTAB) + 2 * i;
    const unsigned lo = __builtin_amdgcn_readfirstlane(t[0]), hi = __builtin_amdgcn_readfirstlane(t[1]);
    return ((unsigned long long)hi << 32) | lo;
}
__device__ __forceinline__ unsigned char* ws_late() { return (unsigned char*)ptab_get(28); }
#define PIN(i) ((const float*)ptab_get(i))
__device__ __forceinline__ void ptab_load(Params& q) {
    asm volatile("" ::: "memory");
#pragma unroll
    for (int i = 0; i < 27; ++i) q.in[i] = (const float*)ptab_get(i);
    q.out = (float*)ptab_get(27); q.ws = (unsigned char*)ptab_get(28); q.ph_lo = 0; q.ph_hi = 0;
}

namespace pg8 {
constexpr int BM = 256, BK = 64, HALF = 128, HTB = HALF * BK * 2, NXCD = 8, WGM = 8;
__device__ __forceinline__ int lds_byte(int r, int c) { const int st = (r >> 4) * 2 + (c >> 5), rr = r & 15, cc = c & 31, ob = rr * 64 + cc * 2; return st * 1024 + (ob ^ (((ob >> 9) & 1) << 5)); }
__device__ __forceinline__ void stage_rc(int b, int& R, int& C) { const int st = b / 1024, sb = b % 1024, swz = sb ^ (((sb >> 9) & 1) << 5); R = (st >> 1) * 16 + swz / 64; C = (st & 1) * 32 + (swz % 64) / 2; }
__device__ __forceinline__ int perm32(int rho) { const int n = rho >> 4, i = rho & 15; return 8 * (i >> 2) + 4 * n + (i & 3); }

struct Unit { unsigned a, b, rows; int pm, pn, aux, nvalid; };

__device__ __forceinline__ bool dense_unit(int i, int G, int c, int nM, int nN, int& pm, int& pn) {
    const int nwg = nM * nN; const long L = (long)i * G + c; if (L >= nwg) return false;
    int wgid = (int)L; { const int q = nwg / NXCD, r = nwg % NXCD, xcd = wgid % NXCD, off = wgid / NXCD; wgid = (xcd < r ? xcd * (q + 1) : r * (q + 1) + (xcd - r) * q) + off; }
    const int nig = WGM * nN, gid = wgid / nig, fm = gid * WGM, gsz = (nM - fm) < WGM ? (nM - fm) : WGM;
    pm = fm + ((wgid % nig) % gsz); pn = (wgid % nig) / gsz; return true;
}

template <class Epi, class Sched, bool ALIGN_EPI, bool GATHER>
__device__ __forceinline__ void gemm_phase(LAS unsigned char* lds, const int K, const int lda, const int ldb, const Sched& S, const Epi& E, const int tid, const char* wsb) {
    const int wid = __builtin_amdgcn_readfirstlane(tid >> 6), lane = tid & 63, wr = wid >> 2, wc = wid & 3, fr = lane & 15, fq = lane >> 4;
    const int nt = K / BK;
    unsigned voffA[2], voffB[2]; int rA[2], cA2[2];
#pragma unroll
    for (int i = 0; i < 2; ++i) { int R, C; stage_rc(tid * 16 + i * 8192, R, C); const int Rb = Epi::PERM ? ((R & ~31) + perm32(R & 31)) : R;
        rA[i] = R; cA2[i] = C * 2; voffA[i] = (unsigned)(R * lda + C) * 2u; voffB[i] = (unsigned)(Rb * ldb + C) * 2u; }
    const unsigned kstep = (unsigned)(BK * 2);
    const unsigned hstepA = GATHER ? 0u : (unsigned)(HALF * lda * 2), hstepB = (unsigned)(HALF * ldb * 2);
    const unsigned ldsw = (unsigned)wid * 1024u;
    const int aoff = lds_byte(wr * 64 + fr, fq * 8), boff = lds_byte(wc * 32 + fr, fq * 8);
#define PG8_SA(b, h) (((b) * 2 + (h)) * HTB)
#define PG8_SB(b, h) ((4 + (b) * 2 + (h)) * HTB)
#define PG8_STAGE(bufoff, gbase, voff) do { _Pragma("unroll") for (int _i = 0; _i < 2; ++_i) \
        __builtin_amdgcn_global_load_lds((const unsigned*)(wsb + (size_t)(unsigned)((gbase) + (voff)[_i])), (LAS unsigned*)(lds + (bufoff) + ldsw + _i * 8192), 16, 0, 0); } while (0)
#define PG8_LDA(dst, b, h) do { _Pragma("unroll") for (int m = 0; m < 4; ++m) _Pragma("unroll") for (int k = 0; k < 2; ++k) dst[m][k] = *(const LAS bf16x8*)(lds + PG8_SA(b, h) + aoff + m * 2048 + k * 1024); } while (0)
#define PG8_LDB(dst, b, h) do { _Pragma("unroll") for (int n = 0; n < 2; ++n) _Pragma("unroll") for (int k = 0; k < 2; ++k) dst[n][k] = *(const LAS bf16x8*)(lds + PG8_SB(b, h) + boff + n * 2048 + k * 1024); } while (0)
#define PG8_MMA(ai, bj, At, Bt) do { __builtin_amdgcn_s_setprio(1); _Pragma("unroll") for (int m = 0; m < 4; ++m) _Pragma("unroll") for (int n = 0; n < 2; ++n) _Pragma("unroll") for (int k = 0; k < 2; ++k) \
        acc[ai][bj][m][n] = __builtin_amdgcn_mfma_f32_16x16x32_bf16(Bt[n][k], At[m][k], acc[ai][bj][m][n], 0, 0, 0); __builtin_amdgcn_s_setprio(0); } while (0)
#define PG8_WAIT_V(n) asm volatile("s_waitcnt vmcnt(" #n ")" ::: "memory")
#define PG8_WAIT_L(n) asm volatile("s_waitcnt lgkmcnt(" #n ")" ::: "memory")
#define PG8_BAR __builtin_amdgcn_s_barrier()
#define PG8_SCHED __builtin_amdgcn_sched_barrier(0)
    Unit cur, nxt; int ui = 0;
    if (!S.next(0, cur)) return;
    f32x4 acc[2][2][4][2];
#pragma unroll
    for (int a = 0; a < 2; ++a)
#pragma unroll
        for (int b = 0; b < 2; ++b)
#pragma unroll
            for (int m = 0; m < 4; ++m)
#pragma unroll
                for (int n = 0; n < 2; ++n) acc[a][b][m][n] = (f32x4){0.f, 0.f, 0.f, 0.f};
    bf16x8 At[4][2], B0[2][2], B1[2][2];
    unsigned cA = cur.a, cB = cur.b;
    LAS unsigned* grec = (LAS unsigned*)(lds + 131072) + tid * 8;
    if constexpr (GATHER) {
#pragma unroll
        for (int i = 0; i < 2; ++i) { const unsigned o0 = (unsigned)S.row(cur, rA[i]) * (unsigned)(lda * 2) + cA2[i], o1 = (unsigned)S.row(cur, HALF + rA[i]) * (unsigned)(lda * 2) + cA2[i];
            grec[i] = o0; grec[2 + i] = o1; grec[4 + i] = o0; grec[6 + i] = o1; }
    }
#define PG8_STAGE_A(bufoff, kptr, h, usenext) do { if constexpr (GATHER) { const u32x2 _w = *(const LAS u32x2*)(grec + ((usenext) ? 4 : 0) + 2 * (h)); unsigned _v[2]; _v[0] = _w.x; _v[1] = _w.y; PG8_STAGE(bufoff, kptr, _v); } \
        else { PG8_STAGE(bufoff, (kptr) + (h) * hstepA, voffA); } } while (0)
    PG8_STAGE(PG8_SB(0, 0), cB, voffB); PG8_STAGE(PG8_SB(0, 1), cB + hstepB, voffB); PG8_STAGE_A(PG8_SA(0, 0), cA, 0, false); PG8_STAGE_A(PG8_SA(0, 1), cA, 1, false);
    if (wr == 1) PG8_BAR;
    PG8_WAIT_V(2); PG8_BAR;
    PG8_STAGE(PG8_SB(1, 0), cB + kstep, voffB); PG8_STAGE_A(PG8_SA(1, 0), cA + kstep, 0, false); PG8_STAGE(PG8_SB(1, 1), cB + hstepB + kstep, voffB);
    PG8_WAIT_V(6); PG8_BAR;
    for (;;) {
        const bool has_next = S.next(ui + 1, nxt);
        const unsigned nA = has_next ? nxt.a : cA, nB = has_next ? nxt.b : cB;
        for (int t = 0; t < nt; t += 2) {
            const bool last = (t == nt - 2);
            const unsigned a1 = cA + (unsigned)(t + 1) * kstep;
            const unsigned a2 = last ? nA : cA + (unsigned)(t + 2) * kstep, b2 = last ? nB : cB + (unsigned)(t + 2) * kstep;
            const unsigned a3 = a2 + kstep, b3 = b2 + kstep;
            if constexpr (GATHER) { if (last && has_next) {
#pragma unroll
                for (int i = 0; i < 2; ++i) { grec[4 + i] = (unsigned)S.row(nxt, rA[i]) * (unsigned)(lda * 2) + cA2[i]; grec[6 + i] = (unsigned)S.row(nxt, HALF + rA[i]) * (unsigned)(lda * 2) + cA2[i]; } } }
            PG8_LDB(B0, 0, 0); PG8_LDB(B1, 0, 1); PG8_SCHED; PG8_LDA(At, 0, 0); PG8_STAGE_A(PG8_SA(1, 1), a1, 1, false);
            PG8_WAIT_V(8); PG8_WAIT_L(0); PG8_BAR; PG8_MMA(0, 0, At, B0); PG8_MMA(0, 1, At, B1); PG8_BAR; PG8_SCHED;
            PG8_LDA(At, 0, 1); PG8_STAGE(PG8_SB(0, 0), b2, voffB); PG8_STAGE(PG8_SB(0, 1), b2 + hstepB, voffB); PG8_STAGE_A(PG8_SA(0, 0), a2, 0, last);
            PG8_WAIT_V(8); PG8_WAIT_L(0); PG8_BAR; PG8_MMA(1, 0, At, B0); PG8_MMA(1, 1, At, B1); PG8_BAR; PG8_SCHED;
            PG8_LDB(B0, 1, 0); PG8_LDB(B1, 1, 1); PG8_SCHED; PG8_LDA(At, 1, 0); PG8_STAGE_A(PG8_SA(0, 1), a2, 1, last);
            PG8_WAIT_V(8); PG8_WAIT_L(0); PG8_BAR; PG8_MMA(0, 0, At, B0); PG8_MMA(0, 1, At, B1); PG8_BAR; PG8_SCHED;
            PG8_LDA(At, 1, 1); PG8_STAGE(PG8_SB(1, 0), b3, voffB); PG8_STAGE(PG8_SB(1, 1), b3 + hstepB, voffB); PG8_STAGE_A(PG8_SA(1, 0), a3, 0, last);
            PG8_WAIT_V(8); PG8_WAIT_L(0); PG8_BAR; PG8_MMA(1, 0, At, B0); PG8_MMA(1, 1, At, B1); PG8_BAR; PG8_SCHED;
        }
        if constexpr (ALIGN_EPI) { if (wr == 0) PG8_BAR; }
        { int tz = tid; asm volatile("" : "+v"(tz)); const int ew = __builtin_amdgcn_readfirstlane(tz >> 6), el = tz & 63;
          E(acc, cur, ew >> 2, ew & 3, el & 15, el >> 4); }
        if (!has_next) break;
#pragma unroll
        for (int a = 0; a < 2; ++a)
#pragma unroll
            for (int b = 0; b < 2; ++b)
#pragma unroll
                for (int m = 0; m < 4; ++m)
#pragma unroll
                    for (int n = 0; n < 2; ++n) acc[a][b][m][n] = (f32x4){0.f, 0.f, 0.f, 0.f};
        cur = nxt; cA = nA; cB = nB; ++ui;
        if constexpr (GATHER) { const u32x4 _n = *(const LAS u32x4*)(grec + 4); *(LAS u32x4*)grec = _n; }
        if constexpr (ALIGN_EPI) { if (wr == 1) PG8_BAR; }
    }
    PG8_WAIT_V(0);
    if constexpr (!ALIGN_EPI) { if (wr == 0) PG8_BAR; }
    PG8_BAR;
#undef PG8_SA
#undef PG8_SB
#undef PG8_STAGE
#undef PG8_STAGE_A
#undef PG8_LDA
#undef PG8_LDB
#undef PG8_MMA
#undef PG8_WAIT_V
#undef PG8_WAIT_L
#undef PG8_BAR
#undef PG8_SCHED
}
}
using pg8::Unit;

struct DenseSched {
    unsigned A, Bt, tA, tB, aBr; int nM, nN, G, c, pnShift;
    __device__ __forceinline__ bool next(int i, Unit& u) const {
        int pm, pn; if (!pg8::dense_unit(i, G, c, nM, nN, pm, pn)) return false;
        u.pm = pm; u.pn = pn; u.aux = 0; u.nvalid = 256; u.rows = 0u;
        u.a = A + (unsigned)(pn >> pnShift) * aBr + (unsigned)pm * tA; u.b = Bt + (unsigned)pn * tB; return true;
    }
    __device__ __forceinline__ int row(const Unit&, int) const { return 0; }
};
struct OneSched {
    Unit u0; bool has;
    __device__ __forceinline__ bool next(int i, Unit& u) const { if (i > 0 || !has) return false; u = u0; return true; }
    __device__ __forceinline__ int row(const Unit&, int) const { return 0; }
};
struct MoeSched {
    const LAS int* pre;
    const LAS int* cnt;
    const char* wsb;
    unsigned A, W, wE, wT, aT; int G, c; bool gatherA;
    __device__ __forceinline__ bool next(int i, Unit& u) const {
        const long L = (long)i * G + c; const int total = pre[16] * 4; if (L >= total) return false;
        const int t = (int)(L >> 2), pn = (int)(L & 3); int e = 0;
#pragma unroll
        for (int j = 1; j < 16; ++j) e += (pre[j] <= t) ? 1 : 0;
        const int pm = t - pre[e];
        u.aux = e; u.pm = t; u.pn = pn; u.nvalid = min(256, cnt[e] - 256 * pm); u.rows = (unsigned)(WS_R + R_LIST) + (unsigned)(e * MTOK + 256 * pm) * 4u;
        u.a = gatherA ? A : A + (unsigned)t * aT; u.b = W + (unsigned)e * wE + (unsigned)pn * wT; return true;
    }
    __device__ __forceinline__ int row(const Unit& u, int R) const { return (R < u.nvalid) ? (((const int*)(wsb + u.rows))[R] >> 1) : 0; }
};

typedef f32x4 Acc[2][2][4][2];
#define EPI_LOOP_AIM _Pragma("unroll") for (int ai = 0; ai < 2; ++ai) _Pragma("unroll") for (int m = 0; m < 4; ++m)
__device__ __forceinline__ u32x4 pack8(const f32x4& a, const f32x4& b) { u32x4 w; w.x = pk2(a[0], a[1]); w.y = pk2(a[2], a[3]); w.z = pk2(b[0], b[1]); w.w = pk2(b[2], b[3]); return w; }

struct EpiProj {
    static constexpr bool PERM = true;
    __device__ __forceinline__ void operator()(const Acc& acc, const Unit& u, int wr, int wc, int fr, int fq) const {
        unsigned char* ws = ws_late(); bf16_t* proj = (bf16_t*)(ws + WS_R + R_PROJ); bf16_t* nkv = (bf16_t*)(ws + WS_R + R_NKV); float* sm = (float*)(ws + WS_R + R_SM);
        const int row0 = u.pm * 256 + wr * 64 + fr;
        if (u.pn < 12) {
            const float sc = (u.pn == 8 || u.pn == 9) ? QSCALE : (u.pn == 5 ? 0.125f : 1.0f);
            const int col0 = u.pn * 256 + wc * 32 + 8 * fq;
            EPI_LOOP_AIM { bf16_t* rp = proj + (size_t)(row0 + ai * 128 + m * 16) * PROJW + col0;
#pragma unroll
                for (int bj = 0; bj < 2; ++bj) *(u32x4*)(rp + bj * 128) = pack8(acc[ai][bj][m][0] * sc, acc[ai][bj][m][1] * sc); }
        } else {
#pragma unroll
            for (int bj = 0; bj < 2; ++bj) {
                if (u.pn == 12 || bj == 0) {
                    const int seg = (u.pn - 12) * 4 + bj * 2 + (wc >> 1), col = 32 * (wc & 1) + 8 * fq;
                    bf16_t* base = nkv + (size_t)seg * (NKV_SEG / 2) + col;
                    EPI_LOOP_AIM { *(u32x4*)(base + (size_t)(row0 + ai * 128 + m * 16) * 64) = pack8(acc[ai][bj][m][0], acc[ai][bj][m][1]); }
                } else if (wc == 0 && fq < 3) {
                    EPI_LOOP_AIM { float* sp = sm + (size_t)(row0 + ai * 128 + m * 16) * 32 + 8 * fq; *(f32x4*)sp = acc[ai][bj][m][0]; *(f32x4*)(sp + 4) = acc[ai][bj][m][1]; }
                }
            }
        }
    }
};
struct EpiH1 {
    static constexpr bool PERM = true;
    bf16_t* h1; const float* cbias;
    __device__ __forceinline__ void operator()(const Acc& acc, const Unit& u, int wr, int wc, int fr, int fq) const {
        const int which = u.aux, rl0 = wr * 64 + fr;
        bf16_t* base = h1 + ((size_t)which * BC * 256 + (size_t)u.pm * 256) * 256;
        const float* bp = cbias + which * 256;
#pragma unroll
        for (int bj = 0; bj < 2; ++bj) { const int col = bj * 128 + wc * 32 + 8 * fq; const f32x4 b0 = *(const f32x4*)(bp + col), b1 = *(const f32x4*)(bp + col + 4);
            EPI_LOOP_AIM { const int rl = rl0 + ai * 128 + m * 16; f32x4 v0 = acc[ai][bj][m][0] + b0, v1 = acc[ai][bj][m][1] + b1;
#pragma unroll
                for (int e = 0; e < 4; ++e) { v0[e] = (rl < 255) ? siluf_(v0[e]) : 0.f; v1[e] = (rl < 255) ? siluf_(v1[e]) : 0.f; }
                *(u32x4*)(base + (size_t)rl * 256 + col) = pack8(v0, v1); } }
    }
};
struct EpiCmp2 {
    static constexpr bool PERM = true;
    bf16_t* kc;
    __device__ __forceinline__ void operator()(const Acc& acc, const Unit& u, int wr, int wc, int fr, int fq) const {
        if (wc >= 2) return;
        const int col = wc * 32 + 8 * fq; bf16_t* base = kc + ((size_t)u.aux * BC + u.pm) * 256 * 64 + col;
        EPI_LOOP_AIM { const int rl = wr * 64 + fr + ai * 128 + m * 16; *(u32x4*)(base + (size_t)rl * 64) = pack8(acc[ai][0][m][0], acc[ai][0][m][1]); }
    }
};
struct EpiP {
    static constexpr bool PERM = true;
    __device__ __forceinline__ void operator()(const Acc& acc, const Unit& u, int wr, int wc, int fr, int fq) const {
        bf16_t* P = (bf16_t*)(ws_late() + WS_R + R_P);
        const int i = u.pn >> 2, pt = u.pn & 3, row0 = u.pm * 256 + wr * 64 + fr;
#pragma unroll
        for (int bj = 0; bj < 2; ++bj)
#pragma unroll
            for (int n = 0; n < 2; ++n) {
                const int png = 4 * pt + 2 * bj + (wc >> 1), wcg = 2 * (wc & 1) + (fq >> 1), fqg = 2 * (fq & 1) + n;
                const int vcol = 256 * png + 128 * (i >> 1) + 32 * wcg + 8 * fqg + 4 * (i & 1);
                EPI_LOOP_AIM { const f32x4 v = acc[ai][bj][m][n]; u32x2 w; w.x = pk2(v[0], v[1]); w.y = pk2(v[2], v[3]);
                    *(u32x2*)(P + (unsigned)((row0 + ai * 128 + m * 16) * 4096 + vcol)) = w; }
            }
    }
};
struct EpiGate {
    static constexpr bool PERM = true;
    __device__ __forceinline__ void operator()(const Acc& acc, const Unit& u, int wr, int wc, int fr, int fq) const {
        unsigned char* ws = ws_late(); const bf16_t* P = (const bf16_t*)(ws + WS_R + R_P); bf16_t* y = (bf16_t*)(ws + WS_R + R_Y);
        const int row0 = u.pm * 256 + wr * 64 + fr, vc = 256 * u.pn + 32 * wc + 8 * fq, oc = 64 * u.pn + 16 * wc + 4 * fq;
        u32x4 pw[2][4][2];
        EPI_LOOP_AIM { const unsigned r = (unsigned)(row0 + ai * 128 + m * 16);
#pragma unroll
            for (int bj = 0; bj < 2; ++bj) pw[ai][m][bj] = *(const u32x4*)(P + (r * 4096u + (unsigned)(vc + 128 * bj))); }
        EPI_LOOP_AIM { const unsigned r = (unsigned)(row0 + ai * 128 + m * 16);
            f32x4 s = {0.f, 0.f, 0.f, 0.f};
#pragma unroll
            for (int bj = 0; bj < 2; ++bj) { const u32x4 pq = pw[ai][m][bj];
#pragma unroll
                for (int n = 0; n < 2; ++n) { const unsigned w0 = n ? pq.z : pq.x, w1 = n ? pq.w : pq.y; const f32x4 a = acc[ai][bj][m][n];
                    s[0] += sigmoidf_(a[0]) * __uint_as_float(w0 << 16); s[1] += sigmoidf_(a[1]) * __uint_as_float(w0 & 0xffff0000u);
                    s[2] += sigmoidf_(a[2]) * __uint_as_float(w1 << 16); s[3] += sigmoidf_(a[3]) * __uint_as_float(w1 & 0xffff0000u); } }
            u32x2 w; w.x = pk2(s[0], s[1]); w.y = pk2(s[2], s[3]); *(u32x2*)(y + (r * 1024u + (unsigned)oc)) = w; }
    }
};
struct EpiOut {
    static constexpr bool PERM = true;
    int row_base;
    __device__ __forceinline__ void operator()(const Acc& acc, const Unit& u, int wr, int wc, int fr, int fq) const {
        bf16_t* T = (bf16_t*)(ws_late() + WS_T);
        const int rg0 = row_base + u.pm * 256 + wr * 64 + fr, col0 = u.pn * 256 + wc * 32 + 8 * fq;
        EPI_LOOP_AIM { bf16_t* rp = T + (size_t)(rg0 + ai * 128 + m * 16) * 1024 + col0;
#pragma unroll
            for (int bj = 0; bj < 2; ++bj) *(u32x4*)(rp + bj * 128) = pack8(acc[ai][bj][m][0], acc[ai][bj][m][1]); }
    }
};
struct EpiMoe1 {
    static constexpr bool PERM = true;
    __device__ __forceinline__ void operator()(const Acc& acc, const Unit& u, int wr, int wc, int fr, int fq) const {
        const int rl0 = wr * 64 + fr, f0 = 128 * u.pn + 32 * wc + 8 * fq;
        bf16_t* hid = (bf16_t*)(ws_late() + WS_R + R_HID);
        EPI_LOOP_AIM { const int rl = rl0 + ai * 128 + m * 16;
            f32x4 a0 = acc[ai][0][m][0], a1 = acc[ai][0][m][1]; const f32x4 b0 = acc[ai][1][m][0], b1 = acc[ai][1][m][1];
#pragma unroll
            for (int e = 0; e < 4; ++e) { a0[e] = siluf_(a0[e]) * b0[e]; a1[e] = siluf_(a1[e]) * b1[e]; }
            *(u32x4*)(hid + (unsigned)((u.pm * 256 + rl) * 512 + f0)) = pack8(a0, a1); __builtin_amdgcn_sched_barrier(0); }
    }
};
struct EpiMoe2 {
    static constexpr bool PERM = true;
    __device__ __forceinline__ void operator()(const Acc& acc, const Unit& u, int wr, int wc, int fr, int fq) const {
        unsigned char* ws = ws_late(); bf16_t* out2 = (bf16_t*)(ws + WS_R + R_OUT2);
        const float* cwb = (const float*)(ws + (R_CW - R_LIST) + u.rows); const int* rws = (const int*)(ws + u.rows);
        const int rl0 = wr * 64 + fr, c0 = 256 * u.pn + 32 * wc + 8 * fq;
        EPI_LOOP_AIM { const int rl = rl0 + ai * 128 + m * 16;
            if (rl < u.nvalid) { const unsigned v = (unsigned)rws[rl]; const float wgt = cwb[rl]; bf16_t* rp = out2 + (size_t)v * 1024 + c0;
#pragma unroll
                for (int bj = 0; bj < 2; ++bj) *(u32x4*)(rp + bj * 128) = pack8(acc[ai][bj][m][0] * wgt, acc[ai][bj][m][1] * wgt); } }
    }
};

enum { IN_X = 0, IN_C, IN_POS, IN_ADAW, IN_ADAB, IN_WIN, IN_CONVW, IN_ALOG, IN_DTB, IN_GNORM, IN_RETGN, IN_PE, IN_CKW1, IN_CKW2, IN_CVW1, IN_CVW2, IN_FBIAS,
       IN_BP, IN_WG, IN_WO, IN_LNG, IN_LNB, IN_RW, IN_RB, IN_EW1, IN_EW3, IN_EW2 };

__device__ __forceinline__ void p0_ada(const Params& p, int item, LAS float* lf, const int tid) {
    LAS float* sc = lf; LAS float* red = lf + 16384;
    const float* c = PIN(IN_C);
    for (int i = tid; i < 16384; i += NTHR) sc[i] = siluf_(c[i]);
    __syncthreads();
    const int ls = item / 48, cb = item % 48, col = cb * 64 + (tid & 63), ks = tid >> 6;
    const float* w = PIN(IN_ADAW) + (size_t)ls * 1024 * 3072 + col;
    float acc[16];
#pragma unroll
    for (int b = 0; b < 16; ++b) acc[b] = 0.f;
    for (int k = ks * 128; k < ks * 128 + 128; ++k) { const float wv = w[(size_t)k * 3072];
#pragma unroll
        for (int b = 0; b < 16; ++b) acc[b] += sc[b * 1024 + k] * wv; }
#pragma unroll
    for (int b = 0; b < 16; ++b) red[(ks * 16 + b) * 64 + (tid & 63)] = acc[b];
    __syncthreads();
    float* mod = (float*)(p.ws + WS_MOD);
    for (int o = tid; o < 1024; o += NTHR) { const int b = o >> 6, cc = o & 63; float s = 0.f;
#pragma unroll
        for (int q = 0; q < 8; ++q) s += red[(q * 16 + b) * 64 + cc];
        mod[((size_t)ls * 16 + b) * 3072 + cb * 64 + cc] = s + PIN(IN_ADAB)[ls * 3072 + cb * 64 + cc]; }
    __syncthreads();
}
__device__ __forceinline__ void p0_rope(const Params& p, int item, const int tid) {
    const int* pos = (const int*)PIN(IN_POS); f32x2* tab = (f32x2*)(p.ws + WS_ROPE);
#pragma unroll
    for (int j = 0; j < 8; ++j) { const int idx = item * 4096 + j * 512 + tid; const int m = idx >> 5, i = idx & 31;
        const float inv = powf(10000.0f, -(float)i / 32.0f); const float ang = (float)pos[m] * inv;
        const float n = rintf(ang * 0.6366197723675814f);
        float r = fmaf(n, -1.5703125f, ang); r = fmaf(n, -4.837512969970703125e-4f, r); r = fmaf(n, -7.54978995489188e-8f, r);
        const float s = sinf(r), cs = cosf(r); const int q = ((int)n) & 3;
        float so, co; if (q == 0) { so = s; co = cs; } else if (q == 1) { so = cs; co = -s; } else if (q == 2) { so = -s; co = -cs; } else { so = -cs; co = s; }
        tab[idx] = (f32x2){co, so}; }
}
__device__ __forceinline__ void p0_cbias(const Params& p, int item, const int tid) {
    const int l = item >> 1, which = item & 1;
    if (tid < 256) { const float* pe = PIN(IN_PE) + (size_t)l * 2048; const float* w1 = PIN(which ? IN_CVW1 : IN_CKW1) + (size_t)l * 2048 * 256 + tid;
        float s = 0.f; for (int k = 0; k < 2048; ++k) s += pe[k] * w1[(size_t)k * 256];
        ((float*)(p.ws + WS_CBIAS))[item * 256 + tid] = s; }
}
struct TJob { bf16_t* dst; int K, nrt, nkt; };
constexpr int TJ_TILES[8] = {56 * 16, 64 * 16, 64 * 4, 16 * 16, 256 * 16, 256 * 8, 8 * 32, 8 * 4};
constexpr int TJ_TOTAL = 56 * 16 + 64 * 16 + 64 * 4 + 16 * 16 + 256 * 16 + 256 * 8 + 8 * 32 + 8 * 4;
__device__ __forceinline__ int win_src_col(int pc) {
    if (pc < 768) return pc;
    if (pc < 1024) return pc - 768 + 776;
    if (pc < 2048) return pc - 1024 + 1032;
    if (pc < 2304) return pc - 2048 + 2056;
    if (pc < 3072) return pc - 2304 + 2708;
    if (pc < 3456) return pc - 3072 + 2312;
    if (pc < 3464) return pc - 3456 + 768;
    if (pc < 3476) return pc - 3464 + 2696;
    if (pc < 3480) return pc - 3476 + 3476;
    return -1;
}
__device__ __forceinline__ const float* tj_src(const Params& p, int l, int job, int n, int& pitch) {
    switch (job) {
    case 0: { pitch = 3480; const int c = win_src_col(n); return c < 0 ? nullptr : PIN(IN_WIN) + (size_t)l * 1024 * 3480 + c; }
    case 1: { pitch = 1024; const int i = 2 * ((n >> 7) & 1) + ((n >> 2) & 1), c = 64 * (n >> 8) + 16 * ((n >> 5) & 3) + 4 * ((n >> 3) & 3) + (n & 3);
              return PIN(IN_WG) + ((size_t)l * 4 + i) * 1024 * 1024 + c; }
    case 2: { pitch = 1024; const int i = n >> 10, c = n & 1023; return PIN(IN_BP) + ((size_t)l * 4 + i) * 256 * 1024 + c; }
    case 3: { pitch = 1024; return PIN(IN_WO) + (size_t)l * 1024 * 1024 + n; }
    case 4: { pitch = 512; const int e = n >> 10, vr = n & 1023, f = 128 * (vr >> 8) + (vr & 127); return PIN(((vr >> 7) & 1) ? IN_EW3 : IN_EW1) + ((size_t)l * 16 + e) * 1024 * 512 + f; }
    case 5: { pitch = 1024; const int e = n >> 10, c = n & 1023; return PIN(IN_EW2) + ((size_t)l * 16 + e) * 512 * 1024 + c; }
    case 6: { pitch = 256; const int which = n >> 8, c = n & 255; return PIN(which ? IN_CVW1 : IN_CKW1) + (size_t)l * 2048 * 256 + c; }
    default: { pitch = 64; const int which = n >> 8, r = n & 255; return r < 64 ? PIN(which ? IN_CVW2 : IN_CKW2) + (size_t)l * 256 * 64 + r : nullptr; }
    }
}
__device__ __forceinline__ void p0_transpose(const Params& p, int item, LAS float* tile, const int tid) {
    const int l = item / TJ_TOTAL; int t = item % TJ_TOTAL, job = 0;
#pragma unroll
    for (int j = 0; j < 8; ++j) { if (job == j && t >= TJ_TILES[j]) { t -= TJ_TILES[j]; job = j + 1; } }
    const size_t lw = WS_W + (size_t)l * ((LW_BYTES + MiB - 1) / MiB) * MiB;
    const size_t offs[8] = {LW_WIN, LW_WGV, LW_BPT, LW_WOT, LW_W13, LW_W2, LW_CW1, LW_CW2};
    const int Ks[8] = {1024, 1024, 256, 1024, 1024, 512, 2048, 256};
    size_t off = 0; int K = 0;
#pragma unroll
    for (int j = 0; j < 8; ++j) if (job == j) { off = offs[j]; K = Ks[j]; }
    bf16_t* dst = (bf16_t*)(p.ws + lw + off);
    const int nkt = K / 64, rt = t / nkt, kt = t % nkt;
    { const int tx = tid & 63, ty = tid >> 6; int pitch; const float* src = tj_src(p, l, job, rt * 64 + tx, pitch);
#pragma unroll
      for (int kk = 0; kk < 8; ++kk) { const int k = ty + 8 * kk; tile[k * 65 + tx] = src ? src[(size_t)(kt * 64 + k) * pitch] : 0.f; } }
    __syncthreads();
    { const int r = tid >> 3, sg = tid & 7; f32x4 a, b;
#pragma unroll
      for (int j = 0; j < 4; ++j) { a[j] = tile[(sg * 8 + j) * 65 + r]; b[j] = tile[(sg * 8 + 4 + j) * 65 + r]; }
      *(u32x4*)(dst + (size_t)(rt * 64 + r) * K + kt * 64 + sg * 8) = pack8(a, b); }
    __syncthreads();
}

struct RowV { f32x4 v[4]; };
__device__ __forceinline__ void row_load(RowV& r, const float* src, int lane) {
#pragma unroll
    for (int j = 0; j < 4; ++j) r.v[j] = *(const f32x4*)(src + 4 * lane + 256 * j);
}
__device__ __forceinline__ void row_stats(const RowV& r, float& mean, float& rstd) {
    float s = 0.f;
#pragma unroll
    for (int j = 0; j < 4; ++j) s += (r.v[j][0] + r.v[j][1]) + (r.v[j][2] + r.v[j][3]);
    mean = wave_sum(s) * (1.0f / 1024.0f);
    float q = 0.f;
#pragma unroll
    for (int j = 0; j < 4; ++j) { const f32x4 d = r.v[j] - mean; q += (d[0] * d[0] + d[1] * d[1]) + (d[2] * d[2] + d[3] * d[3]); }
    rstd = 1.0f / sqrtf(wave_sum(q) * (1.0f / 1024.0f) + LN_EPS);
}
__device__ __forceinline__ void row_ln(RowV& r, float mean, float rstd, const float* g, const float* b, int lane) {
#pragma unroll
    for (int j = 0; j < 4; ++j) { const f32x4 gg = *(const f32x4*)(g + 4 * lane + 256 * j), bb = *(const f32x4*)(b + 4 * lane + 256 * j); r.v[j] = (r.v[j] - mean) * rstd * gg + bb; }
}
__device__ __forceinline__ void row_mod(RowV& h, const RowV& x, const float* mod, int lane) {
#pragma unroll
    for (int j = 0; j < 4; ++j) { const f32x4 sh = *(const f32x4*)(mod + 4 * lane + 256 * j), sc = *(const f32x4*)(mod + 1024 + 4 * lane + 256 * j); h.v[j] = x.v[j] * (sc + 1.0f) + sh; }
}
__device__ __forceinline__ void row_store_bf16(const RowV& h, bf16_t* dst, int lane) {
#pragma unroll
    for (int j = 0; j < 4; ++j) { u32x2 w; w.x = pk2(h.v[j][0], h.v[j][1]); w.y = pk2(h.v[j][2], h.v[j][3]); *(u32x2*)(dst + 4 * lane + 256 * j) = w; }
}
__device__ __forceinline__ void prep_first(const Params& p, const int tid, const int blk) {
    const int lane = tid & 63, wv = tid >> 6; const float* x = p.in[IN_X]; bf16_t* H = (bf16_t*)(p.ws + WS_H); const float* mod = (const float*)(p.ws + WS_MOD);
    for (int row = blk * 8 + wv; row < MTOK; row += NWG * 8) {
        RowV r, h; row_load(r, x + (size_t)row * 1024, lane); row_mod(h, r, mod + (size_t)(row >> 12) * 3072, lane); row_store_bf16(h, H + (size_t)row * 1024, lane); }
}
__device__ __forceinline__ void row_load_t(u32x2 (&t)[4], const bf16_t* src, int lane) {
#pragma unroll
    for (int j = 0; j < 4; ++j) t[j] = *(const u32x2*)(src + 4 * lane + 256 * j);
}
__device__ __forceinline__ void prep_moe(const Params& p, int l, LAS float* rwl, const int tid, const int blk) {
    const int lane = tid & 63, wv = tid >> 6;
    { const float* rw = p.in[IN_RW]; for (int i = tid; i < 16384; i += NTHR) rwl[i] = rw[i]; }
    __syncthreads();
    const float* xin = (l == 0) ? p.in[IN_X] : p.out; float* z = p.out; bf16_t* H = (bf16_t*)(p.ws + WS_H); const bf16_t* T = (const bf16_t*)(p.ws + WS_T);
    const float* modg = (const float*)(p.ws + WS_MOD) + (size_t)(l * 2) * 16 * 3072; const float* mod = (const float*)(p.ws + WS_MOD) + (size_t)(l * 2 + 1) * 16 * 3072;
    f32x2* stats = (f32x2*)(p.ws + WS_STATS); const float* g = p.in[IN_LNG] + (size_t)(l * 2) * 1024; const float* bb = p.in[IN_LNB] + (size_t)(l * 2) * 1024;
    const float* gp = p.in[IN_LNG] + (size_t)((l > 0 ? l - 1 : 0) * 2 + 1) * 1024; const float* bp = p.in[IN_LNB] + (size_t)((l > 0 ? l - 1 : 0) * 2 + 1) * 1024;
    unsigned* cnt = (unsigned*)(p.ws + WS_CTL) + CW_CNT + l * 64; int* list = (int*)(p.ws + WS_R + R_LIST); float* cw = (float*)(p.ws + WS_R + R_CW);
    const float* rb = p.in[IN_RB];
    int row = blk * 8 + wv;
    RowV cur; u32x2 tc[4]; row_load(cur, xin + (size_t)row * 1024, lane); row_load_t(tc, T + (size_t)row * 1024, lane);
    for (; row < MTOK; row += NWG * 8) {
        const int nrow = row + NWG * 8; RowV nx; u32x2 tn[4];
        if (nrow < MTOK) { row_load(nx, xin + (size_t)nrow * 1024, lane); row_load_t(tn, T + (size_t)nrow * 1024, lane); }
        RowV r = cur, h;
        if (l > 0) { const f32x2 st = stats[row]; row_ln(r, st.x, st.y, gp, bp, lane); }
        { const float* gate = modg + (size_t)(row >> 12) * 3072 + 2048;
#pragma unroll
          for (int j = 0; j < 4; ++j) { const f32x4 gt = *(const f32x4*)(gate + 4 * lane + 256 * j);
              f32x4 y; y[0] = __uint_as_float(tc[j].x << 16); y[1] = __uint_as_float(tc[j].x & 0xffff0000u); y[2] = __uint_as_float(tc[j].y << 16); y[3] = __uint_as_float(tc[j].y & 0xffff0000u);
              r.v[j] = r.v[j] * DN_ALPHA + gt * y; *(f32x4*)(z + (size_t)row * 1024 + 4 * lane + 256 * j) = r.v[j]; } }
        float mean, rstd; row_stats(r, mean, rstd); if (lane == 0) stats[row] = (f32x2){mean, rstd};
        row_ln(r, mean, rstd, g, bb, lane); row_mod(h, r, mod + (size_t)(row >> 12) * 3072, lane); row_store_bf16(h, H + (size_t)row * 1024, lane);
        float a[16];
#pragma unroll
        for (int e = 0; e < 16; ++e) a[e] = 0.f;
#pragma unroll
        for (int j = 0; j < 4; ++j)
#pragma unroll
            for (int q = 0; q < 4; ++q) { const float hv = h.v[j][q]; const LAS float* wp = rwl + (4 * lane + 256 * j + q) * 16;
                const f32x4 w0 = *(const LAS f32x4*)wp, w1 = *(const LAS f32x4*)(wp + 4), w2 = *(const LAS f32x4*)(wp + 8), w3 = *(const LAS f32x4*)(wp + 12);
#pragma unroll
                for (int e = 0; e < 4; ++e) { a[e] += hv * w0[e]; a[4 + e] += hv * w1[e]; a[8 + e] += hv * w2[e]; a[12 + e] += hv * w3[e]; }
                __builtin_amdgcn_sched_barrier(0); }
#pragma unroll
        for (int e = 0; e < 16; ++e) a[e] = wave_sum(a[e]);
        float sc[16], bi[16];
#pragma unroll
        for (int e = 0; e < 16; ++e) { sc[e] = sigmoidf_(a[e]); bi[e] = sc[e] + rb[e]; }
        int grp = 0; float best = -INFINITY;
#pragma unroll
        for (int gI = 0; gI < 4; ++gI) { float m1 = -INFINITY, m2 = -INFINITY;
#pragma unroll
            for (int q = 0; q < 4; ++q) { const float v = bi[4 * gI + q]; if (v > m1) { m2 = m1; m1 = v; } else if (v > m2) m2 = v; }
            const float gs = m1 + m2; if (gs > best) { best = gs; grp = gI; } }
        int e0 = 0, e1 = 0; float b0 = -INFINITY, b1 = -INFINITY, s0 = 0.f, s1 = 0.f;
#pragma unroll
        for (int gI = 0; gI < 4; ++gI)
#pragma unroll
            for (int q = 0; q < 4; ++q) { const int e = 4 * gI + q; if (gI == grp) { const float v = bi[e];
                if (v > b0) { b1 = b0; e1 = e0; s1 = s0; b0 = v; e0 = e; s0 = sc[e]; } else if (v > b1) { b1 = v; e1 = e; s1 = sc[e]; } } }
        const float inv = 1.0f / (s0 + s1);
        if (lane == 0) { const unsigned q0 = atomicAdd(cnt + e0, 1u), q1 = atomicAdd(cnt + e1, 1u);
                         list[(size_t)e0 * MTOK + q0] = row * 2; cw[(size_t)e0 * MTOK + q0] = s0 * inv;
                         list[(size_t)e1 * MTOK + q1] = row * 2 + 1; cw[(size_t)e1 * MTOK + q1] = s1 * inv; }
        cur = nx;
#pragma unroll
        for (int j = 0; j < 4; ++j) tc[j] = tn[j];
    }
}
__device__ __forceinline__ void prep_next(const Params& p, int l, bool final_, const int tid, const int blk) {
    const int lane = tid & 63, wv = tid >> 6;
    float* z = p.out; bf16_t* H = (bf16_t*)(p.ws + WS_H); const float* modm = (const float*)(p.ws + WS_MOD) + (size_t)(l * 2 + 1) * 16 * 3072;
    const float* modn = (const float*)(p.ws + WS_MOD) + (size_t)((l + 1) * 2) * 16 * 3072;
    f32x2* stats = (f32x2*)(p.ws + WS_STATS);
    const float* g0 = p.in[IN_LNG] + (size_t)(l * 2) * 1024; const float* b0 = p.in[IN_LNB] + (size_t)(l * 2) * 1024;
    const float* g1 = p.in[IN_LNG] + (size_t)(l * 2 + 1) * 1024; const float* b1 = p.in[IN_LNB] + (size_t)(l * 2 + 1) * 1024;
    const bf16_t* out2 = (const bf16_t*)(p.ws + WS_R + R_OUT2);
    int row = blk * 8 + wv;
    RowV cur; u32x2 ta[4], tb[4]; row_load(cur, z + (size_t)row * 1024, lane); row_load_t(ta, out2 + (size_t)(row * 2) * 1024, lane); row_load_t(tb, out2 + (size_t)(row * 2 + 1) * 1024, lane);
    for (; row < MTOK; row += NWG * 8) {
        const int nrow = row + NWG * 8; RowV nx; u32x2 na[4], nb[4];
        if (nrow < MTOK) { row_load(nx, z + (size_t)nrow * 1024, lane); row_load_t(na, out2 + (size_t)(nrow * 2) * 1024, lane); row_load_t(nb, out2 + (size_t)(nrow * 2 + 1) * 1024, lane); }
        RowV r = cur;
        const f32x2 st = stats[row]; row_ln(r, st.x, st.y, g0, b0, lane);
        const float* gate = modm + (size_t)(row >> 12) * 3072 + 2048;
#pragma unroll
        for (int j = 0; j < 4; ++j) { const u32x2 oa = ta[j], ob = tb[j];
            const f32x4 gt = *(const f32x4*)(gate + 4 * lane + 256 * j);
            f32x4 y; y[0] = __uint_as_float(oa.x << 16) + __uint_as_float(ob.x << 16); y[1] = __uint_as_float(oa.x & 0xffff0000u) + __uint_as_float(ob.x & 0xffff0000u);
            y[2] = __uint_as_float(oa.y << 16) + __uint_as_float(ob.y << 16); y[3] = __uint_as_float(oa.y & 0xffff0000u) + __uint_as_float(ob.y & 0xffff0000u);
            r.v[j] = r.v[j] * DN_ALPHA + gt * y; }
        cur = nx;
#pragma unroll
        for (int j = 0; j < 4; ++j) { ta[j] = na[j]; tb[j] = nb[j]; }
        float mean, rstd; row_stats(r, mean, rstd);
        if (final_) { row_ln(r, mean, rstd, g1, b1, lane);
#pragma unroll
            for (int j = 0; j < 4; ++j) *(f32x4*)(z + (size_t)row * 1024 + 4 * lane + 256 * j) = r.v[j];
        } else {
#pragma unroll
            for (int j = 0; j < 4; ++j) *(f32x4*)(z + (size_t)row * 1024 + 4 * lane + 256 * j) = r.v[j];
            if (lane == 0) stats[row] = (f32x2){mean, rstd};
            RowV h; row_ln(r, mean, rstd, g1, b1, lane); row_mod(h, r, modn + (size_t)(row >> 12) * 3072, lane); row_store_bf16(h, H + (size_t)row * 1024, lane); }
    }
}

__device__ __forceinline__ int q_next(unsigned* ctr, volatile LAS int* slot, const int tid) {
    __syncthreads();
    if (tid == 0) *slot = (int)__hip_atomic_fetch_add(ctr, 1u, __ATOMIC_RELAXED, __HIP_MEMORY_SCOPE_AGENT);
    __syncthreads();
    return *slot;
}

__device__ __forceinline__ void gdn_prep_unit(const Params& p, int l, int unit, LAS unsigned char* lds, const int tid_in_) {
    int tid = tid_in_; asm volatile("" : "+v"(tid)); unsigned char* wsl_ = ws_late();
    const int lane = tid & 63;
    const int n = unit & 63, h = (unit >> 6) & 3, bl = unit >> 8;
    const int tok0 = bl * SEQ + n * 64;
    const bf16_t* proj = (const bf16_t*)(wsl_ + WS_R + R_PROJ); const float* sm = (const float*)(wsl_ + WS_R + R_SM);
    LAS bf16_t* raw = (LAS bf16_t*)lds;
    LAS float* qs = (LAS float*)(lds + 26112); LAS float* ks = qs + 64 * 65; LAS float* vs = ks + 64 * 65;
    LAS float* Lm = vs + 64 * 65;
    LAS float* bc = Lm + 4096; LAS float* eb = bc + 64; LAS float* be = eb + 64; LAS float* cwt = be + 64;
    __syncthreads();
    for (int idx = tid; idx < 67 * 24; idx += NTHR) { const int row = idx / 24, ch = idx % 24, seg = ch >> 3, c8 = ch & 7;
        u32x4 v = {0u, 0u, 0u, 0u};
        if (n > 0 || row >= 3) v = *(const u32x4*)(proj + (size_t)(tok0 + row - 3) * PROJW + seg * 256 + h * 64 + c8 * 8);
        *(LAS u32x4*)(raw + row * 192 + seg * 64 + c8 * 8) = v; }
    for (int idx = tid; idx < 768; idx += NTHR) { const int k = idx / 192, ch = idx % 192; cwt[idx] = PIN(IN_CONVW)[(size_t)l * 4 * 768 + k * 768 + (ch >> 6) * 256 + h * 64 + (ch & 63)]; }
    __syncthreads();
    for (int idx = tid; idx < 64 * 192; idx += NTHR) { const int t = idx / 192, ch = idx % 192; float s = 0.f;
#pragma unroll
        for (int k = 0; k < 4; ++k) s += cwt[k * 192 + ch] * bf2f(raw[(t + k) * 192 + ch]);
        s = siluf_(s); const int seg = ch >> 6, d = ch & 63; (seg == 0 ? qs : seg == 1 ? ks : vs)[t * 65 + d] = s; }
    __syncthreads();
    LAS unsigned char* qb = lds + 129024; LAS unsigned char* kb = qb + 8192; LAS float* Rs = (LAS float*)(kb + 8192);
    {
        const int mat = tid >> 8, row = (tid >> 2) & 63, q4 = tid & 3; LAS float* mt = mat ? ks : qs; float x[16], ss = 0.f;
#pragma unroll
        for (int d = 0; d < 16; ++d) { x[d] = mt[row * 65 + 16 * q4 + d]; ss += x[d] * x[d]; }
        ss += __shfl_xor(ss, 1); ss += __shfl_xor(ss, 2);
        const float sc = (1.0f / sqrtf(ss + 1e-6f)) * (mat ? 1.0f : 0.125f);
#pragma unroll
        for (int d = 0; d < 16; ++d) { x[d] *= sc; mt[row * 65 + 16 * q4 + d] = x[d]; }
        LAS unsigned char* ob = (mat ? kb : qb) + (2 * q4) * 1024 + row * 16;
        u32x4 w0, w1; w0.x = pk2(x[0], x[1]); w0.y = pk2(x[2], x[3]); w0.z = pk2(x[4], x[5]); w0.w = pk2(x[6], x[7]); w1.x = pk2(x[8], x[9]); w1.y = pk2(x[10], x[11]); w1.z = pk2(x[12], x[13]); w1.w = pk2(x[14], x[15]);
        *(LAS u32x4*)ob = w0; *(LAS u32x4*)(ob + 1024) = w1;
    }
    if (tid < 64) { const int i = tid;
        const float a = sm[(size_t)(tok0 + i) * 32 + h], bg = sm[(size_t)(tok0 + i) * 32 + 4 + h];
        const float x = a + PIN(IN_DTB)[l * 4 + h]; const float sp = fmaxf(x, 0.f) + log1pf(__expf(-fabsf(x)));
        float la = -__expf(PIN(IN_ALOG)[l * 4 + h]) * sp;
#pragma unroll
        for (int o = 1; o < 64; o <<= 1) { const float v = __shfl_up(la, o); if (lane >= o) la += v; }
        bc[i] = la; eb[i] = __expf(la); be[i] = sigmoidf_(bg); }
    __syncthreads();
    const size_t ub = WS_R + R_GDN + (size_t)unit * GDN_UNIT_BYTES;
    bf16_t* gW = (bf16_t*)(wsl_ + ub); bf16_t* gATT = gW + 4096; bf16_t* gQD = gW + 8192; bf16_t* gKDT = gW + 12288; bf16_t* gU0 = gW + 16384;
    {
        const int wid = tid >> 6, r32 = lane & 31, hi = lane >> 5, isq = wid >> 2, it = (wid >> 1) & 1, jt = wid & 1;
        const LAS unsigned char* ab = (isq ? qb : kb) + hi * 1024 + (32 * it + r32) * 16; const LAS unsigned char* bb = kb + hi * 1024 + (32 * jt + r32) * 16;
        f32x16 acc = (f32x16){};
#pragma unroll
        for (int d0 = 0; d0 < 4; ++d0) acc = MF32(*(const LAS bf16x8*)(ab + d0 * 2048), *(const LAS bf16x8*)(bb + d0 * 2048), acc);
        const int j = 32 * jt + r32; const float bj = bc[j];
#pragma unroll
        for (int g = 0; g < 4; ++g) { f32x4 lv;
#pragma unroll
            for (int e = 0; e < 4; ++e) { const int i = 32 * it + 8 * g + 4 * hi + e; const float dc = __expf(bc[i] - bj), v = acc[4 * g + e] * dc;
                if (isq) gATT[i * 64 + j] = f2bf((j <= i) ? v : 0.f); else lv[e] = (j < i) ? be[i] * v : 0.f; }
            if (!isq) *(LAS f32x4*)(Lm + j * 64 + 32 * it + 8 * g + 4 * hi) = lv; }
    }
    __syncthreads();
    {
        const int c = tid & 127, cc = c & 63, rg = tid >> 7; const bool isw = c >= 64; LAS float* Xs = cwt + 768;
        for (int I = 0; I < 4; ++I) {
            float r[4];
#pragma unroll
            for (int e = 0; e < 4; ++e) { const int i = 16 * I + 4 * rg + e; r[e] = isw ? be[i] * eb[i] * ks[i * 65 + cc] : be[i] * vs[i * 65 + cc]; }
#pragma unroll 4
            for (int j = 0; j < 16 * I; ++j) { const float xj = Xs[j * 128 + c]; const f32x4 l4 = *(const LAS f32x4*)(Lm + j * 64 + 16 * I + 4 * rg);
#pragma unroll
                for (int e = 0; e < 4; ++e) r[e] -= l4[e] * xj; }
#pragma unroll
            for (int e = 0; e < 4; ++e) Rs[(4 * rg + e) * 128 + c] = r[e];
            __syncthreads();
            if (tid < 128) { float q[16];
#pragma unroll
                for (int ii = 0; ii < 16; ++ii) q[ii] = Rs[ii * 128 + c];
#pragma unroll
                for (int ii = 1; ii < 16; ++ii)
#pragma unroll
                    for (int jj = 0; jj < ii; ++jj) q[ii] -= Lm[(16 * I + jj) * 64 + 16 * I + ii] * q[jj];
#pragma unroll
                for (int ii = 0; ii < 16; ++ii) { Xs[(16 * I + ii) * 128 + c] = q[ii]; (isw ? gW : gU0)[(16 * I + ii) * 64 + cc] = f2bf(q[ii]); }
            } else if (I == 0) {
                const float bl_ = bc[63];
                for (int task = tid - 128; task < 1024; task += 384) {
                    if (task < 512) { const int c2 = task >> 3, sg = task & 7; const float e = eb[c2]; float v[8];
#pragma unroll
                        for (int j = 0; j < 8; ++j) v[j] = qs[c2 * 65 + sg * 8 + j] * e;
                        u32x4 w; w.x = pk2(v[0], v[1]); w.y = pk2(v[2], v[3]); w.z = pk2(v[4], v[5]); w.w = pk2(v[6], v[7]); *(u32x4*)(gQD + c2 * 64 + sg * 8) = w;
                    } else { const int k = (task - 512) >> 3, sg = task & 7; float v[8];
#pragma unroll
                        for (int j = 0; j < 8; ++j) { const int c2 = sg * 8 + j; v[j] = ks[c2 * 65 + k] * __expf(bl_ - bc[c2]); }
                        u32x4 w; w.x = pk2(v[0], v[1]); w.y = pk2(v[2], v[3]); w.z = pk2(v[4], v[5]); w.w = pk2(v[6], v[7]); *(u32x4*)(gKDT + k * 64 + sg * 8) = w; }
                }
                if (tid == 128) ((float*)(wsl_ + WS_R + R_GG))[unit] = __expf(bl_);
            }
            __syncthreads();
        }
    }
}

__device__ __forceinline__ bf16x8 afrag_perm(const LAS unsigned char* M, int row, int ks, int hi) {
    const LAS unsigned char* q = M + row * 144 + (16 * ks + 4 * hi) * 2;
    const s16x4 lo = *(const LAS s16x4*)q, hi4 = *(const LAS s16x4*)(q + 16);
    return (bf16x8){lo[0], lo[1], lo[2], lo[3], hi4[0], hi4[1], hi4[2], hi4[3]};
}
__device__ __forceinline__ bf16x8 pack_acc8(const f32x16& a, int s) {
    u32x4 w; w.x = pk2(a[8 * s + 0], a[8 * s + 1]); w.y = pk2(a[8 * s + 2], a[8 * s + 3]); w.z = pk2(a[8 * s + 4], a[8 * s + 5]); w.w = pk2(a[8 * s + 6], a[8 * s + 7]);
    return __builtin_bit_cast(bf16x8, w);
}
__device__ __forceinline__ void gdn_scan_item(const Params& p, int l, int chunk, int item, LAS unsigned char* lds, const int tid) {
    const int lane = tid & 63, wid = tid >> 6, vl = lane & 31, hi = lane >> 5;
    const int h = item & 3, bl = item >> 2;
    const unsigned char* ubase = p.ws + WS_R + R_GDN + (size_t)item * 64 * GDN_UNIT_BYTES;
    const float* gg = (const float*)(p.ws + WS_R + R_GG) + item * 64;
    const bf16_t* proj = (const bf16_t*)(p.ws + WS_R + R_PROJ); bf16_t* og = (bf16_t*)(p.ws + WS_R + R_O);
    const float* nw = PIN(IN_GNORM) + l * 64;
    constexpr int BUF = 5 * 9216;
    LAS unsigned char* buf0 = lds; LAS float* ob0 = (LAS float*)(lds + 2 * BUF);
    __syncthreads();
    for (int q = tid; q < 2560; q += NTHR) { const int mat = q >> 9, r = (q >> 3) & 63, sg = q & 7;
        *(LAS u32x4*)(buf0 + mat * 9216 + r * 144 + sg * 16) = *(const u32x4*)(ubase + mat * 8192 + r * 128 + sg * 16); }
    __syncthreads();
    f32x16 S[2]; S[0] = (f32x16){}; S[1] = (f32x16){};
    for (int n = 0; n < 64; ++n) {
        LAS unsigned char* bf = buf0 + (n & 1) * BUF; LAS float* ob = ob0 + (n & 1) * 4096;
        if (wid < 2) {
            const LAS unsigned char* Wm = bf; const LAS unsigned char* ATT = bf + 9216; const LAS unsigned char* QD = bf + 18432; const LAS unsigned char* KDT = bf + 27648; const LAS bf16_t* U0 = (const LAS bf16_t*)(bf + 36864);
            const float G = gg[n];
            bf16x8 Sb[4]; Sb[0] = pack_acc8(S[0], 0); Sb[1] = pack_acc8(S[0], 1); Sb[2] = pack_acc8(S[1], 0); Sb[3] = pack_acc8(S[1], 1);
            f32x16 u[2];
#pragma unroll
            for (int ct = 0; ct < 2; ++ct) { f32x16 a = (f32x16){};
#pragma unroll
                for (int ks = 0; ks < 4; ++ks) a = __builtin_amdgcn_mfma_f32_32x32x16_bf16(afrag_perm(Wm, 32 * ct + vl, ks, hi), Sb[ks], a, 0, 0, 0);
#pragma unroll
                for (int r = 0; r < 16; ++r) u[ct][r] = bf2f(U0[(32 * ct + crow(r, hi)) * 72 + 32 * wid + vl]) - a[r]; }
            bf16x8 ub[4]; ub[0] = pack_acc8(u[0], 0); ub[1] = pack_acc8(u[0], 1); ub[2] = pack_acc8(u[1], 0); ub[3] = pack_acc8(u[1], 1);
#pragma unroll
            for (int ct = 0; ct < 2; ++ct) { f32x16 a = (f32x16){};
#pragma unroll
                for (int ks = 0; ks < 4; ++ks) a = __builtin_amdgcn_mfma_f32_32x32x16_bf16(afrag_perm(QD, 32 * ct + vl, ks, hi), Sb[ks], a, 0, 0, 0);
#pragma unroll
                for (int cs = 0; cs < 4; ++cs) a = __builtin_amdgcn_mfma_f32_32x32x16_bf16(afrag_perm(ATT, 32 * ct + vl, cs, hi), ub[cs], a, 0, 0, 0);
#pragma unroll
                for (int r = 0; r < 16; ++r) ob[(32 * ct + crow(r, hi)) * 64 + 32 * wid + vl] = a[r]; }
#pragma unroll
            for (int kt = 0; kt < 2; ++kt) { f32x16 a = S[kt] * G;
#pragma unroll
                for (int cs = 0; cs < 4; ++cs) a = __builtin_amdgcn_mfma_f32_32x32x16_bf16(afrag_perm(KDT, 32 * kt + vl, cs, hi), ub[cs], a, 0, 0, 0);
                S[kt] = a; }
        } else {
            if (n + 1 < 64) { LAS unsigned char* nb = buf0 + ((n + 1) & 1) * BUF; const unsigned char* src = ubase + (size_t)(n + 1) * GDN_UNIT_BYTES;
                for (int q = tid - 128; q < 2560; q += 384) { const int mat = q >> 9, r = (q >> 3) & 63, sg = q & 7;
                    *(LAS u32x4*)(nb + mat * 9216 + r * 144 + sg * 16) = *(const u32x4*)(src + mat * 8192 + r * 128 + sg * 16); } }
        }
        if (wid >= 2 && n >= 1) { const LAS float* po = ob0 + ((n - 1) & 1) * 4096; const int tokb = bl * SEQ + (n - 1) * 64;
            for (int task = tid - 128; task < 512; task += 384) { const int c = task >> 3, sg = task & 7; float v[8], ss = 0.f;
#pragma unroll
                for (int j = 0; j < 8; ++j) { v[j] = po[c * 64 + sg * 8 + j]; ss += v[j] * v[j]; }
                ss += __shfl_xor(ss, 1); ss += __shfl_xor(ss, 2); ss += __shfl_xor(ss, 4);
                const float rs = 1.0f / sqrtf(ss * (1.0f / 64.0f) + 1e-6f);
                const u32x4 zw = *(const u32x4*)(proj + (size_t)(tokb + c) * PROJW + PC_GZ + h * 64 + sg * 8); const unsigned zz[4] = {zw.x, zw.y, zw.z, zw.w};
#pragma unroll
                for (int j = 0; j < 8; ++j) { const float zf = (j & 1) ? __uint_as_float(zz[j >> 1] & 0xffff0000u) : __uint_as_float(zz[j >> 1] << 16); v[j] = v[j] * rs * nw[sg * 8 + j] * siluf_(zf); }
                u32x4 w; w.x = pk2(v[0], v[1]); w.y = pk2(v[2], v[3]); w.z = pk2(v[4], v[5]); w.w = pk2(v[6], v[7]);
                *(u32x4*)(og + (size_t)(tokb + c) * 256 + h * 64 + sg * 8) = w; } }
        __syncthreads();
    }
    { const LAS float* po = ob0 + 4096; const int tokb = bl * SEQ + 63 * 64;
        for (int task = tid; task < 512; task += NTHR) { const int c = task >> 3, sg = task & 7; float v[8], ss = 0.f;
#pragma unroll
            for (int j = 0; j < 8; ++j) { v[j] = po[c * 64 + sg * 8 + j]; ss += v[j] * v[j]; }
            ss += __shfl_xor(ss, 1); ss += __shfl_xor(ss, 2); ss += __shfl_xor(ss, 4);
            const float rs = 1.0f / sqrtf(ss * (1.0f / 64.0f) + 1e-6f);
            const u32x4 zw = *(const u32x4*)(proj + (size_t)(tokb + c) * PROJW + PC_GZ + h * 64 + sg * 8); const unsigned zz[4] = {zw.x, zw.y, zw.z, zw.w};
#pragma unroll
            for (int j = 0; j < 8; ++j) { const float zf = (j & 1) ? __uint_as_float(zz[j >> 1] & 0xffff0000u) : __uint_as_float(zz[j >> 1] << 16); v[j] = v[j] * rs * nw[sg * 8 + j] * siluf_(zf); }
            u32x4 w; w.x = pk2(v[0], v[1]); w.y = pk2(v[2], v[3]); w.z = pk2(v[4], v[5]); w.w = pk2(v[6], v[7]);
            *(u32x4*)(og + (size_t)(tokb + c) * 256 + h * 64 + sg * 8) = w; } }
    __syncthreads();
}

__device__ __forceinline__ void fox_cum_item(const Params& p, int l, int item, LAS float* lf, const int tid) {
    const int lane = tid & 63, wid = tid >> 6, h = item & 3, bl = item >> 2;
    const float* sm = (const float*)(p.ws + WS_R + R_SM); float* nb = (float*)(p.ws + WS_R + R_CUM) + (size_t)item * SEQ;
    const float fb = PIN(IN_FBIAS)[l * 4 + h];
    float v[8], run = 0.f;
#pragma unroll
    for (int j = 0; j < 8; ++j) { const float x = sm[(size_t)(bl * SEQ + tid * 8 + j) * 32 + 20 + h] + fb; run += fminf(x, 0.f) - log1pf(__expf(-fabsf(x))); v[j] = run; }
    float inc = run;
#pragma unroll
    for (int o = 1; o < 64; o <<= 1) { const float t = __shfl_up(inc, o); if (lane >= o) inc += t; }
    __syncthreads();
    if (lane == 63) lf[wid] = inc;
    __syncthreads();
    float base = inc - run;
    for (int w = 0; w < wid; ++w) base += lf[w];
#pragma unroll
    for (int j = 0; j < 8; ++j) nb[tid * 8 + j] = -(base + v[j]) * LOG2E;
    __syncthreads();
}
__device__ __forceinline__ void ret_rope_pass(const Params& p, int chunk, const int tid, const int blk) {
    bf16_t* proj = (bf16_t*)(p.ws + WS_R + R_PROJ); const f32x2* tab = (const f32x2*)(p.ws + WS_ROPE);
    for (int task = blk * NTHR + tid; task < MC * 32; task += NWG * NTHR) {
        const int row = task >> 5, which = (task >> 4) & 1, h = (task >> 2) & 3, i8 = task & 3;
        bf16_t* q1 = proj + (size_t)row * PROJW + (which ? PC_RK : PC_RQ) + h * 64 + i8 * 8; bf16_t* q2 = q1 + 32;
        const u32x4 a = *(const u32x4*)q1, b = *(const u32x4*)q2; const unsigned aa[4] = {a.x, a.y, a.z, a.w}, bb[4] = {b.x, b.y, b.z, b.w};
        const f32x2* tp = tab + (size_t)(chunk * MC + row) * 32 + i8 * 8; float o1[8], o2[8];
#pragma unroll
        for (int j = 0; j < 8; ++j) { const float x1 = (j & 1) ? __uint_as_float(aa[j >> 1] & 0xffff0000u) : __uint_as_float(aa[j >> 1] << 16);
            const float x2 = (j & 1) ? __uint_as_float(bb[j >> 1] & 0xffff0000u) : __uint_as_float(bb[j >> 1] << 16);
            const f32x2 cs = tp[j]; o1[j] = x1 * cs.x - x2 * cs.y; o2[j] = x1 * cs.y + x2 * cs.x; }
        u32x4 w1, w2; w1.x = pk2(o1[0], o1[1]); w1.y = pk2(o1[2], o1[3]); w1.z = pk2(o1[4], o1[5]); w1.w = pk2(o1[6], o1[7]);
        w2.x = pk2(o2[0], o2[1]); w2.y = pk2(o2[2], o2[3]); w2.z = pk2(o2[4], o2[5]); w2.w = pk2(o2[6], o2[7]);
        *(u32x4*)q1 = w1; *(u32x4*)q2 = w2; }
}

constexpr int AL_K0 = 0, AL_V0 = 16384, AL_B0 = 32768;
__device__ __forceinline__ s16x4 vtr(const LAS unsigned char* q) {
    typedef short v4i16_t __attribute__((ext_vector_type(4)));
    return __builtin_bit_cast(s16x4, __builtin_amdgcn_ds_read_tr16_b64_v4i16((LAS v4i16_t*)q));
}
__device__ __forceinline__ void attn_qkt(f32x16& p0, f32x16& p1, const LAS unsigned char* kslot, const bf16x8 (&qf)[4], int r32, int hi) {
    p0 = (f32x16){}; p1 = (f32x16){};
#pragma unroll
    for (int d0 = 0; d0 < 4; ++d0) { const LAS unsigned char* kb = kslot + (2 * d0 + hi) * 1024 + r32 * 16;
        const bf16x8 b0 = *(const LAS bf16x8*)kb, b1 = *(const LAS bf16x8*)(kb + 512);
        p0 = MF32(b0, qf[d0], p0); p1 = MF32(b1, qf[d0], p1); }
}
__device__ __forceinline__ void attn_pv(f32x16 (&o)[2], const LAS unsigned char* vslot, const bf16x8 (&pw)[4], int lane, int hi) {
    const LAS unsigned char* vb = vslot + ((lane >> 4) & 1) * 32 + (lane & 3) * 8 + (4 * hi + ((lane & 15) >> 2)) * 64;
#pragma unroll
    for (int d0 = 0; d0 < 2; ++d0)
#pragma unroll
        for (int ks = 0; ks < 4; ++ks) { const s16x4 lo = vtr(vb + d0 * 4096 + ks * 1024), h4 = vtr(vb + d0 * 4096 + ks * 1024 + 512);
            const bf16x8 vf = (bf16x8){lo[0], lo[1], lo[2], lo[3], h4[0], h4[1], h4[2], h4[3]};
            o[d0] = MF32(vf, pw[ks], o[d0]); }
}
__device__ __forceinline__ void attn_softmax_step(f32x16& p0, f32x16& p1, f32x16 (&o)[2], float& m, float& l) {
    float mt = p0[0];
#pragma unroll
    for (int r = 1; r < 16; ++r) mt = fmaxf(mt, p0[r]);
#pragma unroll
    for (int r = 0; r < 16; ++r) mt = fmaxf(mt, p1[r]);
    mt = fmaxf(mt, __shfl_xor(mt, 32));
    const float mn = fmaxf(m, mt), ms = (mn == -INFINITY) ? 0.f : mn, alpha = ex2(m - ms);
    float s = 0.f;
#pragma unroll
    for (int r = 0; r < 16; ++r) { p0[r] = ex2(p0[r] - ms); p1[r] = ex2(p1[r] - ms); s += p0[r] + p1[r]; }
    l = l * alpha + s; o[0] *= alpha; o[1] *= alpha; m = mn;
}
template <class F>
__device__ __forceinline__ void flash_loop(const F& f, int tlo, int thi, const bf16_t* Kg, const bf16_t* Vg, int pitch, const float* biasg,
                                           const bf16x8 (&qf)[4], f32x16 (&o)[2], float& m, float& l, LAS unsigned char* lds, const int tid) {
    const int lane = tid & 63, wid = tid >> 6, r32 = lane & 31, hi = lane >> 5;
    int t = tlo; while (t < thi && f.skip(t)) ++t;
    __syncthreads();
    if (t >= thi) return;
    const bf16_t* ksrc = Kg + (size_t)lane * pitch + wid * 8;
    const bf16_t* vsrc = Vg + (size_t)(16 * (wid & 3) + (lane >> 2)) * pitch + (wid >> 2) * 32 + (lane & 3) * 8;
    const int sdst = wid * 1024 + lane * 16;
    u32x4 kr = *(const u32x4*)(ksrc + (size_t)t * 64 * pitch), vr = *(const u32x4*)(vsrc + (size_t)t * 64 * pitch); float br = 0.f;
    const int btid = tid & 63;
    if (F::HAS_BIAS) br = biasg[t * 64 + btid];
    *(LAS u32x4*)(lds + AL_K0 + sdst) = kr; *(LAS u32x4*)(lds + AL_V0 + sdst) = vr; if (F::HAS_BIAS) ((LAS float*)(lds + AL_B0))[btid] = br;
    __syncthreads();
    int cur = 0;
    for (;;) {
        int tn = t + 1; while (tn < thi && f.skip(tn)) ++tn;
        if (tn < thi) { kr = *(const u32x4*)(ksrc + (size_t)tn * 64 * pitch); vr = *(const u32x4*)(vsrc + (size_t)tn * 64 * pitch); if (F::HAS_BIAS) br = biasg[tn * 64 + btid]; }
        f32x16 p0, p1;
        attn_qkt(p0, p1, lds + AL_K0 + cur * 8192, qf, r32, hi);
        if (F::HAS_BIAS) { const LAS float* bp = (const LAS float*)(lds + AL_B0 + cur * 256);
#pragma unroll
            for (int g = 0; g < 4; ++g) { const f32x4 b0 = *(const LAS f32x4*)(bp + 8 * g + 4 * hi), b1 = *(const LAS f32x4*)(bp + 32 + 8 * g + 4 * hi);
#pragma unroll
                for (int e = 0; e < 4; ++e) { p0[4 * g + e] += b0[e]; p1[4 * g + e] += b1[e]; } } }
        f.apply(p0, p1, t);
        if (F::MODE == 0) attn_softmax_step(p0, p1, o, m, l);
        bf16x8 pw[4]; pw[0] = pack_acc8(p0, 0); pw[1] = pack_acc8(p0, 1); pw[2] = pack_acc8(p1, 0); pw[3] = pack_acc8(p1, 1);
        attn_pv(o, lds + AL_V0 + cur * 8192, pw, lane, hi);
        if (tn >= thi) break;
        cur ^= 1;
        *(LAS u32x4*)(lds + AL_K0 + cur * 8192 + sdst) = kr; *(LAS u32x4*)(lds + AL_V0 + cur * 8192 + sdst) = vr; if (F::HAS_BIAS) ((LAS float*)(lds + AL_B0 + cur * 256))[btid] = br;
        __syncthreads();
        t = tn;
    }
    __syncthreads();
}
__device__ __forceinline__ void load_qf(bf16x8 (&qf)[4], const bf16_t* qrow, int hi) {
#pragma unroll
    for (int d0 = 0; d0 < 4; ++d0) qf[d0] = *(const bf16x8*)(qrow + d0 * 16 + hi * 8);
}
__device__ __forceinline__ void store_ot(const f32x16 (&o)[2], bf16_t* orow, int hi) {
#pragma unroll
    for (int d0 = 0; d0 < 2; ++d0)
#pragma unroll
        for (int g = 0; g < 4; ++g) { u32x2 w; w.x = pk2(o[d0][4 * g], o[d0][4 * g + 1]); w.y = pk2(o[d0][4 * g + 2], o[d0][4 * g + 3]); *(u32x2*)(orow + 32 * d0 + 8 * g + 4 * hi) = w; }
}

struct FoxF { static constexpr int MODE = 0; static constexpr bool HAS_BIAS = true; int tq, qmin, hi;
    __device__ __forceinline__ bool skip(int) const { return false; }
    __device__ __forceinline__ void apply(f32x16& p0, f32x16& p1, int t) const {
        if (64 * t + 63 > qmin) {
#pragma unroll
            for (int r = 0; r < 16; ++r) { const int key = 64 * t + crow(r, hi); if (key > tq) p0[r] = -INFINITY; if (key + 32 > tq) p1[r] = -INFINITY; } } } };
struct RetF { static constexpr int MODE = 1; static constexpr bool HAS_BIAS = false; int tq, hi; float lg;
    __device__ __forceinline__ bool skip(int) const { return false; }
    __device__ __forceinline__ void apply(f32x16& p0, f32x16& p1, int t) const {
#pragma unroll
        for (int r = 0; r < 16; ++r) { const int key = 64 * t + crow(r, hi);
            p0[r] = (key <= tq) ? p0[r] * ex2((float)(tq - key) * lg) : 0.f; p1[r] = (key + 32 <= tq) ? p1[r] * ex2((float)(tq - key - 32) * lg) : 0.f; } } };
struct SelF { static constexpr int MODE = 0; static constexpr bool HAS_BIAS = false; unsigned long long umask, mymask; int tq, klo, hi;
    __device__ __forceinline__ bool skip(int t) const { return ((umask >> t) & 1ull) == 0ull; }
    __device__ __forceinline__ void apply(f32x16& p0, f32x16& p1, int t) const { const bool on = ((mymask >> t) & 1ull) != 0ull;
#pragma unroll
        for (int r = 0; r < 16; ++r) { const int key = 64 * t + crow(r, hi); if (!on || key > tq || key <= klo) p0[r] = -INFINITY; if (!on || key + 32 > tq || key + 32 <= klo) p1[r] = -INFINITY; } } };
__device__ __forceinline__ void fox_unit(const Params& p, int idx, LAS unsigned char* lds, const int tid_in_) {
    int tid = tid_in_; asm volatile("" : "+v"(tid)); unsigned char* wsl_ = ws_late();
    const int lane = tid & 63, wid = tid >> 6, r32 = lane & 31, hi = lane >> 5;
    const int qb = 15 - (idx >> 5), bh = idx & 31, h = bh & 3, bl = bh >> 2;
    const bf16_t* proj = (const bf16_t*)(wsl_ + WS_R + R_PROJ);
    const int tq = qb * 256 + wid * 32 + r32; const size_t rowc = (size_t)bl * SEQ + tq;
    bf16x8 qf[4]; load_qf(qf, proj + rowc * PROJW + PC_FQ + h * 64, hi);
    f32x16 o[2]; o[0] = (f32x16){}; o[1] = (f32x16){}; float m = -INFINITY, l = 0.f;
    FoxF f; f.tq = tq; f.qmin = qb * 256; f.hi = hi;
    flash_loop(f, 0, 4 * qb + 4, proj + (size_t)bl * SEQ * PROJW + PC_FK + h * 64, proj + (size_t)bl * SEQ * PROJW + PC_FV + h * 64, PROJW,
               (const float*)(wsl_ + WS_R + R_CUM) + (size_t)bh * SEQ, qf, o, m, l, lds, tid);
    l += __shfl_xor(l, 32); const float inv = 1.0f / l; o[0] *= inv; o[1] *= inv;
    store_ot(o, (bf16_t*)(wsl_ + WS_R + R_O) + (size_t)3 * MC * 256 + rowc * 256 + h * 64, hi);
}
__device__ __forceinline__ void ret_unit(const Params& p, int l_, int idx, LAS unsigned char* lds, const int tid_in_) {
    int tid = tid_in_; asm volatile("" : "+v"(tid)); unsigned char* wsl_ = ws_late();
    const int lane = tid & 63, wid = tid >> 6, r32 = lane & 31, hi = lane >> 5;
    const int qb = 15 - (idx >> 5), bh = idx & 31, h = bh & 3, bl = bh >> 2;
    const bf16_t* proj = (const bf16_t*)(wsl_ + WS_R + R_PROJ);
    const int tq = qb * 256 + wid * 32 + r32; const size_t rowc = (size_t)bl * SEQ + tq;
    bf16x8 qf[4]; load_qf(qf, proj + rowc * PROJW + PC_RQ + h * 64, hi);
    f32x16 o[2]; o[0] = (f32x16){}; o[1] = (f32x16){}; float m = 0.f, l = 0.f;
    RetF f; f.tq = tq; f.hi = hi; f.lg = log2f(1.0f - exp2f(-5.0f - (float)h));
    flash_loop(f, 0, 4 * qb + 4, proj + (size_t)bl * SEQ * PROJW + PC_RK + h * 64, proj + (size_t)bl * SEQ * PROJW + PC_RV + h * 64, PROJW, nullptr, qf, o, m, l, lds, tid);
    float s = 0.f;
#pragma unroll
    for (int r = 0; r < 16; ++r) s += o[0][r] + o[1][r];
    s += __shfl_xor(s, 32); const float mu = s * (1.0f / 64.0f); float q = 0.f;
#pragma unroll
    for (int r = 0; r < 16; ++r) { const float a = o[0][r] - mu, b = o[1][r] - mu; q += a * a + b * b; }
    q += __shfl_xor(q, 32); const float rs = 1.0f / sqrtf(q * (1.0f / 64.0f) + LN_EPS);
    const float* gw = PIN(IN_RETGN) + l_ * 256 + h * 64; const bf16_t* grow = proj + rowc * PROJW + PC_RG + h * 64;
#pragma unroll
    for (int d0 = 0; d0 < 2; ++d0)
#pragma unroll
        for (int g = 0; g < 4; ++g) { const int d = 32 * d0 + 8 * g + 4 * hi; const u32x2 gz = *(const u32x2*)(grow + d); const f32x4 w4 = *(const f32x4*)(gw + d);
            const float gg[4] = {__uint_as_float(gz.x << 16), __uint_as_float(gz.x & 0xffff0000u), __uint_as_float(gz.y << 16), __uint_as_float(gz.y & 0xffff0000u)};
#pragma unroll
            for (int e = 0; e < 4; ++e) o[d0][4 * g + e] = (o[d0][4 * g + e] - mu) * rs * w4[e] * siluf_(gg[e]); }
    store_ot(o, (bf16_t*)(wsl_ + WS_R + R_O) + (size_t)1 * MC * 256 + rowc * 256 + h * 64, hi);
}
constexpr int NL_KC = 36864, NL_VC = 69632, NL_IMPM = 102400, NL_IMPS = 118784, NL_SELM = 135424;
__device__ __forceinline__ void nsa_unit(const Params& p, int idx, LAS unsigned char* lds, const int tid_in_) {
    int tid = tid_in_; asm volatile("" : "+v"(tid)); unsigned char* wsl_ = ws_late();
    const int lane = tid & 63, wid = tid >> 6, r32 = lane & 31, hi = lane >> 5, tl = r32 >> 2, hd = r32 & 3;
    const int ib = 63 - (idx >> 3), bl = idx & 7;
    const bf16_t* proj = (const bf16_t*)(wsl_ + WS_R + R_PROJ); const float* sm = (const float*)(wsl_ + WS_R + R_SM);
    const int tokl = 8 * wid + tl, tq = ib * 64 + tokl; const size_t rowc = (size_t)bl * SEQ + tq;
    bf16x8 qf[4]; load_qf(qf, proj + rowc * PROJW + PC_NQ + hd * 64, hi);
    const float g0 = sigmoidf_(sm[rowc * 32 + 8 + hd * 3 + 0]), g1 = sigmoidf_(sm[rowc * 32 + 8 + hd * 3 + 1]), g2 = sigmoidf_(sm[rowc * 32 + 8 + hd * 3 + 2]);
    f32x16 of[2];
    const int ntc = min(3, (4 * ib + 2) >> 6) + 1;
    {
        const bf16_t* kc = (const bf16_t*)(wsl_ + WS_R + R_KCMP) + (size_t)bl * 256 * 64; const bf16_t* vc = kc + (size_t)BC * 256 * 64;
        __syncthreads();
        for (int tt = 0; tt < ntc; ++tt) {
            *(LAS u32x4*)(lds + NL_KC + tt * 8192 + wid * 1024 + lane * 16) = *(const u32x4*)(kc + (size_t)(tt * 64 + lane) * 64 + wid * 8);
            *(LAS u32x4*)(lds + NL_VC + tt * 8192 + wid * 1024 + lane * 16) = *(const u32x4*)(vc + (size_t)(tt * 64 + 16 * (wid & 3) + (lane >> 2)) * 64 + (wid >> 2) * 32 + (lane & 3) * 8); }
        __syncthreads();
        float m = -INFINITY, l = 0.f;
        for (int tt = 0; tt < ntc; ++tt) { f32x16 p0, p1; attn_qkt(p0, p1, lds + NL_KC + tt * 8192, qf, r32, hi);
#pragma unroll
            for (int r = 0; r < 16; ++r) { const int n0 = 64 * tt + crow(r, hi), n1 = n0 + 32; if (n0 >= 255 || 16 * n0 + 31 > tq) p0[r] = -INFINITY; if (n1 >= 255 || 16 * n1 + 31 > tq) p1[r] = -INFINITY; }
            float mt = p0[0];
#pragma unroll
            for (int r = 1; r < 16; ++r) mt = fmaxf(mt, p0[r]);
#pragma unroll
            for (int r = 0; r < 16; ++r) mt = fmaxf(mt, p1[r]);
            mt = fmaxf(mt, __shfl_xor(mt, 32));
            const float mn = fmaxf(m, mt), ms = (mn == -INFINITY) ? 0.f : mn; float s = 0.f;
#pragma unroll
            for (int r = 0; r < 16; ++r) s += ex2(p0[r] - ms) + ex2(p1[r] - ms);
            l = l * ex2(m - ms) + s; m = mn; }
        l += __shfl_xor(l, 32);
        const float inv = (l > 0.f) ? 1.0f / l : 0.f, ms = (m == -INFINITY) ? 0.f : m;
        LAS float* impm = (LAS float*)(lds + NL_IMPM); LAS float* imps = (LAS float*)(lds + NL_IMPS);
        f32x16 oc[2]; oc[0] = (f32x16){}; oc[1] = (f32x16){};
        for (int tt = 0; tt < ntc; ++tt) { f32x16 p0, p1; attn_qkt(p0, p1, lds + NL_KC + tt * 8192, qf, r32, hi);
#pragma unroll
            for (int r = 0; r < 16; ++r) { const int n0 = 64 * tt + crow(r, hi), n1 = n0 + 32;
                p0[r] = (n0 >= 255 || 16 * n0 + 31 > tq) ? 0.f : ex2(p0[r] - ms) * inv; p1[r] = (n1 >= 255 || 16 * n1 + 31 > tq) ? 0.f : ex2(p1[r] - ms) * inv; }
#pragma unroll
            for (int g = 0; g < 4; ++g) {
                float ma = p0[4 * g] + p0[4 * g + 1] + p0[4 * g + 2] + 0.5f * p0[4 * g + 3], sa = 0.5f * p0[4 * g + 3];
                float mb = p1[4 * g] + p1[4 * g + 1] + p1[4 * g + 2] + 0.5f * p1[4 * g + 3], sb = 0.5f * p1[4 * g + 3];
                ma += __shfl_xor(ma, 1); ma += __shfl_xor(ma, 2); sa += __shfl_xor(sa, 1); sa += __shfl_xor(sa, 2);
                mb += __shfl_xor(mb, 1); mb += __shfl_xor(mb, 2); sb += __shfl_xor(sb, 1); sb += __shfl_xor(sb, 2);
                if (hd == 0) { const int ja = 16 * tt + 2 * g + hi, jb = ja + 8;
                    impm[tokl * 64 + ja] = ma; imps[tokl * 65 + ja + 1] = sa; impm[tokl * 64 + jb] = mb; imps[tokl * 65 + jb + 1] = sb; } }
            bf16x8 pw[4]; pw[0] = pack_acc8(p0, 0); pw[1] = pack_acc8(p0, 1); pw[2] = pack_acc8(p1, 0); pw[3] = pack_acc8(p1, 1);
            attn_pv(oc, lds + NL_VC + tt * 8192, pw, lane, hi); }
        of[0] = oc[0] * g0; of[1] = oc[1] * g0;
        LAS unsigned long long* selm = (LAS unsigned long long*)(lds + NL_SELM);
        for (int t8 = 0; t8 < 8; ++t8) { const int tk = 8 * wid + t8; const int j = lane;
            float imp = (j < 16 * ntc) ? impm[tk * 64 + j] + ((j > 0) ? imps[tk * 65 + j] : 0.f) : 0.f;
            const bool forced = (j == 0) || (j == ib) || (j == ib - 1);
            const float score = forced ? 1.0e4f : ((j <= ib) ? imp : -1.0f);
            int rank = 0;
#pragma unroll
            for (int jj = 0; jj < 64; ++jj) { const float sj = __uint_as_float(__builtin_amdgcn_readlane(__float_as_uint(score), jj)); rank += ((sj > score) || (sj == score && jj < j)) ? 1 : 0; }
            const unsigned long long mk = __ballot((rank < 16) && (j <= ib));
            if (lane == 0) selm[tk] = mk; }
    }
    __syncthreads();
    unsigned long long mymask, umask;
    { const LAS unsigned long long* selm = (const LAS unsigned long long*)(lds + NL_SELM); mymask = selm[tokl];
      unsigned long long u = selm[lane]; unsigned lo = (unsigned)u, hi32 = (unsigned)(u >> 32);
#pragma unroll
      for (int o = 32; o >= 1; o >>= 1) { lo |= __shfl_xor(lo, o); hi32 |= __shfl_xor(hi32, o); }
      umask = ((unsigned long long)hi32 << 32) | lo; umask = __builtin_amdgcn_readfirstlane((unsigned)umask) | ((unsigned long long)__builtin_amdgcn_readfirstlane((unsigned)(umask >> 32)) << 32); }
    for (int br = 0; br < 2; ++br) {
        f32x16 o[2]; o[0] = (f32x16){}; o[1] = (f32x16){}; float m = -INFINITY, l = 0.f;
        SelF f; f.umask = br ? ~0ull : umask; f.mymask = br ? ~0ull : mymask; f.tq = tq; f.klo = br ? tq - 512 : -1; f.hi = hi;
        const bf16_t* nkv2 = (const bf16_t*)(ws_late() + WS_R + R_NKV);
        flash_loop(f, br ? max(0, ib - 8) : 0, ib + 1, nkv2 + (size_t)(2 + 2 * br) * (NKV_SEG / 2) + (size_t)bl * SEQ * 64, nkv2 + (size_t)(3 + 2 * br) * (NKV_SEG / 2) + (size_t)bl * SEQ * 64, 64, nullptr, qf, o, m, l, lds, tid);
        l += __shfl_xor(l, 32); const float sc = (l > 0.f) ? (br ? g2 : g1) / l : 0.f; of[0] += o[0] * sc; of[1] += o[1] * sc;
    }
    store_ot(of, (bf16_t*)(ws_late() + WS_R + R_O) + (size_t)2 * MC * 256 + rowc * 256 + hd * 64, hi);
}

constexpr int LDS_MISC = LDS_BYTES - 256;
constexpr size_t LWS = ((LW_BYTES + MiB - 1) / MiB) * MiB;
#define PHASE_PRE const int tid = fresh_tid(); int l, ch; { int k_; bool b_; step_decode(__builtin_amdgcn_readfirstlane(((volatile LAS int*)lds_at(LDS_MISC + 176))[0]), k_, l, ch, b_); } \
    Params p; ptab_load(p); LAS unsigned char* lds = lds_at(0); const int G = NWG; \
    const int c = __builtin_amdgcn_readfirstlane(((volatile LAS int*)(lds + LDS_MISC + 176))[2]); (void)lds; (void)G; (void)c; (void)l; (void)ch; \
    volatile LAS int* qslot = (volatile LAS int*)(lds + LDS_MISC + 16); (void)qslot;
#define LW_ (p.ws + WS_W + (size_t)l * LWS)
#define LWO_ ((unsigned)(WS_W + (size_t)l * LWS))
#define HC_ ((unsigned)(WS_H + (size_t)ch * MC * 1024 * 2))
#define QCTR_ ((unsigned*)(p.ws + WS_CTL) + CW_Q + 64 * ((l * NCHUNK + ch) * 8) + 2048 * __builtin_amdgcn_readfirstlane(((volatile LAS int*)lds_at(LDS_MISC + 176))[3]))
__device__ __forceinline__ int tid_out(int t) { asm volatile("" : "+v"(t)); return t; }
__device__ __forceinline__ int fresh_tid() {
    LAS unsigned* ctr = (LAS unsigned*)lds_at(LDS_MISC + 192);
    unsigned z = 0u; asm volatile("" : "+v"(z));
    const int lane = (int)__builtin_amdgcn_mbcnt_hi(~0u, __builtin_amdgcn_mbcnt_lo(~0u, z));
    unsigned t = 0u; if (lane == 0) t = __hip_atomic_fetch_add(ctr, 1u, __ATOMIC_RELAXED, __HIP_MEMORY_SCOPE_WORKGROUP);
    t = (unsigned)__builtin_amdgcn_readfirstlane((int)t);
    __syncthreads();
    return (int)(((t & 7u) << 6) | (unsigned)lane);
}
__device__ __forceinline__ void step_decode(int s, int& k, int& l, int& ch, bool& bar);
#define PHFN(name) static __device__ __noinline__ void name()
#define PHFI(name) static __device__ __forceinline__ void name()

PHFI(ph_p0) { PHASE_PRE
    constexpr int N_ADA = 192, N_CB = 4, N_ROPE = MTOK * 32 / 4096, N_T = 2 * TJ_TOTAL;
    for (int it = c; it < N_ADA + N_CB + N_ROPE + N_T; it += G) {
        if (it < N_ADA) p0_ada(p, it, (LAS float*)lds, tid);
        else if (it < N_ADA + N_CB) p0_cbias(p, it - N_ADA, tid);
        else if (it < N_ADA + N_CB + N_ROPE) p0_rope(p, it - N_ADA - N_CB, tid);
        else p0_transpose(p, it - N_ADA - N_CB - N_ROPE, (LAS float*)lds, tid);
    }
}
PHFN(ph_p1) { PHASE_PRE prep_first(p, tid, c); }
PHFN(ph_a1) { PHASE_PRE
    DenseSched S; S.A = HC_; S.Bt = LWO_ + (unsigned)LW_WIN; S.tA = 256u * 1024 * 2; S.tB = 256u * 1024 * 2; S.aBr = 0; S.nM = MC / 256; S.nN = NPROJ / 256; S.G = G; S.c = c; S.pnShift = 0;
    EpiProj E;
    pg8::gemm_phase<EpiProj, DenseSched, true, false>(lds, 1024, 1024, 1024, S, E, tid, (const char*)p.ws);
}
PHFN(ph_a2a) { PHASE_PRE
    if (c < 2 * BC) {
        const int which = c & 1, bl = c >> 1;
        OneSched S; S.has = true; S.u0.pm = bl; S.u0.pn = 0; S.u0.aux = which; S.u0.nvalid = 256; S.u0.rows = 0u;
        S.u0.a = (unsigned)(WS_R + R_NKV + (size_t)which * NKV_SEG + (size_t)bl * SEQ * 64 * 2); S.u0.b = LWO_ + (unsigned)(LW_CW1 + (size_t)which * 256 * 2048 * 2);
        EpiH1 E; E.h1 = (bf16_t*)(p.ws + WS_R + R_H1); E.cbias = (const float*)(p.ws + WS_CBIAS) + l * 512;
        pg8::gemm_phase<EpiH1, OneSched, true, false>(lds, 2048, 1024, 2048, S, E, tid, (const char*)p.ws);
        VM_WAIT(); __syncthreads(); __builtin_amdgcn_fence(__ATOMIC_ACQUIRE, "agent"); VM_WAIT(); __syncthreads();
    }
}
PHFN(ph_a2b) { PHASE_PRE
    if (c < 2 * BC) {
        const int which = c & 1, bl = c >> 1;
        OneSched S2; S2.has = true; S2.u0.pm = bl; S2.u0.pn = 0; S2.u0.aux = which; S2.u0.nvalid = 256; S2.u0.rows = 0u;
        S2.u0.a = (unsigned)(WS_R + R_H1 + ((size_t)which * BC * 256 + (size_t)bl * 256) * 256 * 2); S2.u0.b = LWO_ + (unsigned)(LW_CW2 + (size_t)which * 256 * 256 * 2);
        EpiCmp2 E2; E2.kc = (bf16_t*)(p.ws + WS_R + R_KCMP);
        pg8::gemm_phase<EpiCmp2, OneSched, true, false>(lds, 256, 256, 256, S2, E2, tid, (const char*)p.ws);
    }
}
PHFI(ph_a2c) { PHASE_PRE
    for (;;) { const int u = q_next(QCTR_ + 0, qslot, tid); if (u >= BC * 4 * 64) break; gdn_prep_unit(p, l, u, lds, tid); }
}
PHFN(ph_a2d) { PHASE_PRE
    for (;;) { const int u = q_next(QCTR_ + 64, qslot, tid); if (u >= BC * 4) break; fox_cum_item(p, l, u, (LAS float*)lds, tid); }
    ret_rope_pass(p, ch, tid, c);
}
PHFN(ph_a3a) { PHASE_PRE if (c < BC * 4) gdn_scan_item(p, l, ch, c, lds, tid); }
PHFI(ph_a3b) { PHASE_PRE for (;;) { const int u = q_next(QCTR_ + 128, qslot, tid); if (u >= 512) break; fox_unit(p, u, lds, tid); } }
PHFN(ph_a3c) { PHASE_PRE for (;;) { const int u = q_next(QCTR_ + 192, qslot, tid); if (u >= 512) break; ret_unit(p, l, u, lds, tid); } }
PHFI(ph_a3d) { PHASE_PRE for (;;) { const int u = q_next(QCTR_ + 256, qslot, tid); if (u >= 512) break; nsa_unit(p, u, lds, tid); } }
PHFN(ph_a5) { PHASE_PRE
    DenseSched S; S.A = (unsigned)(WS_R + R_O); S.Bt = LWO_ + (unsigned)LW_BPT; S.tA = 256u * 256 * 2; S.tB = 256u * 256 * 2; S.aBr = (unsigned)((size_t)MC * 256 * 2); S.nM = MC / 256; S.nN = 16; S.G = G; S.c = c; S.pnShift = 2;
    EpiP E;
    pg8::gemm_phase<EpiP, DenseSched, true, false>(lds, 256, 256, 256, S, E, tid, (const char*)p.ws);
}
PHFN(ph_a6) { PHASE_PRE
    DenseSched S; S.A = HC_; S.Bt = LWO_ + (unsigned)LW_WGV; S.tA = 256u * 1024 * 2; S.tB = 256u * 1024 * 2; S.aBr = 0; S.nM = MC / 256; S.nN = 16; S.G = G; S.c = c; S.pnShift = 0;
    EpiGate E;
    pg8::gemm_phase<EpiGate, DenseSched, true, false>(lds, 1024, 1024, 1024, S, E, tid, (const char*)p.ws);
}
PHFN(ph_a7) { PHASE_PRE
    DenseSched S; S.A = (unsigned)(WS_R + R_Y); S.Bt = LWO_ + (unsigned)LW_WOT; S.tA = 256u * 1024 * 2; S.tB = 256u * 1024 * 2; S.aBr = 0; S.nM = MC / 256; S.nN = 4; S.G = G; S.c = c; S.pnShift = 0;
    EpiOut E; E.row_base = ch * MC;
    pg8::gemm_phase<EpiOut, DenseSched, true, false>(lds, 1024, 1024, 1024, S, E, tid, (const char*)p.ws);
}
PHFN(ph_b0) { PHASE_PRE prep_moe(p, l, (LAS float*)lds, tid, c); }
__device__ __forceinline__ void moe_tables(const Params& p, int l, LAS int* mcnt, LAS int* mpre, const int tid) {
    __syncthreads();
    if (tid < 16) mcnt[tid] = (int)((unsigned*)(p.ws + WS_CTL))[CW_CNT + l * 64 + tid];
    __syncthreads();
    if (tid == 0) { int s = 0; for (int e = 0; e < 16; ++e) { mpre[e] = s; s += (mcnt[e] + 255) >> 8; } mpre[16] = s; }
    __syncthreads();
}
PHFN(ph_b1) { PHASE_PRE
    LAS int* mcnt = (LAS int*)(lds + LDS_MISC + 32); LAS int* mpre = mcnt + 16; moe_tables(p, l, mcnt, mpre, tid);
    MoeSched S; S.pre = mpre; S.cnt = mcnt; S.wsb = (const char*)p.ws; S.A = (unsigned)WS_H; S.W = LWO_ + (unsigned)LW_W13;
    S.wE = 1024u * 1024 * 2; S.wT = 256u * 1024 * 2; S.aT = 0; S.G = G; S.c = c; S.gatherA = true;
    EpiMoe1 E;
    pg8::gemm_phase<EpiMoe1, MoeSched, true, true>(lds, 1024, 1024, 1024, S, E, tid, (const char*)p.ws);
}
PHFN(ph_b2) { PHASE_PRE
    LAS int* mcnt = (LAS int*)(lds + LDS_MISC + 32); LAS int* mpre = mcnt + 16; moe_tables(p, l, mcnt, mpre, tid);
    MoeSched S; S.pre = mpre; S.cnt = mcnt; S.wsb = (const char*)p.ws; S.A = (unsigned)(WS_R + R_HID); S.W = LWO_ + (unsigned)LW_W2;
    S.wE = 1024u * 512 * 2; S.wT = 256u * 512 * 2; S.aT = 256u * 512 * 2; S.G = G; S.c = c; S.gatherA = false;
    EpiMoe2 E;
    pg8::gemm_phase<EpiMoe2, MoeSched, true, false>(lds, 512, 512, 512, S, E, tid, (const char*)p.ws);
}
PHFN(ph_b3) { PHASE_PRE prep_next(p, l, l == DEPTH - 1, tid, c); }

constexpr int STEPS_CHUNK = 12, STEPS_LAYER = 2 * STEPS_CHUNK + 4, N_STEPS = 2 + DEPTH * STEPS_LAYER;
__device__ __forceinline__ void step_decode(int s, int& k, int& l, int& ch, bool& bar) {
    if (s < 2) { k = s; l = 0; ch = 0; bar = true; return; }
    const int t = s - 2; l = t / STEPS_LAYER; const int r = t % STEPS_LAYER;
    if (r < 2 * STEPS_CHUNK) { ch = r / STEPS_CHUNK; const int q = r % STEPS_CHUNK; k = 2 + q; bar = !(q == 1 || q == 2 || q == 3 || q == 5 || q == 6 || q == 7); }
    else { ch = 0; k = 14 + (r - 2 * STEPS_CHUNK); bar = true; }
}
__global__ void __launch_bounds__(NTHR, 2) __attribute__((disable_tail_calls)) mega_fwd(Params p0_) {
    LAS unsigned char* lds = lds_at(0);
    const int tid = threadIdx.x;
    volatile LAS unsigned* xbw = (volatile LAS unsigned*)(lds + LDS_MISC);
    volatile LAS int* st = (volatile LAS int*)(lds + LDS_MISC + 176);
    if (tid == 0) { xbw[0] = 0u; xbw[1] = 0u; xbw[2] = 0u; xbw[3] = 0u; st[0] = p0_.ph_lo; st[1] = p0_.ph_hi; st[2] = blockIdx.x; st[3] = 0; *(volatile LAS unsigned*)(lds + LDS_MISC + 192) = 0u; }
    ptab_store(p0_, tid);
    __syncthreads();
    (void)xcd_barrier_post((unsigned*)(p0_.ws + WS_CTL) + CW_BAR, xbw, tid);
    for (;;) {
        {
          LAS unsigned char* mb_ = lds_at(LDS_MISC); volatile LAS int* st_ = (volatile LAS int*)(mb_ + 176);
          const int s = __builtin_amdgcn_readfirstlane(st_[0]), e = __builtin_amdgcn_readfirstlane(st_[1]);
          if (s >= e) break;
          int k, l, ch; bool bar; step_decode(s, k, l, ch, bar);
          switch (k) {
          case 0: ph_p0(); break;
          case 1: ph_p1(); break;
          case 2: ph_a1(); break;
          case 3: ph_a2a(); break;
          case 4: ph_a2b(); break;
          case 5: ph_a2c(); break;
          case 6: ph_a2d(); break;
          case 7: ph_a3a(); break;
          case 8: ph_a3b(); break;
          case 9: ph_a3c(); break;
          case 10: ph_a3d(); break;
          case 11: ph_a5(); break;
          case 12: ph_a6(); break;
          case 13: ph_a7(); break;
          case 14: ph_b0(); break;
          case 15: ph_b1(); break;
          case 16: ph_b2(); break;
          default: ph_b3(); break;
          } }
        { const int tid = fresh_tid(); LAS unsigned char* mb_ = lds_at(LDS_MISC); volatile LAS int* st_ = (volatile LAS int*)(mb_ + 176);
          volatile LAS unsigned* xbw_ = (volatile LAS unsigned*)mb_;
          const int s = __builtin_amdgcn_readfirstlane(st_[0]), e = __builtin_amdgcn_readfirstlane(st_[1]);
          int k, l, ch; bool bar; step_decode(s, k, l, ch, bar);
#ifdef DUP_MASK
          const bool adv_ = !(((DUP_MASK >> k) & 1) && __builtin_amdgcn_readfirstlane(st_[3]) == 0);
#else
          const bool adv_ = true;
#endif
          if (adv_ && bar && s + 1 < e) { XcdBarrier b; b.bar = (unsigned*)((unsigned char*)ptab_get(28) + WS_CTL) + CW_BAR; b.x = xb_xcc_id(); b.st = xbw_; xcd_barrier(b, tid); }
          __syncthreads();
#ifdef DUP_MASK
          const int rp = __builtin_amdgcn_readfirstlane(st_[3]);
          if (((DUP_MASK >> k) & 1) && rp == 0) { if (tid == 0) st_[3] = 1; }
          else { if (tid == 0) { st_[3] = 0; st_[0] = s + 1; } }
#else
          if (tid == 0) st_[0] = s + 1;
#endif
          __syncthreads(); }
    }
}

extern "C" void kernel_launch(void* const* d_in, const int* in_sizes, int n_in, void* d_out, int out_size, void* d_ws, size_t ws_size, hipStream_t stream) {
    (void)in_sizes; (void)out_size;
    if (n_in < 27 || ws_size < WS_END) { fprintf(stderr, "kernel_launch: unexpected inputs (n_in %d, ws %zu < %zu)\n", n_in, ws_size, (size_t)WS_END); return; }
    static bool attr_set = false;
    if (!attr_set) { (void)hipFuncSetAttribute((const void*)mega_fwd, hipFuncAttributeMaxDynamicSharedMemorySize, LDS_BYTES); attr_set = true; }
    Params p{};
    for (int i = 0; i < 27; ++i) p.in[i] = (const float*)d_in[i];
    p.out = (float*)d_out; p.ws = (unsigned char*)d_ws;
    (void)hipMemsetAsync((unsigned char*)d_ws + WS_CTL, 0, CTL_BYTES, stream);
#ifndef MK_CUTS
    p.ph_lo = 0; p.ph_hi = N_STEPS;
    hipLaunchKernelGGL(mega_fwd, dim3(NWG), dim3(NTHR), LDS_BYTES, stream, p);
#else
    { static const int cuts[] = {MK_CUTS, N_STEPS}; int lo = 0;
      for (unsigned i = 0; i < sizeof(cuts) / sizeof(cuts[0]); ++i) { p.ph_lo = lo; p.ph_hi = cuts[i]; lo = cuts[i]; hipLaunchKernelGGL(mega_fwd, dim3(NWG), dim3(NTHR), LDS_BYTES, stream, p); } }
#endif
}
```

```cpp
#include <hip/hip_runtime.h>
#include <stdint.h>
#include <stdio.h>

#define GAS __attribute__((address_space(1)))
#define LAS __attribute__((address_space(3)))
typedef unsigned short bf16_t;
typedef short bf16x8 __attribute__((ext_vector_type(8)));
typedef short s16x4 __attribute__((ext_vector_type(4)));
typedef float f32x2 __attribute__((ext_vector_type(2)));
typedef float f32x4 __attribute__((ext_vector_type(4)));
typedef float f32x16 __attribute__((ext_vector_type(16)));
typedef unsigned u32x2 __attribute__((ext_vector_type(2)));
typedef unsigned u32x4 __attribute__((ext_vector_type(4)));
typedef __bf16 bf16x2_t __attribute__((ext_vector_type(2)));

constexpr int D_MODEL = 1024, BATCH = 16, SEQ = 4096, DEPTH = 2, MTOK = BATCH * SEQ;
constexpr int NCHUNK = 2, BC = BATCH / NCHUNK, MC = BC * SEQ;
constexpr int NPROJ = 3584, PROJW = 3072;
constexpr float DN_ALPHA = 1.4142135623730951f;
constexpr float LN_EPS = 1e-5f;
constexpr float LOG2E = 1.4426950408889634f;
constexpr float QSCALE = 0.125f * 1.4426950408889634f;
constexpr int NWG = 256, NTHR = 512;
constexpr int LDS_BYTES = 163840;

constexpr int PC_GQ = 0, PC_GK = 256, PC_GV = 512, PC_GZ = 768, PC_RQ = 1024, PC_RK = 1280, PC_RV = 1536, PC_RG = 1792, PC_NQ = 2048, PC_FQ = 2304, PC_FK = 2560, PC_FV = 2816;

constexpr size_t MiB = 1ull << 20;
constexpr size_t WS_CTL = 0;
constexpr size_t CTL_BYTES = 1 * MiB;
constexpr size_t WS_MOD = 1 * MiB;
constexpr size_t WS_ROPE = 2 * MiB;
constexpr size_t WS_STATS = 18 * MiB;
constexpr size_t WS_CBIAS = 19 * MiB;
constexpr size_t WS_W = 20 * MiB;
constexpr size_t LW_WIN = 0;
constexpr size_t LW_WGV = LW_WIN + (size_t)NPROJ * 1024 * 2;
constexpr size_t LW_BPT = LW_WGV + (size_t)4096 * 1024 * 2;
constexpr size_t LW_WOT = LW_BPT + (size_t)4096 * 256 * 2;
constexpr size_t LW_W13 = LW_WOT + (size_t)1024 * 1024 * 2;
constexpr size_t LW_W2 = LW_W13 + (size_t)16 * 1024 * 1024 * 2;
constexpr size_t LW_CW1 = LW_W2 + (size_t)16 * 1024 * 512 * 2;
constexpr size_t LW_CW2 = LW_CW1 + (size_t)2 * 256 * 2048 * 2;
constexpr size_t LW_BYTES = LW_CW2 + (size_t)2 * 256 * 256 * 2;
constexpr size_t WS_H = WS_W + 2 * ((LW_BYTES + MiB - 1) / MiB) * MiB;
constexpr size_t WS_R = WS_H + 128 * MiB;
constexpr size_t R_PROJ = 0;
constexpr size_t R_GDN = R_PROJ + (size_t)MC * PROJW * 2;
constexpr size_t GDN_UNIT_BYTES = 5 * 8192;
constexpr size_t R_P = 0;
constexpr size_t R_NKV = R_GDN + (size_t)BC * 4 * 64 * GDN_UNIT_BYTES;
constexpr size_t NKV_SEG = (size_t)(MC + 64) * 64 * 2;
constexpr size_t R_SM = R_NKV + 6 * NKV_SEG;
constexpr size_t R_CUM = R_SM + (size_t)MC * 32 * 4;
constexpr size_t R_GG = R_CUM + (size_t)BC * 4 * 4096 * 4;
constexpr size_t R_KCMP = R_GG + (size_t)BC * 4 * 64 * 4 + 768;
constexpr size_t R_H1 = R_KCMP + (size_t)2 * BC * 256 * 64 * 2;
constexpr size_t R_O = R_H1 + (size_t)2 * BC * 256 * 256 * 2;
constexpr size_t R_Y = R_O + (size_t)4 * MC * 256 * 2;
constexpr size_t R_KVT = R_Y + (size_t)MC * 1024 * 2;
constexpr size_t R_MIX_END = R_KVT + (size_t)BC * 4 * 32 * 4096 * 4;
static_assert(R_NKV >= (size_t)MC * 4096 * 2, "P overlay fits under PROJ+GDN");
constexpr size_t R_LIST = 0;
constexpr size_t R_CW = R_LIST + (size_t)16 * MTOK * 4;
constexpr size_t R_HID = R_CW + (size_t)16 * MTOK * 4;
constexpr size_t R_OUT2 = R_HID + (size_t)(2 * MTOK + 4096) * 512 * 2;
constexpr size_t R_MOE_END = R_OUT2 + (size_t)2 * MTOK * 1024 * 2;
constexpr size_t WS_T = WS_R + (((R_MIX_END > R_MOE_END ? R_MIX_END : R_MOE_END) + MiB - 1) / MiB) * MiB;
constexpr size_t WS_END = WS_T + (size_t)MTOK * 1024 * 2;

constexpr int CW_BAR = 4096;
constexpr int CW_CNT = 8192;
constexpr int CW_Q = 8448;

__device__ __forceinline__ float bf2f(bf16_t v) { return __uint_as_float(((unsigned)v) << 16); }
__device__ __forceinline__ unsigned pk2(float lo, float hi) { f32x2 v = {lo, hi}; bf16x2_t b = __builtin_convertvector(v, bf16x2_t); return __builtin_bit_cast(unsigned, b); }
__device__ __forceinline__ bf16_t f2bf(float f) { return (bf16_t)(pk2(f, 0.f) & 0xffffu); }
__device__ __forceinline__ float ex2(float x) { return __builtin_amdgcn_exp2f(x); }
__device__ __forceinline__ float sigmoidf_(float x) { return __builtin_amdgcn_rcpf(1.0f + __expf(-x)); }
__device__ __forceinline__ float siluf_(float x) { return x * __builtin_amdgcn_rcpf(1.0f + __expf(-x)); }
__device__ __forceinline__ int crow(int r, int hi) { return (r & 3) + 8 * (r >> 2) + 4 * hi; }
__device__ __forceinline__ float wave_sum(float v) {
#pragma unroll
    for (int o = 32; o >= 1; o >>= 1) v += __shfl_xor(v, o);
    return v;
}
#define VM_WAIT() asm volatile("s_waitcnt vmcnt(0)" ::: "memory")
#define MF32(a, b, c) __builtin_amdgcn_mfma_f32_32x32x16_bf16(a, b, c, 0, 0, 0)

#define XB_TMO      128
#define XB_XCNT(j)  (256  + 64 * (j))
#define XB_XSUB(j)  (1280 + 64 * (j))
#define XB_XGEN(j)  (2304 + 64 * (j))
#define XB_TOP      3328
#define XB_TOPGEN   3392
#define XCD_BAR_WORDS 3456
#define XB_SPIN_CAP (1u << 22)

__device__ __forceinline__ unsigned xb_ld(unsigned* p)              { return __hip_atomic_load(p, __ATOMIC_RELAXED, __HIP_MEMORY_SCOPE_AGENT); }
__device__ __forceinline__ unsigned xb_add(unsigned* p, unsigned v) { return __hip_atomic_fetch_add(p, v, __ATOMIC_RELAXED, __HIP_MEMORY_SCOPE_AGENT); }
__device__ __forceinline__ unsigned xb_xcc_id() { return (unsigned)__builtin_amdgcn_s_getreg((3 << 11) | 20) & 0xFu; }
#define XB_SPIN(cond, bar) do { unsigned _sp = 0; while (cond) { __builtin_amdgcn_s_sleep(1); \
    if ((++_sp & 255u) == 0u) { if (xb_ld(&(bar)[XB_TMO])) break; if (_sp > XB_SPIN_CAP) { atomicAdd(&(bar)[XB_TMO], 1u); break; } } } } while (0)

struct XcdBarrier { unsigned* bar; unsigned x; volatile LAS unsigned* st; };

__device__ __forceinline__ XcdBarrier xcd_barrier_post(unsigned* bar, volatile LAS unsigned* st, int tid) {
    XcdBarrier b; b.bar = bar; b.x = xb_xcc_id(); b.st = st;
    if (tid == 0) (void)xb_add(&bar[XB_XCNT(b.x)], 1u);
    return b;
}
__device__ __forceinline__ void xcd_barrier_complete(unsigned* bar, unsigned x, unsigned& nloc, unsigned& nx) {
    const unsigned G = NWG;
    unsigned sum, cnt, mine, sp = 0u;
    for (;;) {
        sum = 0u; cnt = 0u; mine = 0u;
#pragma unroll
        for (unsigned j = 0; j < 16; ++j) { const unsigned c = xb_ld(&bar[XB_XCNT(j)]); sum += c; cnt += (c > 0u) ? 1u : 0u; mine = (j == x) ? c : mine; }
        if (sum == G) break;
        __builtin_amdgcn_s_sleep(1);
        if ((++sp & 255u) == 0u) { if (xb_ld(&bar[XB_TMO])) break; if (sp > XB_SPIN_CAP) { atomicAdd(&bar[XB_TMO], 1u); break; } }
    }
    nloc = mine > 0u ? mine : 1u; nx = cnt > 0u ? cnt : 1u;
}
__device__ __forceinline__ void xcd_barrier(const XcdBarrier& b, int tid) {
    asm volatile("s_waitcnt vmcnt(0)" ::: "memory");
    __syncthreads();
    if (tid == 0) {
        unsigned* bar = b.bar;
        __builtin_amdgcn_s_waitcnt(0);
        unsigned nloc = b.st[0], nx = b.st[1];
        if (nloc == 0u) { xcd_barrier_complete(bar, b.x, nloc, nx); b.st[0] = nloc; b.st[1] = nx; }
        const unsigned old = xb_add(&bar[XB_XSUB(b.x)], 1u);
        const unsigned gen = old / nloc;
        if (old + 1u == (gen + 1u) * nloc) {
            __builtin_amdgcn_fence(__ATOMIC_RELEASE, "agent");
            asm volatile("s_waitcnt vmcnt(0)" ::: "memory");
            const unsigned og = xb_add(&bar[XB_TOP], 1u);
            const unsigned tg = og / nx;
            if (og + 1u == (tg + 1u) * nx) xb_add(&bar[XB_TOPGEN], 1u);
            else XB_SPIN(xb_ld(&bar[XB_TOPGEN]) == tg, bar);
            __builtin_amdgcn_fence(__ATOMIC_ACQUIRE, "agent");
            xb_add(&bar[XB_XGEN(b.x)], 1u);
            asm volatile("s_waitcnt vmcnt(0)" ::: "memory");
        } else {
            XB_SPIN(xb_ld(&bar[XB_XGEN(b.x)]) == gen, bar);
            __builtin_amdgcn_fence(__ATOMIC_ACQUIRE, "agent");
            asm volatile("s_waitcnt vmcnt(0)" ::: "memory");
        }
    }
    __syncthreads();
}

struct Params {
    const float* in[27];
    float* out;
    unsigned char* ws;
    int ph_lo, ph_hi;
};
__device__ __forceinline__ LAS unsigned char* lds_at(int off) { asm volatile("" : "+s"(off)); return (LAS unsigned char*)(unsigned)off; }
constexpr int LDS_PTAB = LDS_BYTES - 512;
__device__ __forceinline__ void ptab_store(const Params& p, int tid) {
    LAS unsigned long long* t = (LAS unsigned long long*)lds_at(LDS_PTAB);
    if (tid == 0) {
#pragma unroll
        for (int i = 0; i < 27; ++i) t[i] = (unsigned long long)p.in[i];
        t[27] = (unsigned long long)p.out; t[28] = (unsigned long long)p.ws; }
}
__device__ __forceinline__ unsigned long long ptab_get(int i) {
    const LAS unsigned* t = (const LAS unsigned*)lds_at(LDS_PTAB) + 2 * i;
    const unsigned lo = __builtin_amdgcn_readfirstlane(t[0]), hi = __builtin_amdgcn_readfirstlane(t[1]);
    return ((unsigned long long)hi << 32) | lo;
}
__device__ __forceinline__ unsigned char* ws_late() { return (unsigned char*)ptab_get(28); }
#define PIN(i) ((const float*)ptab_get(i))
__device__ __forceinline__ void ptab_load(Params& q) {
    asm volatile("" ::: "memory");
#pragma unroll
    for (int i = 0; i < 27; ++i) q.in[i] = (const float*)ptab_get(i);
    q.out = (float*)ptab_get(27); q.ws = (unsigned char*)ptab_get(28); q.ph_lo = 0; q.ph_hi = 0;
}

namespace pg8 {
constexpr int BM = 256, BK = 64, HALF = 128, HTB = HALF * BK * 2, NXCD = 8, WGM = 8;
__device__ __forceinline__ int lds_byte(int r, int c) { const int st = (r >> 4) * 2 + (c >> 5), rr = r & 15, cc = c & 31, ob = rr * 64 + cc * 2; return st * 1024 + (ob ^ (((ob >> 9) & 1) << 5)); }
__device__ __forceinline__ void stage_rc(int b, int& R, int& C) { const int st = b / 1024, sb = b % 1024, swz = sb ^ (((sb >> 9) & 1) << 5); R = (st >> 1) * 16 + swz / 64; C = (st & 1) * 32 + (swz % 64) / 2; }
__device__ __forceinline__ int perm32(int rho) { const int n = rho >> 4, i = rho & 15; return 8 * (i >> 2) + 4 * n + (i & 3); }

struct Unit { unsigned a, b, rows; int pm, pn, aux, nvalid; };

__device__ __forceinline__ bool dense_unit(int i, int G, int c, int nM, int nN, int& pm, int& pn) {
    const int nwg = nM * nN; const long L = (long)i * G + c; if (L >= nwg) return false;
    int wgid = (int)L; { const int q = nwg / NXCD, r = nwg % NXCD, xcd = wgid % NXCD, off = wgid / NXCD; wgid = (xcd < r ? xcd * (q + 1) : r * (q + 1) + (xcd - r) * q) + off; }
    const int nig = WGM * nN, gid = wgid / nig, fm = gid * WGM, gsz = (nM - fm) < WGM ? (nM - fm) : WGM;
    pm = fm + ((wgid % nig) % gsz); pn = (wgid % nig) / gsz; return true;
}

template <class Epi, class Sched, bool ALIGN_EPI, bool GATHER>
__device__ __forceinline__ void gemm_phase(LAS unsigned char* lds, const int K, const int lda, const int ldb, const Sched& S, const Epi& E, const int tid, const char* wsb) {
    const int wid = __builtin_amdgcn_readfirstlane(tid >> 6), lane = tid & 63, wr = wid >> 2, wc = wid & 3, fr = lane & 15, fq = lane >> 4;
    const int nt = K / BK;
    unsigned voffA[2], voffB[2]; int rA[2], cA2[2];
#pragma unroll
    for (int i = 0; i < 2; ++i) { int R, C; stage_rc(tid * 16 + i * 8192, R, C); const int Rb = Epi::PERM ? ((R & ~31) + perm32(R & 31)) : R;
        rA[i] = R; cA2[i] = C * 2; voffA[i] = (unsigned)(R * lda + C) * 2u; voffB[i] = (unsigned)(Rb * ldb + C) * 2u; }
    const unsigned kstep = (unsigned)(BK * 2);
    const unsigned hstepA = GATHER ? 0u : (unsigned)(HALF * lda * 2), hstepB = (unsigned)(HALF * ldb * 2);
    const unsigned ldsw = (unsigned)wid * 1024u;
    const int aoff = lds_byte(wr * 64 + fr, fq * 8), boff = lds_byte(wc * 32 + fr, fq * 8);
#define PG8_SA(b, h) (((b) * 2 + (h)) * HTB)
#define PG8_SB(b, h) ((4 + (b) * 2 + (h)) * HTB)
#define PG8_STAGE(bufoff, gbase, voff) do { _Pragma("unroll") for (int _i = 0; _i < 2; ++_i) \
        __builtin_amdgcn_global_load_lds((const unsigned*)(wsb + (size_t)(unsigned)((gbase) + (voff)[_i])), (LAS unsigned*)(lds + (bufoff) + ldsw + _i * 8192), 16, 0, 0); } while (0)
#define PG8_LDA(dst, b, h) do { _Pragma("unroll") for (int m = 0; m < 4; ++m) _Pragma("unroll") for (int k = 0; k < 2; ++k) dst[m][k] = *(const LAS bf16x8*)(lds + PG8_SA(b, h) + aoff + m * 2048 + k * 1024); } while (0)
#define PG8_LDB(dst, b, h) do { _Pragma("unroll") for (int n = 0; n < 2; ++n) _Pragma("unroll") for (int k = 0; k < 2; ++k) dst[n][k] = *(const LAS bf16x8*)(lds + PG8_SB(b, h) + boff + n * 2048 + k * 1024); } while (0)
#define PG8_MMA(ai, bj, At, Bt) do { __builtin_amdgcn_s_setprio(1); _Pragma("unroll") for (int m = 0; m < 4; ++m) _Pragma("unroll") for (int n = 0; n < 2; ++n) _Pragma("unroll") for (int k = 0; k < 2; ++k) \
        acc[ai][bj][m][n] = __builtin_amdgcn_mfma_f32_16x16x32_bf16(Bt[n][k], At[m][k], acc[ai][bj][m][n], 0, 0, 0); __builtin_amdgcn_s_setprio(0); } while (0)
#define PG8_WAIT_V(n) asm volatile("s_waitcnt vmcnt(" #n ")" ::: "memory")
#define PG8_WAIT_L(n) asm volatile("s_waitcnt lgkmcnt(" #n ")" ::: "memory")
#define PG8_BAR __builtin_amdgcn_s_barrier()
#define PG8_SCHED __builtin_amdgcn_sched_barrier(0)
    Unit cur, nxt; int ui = 0;
    if (!S.next(0, cur)) return;
    f32x4 acc[2][2][4][2];
#pragma unroll
    for (int a = 0; a < 2; ++a)
#pragma unroll
        for (int b = 0; b < 2; ++b)
#pragma unroll
            for (int m = 0; m < 4; ++m)
#pragma unroll
                for (int n = 0; n < 2; ++n) acc[a][b][m][n] = (f32x4){0.f, 0.f, 0.f, 0.f};
    bf16x8 At[4][2], B0[2][2], B1[2][2];
    unsigned cA = cur.a, cB = cur.b;
    LAS unsigned* grec = (LAS unsigned*)(lds + 131072) + tid * 8;
    if constexpr (GATHER) {
#pragma unroll
        for (int i = 0; i < 2; ++i) { const unsigned o0 = (unsigned)S.row(cur, rA[i]) * (unsigned)(lda * 2) + cA2[i], o1 = (unsigned)S.row(cur, HALF + rA[i]) * (unsigned)(lda * 2) + cA2[i];
            grec[i] = o0; grec[2 + i] = o1; grec[4 + i] = o0; grec[6 + i] = o1; }
    }
#define PG8_STAGE_A(bufoff, kptr, h, usenext) do { if constexpr (GATHER) { const u32x2 _w = *(const LAS u32x2*)(grec + ((usenext) ? 4 : 0) + 2 * (h)); unsigned _v[2]; _v[0] = _w.x; _v[1] = _w.y; PG8_STAGE(bufoff, kptr, _v); } \
        else { PG8_STAGE(bufoff, (kptr) + (h) * hstepA, voffA); } } while (0)
    PG8_STAGE(PG8_SB(0, 0), cB, voffB); PG8_STAGE(PG8_SB(0, 1), cB + hstepB, voffB); PG8_STAGE_A(PG8_SA(0, 0), cA, 0, false); PG8_STAGE_A(PG8_SA(0, 1), cA, 1, false);
    if (wr == 1) PG8_BAR;
    PG8_WAIT_V(2); PG8_BAR;
    PG8_STAGE(PG8_SB(1, 0), cB + kstep, voffB); PG8_STAGE_A(PG8_SA(1, 0), cA + kstep, 0, false); PG8_STAGE(PG8_SB(1, 1), cB + hstepB + kstep, voffB);
    PG8_WAIT_V(6); PG8_BAR;
    for (;;) {
        const bool has_next = S.next(ui + 1, nxt);
        const unsigned nA = has_next ? nxt.a : cA, nB = has_next ? nxt.b : cB;
        for (int t = 0; t < nt; t += 2) {
            const bool last = (t == nt - 2);
            const unsigned a1 = cA + (unsigned)(t + 1) * kstep;
            const unsigned a2 = last ? nA : cA + (unsigned)(t + 2) * kstep, b2 = last ? nB : cB + (unsigned)(t + 2) * kstep;
            const unsigned a3 = a2 + kstep, b3 = b2 + kstep;
            if constexpr (GATHER) { if (last && has_next) {
#pragma unroll
                for (int i = 0; i < 2; ++i) { grec[4 + i] = (unsigned)S.row(nxt, rA[i]) * (unsigned)(lda * 2) + cA2[i]; grec[6 + i] = (unsigned)S.row(nxt, HALF + rA[i]) * (unsigned)(lda * 2) + cA2[i]; } } }
            PG8_LDB(B0, 0, 0); PG8_LDB(B1, 0, 1); PG8_SCHED; PG8_LDA(At, 0, 0); PG8_STAGE_A(PG8_SA(1, 1), a1, 1, false);
            PG8_WAIT_V(8); PG8_WAIT_L(0); PG8_BAR; PG8_MMA(0, 0, At, B0); PG8_MMA(0, 1, At, B1); PG8_BAR; PG8_SCHED;
            PG8_LDA(At, 0, 1); PG8_STAGE(PG8_SB(0, 0), b2, voffB); PG8_STAGE(PG8_SB(0, 1), b2 + hstepB, voffB); PG8_STAGE_A(PG8_SA(0, 0), a2, 0, last);
            PG8_WAIT_V(8); PG8_WAIT_L(0); PG8_BAR; PG8_MMA(1, 0, At, B0); PG8_MMA(1, 1, At, B1); PG8_BAR; PG8_SCHED;
            PG8_LDB(B0, 1, 0); PG8_LDB(B1, 1, 1); PG8_SCHED; PG8_LDA(At, 1, 0); PG8_STAGE_A(PG8_SA(0, 1), a2, 1, last);
            PG8_WAIT_V(8); PG8_WAIT_L(0); PG8_BAR; PG8_MMA(0, 0, At, B0); PG8_MMA(0, 1, At, B1); PG8_BAR; PG8_SCHED;
            PG8_LDA(At, 1, 1); PG8_STAGE(PG8_SB(1, 0), b3, voffB); PG8_STAGE(PG8_SB(1, 1), b3 + hstepB, voffB); PG8_STAGE_A(PG8_SA(1, 0), a3, 0, last);
            PG8_WAIT_V(8); PG8_WAIT_L(0); PG8_BAR; PG8_MMA(1, 0, At, B0); PG8_MMA(1, 1, At, B1); PG8_BAR; PG8_SCHED;
        }
        if constexpr (ALIGN_EPI) { if (wr == 0) PG8_BAR; }
        { int tz = tid; asm volatile("" : "+v"(tz)); const int ew = __builtin_amdgcn_readfirstlane(tz >> 6), el = tz & 63;
          E(acc, cur, ew >> 2, ew & 3, el & 15, el >> 4); }
        if (!has_next) break;
#pragma unroll
        for (int a = 0; a < 2; ++a)
#pragma unroll
            for (int b = 0; b < 2; ++b)
#pragma unroll
                for (int m = 0; m < 4; ++m)
#pragma unroll
                    for (int n = 0; n < 2; ++n) acc[a][b][m][n] = (f32x4){0.f, 0.f, 0.f, 0.f};
        cur = nxt; cA = nA; cB = nB; ++ui;
        if constexpr (GATHER) { const u32x4 _n = *(const LAS u32x4*)(grec + 4); *(LAS u32x4*)grec = _n; }
        if constexpr (ALIGN_EPI) { if (wr == 1) PG8_BAR; }
    }
    PG8_WAIT_V(0);
    if constexpr (!ALIGN_EPI) { if (wr == 0) PG8_BAR; }
    PG8_BAR;
#undef PG8_SA
#undef PG8_SB
#undef PG8_STAGE
#undef PG8_STAGE_A
#undef PG8_LDA
#undef PG8_LDB
#undef PG8_MMA
#undef PG8_WAIT_V
#undef PG8_WAIT_L
#undef PG8_BAR
#undef PG8_SCHED
}
}
using pg8::Unit;

struct DenseSched {
    unsigned A, Bt, tA, tB, aBr; int nM, nN, G, c, pnShift;
    __device__ __forceinline__ bool next(int i, Unit& u) const {
        int pm, pn; if (!pg8::dense_unit(i, G, c, nM, nN, pm, pn)) return false;
        u.pm = pm; u.pn = pn; u.aux = 0; u.nvalid = 256; u.rows = 0u;
        u.a = A + (unsigned)(pn >> pnShift) * aBr + (unsigned)pm * tA; u.b = Bt + (unsigned)pn * tB; return true;
    }
    __device__ __forceinline__ int row(const Unit&, int) const { return 0; }
};
struct OneSched {
    Unit u0; bool has;
    __device__ __forceinline__ bool next(int i, Unit& u) const { if (i > 0 || !has) return false; u = u0; return true; }
    __device__ __forceinline__ int row(const Unit&, int) const { return 0; }
};
struct MoeSched {
    const LAS int* pre;
    const LAS int* cnt;
    const char* wsb;
    unsigned A, W, wE, wT, aT; int G, c; bool gatherA;
    __device__ __forceinline__ bool next(int i, Unit& u) const {
        const long L = (long)i * G + c; const int total = pre[16] * 4; if (L >= total) return false;
        const int t = (int)(L >> 2), pn = (int)(L & 3); int e = 0;
#pragma unroll
        for (int j = 1; j < 16; ++j) e += (pre[j] <= t) ? 1 : 0;
        const int pm = t - pre[e];
        u.aux = e; u.pm = t; u.pn = pn; u.nvalid = min(256, cnt[e] - 256 * pm); u.rows = (unsigned)(WS_R + R_LIST) + (unsigned)(e * MTOK + 256 * pm) * 4u;
        u.a = gatherA ? A : A + (unsigned)t * aT; u.b = W + (unsigned)e * wE + (unsigned)pn * wT; return true;
    }
    __device__ __forceinline__ int row(const Unit& u, int R) const { return (R < u.nvalid) ? (((const int*)(wsb + u.rows))[R] >> 1) : 0; }
};

typedef f32x4 Acc[2][2][4][2];
#define EPI_LOOP_AIM _Pragma("unroll") for (int ai = 0; ai < 2; ++ai) _Pragma("unroll") for (int m = 0; m < 4; ++m)
__device__ __forceinline__ u32x4 pack8(const f32x4& a, const f32x4& b) { u32x4 w; w.x = pk2(a[0], a[1]); w.y = pk2(a[2], a[3]); w.z = pk2(b[0], b[1]); w.w = pk2(b[2], b[3]); return w; }

struct EpiProj {
    static constexpr bool PERM = true;
    __device__ __forceinline__ void operator()(const Acc& acc, const Unit& u, int wr, int wc, int fr, int fq) const {
        unsigned char* ws = ws_late(); bf16_t* proj = (bf16_t*)(ws + WS_R + R_PROJ); bf16_t* nkv = (bf16_t*)(ws + WS_R + R_NKV); float* sm = (float*)(ws + WS_R + R_SM);
        const int row0 = u.pm * 256 + wr * 64 + fr;
        if (u.pn < 12) {
            const float sc = (u.pn == 8 || u.pn == 9) ? QSCALE : (u.pn == 5 ? 0.125f : 1.0f);
            const int col0 = u.pn * 256 + wc * 32 + 8 * fq;
            EPI_LOOP_AIM { bf16_t* rp = proj + (size_t)(row0 + ai * 128 + m * 16) * PROJW + col0;
#pragma unroll
                for (int bj = 0; bj < 2; ++bj) *(u32x4*)(rp + bj * 128) = pack8(acc[ai][bj][m][0] * sc, acc[ai][bj][m][1] * sc); }
        } else {
#pragma unroll
            for (int bj = 0; bj < 2; ++bj) {
                if (u.pn == 12 || bj == 0) {
                    const int seg = (u.pn - 12) * 4 + bj * 2 + (wc >> 1), col = 32 * (wc & 1) + 8 * fq;
                    bf16_t* base = nkv + (size_t)seg * (NKV_SEG / 2) + col;
                    EPI_LOOP_AIM { *(u32x4*)(base + (size_t)(row0 + ai * 128 + m * 16) * 64) = pack8(acc[ai][bj][m][0], acc[ai][bj][m][1]); }
                } else if (wc == 0 && fq < 3) {
                    EPI_LOOP_AIM { float* sp = sm + (size_t)(row0 + ai * 128 + m * 16) * 32 + 8 * fq; *(f32x4*)sp = acc[ai][bj][m][0]; *(f32x4*)(sp + 4) = acc[ai][bj][m][1]; }
                }
            }
        }
    }
};
struct EpiH1 {
    static constexpr bool PERM = true;
    bf16_t* h1; const float* cbias;
    __device__ __forceinline__ void operator()(const Acc& acc, const Unit& u, int wr, int wc, int fr, int fq) const {
        const int which = u.aux, rl0 = wr * 64 + fr;
        bf16_t* base = h1 + ((size_t)which * BC * 256 + (size_t)u.pm * 256) * 256;
        const float* bp = cbias + which * 256;
#pragma unroll
        for (int bj = 0; bj < 2; ++bj) { const int col = bj * 128 + wc * 32 + 8 * fq; const f32x4 b0 = *(const f32x4*)(bp + col), b1 = *(const f32x4*)(bp + col + 4);
            EPI_LOOP_AIM { const int rl = rl0 + ai * 128 + m * 16; f32x4 v0 = acc[ai][bj][m][0] + b0, v1 = acc[ai][bj][m][1] + b1;
#pragma unroll
                for (int e = 0; e < 4; ++e) { v0[e] = (rl < 255) ? siluf_(v0[e]) : 0.f; v1[e] = (rl < 255) ? siluf_(v1[e]) : 0.f; }
                *(u32x4*)(base + (size_t)rl * 256 + col) = pack8(v0, v1); } }
    }
};
struct EpiCmp2 {
    static constexpr bool PERM = true;
    bf16_t* kc;
    __device__ __forceinline__ void operator()(const Acc& acc, const Unit& u, int wr, int wc, int fr, int fq) const {
        if (wc >= 2) return;
        const int col = wc * 32 + 8 * fq; bf16_t* base = kc + ((size_t)u.aux * BC + u.pm) * 256 * 64 + col;
        EPI_LOOP_AIM { const int rl = wr * 64 + fr + ai * 128 + m * 16; *(u32x4*)(base + (size_t)rl * 64) = pack8(acc[ai][0][m][0], acc[ai][0][m][1]); }
    }
};
struct EpiP {
    static constexpr bool PERM = true;
    __device__ __forceinline__ void operator()(const Acc& acc, const Unit& u, int wr, int wc, int fr, int fq) const {
        bf16_t* P = (bf16_t*)(ws_late() + WS_R + R_P);
        const int i = u.pn >> 2, pt = u.pn & 3, row0 = u.pm * 256 + wr * 64 + fr;
#pragma unroll
        for (int bj = 0; bj < 2; ++bj)
#pragma unroll
            for (int n = 0; n < 2; ++n) {
                const int png = 4 * pt + 2 * bj + (wc >> 1), wcg = 2 * (wc & 1) + (fq >> 1), fqg = 2 * (fq & 1) + n;
                const int vcol = 256 * png + 128 * (i >> 1) + 32 * wcg + 8 * fqg + 4 * (i & 1);
                EPI_LOOP_AIM { const f32x4 v = acc[ai][bj][m][n]; u32x2 w; w.x = pk2(v[0], v[1]); w.y = pk2(v[2], v[3]);
                    *(u32x2*)(P + (unsigned)((row0 + ai * 128 + m * 16) * 4096 + vcol)) = w; }
            }
    }
};
struct EpiGate {
    static constexpr bool PERM = true;
    __device__ __forceinline__ void operator()(const Acc& acc, const Unit& u, int wr, int wc, int fr, int fq) const {
        unsigned char* ws = ws_late(); const bf16_t* P = (const bf16_t*)(ws + WS_R + R_P); bf16_t* y = (bf16_t*)(ws + WS_R + R_Y);
        const int row0 = u.pm * 256 + wr * 64 + fr, vc = 256 * u.pn + 32 * wc + 8 * fq, oc = 64 * u.pn + 16 * wc + 4 * fq;
        u32x4 pw[2][4][2];
        EPI_LOOP_AIM { const unsigned r = (unsigned)(row0 + ai * 128 + m * 16);
#pragma unroll
            for (int bj = 0; bj < 2; ++bj) pw[ai][m][bj] = *(const u32x4*)(P + (r * 4096u + (unsigned)(vc + 128 * bj))); }
        EPI_LOOP_AIM { const unsigned r = (unsigned)(row0 + ai * 128 + m * 16);
            f32x4 s = {0.f, 0.f, 0.f, 0.f};
#pragma unroll
            for (int bj = 0; bj < 2; ++bj) { const u32x4 pq = pw[ai][m][bj];
#pragma unroll
                for (int n = 0; n < 2; ++n) { const unsigned w0 = n ? pq.z : pq.x, w1 = n ? pq.w : pq.y; const f32x4 a = acc[ai][bj][m][n];
                    s[0] += sigmoidf_(a[0]) * __uint_as_float(w0 << 16); s[1] += sigmoidf_(a[1]) * __uint_as_float(w0 & 0xffff0000u);
                    s[2] += sigmoidf_(a[2]) * __uint_as_float(w1 << 16); s[3] += sigmoidf_(a[3]) * __uint_as_float(w1 & 0xffff0000u); } }
            u32x2 w; w.x = pk2(s[0], s[1]); w.y = pk2(s[2], s[3]); *(u32x2*)(y + (r * 1024u + (unsigned)oc)) = w; }
    }
};
struct EpiOut {
    static constexpr bool PERM = true;
    int row_base;
    __device__ __forceinline__ void operator()(const Acc& acc, const Unit& u, int wr, int wc, int fr, int fq) const {
        bf16_t* T = (bf16_t*)(ws_late() + WS_T);
        const int rg0 = row_base + u.pm * 256 + wr * 64 + fr, col0 = u.pn * 256 + wc * 32 + 8 * fq;
        EPI_LOOP_AIM { bf16_t* rp = T + (size_t)(rg0 + ai * 128 + m * 16) * 1024 + col0;
#pragma unroll
            for (int bj = 0; bj < 2; ++bj) *(u32x4*)(rp + bj * 128) = pack8(acc[ai][bj][m][0], acc[ai][bj][m][1]); }
    }
};
struct EpiMoe1 {
    static constexpr bool PERM = true;
    __device__ __forceinline__ void operator()(const Acc& acc, const Unit& u, int wr, int wc, int fr, int fq) const {
        const int rl0 = wr * 64 + fr, f0 = 128 * u.pn + 32 * wc + 8 * fq;
        bf16_t* hid = (bf16_t*)(ws_late() + WS_R + R_HID);
        EPI_LOOP_AIM { const int rl = rl0 + ai * 128 + m * 16;
            f32x4 a0 = acc[ai][0][m][0], a1 = acc[ai][0][m][1]; const f32x4 b0 = acc[ai][1][m][0], b1 = acc[ai][1][m][1];
#pragma unroll
            for (int e = 0; e < 4; ++e) { a0[e] = siluf_(a0[e]) * b0[e]; a1[e] = siluf_(a1[e]) * b1[e]; }
            *(u32x4*)(hid + (unsigned)((u.pm * 256 + rl) * 512 + f0)) = pack8(a0, a1); __builtin_amdgcn_sched_barrier(0); }
    }
};
struct EpiMoe2 {
    static constexpr bool PERM = true;
    __device__ __forceinline__ void operator()(const Acc& acc, const Unit& u, int wr, int wc, int fr, int fq) const {
        unsigned char* ws = ws_late(); bf16_t* out2 = (bf16_t*)(ws + WS_R + R_OUT2);
        const float* cwb = (const float*)(ws + (R_CW - R_LIST) + u.rows); const int* rws = (const int*)(ws + u.rows);
        const int rl0 = wr * 64 + fr, c0 = 256 * u.pn + 32 * wc + 8 * fq;
        EPI_LOOP_AIM { const int rl = rl0 + ai * 128 + m * 16;
            if (rl < u.nvalid) { const unsigned v = (unsigned)rws[rl]; const float wgt = cwb[rl]; bf16_t* rp = out2 + (size_t)v * 1024 + c0;
#pragma unroll
                for (int bj = 0; bj < 2; ++bj) *(u32x4*)(rp + bj * 128) = pack8(acc[ai][bj][m][0] * wgt, acc[ai][bj][m][1] * wgt); } }
    }
};

enum { IN_X = 0, IN_C, IN_POS, IN_ADAW, IN_ADAB, IN_WIN, IN_CONVW, IN_ALOG, IN_DTB, IN_GNORM, IN_RETGN, IN_PE, IN_CKW1, IN_CKW2, IN_CVW1, IN_CVW2, IN_FBIAS,
       IN_BP, IN_WG, IN_WO, IN_LNG, IN_LNB, IN_RW, IN_RB, IN_EW1, IN_EW3, IN_EW2 };

__device__ __forceinline__ void p0_ada(const Params& p, int item, LAS float* lf, const int tid) {
    LAS float* sc = lf; LAS float* red = lf + 16384;
    const float* c = PIN(IN_C);
    for (int i = tid; i < 16384; i += NTHR) sc[i] = siluf_(c[i]);
    __syncthreads();
    const int ls = item / 48, cb = item % 48, col = cb * 64 + (tid & 63), ks = tid >> 6;
    const float* w = PIN(IN_ADAW) + (size_t)ls * 1024 * 3072 + col;
    float acc[16];
#pragma unroll
    for (int b = 0; b < 16; ++b) acc[b] = 0.f;
    for (int k = ks * 128; k < ks * 128 + 128; ++k) { const float wv = w[(size_t)k * 3072];
#pragma unroll
        for (int b = 0; b < 16; ++b) acc[b] += sc[b * 1024 + k] * wv; }
#pragma unroll
    for (int b = 0; b < 16; ++b) red[(ks * 16 + b) * 64 + (tid & 63)] = acc[b];
    __syncthreads();
    float* mod = (float*)(p.ws + WS_MOD);
    for (int o = tid; o < 1024; o += NTHR) { const int b = o >> 6, cc = o & 63; float s = 0.f;
#pragma unroll
        for (int q = 0; q < 8; ++q) s += red[(q * 16 + b) * 64 + cc];
        mod[((size_t)ls * 16 + b) * 3072 + cb * 64 + cc] = s + PIN(IN_ADAB)[ls * 3072 + cb * 64 + cc]; }
    __syncthreads();
}
__device__ __forceinline__ void p0_rope(const Params& p, int item, const int tid) {
    const int* pos = (const int*)PIN(IN_POS); f32x2* tab = (f32x2*)(p.ws + WS_ROPE);
#pragma unroll
    for (int j = 0; j < 8; ++j) { const int idx = item * 4096 + j * 512 + tid; const int m = idx >> 5, i = idx & 31;
        const float inv = powf(10000.0f, -(float)i / 32.0f); const float ang = (float)pos[m] * inv;
        const float n = rintf(ang * 0.6366197723675814f);
        float r = fmaf(n, -1.5703125f, ang); r = fmaf(n, -4.837512969970703125e-4f, r); r = fmaf(n, -7.54978995489188e-8f, r);
        const float s = sinf(r), cs = cosf(r); const int q = ((int)n) & 3;
        float so, co; if (q == 0) { so = s; co = cs; } else if (q == 1) { so = cs; co = -s; } else if (q == 2) { so = -s; co = -cs; } else { so = -cs; co = s; }
        tab[idx] = (f32x2){co, so}; }
}
__device__ __forceinline__ void p0_cbias(const Params& p, int item, const int tid) {
    const int l = item >> 1, which = item & 1;
    if (tid < 256) { const float* pe = PIN(IN_PE) + (size_t)l * 2048; const float* w1 = PIN(which ? IN_CVW1 : IN_CKW1) + (size_t)l * 2048 * 256 + tid;
        float s = 0.f; for (int k = 0; k < 2048; ++k) s += pe[k] * w1[(size_t)k * 256];
        ((float*)(p.ws + WS_CBIAS))[item * 256 + tid] = s; }
}
struct TJob { bf16_t* dst; int K, nrt, nkt; };
constexpr int TJ_TILES[8] = {56 * 16, 64 * 16, 64 * 4, 16 * 16, 256 * 16, 256 * 8, 8 * 32, 8 * 4};
constexpr int TJ_TOTAL = 56 * 16 + 64 * 16 + 64 * 4 + 16 * 16 + 256 * 16 + 256 * 8 + 8 * 32 + 8 * 4;
__device__ __forceinline__ int win_src_col(int pc) {
    if (pc < 768) return pc;
    if (pc < 1024) return pc - 768 + 776;
    if (pc < 2048) return pc - 1024 + 1032;
    if (pc < 2304) return pc - 2048 + 2056;
    if (pc < 3072) return pc - 2304 + 2708;
    if (pc < 3456) return pc - 3072 + 2312;
    if (pc < 3464) return pc - 3456 + 768;
    if (pc < 3476) return pc - 3464 + 2696;
    if (pc < 3480) return pc - 3476 + 3476;
    return -1;
}
__device__ __forceinline__ const float* tj_src(const Params& p, int l, int job, int n, int& pitch) {
    switch (job) {
    case 0: { pitch = 3480; const int c = win_src_col(n); return c < 0 ? nullptr : PIN(IN_WIN) + (size_t)l * 1024 * 3480 + c; }
    case 1: { pitch = 1024; const int i = 2 * ((n >> 7) & 1) + ((n >> 2) & 1), c = 64 * (n >> 8) + 16 * ((n >> 5) & 3) + 4 * ((n >> 3) & 3) + (n & 3);
              return PIN(IN_WG) + ((size_t)l * 4 + i) * 1024 * 1024 + c; }
    case 2: { pitch = 1024; const int i = n >> 10, c = n & 1023; return PIN(IN_BP) + ((size_t)l * 4 + i) * 256 * 1024 + c; }
    case 3: { pitch = 1024; return PIN(IN_WO) + (size_t)l * 1024 * 1024 + n; }
    case 4: { pitch = 512; const int e = n >> 10, vr = n & 1023, f = 128 * (vr >> 8) + (vr & 127); return PIN(((vr >> 7) & 1) ? IN_EW3 : IN_EW1) + ((size_t)l * 16 + e) * 1024 * 512 + f; }
    case 5: { pitch = 1024; const int e = n >> 10, c = n & 1023; return PIN(IN_EW2) + ((size_t)l * 16 + e) * 512 * 1024 + c; }
    case 6: { pitch = 256; const int which = n >> 8, c = n & 255; return PIN(which ? IN_CVW1 : IN_CKW1) + (size_t)l * 2048 * 256 + c; }
    default: { pitch = 64; const int which = n >> 8, r = n & 255; return r < 64 ? PIN(which ? IN_CVW2 : IN_CKW2) + (size_t)l * 256 * 64 + r : nullptr; }
    }
}
__device__ __forceinline__ void p0_transpose(const Params& p, int item, LAS float* tile, const int tid) {
    const int l = item / TJ_TOTAL; int t = item % TJ_TOTAL, job = 0;
#pragma unroll
    for (int j = 0; j < 8; ++j) { if (job == j && t >= TJ_TILES[j]) { t -= TJ_TILES[j]; job = j + 1; } }
    const size_t lw = WS_W + (size_t)l * ((LW_BYTES + MiB - 1) / MiB) * MiB;
    const size_t offs[8] = {LW_WIN, LW_WGV, LW_BPT, LW_WOT, LW_W13, LW_W2, LW_CW1, LW_CW2};
    const int Ks[8] = {1024, 1024, 256, 1024, 1024, 512, 2048, 256};
    size_t off = 0; int K = 0;
#pragma unroll
    for (int j = 0; j < 8; ++j) if (job == j) { off = offs[j]; K = Ks[j]; }
    bf16_t* dst = (bf16_t*)(p.ws + lw + off);
    const int nkt = K / 64, rt = t / nkt, kt = t % nkt;
    { const int tx = tid & 63, ty = tid >> 6; int pitch; const float* src = tj_src(p, l, job, rt * 64 + tx, pitch);
#pragma unroll
      for (int kk = 0; kk < 8; ++kk) { const int k = ty + 8 * kk; tile[k * 65 + tx] = src ? src[(size_t)(kt * 64 + k) * pitch] : 0.f; } }
    __syncthreads();
    { const int r = tid >> 3, sg = tid & 7; f32x4 a, b;
#pragma unroll
      for (int j = 0; j < 4; ++j) { a[j] = tile[(sg * 8 + j) * 65 + r]; b[j] = tile[(sg * 8 + 4 + j) * 65 + r]; }
      *(u32x4*)(dst + (size_t)(rt * 64 + r) * K + kt * 64 + sg * 8) = pack8(a, b); }
    __syncthreads();
}

struct RowV { f32x4 v[4]; };
__device__ __forceinline__ void row_load(RowV& r, const float* src, int lane) {
#pragma unroll
    for (int j = 0; j < 4; ++j) r.v[j] = *(const f32x4*)(src + 4 * lane + 256 * j);
}
__device__ __forceinline__ void row_stats(const RowV& r, float& mean, float& rstd) {
    float s = 0.f;
#pragma unroll
    for (int j = 0; j < 4; ++j) s += (r.v[j][0] + r.v[j][1]) + (r.v[j][2] + r.v[j][3]);
    mean = wave_sum(s) * (1.0f / 1024.0f);
    float q = 0.f;
#pragma unroll
    for (int j = 0; j < 4; ++j) { const f32x4 d = r.v[j] - mean; q += (d[0] * d[0] + d[1] * d[1]) + (d[2] * d[2] + d[3] * d[3]); }
    rstd = 1.0f / sqrtf(wave_sum(q) * (1.0f / 1024.0f) + LN_EPS);
}
__device__ __forceinline__ void row_ln(RowV& r, float mean, float rstd, const float* g, const float* b, int lane) {
#pragma unroll
    for (int j = 0; j < 4; ++j) { const f32x4 gg = *(const f32x4*)(g + 4 * lane + 256 * j), bb = *(const f32x4*)(b + 4 * lane + 256 * j); r.v[j] = (r.v[j] - mean) * rstd * gg + bb; }
}
__device__ __forceinline__ void row_mod(RowV& h, const RowV& x, const float* mod, int lane) {
#pragma unroll
    for (int j = 0; j < 4; ++j) { const f32x4 sh = *(const f32x4*)(mod + 4 * lane + 256 * j), sc = *(const f32x4*)(mod + 1024 + 4 * lane + 256 * j); h.v[j] = x.v[j] * (sc + 1.0f) + sh; }
}
__device__ __forceinline__ void row_store_bf16(const RowV& h, bf16_t* dst, int lane) {
#pragma unroll
    for (int j = 0; j < 4; ++j) { u32x2 w; w.x = pk2(h.v[j][0], h.v[j][1]); w.y = pk2(h.v[j][2], h.v[j][3]); *(u32x2*)(dst + 4 * lane + 256 * j) = w; }
}
__device__ __forceinline__ void prep_first(const Params& p, const int tid, const int blk) {
    const int lane = tid & 63, wv = tid >> 6; const float* x = p.in[IN_X]; bf16_t* H = (bf16_t*)(p.ws + WS_H); const float* mod = (const float*)(p.ws + WS_MOD);
    for (int row = blk * 8 + wv; row < MTOK; row += NWG * 8) {
        RowV r, h; row_load(r, x + (size_t)row * 1024, lane); row_mod(h, r, mod + (size_t)(row >> 12) * 3072, lane); row_store_bf16(h, H + (size_t)row * 1024, lane); }
}
__device__ __forceinline__ void row_load_t(u32x2 (&t)[4], const bf16_t* src, int lane) {
#pragma unroll
    for (int j = 0; j < 4; ++j) t[j] = *(const u32x2*)(src + 4 * lane + 256 * j);
}
__device__ __forceinline__ void prep_moe(const Params& p, int l, LAS float* rwl, const int tid, const int blk) {
    const int lane = tid & 63, wv = tid >> 6;
    { const float* rw = p.in[IN_RW]; for (int i = tid; i < 16384; i += NTHR) { const int c = i >> 4, e = i & 15, ln = (c & 255) >> 2, q = c & 3, j = c >> 8;
        rwl[((((j * 4 + q) * 4 + (e >> 2)) * 64 + ln) << 2) + (e & 3)] = rw[i]; } }
    __syncthreads();
    const float* xin = (l == 0) ? p.in[IN_X] : p.out; float* z = p.out; bf16_t* H = (bf16_t*)(p.ws + WS_H); const bf16_t* T = (const bf16_t*)(p.ws + WS_T);
    const float* modg = (const float*)(p.ws + WS_MOD) + (size_t)(l * 2) * 16 * 3072; const float* mod = (const float*)(p.ws + WS_MOD) + (size_t)(l * 2 + 1) * 16 * 3072;
    f32x2* stats = (f32x2*)(p.ws + WS_STATS); const float* g = p.in[IN_LNG] + (size_t)(l * 2) * 1024; const float* bb = p.in[IN_LNB] + (size_t)(l * 2) * 1024;
    const float* gp = p.in[IN_LNG] + (size_t)((l > 0 ? l - 1 : 0) * 2 + 1) * 1024; const float* bp = p.in[IN_LNB] + (size_t)((l > 0 ? l - 1 : 0) * 2 + 1) * 1024;
    unsigned* cnt = (unsigned*)(p.ws + WS_CTL) + CW_CNT + l * 64; int* list = (int*)(p.ws + WS_R + R_LIST); float* cw = (float*)(p.ws + WS_R + R_CW);
    const float* rb = p.in[IN_RB];
    int row = blk * 8 + wv;
    RowV cur; u32x2 tc[4]; row_load(cur, xin + (size_t)row * 1024, lane); row_load_t(tc, T + (size_t)row * 1024, lane);
    for (; row < MTOK; row += NWG * 8) {
        const int nrow = row + NWG * 8; RowV nx; u32x2 tn[4];
        if (nrow < MTOK) { row_load(nx, xin + (size_t)nrow * 1024, lane); row_load_t(tn, T + (size_t)nrow * 1024, lane); }
        RowV r = cur, h;
        if (l > 0) { const f32x2 st = stats[row]; row_ln(r, st.x, st.y, gp, bp, lane); }
        { const float* gate = modg + (size_t)(row >> 12) * 3072 + 2048;
#pragma unroll
          for (int j = 0; j < 4; ++j) { const f32x4 gt = *(const f32x4*)(gate + 4 * lane + 256 * j);
              f32x4 y; y[0] = __uint_as_float(tc[j].x << 16); y[1] = __uint_as_float(tc[j].x & 0xffff0000u); y[2] = __uint_as_float(tc[j].y << 16); y[3] = __uint_as_float(tc[j].y & 0xffff0000u);
              r.v[j] = r.v[j] * DN_ALPHA + gt * y; *(f32x4*)(z + (size_t)row * 1024 + 4 * lane + 256 * j) = r.v[j]; } }
        float mean, rstd; row_stats(r, mean, rstd); if (lane == 0) stats[row] = (f32x2){mean, rstd};
        row_ln(r, mean, rstd, g, bb, lane); row_mod(h, r, mod + (size_t)(row >> 12) * 3072, lane); row_store_bf16(h, H + (size_t)row * 1024, lane);
        float a[16];
#pragma unroll
        for (int e = 0; e < 16; ++e) a[e] = 0.f;
#pragma unroll
        for (int j = 0; j < 4; ++j)
#pragma unroll
            for (int q = 0; q < 4; ++q) { const float hv = h.v[j][q]; const LAS float* wp = rwl + (((j * 4 + q) * 4) * 64 + lane) * 4;
                const f32x4 w0 = *(const LAS f32x4*)wp, w1 = *(const LAS f32x4*)(wp + 256), w2 = *(const LAS f32x4*)(wp + 512), w3 = *(const LAS f32x4*)(wp + 768);
#pragma unroll
                for (int e = 0; e < 4; ++e) { a[e] += hv * w0[e]; a[4 + e] += hv * w1[e]; a[8 + e] += hv * w2[e]; a[12 + e] += hv * w3[e]; }
                __builtin_amdgcn_sched_barrier(0); }
#pragma unroll
        for (int e = 0; e < 16; ++e) a[e] = wave_sum(a[e]);
        float sc[16], bi[16];
#pragma unroll
        for (int e = 0; e < 16; ++e) { sc[e] = sigmoidf_(a[e]); bi[e] = sc[e] + rb[e]; }
        int grp = 0; float best = -INFINITY;
#pragma unroll
        for (int gI = 0; gI < 4; ++gI) { float m1 = -INFINITY, m2 = -INFINITY;
#pragma unroll
            for (int q = 0; q < 4; ++q) { const float v = bi[4 * gI + q]; if (v > m1) { m2 = m1; m1 = v; } else if (v > m2) m2 = v; }
            const float gs = m1 + m2; if (gs > best) { best = gs; grp = gI; } }
        int e0 = 0, e1 = 0; float b0 = -INFINITY, b1 = -INFINITY, s0 = 0.f, s1 = 0.f;
#pragma unroll
        for (int gI = 0; gI < 4; ++gI)
#pragma unroll
            for (int q = 0; q < 4; ++q) { const int e = 4 * gI + q; if (gI == grp) { const float v = bi[e];
                if (v > b0) { b1 = b0; e1 = e0; s1 = s0; b0 = v; e0 = e; s0 = sc[e]; } else if (v > b1) { b1 = v; e1 = e; s1 = sc[e]; } } }
        const float inv = 1.0f / (s0 + s1);
        if (lane == 0) { const unsigned q0 = atomicAdd(cnt + e0, 1u), q1 = atomicAdd(cnt + e1, 1u);
                         list[(size_t)e0 * MTOK + q0] = row * 2; cw[(size_t)e0 * MTOK + q0] = s0 * inv;
                         list[(size_t)e1 * MTOK + q1] = row * 2 + 1; cw[(size_t)e1 * MTOK + q1] = s1 * inv; }
        cur = nx;
#pragma unroll
        for (int j = 0; j < 4; ++j) tc[j] = tn[j];
    }
}
__device__ __forceinline__ void prep_next(const Params& p, int l, bool final_, const int tid, const int blk) {
    const int lane = tid & 63, wv = tid >> 6;
    float* z = p.out; bf16_t* H = (bf16_t*)(p.ws + WS_H); const float* modm = (const float*)(p.ws + WS_MOD) + (size_t)(l * 2 + 1) * 16 * 3072;
    const float* modn = (const float*)(p.ws + WS_MOD) + (size_t)((l + 1) * 2) * 16 * 3072;
    f32x2* stats = (f32x2*)(p.ws + WS_STATS);
    const float* g0 = p.in[IN_LNG] + (size_t)(l * 2) * 1024; const float* b0 = p.in[IN_LNB] + (size_t)(l * 2) * 1024;
    const float* g1 = p.in[IN_LNG] + (size_t)(l * 2 + 1) * 1024; const float* b1 = p.in[IN_LNB] + (size_t)(l * 2 + 1) * 1024;
    const bf16_t* out2 = (const bf16_t*)(p.ws + WS_R + R_OUT2);
    int row = blk * 8 + wv;
    RowV cur; u32x2 ta[4], tb[4]; row_load(cur, z + (size_t)row * 1024, lane); row_load_t(ta, out2 + (size_t)(row * 2) * 1024, lane); row_load_t(tb, out2 + (size_t)(row * 2 + 1) * 1024, lane);
    for (; row < MTOK; row += NWG * 8) {
        const int nrow = row + NWG * 8; RowV nx; u32x2 na[4], nb[4];
        if (nrow < MTOK) { row_load(nx, z + (size_t)nrow * 1024, lane); row_load_t(na, out2 + (size_t)(nrow * 2) * 1024, lane); row_load_t(nb, out2 + (size_t)(nrow * 2 + 1) * 1024, lane); }
        RowV r = cur;
        const f32x2 st = stats[row]; row_ln(r, st.x, st.y, g0, b0, lane);
        const float* gate = modm + (size_t)(row >> 12) * 3072 + 2048;
#pragma unroll
        for (int j = 0; j < 4; ++j) { const u32x2 oa = ta[j], ob = tb[j];
            const f32x4 gt = *(const f32x4*)(gate + 4 * lane + 256 * j);
            f32x4 y; y[0] = __uint_as_float(oa.x << 16) + __uint_as_float(ob.x << 16); y[1] = __uint_as_float(oa.x & 0xffff0000u) + __uint_as_float(ob.x & 0xffff0000u);
            y[2] = __uint_as_float(oa.y << 16) + __uint_as_float(ob.y << 16); y[3] = __uint_as_float(oa.y & 0xffff0000u) + __uint_as_float(ob.y & 0xffff0000u);
            r.v[j] = r.v[j] * DN_ALPHA + gt * y; }
        cur = nx;
#pragma unroll
        for (int j = 0; j < 4; ++j) { ta[j] = na[j]; tb[j] = nb[j]; }
        float mean, rstd; row_stats(r, mean, rstd);
        if (final_) { row_ln(r, mean, rstd, g1, b1, lane);
#pragma unroll
            for (int j = 0; j < 4; ++j) *(f32x4*)(z + (size_t)row * 1024 + 4 * lane + 256 * j) = r.v[j];
        } else {
#pragma unroll
            for (int j = 0; j < 4; ++j) *(f32x4*)(z + (size_t)row * 1024 + 4 * lane + 256 * j) = r.v[j];
            if (lane == 0) stats[row] = (f32x2){mean, rstd};
            RowV h; row_ln(r, mean, rstd, g1, b1, lane); row_mod(h, r, modn + (size_t)(row >> 12) * 3072, lane); row_store_bf16(h, H + (size_t)row * 1024, lane); }
    }
}

__device__ __forceinline__ int q_next(unsigned* ctr, volatile LAS int* slot, const int tid) {
    __syncthreads();
    if (tid == 0) *slot = (int)__hip_atomic_fetch_add(ctr, 1u, __ATOMIC_RELAXED, __HIP_MEMORY_SCOPE_AGENT);
    __syncthreads();
    return *slot;
}

__device__ __forceinline__ void gdn_prep_unit(const Params& p, int l, int unit, LAS unsigned char* lds, const int tid_in_) {
    int tid = tid_in_; asm volatile("" : "+v"(tid)); unsigned char* wsl_ = ws_late();
    const int lane = tid & 63;
    const int n = unit & 63, h = (unit >> 6) & 3, bl = unit >> 8;
    const int tok0 = bl * SEQ + n * 64;
    const bf16_t* proj = (const bf16_t*)(wsl_ + WS_R + R_PROJ); const float* sm = (const float*)(wsl_ + WS_R + R_SM);
    LAS bf16_t* raw = (LAS bf16_t*)lds;
    LAS float* qs = (LAS float*)(lds + 26112); LAS float* ks = qs + 64 * 65; LAS float* vs = ks + 64 * 65;
    LAS float* Lm = vs + 64 * 65;
    LAS float* bc = Lm + 4096; LAS float* eb = bc + 64; LAS float* be = eb + 64; LAS float* cwt = be + 64;
    __syncthreads();
    for (int idx = tid; idx < 67 * 24; idx += NTHR) { const int row = idx / 24, ch = idx % 24, seg = ch >> 3, c8 = ch & 7;
        u32x4 v = {0u, 0u, 0u, 0u};
        if (n > 0 || row >= 3) v = *(const u32x4*)(proj + (size_t)(tok0 + row - 3) * PROJW + seg * 256 + h * 64 + c8 * 8);
        *(LAS u32x4*)(raw + row * 192 + seg * 64 + c8 * 8) = v; }
    for (int idx = tid; idx < 768; idx += NTHR) { const int k = idx / 192, ch = idx % 192; cwt[idx] = PIN(IN_CONVW)[(size_t)l * 4 * 768 + k * 768 + (ch >> 6) * 256 + h * 64 + (ch & 63)]; }
    __syncthreads();
    for (int idx = tid; idx < 64 * 192; idx += NTHR) { const int t = idx / 192, ch = idx % 192; float s = 0.f;
#pragma unroll
        for (int k = 0; k < 4; ++k) s += cwt[k * 192 + ch] * bf2f(raw[(t + k) * 192 + ch]);
        s = siluf_(s); const int seg = ch >> 6, d = ch & 63; (seg == 0 ? qs : seg == 1 ? ks : vs)[t * 65 + d] = s; }
    __syncthreads();
    LAS unsigned char* qb = lds + 129024; LAS unsigned char* kb = qb + 8192; LAS float* Rs = (LAS float*)(kb + 8192);
    {
        const int mat = tid >> 8, row = (tid >> 2) & 63, q4 = tid & 3; LAS float* mt = mat ? ks : qs; float x[16], ss = 0.f;
#pragma unroll
        for (int d = 0; d < 16; ++d) { x[d] = mt[row * 65 + 16 * q4 + d]; ss += x[d] * x[d]; }
        ss += __shfl_xor(ss, 1); ss += __shfl_xor(ss, 2);
        const float sc = (1.0f / sqrtf(ss + 1e-6f)) * (mat ? 1.0f : 0.125f);
#pragma unroll
        for (int d = 0; d < 16; ++d) { x[d] *= sc; mt[row * 65 + 16 * q4 + d] = x[d]; }
        LAS unsigned char* ob = (mat ? kb : qb) + (2 * q4) * 1024 + row * 16;
        u32x4 w0, w1; w0.x = pk2(x[0], x[1]); w0.y = pk2(x[2], x[3]); w0.z = pk2(x[4], x[5]); w0.w = pk2(x[6], x[7]); w1.x = pk2(x[8], x[9]); w1.y = pk2(x[10], x[11]); w1.z = pk2(x[12], x[13]); w1.w = pk2(x[14], x[15]);
        *(LAS u32x4*)ob = w0; *(LAS u32x4*)(ob + 1024) = w1;
    }
    if (tid < 64) { const int i = tid;
        const float a = sm[(size_t)(tok0 + i) * 32 + h], bg = sm[(size_t)(tok0 + i) * 32 + 4 + h];
        const float x = a + PIN(IN_DTB)[l * 4 + h]; const float sp = fmaxf(x, 0.f) + log1pf(__expf(-fabsf(x)));
        float la = -__expf(PIN(IN_ALOG)[l * 4 + h]) * sp;
#pragma unroll
        for (int o = 1; o < 64; o <<= 1) { const float v = __shfl_up(la, o); if (lane >= o) la += v; }
        bc[i] = la; eb[i] = __expf(la); be[i] = sigmoidf_(bg); }
    __syncthreads();
    const size_t ub = WS_R + R_GDN + (size_t)unit * GDN_UNIT_BYTES;
    bf16_t* gW = (bf16_t*)(wsl_ + ub); bf16_t* gATT = gW + 4096; bf16_t* gQD = gW + 8192; bf16_t* gKDT = gW + 12288; bf16_t* gU0 = gW + 16384;
    {
        const int wid = tid >> 6, r32 = lane & 31, hi = lane >> 5, isq = wid >> 2, it = (wid >> 1) & 1, jt = wid & 1;
        const LAS unsigned char* ab = (isq ? qb : kb) + hi * 1024 + (32 * it + r32) * 16; const LAS unsigned char* bb = kb + hi * 1024 + (32 * jt + r32) * 16;
        f32x16 acc = (f32x16){};
#pragma unroll
        for (int d0 = 0; d0 < 4; ++d0) acc = MF32(*(const LAS bf16x8*)(ab + d0 * 2048), *(const LAS bf16x8*)(bb + d0 * 2048), acc);
        const int j = 32 * jt + r32; const float bj = bc[j];
#pragma unroll
        for (int g = 0; g < 4; ++g) { f32x4 lv;
#pragma unroll
            for (int e = 0; e < 4; ++e) { const int i = 32 * it + 8 * g + 4 * hi + e; const float dc = __expf(bc[i] - bj), v = acc[4 * g + e] * dc;
                if (isq) gATT[i * 64 + j] = f2bf((j <= i) ? v : 0.f); else lv[e] = (j < i) ? be[i] * v : 0.f; }
            if (!isq) *(LAS f32x4*)(Lm + j * 64 + 32 * it + 8 * g + 4 * hi) = lv; }
    }
    __syncthreads();
    {
        const int c = tid & 127, cc = c & 63, rg = tid >> 7; const bool isw = c >= 64; LAS float* Xs = cwt + 768;
        for (int I = 0; I < 4; ++I) {
            float r[4];
#pragma unroll
            for (int e = 0; e < 4; ++e) { const int i = 16 * I + 4 * rg + e; r[e] = isw ? be[i] * eb[i] * ks[i * 65 + cc] : be[i] * vs[i * 65 + cc]; }
#pragma unroll 4
            for (int j = 0; j < 16 * I; ++j) { const float xj = Xs[j * 128 + c]; const f32x4 l4 = *(const LAS f32x4*)(Lm + j * 64 + 16 * I + 4 * rg);
#pragma unroll
                for (int e = 0; e < 4; ++e) r[e] -= l4[e] * xj; }
#pragma unroll
            for (int e = 0; e < 4; ++e) Rs[(4 * rg + e) * 128 + c] = r[e];
            __syncthreads();
            if (tid < 128) { float q[16];
#pragma unroll
                for (int ii = 0; ii < 16; ++ii) q[ii] = Rs[ii * 128 + c];
#pragma unroll
                for (int ii = 1; ii < 16; ++ii)
#pragma unroll
                    for (int jj = 0; jj < ii; ++jj) q[ii] -= Lm[(16 * I + jj) * 64 + 16 * I + ii] * q[jj];
#pragma unroll
                for (int ii = 0; ii < 16; ++ii) { Xs[(16 * I + ii) * 128 + c] = q[ii]; (isw ? gW : gU0)[(16 * I + ii) * 64 + cc] = f2bf(q[ii]); }
            } else if (I == 0) {
                const float bl_ = bc[63];
                for (int task = tid - 128; task < 1024; task += 384) {
                    if (task < 512) { const int c2 = task >> 3, sg = task & 7; const float e = eb[c2]; float v[8];
#pragma unroll
                        for (int j = 0; j < 8; ++j) v[j] = qs[c2 * 65 + sg * 8 + j] * e;
                        u32x4 w; w.x = pk2(v[0], v[1]); w.y = pk2(v[2], v[3]); w.z = pk2(v[4], v[5]); w.w = pk2(v[6], v[7]); *(u32x4*)(gQD + c2 * 64 + sg * 8) = w;
                    } else { const int k = (task - 512) >> 3, sg = task & 7; float v[8];
#pragma unroll
                        for (int j = 0; j < 8; ++j) { const int c2 = sg * 8 + j; v[j] = ks[c2 * 65 + k] * __expf(bl_ - bc[c2]); }
                        u32x4 w; w.x = pk2(v[0], v[1]); w.y = pk2(v[2], v[3]); w.z = pk2(v[4], v[5]); w.w = pk2(v[6], v[7]); *(u32x4*)(gKDT + k * 64 + sg * 8) = w; }
                }
                if (tid == 128) ((float*)(wsl_ + WS_R + R_GG))[unit] = __expf(bl_);
            }
            __syncthreads();
        }
    }
}

__device__ __forceinline__ bf16x8 afrag_perm(const LAS unsigned char* M, int row, int ks, int hi) {
    const LAS unsigned char* q = M + row * 144 + (16 * ks + 4 * hi) * 2;
    const s16x4 lo = *(const LAS s16x4*)q, hi4 = *(const LAS s16x4*)(q + 16);
    return (bf16x8){lo[0], lo[1], lo[2], lo[3], hi4[0], hi4[1], hi4[2], hi4[3]};
}
__device__ __forceinline__ bf16x8 pack_acc8(const f32x16& a, int s) {
    u32x4 w; w.x = pk2(a[8 * s + 0], a[8 * s + 1]); w.y = pk2(a[8 * s + 2], a[8 * s + 3]); w.z = pk2(a[8 * s + 4], a[8 * s + 5]); w.w = pk2(a[8 * s + 6], a[8 * s + 7]);
    return __builtin_bit_cast(bf16x8, w);
}
__device__ __forceinline__ void gdn_scan_item(const Params& p, int l, int chunk, int item, LAS unsigned char* lds, const int tid) {
    const int lane = tid & 63, wid = tid >> 6, vl = lane & 31, hi = lane >> 5;
    const int h = item & 3, bl = item >> 2;
    const unsigned char* ubase = p.ws + WS_R + R_GDN + (size_t)item * 64 * GDN_UNIT_BYTES;
    const float* gg = (const float*)(p.ws + WS_R + R_GG) + item * 64;
    const bf16_t* proj = (const bf16_t*)(p.ws + WS_R + R_PROJ); bf16_t* og = (bf16_t*)(p.ws + WS_R + R_O);
    const float* nw = PIN(IN_GNORM) + l * 64;
    constexpr int BUF = 5 * 9216;
    LAS unsigned char* buf0 = lds; LAS float* ob0 = (LAS float*)(lds + 2 * BUF);
    __syncthreads();
    for (int q = tid; q < 2560; q += NTHR) { const int mat = q >> 9, r = (q >> 3) & 63, sg = q & 7;
        *(LAS u32x4*)(buf0 + mat * 9216 + r * 144 + sg * 16) = *(const u32x4*)(ubase + mat * 8192 + r * 128 + sg * 16); }
    __syncthreads();
    f32x16 S[2]; S[0] = (f32x16){}; S[1] = (f32x16){};
    for (int n = 0; n < 64; ++n) {
        LAS unsigned char* bf = buf0 + (n & 1) * BUF; LAS float* ob = ob0 + (n & 1) * 4096;
        if (wid < 2) {
            const LAS unsigned char* Wm = bf; const LAS unsigned char* ATT = bf + 9216; const LAS unsigned char* QD = bf + 18432; const LAS unsigned char* KDT = bf + 27648; const LAS bf16_t* U0 = (const LAS bf16_t*)(bf + 36864);
            const float G = gg[n];
            bf16x8 Sb[4]; Sb[0] = pack_acc8(S[0], 0); Sb[1] = pack_acc8(S[0], 1); Sb[2] = pack_acc8(S[1], 0); Sb[3] = pack_acc8(S[1], 1);
            f32x16 u[2];
#pragma unroll
            for (int ct = 0; ct < 2; ++ct) { f32x16 a = (f32x16){};
#pragma unroll
                for (int ks = 0; ks < 4; ++ks) a = __builtin_amdgcn_mfma_f32_32x32x16_bf16(afrag_perm(Wm, 32 * ct + vl, ks, hi), Sb[ks], a, 0, 0, 0);
#pragma unroll
                for (int r = 0; r < 16; ++r) u[ct][r] = bf2f(U0[(32 * ct + crow(r, hi)) * 72 + 32 * wid + vl]) - a[r]; }
            bf16x8 ub[4]; ub[0] = pack_acc8(u[0], 0); ub[1] = pack_acc8(u[0], 1); ub[2] = pack_acc8(u[1], 0); ub[3] = pack_acc8(u[1], 1);
#pragma unroll
            for (int ct = 0; ct < 2; ++ct) { f32x16 a = (f32x16){};
#pragma unroll
                for (int ks = 0; ks < 4; ++ks) a = __builtin_amdgcn_mfma_f32_32x32x16_bf16(afrag_perm(QD, 32 * ct + vl, ks, hi), Sb[ks], a, 0, 0, 0);
#pragma unroll
                for (int cs = 0; cs < 4; ++cs) a = __builtin_amdgcn_mfma_f32_32x32x16_bf16(afrag_perm(ATT, 32 * ct + vl, cs, hi), ub[cs], a, 0, 0, 0);
#pragma unroll
                for (int r = 0; r < 16; ++r) ob[(32 * ct + crow(r, hi)) * 64 + 32 * wid + vl] = a[r]; }
#pragma unroll
            for (int kt = 0; kt < 2; ++kt) { f32x16 a = S[kt] * G;
#pragma unroll
                for (int cs = 0; cs < 4; ++cs) a = __builtin_amdgcn_mfma_f32_32x32x16_bf16(afrag_perm(KDT, 32 * kt + vl, cs, hi), ub[cs], a, 0, 0, 0);
                S[kt] = a; }
        } else {
            if (n + 1 < 64) { LAS unsigned char* nb = buf0 + ((n + 1) & 1) * BUF; const unsigned char* src = ubase + (size_t)(n + 1) * GDN_UNIT_BYTES;
                for (int q = tid - 128; q < 2560; q += 384) { const int mat = q >> 9, r = (q >> 3) & 63, sg = q & 7;
                    *(LAS u32x4*)(nb + mat * 9216 + r * 144 + sg * 16) = *(const u32x4*)(src + mat * 8192 + r * 128 + sg * 16); } }
        }
        if (wid >= 2 && n >= 1) { const LAS float* po = ob0 + ((n - 1) & 1) * 4096; const int tokb = bl * SEQ + (n - 1) * 64;
            for (int task = tid - 128; task < 512; task += 384) { const int c = task >> 3, sg = task & 7; float v[8], ss = 0.f;
#pragma unroll
                for (int j = 0; j < 8; ++j) { v[j] = po[c * 64 + sg * 8 + j]; ss += v[j] * v[j]; }
                ss += __shfl_xor(ss, 1); ss += __shfl_xor(ss, 2); ss += __shfl_xor(ss, 4);
                const float rs = 1.0f / sqrtf(ss * (1.0f / 64.0f) + 1e-6f);
                const u32x4 zw = *(const u32x4*)(proj + (size_t)(tokb + c) * PROJW + PC_GZ + h * 64 + sg * 8); const unsigned zz[4] = {zw.x, zw.y, zw.z, zw.w};
#pragma unroll
                for (int j = 0; j < 8; ++j) { const float zf = (j & 1) ? __uint_as_float(zz[j >> 1] & 0xffff0000u) : __uint_as_float(zz[j >> 1] << 16); v[j] = v[j] * rs * nw[sg * 8 + j] * siluf_(zf); }
                u32x4 w; w.x = pk2(v[0], v[1]); w.y = pk2(v[2], v[3]); w.z = pk2(v[4], v[5]); w.w = pk2(v[6], v[7]);
                *(u32x4*)(og + (size_t)(tokb + c) * 256 + h * 64 + sg * 8) = w; } }
        __syncthreads();
    }
    { const LAS float* po = ob0 + 4096; const int tokb = bl * SEQ + 63 * 64;
        for (int task = tid; task < 512; task += NTHR) { const int c = task >> 3, sg = task & 7; float v[8], ss = 0.f;
#pragma unroll
            for (int j = 0; j < 8; ++j) { v[j] = po[c * 64 + sg * 8 + j]; ss += v[j] * v[j]; }
            ss += __shfl_xor(ss, 1); ss += __shfl_xor(ss, 2); ss += __shfl_xor(ss, 4);
            const float rs = 1.0f / sqrtf(ss * (1.0f / 64.0f) + 1e-6f);
            const u32x4 zw = *(const u32x4*)(proj + (size_t)(tokb + c) * PROJW + PC_GZ + h * 64 + sg * 8); const unsigned zz[4] = {zw.x, zw.y, zw.z, zw.w};
#pragma unroll
            for (int j = 0; j < 8; ++j) { const float zf = (j & 1) ? __uint_as_float(zz[j >> 1] & 0xffff0000u) : __uint_as_float(zz[j >> 1] << 16); v[j] = v[j] * rs * nw[sg * 8 + j] * siluf_(zf); }
            u32x4 w; w.x = pk2(v[0], v[1]); w.y = pk2(v[2], v[3]); w.z = pk2(v[4], v[5]); w.w = pk2(v[6], v[7]);
            *(u32x4*)(og + (size_t)(tokb + c) * 256 + h * 64 + sg * 8) = w; } }
    __syncthreads();
}

__device__ __forceinline__ void fox_cum_item(const Params& p, int l, int item, LAS float* lf, const int tid) {
    const int lane = tid & 63, wid = tid >> 6, h = item & 3, bl = item >> 2;
    const float* sm = (const float*)(p.ws + WS_R + R_SM); float* nb = (float*)(p.ws + WS_R + R_CUM) + (size_t)item * SEQ;
    const float fb = PIN(IN_FBIAS)[l * 4 + h];
    float v[8], run = 0.f;
#pragma unroll
    for (int j = 0; j < 8; ++j) { const float x = sm[(size_t)(bl * SEQ + tid * 8 + j) * 32 + 20 + h] + fb; run += fminf(x, 0.f) - log1pf(__expf(-fabsf(x))); v[j] = run; }
    float inc = run;
#pragma unroll
    for (int o = 1; o < 64; o <<= 1) { const float t = __shfl_up(inc, o); if (lane >= o) inc += t; }
    __syncthreads();
    if (lane == 63) lf[wid] = inc;
    __syncthreads();
    float base = inc - run;
    for (int w = 0; w < wid; ++w) base += lf[w];
#pragma unroll
    for (int j = 0; j < 8; ++j) nb[tid * 8 + j] = -(base + v[j]) * LOG2E;
    __syncthreads();
}
__device__ __forceinline__ void ret_rope_pass(const Params& p, int chunk, const int tid, const int blk) {
    bf16_t* proj = (bf16_t*)(p.ws + WS_R + R_PROJ); const f32x2* tab = (const f32x2*)(p.ws + WS_ROPE);
    for (int task = blk * NTHR + tid; task < MC * 32; task += NWG * NTHR) {
        const int row = task >> 5, which = (task >> 4) & 1, h = (task >> 2) & 3, i8 = task & 3;
        bf16_t* q1 = proj + (size_t)row * PROJW + (which ? PC_RK : PC_RQ) + h * 64 + i8 * 8; bf16_t* q2 = q1 + 32;
        const u32x4 a = *(const u32x4*)q1, b = *(const u32x4*)q2; const unsigned aa[4] = {a.x, a.y, a.z, a.w}, bb[4] = {b.x, b.y, b.z, b.w};
        const f32x2* tp = tab + (size_t)(chunk * MC + row) * 32 + i8 * 8; float o1[8], o2[8];
#pragma unroll
        for (int j = 0; j < 8; ++j) { const float x1 = (j & 1) ? __uint_as_float(aa[j >> 1] & 0xffff0000u) : __uint_as_float(aa[j >> 1] << 16);
            const float x2 = (j & 1) ? __uint_as_float(bb[j >> 1] & 0xffff0000u) : __uint_as_float(bb[j >> 1] << 16);
            const f32x2 cs = tp[j]; o1[j] = x1 * cs.x - x2 * cs.y; o2[j] = x1 * cs.y + x2 * cs.x; }
        u32x4 w1, w2; w1.x = pk2(o1[0], o1[1]); w1.y = pk2(o1[2], o1[3]); w1.z = pk2(o1[4], o1[5]); w1.w = pk2(o1[6], o1[7]);
        w2.x = pk2(o2[0], o2[1]); w2.y = pk2(o2[2], o2[3]); w2.z = pk2(o2[4], o2[5]); w2.w = pk2(o2[6], o2[7]);
        *(u32x4*)q1 = w1; *(u32x4*)q2 = w2; }
}

constexpr int AL_K0 = 0, AL_V0 = 16384, AL_B0 = 32768;
__device__ __forceinline__ s16x4 vtr(const LAS unsigned char* q) {
    typedef short v4i16_t __attribute__((ext_vector_type(4)));
    return __builtin_bit_cast(s16x4, __builtin_amdgcn_ds_read_tr16_b64_v4i16((LAS v4i16_t*)q));
}
__device__ __forceinline__ void attn_qkt(f32x16& p0, f32x16& p1, const LAS unsigned char* kslot, const bf16x8 (&qf)[4], int r32, int hi) {
    p0 = (f32x16){}; p1 = (f32x16){};
#pragma unroll
    for (int d0 = 0; d0 < 4; ++d0) { const LAS unsigned char* kb = kslot + (2 * d0 + hi) * 1024 + r32 * 16;
        const bf16x8 b0 = *(const LAS bf16x8*)kb, b1 = *(const LAS bf16x8*)(kb + 512);
        p0 = MF32(b0, qf[d0], p0); p1 = MF32(b1, qf[d0], p1); }
}
__device__ __forceinline__ void attn_pv(f32x16 (&o)[2], const LAS unsigned char* vslot, const bf16x8 (&pw)[4], int lane, int hi) {
    const LAS unsigned char* vb = vslot + ((lane >> 4) & 1) * 32 + (lane & 3) * 8 + (4 * hi + ((lane & 15) >> 2)) * 64;
#pragma unroll
    for (int d0 = 0; d0 < 2; ++d0)
#pragma unroll
        for (int ks = 0; ks < 4; ++ks) { const s16x4 lo = vtr(vb + d0 * 4096 + ks * 1024), h4 = vtr(vb + d0 * 4096 + ks * 1024 + 512);
            const bf16x8 vf = (bf16x8){lo[0], lo[1], lo[2], lo[3], h4[0], h4[1], h4[2], h4[3]};
            o[d0] = MF32(vf, pw[ks], o[d0]); }
}
__device__ __forceinline__ void attn_softmax_step(f32x16& p0, f32x16& p1, f32x16 (&o)[2], float& m, float& l) {
    float mt = p0[0];
#pragma unroll
    for (int r = 1; r < 16; ++r) mt = fmaxf(mt, p0[r]);
#pragma unroll
    for (int r = 0; r < 16; ++r) mt = fmaxf(mt, p1[r]);
    mt = fmaxf(mt, __shfl_xor(mt, 32));
    const float mn = fmaxf(m, mt), ms = (mn == -INFINITY) ? 0.f : mn, alpha = ex2(m - ms);
    float s = 0.f;
#pragma unroll
    for (int r = 0; r < 16; ++r) { p0[r] = ex2(p0[r] - ms); p1[r] = ex2(p1[r] - ms); s += p0[r] + p1[r]; }
    l = l * alpha + s; o[0] *= alpha; o[1] *= alpha; m = mn;
}
template <class F>
__device__ __forceinline__ void flash_loop(const F& f, int tlo, int thi, const bf16_t* Kg, const bf16_t* Vg, int pitch, const float* biasg,
                                           const bf16x8 (&qf)[4], f32x16 (&o)[2], float& m, float& l, LAS unsigned char* lds, const int tid) {
    const int lane = tid & 63, wid = tid >> 6, r32 = lane & 31, hi = lane >> 5;
    int t = tlo; while (t < thi && f.skip(t)) ++t;
    __syncthreads();
    if (t >= thi) return;
    const bf16_t* ksrc = Kg + (size_t)lane * pitch + wid * 8;
    const bf16_t* vsrc = Vg + (size_t)(16 * (wid & 3) + (lane >> 2)) * pitch + (wid >> 2) * 32 + (lane & 3) * 8;
    const int sdst = wid * 1024 + lane * 16;
    u32x4 kr = *(const u32x4*)(ksrc + (size_t)t * 64 * pitch), vr = *(const u32x4*)(vsrc + (size_t)t * 64 * pitch); float br = 0.f;
    const int btid = tid & 63;
    if (F::HAS_BIAS) br = biasg[t * 64 + btid];
    *(LAS u32x4*)(lds + AL_K0 + sdst) = kr; *(LAS u32x4*)(lds + AL_V0 + sdst) = vr; if (F::HAS_BIAS) ((LAS float*)(lds + AL_B0))[btid] = br;
    __syncthreads();
    int cur = 0;
    for (;;) {
        int tn = t + 1; while (tn < thi && f.skip(tn)) ++tn;
        if (tn < thi) { kr = *(const u32x4*)(ksrc + (size_t)tn * 64 * pitch); vr = *(const u32x4*)(vsrc + (size_t)tn * 64 * pitch); if (F::HAS_BIAS) br = biasg[tn * 64 + btid]; }
        f32x16 p0, p1;
        attn_qkt(p0, p1, lds + AL_K0 + cur * 8192, qf, r32, hi);
        if (F::HAS_BIAS) { const LAS float* bp = (const LAS float*)(lds + AL_B0 + cur * 256);
#pragma unroll
            for (int g = 0; g < 4; ++g) { const f32x4 b0 = *(const LAS f32x4*)(bp + 8 * g + 4 * hi), b1 = *(const LAS f32x4*)(bp + 32 + 8 * g + 4 * hi);
#pragma unroll
                for (int e = 0; e < 4; ++e) { p0[4 * g + e] += b0[e]; p1[4 * g + e] += b1[e]; } } }
        f.apply(p0, p1, t);
        if (F::MODE == 0) attn_softmax_step(p0, p1, o, m, l);
        bf16x8 pw[4]; pw[0] = pack_acc8(p0, 0); pw[1] = pack_acc8(p0, 1); pw[2] = pack_acc8(p1, 0); pw[3] = pack_acc8(p1, 1);
        attn_pv(o, lds + AL_V0 + cur * 8192, pw, lane, hi);
        if (tn >= thi) break;
        cur ^= 1;
        *(LAS u32x4*)(lds + AL_K0 + cur * 8192 + sdst) = kr; *(LAS u32x4*)(lds + AL_V0 + cur * 8192 + sdst) = vr; if (F::HAS_BIAS) ((LAS float*)(lds + AL_B0 + cur * 256))[btid] = br;
        __syncthreads();
        t = tn;
    }
    __syncthreads();
}
__device__ __forceinline__ void load_qf(bf16x8 (&qf)[4], const bf16_t* qrow, int hi) {
#pragma unroll
    for (int d0 = 0; d0 < 4; ++d0) qf[d0] = *(const bf16x8*)(qrow + d0 * 16 + hi * 8);
}
__device__ __forceinline__ void store_ot(const f32x16 (&o)[2], bf16_t* orow, int hi) {
#pragma unroll
    for (int d0 = 0; d0 < 2; ++d0)
#pragma unroll
        for (int g = 0; g < 4; ++g) { u32x2 w; w.x = pk2(o[d0][4 * g], o[d0][4 * g + 1]); w.y = pk2(o[d0][4 * g + 2], o[d0][4 * g + 3]); *(u32x2*)(orow + 32 * d0 + 8 * g + 4 * hi) = w; }
}

struct FoxF { static constexpr int MODE = 0; static constexpr bool HAS_BIAS = true; int tq, qmin, hi;
    __device__ __forceinline__ bool skip(int) const { return false; }
    __device__ __forceinline__ void apply(f32x16& p0, f32x16& p1, int t) const {
        if (64 * t + 63 > qmin) {
#pragma unroll
            for (int r = 0; r < 16; ++r) { const int key = 64 * t + crow(r, hi); if (key > tq) p0[r] = -INFINITY; if (key + 32 > tq) p1[r] = -INFINITY; } } } };
struct RetF { static constexpr int MODE = 1; static constexpr bool HAS_BIAS = false; int tq, hi; float lg;
    __device__ __forceinline__ bool skip(int) const { return false; }
    __device__ __forceinline__ void apply(f32x16& p0, f32x16& p1, int t) const {
#pragma unroll
        for (int r = 0; r < 16; ++r) { const int key = 64 * t + crow(r, hi);
            p0[r] = (key <= tq) ? p0[r] * ex2((float)(tq - key) * lg) : 0.f; p1[r] = (key + 32 <= tq) ? p1[r] * ex2((float)(tq - key - 32) * lg) : 0.f; } } };
struct SelF { static constexpr int MODE = 0; static constexpr bool HAS_BIAS = false; unsigned long long umask, mymask; int tq, klo, hi;
    __device__ __forceinline__ bool skip(int t) const { return ((umask >> t) & 1ull) == 0ull; }
    __device__ __forceinline__ void apply(f32x16& p0, f32x16& p1, int t) const { const bool on = ((mymask >> t) & 1ull) != 0ull;
#pragma unroll
        for (int r = 0; r < 16; ++r) { const int key = 64 * t + crow(r, hi); if (!on || key > tq || key <= klo) p0[r] = -INFINITY; if (!on || key + 32 > tq || key + 32 <= klo) p1[r] = -INFINITY; } } };
__device__ __forceinline__ void fox_unit(const Params& p, int idx, LAS unsigned char* lds, const int tid_in_) {
    int tid = tid_in_; asm volatile("" : "+v"(tid)); unsigned char* wsl_ = ws_late();
    const int lane = tid & 63, wid = tid >> 6, r32 = lane & 31, hi = lane >> 5;
    const int qb = 15 - idx / (BC * 4), bh = idx % (BC * 4), h = bh & 3, bl = bh >> 2;
    const bf16_t* proj = (const bf16_t*)(wsl_ + WS_R + R_PROJ);
    const int tq = qb * 256 + wid * 32 + r32; const size_t rowc = (size_t)bl * SEQ + tq;
    bf16x8 qf[4]; load_qf(qf, proj + rowc * PROJW + PC_FQ + h * 64, hi);
    f32x16 o[2]; o[0] = (f32x16){}; o[1] = (f32x16){}; float m = -INFINITY, l = 0.f;
    FoxF f; f.tq = tq; f.qmin = qb * 256; f.hi = hi;
    flash_loop(f, 0, 4 * qb + 4, proj + (size_t)bl * SEQ * PROJW + PC_FK + h * 64, proj + (size_t)bl * SEQ * PROJW + PC_FV + h * 64, PROJW,
               (const float*)(wsl_ + WS_R + R_CUM) + (size_t)bh * SEQ, qf, o, m, l, lds, tid);
    l += __shfl_xor(l, 32); const float inv = 1.0f / l; o[0] *= inv; o[1] *= inv;
    store_ot(o, (bf16_t*)(wsl_ + WS_R + R_O) + (size_t)3 * MC * 256 + rowc * 256 + h * 64, hi);
}
__device__ __forceinline__ void rope8(float (&o1)[8], float (&o2)[8], const u32x4& a, const u32x4& b, const f32x2* tp) {
    const unsigned aa[4] = {a.x, a.y, a.z, a.w}, bb[4] = {b.x, b.y, b.z, b.w};
#pragma unroll
    for (int j = 0; j < 8; ++j) { const float x1 = (j & 1) ? __uint_as_float(aa[j >> 1] & 0xffff0000u) : __uint_as_float(aa[j >> 1] << 16);
        const float x2 = (j & 1) ? __uint_as_float(bb[j >> 1] & 0xffff0000u) : __uint_as_float(bb[j >> 1] << 16);
        const f32x2 cs = tp[j]; o1[j] = x1 * cs.x - x2 * cs.y; o2[j] = x1 * cs.y + x2 * cs.x; }
}
__device__ __forceinline__ u32x4 pack8f(const float (&v)[8]) { u32x4 w; w.x = pk2(v[0], v[1]); w.y = pk2(v[2], v[3]); w.z = pk2(v[4], v[5]); w.w = pk2(v[6], v[7]); return w; }
__device__ __forceinline__ void ret_kv_unit(const Params& p, int ch, int idx, LAS unsigned char* lds, const int tid_in_) {
    int tid = tid_in_; asm volatile("" : "+v"(tid)); unsigned char* wsl_ = ws_late();
    const int lane = tid & 63, wid = tid >> 6, hi = lane >> 5;
    const int n = idx & 31, bh = idx >> 5, h = bh & 3, bl = bh >> 2;
    const bf16_t* proj = (const bf16_t*)(wsl_ + WS_R + R_PROJ); const f32x2* tab = (const f32x2*)(wsl_ + WS_ROPE);
    const size_t rowc0 = (size_t)bl * SEQ + n * 128; const float lg = log2f(1.0f - exp2f(-5.0f - (float)h));
    LAS unsigned char* KZ = lds; LAS unsigned char* VT = lds + 16384;
    __syncthreads();
    { const int key = tid >> 2, cp = tid & 3; const bf16_t* src = proj + (rowc0 + key) * PROJW + PC_RK + h * 64 + cp * 8;
      const u32x4 a = *(const u32x4*)src, b = *(const u32x4*)(src + 32); float o1[8], o2[8];
      rope8(o1, o2, a, b, tab + ((size_t)ch * MC + rowc0 + key) * 32 + cp * 8);
      const float zt = ex2((float)(127 - key) * lg);
#pragma unroll
      for (int j = 0; j < 8; ++j) { o1[j] *= zt; o2[j] *= zt; }
      LAS unsigned char* d = KZ + (key >> 6) * 8192 + ((key & 63) >> 4) * 1024 + (key & 15) * 64 + cp * 16;
      *(LAS u32x4*)d = pack8f(o1); *(LAS u32x4*)(d + 4096) = pack8f(o2); }
#pragma unroll
    for (int t2 = 0; t2 < 2; ++t2)
        *(LAS u32x4*)(VT + t2 * 8192 + wid * 1024 + lane * 16) = *(const u32x4*)(proj + (rowc0 + 64 * t2 + 16 * (wid & 3) + (lane >> 2)) * PROJW + PC_RV + h * 64 + (wid >> 2) * 32 + (lane & 3) * 8);
    __syncthreads();
    if (wid < 4) { const int vt = wid >> 1, kt = wid & 1;
        const int fo = ((lane >> 4) & 1) * 32 + (lane & 3) * 8 + (4 * hi + ((lane & 15) >> 2)) * 64;
        f32x16 acc = (f32x16){};
#pragma unroll
        for (int t2 = 0; t2 < 2; ++t2)
#pragma unroll
            for (int ks = 0; ks < 4; ++ks) { const LAS unsigned char* va = VT + t2 * 8192 + vt * 4096 + ks * 1024 + fo; const LAS unsigned char* ka = KZ + t2 * 8192 + kt * 4096 + ks * 1024 + fo;
                const s16x4 v0 = vtr(va), v1 = vtr(va + 512), k0 = vtr(ka), k1 = vtr(ka + 512);
                acc = MF32(((bf16x8){v0[0], v0[1], v0[2], v0[3], v1[0], v1[1], v1[2], v1[3]}), ((bf16x8){k0[0], k0[1], k0[2], k0[3], k1[0], k1[1], k1[2], k1[3]}), acc); }
        float* kvt = (float*)(wsl_ + WS_R + R_KVT) + (size_t)idx * 4096;
#pragma unroll
        for (int r = 0; r < 16; ++r) kvt[(32 * vt + crow(r, hi)) * 64 + 32 * kt + (lane & 31)] = acc[r]; }
    __syncthreads();
}
__device__ __forceinline__ void ret_out_unit(const Params& p, int l_, int ch, int idx, LAS unsigned char* lds, const int tid_in_) {
    int tid = tid_in_; asm volatile("" : "+v"(tid)); unsigned char* wsl_ = ws_late();
    const int lane = tid & 63, wid = tid >> 6, r32 = lane & 31, hi = lane >> 5, gw = wid >> 2, wq = wid & 3;
    const int np = 15 - idx / (BC * 4), bh = idx % (BC * 4), h = bh & 3, bl = bh >> 2, n = 2 * np + gw;
    const bf16_t* proj = (const bf16_t*)(wsl_ + WS_R + R_PROJ); const f32x2* tab = (const f32x2*)(wsl_ + WS_ROPE);
    const float lg = log2f(1.0f - exp2f(-5.0f - (float)h));
    LAS unsigned char* KS = lds; LAS unsigned char* VS = lds + 32768; LAS unsigned char* RT = lds + 65536;
    const int tql = 32 * wq + r32; const size_t rowc = (size_t)bl * SEQ + n * 128 + tql;
    bf16x8 qf[4];
    { const bf16_t* qrow = proj + rowc * PROJW + PC_RQ + h * 64; const f32x2* tp = tab + ((size_t)ch * MC + rowc) * 32;
#pragma unroll
      for (int d0 = 0; d0 < 2; ++d0) { const u32x4 a = *(const u32x4*)(qrow + d0 * 16 + hi * 8), b = *(const u32x4*)(qrow + 32 + d0 * 16 + hi * 8); float o1[8], o2[8];
          rope8(o1, o2, a, b, tp + d0 * 16 + hi * 8); qf[d0] = __builtin_bit_cast(bf16x8, pack8f(o1)); qf[d0 + 2] = __builtin_bit_cast(bf16x8, pack8f(o2)); } }
    __syncthreads();
#pragma unroll
    for (int g = 0; g < 2; ++g) { const size_t r0 = (size_t)bl * SEQ + (2 * np + g) * 128;
        { const int key = tid >> 2, cp = tid & 3; const bf16_t* src = proj + (r0 + key) * PROJW + PC_RK + h * 64 + cp * 8;
          const u32x4 a = *(const u32x4*)src, b = *(const u32x4*)(src + 32); float o1[8], o2[8];
          rope8(o1, o2, a, b, tab + ((size_t)ch * MC + r0 + key) * 32 + cp * 8);
          LAS unsigned char* d = KS + (g * 2 + (key >> 6)) * 8192 + cp * 1024 + (key & 63) * 16;
          *(LAS u32x4*)d = pack8f(o1); *(LAS u32x4*)(d + 4096) = pack8f(o2); }
#pragma unroll
        for (int t2 = 0; t2 < 2; ++t2)
            *(LAS u32x4*)(VS + (g * 2 + t2) * 8192 + wid * 1024 + lane * 16) = *(const u32x4*)(proj + (r0 + 64 * t2 + 16 * (wid & 3) + (lane >> 2)) * PROJW + PC_RV + h * 64 + (wid >> 2) * 32 + (lane & 3) * 8); }
    { const int t = tid & 255; const float gdec = ex2(128.0f * lg); const float* kv0 = (const float*)(wsl_ + WS_R + R_KVT) + (size_t)(bh * 32) * 4096;
#pragma unroll
      for (int q = 0; q < 2; ++q) { const int task = t + 256 * q, v = task >> 3, kc = task & 7; f32x4 a0 = {0.f, 0.f, 0.f, 0.f}, a1 = {0.f, 0.f, 0.f, 0.f};
          for (int m = 0; m < n; ++m) { const float* s = kv0 + (size_t)m * 4096 + v * 64 + kc * 8; a0 = a0 * gdec + *(const f32x4*)s; a1 = a1 * gdec + *(const f32x4*)(s + 4); }
          *(LAS u32x4*)(RT + gw * 8192 + kc * 1024 + v * 16) = pack8(a0, a1); } }
    __syncthreads();
    f32x16 o[2];
    { f32x16 p0, p1; attn_qkt(p0, p1, RT + gw * 8192, qf, r32, hi); const float xi = ex2((float)(tql + 1) * lg); o[0] = p0 * xi; o[1] = p1 * xi; }
    for (int kt = 0; kt <= (wq >> 1); ++kt) { f32x16 p0, p1; attn_qkt(p0, p1, KS + (gw * 2 + kt) * 8192, qf, r32, hi);
#pragma unroll
        for (int r = 0; r < 16; ++r) { const int key = 64 * kt + crow(r, hi);
            p0[r] = (key <= tql) ? p0[r] * ex2((float)(tql - key) * lg) : 0.f; p1[r] = (key + 32 <= tql) ? p1[r] * ex2((float)(tql - key - 32) * lg) : 0.f; }
        bf16x8 pw[4]; pw[0] = pack_acc8(p0, 0); pw[1] = pack_acc8(p0, 1); pw[2] = pack_acc8(p1, 0); pw[3] = pack_acc8(p1, 1);
        attn_pv(o, VS + (gw * 2 + kt) * 8192, pw, lane, hi); }
    float s = 0.f;
#pragma unroll
    for (int r = 0; r < 16; ++r) s += o[0][r] + o[1][r];
    s += __shfl_xor(s, 32); const float mu = s * (1.0f / 64.0f); float q = 0.f;
#pragma unroll
    for (int r = 0; r < 16; ++r) { const float a = o[0][r] - mu, b = o[1][r] - mu; q += a * a + b * b; }
    q += __shfl_xor(q, 32); const float rs = 1.0f / sqrtf(q * (1.0f / 64.0f) + LN_EPS);
    const float* gw_ = PIN(IN_RETGN) + l_ * 256 + h * 64; const bf16_t* grow = proj + rowc * PROJW + PC_RG + h * 64;
#pragma unroll
    for (int d0 = 0; d0 < 2; ++d0)
#pragma unroll
        for (int g = 0; g < 4; ++g) { const int d = 32 * d0 + 8 * g + 4 * hi; const u32x2 gz = *(const u32x2*)(grow + d); const f32x4 w4 = *(const f32x4*)(gw_ + d);
            const float gg[4] = {__uint_as_float(gz.x << 16), __uint_as_float(gz.x & 0xffff0000u), __uint_as_float(gz.y << 16), __uint_as_float(gz.y & 0xffff0000u)};
#pragma unroll
            for (int e = 0; e < 4; ++e) o[d0][4 * g + e] = (o[d0][4 * g + e] - mu) * rs * w4[e] * siluf_(gg[e]); }
    store_ot(o, (bf16_t*)(wsl_ + WS_R + R_O) + (size_t)1 * MC * 256 + rowc * 256 + h * 64, hi);
    __syncthreads();
}
constexpr int NL_KC = 36864, NL_VC = 69632, NL_IMPM = 102400, NL_IMPS = 118784, NL_SELM = 135424;
__device__ __forceinline__ void nsa_unit(const Params& p, int idx, LAS unsigned char* lds, const int tid_in_) {
    int tid = tid_in_; asm volatile("" : "+v"(tid)); unsigned char* wsl_ = ws_late();
    const int lane = tid & 63, wid = tid >> 6, r32 = lane & 31, hi = lane >> 5, tl = r32 >> 2, hd = r32 & 3;
    const int ib = 63 - idx / BC, bl = idx % BC;
    const bf16_t* proj = (const bf16_t*)(wsl_ + WS_R + R_PROJ); const float* sm = (const float*)(wsl_ + WS_R + R_SM);
    const int tokl = 8 * wid + tl, tq = ib * 64 + tokl; const size_t rowc = (size_t)bl * SEQ + tq;
    bf16x8 qf[4]; load_qf(qf, proj + rowc * PROJW + PC_NQ + hd * 64, hi);
    const float g0 = sigmoidf_(sm[rowc * 32 + 8 + hd * 3 + 0]), g1 = sigmoidf_(sm[rowc * 32 + 8 + hd * 3 + 1]), g2 = sigmoidf_(sm[rowc * 32 + 8 + hd * 3 + 2]);
    f32x16 of[2];
    const int ntc = min(3, (4 * ib + 2) >> 6) + 1;
    {
        const bf16_t* kc = (const bf16_t*)(wsl_ + WS_R + R_KCMP) + (size_t)bl * 256 * 64; const bf16_t* vc = kc + (size_t)BC * 256 * 64;
        __syncthreads();
        for (int tt = 0; tt < ntc; ++tt) {
            *(LAS u32x4*)(lds + NL_KC + tt * 8192 + wid * 1024 + lane * 16) = *(const u32x4*)(kc + (size_t)(tt * 64 + lane) * 64 + wid * 8);
            *(LAS u32x4*)(lds + NL_VC + tt * 8192 + wid * 1024 + lane * 16) = *(const u32x4*)(vc + (size_t)(tt * 64 + 16 * (wid & 3) + (lane >> 2)) * 64 + (wid >> 2) * 32 + (lane & 3) * 8); }
        __syncthreads();
        float m = -INFINITY, l = 0.f;
        for (int tt = 0; tt < ntc; ++tt) { f32x16 p0, p1; attn_qkt(p0, p1, lds + NL_KC + tt * 8192, qf, r32, hi);
#pragma unroll
            for (int r = 0; r < 16; ++r) { const int n0 = 64 * tt + crow(r, hi), n1 = n0 + 32; if (n0 >= 255 || 16 * n0 + 31 > tq) p0[r] = -INFINITY; if (n1 >= 255 || 16 * n1 + 31 > tq) p1[r] = -INFINITY; }
            float mt = p0[0];
#pragma unroll
            for (int r = 1; r < 16; ++r) mt = fmaxf(mt, p0[r]);
#pragma unroll
            for (int r = 0; r < 16; ++r) mt = fmaxf(mt, p1[r]);
            mt = fmaxf(mt, __shfl_xor(mt, 32));
            const float mn = fmaxf(m, mt), ms = (mn == -INFINITY) ? 0.f : mn; float s = 0.f;
#pragma unroll
            for (int r = 0; r < 16; ++r) s += ex2(p0[r] - ms) + ex2(p1[r] - ms);
            l = l * ex2(m - ms) + s; m = mn; }
        l += __shfl_xor(l, 32);
        const float inv = (l > 0.f) ? 1.0f / l : 0.f, ms = (m == -INFINITY) ? 0.f : m;
        LAS float* impm = (LAS float*)(lds + NL_IMPM); LAS float* imps = (LAS float*)(lds + NL_IMPS);
        f32x16 oc[2]; oc[0] = (f32x16){}; oc[1] = (f32x16){};
        for (int tt = 0; tt < ntc; ++tt) { f32x16 p0, p1; attn_qkt(p0, p1, lds + NL_KC + tt * 8192, qf, r32, hi);
#pragma unroll
            for (int r = 0; r < 16; ++r) { const int n0 = 64 * tt + crow(r, hi), n1 = n0 + 32;
                p0[r] = (n0 >= 255 || 16 * n0 + 31 > tq) ? 0.f : ex2(p0[r] - ms) * inv; p1[r] = (n1 >= 255 || 16 * n1 + 31 > tq) ? 0.f : ex2(p1[r] - ms) * inv; }
#pragma unroll
            for (int g = 0; g < 4; ++g) {
                float ma = p0[4 * g] + p0[4 * g + 1] + p0[4 * g + 2] + 0.5f * p0[4 * g + 3], sa = 0.5f * p0[4 * g + 3];
                float mb = p1[4 * g] + p1[4 * g + 1] + p1[4 * g + 2] + 0.5f * p1[4 * g + 3], sb = 0.5f * p1[4 * g + 3];
                ma += __shfl_xor(ma, 1); ma += __shfl_xor(ma, 2); sa += __shfl_xor(sa, 1); sa += __shfl_xor(sa, 2);
                mb += __shfl_xor(mb, 1); mb += __shfl_xor(mb, 2); sb += __shfl_xor(sb, 1); sb += __shfl_xor(sb, 2);
                if (hd == 0) { const int ja = 16 * tt + 2 * g + hi, jb = ja + 8;
                    impm[tokl * 64 + ja] = ma; imps[tokl * 65 + ja + 1] = sa; impm[tokl * 64 + jb] = mb; imps[tokl * 65 + jb + 1] = sb; } }
            bf16x8 pw[4]; pw[0] = pack_acc8(p0, 0); pw[1] = pack_acc8(p0, 1); pw[2] = pack_acc8(p1, 0); pw[3] = pack_acc8(p1, 1);
            attn_pv(oc, lds + NL_VC + tt * 8192, pw, lane, hi); }
        of[0] = oc[0] * g0; of[1] = oc[1] * g0;
        LAS unsigned long long* selm = (LAS unsigned long long*)(lds + NL_SELM);
        for (int t8 = 0; t8 < 8; ++t8) { const int tk = 8 * wid + t8; const int j = lane;
            float imp = (j < 16 * ntc) ? impm[tk * 64 + j] + ((j > 0) ? imps[tk * 65 + j] : 0.f) : 0.f;
            const bool forced = (j == 0) || (j == ib) || (j == ib - 1);
            const float score = forced ? 1.0e4f : ((j <= ib) ? imp : -1.0f);
            int rank = 0;
#pragma unroll
            for (int jj = 0; jj < 64; ++jj) { const float sj = __uint_as_float(__builtin_amdgcn_readlane(__float_as_uint(score), jj)); rank += ((sj > score) || (sj == score && jj < j)) ? 1 : 0; }
            const unsigned long long mk = __ballot((rank < 16) && (j <= ib));
            if (lane == 0) selm[tk] = mk; }
    }
    __syncthreads();
    unsigned long long mymask, umask;
    { const LAS unsigned long long* selm = (const LAS unsigned long long*)(lds + NL_SELM); mymask = selm[tokl];
      unsigned long long u = selm[lane]; unsigned lo = (unsigned)u, hi32 = (unsigned)(u >> 32);
#pragma unroll
      for (int o = 32; o >= 1; o >>= 1) { lo |= __shfl_xor(lo, o); hi32 |= __shfl_xor(hi32, o); }
      umask = ((unsigned long long)hi32 << 32) | lo; umask = __builtin_amdgcn_readfirstlane((unsigned)umask) | ((unsigned long long)__builtin_amdgcn_readfirstlane((unsigned)(umask >> 32)) << 32); }
    for (int br = 0; br < 2; ++br) {
        f32x16 o[2]; o[0] = (f32x16){}; o[1] = (f32x16){}; float m = -INFINITY, l = 0.f;
        SelF f; f.umask = br ? ~0ull : umask; f.mymask = br ? ~0ull : mymask; f.tq = tq; f.klo = br ? tq - 512 : -1; f.hi = hi;
        const bf16_t* nkv2 = (const bf16_t*)(ws_late() + WS_R + R_NKV);
        flash_loop(f, br ? max(0, ib - 8) : 0, ib + 1, nkv2 + (size_t)(2 + 2 * br) * (NKV_SEG / 2) + (size_t)bl * SEQ * 64, nkv2 + (size_t)(3 + 2 * br) * (NKV_SEG / 2) + (size_t)bl * SEQ * 64, 64, nullptr, qf, o, m, l, lds, tid);
        l += __shfl_xor(l, 32); const float sc = (l > 0.f) ? (br ? g2 : g1) / l : 0.f; of[0] += o[0] * sc; of[1] += o[1] * sc;
    }
    store_ot(of, (bf16_t*)(ws_late() + WS_R + R_O) + (size_t)2 * MC * 256 + rowc * 256 + hd * 64, hi);
}

constexpr int LDS_MISC = LDS_BYTES - 256;
constexpr size_t LWS = ((LW_BYTES + MiB - 1) / MiB) * MiB;
#define PHASE_PRE const int tid = fresh_tid(); int l, ch; { int k_; bool b_; step_decode(__builtin_amdgcn_readfirstlane(((volatile LAS int*)lds_at(LDS_MISC + 176))[0]), k_, l, ch, b_); } \
    Params p; ptab_load(p); LAS unsigned char* lds = lds_at(0); const int G = NWG; \
    const int c = __builtin_amdgcn_readfirstlane(((volatile LAS int*)(lds + LDS_MISC + 176))[2]); (void)lds; (void)G; (void)c; (void)l; (void)ch; \
    volatile LAS int* qslot = (volatile LAS int*)(lds + LDS_MISC + 16); (void)qslot;
#define LW_ (p.ws + WS_W + (size_t)l * LWS)
#define LWO_ ((unsigned)(WS_W + (size_t)l * LWS))
#define HC_ ((unsigned)(WS_H + (size_t)ch * MC * 1024 * 2))
#define QCTR_ ((unsigned*)(p.ws + WS_CTL) + CW_Q + 64 * ((l * NCHUNK + ch) * 8) + 8192 * __builtin_amdgcn_readfirstlane(((volatile LAS int*)lds_at(LDS_MISC + 176))[3]))
__device__ __forceinline__ int tid_out(int t) { asm volatile("" : "+v"(t)); return t; }
__device__ __forceinline__ int fresh_tid() {
    LAS unsigned* ctr = (LAS unsigned*)lds_at(LDS_MISC + 192);
    unsigned z = 0u; asm volatile("" : "+v"(z));
    const int lane = (int)__builtin_amdgcn_mbcnt_hi(~0u, __builtin_amdgcn_mbcnt_lo(~0u, z));
    unsigned t = 0u; if (lane == 0) t = __hip_atomic_fetch_add(ctr, 1u, __ATOMIC_RELAXED, __HIP_MEMORY_SCOPE_WORKGROUP);
    t = (unsigned)__builtin_amdgcn_readfirstlane((int)t);
    __syncthreads();
    return (int)(((t & 7u) << 6) | (unsigned)lane);
}
__device__ __forceinline__ void step_decode(int s, int& k, int& l, int& ch, bool& bar);
#define PHFN(name) static __device__ __noinline__ void name()
#define PHFI(name) static __device__ __forceinline__ void name()

PHFI(ph_p0) { PHASE_PRE
    constexpr int N_ADA = 192, N_CB = 4, N_ROPE = MTOK * 32 / 4096, N_T = 2 * TJ_TOTAL;
    for (int it = c; it < N_ADA + N_CB + N_ROPE + N_T; it += G) {
        if (it < N_ADA) p0_ada(p, it, (LAS float*)lds, tid);
        else if (it < N_ADA + N_CB) p0_cbias(p, it - N_ADA, tid);
        else if (it < N_ADA + N_CB + N_ROPE) p0_rope(p, it - N_ADA - N_CB, tid);
        else p0_transpose(p, it - N_ADA - N_CB - N_ROPE, (LAS float*)lds, tid);
    }
}
PHFN(ph_p1) { PHASE_PRE prep_first(p, tid, c); }
PHFN(ph_a1) { PHASE_PRE
    DenseSched S; S.A = HC_; S.Bt = LWO_ + (unsigned)LW_WIN; S.tA = 256u * 1024 * 2; S.tB = 256u * 1024 * 2; S.aBr = 0; S.nM = MC / 256; S.nN = NPROJ / 256; S.G = G; S.c = c; S.pnShift = 0;
    EpiProj E;
    pg8::gemm_phase<EpiProj, DenseSched, true, false>(lds, 1024, 1024, 1024, S, E, tid, (const char*)p.ws);
}
PHFN(ph_a2a) { PHASE_PRE
    if (c < 2 * BC) {
        const int which = c & 1, bl = c >> 1;
        OneSched S; S.has = true; S.u0.pm = bl; S.u0.pn = 0; S.u0.aux = which; S.u0.nvalid = 256; S.u0.rows = 0u;
        S.u0.a = (unsigned)(WS_R + R_NKV + (size_t)which * NKV_SEG + (size_t)bl * SEQ * 64 * 2); S.u0.b = LWO_ + (unsigned)(LW_CW1 + (size_t)which * 256 * 2048 * 2);
        EpiH1 E; E.h1 = (bf16_t*)(p.ws + WS_R + R_H1); E.cbias = (const float*)(p.ws + WS_CBIAS) + l * 512;
        pg8::gemm_phase<EpiH1, OneSched, true, false>(lds, 2048, 1024, 2048, S, E, tid, (const char*)p.ws);
        VM_WAIT(); __syncthreads(); __builtin_amdgcn_fence(__ATOMIC_ACQUIRE, "agent"); VM_WAIT(); __syncthreads();
    }
}
PHFN(ph_a2b) { PHASE_PRE
    if (c < 2 * BC) {
        const int which = c & 1, bl = c >> 1;
        OneSched S2; S2.has = true; S2.u0.pm = bl; S2.u0.pn = 0; S2.u0.aux = which; S2.u0.nvalid = 256; S2.u0.rows = 0u;
        S2.u0.a = (unsigned)(WS_R + R_H1 + ((size_t)which * BC * 256 + (size_t)bl * 256) * 256 * 2); S2.u0.b = LWO_ + (unsigned)(LW_CW2 + (size_t)which * 256 * 256 * 2);
        EpiCmp2 E2; E2.kc = (bf16_t*)(p.ws + WS_R + R_KCMP);
        pg8::gemm_phase<EpiCmp2, OneSched, true, false>(lds, 256, 256, 256, S2, E2, tid, (const char*)p.ws);
    }
}
PHFI(ph_a2c) { PHASE_PRE
    for (;;) { const int u = q_next(QCTR_ + 0, qslot, tid); if (u >= BC * 4 * 64) break; gdn_prep_unit(p, l, u, lds, tid); }
}
PHFN(ph_a2d) { PHASE_PRE
    for (;;) { const int u = q_next(QCTR_ + 64, qslot, tid); if (u >= BC * 4) break; fox_cum_item(p, l, u, (LAS float*)lds, tid); }
    for (;;) { const int u = q_next(QCTR_ + 320, qslot, tid); if (u >= BC * 4 * 32) break; ret_kv_unit(p, ch, u, lds, tid); }
}
PHFN(ph_a3a) { PHASE_PRE if (c < BC * 4) gdn_scan_item(p, l, ch, c, lds, tid); }
PHFI(ph_a3b) { PHASE_PRE for (;;) { const int u = q_next(QCTR_ + 128, qslot, tid); if (u >= BC * 4 * 16) break; fox_unit(p, u, lds, tid); } }
PHFI(ph_a3c) { PHASE_PRE for (;;) { const int u = q_next(QCTR_ + 192, qslot, tid); if (u >= BC * 4 * 16) break; ret_out_unit(p, l, ch, u, lds, tid); } }
PHFI(ph_a3d) { PHASE_PRE for (;;) { const int u = q_next(QCTR_ + 256, qslot, tid); if (u >= BC * 64) break; nsa_unit(p, u, lds, tid); } }
PHFN(ph_a5) { PHASE_PRE
    DenseSched S; S.A = (unsigned)(WS_R + R_O); S.Bt = LWO_ + (unsigned)LW_BPT; S.tA = 256u * 256 * 2; S.tB = 256u * 256 * 2; S.aBr = (unsigned)((size_t)MC * 256 * 2); S.nM = MC / 256; S.nN = 16; S.G = G; S.c = c; S.pnShift = 2;
    EpiP E;
    pg8::gemm_phase<EpiP, DenseSched, true, false>(lds, 256, 256, 256, S, E, tid, (const char*)p.ws);
}
PHFN(ph_a6) { PHASE_PRE
    DenseSched S; S.A = HC_; S.Bt = LWO_ + (unsigned)LW_WGV; S.tA = 256u * 1024 * 2; S.tB = 256u * 1024 * 2; S.aBr = 0; S.nM = MC / 256; S.nN = 16; S.G = G; S.c = c; S.pnShift = 0;
    EpiGate E;
    pg8::gemm_phase<EpiGate, DenseSched, true, false>(lds, 1024, 1024, 1024, S, E, tid, (const char*)p.ws);
}
PHFN(ph_a7) { PHASE_PRE
    DenseSched S; S.A = (unsigned)(WS_R + R_Y); S.Bt = LWO_ + (unsigned)LW_WOT; S.tA = 256u * 1024 * 2; S.tB = 256u * 1024 * 2; S.aBr = 0; S.nM = MC / 256; S.nN = 4; S.G = G; S.c = c; S.pnShift = 0;
    EpiOut E; E.row_base = ch * MC;
    pg8::gemm_phase<EpiOut, DenseSched, true, false>(lds, 1024, 1024, 1024, S, E, tid, (const char*)p.ws);
}
PHFN(ph_b0) { PHASE_PRE prep_moe(p, l, (LAS float*)lds, tid, c); }
__device__ __forceinline__ void moe_tables(const Params& p, int l, LAS int* mcnt, LAS int* mpre, const int tid) {
    __syncthreads();
    if (tid < 16) mcnt[tid] = (int)((unsigned*)(p.ws + WS_CTL))[CW_CNT + l * 64 + tid];
    __syncthreads();
    if (tid == 0) { int s = 0; for (int e = 0; e < 16; ++e) { mpre[e] = s; s += (mcnt[e] + 255) >> 8; } mpre[16] = s; }
    __syncthreads();
}
PHFN(ph_b1) { PHASE_PRE
    LAS int* mcnt = (LAS int*)(lds + LDS_MISC + 32); LAS int* mpre = mcnt + 16; moe_tables(p, l, mcnt, mpre, tid);
    MoeSched S; S.pre = mpre; S.cnt = mcnt; S.wsb = (const char*)p.ws; S.A = (unsigned)WS_H; S.W = LWO_ + (unsigned)LW_W13;
    S.wE = 1024u * 1024 * 2; S.wT = 256u * 1024 * 2; S.aT = 0; S.G = G; S.c = c; S.gatherA = true;
    EpiMoe1 E;
    pg8::gemm_phase<EpiMoe1, MoeSched, true, true>(lds, 1024, 1024, 1024, S, E, tid, (const char*)p.ws);
}
PHFN(ph_b2) { PHASE_PRE
    LAS int* mcnt = (LAS int*)(lds + LDS_MISC + 32); LAS int* mpre = mcnt + 16; moe_tables(p, l, mcnt, mpre, tid);
    MoeSched S; S.pre = mpre; S.cnt = mcnt; S.wsb = (const char*)p.ws; S.A = (unsigned)(WS_R + R_HID); S.W = LWO_ + (unsigned)LW_W2;
    S.wE = 1024u * 512 * 2; S.wT = 256u * 512 * 2; S.aT = 256u * 512 * 2; S.G = G; S.c = c; S.gatherA = false;
    EpiMoe2 E;
    pg8::gemm_phase<EpiMoe2, MoeSched, true, false>(lds, 512, 512, 512, S, E, tid, (const char*)p.ws);
}
PHFN(ph_b3) { PHASE_PRE prep_next(p, l, l == DEPTH - 1, tid, c); }

constexpr int STEPS_CHUNK = 12, STEPS_LAYER = NCHUNK * STEPS_CHUNK + 4, N_STEPS = 2 + DEPTH * STEPS_LAYER;
__device__ __forceinline__ void step_decode(int s, int& k, int& l, int& ch, bool& bar) {
    if (s < 2) { k = s; l = 0; ch = 0; bar = true; return; }
    const int t = s - 2; l = t / STEPS_LAYER; const int r = t % STEPS_LAYER;
    if (r < NCHUNK * STEPS_CHUNK) { ch = r / STEPS_CHUNK; const int q = r % STEPS_CHUNK; k = 2 + q; bar = !(q == 1 || q == 2 || q == 3 || q == 5 || q == 6 || q == 7); }
    else { ch = 0; k = 14 + (r - NCHUNK * STEPS_CHUNK); bar = true; }
}
__global__ void __launch_bounds__(NTHR, 2) __attribute__((disable_tail_calls)) mega_fwd(Params p0_) {
    LAS unsigned char* lds = lds_at(0);
    const int tid = threadIdx.x;
    volatile LAS unsigned* xbw = (volatile LAS unsigned*)(lds + LDS_MISC);
    volatile LAS int* st = (volatile LAS int*)(lds + LDS_MISC + 176);
    if (tid == 0) { xbw[0] = 0u; xbw[1] = 0u; xbw[2] = 0u; xbw[3] = 0u; st[0] = p0_.ph_lo; st[1] = p0_.ph_hi; st[2] = blockIdx.x; st[3] = 0; *(volatile LAS unsigned*)(lds + LDS_MISC + 200) = 0u; *(volatile LAS unsigned*)(lds + LDS_MISC + 192) = 0u; }
    ptab_store(p0_, tid);
    __syncthreads();
    (void)xcd_barrier_post((unsigned*)(p0_.ws + WS_CTL) + CW_BAR, xbw, tid);
    for (;;) {
        {
          LAS unsigned char* mb_ = lds_at(LDS_MISC); volatile LAS int* st_ = (volatile LAS int*)(mb_ + 176);
          const int s = __builtin_amdgcn_readfirstlane(st_[0]), e = __builtin_amdgcn_readfirstlane(st_[1]);
          if (s >= e) break;
          int k, l, ch; bool bar; step_decode(s, k, l, ch, bar);
          switch (k) {
          case 0: ph_p0(); break;
          case 1: ph_p1(); break;
          case 2: ph_a1(); break;
          case 3: ph_a2a(); break;
          case 4: ph_a2b(); break;
          case 5: ph_a2c(); break;
          case 6: ph_a2d(); break;
          case 7: ph_a3a(); break;
          case 8: ph_a3b(); break;
          case 9: ph_a3c(); break;
          case 10: ph_a3d(); break;
          case 11: ph_a5(); break;
          case 12: ph_a6(); break;
          case 13: ph_a7(); break;
          case 14: ph_b0(); break;
          case 15: ph_b1(); break;
          case 16: ph_b2(); break;
          default: ph_b3(); break;
          } }
        { const int tid = fresh_tid(); LAS unsigned char* mb_ = lds_at(LDS_MISC); volatile LAS int* st_ = (volatile LAS int*)(mb_ + 176);
          volatile LAS unsigned* xbw_ = (volatile LAS unsigned*)mb_;
          const int s = __builtin_amdgcn_readfirstlane(st_[0]), e = __builtin_amdgcn_readfirstlane(st_[1]);
          int k, l, ch; bool bar; step_decode(s, k, l, ch, bar);
#ifdef DUP_MASK
          const bool adv_ = !(((DUP_MASK >> k) & 1) && __builtin_amdgcn_readfirstlane(st_[3]) == 0);
#else
          const bool adv_ = true;
#endif
          if (adv_ && bar && s + 1 < e) { XcdBarrier b; b.bar = (unsigned*)((unsigned char*)ptab_get(28) + WS_CTL) + CW_BAR; b.x = xb_xcc_id(); b.st = xbw_;
#ifdef PROBE_BARWAIT
              __syncthreads(); const unsigned long long t0_ = __builtin_amdgcn_s_memrealtime();
              xcd_barrier(b, tid);
              const unsigned long long t1_ = __builtin_amdgcn_s_memrealtime(); if (tid == 0) { volatile LAS unsigned* ac_ = (volatile LAS unsigned*)(mb_ + 200); ac_[0] = ac_[0] + (unsigned)(t1_ - t0_); }
#else
              xcd_barrier(b, tid);
#endif
          }
          __syncthreads();
#ifdef DUP_MASK
          const int rp = __builtin_amdgcn_readfirstlane(st_[3]);
          if (((DUP_MASK >> k) & 1) && rp == 0) { if (tid == 0) st_[3] = 1; }
          else { if (tid == 0) { st_[3] = 0; st_[0] = s + 1; } }
#else
          if (tid == 0) st_[0] = s + 1;
#endif
          __syncthreads(); }
    }
#ifdef PROBE_BARWAIT
    { const unsigned w_ = *(volatile LAS unsigned*)(lds_at(LDS_MISC) + 200); const unsigned long long t0_ = __builtin_amdgcn_s_memrealtime();
      while (__builtin_amdgcn_s_memrealtime() - t0_ < (unsigned long long)w_) __builtin_amdgcn_s_sleep(8); }
#endif
}

extern "C" void kernel_launch(void* const* d_in, const int* in_sizes, int n_in, void* d_out, int out_size, void* d_ws, size_t ws_size, hipStream_t stream) {
    (void)in_sizes; (void)out_size;
    if (n_in < 27 || ws_size < WS_END) { fprintf(stderr, "kernel_launch: unexpected inputs (n_in %d, ws %zu < %zu)\n", n_in, ws_size, (size_t)WS_END); return; }
    static bool attr_set = false;
    if (!attr_set) { (void)hipFuncSetAttribute((const void*)mega_fwd, hipFuncAttributeMaxDynamicSharedMemorySize, LDS_BYTES); attr_set = true; }
    Params p{};
    for (int i = 0; i < 27; ++i) p.in[i] = (const float*)d_in[i];
    p.out = (float*)d_out; p.ws = (unsigned char*)d_ws;
    (void)hipMemsetAsync((unsigned char*)d_ws + WS_CTL, 0, CTL_BYTES, stream);
#ifndef MK_CUTS
    p.ph_lo = 0; p.ph_hi = N_STEPS;
    hipLaunchKernelGGL(mega_fwd, dim3(NWG), dim3(NTHR), LDS_BYTES, stream, p);
#else
    { static const int cuts[] = {MK_CUTS, N_STEPS}; int lo = 0;
      for (unsigned i = 0; i < sizeof(cuts) / sizeof(cuts[0]); ++i) { p.ph_lo = lo; p.ph_hi = cuts[i]; lo = cuts[i]; hipLaunchKernelGGL(mega_fwd, dim3(NWG), dim3(NTHR), LDS_BYTES, stream, p); } }
#endif
}
```

```cpp
#include <hip/hip_runtime.h>
#include <stdint.h>
#include <stdio.h>

#define GAS __attribute__((address_space(1)))
#define LAS __attribute__((address_space(3)))
typedef unsigned short bf16_t;
typedef short bf16x8 __attribute__((ext_vector_type(8)));
typedef short s16x4 __attribute__((ext_vector_type(4)));
typedef float f32x2 __attribute__((ext_vector_type(2)));
typedef float f32x4 __attribute__((ext_vector_type(4)));
typedef float f32x16 __attribute__((ext_vector_type(16)));
typedef unsigned u32x2 __attribute__((ext_vector_type(2)));
typedef unsigned u32x4 __attribute__((ext_vector_type(4)));
typedef __bf16 bf16x2_t __attribute__((ext_vector_type(2)));

constexpr int D_MODEL = 1024, BATCH = 16, SEQ = 4096, DEPTH = 2, MTOK = BATCH * SEQ;
constexpr int NCHUNK = 2, BC = BATCH / NCHUNK, MC = BC * SEQ;
constexpr int NPROJ = 3584, PROJW = 3072;
constexpr float DN_ALPHA = 1.4142135623730951f;
constexpr float LN_EPS = 1e-5f;
constexpr float LOG2E = 1.4426950408889634f;
constexpr float QSCALE = 0.125f * 1.4426950408889634f;
constexpr int NWG = 256, NTHR = 512;
constexpr int LDS_BYTES = 163840;

constexpr int PC_GQ = 0, PC_GK = 256, PC_GV = 512, PC_GZ = 768, PC_RQ = 1024, PC_RK = 1280, PC_RV = 1536, PC_RG = 1792, PC_NQ = 2048, PC_FQ = 2304, PC_FK = 2560, PC_FV = 2816;

constexpr size_t MiB = 1ull << 20;
constexpr size_t WS_CTL = 0;
constexpr size_t CTL_BYTES = 1 * MiB;
constexpr size_t WS_MOD = 1 * MiB;
constexpr size_t WS_ROPE = 2 * MiB;
constexpr size_t WS_STATS = 18 * MiB;
constexpr size_t WS_CBIAS = 19 * MiB;
constexpr size_t WS_W = 20 * MiB;
constexpr size_t LW_WIN = 0;
constexpr size_t LW_WGV = LW_WIN + (size_t)NPROJ * 1024 * 2;
constexpr size_t LW_BPT = LW_WGV + (size_t)4096 * 1024 * 2;
constexpr size_t LW_WOT = LW_BPT + (size_t)4096 * 256 * 2;
constexpr size_t LW_W13 = LW_WOT + (size_t)1024 * 1024 * 2;
constexpr size_t LW_W2 = LW_W13 + (size_t)16 * 1024 * 1024 * 2;
constexpr size_t LW_CW1 = LW_W2 + (size_t)16 * 1024 * 512 * 2;
constexpr size_t LW_CW2 = LW_CW1 + (size_t)2 * 256 * 2048 * 2;
constexpr size_t LW_BYTES = LW_CW2 + (size_t)2 * 256 * 256 * 2;
constexpr size_t WS_H = WS_W + 2 * ((LW_BYTES + MiB - 1) / MiB) * MiB;
constexpr size_t WS_R = WS_H + 128 * MiB;
constexpr size_t R_PROJ = 0;
constexpr size_t R_GDN = R_PROJ + (size_t)MC * PROJW * 2;
constexpr size_t GDN_UNIT_BYTES = 5 * 8192;
constexpr size_t R_P = 0;
constexpr size_t R_NKV = R_GDN + (size_t)BC * 4 * 64 * GDN_UNIT_BYTES;
constexpr size_t NKV_SEG = (size_t)(MC + 64) * 64 * 2;
constexpr size_t R_SM = R_NKV + 6 * NKV_SEG;
constexpr size_t R_CUM = R_SM + (size_t)MC * 32 * 4;
constexpr size_t R_GG = R_CUM + (size_t)BC * 4 * 4096 * 4;
constexpr size_t R_KCMP = R_GG + (size_t)BC * 4 * 64 * 4 + 768;
constexpr size_t R_H1 = R_KCMP + (size_t)2 * BC * 256 * 64 * 2;
constexpr size_t R_O = R_H1 + (size_t)2 * BC * 256 * 256 * 2;
constexpr size_t R_Y = R_O + (size_t)4 * MC * 256 * 2;
constexpr size_t R_KVT = R_Y + (size_t)MC * 1024 * 2;
constexpr size_t R_MIX_END = R_KVT + (size_t)BC * 4 * 32 * 4096 * 4;
static_assert(R_NKV >= (size_t)MC * 4096 * 2, "P overlay fits under PROJ+GDN");
constexpr size_t R_LIST = 0;
constexpr size_t R_CW = R_LIST + (size_t)16 * MTOK * 4;
constexpr size_t R_HID = R_CW + (size_t)16 * MTOK * 4;
constexpr size_t R_OUT2 = R_HID + (size_t)(2 * MTOK + 4096) * 512 * 2;
constexpr size_t R_MOE_END = R_OUT2 + (size_t)2 * MTOK * 1024 * 2;
constexpr size_t WS_T = WS_R + (((R_MIX_END > R_MOE_END ? R_MIX_END : R_MOE_END) + MiB - 1) / MiB) * MiB;
constexpr size_t WS_END = WS_T + (size_t)MTOK * 1024 * 2;

constexpr int CW_BAR = 4096;
constexpr int CW_CNT = 8192;
constexpr int CW_Q = 8448;
constexpr int CW_G = 65536;

__device__ __forceinline__ float bf2f(bf16_t v) { return __uint_as_float(((unsigned)v) << 16); }
__device__ __forceinline__ unsigned pk2(float lo, float hi) { f32x2 v = {lo, hi}; bf16x2_t b = __builtin_convertvector(v, bf16x2_t); return __builtin_bit_cast(unsigned, b); }
__device__ __forceinline__ bf16_t f2bf(float f) { return (bf16_t)(pk2(f, 0.f) & 0xffffu); }
__device__ __forceinline__ float ex2(float x) { return __builtin_amdgcn_exp2f(x); }
__device__ __forceinline__ float sigmoidf_(float x) { return __builtin_amdgcn_rcpf(1.0f + __expf(-x)); }
__device__ __forceinline__ float siluf_(float x) { return x * __builtin_amdgcn_rcpf(1.0f + __expf(-x)); }
__device__ __forceinline__ int crow(int r, int hi) { return (r & 3) + 8 * (r >> 2) + 4 * hi; }
template <int M> __device__ __forceinline__ float swz_xor(float v) { return __builtin_bit_cast(float, __builtin_amdgcn_ds_swizzle(__builtin_bit_cast(int, v), 0x1f | (M << 10))); }
template <int M> __device__ __forceinline__ unsigned swz_xor_u(unsigned v) { return (unsigned)__builtin_amdgcn_ds_swizzle((int)v, 0x1f | (M << 10)); }
__device__ __forceinline__ float x32_sum(float v) { auto r = __builtin_amdgcn_permlane32_swap(__float_as_uint(v), __float_as_uint(v), false, false); return __uint_as_float(r[0]) + __uint_as_float(r[1]); }
__device__ __forceinline__ float x32_max(float v) { auto r = __builtin_amdgcn_permlane32_swap(__float_as_uint(v), __float_as_uint(v), false, false); return fmaxf(__uint_as_float(r[0]), __uint_as_float(r[1])); }
__device__ __forceinline__ unsigned x32_or(unsigned v) { auto r = __builtin_amdgcn_permlane32_swap(v, v, false, false); return r[0] | r[1]; }
__device__ __forceinline__ float shfl_up_l(float v, int o, int lane) { return __builtin_bit_cast(float, __builtin_amdgcn_ds_bpermute((lane - o) << 2, __builtin_bit_cast(int, v))); }
__device__ __forceinline__ float wave_sum(float v) {
    v += swz_xor<1>(v); v += swz_xor<2>(v); v += swz_xor<4>(v); v += swz_xor<8>(v); v += swz_xor<16>(v);
    return x32_sum(v);
}
__device__ __forceinline__ float ninf_() { float z = -INFINITY; asm volatile("" : "+v"(z)); return z; }
__device__ __forceinline__ f32x16 z16() { float z = 0.f; asm volatile("" : "+v"(z)); f32x16 r;
#pragma unroll
    for (int i = 0; i < 16; ++i) r[i] = z;
    return r; }
#define VM_WAIT() asm volatile("s_waitcnt vmcnt(0)" ::: "memory")
#define MF32(a, b, c) __builtin_amdgcn_mfma_f32_32x32x16_bf16(a, b, c, 0, 0, 0)

#define XB_TMO      128
#define XB_XCNT(j)  (256  + 64 * (j))
#define XB_XSUB(j)  (1280 + 64 * (j))
#define XB_XGEN(j)  (2304 + 64 * (j))
#define XB_TOP      3328
#define XB_TOPGEN   3392
#define XCD_BAR_WORDS 3456
#define XB_SPIN_CAP (1u << 22)

__device__ __forceinline__ unsigned xb_ld(unsigned* p)              { return __hip_atomic_load(p, __ATOMIC_RELAXED, __HIP_MEMORY_SCOPE_AGENT); }
__device__ __forceinline__ unsigned xb_add(unsigned* p, unsigned v) { return __hip_atomic_fetch_add(p, v, __ATOMIC_RELAXED, __HIP_MEMORY_SCOPE_AGENT); }
__device__ __forceinline__ unsigned xb_xcc_id() { return (unsigned)__builtin_amdgcn_s_getreg((3 << 11) | 20) & 0xFu; }
#define XB_SPIN(cond, bar) do { unsigned _sp = 0; while (cond) { __builtin_amdgcn_s_sleep(1); \
    if ((++_sp & 255u) == 0u) { if (xb_ld(&(bar)[XB_TMO])) break; if (_sp > XB_SPIN_CAP) { atomicAdd(&(bar)[XB_TMO], 1u); break; } } } } while (0)

struct XcdBarrier { unsigned* bar; unsigned x; volatile LAS unsigned* st; };

__device__ __forceinline__ XcdBarrier xcd_barrier_post(unsigned* bar, volatile LAS unsigned* st, int tid) {
    XcdBarrier b; b.bar = bar; b.x = xb_xcc_id(); b.st = st;
    if (tid == 0) (void)xb_add(&bar[XB_XCNT(b.x)], 1u);
    return b;
}
__device__ __forceinline__ void xcd_barrier_complete(unsigned* bar, unsigned x, unsigned& nloc, unsigned& nx) {
    const unsigned G = NWG;
    unsigned sum, cnt, mine, sp = 0u;
    for (;;) {
        sum = 0u; cnt = 0u; mine = 0u;
#pragma unroll
        for (unsigned j = 0; j < 16; ++j) { const unsigned c = xb_ld(&bar[XB_XCNT(j)]); sum += c; cnt += (c > 0u) ? 1u : 0u; mine = (j == x) ? c : mine; }
        if (sum == G) break;
        __builtin_amdgcn_s_sleep(1);
        if ((++sp & 255u) == 0u) { if (xb_ld(&bar[XB_TMO])) break; if (sp > XB_SPIN_CAP) { atomicAdd(&bar[XB_TMO], 1u); break; } }
    }
    nloc = mine > 0u ? mine : 1u; nx = cnt > 0u ? cnt : 1u;
}
__device__ __forceinline__ void xcd_barrier(const XcdBarrier& b, int tid) {
    asm volatile("s_waitcnt vmcnt(0)" ::: "memory");
    __syncthreads();
    if (tid == 0) {
        unsigned* bar = b.bar;
        __builtin_amdgcn_s_waitcnt(0);
        unsigned nloc = b.st[0], nx = b.st[1];
        if (nloc == 0u) { xcd_barrier_complete(bar, b.x, nloc, nx); b.st[0] = nloc; b.st[1] = nx; }
        const unsigned old = xb_add(&bar[XB_XSUB(b.x)], 1u);
        const unsigned gen = old / nloc;
        if (old + 1u == (gen + 1u) * nloc) {
            __builtin_amdgcn_fence(__ATOMIC_RELEASE, "agent");
            asm volatile("s_waitcnt vmcnt(0)" ::: "memory");
            const unsigned og = xb_add(&bar[XB_TOP], 1u);
            const unsigned tg = og / nx;
            if (og + 1u == (tg + 1u) * nx) xb_add(&bar[XB_TOPGEN], 1u);
            else XB_SPIN(xb_ld(&bar[XB_TOPGEN]) == tg, bar);
            __builtin_amdgcn_fence(__ATOMIC_ACQUIRE, "agent");
            xb_add(&bar[XB_XGEN(b.x)], 1u);
            asm volatile("s_waitcnt vmcnt(0)" ::: "memory");
        } else {
            XB_SPIN(xb_ld(&bar[XB_XGEN(b.x)]) == gen, bar);
            __builtin_amdgcn_fence(__ATOMIC_ACQUIRE, "agent");
            asm volatile("s_waitcnt vmcnt(0)" ::: "memory");
        }
    }
    __syncthreads();
}

struct Params {
    const float* in[27];
    float* out;
    unsigned char* ws;
    int ph_lo, ph_hi;
};
__device__ __forceinline__ LAS unsigned char* lds_at(int off) { asm volatile("" : "+s"(off)); return (LAS unsigned char*)(unsigned)off; }
constexpr int LDS_PTAB = LDS_BYTES - 512;
__device__ __forceinline__ void ptab_store(const Params& p, int tid) {
    LAS unsigned long long* t = (LAS unsigned long long*)lds_at(LDS_PTAB);
    if (tid == 0) {
#pragma unroll
        for (int i = 0; i < 27; ++i) t[i] = (unsigned long long)p.in[i];
        t[27] = (unsigned long long)p.out; t[28] = (unsigned long long)p.ws; }
}
__device__ __forceinline__ unsigned long long ptab_get(int i) {
    const LAS unsigned* t = (const LAS unsigned*)lds_at(LDS_PTAB) + 2 * i;
    const unsigned lo = __builtin_amdgcn_readfirstlane(t[0]), hi = __builtin_amdgcn_readfirstlane(t[1]);
    return ((unsigned long long)hi << 32) | lo;
}
__device__ __forceinline__ unsigned char* ws_late() { return (unsigned char*)ptab_get(28); }
#define PIN(i) ((const float*)ptab_get(i))
__device__ __forceinline__ void ptab_load(Params& q) {
    asm volatile("" ::: "memory");
#pragma unroll
    for (int i = 0; i < 27; ++i) q.in[i] = (const float*)ptab_get(i);
    q.out = (float*)ptab_get(27); q.ws = (unsigned char*)ptab_get(28); q.ph_lo = 0; q.ph_hi = 0;
}

namespace pg8 {
constexpr int BM = 256, BK = 64, HALF = 128, HTB = HALF * BK * 2, NXCD = 8, WGM = 8;
__device__ __forceinline__ int lds_byte(int r, int c) { const int st = (r >> 4) * 2 + (c >> 5), rr = r & 15, cc = c & 31, ob = rr * 64 + cc * 2; return st * 1024 + (ob ^ (((ob >> 9) & 1) << 5)); }
__device__ __forceinline__ void stage_rc(int b, int& R, int& C) { const int st = b / 1024, sb = b % 1024, swz = sb ^ (((sb >> 9) & 1) << 5); R = (st >> 1) * 16 + swz / 64; C = (st & 1) * 32 + (swz % 64) / 2; }
__device__ __forceinline__ int perm32(int rho) { const int n = rho >> 4, i = rho & 15; return 8 * (i >> 2) + 4 * n + (i & 3); }

struct Unit { unsigned a, b, rows; int pm, pn, aux, nvalid; };

__device__ __forceinline__ bool dense_unit(int i, int G, int c, int nM, int nN, int& pm, int& pn) {
    const int nwg = nM * nN; const long L = (long)i * G + c; if (L >= nwg) return false;
    int wgid = (int)L; { const int q = nwg / NXCD, r = nwg % NXCD, xcd = wgid % NXCD, off = wgid / NXCD; wgid = (xcd < r ? xcd * (q + 1) : r * (q + 1) + (xcd - r) * q) + off; }
    const int nig = WGM * nN, gid = wgid / nig, fm = gid * WGM, gsz = (nM - fm) < WGM ? (nM - fm) : WGM;
    pm = fm + ((wgid % nig) % gsz); pn = (wgid % nig) / gsz; return true;
}

template <class Epi, class Sched, bool ALIGN_EPI, bool GATHER>
__device__ __forceinline__ void gemm_phase(LAS unsigned char* lds, const int K, const int lda, const int ldb, const Sched& S, const Epi& E, const int tid, const char* wsb) {
    const int wid = __builtin_amdgcn_readfirstlane(tid >> 6), lane = tid & 63, wr = wid >> 2, wc = wid & 3, fr = lane & 15, fq = lane >> 4;
    const int nt = K / BK;
    unsigned voffA[2], voffB[2]; int rA[2], cA2[2];
#pragma unroll
    for (int i = 0; i < 2; ++i) { int R, C; stage_rc(tid * 16 + i * 8192, R, C); const int Rb = Epi::PERM ? ((R & ~31) + perm32(R & 31)) : R;
        rA[i] = R; cA2[i] = C * 2; voffA[i] = (unsigned)(R * lda + C) * 2u; voffB[i] = (unsigned)(Rb * ldb + C) * 2u; }
    const unsigned kstep = (unsigned)(BK * 2);
    const unsigned hstepA = GATHER ? 0u : (unsigned)(HALF * lda * 2), hstepB = (unsigned)(HALF * ldb * 2);
    const unsigned ldsw = (unsigned)wid * 1024u;
    const int aoff = lds_byte(wr * 64 + fr, fq * 8), boff = lds_byte(wc * 32 + fr, fq * 8);
#define PG8_SA(b, h) (((b) * 2 + (h)) * HTB)
#define PG8_SB(b, h) ((4 + (b) * 2 + (h)) * HTB)
#define PG8_STAGE(bufoff, gbase, voff) do { _Pragma("unroll") for (int _i = 0; _i < 2; ++_i) \
        __builtin_amdgcn_global_load_lds((const unsigned*)(wsb + (size_t)(unsigned)((gbase) + (voff)[_i])), (LAS unsigned*)(lds + (bufoff) + ldsw + _i * 8192), 16, 0, 0); } while (0)
#define PG8_LDA(dst, b, h) do { _Pragma("unroll") for (int m = 0; m < 4; ++m) _Pragma("unroll") for (int k = 0; k < 2; ++k) dst[m][k] = *(const LAS bf16x8*)(lds + PG8_SA(b, h) + aoff + m * 2048 + k * 1024); } while (0)
#define PG8_LDB(dst, b, h) do { _Pragma("unroll") for (int n = 0; n < 2; ++n) _Pragma("unroll") for (int k = 0; k < 2; ++k) dst[n][k] = *(const LAS bf16x8*)(lds + PG8_SB(b, h) + boff + n * 2048 + k * 1024); } while (0)
#define PG8_MMA(ai, bj, At, Bt) do { __builtin_amdgcn_s_setprio(1); _Pragma("unroll") for (int m = 0; m < 4; ++m) _Pragma("unroll") for (int n = 0; n < 2; ++n) _Pragma("unroll") for (int k = 0; k < 2; ++k) \
        acc[ai][bj][m][n] = __builtin_amdgcn_mfma_f32_16x16x32_bf16(Bt[n][k], At[m][k], acc[ai][bj][m][n], 0, 0, 0); __builtin_amdgcn_s_setprio(0); } while (0)
#define PG8_WAIT_V(n) asm volatile("s_waitcnt vmcnt(" #n ")" ::: "memory")
#define PG8_WAIT_L(n) asm volatile("s_waitcnt lgkmcnt(" #n ")" ::: "memory")
#define PG8_BAR __builtin_amdgcn_s_barrier()
#define PG8_SCHED __builtin_amdgcn_sched_barrier(0)
    Unit cur, nxt; int ui = 0;
    S.begin(tid);
    if (!S.next(0, cur)) return;
    f32x4 acc[2][2][4][2];
#pragma unroll
    for (int a = 0; a < 2; ++a)
#pragma unroll
        for (int b = 0; b < 2; ++b)
#pragma unroll
            for (int m = 0; m < 4; ++m)
#pragma unroll
                for (int n = 0; n < 2; ++n) acc[a][b][m][n] = (f32x4){0.f, 0.f, 0.f, 0.f};
    bf16x8 At[4][2], B0[2][2], B1[2][2];
    unsigned cA = cur.a, cB = cur.b;
    LAS unsigned* grec = (LAS unsigned*)(lds + 131072) + tid * 8;
    if constexpr (GATHER) {
#pragma unroll
        for (int i = 0; i < 2; ++i) { const unsigned o0 = (unsigned)S.row(cur, rA[i]) * (unsigned)(lda * 2) + cA2[i], o1 = (unsigned)S.row(cur, HALF + rA[i]) * (unsigned)(lda * 2) + cA2[i];
            grec[i] = o0; grec[2 + i] = o1; grec[4 + i] = o0; grec[6 + i] = o1; }
    }
#define PG8_STAGE_A(bufoff, kptr, h, usenext) do { if constexpr (GATHER) { const u32x2 _w = *(const LAS u32x2*)(grec + ((usenext) ? 4 : 0) + 2 * (h)); unsigned _v[2]; _v[0] = _w.x; _v[1] = _w.y; PG8_STAGE(bufoff, kptr, _v); } \
        else { PG8_STAGE(bufoff, (kptr) + (h) * hstepA, voffA); } } while (0)
    PG8_STAGE(PG8_SB(0, 0), cB, voffB); PG8_STAGE(PG8_SB(0, 1), cB + hstepB, voffB); PG8_STAGE_A(PG8_SA(0, 0), cA, 0, false); PG8_STAGE_A(PG8_SA(0, 1), cA, 1, false);
    if (wr == 1) PG8_BAR;
    PG8_WAIT_V(2); PG8_BAR;
    PG8_STAGE(PG8_SB(1, 0), cB + kstep, voffB); PG8_STAGE_A(PG8_SA(1, 0), cA + kstep, 0, false); PG8_STAGE(PG8_SB(1, 1), cB + hstepB + kstep, voffB);
    PG8_WAIT_V(6); PG8_BAR;
    for (;;) {
        const bool has_next = S.next(ui + 1, nxt);
        const int tk_ = S.issue(tid, has_next);
        const unsigned nA = has_next ? nxt.a : cA, nB = has_next ? nxt.b : cB;
        for (int t = 0; t < nt; t += 2) {
            const bool last = (t == nt - 2);
            const unsigned a1 = cA + (unsigned)(t + 1) * kstep;
            const unsigned a2 = last ? nA : cA + (unsigned)(t + 2) * kstep, b2 = last ? nB : cB + (unsigned)(t + 2) * kstep;
            const unsigned a3 = a2 + kstep, b3 = b2 + kstep;
            if constexpr (GATHER) { if (last && has_next) {
#pragma unroll
                for (int i = 0; i < 2; ++i) { grec[4 + i] = (unsigned)S.row(nxt, rA[i]) * (unsigned)(lda * 2) + cA2[i]; grec[6 + i] = (unsigned)S.row(nxt, HALF + rA[i]) * (unsigned)(lda * 2) + cA2[i]; } } }
            PG8_LDB(B0, 0, 0); PG8_LDB(B1, 0, 1); PG8_SCHED; PG8_LDA(At, 0, 0); PG8_STAGE_A(PG8_SA(1, 1), a1, 1, false);
            PG8_WAIT_V(8); PG8_WAIT_L(0); PG8_BAR; PG8_MMA(0, 0, At, B0); PG8_MMA(0, 1, At, B1); PG8_BAR; PG8_SCHED;
            PG8_LDA(At, 0, 1); PG8_STAGE(PG8_SB(0, 0), b2, voffB); PG8_STAGE(PG8_SB(0, 1), b2 + hstepB, voffB); PG8_STAGE_A(PG8_SA(0, 0), a2, 0, last);
            PG8_WAIT_V(8); PG8_WAIT_L(0); PG8_BAR; PG8_MMA(1, 0, At, B0); PG8_MMA(1, 1, At, B1); PG8_BAR; PG8_SCHED;
            PG8_LDB(B0, 1, 0); PG8_LDB(B1, 1, 1); PG8_SCHED; PG8_LDA(At, 1, 0); PG8_STAGE_A(PG8_SA(0, 1), a2, 1, last);
            PG8_WAIT_V(8); PG8_WAIT_L(0); PG8_BAR; PG8_MMA(0, 0, At, B0); PG8_MMA(0, 1, At, B1); PG8_BAR; PG8_SCHED;
            PG8_LDA(At, 1, 1); PG8_STAGE(PG8_SB(1, 0), b3, voffB); PG8_STAGE(PG8_SB(1, 1), b3 + hstepB, voffB); PG8_STAGE_A(PG8_SA(1, 0), a3, 0, last);
            PG8_WAIT_V(8); PG8_WAIT_L(0); PG8_BAR; PG8_MMA(1, 0, At, B0); PG8_MMA(1, 1, At, B1); PG8_BAR; PG8_SCHED;
        }
        S.commit(tid, ui, tk_);
        if constexpr (ALIGN_EPI) { if (wr == 0) PG8_BAR; }
        { int tz = tid; asm volatile("" : "+v"(tz)); const int ew = __builtin_amdgcn_readfirstlane(tz >> 6), el = tz & 63;
          E(acc, cur, ew >> 2, ew & 3, el & 15, el >> 4); }
        if (!has_next) break;
#pragma unroll
        for (int a = 0; a < 2; ++a)
#pragma unroll
            for (int b = 0; b < 2; ++b)
#pragma unroll
                for (int m = 0; m < 4; ++m)
#pragma unroll
                    for (int n = 0; n < 2; ++n) acc[a][b][m][n] = (f32x4){0.f, 0.f, 0.f, 0.f};
        cur = nxt; cA = nA; cB = nB; ++ui;
        if constexpr (GATHER) { const u32x4 _n = *(const LAS u32x4*)(grec + 4); *(LAS u32x4*)grec = _n; }
        if constexpr (ALIGN_EPI) { if (wr == 1) PG8_BAR; }
    }
    PG8_WAIT_V(0);
    if constexpr (!ALIGN_EPI) { if (wr == 0) PG8_BAR; }
    PG8_BAR;
#undef PG8_SA
#undef PG8_SB
#undef PG8_STAGE
#undef PG8_STAGE_A
#undef PG8_LDA
#undef PG8_LDB
#undef PG8_MMA
#undef PG8_WAIT_V
#undef PG8_WAIT_L
#undef PG8_BAR
#undef PG8_SCHED
}
}
using pg8::Unit;

constexpr int LDS_TICK = 147456;
struct DenseSched {
    unsigned A, Bt, tA, tB, aBr; int nM, nN, G, c, pnShift; unsigned* ctr;
    __device__ __forceinline__ void begin(int tid) const { volatile LAS int* tk = (volatile LAS int*)lds_at(LDS_TICK);
        __syncthreads();
        if (tid == 0) { const int t0 = (int)__hip_atomic_fetch_add(ctr, 1u, __ATOMIC_RELAXED, __HIP_MEMORY_SCOPE_AGENT), t1 = (int)__hip_atomic_fetch_add(ctr, 1u, __ATOMIC_RELAXED, __HIP_MEMORY_SCOPE_AGENT); tk[0] = t0; tk[1] = t1; }
        __syncthreads(); }
    __device__ __forceinline__ int issue(int tid, bool more) const { int t = 0x3fffffff; if (tid == 0 && more) t = (int)__hip_atomic_fetch_add(ctr, 1u, __ATOMIC_RELAXED, __HIP_MEMORY_SCOPE_AGENT); return t; }
    __device__ __forceinline__ void commit(int tid, int ui, int t) const { if (tid == 0) { volatile LAS int* tk = (volatile LAS int*)lds_at(LDS_TICK); tk[ui & 1] = t; asm volatile("s_waitcnt vmcnt(0) lgkmcnt(0)" ::: "memory"); } }
    __device__ __forceinline__ bool next(int i, Unit& u) const {
        const int L = __builtin_amdgcn_readfirstlane(((volatile LAS int*)lds_at(LDS_TICK))[i & 1]);
        int pm, pn; if (L < 0 || L >= nM * nN || !pg8::dense_unit(0, 1, L, nM, nN, pm, pn)) return false;
        u.pm = pm; u.pn = pn; u.aux = 0; u.nvalid = 256; u.rows = 0u;
        u.a = A + (unsigned)(pn >> pnShift) * aBr + (unsigned)pm * tA; u.b = Bt + (unsigned)pn * tB; return true;
    }
    __device__ __forceinline__ int row(const Unit&, int) const { return 0; }
};
struct OneSched {
    Unit u0; bool has;
    __device__ __forceinline__ void begin(int) const {}
    __device__ __forceinline__ int issue(int, bool) const { return 0; }
    __device__ __forceinline__ void commit(int, int, int) const {}
    __device__ __forceinline__ bool next(int i, Unit& u) const { if (i > 0 || !has) return false; u = u0; return true; }
    __device__ __forceinline__ int row(const Unit&, int) const { return 0; }
};
struct MoeSched {
    const LAS int* pre;
    const LAS int* cnt;
    const char* wsb;
    unsigned A, W, wE, wT, aT; int G, c; bool gatherA; unsigned* ctr;
    __device__ __forceinline__ void begin(int tid) const { volatile LAS int* tk = (volatile LAS int*)lds_at(LDS_TICK);
        __syncthreads();
        if (tid == 0) { const int t0 = (int)__hip_atomic_fetch_add(ctr, 1u, __ATOMIC_RELAXED, __HIP_MEMORY_SCOPE_AGENT), t1 = (int)__hip_atomic_fetch_add(ctr, 1u, __ATOMIC_RELAXED, __HIP_MEMORY_SCOPE_AGENT); tk[0] = t0; tk[1] = t1; }
        __syncthreads(); }
    __device__ __forceinline__ int issue(int tid, bool more) const { int t = 0x3fffffff; if (tid == 0 && more) t = (int)__hip_atomic_fetch_add(ctr, 1u, __ATOMIC_RELAXED, __HIP_MEMORY_SCOPE_AGENT); return t; }
    __device__ __forceinline__ void commit(int tid, int ui, int t) const { if (tid == 0) { volatile LAS int* tk = (volatile LAS int*)lds_at(LDS_TICK); tk[ui & 1] = t; asm volatile("s_waitcnt vmcnt(0) lgkmcnt(0)" ::: "memory"); } }
    __device__ __forceinline__ bool next(int i, Unit& u) const {
        const int L = __builtin_amdgcn_readfirstlane(((volatile LAS int*)lds_at(LDS_TICK))[i & 1]); const int total = pre[16] * 4; if (L < 0 || L >= total) return false;
        const int t = (int)(L >> 2), pn = (int)(L & 3); int e = 0;
#pragma unroll
        for (int j = 1; j < 16; ++j) e += (pre[j] <= t) ? 1 : 0;
        const int pm = t - pre[e];
        u.aux = e; u.pm = t; u.pn = pn; u.nvalid = min(256, cnt[e] - 256 * pm); u.rows = (unsigned)(WS_R + R_LIST) + (unsigned)(e * MTOK + 256 * pm) * 4u;
        u.a = gatherA ? A : A + (unsigned)t * aT; u.b = W + (unsigned)e * wE + (unsigned)pn * wT; return true;
    }
    __device__ __forceinline__ int row(const Unit& u, int R) const { return (R < u.nvalid) ? (((const int*)(wsb + u.rows))[R] >> 1) : 0; }
};

typedef f32x4 Acc[2][2][4][2];
#define EPI_LOOP_AIM _Pragma("unroll") for (int ai = 0; ai < 2; ++ai) _Pragma("unroll") for (int m = 0; m < 4; ++m)
__device__ __forceinline__ u32x4 pack8(const f32x4& a, const f32x4& b) { u32x4 w; w.x = pk2(a[0], a[1]); w.y = pk2(a[2], a[3]); w.z = pk2(b[0], b[1]); w.w = pk2(b[2], b[3]); return w; }

struct EpiProj {
    static constexpr bool PERM = true;
    __device__ __forceinline__ void operator()(const Acc& acc, const Unit& u, int wr, int wc, int fr, int fq) const {
        unsigned char* ws = ws_late(); bf16_t* proj = (bf16_t*)(ws + WS_R + R_PROJ); bf16_t* nkv = (bf16_t*)(ws + WS_R + R_NKV); float* sm = (float*)(ws + WS_R + R_SM);
        const int row0 = u.pm * 256 + wr * 64 + fr;
        if (u.pn < 12) {
            const float sc = (u.pn == 8 || u.pn == 9) ? QSCALE : (u.pn == 5 ? 0.125f : 1.0f);
            const int col0 = u.pn * 256 + wc * 32 + 8 * fq;
            EPI_LOOP_AIM { bf16_t* rp = proj + (size_t)(row0 + ai * 128 + m * 16) * PROJW + col0;
#pragma unroll
                for (int bj = 0; bj < 2; ++bj) *(u32x4*)(rp + bj * 128) = pack8(acc[ai][bj][m][0] * sc, acc[ai][bj][m][1] * sc); }
        } else {
#pragma unroll
            for (int bj = 0; bj < 2; ++bj) {
                if (u.pn == 12 || bj == 0) {
                    const int seg = (u.pn - 12) * 4 + bj * 2 + (wc >> 1), col = 32 * (wc & 1) + 8 * fq;
                    bf16_t* base = nkv + (size_t)seg * (NKV_SEG / 2) + col;
                    EPI_LOOP_AIM { *(u32x4*)(base + (size_t)(row0 + ai * 128 + m * 16) * 64) = pack8(acc[ai][bj][m][0], acc[ai][bj][m][1]); }
                } else if (wc == 0 && fq < 3) {
                    EPI_LOOP_AIM { float* sp = sm + (size_t)(row0 + ai * 128 + m * 16) * 32 + 8 * fq; *(f32x4*)sp = acc[ai][bj][m][0]; *(f32x4*)(sp + 4) = acc[ai][bj][m][1]; }
                }
            }
        }
    }
};
struct EpiH1 {
    static constexpr bool PERM = true;
    bf16_t* h1; const float* cbias;
    __device__ __forceinline__ void operator()(const Acc& acc, const Unit& u, int wr, int wc, int fr, int fq) const {
        const int which = u.aux, rl0 = wr * 64 + fr;
        bf16_t* base = h1 + ((size_t)which * BC * 256 + (size_t)u.pm * 256) * 256;
        const float* bp = cbias + which * 256;
#pragma unroll
        for (int bj = 0; bj < 2; ++bj) { const int col = bj * 128 + wc * 32 + 8 * fq; const f32x4 b0 = *(const f32x4*)(bp + col), b1 = *(const f32x4*)(bp + col + 4);
            EPI_LOOP_AIM { const int rl = rl0 + ai * 128 + m * 16; f32x4 v0 = acc[ai][bj][m][0] + b0, v1 = acc[ai][bj][m][1] + b1;
#pragma unroll
                for (int e = 0; e < 4; ++e) { v0[e] = (rl < 255) ? siluf_(v0[e]) : 0.f; v1[e] = (rl < 255) ? siluf_(v1[e]) : 0.f; }
                *(u32x4*)(base + (size_t)rl * 256 + col) = pack8(v0, v1); } }
    }
};
struct EpiCmp2 {
    static constexpr bool PERM = true;
    bf16_t* kc;
    __device__ __forceinline__ void operator()(const Acc& acc, const Unit& u, int wr, int wc, int fr, int fq) const {
        if (wc >= 2) return;
        const int col = wc * 32 + 8 * fq; bf16_t* base = kc + ((size_t)u.aux * BC + u.pm) * 256 * 64 + col;
        EPI_LOOP_AIM { const int rl = wr * 64 + fr + ai * 128 + m * 16; *(u32x4*)(base + (size_t)rl * 64) = pack8(acc[ai][0][m][0], acc[ai][0][m][1]); }
    }
};
struct EpiP {
    static constexpr bool PERM = true;
    __device__ __forceinline__ void operator()(const Acc& acc, const Unit& u, int wr, int wc, int fr, int fq) const {
        const int i = u.pn >> 2, pt = u.pn & 3, row0 = u.pm * 256 + wr * 64 + fr, col0 = 256 * pt + 32 * wc + 8 * fq;
        bf16_t* P = (bf16_t*)(ws_late() + WS_R + R_P) + (size_t)i * MC * 1024;
        EPI_LOOP_AIM { bf16_t* rp = P + (unsigned)((row0 + ai * 128 + m * 16) * 1024 + col0);
#pragma unroll
            for (int bj = 0; bj < 2; ++bj) *(u32x4*)(rp + bj * 128) = pack8(acc[ai][bj][m][0], acc[ai][bj][m][1]); }
    }
};
struct EpiGate {
    static constexpr bool PERM = true;
    __device__ __forceinline__ void operator()(const Acc& acc, const Unit& u, int wr, int wc, int fr, int fq) const {
        unsigned char* ws = ws_late(); const bf16_t* P = (const bf16_t*)(ws + WS_R + R_P); bf16_t* y = (bf16_t*)(ws + WS_R + R_Y);
        const int row0 = u.pm * 256 + wr * 64 + fr, oc = 64 * u.pn + 16 * wc + 4 * fq;
#pragma unroll
        for (int ai = 0; ai < 2; ++ai)
#pragma unroll
            for (int mh = 0; mh < 2; ++mh) {
                u32x2 pw[2][4];
#pragma unroll
                for (int mm = 0; mm < 2; ++mm) { const unsigned r = (unsigned)(row0 + ai * 128 + (2 * mh + mm) * 16);
#pragma unroll
                    for (int i = 0; i < 4; ++i) pw[mm][i] = *(const u32x2*)(P + ((size_t)i * MC * 1024 + r * 1024u + (unsigned)oc)); }
#pragma unroll
                for (int mm = 0; mm < 2; ++mm) { const int m = 2 * mh + mm; const unsigned r = (unsigned)(row0 + ai * 128 + m * 16);
                    f32x4 s = {0.f, 0.f, 0.f, 0.f};
#pragma unroll
                    for (int bj = 0; bj < 2; ++bj)
#pragma unroll
                        for (int n = 0; n < 2; ++n) { const u32x2 pq = pw[mm][2 * bj + n]; const f32x4 a = acc[ai][bj][m][n];
                            s[0] += sigmoidf_(a[0]) * __uint_as_float(pq.x << 16); s[1] += sigmoidf_(a[1]) * __uint_as_float(pq.x & 0xffff0000u);
                            s[2] += sigmoidf_(a[2]) * __uint_as_float(pq.y << 16); s[3] += sigmoidf_(a[3]) * __uint_as_float(pq.y & 0xffff0000u); }
                    u32x2 w; w.x = pk2(s[0], s[1]); w.y = pk2(s[2], s[3]); *(u32x2*)(y + (r * 1024u + (unsigned)oc)) = w; }
            }
    }
};
struct EpiOut {
    static constexpr bool PERM = true;
    int row_base;
    __device__ __forceinline__ void operator()(const Acc& acc, const Unit& u, int wr, int wc, int fr, int fq) const {
        bf16_t* T = (bf16_t*)(ws_late() + WS_T);
        const int rg0 = row_base + u.pm * 256 + wr * 64 + fr, col0 = u.pn * 256 + wc * 32 + 8 * fq;
        EPI_LOOP_AIM { bf16_t* rp = T + (size_t)(rg0 + ai * 128 + m * 16) * 1024 + col0;
#pragma unroll
            for (int bj = 0; bj < 2; ++bj) *(u32x4*)(rp + bj * 128) = pack8(acc[ai][bj][m][0], acc[ai][bj][m][1]); }
    }
};
struct EpiMoe1 {
    static constexpr bool PERM = true;
    __device__ __forceinline__ void operator()(const Acc& acc, const Unit& u, int wr, int wc, int fr, int fq) const {
        const int rl0 = wr * 64 + fr, f0 = 128 * u.pn + 32 * wc + 8 * fq;
        bf16_t* hid = (bf16_t*)(ws_late() + WS_R + R_HID);
        EPI_LOOP_AIM { const int rl = rl0 + ai * 128 + m * 16;
            f32x4 a0 = acc[ai][0][m][0], a1 = acc[ai][0][m][1]; const f32x4 b0 = acc[ai][1][m][0], b1 = acc[ai][1][m][1];
#pragma unroll
            for (int e = 0; e < 4; ++e) { a0[e] = siluf_(a0[e]) * b0[e]; a1[e] = siluf_(a1[e]) * b1[e]; }
            *(u32x4*)(hid + (unsigned)((u.pm * 256 + rl) * 512 + f0)) = pack8(a0, a1); __builtin_amdgcn_sched_barrier(0); }
    }
};
struct EpiMoe2 {
    static constexpr bool PERM = true;
    __device__ __forceinline__ void operator()(const Acc& acc, const Unit& u, int wr, int wc, int fr, int fq) const {
        unsigned char* ws = ws_late(); bf16_t* out2 = (bf16_t*)(ws + WS_R + R_OUT2);
        const float* cwb = (const float*)(ws + (R_CW - R_LIST) + u.rows); const int* rws = (const int*)(ws + u.rows);
        const int rl0 = wr * 64 + fr, c0 = 256 * u.pn + 32 * wc + 8 * fq;
        EPI_LOOP_AIM { const int rl = rl0 + ai * 128 + m * 16;
            if (rl < u.nvalid) { const unsigned v = (unsigned)rws[rl]; const float wgt = cwb[rl]; bf16_t* rp = out2 + (size_t)v * 1024 + c0;
#pragma unroll
                for (int bj = 0; bj < 2; ++bj) *(u32x4*)(rp + bj * 128) = pack8(acc[ai][bj][m][0] * wgt, acc[ai][bj][m][1] * wgt); } }
    }
};

enum { IN_X = 0, IN_C, IN_POS, IN_ADAW, IN_ADAB, IN_WIN, IN_CONVW, IN_ALOG, IN_DTB, IN_GNORM, IN_RETGN, IN_PE, IN_CKW1, IN_CKW2, IN_CVW1, IN_CVW2, IN_FBIAS,
       IN_BP, IN_WG, IN_WO, IN_LNG, IN_LNB, IN_RW, IN_RB, IN_EW1, IN_EW3, IN_EW2 };

__device__ __forceinline__ void p0_ada(const Params& p, int item, LAS float* lf, const int tid) {
    LAS float* sc = lf; LAS float* red = lf + 16384;
    const float* c = PIN(IN_C);
    for (int i = tid; i < 16384; i += NTHR) sc[i] = siluf_(c[i]);
    __syncthreads();
    const int ls = item / 48, cb = item % 48, col = cb * 64 + (tid & 63), ks = tid >> 6;
    const float* w = PIN(IN_ADAW) + (size_t)ls * 1024 * 3072 + col;
    float acc[16];
#pragma unroll
    for (int b = 0; b < 16; ++b) acc[b] = 0.f;
    for (int k = ks * 128; k < ks * 128 + 128; ++k) { const float wv = w[(size_t)k * 3072];
#pragma unroll
        for (int b = 0; b < 16; ++b) acc[b] += sc[b * 1024 + k] * wv; }
#pragma unroll
    for (int b = 0; b < 16; ++b) red[(ks * 16 + b) * 64 + (tid & 63)] = acc[b];
    __syncthreads();
    float* mod = (float*)(p.ws + WS_MOD);
    for (int o = tid; o < 1024; o += NTHR) { const int b = o >> 6, cc = o & 63; float s = 0.f;
#pragma unroll
        for (int q = 0; q < 8; ++q) s += red[(q * 16 + b) * 64 + cc];
        mod[((size_t)ls * 16 + b) * 3072 + cb * 64 + cc] = s + PIN(IN_ADAB)[ls * 3072 + cb * 64 + cc]; }
    __syncthreads();
}
__device__ __forceinline__ void p0_rope(const Params& p, int item, const int tid) {
    const int* pos = (const int*)PIN(IN_POS); f32x2* tab = (f32x2*)(p.ws + WS_ROPE);
#pragma unroll
    for (int j = 0; j < 8; ++j) { const int idx = item * 4096 + j * 512 + tid; const int m = idx >> 5, i = idx & 31;
        const float inv = powf(10000.0f, -(float)i / 32.0f); const float ang = (float)pos[m] * inv;
        const float n = rintf(ang * 0.6366197723675814f);
        float r = fmaf(n, -1.5703125f, ang); r = fmaf(n, -4.837512969970703125e-4f, r); r = fmaf(n, -7.54978995489188e-8f, r);
        const float s = sinf(r), cs = cosf(r); const int q = ((int)n) & 3;
        float so, co; if (q == 0) { so = s; co = cs; } else if (q == 1) { so = cs; co = -s; } else if (q == 2) { so = -s; co = -cs; } else { so = -cs; co = s; }
        tab[idx] = (f32x2){co, so}; }
}
__device__ __forceinline__ void p0_cbias(const Params& p, int item, const int tid) {
    const int l = item >> 1, which = item & 1;
    if (tid < 256) { const float* pe = PIN(IN_PE) + (size_t)l * 2048; const float* w1 = PIN(which ? IN_CVW1 : IN_CKW1) + (size_t)l * 2048 * 256 + tid;
        float s = 0.f; for (int k = 0; k < 2048; ++k) s += pe[k] * w1[(size_t)k * 256];
        ((float*)(p.ws + WS_CBIAS))[item * 256 + tid] = s; }
}
struct TJob { bf16_t* dst; int K, nrt, nkt; };
constexpr int TJ_TILES[8] = {56 * 16, 64 * 16, 64 * 4, 16 * 16, 256 * 16, 256 * 8, 8 * 32, 8 * 4};
constexpr int TJ_TOTAL = 56 * 16 + 64 * 16 + 64 * 4 + 16 * 16 + 256 * 16 + 256 * 8 + 8 * 32 + 8 * 4;
__device__ __forceinline__ int win_src_col(int pc) {
    if (pc < 768) return pc;
    if (pc < 1024) return pc - 768 + 776;
    if (pc < 2048) return pc - 1024 + 1032;
    if (pc < 2304) return pc - 2048 + 2056;
    if (pc < 3072) return pc - 2304 + 2708;
    if (pc < 3456) return pc - 3072 + 2312;
    if (pc < 3464) return pc - 3456 + 768;
    if (pc < 3476) return pc - 3464 + 2696;
    if (pc < 3480) return pc - 3476 + 3476;
    return -1;
}
__device__ __forceinline__ const float* tj_src(const Params& p, int l, int job, int n, int& pitch) {
    switch (job) {
    case 0: { pitch = 3480; const int c = win_src_col(n); return c < 0 ? nullptr : PIN(IN_WIN) + (size_t)l * 1024 * 3480 + c; }
    case 1: { pitch = 1024; const int i = 2 * ((n >> 7) & 1) + ((n >> 2) & 1), c = 64 * (n >> 8) + 16 * ((n >> 5) & 3) + 4 * ((n >> 3) & 3) + (n & 3);
              return PIN(IN_WG) + ((size_t)l * 4 + i) * 1024 * 1024 + c; }
    case 2: { pitch = 1024; const int i = n >> 10, c = n & 1023; return PIN(IN_BP) + ((size_t)l * 4 + i) * 256 * 1024 + c; }
    case 3: { pitch = 1024; return PIN(IN_WO) + (size_t)l * 1024 * 1024 + n; }
    case 4: { pitch = 512; const int e = n >> 10, vr = n & 1023, f = 128 * (vr >> 8) + (vr & 127); return PIN(((vr >> 7) & 1) ? IN_EW3 : IN_EW1) + ((size_t)l * 16 + e) * 1024 * 512 + f; }
    case 5: { pitch = 1024; const int e = n >> 10, c = n & 1023; return PIN(IN_EW2) + ((size_t)l * 16 + e) * 512 * 1024 + c; }
    case 6: { pitch = 256; const int which = n >> 8, c = n & 255; return PIN(which ? IN_CVW1 : IN_CKW1) + (size_t)l * 2048 * 256 + c; }
    default: { pitch = 64; const int which = n >> 8, r = n & 255; return r < 64 ? PIN(which ? IN_CVW2 : IN_CKW2) + (size_t)l * 256 * 64 + r : nullptr; }
    }
}
__device__ __forceinline__ void p0_transpose(const Params& p, int item, LAS float* tile, const int tid) {
    const int l = item / TJ_TOTAL; int t = item % TJ_TOTAL, job = 0;
#pragma unroll
    for (int j = 0; j < 8; ++j) { if (job == j && t >= TJ_TILES[j]) { t -= TJ_TILES[j]; job = j + 1; } }
    const size_t lw = WS_W + (size_t)l * ((LW_BYTES + MiB - 1) / MiB) * MiB;
    const size_t offs[8] = {LW_WIN, LW_WGV, LW_BPT, LW_WOT, LW_W13, LW_W2, LW_CW1, LW_CW2};
    const int Ks[8] = {1024, 1024, 256, 1024, 1024, 512, 2048, 256};
    size_t off = 0; int K = 0;
#pragma unroll
    for (int j = 0; j < 8; ++j) if (job == j) { off = offs[j]; K = Ks[j]; }
    bf16_t* dst = (bf16_t*)(p.ws + lw + off);
    const int nkt = K / 64, rt = t / nkt, kt = t % nkt;
    { const int tx = tid & 63, ty = tid >> 6; int pitch; const float* src = tj_src(p, l, job, rt * 64 + tx, pitch);
#pragma unroll
      for (int kk = 0; kk < 8; ++kk) { const int k = ty + 8 * kk; tile[k * 65 + tx] = src ? src[(size_t)(kt * 64 + k) * pitch] : 0.f; } }
    __syncthreads();
    { const int r = tid >> 3, sg = tid & 7; f32x4 a, b;
#pragma unroll
      for (int j = 0; j < 4; ++j) { a[j] = tile[(sg * 8 + j) * 65 + r]; b[j] = tile[(sg * 8 + 4 + j) * 65 + r]; }
      *(u32x4*)(dst + (size_t)(rt * 64 + r) * K + kt * 64 + sg * 8) = pack8(a, b); }
    __syncthreads();
}

struct RowV { f32x4 v[4]; };
__device__ __forceinline__ void row_load(RowV& r, const float* src, int lane) {
#pragma unroll
    for (int j = 0; j < 4; ++j) r.v[j] = *(const f32x4*)(src + 4 * lane + 256 * j);
}
__device__ __forceinline__ void row_stats(const RowV& r, float& mean, float& rstd) {
    float s = 0.f;
#pragma unroll
    for (int j = 0; j < 4; ++j) s += (r.v[j][0] + r.v[j][1]) + (r.v[j][2] + r.v[j][3]);
    mean = wave_sum(s) * (1.0f / 1024.0f);
    float q = 0.f;
#pragma unroll
    for (int j = 0; j < 4; ++j) { const f32x4 d = r.v[j] - mean; q += (d[0] * d[0] + d[1] * d[1]) + (d[2] * d[2] + d[3] * d[3]); }
    rstd = 1.0f / sqrtf(wave_sum(q) * (1.0f / 1024.0f) + LN_EPS);
}
__device__ __forceinline__ void row_ln(RowV& r, float mean, float rstd, const float* g, const float* b, int lane) {
#pragma unroll
    for (int j = 0; j < 4; ++j) { const f32x4 gg = *(const f32x4*)(g + 4 * lane + 256 * j), bb = *(const f32x4*)(b + 4 * lane + 256 * j); r.v[j] = (r.v[j] - mean) * rstd * gg + bb; }
}
__device__ __forceinline__ void row_mod(RowV& h, const RowV& x, const float* mod, int lane) {
#pragma unroll
    for (int j = 0; j < 4; ++j) { const f32x4 sh = *(const f32x4*)(mod + 4 * lane + 256 * j), sc = *(const f32x4*)(mod + 1024 + 4 * lane + 256 * j); h.v[j] = x.v[j] * (sc + 1.0f) + sh; }
}
__device__ __forceinline__ void row_store_bf16(const RowV& h, bf16_t* dst, int lane) {
#pragma unroll
    for (int j = 0; j < 4; ++j) { u32x2 w; w.x = pk2(h.v[j][0], h.v[j][1]); w.y = pk2(h.v[j][2], h.v[j][3]); *(u32x2*)(dst + 4 * lane + 256 * j) = w; }
}
__device__ __forceinline__ void prep_first(const Params& p, const int tid, const int blk) {
    const int lane = tid & 63, wv = tid >> 6; const float* x = p.in[IN_X]; bf16_t* H = (bf16_t*)(p.ws + WS_H); const float* mod = (const float*)(p.ws + WS_MOD);
    for (int row = blk * 8 + wv; row < MTOK; row += NWG * 8) {
        RowV r, h; row_load(r, x + (size_t)row * 1024, lane); row_mod(h, r, mod + (size_t)(row >> 12) * 3072, lane); row_store_bf16(h, H + (size_t)row * 1024, lane); }
}
__device__ __forceinline__ void row_load_t(u32x2 (&t)[4], const bf16_t* src, int lane) {
#pragma unroll
    for (int j = 0; j < 4; ++j) t[j] = *(const u32x2*)(src + 4 * lane + 256 * j);
}
__device__ __forceinline__ void prep_moe(const Params& p, int l, LAS float* rwl, const int tid, const int blk) {
    const int lane = tid & 63, wv = tid >> 6;
    { const float* rw = p.in[IN_RW]; for (int i = tid; i < 16384; i += NTHR) { const int c = i >> 4, e = i & 15, ln = (c & 255) >> 2, q = c & 3, j = c >> 8;
        rwl[((((j * 4 + q) * 4 + (e >> 2)) * 64 + ln) << 2) + (e & 3)] = rw[i]; } }
    __syncthreads();
    const float* xin = (l == 0) ? p.in[IN_X] : p.out; float* z = p.out; bf16_t* H = (bf16_t*)(p.ws + WS_H); const bf16_t* T = (const bf16_t*)(p.ws + WS_T);
    const float* modg = (const float*)(p.ws + WS_MOD) + (size_t)(l * 2) * 16 * 3072; const float* mod = (const float*)(p.ws + WS_MOD) + (size_t)(l * 2 + 1) * 16 * 3072;
    f32x2* stats = (f32x2*)(p.ws + WS_STATS); const float* g = p.in[IN_LNG] + (size_t)(l * 2) * 1024; const float* bb = p.in[IN_LNB] + (size_t)(l * 2) * 1024;
    const float* gp = p.in[IN_LNG] + (size_t)((l > 0 ? l - 1 : 0) * 2 + 1) * 1024; const float* bp = p.in[IN_LNB] + (size_t)((l > 0 ? l - 1 : 0) * 2 + 1) * 1024;
    unsigned* cnt = (unsigned*)(p.ws + WS_CTL) + CW_CNT + l * 64; int* list = (int*)(p.ws + WS_R + R_LIST); float* cw = (float*)(p.ws + WS_R + R_CW);
    const float* rb = p.in[IN_RB];
    int row = blk * 8 + wv;
    RowV cur; u32x2 tc[4]; row_load(cur, xin + (size_t)row * 1024, lane); row_load_t(tc, T + (size_t)row * 1024, lane);
    for (; row < MTOK; row += NWG * 8) {
        const int nrow = row + NWG * 8; RowV nx; u32x2 tn[4];
        if (nrow < MTOK) { row_load(nx, xin + (size_t)nrow * 1024, lane); row_load_t(tn, T + (size_t)nrow * 1024, lane); }
        RowV r = cur, h;
        if (l > 0) { const f32x2 st = stats[row]; row_ln(r, st.x, st.y, gp, bp, lane); }
        { const float* gate = modg + (size_t)(row >> 12) * 3072 + 2048;
#pragma unroll
          for (int j = 0; j < 4; ++j) { const f32x4 gt = *(const f32x4*)(gate + 4 * lane + 256 * j);
              f32x4 y; y[0] = __uint_as_float(tc[j].x << 16); y[1] = __uint_as_float(tc[j].x & 0xffff0000u); y[2] = __uint_as_float(tc[j].y << 16); y[3] = __uint_as_float(tc[j].y & 0xffff0000u);
              r.v[j] = r.v[j] * DN_ALPHA + gt * y; *(f32x4*)(z + (size_t)row * 1024 + 4 * lane + 256 * j) = r.v[j]; } }
        float mean, rstd; row_stats(r, mean, rstd); if (lane == 0) stats[row] = (f32x2){mean, rstd};
        row_ln(r, mean, rstd, g, bb, lane); row_mod(h, r, mod + (size_t)(row >> 12) * 3072, lane); row_store_bf16(h, H + (size_t)row * 1024, lane);
        float a[16];
#pragma unroll
        for (int e = 0; e < 16; ++e) a[e] = 0.f;
#pragma unroll
        for (int j = 0; j < 4; ++j)
#pragma unroll
            for (int q = 0; q < 4; ++q) { const float hv = h.v[j][q]; const LAS float* wp = rwl + (((j * 4 + q) * 4) * 64 + lane) * 4;
                const f32x4 w0 = *(const LAS f32x4*)wp, w1 = *(const LAS f32x4*)(wp + 256), w2 = *(const LAS f32x4*)(wp + 512), w3 = *(const LAS f32x4*)(wp + 768);
#pragma unroll
                for (int e = 0; e < 4; ++e) { a[e] += hv * w0[e]; a[4 + e] += hv * w1[e]; a[8 + e] += hv * w2[e]; a[12 + e] += hv * w3[e]; }
                __builtin_amdgcn_sched_barrier(0); }
#pragma unroll
        for (int e = 0; e < 16; ++e) a[e] = wave_sum(a[e]);
        float sc[16], bi[16];
#pragma unroll
        for (int e = 0; e < 16; ++e) { sc[e] = sigmoidf_(a[e]); bi[e] = sc[e] + rb[e]; }
        int grp = 0; float best = -INFINITY;
#pragma unroll
        for (int gI = 0; gI < 4; ++gI) { float m1 = -INFINITY, m2 = -INFINITY;
#pragma unroll
            for (int q = 0; q < 4; ++q) { const float v = bi[4 * gI + q]; if (v > m1) { m2 = m1; m1 = v; } else if (v > m2) m2 = v; }
            const float gs = m1 + m2; if (gs > best) { best = gs; grp = gI; } }
        int e0 = 0, e1 = 0; float b0 = -INFINITY, b1 = -INFINITY, s0 = 0.f, s1 = 0.f;
#pragma unroll
        for (int gI = 0; gI < 4; ++gI)
#pragma unroll
            for (int q = 0; q < 4; ++q) { const int e = 4 * gI + q; if (gI == grp) { const float v = bi[e];
                if (v > b0) { b1 = b0; e1 = e0; s1 = s0; b0 = v; e0 = e; s0 = sc[e]; } else if (v > b1) { b1 = v; e1 = e; s1 = sc[e]; } } }
        const float inv = 1.0f / (s0 + s1);
        if (lane == 0) { const unsigned q0 = atomicAdd(cnt + e0, 1u), q1 = atomicAdd(cnt + e1, 1u);
                         list[(size_t)e0 * MTOK + q0] = row * 2; cw[(size_t)e0 * MTOK + q0] = s0 * inv;
                         list[(size_t)e1 * MTOK + q1] = row * 2 + 1; cw[(size_t)e1 * MTOK + q1] = s1 * inv; }
        cur = nx;
#pragma unroll
        for (int j = 0; j < 4; ++j) tc[j] = tn[j];
    }
}
__device__ __forceinline__ void prep_next(const Params& p, int l, bool final_, const int tid, const int blk) {
    const int lane = tid & 63, wv = tid >> 6;
    float* z = p.out; bf16_t* H = (bf16_t*)(p.ws + WS_H); const float* modm = (const float*)(p.ws + WS_MOD) + (size_t)(l * 2 + 1) * 16 * 3072;
    const float* modn = (const float*)(p.ws + WS_MOD) + (size_t)((l + 1) * 2) * 16 * 3072;
    f32x2* stats = (f32x2*)(p.ws + WS_STATS);
    const float* g0 = p.in[IN_LNG] + (size_t)(l * 2) * 1024; const float* b0 = p.in[IN_LNB] + (size_t)(l * 2) * 1024;
    const float* g1 = p.in[IN_LNG] + (size_t)(l * 2 + 1) * 1024; const float* b1 = p.in[IN_LNB] + (size_t)(l * 2 + 1) * 1024;
    const bf16_t* out2 = (const bf16_t*)(p.ws + WS_R + R_OUT2);
    int row = blk * 8 + wv;
    RowV cur; u32x2 ta[4], tb[4]; row_load(cur, z + (size_t)row * 1024, lane); row_load_t(ta, out2 + (size_t)(row * 2) * 1024, lane); row_load_t(tb, out2 + (size_t)(row * 2 + 1) * 1024, lane);
    for (; row < MTOK; row += NWG * 8) {
        const int nrow = row + NWG * 8; RowV nx; u32x2 na[4], nb[4];
        if (nrow < MTOK) { row_load(nx, z + (size_t)nrow * 1024, lane); row_load_t(na, out2 + (size_t)(nrow * 2) * 1024, lane); row_load_t(nb, out2 + (size_t)(nrow * 2 + 1) * 1024, lane); }
        RowV r = cur;
        const f32x2 st = stats[row]; row_ln(r, st.x, st.y, g0, b0, lane);
        const float* gate = modm + (size_t)(row >> 12) * 3072 + 2048;
#pragma unroll
        for (int j = 0; j < 4; ++j) { const u32x2 oa = ta[j], ob = tb[j];
            const f32x4 gt = *(const f32x4*)(gate + 4 * lane + 256 * j);
            f32x4 y; y[0] = __uint_as_float(oa.x << 16) + __uint_as_float(ob.x << 16); y[1] = __uint_as_float(oa.x & 0xffff0000u) + __uint_as_float(ob.x & 0xffff0000u);
            y[2] = __uint_as_float(oa.y << 16) + __uint_as_float(ob.y << 16); y[3] = __uint_as_float(oa.y & 0xffff0000u) + __uint_as_float(ob.y & 0xffff0000u);
            r.v[j] = r.v[j] * DN_ALPHA + gt * y; }
        cur = nx;
#pragma unroll
        for (int j = 0; j < 4; ++j) { ta[j] = na[j]; tb[j] = nb[j]; }
        float mean, rstd; row_stats(r, mean, rstd);
        if (final_) { row_ln(r, mean, rstd, g1, b1, lane);
#pragma unroll
            for (int j = 0; j < 4; ++j) *(f32x4*)(z + (size_t)row * 1024 + 4 * lane + 256 * j) = r.v[j];
        } else {
#pragma unroll
            for (int j = 0; j < 4; ++j) *(f32x4*)(z + (size_t)row * 1024 + 4 * lane + 256 * j) = r.v[j];
            if (lane == 0) stats[row] = (f32x2){mean, rstd};
            RowV h; row_ln(r, mean, rstd, g1, b1, lane); row_mod(h, r, modn + (size_t)(row >> 12) * 3072, lane); row_store_bf16(h, H + (size_t)row * 1024, lane); }
    }
}

__device__ __forceinline__ int q_next(unsigned* ctr, volatile LAS int* slot, const int tid) {
    __syncthreads();
    if (tid == 0) *slot = (int)__hip_atomic_fetch_add(ctr, 1u, __ATOMIC_RELAXED, __HIP_MEMORY_SCOPE_AGENT);
    __syncthreads();
    return *slot;
}

__device__ __forceinline__ void gdn_prep_unit(const Params& p, int l, int unit, LAS unsigned char* lds, const int tid_in_) {
    int tid = tid_in_; asm volatile("" : "+v"(tid)); unsigned char* wsl_ = ws_late();
    const int lane = tid & 63;
    const int n = unit & 63, h = (unit >> 6) & 3, bl = unit >> 8;
    const int tok0 = bl * SEQ + n * 64;
    const bf16_t* proj = (const bf16_t*)(wsl_ + WS_R + R_PROJ); const float* sm = (const float*)(wsl_ + WS_R + R_SM);
    LAS bf16_t* raw = (LAS bf16_t*)lds;
    LAS float* qs = (LAS float*)(lds + 26112); LAS float* ks = qs + 64 * 65; LAS float* vs = ks + 64 * 65;
    LAS float* Lm = vs + 64 * 65;
    LAS float* bc = Lm + 4096; LAS float* eb = bc + 64; LAS float* be = eb + 64; LAS float* cwt = be + 64;
    __syncthreads();
    for (int idx = tid; idx < 67 * 24; idx += NTHR) { const int row = idx / 24, ch = idx % 24, seg = ch >> 3, c8 = ch & 7;
        u32x4 v = {0u, 0u, 0u, 0u};
        if (n > 0 || row >= 3) v = *(const u32x4*)(proj + (size_t)(tok0 + row - 3) * PROJW + seg * 256 + h * 64 + c8 * 8);
        *(LAS u32x4*)(raw + row * 192 + seg * 64 + c8 * 8) = v; }
    for (int idx = tid; idx < 768; idx += NTHR) { const int k = idx / 192, ch = idx % 192; cwt[idx] = PIN(IN_CONVW)[(size_t)l * 4 * 768 + k * 768 + (ch >> 6) * 256 + h * 64 + (ch & 63)]; }
    __syncthreads();
    for (int idx = tid; idx < 64 * 192; idx += NTHR) { const int t = idx / 192, ch = idx % 192; float s = 0.f;
#pragma unroll
        for (int k = 0; k < 4; ++k) s += cwt[k * 192 + ch] * bf2f(raw[(t + k) * 192 + ch]);
        s = siluf_(s); const int seg = ch >> 6, d = ch & 63; (seg == 0 ? qs : seg == 1 ? ks : vs)[t * 65 + d] = s; }
    __syncthreads();
    LAS unsigned char* qb = lds + 129024; LAS unsigned char* kb = qb + 8192; LAS float* Rs = (LAS float*)(kb + 8192);
    {
        const int mat = tid >> 8, row = (tid >> 2) & 63, q4 = tid & 3; LAS float* mt = mat ? ks : qs; float x[16], ss = 0.f;
#pragma unroll
        for (int d = 0; d < 16; ++d) { x[d] = mt[row * 65 + 16 * q4 + d]; ss += x[d] * x[d]; }
        ss += swz_xor<1>(ss); ss += swz_xor<2>(ss);
        const float sc = (1.0f / sqrtf(ss + 1e-6f)) * (mat ? 1.0f : 0.125f);
#pragma unroll
        for (int d = 0; d < 16; ++d) { x[d] *= sc; mt[row * 65 + 16 * q4 + d] = x[d]; }
        LAS unsigned char* ob = (mat ? kb : qb) + (2 * q4) * 1024 + row * 16;
        u32x4 w0, w1; w0.x = pk2(x[0], x[1]); w0.y = pk2(x[2], x[3]); w0.z = pk2(x[4], x[5]); w0.w = pk2(x[6], x[7]); w1.x = pk2(x[8], x[9]); w1.y = pk2(x[10], x[11]); w1.z = pk2(x[12], x[13]); w1.w = pk2(x[14], x[15]);
        *(LAS u32x4*)ob = w0; *(LAS u32x4*)(ob + 1024) = w1;
    }
    if (tid < 64) { const int i = tid;
        const float a = sm[(size_t)(tok0 + i) * 32 + h], bg = sm[(size_t)(tok0 + i) * 32 + 4 + h];
        const float x = a + PIN(IN_DTB)[l * 4 + h]; const float sp = fmaxf(x, 0.f) + log1pf(__expf(-fabsf(x)));
        float la = -__expf(PIN(IN_ALOG)[l * 4 + h]) * sp;
#pragma unroll
        for (int o = 1; o < 64; o <<= 1) { const float v = shfl_up_l(la, o, lane); if (lane >= o) la += v; }
        bc[i] = la; eb[i] = __expf(la); be[i] = sigmoidf_(bg); }
    __syncthreads();
    const size_t ub = WS_R + R_GDN + (size_t)unit * GDN_UNIT_BYTES;
    bf16_t* gW = (bf16_t*)(wsl_ + ub); bf16_t* gATT = gW + 4096; bf16_t* gQD = gW + 8192; bf16_t* gKDT = gW + 12288; bf16_t* gU0 = gW + 16384;
    {
        const int wid = tid >> 6, r32 = lane & 31, hi = lane >> 5, isq = wid >> 2, it = (wid >> 1) & 1, jt = wid & 1;
        const LAS unsigned char* ab = (isq ? qb : kb) + hi * 1024 + (32 * it + r32) * 16; const LAS unsigned char* bb = kb + hi * 1024 + (32 * jt + r32) * 16;
        f32x16 acc = z16();
#pragma unroll
        for (int d0 = 0; d0 < 4; ++d0) acc = MF32(*(const LAS bf16x8*)(ab + d0 * 2048), *(const LAS bf16x8*)(bb + d0 * 2048), acc);
        const int j = 32 * jt + r32; const float bj = bc[j];
#pragma unroll
        for (int g = 0; g < 4; ++g) { f32x4 lv;
#pragma unroll
            for (int e = 0; e < 4; ++e) { const int i = 32 * it + 8 * g + 4 * hi + e; const float dc = __expf(bc[i] - bj), v = acc[4 * g + e] * dc;
                if (isq) gATT[i * 64 + j] = f2bf((j <= i) ? v : 0.f); else lv[e] = (j < i) ? be[i] * v : 0.f; }
            if (!isq) *(LAS f32x4*)(Lm + j * 64 + 32 * it + 8 * g + 4 * hi) = lv; }
    }
    __syncthreads();
    {
        const int c = tid & 127, cc = c & 63, rg = tid >> 7; const bool isw = c >= 64; LAS float* Xs = cwt + 768;
        for (int I = 0; I < 4; ++I) {
            float r[4];
#pragma unroll
            for (int e = 0; e < 4; ++e) { const int i = 16 * I + 4 * rg + e; r[e] = isw ? be[i] * eb[i] * ks[i * 65 + cc] : be[i] * vs[i * 65 + cc]; }
#pragma unroll 4
            for (int j = 0; j < 16 * I; ++j) { const float xj = Xs[j * 128 + c]; const f32x4 l4 = *(const LAS f32x4*)(Lm + j * 64 + 16 * I + 4 * rg);
#pragma unroll
                for (int e = 0; e < 4; ++e) r[e] -= l4[e] * xj; }
#pragma unroll
            for (int e = 0; e < 4; ++e) Rs[(4 * rg + e) * 128 + c] = r[e];
            __syncthreads();
            if (tid < 128) { float q[16];
#pragma unroll
                for (int ii = 0; ii < 16; ++ii) q[ii] = Rs[ii * 128 + c];
#pragma unroll
                for (int ii = 1; ii < 16; ++ii)
#pragma unroll
                    for (int jj = 0; jj < ii; ++jj) q[ii] -= Lm[(16 * I + jj) * 64 + 16 * I + ii] * q[jj];
#pragma unroll
                for (int ii = 0; ii < 16; ++ii) { Xs[(16 * I + ii) * 128 + c] = q[ii]; (isw ? gW : gU0)[(16 * I + ii) * 64 + cc] = f2bf(q[ii]); }
            } else if (I == 0) {
                const float bl_ = bc[63];
                for (int task = tid - 128; task < 1024; task += 384) {
                    if (task < 512) { const int c2 = task >> 3, sg = task & 7; const float e = eb[c2]; float v[8];
#pragma unroll
                        for (int j = 0; j < 8; ++j) v[j] = qs[c2 * 65 + sg * 8 + j] * e;
                        u32x4 w; w.x = pk2(v[0], v[1]); w.y = pk2(v[2], v[3]); w.z = pk2(v[4], v[5]); w.w = pk2(v[6], v[7]); *(u32x4*)(gQD + c2 * 64 + sg * 8) = w;
                    } else { const int k = (task - 512) >> 3, sg = task & 7; float v[8];
#pragma unroll
                        for (int j = 0; j < 8; ++j) { const int c2 = sg * 8 + j; v[j] = ks[c2 * 65 + k] * __expf(bl_ - bc[c2]); }
                        u32x4 w; w.x = pk2(v[0], v[1]); w.y = pk2(v[2], v[3]); w.z = pk2(v[4], v[5]); w.w = pk2(v[6], v[7]); *(u32x4*)(gKDT + k * 64 + sg * 8) = w; }
                }
                if (tid == 128) ((float*)(wsl_ + WS_R + R_GG))[unit] = __expf(bl_);
            }
            __syncthreads();
        }
    }
}

__device__ __forceinline__ bf16x8 afrag_perm(const LAS unsigned char* M, int row, int ks, int hi) {
    const LAS unsigned char* q = M + row * 144 + (16 * ks + 4 * hi) * 2;
    const s16x4 lo = *(const LAS s16x4*)q, hi4 = *(const LAS s16x4*)(q + 16);
    return (bf16x8){lo[0], lo[1], lo[2], lo[3], hi4[0], hi4[1], hi4[2], hi4[3]};
}
__device__ __forceinline__ bf16x8 pack_acc8(const f32x16& a, int s) {
    u32x4 w; w.x = pk2(a[8 * s + 0], a[8 * s + 1]); w.y = pk2(a[8 * s + 2], a[8 * s + 3]); w.z = pk2(a[8 * s + 4], a[8 * s + 5]); w.w = pk2(a[8 * s + 6], a[8 * s + 7]);
    return __builtin_bit_cast(bf16x8, w);
}
__device__ __forceinline__ void gdn_scan_item(const Params& p, int l, int chunk, int item, LAS unsigned char* lds, const int tid) {
    const int lane = tid & 63, wid = tid >> 6, vl = lane & 31, hi = lane >> 5;
    const int h = item & 3, bl = item >> 2;
    const unsigned char* ubase = p.ws + WS_R + R_GDN + (size_t)item * 64 * GDN_UNIT_BYTES;
    const float* gg = (const float*)(p.ws + WS_R + R_GG) + item * 64;
    const bf16_t* proj = (const bf16_t*)(p.ws + WS_R + R_PROJ); bf16_t* og = (bf16_t*)(p.ws + WS_R + R_O);
    const float* nw = PIN(IN_GNORM) + l * 64;
    constexpr int BUF = 5 * 9216;
    LAS unsigned char* buf0 = lds; LAS float* ob0 = (LAS float*)(lds + 2 * BUF);
    __syncthreads();
    for (int q = tid; q < 2560; q += NTHR) { const int mat = q >> 9, r = (q >> 3) & 63, sg = q & 7;
        *(LAS u32x4*)(buf0 + mat * 9216 + r * 144 + sg * 16) = *(const u32x4*)(ubase + mat * 8192 + r * 128 + sg * 16); }
    __syncthreads();
    f32x16 S[2]; S[0] = z16(); S[1] = z16();
    for (int n = 0; n < 64; ++n) {
        LAS unsigned char* bf = buf0 + (n & 1) * BUF; LAS float* ob = ob0 + (n & 1) * 4096;
        if (wid < 2) {
            const LAS unsigned char* Wm = bf; const LAS unsigned char* ATT = bf + 9216; const LAS unsigned char* QD = bf + 18432; const LAS unsigned char* KDT = bf + 27648; const LAS bf16_t* U0 = (const LAS bf16_t*)(bf + 36864);
            const float G = gg[n];
            bf16x8 Sb[4]; Sb[0] = pack_acc8(S[0], 0); Sb[1] = pack_acc8(S[0], 1); Sb[2] = pack_acc8(S[1], 0); Sb[3] = pack_acc8(S[1], 1);
            f32x16 u[2];
#pragma unroll
            for (int ct = 0; ct < 2; ++ct) { f32x16 a = z16();
#pragma unroll
                for (int ks = 0; ks < 4; ++ks) a = __builtin_amdgcn_mfma_f32_32x32x16_bf16(afrag_perm(Wm, 32 * ct + vl, ks, hi), Sb[ks], a, 0, 0, 0);
#pragma unroll
                for (int r = 0; r < 16; ++r) u[ct][r] = bf2f(U0[(32 * ct + crow(r, hi)) * 72 + 32 * wid + vl]) - a[r]; }
            bf16x8 ub[4]; ub[0] = pack_acc8(u[0], 0); ub[1] = pack_acc8(u[0], 1); ub[2] = pack_acc8(u[1], 0); ub[3] = pack_acc8(u[1], 1);
#pragma unroll
            for (int ct = 0; ct < 2; ++ct) { f32x16 a = z16();
#pragma unroll
                for (int ks = 0; ks < 4; ++ks) a = __builtin_amdgcn_mfma_f32_32x32x16_bf16(afrag_perm(QD, 32 * ct + vl, ks, hi), Sb[ks], a, 0, 0, 0);
#pragma unroll
                for (int cs = 0; cs < 4; ++cs) a = __builtin_amdgcn_mfma_f32_32x32x16_bf16(afrag_perm(ATT, 32 * ct + vl, cs, hi), ub[cs], a, 0, 0, 0);
#pragma unroll
                for (int r = 0; r < 16; ++r) ob[(32 * ct + crow(r, hi)) * 64 + 32 * wid + vl] = a[r]; }
#pragma unroll
            for (int kt = 0; kt < 2; ++kt) { f32x16 a = S[kt] * G;
#pragma unroll
                for (int cs = 0; cs < 4; ++cs) a = __builtin_amdgcn_mfma_f32_32x32x16_bf16(afrag_perm(KDT, 32 * kt + vl, cs, hi), ub[cs], a, 0, 0, 0);
                S[kt] = a; }
        } else {
            if (n + 1 < 64) { LAS unsigned char* nb = buf0 + ((n + 1) & 1) * BUF; const unsigned char* src = ubase + (size_t)(n + 1) * GDN_UNIT_BYTES;
                for (int q = tid - 128; q < 2560; q += 384) { const int mat = q >> 9, r = (q >> 3) & 63, sg = q & 7;
                    *(LAS u32x4*)(nb + mat * 9216 + r * 144 + sg * 16) = *(const u32x4*)(src + mat * 8192 + r * 128 + sg * 16); } }
        }
        if (wid >= 2 && n >= 1) { const LAS float* po = ob0 + ((n - 1) & 1) * 4096; const int tokb = bl * SEQ + (n - 1) * 64;
            for (int task = tid - 128; task < 512; task += 384) { const int c = task >> 3, sg = task & 7; float v[8], ss = 0.f;
#pragma unroll
                for (int j = 0; j < 8; ++j) { v[j] = po[c * 64 + sg * 8 + j]; ss += v[j] * v[j]; }
                ss += swz_xor<1>(ss); ss += swz_xor<2>(ss); ss += swz_xor<4>(ss);
                const float rs = 1.0f / sqrtf(ss * (1.0f / 64.0f) + 1e-6f);
                const u32x4 zw = *(const u32x4*)(proj + (size_t)(tokb + c) * PROJW + PC_GZ + h * 64 + sg * 8); const unsigned zz[4] = {zw.x, zw.y, zw.z, zw.w};
#pragma unroll
                for (int j = 0; j < 8; ++j) { const float zf = (j & 1) ? __uint_as_float(zz[j >> 1] & 0xffff0000u) : __uint_as_float(zz[j >> 1] << 16); v[j] = v[j] * rs * nw[sg * 8 + j] * siluf_(zf); }
                u32x4 w; w.x = pk2(v[0], v[1]); w.y = pk2(v[2], v[3]); w.z = pk2(v[4], v[5]); w.w = pk2(v[6], v[7]);
                *(u32x4*)(og + (size_t)(tokb + c) * 256 + h * 64 + sg * 8) = w; } }
        __syncthreads();
    }
    { const LAS float* po = ob0 + 4096; const int tokb = bl * SEQ + 63 * 64;
        for (int task = tid; task < 512; task += NTHR) { const int c = task >> 3, sg = task & 7; float v[8], ss = 0.f;
#pragma unroll
            for (int j = 0; j < 8; ++j) { v[j] = po[c * 64 + sg * 8 + j]; ss += v[j] * v[j]; }
            ss += swz_xor<1>(ss); ss += swz_xor<2>(ss); ss += swz_xor<4>(ss);
            const float rs = 1.0f / sqrtf(ss * (1.0f / 64.0f) + 1e-6f);
            const u32x4 zw = *(const u32x4*)(proj + (size_t)(tokb + c) * PROJW + PC_GZ + h * 64 + sg * 8); const unsigned zz[4] = {zw.x, zw.y, zw.z, zw.w};
#pragma unroll
            for (int j = 0; j < 8; ++j) { const float zf = (j & 1) ? __uint_as_float(zz[j >> 1] & 0xffff0000u) : __uint_as_float(zz[j >> 1] << 16); v[j] = v[j] * rs * nw[sg * 8 + j] * siluf_(zf); }
            u32x4 w; w.x = pk2(v[0], v[1]); w.y = pk2(v[2], v[3]); w.z = pk2(v[4], v[5]); w.w = pk2(v[6], v[7]);
            *(u32x4*)(og + (size_t)(tokb + c) * 256 + h * 64 + sg * 8) = w; } }
    __syncthreads();
}

__device__ __forceinline__ void fox_cum_item(const Params& p, int l, int item, LAS float* lf, const int tid) {
    const int lane = tid & 63, wid = tid >> 6, h = item & 3, bl = item >> 2;
    const float* sm = (const float*)(p.ws + WS_R + R_SM); float* nb = (float*)(p.ws + WS_R + R_CUM) + (size_t)item * SEQ;
    const float fb = PIN(IN_FBIAS)[l * 4 + h];
    float v[8], run = 0.f;
#pragma unroll
    for (int j = 0; j < 8; ++j) { const float x = sm[(size_t)(bl * SEQ + tid * 8 + j) * 32 + 20 + h] + fb; run += fminf(x, 0.f) - log1pf(__expf(-fabsf(x))); v[j] = run; }
    float inc = run;
#pragma unroll
    for (int o = 1; o < 64; o <<= 1) { const float t = shfl_up_l(inc, o, lane); if (lane >= o) inc += t; }
    __syncthreads();
    if (lane == 63) lf[wid] = inc;
    __syncthreads();
    float base = inc - run;
    for (int w = 0; w < wid; ++w) base += lf[w];
#pragma unroll
    for (int j = 0; j < 8; ++j) nb[tid * 8 + j] = -(base + v[j]) * LOG2E;
    __syncthreads();
}
__device__ __forceinline__ void ret_rope_pass(const Params& p, int chunk, const int tid, const int blk) {
    bf16_t* proj = (bf16_t*)(p.ws + WS_R + R_PROJ); const f32x2* tab = (const f32x2*)(p.ws + WS_ROPE);
    for (int task = blk * NTHR + tid; task < MC * 32; task += NWG * NTHR) {
        const int row = task >> 5, which = (task >> 4) & 1, h = (task >> 2) & 3, i8 = task & 3;
        bf16_t* q1 = proj + (size_t)row * PROJW + (which ? PC_RK : PC_RQ) + h * 64 + i8 * 8; bf16_t* q2 = q1 + 32;
        const u32x4 a = *(const u32x4*)q1, b = *(const u32x4*)q2; const unsigned aa[4] = {a.x, a.y, a.z, a.w}, bb[4] = {b.x, b.y, b.z, b.w};
        const f32x2* tp = tab + (size_t)(chunk * MC + row) * 32 + i8 * 8; float o1[8], o2[8];
#pragma unroll
        for (int j = 0; j < 8; ++j) { const float x1 = (j & 1) ? __uint_as_float(aa[j >> 1] & 0xffff0000u) : __uint_as_float(aa[j >> 1] << 16);
            const float x2 = (j & 1) ? __uint_as_float(bb[j >> 1] & 0xffff0000u) : __uint_as_float(bb[j >> 1] << 16);
            const f32x2 cs = tp[j]; o1[j] = x1 * cs.x - x2 * cs.y; o2[j] = x1 * cs.y + x2 * cs.x; }
        u32x4 w1, w2; w1.x = pk2(o1[0], o1[1]); w1.y = pk2(o1[2], o1[3]); w1.z = pk2(o1[4], o1[5]); w1.w = pk2(o1[6], o1[7]);
        w2.x = pk2(o2[0], o2[1]); w2.y = pk2(o2[2], o2[3]); w2.z = pk2(o2[4], o2[5]); w2.w = pk2(o2[6], o2[7]);
        *(u32x4*)q1 = w1; *(u32x4*)q2 = w2; }
}

constexpr int AL_K0 = 0, AL_V0 = 16384, AL_B0 = 32768;
__device__ __forceinline__ s16x4 vtr(const LAS unsigned char* q) {
    typedef short v4i16_t __attribute__((ext_vector_type(4)));
    return __builtin_bit_cast(s16x4, __builtin_amdgcn_ds_read_tr16_b64_v4i16((LAS v4i16_t*)q));
}
__device__ __forceinline__ void attn_qkt(f32x16& p0, f32x16& p1, const LAS unsigned char* kslot, const bf16x8 (&qf)[4], int r32, int hi) {
    p0 = z16(); p1 = z16();
#pragma unroll
    for (int d0 = 0; d0 < 4; ++d0) { const LAS unsigned char* kb = kslot + (2 * d0 + hi) * 1024 + r32 * 16;
        const bf16x8 b0 = *(const LAS bf16x8*)kb, b1 = *(const LAS bf16x8*)(kb + 512);
        p0 = MF32(b0, qf[d0], p0); p1 = MF32(b1, qf[d0], p1); }
}
__device__ __forceinline__ void attn_pv(f32x16 (&o)[2], const LAS unsigned char* vslot, const bf16x8 (&pw)[4], int lane, int hi) {
    const LAS unsigned char* vb = vslot + ((lane >> 4) & 1) * 32 + (lane & 3) * 8 + (4 * hi + ((lane & 15) >> 2)) * 64;
#pragma unroll
    for (int d0 = 0; d0 < 2; ++d0)
#pragma unroll
        for (int ks = 0; ks < 4; ++ks) { const s16x4 lo = vtr(vb + d0 * 4096 + ks * 1024), h4 = vtr(vb + d0 * 4096 + ks * 1024 + 512);
            const bf16x8 vf = (bf16x8){lo[0], lo[1], lo[2], lo[3], h4[0], h4[1], h4[2], h4[3]};
            o[d0] = MF32(vf, pw[ks], o[d0]); }
}
__device__ __forceinline__ void attn_softmax_step(f32x16& p0, f32x16& p1, f32x16 (&o)[2], float& m, float& l) {
    float mt = p0[0];
#pragma unroll
    for (int r = 1; r < 16; ++r) mt = fmaxf(mt, p0[r]);
#pragma unroll
    for (int r = 0; r < 16; ++r) mt = fmaxf(mt, p1[r]);
    mt = x32_max(mt);
    const float mn = fmaxf(m, mt), ms = (mn == -INFINITY) ? 0.f : mn, alpha = ex2(m - ms);
    float s = 0.f;
#pragma unroll
    for (int r = 0; r < 16; ++r) { p0[r] = ex2(p0[r] - ms); p1[r] = ex2(p1[r] - ms); s += p0[r] + p1[r]; }
    l = l * alpha + s; m = mn;
    if (__builtin_amdgcn_ballot_w64(alpha != 1.0f) != 0ull) { o[0] *= alpha; o[1] *= alpha; }
}
template <class F>
__device__ __forceinline__ void flash_loop(const F& f, int tlo, int thi, const bf16_t* Kg, const bf16_t* Vg, int pitch, const float* biasg,
                                           const bf16x8 (&qf)[4], f32x16 (&o)[2], float& m, float& l, LAS unsigned char* lds, const int tid) {
    const int lane = tid & 63, wid = tid >> 6, r32 = lane & 31, hi = lane >> 5;
    int t = tlo; while (t < thi && f.skip(t)) ++t;
    __syncthreads();
    if (t >= thi) return;
    const bf16_t* ksrc = Kg + (size_t)lane * pitch + wid * 8;
    const bf16_t* vsrc = Vg + (size_t)(16 * (wid & 3) + (lane >> 2)) * pitch + (wid >> 2) * 32 + (lane & 3) * 8;
    const int sdst = wid * 1024 + lane * 16;
    u32x4 kr = *(const u32x4*)(ksrc + (size_t)t * 64 * pitch), vr = *(const u32x4*)(vsrc + (size_t)t * 64 * pitch); float br = 0.f;
    const int btid = tid & 63;
    if (F::HAS_BIAS) br = biasg[t * 64 + btid];
    *(LAS u32x4*)(lds + AL_K0 + sdst) = kr; *(LAS u32x4*)(lds + AL_V0 + sdst) = vr; if (F::HAS_BIAS) ((LAS float*)(lds + AL_B0))[btid] = br;
    __syncthreads();
    int cur = 0;
    for (;;) {
        int tn = t + 1; while (tn < thi && f.skip(tn)) ++tn;
        if (tn < thi) { kr = *(const u32x4*)(ksrc + (size_t)tn * 64 * pitch); vr = *(const u32x4*)(vsrc + (size_t)tn * 64 * pitch); if (F::HAS_BIAS) br = biasg[tn * 64 + btid]; }
        if (!f.wskip(t)) {
        f32x16 p0, p1;
        attn_qkt(p0, p1, lds + AL_K0 + cur * 8192, qf, r32, hi);
        if (F::HAS_BIAS) { const LAS float* bp = (const LAS float*)(lds + AL_B0 + cur * 256);
#pragma unroll
            for (int g = 0; g < 4; ++g) { const f32x4 b0 = *(const LAS f32x4*)(bp + 8 * g + 4 * hi), b1 = *(const LAS f32x4*)(bp + 32 + 8 * g + 4 * hi);
#pragma unroll
                for (int e = 0; e < 4; ++e) { p0[4 * g + e] += b0[e]; p1[4 * g + e] += b1[e]; } } }
        f.apply(p0, p1, t);
        if (F::MODE == 0) attn_softmax_step(p0, p1, o, m, l);
        bf16x8 pw[4]; pw[0] = pack_acc8(p0, 0); pw[1] = pack_acc8(p0, 1); pw[2] = pack_acc8(p1, 0); pw[3] = pack_acc8(p1, 1);
        attn_pv(o, lds + AL_V0 + cur * 8192, pw, lane, hi);
        }
        if (tn >= thi) break;
        cur ^= 1;
        *(LAS u32x4*)(lds + AL_K0 + cur * 8192 + sdst) = kr; *(LAS u32x4*)(lds + AL_V0 + cur * 8192 + sdst) = vr; if (F::HAS_BIAS) ((LAS float*)(lds + AL_B0 + cur * 256))[btid] = br;
        __syncthreads();
        t = tn;
    }
    __syncthreads();
}
__device__ __forceinline__ void load_qf(bf16x8 (&qf)[4], const bf16_t* qrow, int hi) {
#pragma unroll
    for (int d0 = 0; d0 < 4; ++d0) qf[d0] = *(const bf16x8*)(qrow + d0 * 16 + hi * 8);
}
__device__ __forceinline__ void store_ot(const f32x16 (&o)[2], bf16_t* orow, int hi) {
#pragma unroll
    for (int d0 = 0; d0 < 2; ++d0)
#pragma unroll
        for (int g = 0; g < 4; ++g) { u32x2 w; w.x = pk2(o[d0][4 * g], o[d0][4 * g + 1]); w.y = pk2(o[d0][4 * g + 2], o[d0][4 * g + 3]); *(u32x2*)(orow + 32 * d0 + 8 * g + 4 * hi) = w; }
}

struct FoxF { static constexpr int MODE = 0; static constexpr bool HAS_BIAS = true; int tq, qmin, hi;
    __device__ __forceinline__ bool skip(int) const { return false; }
    __device__ __forceinline__ bool wskip(int) const { return false; }
    __device__ __forceinline__ void apply(f32x16& p0, f32x16& p1, int t) const { const float NI = ninf_();
        if (64 * t + 63 > qmin) {
#pragma unroll
            for (int r = 0; r < 16; ++r) { const int key = 64 * t + crow(r, hi); if (key > tq) p0[r] = NI; if (key + 32 > tq) p1[r] = NI; } } } };
struct RetF { static constexpr int MODE = 1; static constexpr bool HAS_BIAS = false; int tq, hi; float lg;
    __device__ __forceinline__ bool skip(int) const { return false; }
    __device__ __forceinline__ bool wskip(int) const { return false; }
    __device__ __forceinline__ void apply(f32x16& p0, f32x16& p1, int t) const { const float NI = ninf_();
#pragma unroll
        for (int r = 0; r < 16; ++r) { const int key = 64 * t + crow(r, hi);
            p0[r] = (key <= tq) ? p0[r] * ex2((float)(tq - key) * lg) : 0.f; p1[r] = (key + 32 <= tq) ? p1[r] * ex2((float)(tq - key - 32) * lg) : 0.f; } } };
struct SelF { static constexpr int MODE = 0; static constexpr bool HAS_BIAS = false; unsigned long long umask, wmask, mymask; int tq, klo, hi;
    __device__ __forceinline__ bool skip(int t) const { return ((umask >> t) & 1ull) == 0ull; }
    __device__ __forceinline__ bool wskip(int t) const { return ((wmask >> t) & 1ull) == 0ull; }
    int tdiag, tlo;
    __device__ __forceinline__ void apply(f32x16& p0, f32x16& p1, int t) const { const float NI = ninf_(); const bool on = ((mymask >> t) & 1ull) != 0ull;
        if (t >= tdiag || t <= tlo) {
#pragma unroll
            for (int r = 0; r < 16; ++r) { const int key = 64 * t + crow(r, hi); if (!on || key > tq || key <= klo) p0[r] = NI; if (!on || key + 32 > tq || key + 32 <= klo) p1[r] = NI; }
        } else if (__builtin_amdgcn_ballot_w64(!on) != 0ull) {
#pragma unroll
            for (int r = 0; r < 16; ++r) { if (!on) { p0[r] = NI; p1[r] = NI; } }
        } } };
__device__ __forceinline__ void fox_unit(const Params& p, int idx, LAS unsigned char* lds, const int tid_in_) {
    int tid = tid_in_; asm volatile("" : "+v"(tid)); unsigned char* wsl_ = ws_late();
    const int lane = tid & 63, wid = tid >> 6, r32 = lane & 31, hi = lane >> 5;
    const int qb = 15 - idx / (BC * 4), bh = idx % (BC * 4), h = bh & 3, bl = bh >> 2;
    const bf16_t* proj = (const bf16_t*)(wsl_ + WS_R + R_PROJ);
    const int tq = qb * 256 + wid * 32 + r32; const size_t rowc = (size_t)bl * SEQ + tq;
    bf16x8 qf[4]; load_qf(qf, proj + rowc * PROJW + PC_FQ + h * 64, hi);
    f32x16 o[2]; o[0] = z16(); o[1] = z16(); float m = -INFINITY, l = 0.f;
    FoxF f; f.tq = tq; f.qmin = qb * 256; f.hi = hi;
    flash_loop(f, 0, 4 * qb + 4, proj + (size_t)bl * SEQ * PROJW + PC_FK + h * 64, proj + (size_t)bl * SEQ * PROJW + PC_FV + h * 64, PROJW,
               (const float*)(wsl_ + WS_R + R_CUM) + (size_t)bh * SEQ, qf, o, m, l, lds, tid);
    l = x32_sum(l); const float inv = 1.0f / l; o[0] *= inv; o[1] *= inv;
    store_ot(o, (bf16_t*)(wsl_ + WS_R + R_O) + (size_t)3 * MC * 256 + rowc * 256 + h * 64, hi);
}
__device__ __forceinline__ void rope8(float (&o1)[8], float (&o2)[8], const u32x4& a, const u32x4& b, const f32x2* tp) {
    const unsigned aa[4] = {a.x, a.y, a.z, a.w}, bb[4] = {b.x, b.y, b.z, b.w};
#pragma unroll
    for (int j = 0; j < 8; ++j) { const float x1 = (j & 1) ? __uint_as_float(aa[j >> 1] & 0xffff0000u) : __uint_as_float(aa[j >> 1] << 16);
        const float x2 = (j & 1) ? __uint_as_float(bb[j >> 1] & 0xffff0000u) : __uint_as_float(bb[j >> 1] << 16);
        const f32x2 cs = tp[j]; o1[j] = x1 * cs.x - x2 * cs.y; o2[j] = x1 * cs.y + x2 * cs.x; }
}
__device__ __forceinline__ u32x4 pack8f(const float (&v)[8]) { u32x4 w; w.x = pk2(v[0], v[1]); w.y = pk2(v[2], v[3]); w.z = pk2(v[4], v[5]); w.w = pk2(v[6], v[7]); return w; }
__device__ __forceinline__ void ret_kv_unit(const Params& p, int ch, int idx, LAS unsigned char* lds, const int tid_in_) {
    int tid = tid_in_; asm volatile("" : "+v"(tid)); unsigned char* wsl_ = ws_late();
    const int lane = tid & 63, wid = tid >> 6, hi = lane >> 5;
    const int n = idx & 31, bh = idx >> 5, h = bh & 3, bl = bh >> 2;
    const bf16_t* proj = (const bf16_t*)(wsl_ + WS_R + R_PROJ); const f32x2* tab = (const f32x2*)(wsl_ + WS_ROPE);
    const size_t rowc0 = (size_t)bl * SEQ + n * 128; const float lg = log2f(1.0f - exp2f(-5.0f - (float)h));
    LAS unsigned char* KZ = lds; LAS unsigned char* VT = lds + 16384;
    __syncthreads();
    { const int key = tid >> 2, cp = tid & 3; const bf16_t* src = proj + (rowc0 + key) * PROJW + PC_RK + h * 64 + cp * 8;
      const u32x4 a = *(const u32x4*)src, b = *(const u32x4*)(src + 32); float o1[8], o2[8];
      rope8(o1, o2, a, b, tab + ((size_t)ch * MC + rowc0 + key) * 32 + cp * 8);
      const float zt = ex2((float)(127 - key) * lg);
#pragma unroll
      for (int j = 0; j < 8; ++j) { o1[j] *= zt; o2[j] *= zt; }
      LAS unsigned char* d = KZ + (key >> 6) * 8192 + ((key & 63) >> 4) * 1024 + (key & 15) * 64 + cp * 16;
      *(LAS u32x4*)d = pack8f(o1); *(LAS u32x4*)(d + 4096) = pack8f(o2); }
#pragma unroll
    for (int t2 = 0; t2 < 2; ++t2)
        *(LAS u32x4*)(VT + t2 * 8192 + wid * 1024 + lane * 16) = *(const u32x4*)(proj + (rowc0 + 64 * t2 + 16 * (wid & 3) + (lane >> 2)) * PROJW + PC_RV + h * 64 + (wid >> 2) * 32 + (lane & 3) * 8);
    __syncthreads();
    if (wid < 4) { const int vt = wid >> 1, kt = wid & 1;
        const int fo = ((lane >> 4) & 1) * 32 + (lane & 3) * 8 + (4 * hi + ((lane & 15) >> 2)) * 64;
        f32x16 acc = z16();
#pragma unroll
        for (int t2 = 0; t2 < 2; ++t2)
#pragma unroll
            for (int ks = 0; ks < 4; ++ks) { const LAS unsigned char* va = VT + t2 * 8192 + vt * 4096 + ks * 1024 + fo; const LAS unsigned char* ka = KZ + t2 * 8192 + kt * 4096 + ks * 1024 + fo;
                const s16x4 v0 = vtr(va), v1 = vtr(va + 512), k0 = vtr(ka), k1 = vtr(ka + 512);
                acc = MF32(((bf16x8){v0[0], v0[1], v0[2], v0[3], v1[0], v1[1], v1[2], v1[3]}), ((bf16x8){k0[0], k0[1], k0[2], k0[3], k1[0], k1[1], k1[2], k1[3]}), acc); }
        float* kvt = (float*)(wsl_ + WS_R + R_KVT) + (size_t)idx * 4096;
#pragma unroll
        for (int r = 0; r < 16; ++r) kvt[(32 * vt + crow(r, hi)) * 64 + 32 * kt + (lane & 31)] = acc[r]; }
    __syncthreads();
}
__device__ __forceinline__ void ret_out_unit(const Params& p, int l_, int ch, int idx, LAS unsigned char* lds, const int tid_in_) {
    int tid = tid_in_; asm volatile("" : "+v"(tid)); unsigned char* wsl_ = ws_late();
    const int lane = tid & 63, wid = tid >> 6, r32 = lane & 31, hi = lane >> 5, gw = wid >> 2, wq = wid & 3;
    const int np = 15 - idx / (BC * 4), bh = idx % (BC * 4), h = bh & 3, bl = bh >> 2, n = 2 * np + gw;
    const bf16_t* proj = (const bf16_t*)(wsl_ + WS_R + R_PROJ); const f32x2* tab = (const f32x2*)(wsl_ + WS_ROPE);
    const float lg = log2f(1.0f - exp2f(-5.0f - (float)h));
    LAS unsigned char* KS = lds; LAS unsigned char* VS = lds + 32768; LAS unsigned char* RT = lds + 65536;
    const int tql = 32 * wq + r32; const size_t rowc = (size_t)bl * SEQ + n * 128 + tql;
    bf16x8 qf[4];
    { const bf16_t* qrow = proj + rowc * PROJW + PC_RQ + h * 64; const f32x2* tp = tab + ((size_t)ch * MC + rowc) * 32;
#pragma unroll
      for (int d0 = 0; d0 < 2; ++d0) { const u32x4 a = *(const u32x4*)(qrow + d0 * 16 + hi * 8), b = *(const u32x4*)(qrow + 32 + d0 * 16 + hi * 8); float o1[8], o2[8];
          rope8(o1, o2, a, b, tp + d0 * 16 + hi * 8); qf[d0] = __builtin_bit_cast(bf16x8, pack8f(o1)); qf[d0 + 2] = __builtin_bit_cast(bf16x8, pack8f(o2)); } }
    __syncthreads();
#pragma unroll
    for (int g = 0; g < 2; ++g) { const size_t r0 = (size_t)bl * SEQ + (2 * np + g) * 128;
        { const int key = tid >> 2, cp = tid & 3; const bf16_t* src = proj + (r0 + key) * PROJW + PC_RK + h * 64 + cp * 8;
          const u32x4 a = *(const u32x4*)src, b = *(const u32x4*)(src + 32); float o1[8], o2[8];
          rope8(o1, o2, a, b, tab + ((size_t)ch * MC + r0 + key) * 32 + cp * 8);
          LAS unsigned char* d = KS + (g * 2 + (key >> 6)) * 8192 + cp * 1024 + (key & 63) * 16;
          *(LAS u32x4*)d = pack8f(o1); *(LAS u32x4*)(d + 4096) = pack8f(o2); }
#pragma unroll
        for (int t2 = 0; t2 < 2; ++t2)
            *(LAS u32x4*)(VS + (g * 2 + t2) * 8192 + wid * 1024 + lane * 16) = *(const u32x4*)(proj + (r0 + 64 * t2 + 16 * (wid & 3) + (lane >> 2)) * PROJW + PC_RV + h * 64 + (wid >> 2) * 32 + (lane & 3) * 8); }
    { const int t = tid & 255; const float gdec = ex2(128.0f * lg); const float* kv0 = (const float*)(wsl_ + WS_R + R_KVT) + (size_t)(bh * 32) * 4096;
#pragma unroll
      for (int q = 0; q < 2; ++q) { const int task = t + 256 * q, v = task >> 3, kc = task & 7; f32x4 a0 = {0.f, 0.f, 0.f, 0.f}, a1 = {0.f, 0.f, 0.f, 0.f};
          for (int m = 0; m < n; ++m) { const float* s = kv0 + (size_t)m * 4096 + v * 64 + kc * 8; a0 = a0 * gdec + *(const f32x4*)s; a1 = a1 * gdec + *(const f32x4*)(s + 4); }
          *(LAS u32x4*)(RT + gw * 8192 + kc * 1024 + v * 16) = pack8(a0, a1); } }
    __syncthreads();
    f32x16 o[2];
    { f32x16 p0, p1; attn_qkt(p0, p1, RT + gw * 8192, qf, r32, hi); const float xi = ex2((float)(tql + 1) * lg); o[0] = p0 * xi; o[1] = p1 * xi; }
    for (int kt = 0; kt <= (wq >> 1); ++kt) { f32x16 p0, p1; attn_qkt(p0, p1, KS + (gw * 2 + kt) * 8192, qf, r32, hi);
#pragma unroll
        for (int r = 0; r < 16; ++r) { const int key = 64 * kt + crow(r, hi);
            p0[r] = (key <= tql) ? p0[r] * ex2((float)(tql - key) * lg) : 0.f; p1[r] = (key + 32 <= tql) ? p1[r] * ex2((float)(tql - key - 32) * lg) : 0.f; }
        bf16x8 pw[4]; pw[0] = pack_acc8(p0, 0); pw[1] = pack_acc8(p0, 1); pw[2] = pack_acc8(p1, 0); pw[3] = pack_acc8(p1, 1);
        attn_pv(o, VS + (gw * 2 + kt) * 8192, pw, lane, hi); }
    float s = 0.f;
#pragma unroll
    for (int r = 0; r < 16; ++r) s += o[0][r] + o[1][r];
    s = x32_sum(s); const float mu = s * (1.0f / 64.0f); float q = 0.f;
#pragma unroll
    for (int r = 0; r < 16; ++r) { const float a = o[0][r] - mu, b = o[1][r] - mu; q += a * a + b * b; }
    q = x32_sum(q); const float rs = 1.0f / sqrtf(q * (1.0f / 64.0f) + LN_EPS);
    const float* gw_ = PIN(IN_RETGN) + l_ * 256 + h * 64; const bf16_t* grow = proj + rowc * PROJW + PC_RG + h * 64;
#pragma unroll
    for (int d0 = 0; d0 < 2; ++d0)
#pragma unroll
        for (int g = 0; g < 4; ++g) { const int d = 32 * d0 + 8 * g + 4 * hi; const u32x2 gz = *(const u32x2*)(grow + d); const f32x4 w4 = *(const f32x4*)(gw_ + d);
            const float gg[4] = {__uint_as_float(gz.x << 16), __uint_as_float(gz.x & 0xffff0000u), __uint_as_float(gz.y << 16), __uint_as_float(gz.y & 0xffff0000u)};
#pragma unroll
            for (int e = 0; e < 4; ++e) o[d0][4 * g + e] = (o[d0][4 * g + e] - mu) * rs * w4[e] * siluf_(gg[e]); }
    store_ot(o, (bf16_t*)(wsl_ + WS_R + R_O) + (size_t)1 * MC * 256 + rowc * 256 + h * 64, hi);
    __syncthreads();
}
constexpr int NL_KC = 36864, NL_VC = 69632, NL_IMPM = 102400, NL_IMPS = 118784, NL_SELM = 135424;
__device__ __forceinline__ void nsa_unit(const Params& p, int idx, LAS unsigned char* lds, const int tid_in_) {
    int tid = tid_in_; asm volatile("" : "+v"(tid)); unsigned char* wsl_ = ws_late();
    const int lane = tid & 63, wid = tid >> 6, r32 = lane & 31, hi = lane >> 5, tl = r32 >> 2, hd = r32 & 3;
    const int ib = 63 - idx / BC, bl = idx % BC;
    const bf16_t* proj = (const bf16_t*)(wsl_ + WS_R + R_PROJ); const float* sm = (const float*)(wsl_ + WS_R + R_SM);
    const int tokl = 8 * wid + tl, tq = ib * 64 + tokl; const size_t rowc = (size_t)bl * SEQ + tq;
    bf16x8 qf[4]; load_qf(qf, proj + rowc * PROJW + PC_NQ + hd * 64, hi);
    const float g0 = sigmoidf_(sm[rowc * 32 + 8 + hd * 3 + 0]), g1 = sigmoidf_(sm[rowc * 32 + 8 + hd * 3 + 1]), g2 = sigmoidf_(sm[rowc * 32 + 8 + hd * 3 + 2]);
    f32x16 of[2];
    const int ntc = min(3, (4 * ib + 2) >> 6) + 1;
    {
        const bf16_t* kc = (const bf16_t*)(wsl_ + WS_R + R_KCMP) + (size_t)bl * 256 * 64; const bf16_t* vc = kc + (size_t)BC * 256 * 64;
        __syncthreads();
        for (int tt = 0; tt < ntc; ++tt) {
            *(LAS u32x4*)(lds + NL_KC + tt * 8192 + wid * 1024 + lane * 16) = *(const u32x4*)(kc + (size_t)(tt * 64 + lane) * 64 + wid * 8);
            *(LAS u32x4*)(lds + NL_VC + tt * 8192 + wid * 1024 + lane * 16) = *(const u32x4*)(vc + (size_t)(tt * 64 + 16 * (wid & 3) + (lane >> 2)) * 64 + (wid >> 2) * 32 + (lane & 3) * 8); }
        __syncthreads();
        float m = -INFINITY, l = 0.f;
        for (int tt = 0; tt < ntc; ++tt) { f32x16 p0, p1; attn_qkt(p0, p1, lds + NL_KC + tt * 8192, qf, r32, hi);
#pragma unroll
            for (int r = 0; r < 16; ++r) { const int n0 = 64 * tt + crow(r, hi), n1 = n0 + 32; if (n0 >= 255 || 16 * n0 + 31 > tq) p0[r] = -INFINITY; if (n1 >= 255 || 16 * n1 + 31 > tq) p1[r] = -INFINITY; }
            float mt = p0[0];
#pragma unroll
            for (int r = 1; r < 16; ++r) mt = fmaxf(mt, p0[r]);
#pragma unroll
            for (int r = 0; r < 16; ++r) mt = fmaxf(mt, p1[r]);
            mt = x32_max(mt);
            const float mn = fmaxf(m, mt), ms = (mn == -INFINITY) ? 0.f : mn; float s = 0.f;
#pragma unroll
            for (int r = 0; r < 16; ++r) s += ex2(p0[r] - ms) + ex2(p1[r] - ms);
            l = l * ex2(m - ms) + s; m = mn; }
        l = x32_sum(l);
        const float inv = (l > 0.f) ? 1.0f / l : 0.f, ms = (m == -INFINITY) ? 0.f : m;
        LAS float* impm = (LAS float*)(lds + NL_IMPM); LAS float* imps = (LAS float*)(lds + NL_IMPS);
        f32x16 oc[2]; oc[0] = z16(); oc[1] = z16();
        for (int tt = 0; tt < ntc; ++tt) { f32x16 p0, p1; attn_qkt(p0, p1, lds + NL_KC + tt * 8192, qf, r32, hi);
#pragma unroll
            for (int r = 0; r < 16; ++r) { const int n0 = 64 * tt + crow(r, hi), n1 = n0 + 32;
                p0[r] = (n0 >= 255 || 16 * n0 + 31 > tq) ? 0.f : ex2(p0[r] - ms) * inv; p1[r] = (n1 >= 255 || 16 * n1 + 31 > tq) ? 0.f : ex2(p1[r] - ms) * inv; }
#pragma unroll
            for (int g = 0; g < 4; ++g) {
                float ma = p0[4 * g] + p0[4 * g + 1] + p0[4 * g + 2] + 0.5f * p0[4 * g + 3], sa = 0.5f * p0[4 * g + 3];
                float mb = p1[4 * g] + p1[4 * g + 1] + p1[4 * g + 2] + 0.5f * p1[4 * g + 3], sb = 0.5f * p1[4 * g + 3];
                ma += swz_xor<1>(ma); ma += swz_xor<2>(ma); sa += swz_xor<1>(sa); sa += swz_xor<2>(sa);
                mb += swz_xor<1>(mb); mb += swz_xor<2>(mb); sb += swz_xor<1>(sb); sb += swz_xor<2>(sb);
                if (hd == 0) { const int ja = 16 * tt + 2 * g + hi, jb = ja + 8;
                    impm[tokl * 64 + ja] = ma; imps[tokl * 65 + ja + 1] = sa; impm[tokl * 64 + jb] = mb; imps[tokl * 65 + jb + 1] = sb; } }
            bf16x8 pw[4]; pw[0] = pack_acc8(p0, 0); pw[1] = pack_acc8(p0, 1); pw[2] = pack_acc8(p1, 0); pw[3] = pack_acc8(p1, 1);
            attn_pv(oc, lds + NL_VC + tt * 8192, pw, lane, hi); }
        of[0] = oc[0] * g0; of[1] = oc[1] * g0;
        LAS unsigned long long* selm = (LAS unsigned long long*)(lds + NL_SELM);
        if (ib < 16) { if (lane < 8) selm[8 * wid + lane] = (2ull << ib) - 1ull; }
        else for (int t8 = 0; t8 < 8; ++t8) { const int tk = 8 * wid + t8; const int j = lane;
            float imp = (j < 16 * ntc) ? impm[tk * 64 + j] + ((j > 0) ? imps[tk * 65 + j] : 0.f) : 0.f;
            const bool forced = (j == 0) || (j == ib) || (j == ib - 1);
            const float score = forced ? 1.0e4f : ((j <= ib) ? imp : -1.0f);
            int rank = 0;
#pragma unroll
            for (int jj = 0; jj < 64; ++jj) { const float sj = __uint_as_float(__builtin_amdgcn_readlane(__float_as_uint(score), jj)); rank += ((sj > score) || (sj == score && jj < j)) ? 1 : 0; }
            const unsigned long long mk = __ballot((rank < 16) && (j <= ib));
            if (lane == 0) selm[tk] = mk; }
    }
    __syncthreads();
    unsigned long long mymask, umask, wmask;
    { const LAS unsigned long long* selm = (const LAS unsigned long long*)(lds + NL_SELM); mymask = selm[tokl];
      unsigned long long u = selm[lane]; unsigned lo = (unsigned)u, hi32 = (unsigned)(u >> 32);
      lo |= swz_xor_u<1>(lo); lo |= swz_xor_u<2>(lo); lo |= swz_xor_u<4>(lo); lo |= swz_xor_u<8>(lo); lo |= swz_xor_u<16>(lo); lo = x32_or(lo);
      hi32 |= swz_xor_u<1>(hi32); hi32 |= swz_xor_u<2>(hi32); hi32 |= swz_xor_u<4>(hi32); hi32 |= swz_xor_u<8>(hi32); hi32 |= swz_xor_u<16>(hi32); hi32 = x32_or(hi32);
      umask = ((unsigned long long)hi32 << 32) | lo; umask = __builtin_amdgcn_readfirstlane((unsigned)umask) | ((unsigned long long)__builtin_amdgcn_readfirstlane((unsigned)(umask >> 32)) << 32);
      unsigned wl = 0u, wh = 0u;
#pragma unroll
      for (int t8 = 0; t8 < 8; ++t8) { const unsigned long long mk = selm[8 * wid + t8]; wl |= (unsigned)mk; wh |= (unsigned)(mk >> 32); }
      wmask = (unsigned long long)(unsigned)__builtin_amdgcn_readfirstlane((int)wl) | ((unsigned long long)(unsigned)__builtin_amdgcn_readfirstlane((int)wh) << 32); }
    for (int br = 0; br < 2; ++br) {
        f32x16 o[2]; o[0] = z16(); o[1] = z16(); float m = -INFINITY, l = 0.f;
        SelF f; f.umask = br ? ~0ull : umask; f.wmask = br ? ~0ull : wmask; f.mymask = br ? ~0ull : mymask; f.tq = tq; f.klo = br ? tq - 512 : -1; f.hi = hi; f.tdiag = ib; f.tlo = br ? (ib * 64 + 63 - 512) / 64 : -1;
        const bf16_t* nkv2 = (const bf16_t*)(ws_late() + WS_R + R_NKV);
        flash_loop(f, br ? max(0, ib - 8) : 0, ib + 1, nkv2 + (size_t)(2 + 2 * br) * (NKV_SEG / 2) + (size_t)bl * SEQ * 64, nkv2 + (size_t)(3 + 2 * br) * (NKV_SEG / 2) + (size_t)bl * SEQ * 64, 64, nullptr, qf, o, m, l, lds, tid);
        l = x32_sum(l); const float sc = (l > 0.f) ? (br ? g2 : g1) / l : 0.f; of[0] += o[0] * sc; of[1] += o[1] * sc;
    }
    store_ot(of, (bf16_t*)(ws_late() + WS_R + R_O) + (size_t)2 * MC * 256 + rowc * 256 + hd * 64, hi);
}

constexpr int LDS_MISC = LDS_BYTES - 256;
constexpr size_t LWS = ((LW_BYTES + MiB - 1) / MiB) * MiB;
#define PHASE_PRE const int tid = fresh_tid(); int l, ch; { int k_; bool b_; step_decode(__builtin_amdgcn_readfirstlane(((volatile LAS int*)lds_at(LDS_MISC + 176))[0]), k_, l, ch, b_); } \
    Params p; ptab_load(p); LAS unsigned char* lds = lds_at(0); const int G = NWG; \
    const int c = __builtin_amdgcn_readfirstlane(((volatile LAS int*)(lds + LDS_MISC + 176))[2]); (void)lds; (void)G; (void)c; (void)l; (void)ch; \
    volatile LAS int* qslot = (volatile LAS int*)(lds + LDS_MISC + 16); (void)qslot;
#define LW_ (p.ws + WS_W + (size_t)l * LWS)
#define LWO_ ((unsigned)(WS_W + (size_t)l * LWS))
#define HC_ ((unsigned)(WS_H + (size_t)ch * MC * 1024 * 2))
#define QCTR_ ((unsigned*)(p.ws + WS_CTL) + CW_Q + 64 * ((l * NCHUNK + ch) * 8) + 8192 * __builtin_amdgcn_readfirstlane(((volatile LAS int*)lds_at(LDS_MISC + 176))[3]))
__device__ __forceinline__ int tid_out(int t) { asm volatile("" : "+v"(t)); return t; }
__device__ __forceinline__ int fresh_tid() {
    LAS unsigned* ctr = (LAS unsigned*)lds_at(LDS_MISC + 192);
    unsigned z = 0u; asm volatile("" : "+v"(z));
    const int lane = (int)__builtin_amdgcn_mbcnt_hi(~0u, __builtin_amdgcn_mbcnt_lo(~0u, z));
    unsigned t = 0u; if (lane == 0) t = __hip_atomic_fetch_add(ctr, 1u, __ATOMIC_RELAXED, __HIP_MEMORY_SCOPE_WORKGROUP);
    t = (unsigned)__builtin_amdgcn_readfirstlane((int)t);
    __syncthreads();
    return (int)(((t & 7u) << 6) | (unsigned)lane);
}
__device__ __forceinline__ void step_decode(int s, int& k, int& l, int& ch, bool& bar);
#define GCTR_(j) ((unsigned*)(p.ws + WS_CTL) + CW_G + 64 * ((l * NCHUNK + ch) * 8 + (j)) + 16384 * __builtin_amdgcn_readfirstlane(((volatile LAS int*)lds_at(LDS_MISC + 176))[3]))
#define PHFN(name) static __device__ __noinline__ void name()
#define PHFI(name) static __device__ __forceinline__ void name()

PHFI(ph_p0) { PHASE_PRE
    constexpr int N_ADA = 192, N_CB = 4, N_ROPE = MTOK * 32 / 4096, N_T = 2 * TJ_TOTAL;
    for (int it = c; it < N_ADA + N_CB + N_ROPE + N_T; it += G) {
        if (it < N_ADA) p0_ada(p, it, (LAS float*)lds, tid);
        else if (it < N_ADA + N_CB) p0_cbias(p, it - N_ADA, tid);
        else if (it < N_ADA + N_CB + N_ROPE) p0_rope(p, it - N_ADA - N_CB, tid);
        else p0_transpose(p, it - N_ADA - N_CB - N_ROPE, (LAS float*)lds, tid);
    }
}
PHFN(ph_p1) { PHASE_PRE prep_first(p, tid, c); }
PHFI(ph_a1) { PHASE_PRE
    DenseSched S; S.A = HC_; S.Bt = LWO_ + (unsigned)LW_WIN; S.tA = 256u * 1024 * 2; S.tB = 256u * 1024 * 2; S.aBr = 0; S.nM = MC / 256; S.nN = NPROJ / 256; S.G = G; S.c = c; S.pnShift = 0; S.ctr = GCTR_(0);
    EpiProj E;
    pg8::gemm_phase<EpiProj, DenseSched, true, false>(lds, 1024, 1024, 1024, S, E, tid, (const char*)p.ws);
}
PHFN(ph_a2a) { PHASE_PRE
    if (c < 2 * BC) {
        const int which = c & 1, bl = c >> 1;
        OneSched S; S.has = true; S.u0.pm = bl; S.u0.pn = 0; S.u0.aux = which; S.u0.nvalid = 256; S.u0.rows = 0u;
        S.u0.a = (unsigned)(WS_R + R_NKV + (size_t)which * NKV_SEG + (size_t)bl * SEQ * 64 * 2); S.u0.b = LWO_ + (unsigned)(LW_CW1 + (size_t)which * 256 * 2048 * 2);
        EpiH1 E; E.h1 = (bf16_t*)(p.ws + WS_R + R_H1); E.cbias = (const float*)(p.ws + WS_CBIAS) + l * 512;
        pg8::gemm_phase<EpiH1, OneSched, true, false>(lds, 2048, 1024, 2048, S, E, tid, (const char*)p.ws);
        VM_WAIT(); __syncthreads(); __builtin_amdgcn_fence(__ATOMIC_ACQUIRE, "agent"); VM_WAIT(); __syncthreads();
    }
}
PHFN(ph_a2b) { PHASE_PRE
    if (c < 2 * BC) {
        const int which = c & 1, bl = c >> 1;
        OneSched S2; S2.has = true; S2.u0.pm = bl; S2.u0.pn = 0; S2.u0.aux = which; S2.u0.nvalid = 256; S2.u0.rows = 0u;
        S2.u0.a = (unsigned)(WS_R + R_H1 + ((size_t)which * BC * 256 + (size_t)bl * 256) * 256 * 2); S2.u0.b = LWO_ + (unsigned)(LW_CW2 + (size_t)which * 256 * 256 * 2);
        EpiCmp2 E2; E2.kc = (bf16_t*)(p.ws + WS_R + R_KCMP);
        pg8::gemm_phase<EpiCmp2, OneSched, true, false>(lds, 256, 256, 256, S2, E2, tid, (const char*)p.ws);
    }
}
PHFI(ph_a2c) { PHASE_PRE
    for (;;) { const int u = q_next(QCTR_ + 0, qslot, tid); if (u >= BC * 4 * 64) break; gdn_prep_unit(p, l, u, lds, tid); }
}
PHFN(ph_a2d) { PHASE_PRE
    for (;;) { const int u = q_next(QCTR_ + 64, qslot, tid); if (u >= BC * 4) break; fox_cum_item(p, l, u, (LAS float*)lds, tid); }
    for (;;) { const int u = q_next(QCTR_ + 320, qslot, tid); if (u >= BC * 4 * 32) break; ret_kv_unit(p, ch, u, lds, tid); }
}
PHFN(ph_a3a) { PHASE_PRE if (c < BC * 4) gdn_scan_item(p, l, ch, c, lds, tid); }
PHFI(ph_a3b) { PHASE_PRE for (;;) { const int u = q_next(QCTR_ + 128, qslot, tid); if (u >= BC * 4 * 16) break; fox_unit(p, u, lds, tid); } }
PHFI(ph_a3c) { PHASE_PRE for (;;) { const int u = q_next(QCTR_ + 192, qslot, tid); if (u >= BC * 4 * 16) break; ret_out_unit(p, l, ch, u, lds, tid); } }
PHFI(ph_a3d) { PHASE_PRE for (;;) { const int u = q_next(QCTR_ + 256, qslot, tid); if (u >= BC * 64) break; nsa_unit(p, u, lds, tid); } }
PHFN(ph_a5) { PHASE_PRE
    DenseSched S; S.A = (unsigned)(WS_R + R_O); S.Bt = LWO_ + (unsigned)LW_BPT; S.tA = 256u * 256 * 2; S.tB = 256u * 256 * 2; S.aBr = (unsigned)((size_t)MC * 256 * 2); S.nM = MC / 256; S.nN = 16; S.G = G; S.c = c; S.pnShift = 2; S.ctr = GCTR_(1);
    EpiP E;
    pg8::gemm_phase<EpiP, DenseSched, true, false>(lds, 256, 256, 256, S, E, tid, (const char*)p.ws);
}
PHFN(ph_a6) { PHASE_PRE
    DenseSched S; S.A = HC_; S.Bt = LWO_ + (unsigned)LW_WGV; S.tA = 256u * 1024 * 2; S.tB = 256u * 1024 * 2; S.aBr = 0; S.nM = MC / 256; S.nN = 16; S.G = G; S.c = c; S.pnShift = 0; S.ctr = GCTR_(2);
    EpiGate E;
    pg8::gemm_phase<EpiGate, DenseSched, true, false>(lds, 1024, 1024, 1024, S, E, tid, (const char*)p.ws);
}
PHFN(ph_a7) { PHASE_PRE
    DenseSched S; S.A = (unsigned)(WS_R + R_Y); S.Bt = LWO_ + (unsigned)LW_WOT; S.tA = 256u * 1024 * 2; S.tB = 256u * 1024 * 2; S.aBr = 0; S.nM = MC / 256; S.nN = 4; S.G = G; S.c = c; S.pnShift = 0; S.ctr = GCTR_(3);
    EpiOut E; E.row_base = ch * MC;
    pg8::gemm_phase<EpiOut, DenseSched, true, false>(lds, 1024, 1024, 1024, S, E, tid, (const char*)p.ws);
}
PHFN(ph_b0) { PHASE_PRE prep_moe(p, l, (LAS float*)lds, tid, c); }
__device__ __forceinline__ void moe_tables(const Params& p, int l, LAS int* mcnt, LAS int* mpre, const int tid) {
    __syncthreads();
    if (tid < 16) mcnt[tid] = (int)((unsigned*)(p.ws + WS_CTL))[CW_CNT + l * 64 + tid];
    __syncthreads();
    if (tid == 0) { int s = 0; for (int e = 0; e < 16; ++e) { mpre[e] = s; s += (mcnt[e] + 255) >> 8; } mpre[16] = s; }
    __syncthreads();
}
PHFI(ph_b1) { PHASE_PRE
    LAS int* mcnt = (LAS int*)(lds + LDS_MISC + 32); LAS int* mpre = mcnt + 16; moe_tables(p, l, mcnt, mpre, tid);
    MoeSched S; S.pre = mpre; S.cnt = mcnt; S.wsb = (const char*)p.ws; S.A = (unsigned)WS_H; S.W = LWO_ + (unsigned)LW_W13;
    S.wE = 1024u * 1024 * 2; S.wT = 256u * 1024 * 2; S.aT = 0; S.G = G; S.c = c; S.gatherA = true; S.ctr = GCTR_(4);
    EpiMoe1 E;
    pg8::gemm_phase<EpiMoe1, MoeSched, true, true>(lds, 1024, 1024, 1024, S, E, tid, (const char*)p.ws);
}
PHFN(ph_b2) { PHASE_PRE
    LAS int* mcnt = (LAS int*)(lds + LDS_MISC + 32); LAS int* mpre = mcnt + 16; moe_tables(p, l, mcnt, mpre, tid);
    MoeSched S; S.pre = mpre; S.cnt = mcnt; S.wsb = (const char*)p.ws; S.A = (unsigned)(WS_R + R_HID); S.W = LWO_ + (unsigned)LW_W2;
    S.wE = 1024u * 512 * 2; S.wT = 256u * 512 * 2; S.aT = 256u * 512 * 2; S.G = G; S.c = c; S.gatherA = false; S.ctr = GCTR_(5);
    EpiMoe2 E;
    pg8::gemm_phase<EpiMoe2, MoeSched, true, false>(lds, 512, 512, 512, S, E, tid, (const char*)p.ws);
}
PHFN(ph_b3) { PHASE_PRE prep_next(p, l, l == DEPTH - 1, tid, c); }

constexpr int STEPS_CHUNK = 12, STEPS_LAYER = NCHUNK * STEPS_CHUNK + 4, N_STEPS = 2 + DEPTH * STEPS_LAYER;
__device__ __forceinline__ void step_decode(int s, int& k, int& l, int& ch, bool& bar) {
    if (s < 2) { k = s; l = 0; ch = 0; bar = true; return; }
    const int t = s - 2; l = t / STEPS_LAYER; const int r = t % STEPS_LAYER;
    if (r < NCHUNK * STEPS_CHUNK) { ch = r / STEPS_CHUNK; const int q = r % STEPS_CHUNK; k = 2 + q; bar = !(q == 1 || q == 2 || q == 3 || q == 5 || q == 6 || q == 7); }
    else { ch = 0; k = 14 + (r - NCHUNK * STEPS_CHUNK); bar = true; }
}
__global__ void __launch_bounds__(NTHR, 2) __attribute__((disable_tail_calls)) mega_fwd(Params p0_) {
    LAS unsigned char* lds = lds_at(0);
    const int tid = threadIdx.x;
    volatile LAS unsigned* xbw = (volatile LAS unsigned*)(lds + LDS_MISC);
    volatile LAS int* st = (volatile LAS int*)(lds + LDS_MISC + 176);
    if (tid == 0) { xbw[0] = 0u; xbw[1] = 0u; xbw[2] = 0u; xbw[3] = 0u; st[0] = p0_.ph_lo; st[1] = p0_.ph_hi; st[2] = blockIdx.x; st[3] = 0; *(volatile LAS unsigned*)(lds + LDS_MISC + 200) = 0u; *(volatile LAS unsigned*)(lds + LDS_MISC + 192) = 0u; }
    ptab_store(p0_, tid);
    __syncthreads();
    (void)xcd_barrier_post((unsigned*)(p0_.ws + WS_CTL) + CW_BAR, xbw, tid);
    for (;;) {
        {
          LAS unsigned char* mb_ = lds_at(LDS_MISC); volatile LAS int* st_ = (volatile LAS int*)(mb_ + 176);
          const int s = __builtin_amdgcn_readfirstlane(st_[0]), e = __builtin_amdgcn_readfirstlane(st_[1]);
          if (s >= e) break;
          int k, l, ch; bool bar; step_decode(s, k, l, ch, bar);
          switch (k) {
          case 0: ph_p0(); break;
          case 1: ph_p1(); break;
          case 2: ph_a1(); break;
          case 3: ph_a2a(); break;
          case 4: ph_a2b(); break;
          case 5: ph_a2c(); break;
          case 6: ph_a2d(); break;
          case 7: ph_a3a(); break;
          case 8: ph_a3b(); break;
          case 9: ph_a3c(); break;
          case 10: ph_a3d(); break;
          case 11: ph_a5(); break;
          case 12: ph_a6(); break;
          case 13: ph_a7(); break;
          case 14: ph_b0(); break;
          case 15: ph_b1(); break;
          case 16: ph_b2(); break;
          default: ph_b3(); break;
          } }
        { const int tid = fresh_tid(); LAS unsigned char* mb_ = lds_at(LDS_MISC); volatile LAS int* st_ = (volatile LAS int*)(mb_ + 176);
          volatile LAS unsigned* xbw_ = (volatile LAS unsigned*)mb_;
          const int s = __builtin_amdgcn_readfirstlane(st_[0]), e = __builtin_amdgcn_readfirstlane(st_[1]);
          int k, l, ch; bool bar; step_decode(s, k, l, ch, bar);
#ifdef DUP_MASK
          const bool adv_ = !(((DUP_MASK >> k) & 1) && __builtin_amdgcn_readfirstlane(st_[3]) == 0);
#else
          const bool adv_ = true;
#endif
          if (adv_ && bar && s + 1 < e) { XcdBarrier b; b.bar = (unsigned*)((unsigned char*)ptab_get(28) + WS_CTL) + CW_BAR; b.x = xb_xcc_id(); b.st = xbw_;
#ifdef PROBE_BARWAIT
              __syncthreads(); const unsigned long long t0_ = __builtin_amdgcn_s_memrealtime();
              xcd_barrier(b, tid);
              const unsigned long long t1_ = __builtin_amdgcn_s_memrealtime(); if (tid == 0) { volatile LAS unsigned* ac_ = (volatile LAS unsigned*)(mb_ + 200); ac_[0] = ac_[0] + (unsigned)(t1_ - t0_); }
#else
              xcd_barrier(b, tid);
#endif
          }
          __syncthreads();
#ifdef DUP_MASK
          const int rp = __builtin_amdgcn_readfirstlane(st_[3]);
          if (((DUP_MASK >> k) & 1) && rp == 0) { if (tid == 0) st_[3] = 1; }
          else { if (tid == 0) { st_[3] = 0; st_[0] = s + 1; } }
#else
          if (tid == 0) st_[0] = s + 1;
#endif
          __syncthreads(); }
    }
#ifdef PROBE_BARWAIT
    { const unsigned w_ = *(volatile LAS unsigned*)(lds_at(LDS_MISC) + 200); const unsigned long long t0_ = __builtin_amdgcn_s_memrealtime();
      while (__builtin_amdgcn_s_memrealtime() - t0_ < (unsigned long long)w_) __builtin_amdgcn_s_sleep(8); }
#endif
}

extern "C" void kernel_launch(void* const* d_in, const int* in_sizes, int n_in, void* d_out, int out_size, void* d_ws, size_t ws_size, hipStream_t stream) {
    (void)in_sizes; (void)out_size;
    if (n_in < 27 || ws_size < WS_END) { fprintf(stderr, "kernel_launch: unexpected inputs (n_in %d, ws %zu < %zu)\n", n_in, ws_size, (size_t)WS_END); return; }
    static bool attr_set = false;
    if (!attr_set) { (void)hipFuncSetAttribute((const void*)mega_fwd, hipFuncAttributeMaxDynamicSharedMemorySize, LDS_BYTES); attr_set = true; }
    Params p{};
    for (int i = 0; i < 27; ++i) p.in[i] = (const float*)d_in[i];
    p.out = (float*)d_out; p.ws = (unsigned char*)d_ws;
    (void)hipMemsetAsync((unsigned char*)d_ws + WS_CTL, 0, CTL_BYTES, stream);
#ifndef MK_CUTS
    p.ph_lo = 0; p.ph_hi = N_STEPS;
    hipLaunchKernelGGL(mega_fwd, dim3(NWG), dim3(NTHR), LDS_BYTES, stream, p);
#else
    { static const int cuts[] = {MK_CUTS, N_STEPS}; int lo = 0;
      for (unsigned i = 0; i < sizeof(cuts) / sizeof(cuts[0]); ++i) { p.ph_lo = lo; p.ph_hi = cuts[i]; lo = cuts[i]; hipLaunchKernelGGL(mega_fwd, dim3(NWG), dim3(NTHR), LDS_BYTES, stream, p); } }
#endif
}
```

```cpp
#include <hip/hip_runtime.h>
#include <stdint.h>
#include <stdio.h>

#define GAS __attribute__((address_space(1)))
#define LAS __attribute__((address_space(3)))
typedef unsigned short bf16_t;
typedef short bf16x8 __attribute__((ext_vector_type(8)));
typedef short s16x4 __attribute__((ext_vector_type(4)));
typedef float f32x2 __attribute__((ext_vector_type(2)));
typedef float f32x4 __attribute__((ext_vector_type(4)));
typedef float f32x16 __attribute__((ext_vector_type(16)));
typedef unsigned u32x2 __attribute__((ext_vector_type(2)));
typedef unsigned u32x4 __attribute__((ext_vector_type(4)));
typedef __bf16 bf16x2_t __attribute__((ext_vector_type(2)));

constexpr int D_MODEL = 1024, BATCH = 16, SEQ = 4096, DEPTH = 2, MTOK = BATCH * SEQ;
constexpr int NCHUNK = 2, BC = BATCH / NCHUNK, MC = BC * SEQ;
constexpr int NPROJ = 3584, PROJW = 3072;
constexpr float DN_ALPHA = 1.4142135623730951f;
constexpr float LN_EPS = 1e-5f;
constexpr float LOG2E = 1.4426950408889634f;
constexpr float QSCALE = 0.125f * 1.4426950408889634f;
constexpr int NWG = 256, NTHR = 512;
constexpr int LDS_BYTES = 163840;

constexpr int PC_GQ = 0, PC_GK = 256, PC_GV = 512, PC_GZ = 768, PC_RQ = 1024, PC_RK = 1280, PC_RV = 1536, PC_RG = 1792, PC_NQ = 2048, PC_FQ = 2304, PC_FK = 2560, PC_FV = 2816;

constexpr size_t MiB = 1ull << 20;
constexpr size_t WS_CTL = 0;
constexpr size_t CTL_BYTES = 1 * MiB;
constexpr size_t WS_MOD = 1 * MiB;
constexpr size_t WS_ROPE = 2 * MiB;
constexpr size_t WS_STATS = 18 * MiB;
constexpr size_t WS_CBIAS = 19 * MiB;
constexpr size_t WS_W = 20 * MiB;
constexpr size_t LW_WIN = 0;
constexpr size_t LW_WGV = LW_WIN + (size_t)NPROJ * 1024 * 2;
constexpr size_t LW_BPT = LW_WGV + (size_t)4096 * 1024 * 2;
constexpr size_t LW_WOT = LW_BPT + (size_t)4096 * 256 * 2;
constexpr size_t LW_W13 = LW_WOT + (size_t)1024 * 1024 * 2;
constexpr size_t LW_W2 = LW_W13 + (size_t)16 * 1024 * 1024 * 2;
constexpr size_t LW_CW1 = LW_W2 + (size_t)16 * 1024 * 512 * 2;
constexpr size_t LW_CW2 = LW_CW1 + (size_t)2 * 256 * 2048 * 2;
constexpr size_t LW_BYTES = LW_CW2 + (size_t)2 * 256 * 256 * 2;
constexpr size_t WS_H = WS_W + 2 * ((LW_BYTES + MiB - 1) / MiB) * MiB;
constexpr size_t WS_R = WS_H + 128 * MiB;
constexpr size_t R_PROJ = 0;
constexpr size_t R_GDN = R_PROJ + (size_t)MC * PROJW * 2;
constexpr size_t GDN_UNIT_BYTES = 5 * 8192;
constexpr size_t R_P = 0;
constexpr size_t R_NKV = R_GDN + (size_t)BC * 4 * 64 * GDN_UNIT_BYTES;
constexpr size_t NKV_SEG = (size_t)(MC + 64) * 64 * 2;
constexpr size_t R_SM = R_NKV + 6 * NKV_SEG;
constexpr size_t R_CUM = R_SM + (size_t)MC * 32 * 4;
constexpr size_t R_GG = R_CUM + (size_t)BC * 4 * 4096 * 4;
constexpr size_t R_KCMP = R_GG + (size_t)BC * 4 * 64 * 4 + 768;
constexpr size_t R_H1 = R_KCMP + (size_t)2 * BC * 256 * 64 * 2;
constexpr size_t R_O = R_H1 + (size_t)2 * BC * 256 * 256 * 2;
constexpr size_t R_Y = R_O + (size_t)4 * MC * 256 * 2;
constexpr size_t R_KVT = R_Y + (size_t)MC * 1024 * 2;
constexpr size_t R_MIX_END = R_KVT + (size_t)BC * 4 * 32 * 4096 * 4;
static_assert(R_NKV >= (size_t)MC * 4096 * 2, "P overlay fits under PROJ+GDN");
constexpr size_t R_LIST = 0;
constexpr size_t R_CW = R_LIST + (size_t)16 * MTOK * 4;
constexpr size_t R_HID = R_CW + (size_t)16 * MTOK * 4;
constexpr size_t R_OUT2 = R_HID + (size_t)(2 * MTOK + 4096) * 512 * 2;
constexpr size_t R_MOE_END = R_OUT2 + (size_t)2 * MTOK * 1024 * 2;
constexpr size_t WS_T = WS_R + (((R_MIX_END > R_MOE_END ? R_MIX_END : R_MOE_END) + MiB - 1) / MiB) * MiB;
constexpr size_t WS_END = WS_T + (size_t)MTOK * 1024 * 2;

constexpr int CW_BAR = 4096;
constexpr int CW_CNT = 8192;
constexpr int CW_Q = 8448;
constexpr int CW_G = 65536;

__device__ __forceinline__ float bf2f(bf16_t v) { return __uint_as_float(((unsigned)v) << 16); }
__device__ __forceinline__ unsigned pk2(float lo, float hi) { f32x2 v = {lo, hi}; bf16x2_t b = __builtin_convertvector(v, bf16x2_t); return __builtin_bit_cast(unsigned, b); }
__device__ __forceinline__ bf16_t f2bf(float f) { return (bf16_t)(pk2(f, 0.f) & 0xffffu); }
__device__ __forceinline__ float ex2(float x) { return __builtin_amdgcn_exp2f(x); }
__device__ __forceinline__ float sigmoidf_(float x) { return __builtin_amdgcn_rcpf(1.0f + __expf(-x)); }
__device__ __forceinline__ float siluf_(float x) { return x * __builtin_amdgcn_rcpf(1.0f + __expf(-x)); }
__device__ __forceinline__ int crow(int r, int hi) { return (r & 3) + 8 * (r >> 2) + 4 * hi; }
template <int M> __device__ __forceinline__ float swz_xor(float v) { return __builtin_bit_cast(float, __builtin_amdgcn_ds_swizzle(__builtin_bit_cast(int, v), 0x1f | (M << 10))); }
template <int M> __device__ __forceinline__ unsigned swz_xor_u(unsigned v) { return (unsigned)__builtin_amdgcn_ds_swizzle((int)v, 0x1f | (M << 10)); }
__device__ __forceinline__ float x32_sum(float v) { auto r = __builtin_amdgcn_permlane32_swap(__float_as_uint(v), __float_as_uint(v), false, false); return __uint_as_float(r[0]) + __uint_as_float(r[1]); }
__device__ __forceinline__ float x32_max(float v) { auto r = __builtin_amdgcn_permlane32_swap(__float_as_uint(v), __float_as_uint(v), false, false); return fmaxf(__uint_as_float(r[0]), __uint_as_float(r[1])); }
__device__ __forceinline__ unsigned x32_or(unsigned v) { auto r = __builtin_amdgcn_permlane32_swap(v, v, false, false); return r[0] | r[1]; }
__device__ __forceinline__ float shfl_up_l(float v, int o, int lane) { return __builtin_bit_cast(float, __builtin_amdgcn_ds_bpermute((lane - o) << 2, __builtin_bit_cast(int, v))); }
__device__ __forceinline__ float wave_sum(float v) {
    v += swz_xor<1>(v); v += swz_xor<2>(v); v += swz_xor<4>(v); v += swz_xor<8>(v); v += swz_xor<16>(v);
    return x32_sum(v);
}
__device__ __forceinline__ float ninf_() { float z = -INFINITY; asm volatile("" : "+v"(z)); return z; }
__device__ __forceinline__ f32x16 z16() { float z = 0.f; asm volatile("" : "+v"(z)); f32x16 r;
#pragma unroll
    for (int i = 0; i < 16; ++i) r[i] = z;
    return r; }
#define VM_WAIT() asm volatile("s_waitcnt vmcnt(0)" ::: "memory")
#define MF32(a, b, c) __builtin_amdgcn_mfma_f32_32x32x16_bf16(a, b, c, 0, 0, 0)

#define XB_TMO      128
#define XB_XCNT(j)  (256  + 64 * (j))
#define XB_XSUB(j)  (1280 + 64 * (j))
#define XB_XGEN(j)  (2304 + 64 * (j))
#define XB_TOP      3328
#define XB_TOPGEN   3392
#define XCD_BAR_WORDS 3456
#define XB_SPIN_CAP (1u << 22)

__device__ __forceinline__ unsigned xb_ld(unsigned* p)              { return __hip_atomic_load(p, __ATOMIC_RELAXED, __HIP_MEMORY_SCOPE_AGENT); }
__device__ __forceinline__ unsigned xb_add(unsigned* p, unsigned v) { return __hip_atomic_fetch_add(p, v, __ATOMIC_RELAXED, __HIP_MEMORY_SCOPE_AGENT); }
__device__ __forceinline__ unsigned xb_xcc_id() { return (unsigned)__builtin_amdgcn_s_getreg((3 << 11) | 20) & 0xFu; }
#define XB_SPIN(cond, bar) do { unsigned _sp = 0; while (cond) { __builtin_amdgcn_s_sleep(1); \
    if ((++_sp & 255u) == 0u) { if (xb_ld(&(bar)[XB_TMO])) break; if (_sp > XB_SPIN_CAP) { atomicAdd(&(bar)[XB_TMO], 1u); break; } } } } while (0)

struct XcdBarrier { unsigned* bar; unsigned x; volatile LAS unsigned* st; };

__device__ __forceinline__ XcdBarrier xcd_barrier_post(unsigned* bar, volatile LAS unsigned* st, int tid) {
    XcdBarrier b; b.bar = bar; b.x = xb_xcc_id(); b.st = st;
    if (tid == 0) (void)xb_add(&bar[XB_XCNT(b.x)], 1u);
    return b;
}
__device__ __forceinline__ void xcd_barrier_complete(unsigned* bar, unsigned x, unsigned& nloc, unsigned& nx) {
    const unsigned G = NWG;
    unsigned sum, cnt, mine, sp = 0u;
    for (;;) {
        sum = 0u; cnt = 0u; mine = 0u;
#pragma unroll
        for (unsigned j = 0; j < 16; ++j) { const unsigned c = xb_ld(&bar[XB_XCNT(j)]); sum += c; cnt += (c > 0u) ? 1u : 0u; mine = (j == x) ? c : mine; }
        if (sum == G) break;
        __builtin_amdgcn_s_sleep(1);
        if ((++sp & 255u) == 0u) { if (xb_ld(&bar[XB_TMO])) break; if (sp > XB_SPIN_CAP) { atomicAdd(&bar[XB_TMO], 1u); break; } }
    }
    nloc = mine > 0u ? mine : 1u; nx = cnt > 0u ? cnt : 1u;
}
__device__ __forceinline__ void xcd_barrier(const XcdBarrier& b, int tid) {
    asm volatile("s_waitcnt vmcnt(0)" ::: "memory");
    __syncthreads();
    if (tid == 0) {
        unsigned* bar = b.bar;
        __builtin_amdgcn_s_waitcnt(0);
        unsigned nloc = b.st[0], nx = b.st[1];
        if (nloc == 0u) { xcd_barrier_complete(bar, b.x, nloc, nx); b.st[0] = nloc; b.st[1] = nx; }
        const unsigned old = xb_add(&bar[XB_XSUB(b.x)], 1u);
        const unsigned gen = old / nloc;
        if (old + 1u == (gen + 1u) * nloc) {
            __builtin_amdgcn_fence(__ATOMIC_RELEASE, "agent");
            asm volatile("s_waitcnt vmcnt(0)" ::: "memory");
            const unsigned og = xb_add(&bar[XB_TOP], 1u);
            const unsigned tg = og / nx;
            if (og + 1u == (tg + 1u) * nx) xb_add(&bar[XB_TOPGEN], 1u);
            else XB_SPIN(xb_ld(&bar[XB_TOPGEN]) == tg, bar);
            __builtin_amdgcn_fence(__ATOMIC_ACQUIRE, "agent");
            xb_add(&bar[XB_XGEN(b.x)], 1u);
            asm volatile("s_waitcnt vmcnt(0)" ::: "memory");
        } else {
            XB_SPIN(xb_ld(&bar[XB_XGEN(b.x)]) == gen, bar);
            __builtin_amdgcn_fence(__ATOMIC_ACQUIRE, "agent");
            asm volatile("s_waitcnt vmcnt(0)" ::: "memory");
        }
    }
    __syncthreads();
}

struct Params {
    const float* in[27];
    float* out;
    unsigned char* ws;
    int ph_lo, ph_hi;
};
__device__ __forceinline__ LAS unsigned char* lds_at(int off) { asm volatile("" : "+s"(off)); return (LAS unsigned char*)(unsigned)off; }
constexpr int LDS_PTAB = LDS_BYTES - 512;
__device__ __forceinline__ void ptab_store(const Params& p, int tid) {
    LAS unsigned long long* t = (LAS unsigned long long*)lds_at(LDS_PTAB);
    if (tid == 0) {
#pragma unroll
        for (int i = 0; i < 27; ++i) t[i] = (unsigned long long)p.in[i];
        t[27] = (unsigned long long)p.out; t[28] = (unsigned long long)p.ws; }
}
__device__ __forceinline__ unsigned long long ptab_get(int i) {
    const LAS unsigned* t = (const LAS unsigned*)lds_at(LDS_PTAB) + 2 * i;
    const unsigned lo = __builtin_amdgcn_readfirstlane(t[0]), hi = __builtin_amdgcn_readfirstlane(t[1]);
    return ((unsigned long long)hi << 32) | lo;
}
__device__ __forceinline__ unsigned char* ws_late() { return (unsigned char*)ptab_get(28); }
#define PIN(i) ((const float*)ptab_get(i))
__device__ __forceinline__ void ptab_load(Params& q) {
    asm volatile("" ::: "memory");
#pragma unroll
    for (int i = 0; i < 27; ++i) q.in[i] = (const float*)ptab_get(i);
    q.out = (float*)ptab_get(27); q.ws = (unsigned char*)ptab_get(28); q.ph_lo = 0; q.ph_hi = 0;
}

namespace pg8 {
constexpr int BM = 256, BK = 64, HALF = 128, HTB = HALF * BK * 2, NXCD = 8, WGM = 8;
__device__ __forceinline__ int lds_byte(int r, int c) { const int st = (r >> 4) * 2 + (c >> 5), rr = r & 15, cc = c & 31, ob = rr * 64 + cc * 2; return st * 1024 + (ob ^ (((ob >> 9) & 1) << 5)); }
__device__ __forceinline__ void stage_rc(int b, int& R, int& C) { const int st = b / 1024, sb = b % 1024, swz = sb ^ (((sb >> 9) & 1) << 5); R = (st >> 1) * 16 + swz / 64; C = (st & 1) * 32 + (swz % 64) / 2; }
__device__ __forceinline__ int perm32(int rho) { const int n = rho >> 4, i = rho & 15; return 8 * (i >> 2) + 4 * n + (i & 3); }

struct Unit { unsigned a, b, rows; int pm, pn, aux, nvalid; };

__device__ __forceinline__ bool dense_unit(int i, int G, int c, int nM, int nN, int& pm, int& pn) {
    const int nwg = nM * nN; const long L = (long)i * G + c; if (L >= nwg) return false;
    int wgid = (int)L; { const int q = nwg / NXCD, r = nwg % NXCD, xcd = wgid % NXCD, off = wgid / NXCD; wgid = (xcd < r ? xcd * (q + 1) : r * (q + 1) + (xcd - r) * q) + off; }
    const int nig = WGM * nN, gid = wgid / nig, fm = gid * WGM, gsz = (nM - fm) < WGM ? (nM - fm) : WGM;
    pm = fm + ((wgid % nig) % gsz); pn = (wgid % nig) / gsz; return true;
}

template <class Epi, class Sched, bool ALIGN_EPI, bool GATHER>
__device__ __forceinline__ void gemm_phase(LAS unsigned char* lds, const int K, const int lda, const int ldb, const Sched& S, const Epi& E, const int tid, const char* wsb) {
    const int wid = __builtin_amdgcn_readfirstlane(tid >> 6), lane = tid & 63, wr = wid >> 2, wc = wid & 3, fr = lane & 15, fq = lane >> 4;
    const int nt = K / BK;
    unsigned voffA[2], voffB[2]; int rA[2], cA2[2];
#pragma unroll
    for (int i = 0; i < 2; ++i) { int R, C; stage_rc(tid * 16 + i * 8192, R, C); const int Rb = Epi::PERM ? ((R & ~31) + perm32(R & 31)) : R;
        rA[i] = R; cA2[i] = C * 2; voffA[i] = (unsigned)(R * lda + C) * 2u; voffB[i] = (unsigned)(Rb * ldb + C) * 2u; }
    const unsigned kstep = (unsigned)(BK * 2);
    const unsigned hstepA = GATHER ? 0u : (unsigned)(HALF * lda * 2), hstepB = (unsigned)(HALF * ldb * 2);
    const unsigned ldsw = (unsigned)wid * 1024u;
    const int aoff = lds_byte(wr * 64 + fr, fq * 8), boff = lds_byte(wc * 32 + fr, fq * 8);
#define PG8_SA(b, h) (((b) * 2 + (h)) * HTB)
#define PG8_SB(b, h) ((4 + (b) * 2 + (h)) * HTB)
#define PG8_STAGE(bufoff, gbase, voff) do { _Pragma("unroll") for (int _i = 0; _i < 2; ++_i) \
        __builtin_amdgcn_global_load_lds((const unsigned*)(wsb + (size_t)(unsigned)((gbase) + (voff)[_i])), (LAS unsigned*)(lds + (bufoff) + ldsw + _i * 8192), 16, 0, 0); } while (0)
#define PG8_LDA(dst, b, h) do { _Pragma("unroll") for (int m = 0; m < 4; ++m) _Pragma("unroll") for (int k = 0; k < 2; ++k) dst[m][k] = *(const LAS bf16x8*)(lds + PG8_SA(b, h) + aoff + m * 2048 + k * 1024); } while (0)
#define PG8_LDB(dst, b, h) do { _Pragma("unroll") for (int n = 0; n < 2; ++n) _Pragma("unroll") for (int k = 0; k < 2; ++k) dst[n][k] = *(const LAS bf16x8*)(lds + PG8_SB(b, h) + boff + n * 2048 + k * 1024); } while (0)
#define PG8_MMA(ai, bj, At, Bt) do { __builtin_amdgcn_s_setprio(1); _Pragma("unroll") for (int m = 0; m < 4; ++m) _Pragma("unroll") for (int n = 0; n < 2; ++n) _Pragma("unroll") for (int k = 0; k < 2; ++k) \
        acc[ai][bj][m][n] = __builtin_amdgcn_mfma_f32_16x16x32_bf16(Bt[n][k], At[m][k], acc[ai][bj][m][n], 0, 0, 0); __builtin_amdgcn_s_setprio(0); } while (0)
#define PG8_WAIT_V(n) asm volatile("s_waitcnt vmcnt(" #n ")" ::: "memory")
#define PG8_WAIT_L(n) asm volatile("s_waitcnt lgkmcnt(" #n ")" ::: "memory")
#define PG8_BAR __builtin_amdgcn_s_barrier()
#define PG8_SCHED __builtin_amdgcn_sched_barrier(0)
    Unit cur, nxt; int ui = 0;
    S.begin(tid);
    if (!S.next(0, cur)) return;
    f32x4 acc[2][2][4][2];
#pragma unroll
    for (int a = 0; a < 2; ++a)
#pragma unroll
        for (int b = 0; b < 2; ++b)
#pragma unroll
            for (int m = 0; m < 4; ++m)
#pragma unroll
                for (int n = 0; n < 2; ++n) acc[a][b][m][n] = (f32x4){0.f, 0.f, 0.f, 0.f};
    bf16x8 At[4][2], B0[2][2], B1[2][2];
    unsigned cA = cur.a, cB = cur.b;
    LAS unsigned* grec = (LAS unsigned*)(lds + 131072) + tid * 8;
    if constexpr (GATHER) {
#pragma unroll
        for (int i = 0; i < 2; ++i) { const unsigned o0 = (unsigned)S.row(cur, rA[i]) * (unsigned)(lda * 2) + cA2[i], o1 = (unsigned)S.row(cur, HALF + rA[i]) * (unsigned)(lda * 2) + cA2[i];
            grec[i] = o0; grec[2 + i] = o1; grec[4 + i] = o0; grec[6 + i] = o1; }
    }
#define PG8_STAGE_A(bufoff, kptr, h, usenext) do { if constexpr (GATHER) { const u32x2 _w = *(const LAS u32x2*)(grec + ((usenext) ? 4 : 0) + 2 * (h)); unsigned _v[2]; _v[0] = _w.x; _v[1] = _w.y; PG8_STAGE(bufoff, kptr, _v); } \
        else { PG8_STAGE(bufoff, (kptr) + (h) * hstepA, voffA); } } while (0)
    PG8_STAGE(PG8_SB(0, 0), cB, voffB); PG8_STAGE(PG8_SB(0, 1), cB + hstepB, voffB); PG8_STAGE_A(PG8_SA(0, 0), cA, 0, false); PG8_STAGE_A(PG8_SA(0, 1), cA, 1, false);
    if (wr == 1) PG8_BAR;
    PG8_WAIT_V(2); PG8_BAR;
    PG8_STAGE(PG8_SB(1, 0), cB + kstep, voffB); PG8_STAGE_A(PG8_SA(1, 0), cA + kstep, 0, false); PG8_STAGE(PG8_SB(1, 1), cB + hstepB + kstep, voffB);
    PG8_WAIT_V(6); PG8_BAR;
    for (;;) {
        const bool has_next = S.next(ui + 1, nxt);
        const int tk_ = S.issue(tid, has_next);
        const unsigned nA = has_next ? nxt.a : cA, nB = has_next ? nxt.b : cB;
        for (int t = 0; t < nt; t += 2) {
            const bool last = (t == nt - 2);
            const unsigned a1 = cA + (unsigned)(t + 1) * kstep;
            const unsigned a2 = last ? nA : cA + (unsigned)(t + 2) * kstep, b2 = last ? nB : cB + (unsigned)(t + 2) * kstep;
            const unsigned a3 = a2 + kstep, b3 = b2 + kstep;
            if constexpr (GATHER) { if (last && has_next) {
#pragma unroll
                for (int i = 0; i < 2; ++i) { grec[4 + i] = (unsigned)S.row(nxt, rA[i]) * (unsigned)(lda * 2) + cA2[i]; grec[6 + i] = (unsigned)S.row(nxt, HALF + rA[i]) * (unsigned)(lda * 2) + cA2[i]; } } }
            PG8_LDB(B0, 0, 0); PG8_LDB(B1, 0, 1); PG8_SCHED; PG8_LDA(At, 0, 0); PG8_STAGE_A(PG8_SA(1, 1), a1, 1, false);
            PG8_WAIT_V(8); PG8_WAIT_L(0); PG8_BAR; PG8_MMA(0, 0, At, B0); PG8_MMA(0, 1, At, B1); PG8_BAR; PG8_SCHED;
            PG8_LDA(At, 0, 1); PG8_STAGE(PG8_SB(0, 0), b2, voffB); PG8_STAGE(PG8_SB(0, 1), b2 + hstepB, voffB); PG8_STAGE_A(PG8_SA(0, 0), a2, 0, last);
            PG8_WAIT_V(8); PG8_WAIT_L(0); PG8_BAR; PG8_MMA(1, 0, At, B0); PG8_MMA(1, 1, At, B1); PG8_BAR; PG8_SCHED;
            PG8_LDB(B0, 1, 0); PG8_LDB(B1, 1, 1); PG8_SCHED; PG8_LDA(At, 1, 0); PG8_STAGE_A(PG8_SA(0, 1), a2, 1, last);
            PG8_WAIT_V(8); PG8_WAIT_L(0); PG8_BAR; PG8_MMA(0, 0, At, B0); PG8_MMA(0, 1, At, B1); PG8_BAR; PG8_SCHED;
            PG8_LDA(At, 1, 1); PG8_STAGE(PG8_SB(1, 0), b3, voffB); PG8_STAGE(PG8_SB(1, 1), b3 + hstepB, voffB); PG8_STAGE_A(PG8_SA(1, 0), a3, 0, last);
            PG8_WAIT_V(8); PG8_WAIT_L(0); PG8_BAR; PG8_MMA(1, 0, At, B0); PG8_MMA(1, 1, At, B1); PG8_BAR; PG8_SCHED;
        }
        S.commit(tid, ui, tk_);
        if constexpr (ALIGN_EPI) { if (wr == 0) PG8_BAR; }
        { int tz = tid; asm volatile("" : "+v"(tz)); const int ew = __builtin_amdgcn_readfirstlane(tz >> 6), el = tz & 63;
          E(acc, cur, ew >> 2, ew & 3, el & 15, el >> 4); }
        if (!has_next) break;
#pragma unroll
        for (int a = 0; a < 2; ++a)
#pragma unroll
            for (int b = 0; b < 2; ++b)
#pragma unroll
                for (int m = 0; m < 4; ++m)
#pragma unroll
                    for (int n = 0; n < 2; ++n) acc[a][b][m][n] = (f32x4){0.f, 0.f, 0.f, 0.f};
        cur = nxt; cA = nA; cB = nB; ++ui;
        if constexpr (GATHER) { const u32x4 _n = *(const LAS u32x4*)(grec + 4); *(LAS u32x4*)grec = _n; }
        if constexpr (ALIGN_EPI) { if (wr == 1) PG8_BAR; }
    }
    PG8_WAIT_V(0);
    if constexpr (!ALIGN_EPI) { if (wr == 0) PG8_BAR; }
    PG8_BAR;
#undef PG8_SA
#undef PG8_SB
#undef PG8_STAGE
#undef PG8_STAGE_A
#undef PG8_LDA
#undef PG8_LDB
#undef PG8_MMA
#undef PG8_WAIT_V
#undef PG8_WAIT_L
#undef PG8_BAR
#undef PG8_SCHED
}
}
using pg8::Unit;

constexpr int LDS_TICK = 147456;
struct DenseSched {
    unsigned A, Bt, tA, tB, aBr; int nM, nN, G, c, pnShift; unsigned* ctr;
    __device__ __forceinline__ void begin(int tid) const { volatile LAS int* tk = (volatile LAS int*)lds_at(LDS_TICK);
        __syncthreads();
        if (tid == 0) { const int t0 = (int)__hip_atomic_fetch_add(ctr, 1u, __ATOMIC_RELAXED, __HIP_MEMORY_SCOPE_AGENT), t1 = (int)__hip_atomic_fetch_add(ctr, 1u, __ATOMIC_RELAXED, __HIP_MEMORY_SCOPE_AGENT); tk[0] = t0; tk[1] = t1; }
        __syncthreads(); }
    __device__ __forceinline__ int issue(int tid, bool more) const { int t = 0x3fffffff; if (tid == 0 && more) t = (int)__hip_atomic_fetch_add(ctr, 1u, __ATOMIC_RELAXED, __HIP_MEMORY_SCOPE_AGENT); return t; }
    __device__ __forceinline__ void commit(int tid, int ui, int t) const { if (tid == 0) { volatile LAS int* tk = (volatile LAS int*)lds_at(LDS_TICK); tk[ui & 1] = t; asm volatile("s_waitcnt vmcnt(0) lgkmcnt(0)" ::: "memory"); } }
    __device__ __forceinline__ bool next(int i, Unit& u) const {
        const int L = __builtin_amdgcn_readfirstlane(((volatile LAS int*)lds_at(LDS_TICK))[i & 1]);
        int pm, pn; if (L < 0 || L >= nM * nN || !pg8::dense_unit(0, 1, L, nM, nN, pm, pn)) return false;
        u.pm = pm; u.pn = pn; u.aux = 0; u.nvalid = 256; u.rows = 0u;
        u.a = A + (unsigned)(pn >> pnShift) * aBr + (unsigned)pm * tA; u.b = Bt + (unsigned)pn * tB; return true;
    }
    __device__ __forceinline__ int row(const Unit&, int) const { return 0; }
};
struct OneSched {
    Unit u0; bool has;
    __device__ __forceinline__ void begin(int) const {}
    __device__ __forceinline__ int issue(int, bool) const { return 0; }
    __device__ __forceinline__ void commit(int, int, int) const {}
    __device__ __forceinline__ bool next(int i, Unit& u) const { if (i > 0 || !has) return false; u = u0; return true; }
    __device__ __forceinline__ int row(const Unit&, int) const { return 0; }
};
struct MoeSched {
    const LAS int* pre;
    const LAS int* cnt;
    const char* wsb;
    unsigned A, W, wE, wT, aT; int G, c; bool gatherA; unsigned* ctr;
    __device__ __forceinline__ void begin(int tid) const { volatile LAS int* tk = (volatile LAS int*)lds_at(LDS_TICK);
        __syncthreads();
        if (tid == 0) { const int t0 = (int)__hip_atomic_fetch_add(ctr, 1u, __ATOMIC_RELAXED, __HIP_MEMORY_SCOPE_AGENT), t1 = (int)__hip_atomic_fetch_add(ctr, 1u, __ATOMIC_RELAXED, __HIP_MEMORY_SCOPE_AGENT); tk[0] = t0; tk[1] = t1; }
        __syncthreads(); }
    __device__ __forceinline__ int issue(int tid, bool more) const { int t = 0x3fffffff; if (tid == 0 && more) t = (int)__hip_atomic_fetch_add(ctr, 1u, __ATOMIC_RELAXED, __HIP_MEMORY_SCOPE_AGENT); return t; }
    __device__ __forceinline__ void commit(int tid, int ui, int t) const { if (tid == 0) { volatile LAS int* tk = (volatile LAS int*)lds_at(LDS_TICK); tk[ui & 1] = t; asm volatile("s_waitcnt vmcnt(0) lgkmcnt(0)" ::: "memory"); } }
    __device__ __forceinline__ bool next(int i, Unit& u) const {
        const int L = __builtin_amdgcn_readfirstlane(((volatile LAS int*)lds_at(LDS_TICK))[i & 1]); const int total = pre[16] * 4; if (L < 0 || L >= total) return false;
        const int t = (int)(L >> 2), pn = (int)(L & 3); int e = 0;
#pragma unroll
        for (int j = 1; j < 16; ++j) e += (pre[j] <= t) ? 1 : 0;
        const int pm = t - pre[e];
        u.aux = e; u.pm = t; u.pn = pn; u.nvalid = min(256, cnt[e] - 256 * pm); u.rows = (unsigned)(WS_R + R_LIST) + (unsigned)(e * MTOK + 256 * pm) * 4u;
        u.a = gatherA ? A : A + (unsigned)t * aT; u.b = W + (unsigned)e * wE + (unsigned)pn * wT; return true;
    }
    __device__ __forceinline__ int row(const Unit& u, int R) const { return (R < u.nvalid) ? (((const int*)(wsb + u.rows))[R] >> 1) : 0; }
};

typedef f32x4 Acc[2][2][4][2];
#define EPI_LOOP_AIM _Pragma("unroll") for (int ai = 0; ai < 2; ++ai) _Pragma("unroll") for (int m = 0; m < 4; ++m)
__device__ __forceinline__ u32x4 pack8(const f32x4& a, const f32x4& b) { u32x4 w; w.x = pk2(a[0], a[1]); w.y = pk2(a[2], a[3]); w.z = pk2(b[0], b[1]); w.w = pk2(b[2], b[3]); return w; }

struct EpiProj {
    static constexpr bool PERM = true;
    __device__ __forceinline__ void operator()(const Acc& acc, const Unit& u, int wr, int wc, int fr, int fq) const {
        unsigned char* ws = ws_late(); bf16_t* proj = (bf16_t*)(ws + WS_R + R_PROJ); bf16_t* nkv = (bf16_t*)(ws + WS_R + R_NKV); float* sm = (float*)(ws + WS_R + R_SM);
        const int row0 = u.pm * 256 + wr * 64 + fr;
        if (u.pn < 12) {
            const float sc = (u.pn == 8 || u.pn == 9) ? QSCALE : (u.pn == 5 ? 0.125f : 1.0f);
            const int col0 = u.pn * 256 + wc * 32 + 8 * fq;
            EPI_LOOP_AIM { bf16_t* rp = proj + (size_t)(row0 + ai * 128 + m * 16) * PROJW + col0;
#pragma unroll
                for (int bj = 0; bj < 2; ++bj) *(u32x4*)(rp + bj * 128) = pack8(acc[ai][bj][m][0] * sc, acc[ai][bj][m][1] * sc); }
        } else {
#pragma unroll
            for (int bj = 0; bj < 2; ++bj) {
                if (u.pn == 12 || bj == 0) {
                    const int seg = (u.pn - 12) * 4 + bj * 2 + (wc >> 1), col = 32 * (wc & 1) + 8 * fq;
                    bf16_t* base = nkv + (size_t)seg * (NKV_SEG / 2) + col;
                    EPI_LOOP_AIM { *(u32x4*)(base + (size_t)(row0 + ai * 128 + m * 16) * 64) = pack8(acc[ai][bj][m][0], acc[ai][bj][m][1]); }
                } else if (wc == 0 && fq < 3) {
                    EPI_LOOP_AIM { float* sp = sm + (size_t)(row0 + ai * 128 + m * 16) * 32 + 8 * fq; *(f32x4*)sp = acc[ai][bj][m][0]; *(f32x4*)(sp + 4) = acc[ai][bj][m][1]; }
                }
            }
        }
    }
};
struct EpiH1 {
    static constexpr bool PERM = true;
    bf16_t* h1; const float* cbias;
    __device__ __forceinline__ void operator()(const Acc& acc, const Unit& u, int wr, int wc, int fr, int fq) const {
        const int which = u.aux, rl0 = wr * 64 + fr;
        bf16_t* base = h1 + ((size_t)which * BC * 256 + (size_t)u.pm * 256) * 256;
        const float* bp = cbias + which * 256;
#pragma unroll
        for (int bj = 0; bj < 2; ++bj) { const int col = bj * 128 + wc * 32 + 8 * fq; const f32x4 b0 = *(const f32x4*)(bp + col), b1 = *(const f32x4*)(bp + col + 4);
            EPI_LOOP_AIM { const int rl = rl0 + ai * 128 + m * 16; f32x4 v0 = acc[ai][bj][m][0] + b0, v1 = acc[ai][bj][m][1] + b1;
#pragma unroll
                for (int e = 0; e < 4; ++e) { v0[e] = (rl < 255) ? siluf_(v0[e]) : 0.f; v1[e] = (rl < 255) ? siluf_(v1[e]) : 0.f; }
                *(u32x4*)(base + (size_t)rl * 256 + col) = pack8(v0, v1); } }
    }
};
struct EpiCmp2 {
    static constexpr bool PERM = true;
    bf16_t* kc;
    __device__ __forceinline__ void operator()(const Acc& acc, const Unit& u, int wr, int wc, int fr, int fq) const {
        if (wc >= 2) return;
        const int col = wc * 32 + 8 * fq; bf16_t* base = kc + ((size_t)u.aux * BC + u.pm) * 256 * 64 + col;
        EPI_LOOP_AIM { const int rl = wr * 64 + fr + ai * 128 + m * 16; *(u32x4*)(base + (size_t)rl * 64) = pack8(acc[ai][0][m][0], acc[ai][0][m][1]); }
    }
};
struct EpiP {
    static constexpr bool PERM = true;
    __device__ __forceinline__ void operator()(const Acc& acc, const Unit& u, int wr, int wc, int fr, int fq) const {
        const int i = u.pn >> 2, pt = u.pn & 3, row0 = u.pm * 256 + wr * 64 + fr, col0 = 256 * pt + 32 * wc + 8 * fq;
        bf16_t* P = (bf16_t*)(ws_late() + WS_R + R_P) + (size_t)i * MC * 1024;
        EPI_LOOP_AIM { bf16_t* rp = P + (unsigned)((row0 + ai * 128 + m * 16) * 1024 + col0);
#pragma unroll
            for (int bj = 0; bj < 2; ++bj) *(u32x4*)(rp + bj * 128) = pack8(acc[ai][bj][m][0], acc[ai][bj][m][1]); }
    }
};
struct EpiGate {
    static constexpr bool PERM = true;
    __device__ __forceinline__ void operator()(const Acc& acc, const Unit& u, int wr, int wc, int fr, int fq) const {
        unsigned char* ws = ws_late(); const bf16_t* P = (const bf16_t*)(ws + WS_R + R_P); bf16_t* y = (bf16_t*)(ws + WS_R + R_Y);
        const int row0 = u.pm * 256 + wr * 64 + fr, oc = 64 * u.pn + 16 * wc + 4 * fq;
#pragma unroll
        for (int ai = 0; ai < 2; ++ai)
#pragma unroll
            for (int mh = 0; mh < 2; ++mh) {
                u32x2 pw[2][4];
#pragma unroll
                for (int mm = 0; mm < 2; ++mm) { const unsigned r = (unsigned)(row0 + ai * 128 + (2 * mh + mm) * 16);
#pragma unroll
                    for (int i = 0; i < 4; ++i) pw[mm][i] = *(const u32x2*)(P + ((size_t)i * MC * 1024 + r * 1024u + (unsigned)oc)); }
#pragma unroll
                for (int mm = 0; mm < 2; ++mm) { const int m = 2 * mh + mm; const unsigned r = (unsigned)(row0 + ai * 128 + m * 16);
                    f32x4 s = {0.f, 0.f, 0.f, 0.f};
#pragma unroll
                    for (int bj = 0; bj < 2; ++bj)
#pragma unroll
                        for (int n = 0; n < 2; ++n) { const u32x2 pq = pw[mm][2 * bj + n]; const f32x4 a = acc[ai][bj][m][n];
                            s[0] += sigmoidf_(a[0]) * __uint_as_float(pq.x << 16); s[1] += sigmoidf_(a[1]) * __uint_as_float(pq.x & 0xffff0000u);
                            s[2] += sigmoidf_(a[2]) * __uint_as_float(pq.y << 16); s[3] += sigmoidf_(a[3]) * __uint_as_float(pq.y & 0xffff0000u); }
                    u32x2 w; w.x = pk2(s[0], s[1]); w.y = pk2(s[2], s[3]); *(u32x2*)(y + (r * 1024u + (unsigned)oc)) = w; }
            }
    }
};
struct EpiOut {
    static constexpr bool PERM = true;
    int row_base;
    __device__ __forceinline__ void operator()(const Acc& acc, const Unit& u, int wr, int wc, int fr, int fq) const {
        bf16_t* T = (bf16_t*)(ws_late() + WS_T);
        const int rg0 = row_base + u.pm * 256 + wr * 64 + fr, col0 = u.pn * 256 + wc * 32 + 8 * fq;
        EPI_LOOP_AIM { bf16_t* rp = T + (size_t)(rg0 + ai * 128 + m * 16) * 1024 + col0;
#pragma unroll
            for (int bj = 0; bj < 2; ++bj) *(u32x4*)(rp + bj * 128) = pack8(acc[ai][bj][m][0], acc[ai][bj][m][1]); }
    }
};
struct EpiMoe1 {
    static constexpr bool PERM = true;
    __device__ __forceinline__ void operator()(const Acc& acc, const Unit& u, int wr, int wc, int fr, int fq) const {
        const int rl0 = wr * 64 + fr, f0 = 128 * u.pn + 32 * wc + 8 * fq;
        bf16_t* hid = (bf16_t*)(ws_late() + WS_R + R_HID);
        EPI_LOOP_AIM { const int rl = rl0 + ai * 128 + m * 16;
            f32x4 a0 = acc[ai][0][m][0], a1 = acc[ai][0][m][1]; const f32x4 b0 = acc[ai][1][m][0], b1 = acc[ai][1][m][1];
#pragma unroll
            for (int e = 0; e < 4; ++e) { a0[e] = siluf_(a0[e]) * b0[e]; a1[e] = siluf_(a1[e]) * b1[e]; }
            *(u32x4*)(hid + (unsigned)((u.pm * 256 + rl) * 512 + f0)) = pack8(a0, a1); __builtin_amdgcn_sched_barrier(0); }
    }
};
struct EpiMoe2 {
    static constexpr bool PERM = true;
    __device__ __forceinline__ void operator()(const Acc& acc, const Unit& u, int wr, int wc, int fr, int fq) const {
        unsigned char* ws = ws_late(); bf16_t* out2 = (bf16_t*)(ws + WS_R + R_OUT2);
        const float* cwb = (const float*)(ws + (R_CW - R_LIST) + u.rows); const int* rws = (const int*)(ws + u.rows);
        const int rl0 = wr * 64 + fr, c0 = 256 * u.pn + 32 * wc + 8 * fq;
        EPI_LOOP_AIM { const int rl = rl0 + ai * 128 + m * 16;
            if (rl < u.nvalid) { const unsigned v = (unsigned)rws[rl]; const float wgt = cwb[rl]; bf16_t* rp = out2 + (size_t)v * 1024 + c0;
#pragma unroll
                for (int bj = 0; bj < 2; ++bj) *(u32x4*)(rp + bj * 128) = pack8(acc[ai][bj][m][0] * wgt, acc[ai][bj][m][1] * wgt); } }
    }
};

enum { IN_X = 0, IN_C, IN_POS, IN_ADAW, IN_ADAB, IN_WIN, IN_CONVW, IN_ALOG, IN_DTB, IN_GNORM, IN_RETGN, IN_PE, IN_CKW1, IN_CKW2, IN_CVW1, IN_CVW2, IN_FBIAS,
       IN_BP, IN_WG, IN_WO, IN_LNG, IN_LNB, IN_RW, IN_RB, IN_EW1, IN_EW3, IN_EW2 };

__device__ __forceinline__ void p0_ada(const Params& p, int item, LAS float* lf, const int tid) {
    LAS float* sc = lf; LAS float* red = lf + 16384;
    const float* c = PIN(IN_C);
    for (int i = tid; i < 16384; i += NTHR) sc[i] = siluf_(c[i]);
    __syncthreads();
    const int ls = item / 48, cb = item % 48, col = cb * 64 + (tid & 63), ks = tid >> 6;
    const float* w = PIN(IN_ADAW) + (size_t)ls * 1024 * 3072 + col;
    float acc[16];
#pragma unroll
    for (int b = 0; b < 16; ++b) acc[b] = 0.f;
    for (int k0 = ks * 128; k0 < ks * 128 + 128; k0 += 16) { float wv[16];
#pragma unroll
        for (int kk = 0; kk < 16; ++kk) wv[kk] = w[(size_t)(k0 + kk) * 3072];
#pragma unroll
        for (int kk = 0; kk < 16; ++kk)
#pragma unroll
            for (int b = 0; b < 16; ++b) acc[b] += sc[b * 1024 + k0 + kk] * wv[kk]; }
#pragma unroll
    for (int b = 0; b < 16; ++b) red[(ks * 16 + b) * 64 + (tid & 63)] = acc[b];
    __syncthreads();
    float* mod = (float*)(p.ws + WS_MOD);
    for (int o = tid; o < 1024; o += NTHR) { const int b = o >> 6, cc = o & 63; float s = 0.f;
#pragma unroll
        for (int q = 0; q < 8; ++q) s += red[(q * 16 + b) * 64 + cc];
        mod[((size_t)ls * 16 + b) * 3072 + cb * 64 + cc] = s + PIN(IN_ADAB)[ls * 3072 + cb * 64 + cc]; }
    __syncthreads();
}
__device__ __forceinline__ void p0_rope(const Params& p, int item, const int tid) {
    const int* pos = (const int*)PIN(IN_POS); f32x2* tab = (f32x2*)(p.ws + WS_ROPE);
#pragma unroll
    for (int j = 0; j < 8; ++j) { const int idx = item * 4096 + j * 512 + tid; const int m = idx >> 5, i = idx & 31;
        const float inv = powf(10000.0f, -(float)i / 32.0f); const float ang = (float)pos[m] * inv;
        const float n = rintf(ang * 0.6366197723675814f);
        float r = fmaf(n, -1.5703125f, ang); r = fmaf(n, -4.837512969970703125e-4f, r); r = fmaf(n, -7.54978995489188e-8f, r);
        const float s = sinf(r), cs = cosf(r); const int q = ((int)n) & 3;
        float so, co; if (q == 0) { so = s; co = cs; } else if (q == 1) { so = cs; co = -s; } else if (q == 2) { so = -s; co = -cs; } else { so = -cs; co = s; }
        tab[idx] = (f32x2){co, so}; }
}
__device__ __forceinline__ void p0_cbias(const Params& p, int item, const int tid) {
    const int l = item >> 1, which = item & 1;
    if (tid < 256) { const float* pe = PIN(IN_PE) + (size_t)l * 2048; const float* w1 = PIN(which ? IN_CVW1 : IN_CKW1) + (size_t)l * 2048 * 256 + tid;
        float s = 0.f; for (int k = 0; k < 2048; ++k) s += pe[k] * w1[(size_t)k * 256];
        ((float*)(p.ws + WS_CBIAS))[item * 256 + tid] = s; }
}
struct TJob { bf16_t* dst; int K, nrt, nkt; };
constexpr int TJ_TILES[8] = {56 * 16, 64 * 16, 64 * 4, 16 * 16, 256 * 16, 256 * 8, 8 * 32, 8 * 4};
constexpr int TJ_TOTAL = 56 * 16 + 64 * 16 + 64 * 4 + 16 * 16 + 256 * 16 + 256 * 8 + 8 * 32 + 8 * 4;
__device__ __forceinline__ int win_src_col(int pc) {
    if (pc < 768) return pc;
    if (pc < 1024) return pc - 768 + 776;
    if (pc < 2048) return pc - 1024 + 1032;
    if (pc < 2304) return pc - 2048 + 2056;
    if (pc < 3072) return pc - 2304 + 2708;
    if (pc < 3456) return pc - 3072 + 2312;
    if (pc < 3464) return pc - 3456 + 768;
    if (pc < 3476) return pc - 3464 + 2696;
    if (pc < 3480) return pc - 3476 + 3476;
    return -1;
}
__device__ __forceinline__ const float* tj_src(const Params& p, int l, int job, int n, int& pitch) {
    switch (job) {
    case 0: { pitch = 3480; const int c = win_src_col(n); return c < 0 ? nullptr : PIN(IN_WIN) + (size_t)l * 1024 * 3480 + c; }
    case 1: { pitch = 1024; const int i = 2 * ((n >> 7) & 1) + ((n >> 2) & 1), c = 64 * (n >> 8) + 16 * ((n >> 5) & 3) + 4 * ((n >> 3) & 3) + (n & 3);
              return PIN(IN_WG) + ((size_t)l * 4 + i) * 1024 * 1024 + c; }
    case 2: { pitch = 1024; const int i = n >> 10, c = n & 1023; return PIN(IN_BP) + ((size_t)l * 4 + i) * 256 * 1024 + c; }
    case 3: { pitch = 1024; return PIN(IN_WO) + (size_t)l * 1024 * 1024 + n; }
    case 4: { pitch = 512; const int e = n >> 10, vr = n & 1023, f = 128 * (vr >> 8) + (vr & 127); return PIN(((vr >> 7) & 1) ? IN_EW3 : IN_EW1) + ((size_t)l * 16 + e) * 1024 * 512 + f; }
    case 5: { pitch = 1024; const int e = n >> 10, c = n & 1023; return PIN(IN_EW2) + ((size_t)l * 16 + e) * 512 * 1024 + c; }
    case 6: { pitch = 256; const int which = n >> 8, c = n & 255; return PIN(which ? IN_CVW1 : IN_CKW1) + (size_t)l * 2048 * 256 + c; }
    default: { pitch = 64; const int which = n >> 8, r = n & 255; return r < 64 ? PIN(which ? IN_CVW2 : IN_CKW2) + (size_t)l * 256 * 64 + r : nullptr; }
    }
}
struct TDesc { const float* src; bf16_t* dst; int pitch, K, rt, kt; };
__device__ __forceinline__ void tj_decode(const Params& p, int item, int tx, TDesc& d) {
    const int l = item / TJ_TOTAL; int t = item % TJ_TOTAL, job = 0;
#pragma unroll
    for (int j = 0; j < 8; ++j) { if (job == j && t >= TJ_TILES[j]) { t -= TJ_TILES[j]; job = j + 1; } }
    const size_t lw = WS_W + (size_t)l * ((LW_BYTES + MiB - 1) / MiB) * MiB;
    const size_t offs[8] = {LW_WIN, LW_WGV, LW_BPT, LW_WOT, LW_W13, LW_W2, LW_CW1, LW_CW2};
    const int Ks[8] = {1024, 1024, 256, 1024, 1024, 512, 2048, 256};
    size_t off = 0; int K = 0;
#pragma unroll
    for (int j = 0; j < 8; ++j) if (job == j) { off = offs[j]; K = Ks[j]; }
    d.dst = (bf16_t*)(p.ws + lw + off); d.K = K;
    const int nkt = K / 64; d.rt = t / nkt; d.kt = t % nkt;
    d.src = tj_src(p, l, job, d.rt * 64 + tx, d.pitch);
}
__device__ __forceinline__ void p0_transpose4(const Params& p, int it, int G, int end, LAS float* tiles, const int tid) {
    const int tx = tid & 63, ty = tid >> 6; float v[4][8]; TDesc d[4];
#pragma unroll
    for (int q = 0; q < 4; ++q) { const int item = it + q * G; if (item < end) { tj_decode(p, item, tx, d[q]);
#pragma unroll
            for (int kk = 0; kk < 8; ++kk) v[q][kk] = d[q].src ? d[q].src[(size_t)(d[q].kt * 64 + ty + 8 * kk) * d[q].pitch] : 0.f; } }
#pragma unroll
    for (int q = 0; q < 4; ++q) { if (it + q * G < end) {
#pragma unroll
            for (int kk = 0; kk < 8; ++kk) tiles[q * 4160 + (ty + 8 * kk) * 65 + tx] = v[q][kk]; } }
    __syncthreads();
    const int r = tid >> 3, sg = tid & 7;
#pragma unroll
    for (int q = 0; q < 4; ++q) { if (it + q * G < end) { f32x4 a, b;
#pragma unroll
            for (int j = 0; j < 4; ++j) { a[j] = tiles[q * 4160 + (sg * 8 + j) * 65 + r]; b[j] = tiles[q * 4160 + (sg * 8 + 4 + j) * 65 + r]; }
            *(u32x4*)(d[q].dst + (size_t)(d[q].rt * 64 + r) * d[q].K + d[q].kt * 64 + sg * 8) = pack8(a, b); } }
    __syncthreads();
}

struct RowV { f32x4 v[4]; };
__device__ __forceinline__ void row_load(RowV& r, const float* src, int lane) {
#pragma unroll
    for (int j = 0; j < 4; ++j) r.v[j] = *(const f32x4*)(src + 4 * lane + 256 * j);
}
__device__ __forceinline__ void row_stats(const RowV& r, float& mean, float& rstd) {
    float s = 0.f;
#pragma unroll
    for (int j = 0; j < 4; ++j) s += (r.v[j][0] + r.v[j][1]) + (r.v[j][2] + r.v[j][3]);
    mean = wave_sum(s) * (1.0f / 1024.0f);
    float q = 0.f;
#pragma unroll
    for (int j = 0; j < 4; ++j) { const f32x4 d = r.v[j] - mean; q += (d[0] * d[0] + d[1] * d[1]) + (d[2] * d[2] + d[3] * d[3]); }
    rstd = 1.0f / sqrtf(wave_sum(q) * (1.0f / 1024.0f) + LN_EPS);
}
__device__ __forceinline__ void row_ln(RowV& r, float mean, float rstd, const float* g, const float* b, int lane) {
#pragma unroll
    for (int j = 0; j < 4; ++j) { const f32x4 gg = *(const f32x4*)(g + 4 * lane + 256 * j), bb = *(const f32x4*)(b + 4 * lane + 256 * j); r.v[j] = (r.v[j] - mean) * rstd * gg + bb; }
}
__device__ __forceinline__ void row_mod(RowV& h, const RowV& x, const float* mod, int lane) {
#pragma unroll
    for (int j = 0; j < 4; ++j) { const f32x4 sh = *(const f32x4*)(mod + 4 * lane + 256 * j), sc = *(const f32x4*)(mod + 1024 + 4 * lane + 256 * j); h.v[j] = x.v[j] * (sc + 1.0f) + sh; }
}
__device__ __forceinline__ void row_store_bf16(const RowV& h, bf16_t* dst, int lane) {
#pragma unroll
    for (int j = 0; j < 4; ++j) { u32x2 w; w.x = pk2(h.v[j][0], h.v[j][1]); w.y = pk2(h.v[j][2], h.v[j][3]); *(u32x2*)(dst + 4 * lane + 256 * j) = w; }
}
__device__ __forceinline__ void prep_first(const Params& p, const int tid, const int blk) {
    const int lane = tid & 63, wv = tid >> 6; const float* x = p.in[IN_X]; bf16_t* H = (bf16_t*)(p.ws + WS_H); const float* mod = (const float*)(p.ws + WS_MOD);
    for (int row = blk * 8 + wv; row < MTOK; row += NWG * 8) {
        RowV r, h; row_load(r, x + (size_t)row * 1024, lane); row_mod(h, r, mod + (size_t)(row >> 12) * 3072, lane); row_store_bf16(h, H + (size_t)row * 1024, lane); }
}
__device__ __forceinline__ void row_load_t(u32x2 (&t)[4], const bf16_t* src, int lane) {
#pragma unroll
    for (int j = 0; j < 4; ++j) t[j] = *(const u32x2*)(src + 4 * lane + 256 * j);
}
__device__ __forceinline__ void prep_moe(const Params& p, int l, LAS float* rwl, const int tid, const int blk) {
    const int lane = tid & 63, wv = tid >> 6;
    { const float* rw = p.in[IN_RW]; for (int i = tid; i < 16384; i += NTHR) { const int c = i >> 4, e = i & 15, ln = (c & 255) >> 2, q = c & 3, j = c >> 8;
        rwl[((((j * 4 + q) * 4 + (e >> 2)) * 64 + ln) << 2) + (e & 3)] = rw[i]; } }
    __syncthreads();
    const float* xin = (l == 0) ? p.in[IN_X] : p.out; float* z = p.out; bf16_t* H = (bf16_t*)(p.ws + WS_H); const bf16_t* T = (const bf16_t*)(p.ws + WS_T);
    const float* modg = (const float*)(p.ws + WS_MOD) + (size_t)(l * 2) * 16 * 3072; const float* mod = (const float*)(p.ws + WS_MOD) + (size_t)(l * 2 + 1) * 16 * 3072;
    f32x2* stats = (f32x2*)(p.ws + WS_STATS); const float* g = p.in[IN_LNG] + (size_t)(l * 2) * 1024; const float* bb = p.in[IN_LNB] + (size_t)(l * 2) * 1024;
    const float* gp = p.in[IN_LNG] + (size_t)((l > 0 ? l - 1 : 0) * 2 + 1) * 1024; const float* bp = p.in[IN_LNB] + (size_t)((l > 0 ? l - 1 : 0) * 2 + 1) * 1024;
    unsigned* cnt = (unsigned*)(p.ws + WS_CTL) + CW_CNT + l * 64; int* list = (int*)(p.ws + WS_R + R_LIST); float* cw = (float*)(p.ws + WS_R + R_CW);
    const float* rb = p.in[IN_RB];
    LAS unsigned* lcnt = (LAS unsigned*)(rwl + 16384); LAS unsigned* lbase = lcnt + 16; LAS unsigned* lrec = lcnt + 32;
    if (tid < 16) lcnt[tid] = 0u;
    __syncthreads();
    int row = blk * 8 + wv, it_ = 0;
    RowV cur; u32x2 tc[4]; row_load(cur, xin + (size_t)row * 1024, lane); row_load_t(tc, T + (size_t)row * 1024, lane);
    for (; row < MTOK; row += NWG * 8) {
        const int nrow = row + NWG * 8; RowV nx; u32x2 tn[4];
        if (nrow < MTOK) { row_load(nx, xin + (size_t)nrow * 1024, lane); row_load_t(tn, T + (size_t)nrow * 1024, lane); }
        RowV r = cur, h;
        if (l > 0) { const f32x2 st = stats[row]; row_ln(r, st.x, st.y, gp, bp, lane); }
        { const float* gate = modg + (size_t)(row >> 12) * 3072 + 2048;
#pragma unroll
          for (int j = 0; j < 4; ++j) { const f32x4 gt = *(const f32x4*)(gate + 4 * lane + 256 * j);
              f32x4 y; y[0] = __uint_as_float(tc[j].x << 16); y[1] = __uint_as_float(tc[j].x & 0xffff0000u); y[2] = __uint_as_float(tc[j].y << 16); y[3] = __uint_as_float(tc[j].y & 0xffff0000u);
              r.v[j] = r.v[j] * DN_ALPHA + gt * y; *(f32x4*)(z + (size_t)row * 1024 + 4 * lane + 256 * j) = r.v[j]; } }
        float mean, rstd; row_stats(r, mean, rstd); if (lane == 0) stats[row] = (f32x2){mean, rstd};
        row_ln(r, mean, rstd, g, bb, lane); row_mod(h, r, mod + (size_t)(row >> 12) * 3072, lane); row_store_bf16(h, H + (size_t)row * 1024, lane);
        float a[16];
#pragma unroll
        for (int e = 0; e < 16; ++e) a[e] = 0.f;
#pragma unroll
        for (int j = 0; j < 4; ++j)
#pragma unroll
            for (int q = 0; q < 4; ++q) { const float hv = h.v[j][q]; const LAS float* wp = rwl + (((j * 4 + q) * 4) * 64 + lane) * 4;
                const f32x4 w0 = *(const LAS f32x4*)wp, w1 = *(const LAS f32x4*)(wp + 256), w2 = *(const LAS f32x4*)(wp + 512), w3 = *(const LAS f32x4*)(wp + 768);
#pragma unroll
                for (int e = 0; e < 4; ++e) { a[e] += hv * w0[e]; a[4 + e] += hv * w1[e]; a[8 + e] += hv * w2[e]; a[12 + e] += hv * w3[e]; }
                __builtin_amdgcn_sched_barrier(0); }
#pragma unroll
        for (int e = 0; e < 16; ++e) a[e] = wave_sum(a[e]);
        float sc[16], bi[16];
#pragma unroll
        for (int e = 0; e < 16; ++e) { sc[e] = sigmoidf_(a[e]); bi[e] = sc[e] + rb[e]; }
        int grp = 0; float best = -INFINITY;
#pragma unroll
        for (int gI = 0; gI < 4; ++gI) { float m1 = -INFINITY, m2 = -INFINITY;
#pragma unroll
            for (int q = 0; q < 4; ++q) { const float v = bi[4 * gI + q]; if (v > m1) { m2 = m1; m1 = v; } else if (v > m2) m2 = v; }
            const float gs = m1 + m2; if (gs > best) { best = gs; grp = gI; } }
        int e0 = 0, e1 = 0; float b0 = -INFINITY, b1 = -INFINITY, s0 = 0.f, s1 = 0.f;
#pragma unroll
        for (int gI = 0; gI < 4; ++gI)
#pragma unroll
            for (int q = 0; q < 4; ++q) { const int e = 4 * gI + q; if (gI == grp) { const float v = bi[e];
                if (v > b0) { b1 = b0; e1 = e0; s1 = s0; b0 = v; e0 = e; s0 = sc[e]; } else if (v > b1) { b1 = v; e1 = e; s1 = sc[e]; } } }
        const float inv = 1.0f / (s0 + s1);
        if (lane == 0) { const int li = wv * 32 + it_; const unsigned q0 = __hip_atomic_fetch_add(lcnt + e0, 1u, __ATOMIC_RELAXED, __HIP_MEMORY_SCOPE_WORKGROUP), q1 = __hip_atomic_fetch_add(lcnt + e1, 1u, __ATOMIC_RELAXED, __HIP_MEMORY_SCOPE_WORKGROUP);
                         lrec[li * 4 + 0] = (unsigned)e0 | (q0 << 8); lrec[li * 4 + 1] = (unsigned)e1 | (q1 << 8); lrec[li * 4 + 2] = __float_as_uint(s0 * inv); lrec[li * 4 + 3] = __float_as_uint(s1 * inv); }
        ++it_;
        cur = nx;
#pragma unroll
        for (int j = 0; j < 4; ++j) tc[j] = tn[j];
    }
    __syncthreads();
    if (tid < 16) lbase[tid] = atomicAdd(cnt + tid, lcnt[tid]);
    __syncthreads();
    if (tid < 256) { const int wv2 = tid >> 5, i2 = tid & 31, grow = blk * 8 + wv2 + i2 * (NWG * 8);
        const unsigned r0 = lrec[tid * 4 + 0], r1 = lrec[tid * 4 + 1]; const unsigned e0 = r0 & 255u, e1 = r1 & 255u;
        const size_t p0 = (size_t)e0 * MTOK + lbase[e0] + (r0 >> 8), p1 = (size_t)e1 * MTOK + lbase[e1] + (r1 >> 8);
        list[p0] = grow * 2; cw[p0] = __uint_as_float(lrec[tid * 4 + 2]); list[p1] = grow * 2 + 1; cw[p1] = __uint_as_float(lrec[tid * 4 + 3]); }
}
__device__ __forceinline__ void prep_next(const Params& p, int l, bool final_, const int tid, const int blk) {
    const int lane = tid & 63, wv = tid >> 6;
    float* z = p.out; bf16_t* H = (bf16_t*)(p.ws + WS_H); const float* modm = (const float*)(p.ws + WS_MOD) + (size_t)(l * 2 + 1) * 16 * 3072;
    const float* modn = (const float*)(p.ws + WS_MOD) + (size_t)((l + 1) * 2) * 16 * 3072;
    f32x2* stats = (f32x2*)(p.ws + WS_STATS);
    const float* g0 = p.in[IN_LNG] + (size_t)(l * 2) * 1024; const float* b0 = p.in[IN_LNB] + (size_t)(l * 2) * 1024;
    const float* g1 = p.in[IN_LNG] + (size_t)(l * 2 + 1) * 1024; const float* b1 = p.in[IN_LNB] + (size_t)(l * 2 + 1) * 1024;
    const bf16_t* out2 = (const bf16_t*)(p.ws + WS_R + R_OUT2);
    int row = blk * 8 + wv;
    RowV cur; u32x2 ta[4], tb[4]; row_load(cur, z + (size_t)row * 1024, lane); row_load_t(ta, out2 + (size_t)(row * 2) * 1024, lane); row_load_t(tb, out2 + (size_t)(row * 2 + 1) * 1024, lane);
    for (; row < MTOK; row += NWG * 8) {
        const int nrow = row + NWG * 8; RowV nx; u32x2 na[4], nb[4];
        if (nrow < MTOK) { row_load(nx, z + (size_t)nrow * 1024, lane); row_load_t(na, out2 + (size_t)(nrow * 2) * 1024, lane); row_load_t(nb, out2 + (size_t)(nrow * 2 + 1) * 1024, lane); }
        RowV r = cur;
        const f32x2 st = stats[row]; row_ln(r, st.x, st.y, g0, b0, lane);
        const float* gate = modm + (size_t)(row >> 12) * 3072 + 2048;
#pragma unroll
        for (int j = 0; j < 4; ++j) { const u32x2 oa = ta[j], ob = tb[j];
            const f32x4 gt = *(const f32x4*)(gate + 4 * lane + 256 * j);
            f32x4 y; y[0] = __uint_as_float(oa.x << 16) + __uint_as_float(ob.x << 16); y[1] = __uint_as_float(oa.x & 0xffff0000u) + __uint_as_float(ob.x & 0xffff0000u);
            y[2] = __uint_as_float(oa.y << 16) + __uint_as_float(ob.y << 16); y[3] = __uint_as_float(oa.y & 0xffff0000u) + __uint_as_float(ob.y & 0xffff0000u);
            r.v[j] = r.v[j] * DN_ALPHA + gt * y; }
        cur = nx;
#pragma unroll
        for (int j = 0; j < 4; ++j) { ta[j] = na[j]; tb[j] = nb[j]; }
        float mean, rstd; row_stats(r, mean, rstd);
        if (final_) { row_ln(r, mean, rstd, g1, b1, lane);
#pragma unroll
            for (int j = 0; j < 4; ++j) *(f32x4*)(z + (size_t)row * 1024 + 4 * lane + 256 * j) = r.v[j];
        } else {
#pragma unroll
            for (int j = 0; j < 4; ++j) *(f32x4*)(z + (size_t)row * 1024 + 4 * lane + 256 * j) = r.v[j];
            if (lane == 0) stats[row] = (f32x2){mean, rstd};
            RowV h; row_ln(r, mean, rstd, g1, b1, lane); row_mod(h, r, modn + (size_t)(row >> 12) * 3072, lane); row_store_bf16(h, H + (size_t)row * 1024, lane); }
    }
}

__device__ __forceinline__ int q_next(unsigned* ctr, volatile LAS int* slot, const int tid) {
    __syncthreads();
    if (tid == 0) *slot = (int)__hip_atomic_fetch_add(ctr, 1u, __ATOMIC_RELAXED, __HIP_MEMORY_SCOPE_AGENT);
    __syncthreads();
    return *slot;
}

struct GdnRaw { u32x4 v[4]; float a, bg; };
__device__ __forceinline__ void gdn_prep_load(GdnRaw& g, int unit, const int tid) {
    unsigned char* ws = ws_late(); const int n = unit & 63, h = (unit >> 6) & 3, bl = unit >> 8; const int tok0 = bl * SEQ + n * 64;
    const bf16_t* proj = (const bf16_t*)(ws + WS_R + R_PROJ); const float* sm = (const float*)(ws + WS_R + R_SM);
#pragma unroll
    for (int j = 0; j < 4; ++j) { const int idx = tid + j * NTHR; const int row = idx / 24, ch = idx % 24, seg = ch >> 3, c8 = ch & 7;
        u32x4 v = {0u, 0u, 0u, 0u};
        if (idx < 67 * 24 && (n > 0 || row >= 3)) v = *(const u32x4*)(proj + (size_t)(tok0 + row - 3) * PROJW + seg * 256 + h * 64 + c8 * 8);
        g.v[j] = v; }
    g.a = 0.f; g.bg = 0.f;
    if (tid < 64) { g.a = sm[(size_t)(tok0 + tid) * 32 + h]; g.bg = sm[(size_t)(tok0 + tid) * 32 + 4 + h]; }
}
__device__ __forceinline__ void gdn_prep_unit(const Params& p, int l, int unit, LAS unsigned char* lds, const int tid_in_, const GdnRaw& graw) {
    int tid = tid_in_; asm volatile("" : "+v"(tid)); unsigned char* wsl_ = ws_late();
    const int lane = tid & 63;
    const int n = unit & 63, h = (unit >> 6) & 3, bl = unit >> 8;
    const int tok0 = bl * SEQ + n * 64;
    const bf16_t* proj = (const bf16_t*)(wsl_ + WS_R + R_PROJ); const float* sm = (const float*)(wsl_ + WS_R + R_SM);
    LAS bf16_t* raw = (LAS bf16_t*)lds;
    LAS float* qs = (LAS float*)(lds + 26112); LAS float* ks = qs + 64 * 65; LAS float* vs = ks + 64 * 65;
    LAS float* Lm = vs + 64 * 65;
    LAS float* bc = Lm + 4096; LAS float* eb = bc + 64; LAS float* be = eb + 64; LAS float* cwt = be + 64;
    __syncthreads();
#pragma unroll
    for (int j = 0; j < 4; ++j) { const int idx = tid + j * NTHR; const int row = idx / 24, ch = idx % 24, seg = ch >> 3, c8 = ch & 7;
        if (idx < 67 * 24) *(LAS u32x4*)(raw + row * 192 + seg * 64 + c8 * 8) = graw.v[j]; }
    for (int idx = tid; idx < 768; idx += NTHR) { const int k = idx / 192, ch = idx % 192; cwt[idx] = PIN(IN_CONVW)[(size_t)l * 4 * 768 + k * 768 + (ch >> 6) * 256 + h * 64 + (ch & 63)]; }
    __syncthreads();
    for (int idx = tid; idx < 64 * 192; idx += NTHR) { const int t = idx / 192, ch = idx % 192; float s = 0.f;
#pragma unroll
        for (int k = 0; k < 4; ++k) s += cwt[k * 192 + ch] * bf2f(raw[(t + k) * 192 + ch]);
        s = siluf_(s); const int seg = ch >> 6, d = ch & 63; (seg == 0 ? qs : seg == 1 ? ks : vs)[t * 65 + d] = s; }
    __syncthreads();
    LAS unsigned char* qb = lds + 129024; LAS unsigned char* kb = qb + 8192; LAS float* Rs = (LAS float*)(kb + 8192);
    {
        const int mat = tid >> 8, row = (tid >> 2) & 63, q4 = tid & 3; LAS float* mt = mat ? ks : qs; float x[16], ss = 0.f;
#pragma unroll
        for (int d = 0; d < 16; ++d) { x[d] = mt[row * 65 + 16 * q4 + d]; ss += x[d] * x[d]; }
        ss += swz_xor<1>(ss); ss += swz_xor<2>(ss);
        const float sc = (1.0f / sqrtf(ss + 1e-6f)) * (mat ? 1.0f : 0.125f);
#pragma unroll
        for (int d = 0; d < 16; ++d) { x[d] *= sc; mt[row * 65 + 16 * q4 + d] = x[d]; }
        LAS unsigned char* ob = (mat ? kb : qb) + (2 * q4) * 1024 + row * 16;
        u32x4 w0, w1; w0.x = pk2(x[0], x[1]); w0.y = pk2(x[2], x[3]); w0.z = pk2(x[4], x[5]); w0.w = pk2(x[6], x[7]); w1.x = pk2(x[8], x[9]); w1.y = pk2(x[10], x[11]); w1.z = pk2(x[12], x[13]); w1.w = pk2(x[14], x[15]);
        *(LAS u32x4*)ob = w0; *(LAS u32x4*)(ob + 1024) = w1;
    }
    if (tid < 64) { const int i = tid;
        const float a = graw.a, bg = graw.bg;
        const float x = a + PIN(IN_DTB)[l * 4 + h]; const float sp = fmaxf(x, 0.f) + log1pf(__expf(-fabsf(x)));
        float la = -__expf(PIN(IN_ALOG)[l * 4 + h]) * sp;
#pragma unroll
        for (int o = 1; o < 64; o <<= 1) { const float v = shfl_up_l(la, o, lane); if (lane >= o) la += v; }
        bc[i] = la; eb[i] = __expf(la); be[i] = sigmoidf_(bg); }
    __syncthreads();
    const size_t ub = WS_R + R_GDN + (size_t)unit * GDN_UNIT_BYTES;
    bf16_t* gW = (bf16_t*)(wsl_ + ub); bf16_t* gATT = gW + 4096; bf16_t* gQD = gW + 8192; bf16_t* gKDT = gW + 12288; bf16_t* gU0 = gW + 16384;
    {
        const int wid = tid >> 6, r32 = lane & 31, hi = lane >> 5, isq = wid >> 2, it = (wid >> 1) & 1, jt = wid & 1;
        const LAS unsigned char* ab = (isq ? qb : kb) + hi * 1024 + (32 * it + r32) * 16; const LAS unsigned char* bb = kb + hi * 1024 + (32 * jt + r32) * 16;
        f32x16 acc = z16();
#pragma unroll
        for (int d0 = 0; d0 < 4; ++d0) acc = MF32(*(const LAS bf16x8*)(ab + d0 * 2048), *(const LAS bf16x8*)(bb + d0 * 2048), acc);
        const int j = 32 * jt + r32; const float bj = bc[j];
#pragma unroll
        for (int g = 0; g < 4; ++g) { f32x4 lv;
#pragma unroll
            for (int e = 0; e < 4; ++e) { const int i = 32 * it + 8 * g + 4 * hi + e; const float dc = __expf(bc[i] - bj), v = acc[4 * g + e] * dc;
                if (isq) gATT[i * 64 + j] = f2bf((j <= i) ? v : 0.f); else lv[e] = (j < i) ? be[i] * v : 0.f; }
            if (!isq) *(LAS f32x4*)(Lm + j * 64 + 32 * it + 8 * g + 4 * hi) = lv; }
    }
    __syncthreads();
    {
        const int c = tid & 127, cc = c & 63, rg = tid >> 7; const bool isw = c >= 64; LAS float* Xs = cwt + 768;
        for (int I = 0; I < 4; ++I) {
            float r[4];
#pragma unroll
            for (int e = 0; e < 4; ++e) { const int i = 16 * I + 4 * rg + e; r[e] = isw ? be[i] * eb[i] * ks[i * 65 + cc] : be[i] * vs[i * 65 + cc]; }
#pragma unroll 4
            for (int j = 0; j < 16 * I; ++j) { const float xj = Xs[j * 128 + c]; const f32x4 l4 = *(const LAS f32x4*)(Lm + j * 64 + 16 * I + 4 * rg);
#pragma unroll
                for (int e = 0; e < 4; ++e) r[e] -= l4[e] * xj; }
#pragma unroll
            for (int e = 0; e < 4; ++e) Rs[(4 * rg + e) * 128 + c] = r[e];
            __syncthreads();
            if (tid < 128) { float q[16];
#pragma unroll
                for (int ii = 0; ii < 16; ++ii) q[ii] = Rs[ii * 128 + c];
#pragma unroll
                for (int ii = 1; ii < 16; ++ii)
#pragma unroll
                    for (int jj = 0; jj < ii; ++jj) q[ii] -= Lm[(16 * I + jj) * 64 + 16 * I + ii] * q[jj];
#pragma unroll
                for (int ii = 0; ii < 16; ++ii) { Xs[(16 * I + ii) * 128 + c] = q[ii]; (isw ? gW : gU0)[(16 * I + ii) * 64 + cc] = f2bf(q[ii]); }
            } else if (I == 0) {
                const float bl_ = bc[63];
                for (int task = tid - 128; task < 1024; task += 384) {
                    if (task < 512) { const int c2 = task >> 3, sg = task & 7; const float e = eb[c2]; float v[8];
#pragma unroll
                        for (int j = 0; j < 8; ++j) v[j] = qs[c2 * 65 + sg * 8 + j] * e;
                        u32x4 w; w.x = pk2(v[0], v[1]); w.y = pk2(v[2], v[3]); w.z = pk2(v[4], v[5]); w.w = pk2(v[6], v[7]); *(u32x4*)(gQD + c2 * 64 + sg * 8) = w;
                    } else { const int k = (task - 512) >> 3, sg = task & 7; float v[8];
#pragma unroll
                        for (int j = 0; j < 8; ++j) { const int c2 = sg * 8 + j; v[j] = ks[c2 * 65 + k] * __expf(bl_ - bc[c2]); }
                        u32x4 w; w.x = pk2(v[0], v[1]); w.y = pk2(v[2], v[3]); w.z = pk2(v[4], v[5]); w.w = pk2(v[6], v[7]); *(u32x4*)(gKDT + k * 64 + sg * 8) = w; }
                }
                if (tid == 128) ((float*)(wsl_ + WS_R + R_GG))[unit] = __expf(bl_);
            }
            __syncthreads();
        }
    }
}

__device__ __forceinline__ bf16x8 afrag_perm(const LAS unsigned char* M, int row, int ks, int hi) {
    const LAS unsigned char* q = M + row * 144 + (16 * ks + 4 * hi) * 2;
    const s16x4 lo = *(const LAS s16x4*)q, hi4 = *(const LAS s16x4*)(q + 16);
    return (bf16x8){lo[0], lo[1], lo[2], lo[3], hi4[0], hi4[1], hi4[2], hi4[3]};
}
__device__ __forceinline__ bf16x8 pack_acc8(const f32x16& a, int s) {
    u32x4 w; w.x = pk2(a[8 * s + 0], a[8 * s + 1]); w.y = pk2(a[8 * s + 2], a[8 * s + 3]); w.z = pk2(a[8 * s + 4], a[8 * s + 5]); w.w = pk2(a[8 * s + 6], a[8 * s + 7]);
    return __builtin_bit_cast(bf16x8, w);
}
__device__ __forceinline__ void gdn_scan_item(const Params& p, int l, int chunk, int item, LAS unsigned char* lds, const int tid) {
    const int lane = tid & 63, wid = tid >> 6, vl = lane & 31, hi = lane >> 5;
    const int h = item & 3, bl = item >> 2;
    const unsigned char* ubase = p.ws + WS_R + R_GDN + (size_t)item * 64 * GDN_UNIT_BYTES;
    const float* gg = (const float*)(p.ws + WS_R + R_GG) + item * 64;
    const bf16_t* proj = (const bf16_t*)(p.ws + WS_R + R_PROJ); bf16_t* og = (bf16_t*)(p.ws + WS_R + R_O);
    const float* nw = PIN(IN_GNORM) + l * 64;
    constexpr int BUF = 5 * 9216;
    LAS unsigned char* buf0 = lds; LAS float* ob0 = (LAS float*)(lds + 2 * BUF);
    __syncthreads();
    for (int q = tid; q < 2560; q += NTHR) { const int mat = q >> 9, r = (q >> 3) & 63, sg = q & 7;
        *(LAS u32x4*)(buf0 + mat * 9216 + r * 144 + sg * 16) = *(const u32x4*)(ubase + mat * 8192 + r * 128 + sg * 16); }
    __syncthreads();
    f32x16 S[2]; S[0] = z16(); S[1] = z16();
    for (int n = 0; n < 64; ++n) {
        LAS unsigned char* bf = buf0 + (n & 1) * BUF; LAS float* ob = ob0 + (n & 1) * 4096;
        if (wid < 2) {
            const LAS unsigned char* Wm = bf; const LAS unsigned char* ATT = bf + 9216; const LAS unsigned char* QD = bf + 18432; const LAS unsigned char* KDT = bf + 27648; const LAS bf16_t* U0 = (const LAS bf16_t*)(bf + 36864);
            const float G = gg[n];
            bf16x8 Sb[4]; Sb[0] = pack_acc8(S[0], 0); Sb[1] = pack_acc8(S[0], 1); Sb[2] = pack_acc8(S[1], 0); Sb[3] = pack_acc8(S[1], 1);
            f32x16 u[2];
#pragma unroll
            for (int ct = 0; ct < 2; ++ct) { f32x16 a = z16();
#pragma unroll
                for (int ks = 0; ks < 4; ++ks) a = __builtin_amdgcn_mfma_f32_32x32x16_bf16(afrag_perm(Wm, 32 * ct + vl, ks, hi), Sb[ks], a, 0, 0, 0);
#pragma unroll
                for (int r = 0; r < 16; ++r) u[ct][r] = bf2f(U0[(32 * ct + crow(r, hi)) * 72 + 32 * wid + vl]) - a[r]; }
            bf16x8 ub[4]; ub[0] = pack_acc8(u[0], 0); ub[1] = pack_acc8(u[0], 1); ub[2] = pack_acc8(u[1], 0); ub[3] = pack_acc8(u[1], 1);
#pragma unroll
            for (int ct = 0; ct < 2; ++ct) { f32x16 a = z16();
#pragma unroll
                for (int ks = 0; ks < 4; ++ks) a = __builtin_amdgcn_mfma_f32_32x32x16_bf16(afrag_perm(QD, 32 * ct + vl, ks, hi), Sb[ks], a, 0, 0, 0);
#pragma unroll
                for (int cs = 0; cs < 4; ++cs) a = __builtin_amdgcn_mfma_f32_32x32x16_bf16(afrag_perm(ATT, 32 * ct + vl, cs, hi), ub[cs], a, 0, 0, 0);
#pragma unroll
                for (int r = 0; r < 16; ++r) ob[(32 * ct + crow(r, hi)) * 64 + 32 * wid + vl] = a[r]; }
#pragma unroll
            for (int kt = 0; kt < 2; ++kt) { f32x16 a = S[kt] * G;
#pragma unroll
                for (int cs = 0; cs < 4; ++cs) a = __builtin_amdgcn_mfma_f32_32x32x16_bf16(afrag_perm(KDT, 32 * kt + vl, cs, hi), ub[cs], a, 0, 0, 0);
                S[kt] = a; }
        } else {
            if (n + 1 < 64) { LAS unsigned char* nb = buf0 + ((n + 1) & 1) * BUF; const unsigned char* src = ubase + (size_t)(n + 1) * GDN_UNIT_BYTES;
                for (int q = tid - 128; q < 2560; q += 384) { const int mat = q >> 9, r = (q >> 3) & 63, sg = q & 7;
                    *(LAS u32x4*)(nb + mat * 9216 + r * 144 + sg * 16) = *(const u32x4*)(src + mat * 8192 + r * 128 + sg * 16); } }
        }
        if (wid >= 2 && n >= 1) { const LAS float* po = ob0 + ((n - 1) & 1) * 4096; const int tokb = bl * SEQ + (n - 1) * 64;
            for (int task = tid - 128; task < 512; task += 384) { const int c = task >> 3, sg = task & 7; float v[8], ss = 0.f;
#pragma unroll
                for (int j = 0; j < 8; ++j) { v[j] = po[c * 64 + sg * 8 + j]; ss += v[j] * v[j]; }
                ss += swz_xor<1>(ss); ss += swz_xor<2>(ss); ss += swz_xor<4>(ss);
                const float rs = 1.0f / sqrtf(ss * (1.0f / 64.0f) + 1e-6f);
                const u32x4 zw = *(const u32x4*)(proj + (size_t)(tokb + c) * PROJW + PC_GZ + h * 64 + sg * 8); const unsigned zz[4] = {zw.x, zw.y, zw.z, zw.w};
#pragma unroll
                for (int j = 0; j < 8; ++j) { const float zf = (j & 1) ? __uint_as_float(zz[j >> 1] & 0xffff0000u) : __uint_as_float(zz[j >> 1] << 16); v[j] = v[j] * rs * nw[sg * 8 + j] * siluf_(zf); }
                u32x4 w; w.x = pk2(v[0], v[1]); w.y = pk2(v[2], v[3]); w.z = pk2(v[4], v[5]); w.w = pk2(v[6], v[7]);
                *(u32x4*)(og + (size_t)(tokb + c) * 256 + h * 64 + sg * 8) = w; } }
        __syncthreads();
    }
    { const LAS float* po = ob0 + 4096; const int tokb = bl * SEQ + 63 * 64;
        for (int task = tid; task < 512; task += NTHR) { const int c = task >> 3, sg = task & 7; float v[8], ss = 0.f;
#pragma unroll
            for (int j = 0; j < 8; ++j) { v[j] = po[c * 64 + sg * 8 + j]; ss += v[j] * v[j]; }
            ss += swz_xor<1>(ss); ss += swz_xor<2>(ss); ss += swz_xor<4>(ss);
            const float rs = 1.0f / sqrtf(ss * (1.0f / 64.0f) + 1e-6f);
            const u32x4 zw = *(const u32x4*)(proj + (size_t)(tokb + c) * PROJW + PC_GZ + h * 64 + sg * 8); const unsigned zz[4] = {zw.x, zw.y, zw.z, zw.w};
#pragma unroll
            for (int j = 0; j < 8; ++j) { const float zf = (j & 1) ? __uint_as_float(zz[j >> 1] & 0xffff0000u) : __uint_as_float(zz[j >> 1] << 16); v[j] = v[j] * rs * nw[sg * 8 + j] * siluf_(zf); }
            u32x4 w; w.x = pk2(v[0], v[1]); w.y = pk2(v[2], v[3]); w.z = pk2(v[4], v[5]); w.w = pk2(v[6], v[7]);
            *(u32x4*)(og + (size_t)(tokb + c) * 256 + h * 64 + sg * 8) = w; } }
    __syncthreads();
}

__device__ __forceinline__ void fox_cum_item(const Params& p, int l, int item, LAS float* lf, const int tid) {
    const int lane = tid & 63, wid = tid >> 6, h = item & 3, bl = item >> 2;
    const float* sm = (const float*)(p.ws + WS_R + R_SM); float* nb = (float*)(p.ws + WS_R + R_CUM) + (size_t)item * SEQ;
    const float fb = PIN(IN_FBIAS)[l * 4 + h];
    float v[8], run = 0.f;
#pragma unroll
    for (int j = 0; j < 8; ++j) { const float x = sm[(size_t)(bl * SEQ + tid * 8 + j) * 32 + 20 + h] + fb; run += fminf(x, 0.f) - log1pf(__expf(-fabsf(x))); v[j] = run; }
    float inc = run;
#pragma unroll
    for (int o = 1; o < 64; o <<= 1) { const float t = shfl_up_l(inc, o, lane); if (lane >= o) inc += t; }
    __syncthreads();
    if (lane == 63) lf[wid] = inc;
    __syncthreads();
    float base = inc - run;
    for (int w = 0; w < wid; ++w) base += lf[w];
#pragma unroll
    for (int j = 0; j < 8; ++j) nb[tid * 8 + j] = -(base + v[j]) * LOG2E;
    __syncthreads();
}
__device__ __forceinline__ void ret_rope_pass(const Params& p, int chunk, const int tid, const int blk) {
    bf16_t* proj = (bf16_t*)(p.ws + WS_R + R_PROJ); const f32x2* tab = (const f32x2*)(p.ws + WS_ROPE);
    for (int task = blk * NTHR + tid; task < MC * 32; task += NWG * NTHR) {
        const int row = task >> 5, which = (task >> 4) & 1, h = (task >> 2) & 3, i8 = task & 3;
        bf16_t* q1 = proj + (size_t)row * PROJW + (which ? PC_RK : PC_RQ) + h * 64 + i8 * 8; bf16_t* q2 = q1 + 32;
        const u32x4 a = *(const u32x4*)q1, b = *(const u32x4*)q2; const unsigned aa[4] = {a.x, a.y, a.z, a.w}, bb[4] = {b.x, b.y, b.z, b.w};
        const f32x2* tp = tab + (size_t)(chunk * MC + row) * 32 + i8 * 8; float o1[8], o2[8];
#pragma unroll
        for (int j = 0; j < 8; ++j) { const float x1 = (j & 1) ? __uint_as_float(aa[j >> 1] & 0xffff0000u) : __uint_as_float(aa[j >> 1] << 16);
            const float x2 = (j & 1) ? __uint_as_float(bb[j >> 1] & 0xffff0000u) : __uint_as_float(bb[j >> 1] << 16);
            const f32x2 cs = tp[j]; o1[j] = x1 * cs.x - x2 * cs.y; o2[j] = x1 * cs.y + x2 * cs.x; }
        u32x4 w1, w2; w1.x = pk2(o1[0], o1[1]); w1.y = pk2(o1[2], o1[3]); w1.z = pk2(o1[4], o1[5]); w1.w = pk2(o1[6], o1[7]);
        w2.x = pk2(o2[0], o2[1]); w2.y = pk2(o2[2], o2[3]); w2.z = pk2(o2[4], o2[5]); w2.w = pk2(o2[6], o2[7]);
        *(u32x4*)q1 = w1; *(u32x4*)q2 = w2; }
}

constexpr int AL_K0 = 0, AL_V0 = 16384, AL_B0 = 32768;
__device__ __forceinline__ s16x4 vtr(const LAS unsigned char* q) {
    typedef short v4i16_t __attribute__((ext_vector_type(4)));
    return __builtin_bit_cast(s16x4, __builtin_amdgcn_ds_read_tr16_b64_v4i16((LAS v4i16_t*)q));
}
__device__ __forceinline__ void attn_qkt(f32x16& p0, f32x16& p1, const LAS unsigned char* kslot, const bf16x8 (&qf)[4], int r32, int hi) {
    p0 = z16(); p1 = z16();
#pragma unroll
    for (int d0 = 0; d0 < 4; ++d0) { const LAS unsigned char* kb = kslot + (2 * d0 + hi) * 1024 + r32 * 16;
        const bf16x8 b0 = *(const LAS bf16x8*)kb, b1 = *(const LAS bf16x8*)(kb + 512);
        p0 = MF32(b0, qf[d0], p0); p1 = MF32(b1, qf[d0], p1); }
}
__device__ __forceinline__ void attn_pv(f32x16 (&o)[2], const LAS unsigned char* vslot, const bf16x8 (&pw)[4], int lane, int hi) {
    const LAS unsigned char* vb = vslot + ((lane >> 4) & 1) * 32 + (lane & 3) * 8 + (4 * hi + ((lane & 15) >> 2)) * 64;
#pragma unroll
    for (int d0 = 0; d0 < 2; ++d0)
#pragma unroll
        for (int ks = 0; ks < 4; ++ks) { const s16x4 lo = vtr(vb + d0 * 4096 + ks * 1024), h4 = vtr(vb + d0 * 4096 + ks * 1024 + 512);
            const bf16x8 vf = (bf16x8){lo[0], lo[1], lo[2], lo[3], h4[0], h4[1], h4[2], h4[3]};
            o[d0] = MF32(vf, pw[ks], o[d0]); }
}
__device__ __forceinline__ void attn_softmax_step(f32x16& p0, f32x16& p1, f32x16 (&o)[2], float& m, float& l) {
    float mt = p0[0];
#pragma unroll
    for (int r = 1; r < 16; ++r) mt = fmaxf(mt, p0[r]);
#pragma unroll
    for (int r = 0; r < 16; ++r) mt = fmaxf(mt, p1[r]);
    mt = x32_max(mt);
    const float mn = fmaxf(m, mt), ms = (mn == -INFINITY) ? 0.f : mn, alpha = ex2(m - ms);
    float s = 0.f;
#pragma unroll
    for (int r = 0; r < 16; ++r) { p0[r] = ex2(p0[r] - ms); p1[r] = ex2(p1[r] - ms); s += p0[r] + p1[r]; }
    l = l * alpha + s; m = mn;
    if (__builtin_amdgcn_ballot_w64(alpha != 1.0f) != 0ull) { o[0] *= alpha; o[1] *= alpha; }
}
template <class F>
__device__ __forceinline__ void flash_loop(const F& f, int tlo, int thi, const bf16_t* Kg, const bf16_t* Vg, int pitch, const float* biasg,
                                           const bf16x8 (&qf)[4], f32x16 (&o)[2], float& m, float& l, LAS unsigned char* lds, const int tid) {
    const int lane = tid & 63, wid = tid >> 6, r32 = lane & 31, hi = lane >> 5;
    int t = tlo; while (t < thi && f.skip(t)) ++t;
    __syncthreads();
    if (t >= thi) return;
    const bf16_t* ksrc = Kg + (size_t)lane * pitch + wid * 8;
    const bf16_t* vsrc = Vg + (size_t)(16 * (wid & 3) + (lane >> 2)) * pitch + (wid >> 2) * 32 + (lane & 3) * 8;
    const int sdst = wid * 1024 + lane * 16;
    u32x4 kr = *(const u32x4*)(ksrc + (size_t)t * 64 * pitch), vr = *(const u32x4*)(vsrc + (size_t)t * 64 * pitch); float br = 0.f;
    const int btid = tid & 63;
    if (F::HAS_BIAS) br = biasg[t * 64 + btid];
    *(LAS u32x4*)(lds + AL_K0 + sdst) = kr; *(LAS u32x4*)(lds + AL_V0 + sdst) = vr; if (F::HAS_BIAS) ((LAS float*)(lds + AL_B0))[btid] = br;
    __syncthreads();
    int cur = 0;
    for (;;) {
        int tn = t + 1; while (tn < thi && f.skip(tn)) ++tn;
        if (tn < thi) { kr = *(const u32x4*)(ksrc + (size_t)tn * 64 * pitch); vr = *(const u32x4*)(vsrc + (size_t)tn * 64 * pitch); if (F::HAS_BIAS) br = biasg[tn * 64 + btid]; }
        if (!f.wskip(t)) {
        f32x16 p0, p1;
        attn_qkt(p0, p1, lds + AL_K0 + cur * 8192, qf, r32, hi);
        if (F::HAS_BIAS) { const LAS float* bp = (const LAS float*)(lds + AL_B0 + cur * 256);
#pragma unroll
            for (int g = 0; g < 4; ++g) { const f32x4 b0 = *(const LAS f32x4*)(bp + 8 * g + 4 * hi), b1 = *(const LAS f32x4*)(bp + 32 + 8 * g + 4 * hi);
#pragma unroll
                for (int e = 0; e < 4; ++e) { p0[4 * g + e] += b0[e]; p1[4 * g + e] += b1[e]; } } }
        f.apply(p0, p1, t);
        if (F::MODE == 0) attn_softmax_step(p0, p1, o, m, l);
        bf16x8 pw[4]; pw[0] = pack_acc8(p0, 0); pw[1] = pack_acc8(p0, 1); pw[2] = pack_acc8(p1, 0); pw[3] = pack_acc8(p1, 1);
        attn_pv(o, lds + AL_V0 + cur * 8192, pw, lane, hi);
        }
        if (tn >= thi) break;
        cur ^= 1;
        *(LAS u32x4*)(lds + AL_K0 + cur * 8192 + sdst) = kr; *(LAS u32x4*)(lds + AL_V0 + cur * 8192 + sdst) = vr; if (F::HAS_BIAS) ((LAS float*)(lds + AL_B0 + cur * 256))[btid] = br;
        __syncthreads();
        t = tn;
    }
    __syncthreads();
}
__device__ __forceinline__ void load_qf(bf16x8 (&qf)[4], const bf16_t* qrow, int hi) {
#pragma unroll
    for (int d0 = 0; d0 < 4; ++d0) qf[d0] = *(const bf16x8*)(qrow + d0 * 16 + hi * 8);
}
__device__ __forceinline__ void store_ot(const f32x16 (&o)[2], bf16_t* orow, int hi) {
#pragma unroll
    for (int d0 = 0; d0 < 2; ++d0)
#pragma unroll
        for (int g = 0; g < 4; ++g) { u32x2 w; w.x = pk2(o[d0][4 * g], o[d0][4 * g + 1]); w.y = pk2(o[d0][4 * g + 2], o[d0][4 * g + 3]); *(u32x2*)(orow + 32 * d0 + 8 * g + 4 * hi) = w; }
}

struct FoxF { static constexpr int MODE = 0; static constexpr bool HAS_BIAS = true; int tq, qmin, hi;
    __device__ __forceinline__ bool skip(int) const { return false; }
    __device__ __forceinline__ bool wskip(int) const { return false; }
    __device__ __forceinline__ void apply(f32x16& p0, f32x16& p1, int t) const { const float NI = ninf_();
        if (64 * t + 63 > qmin) {
#pragma unroll
            for (int r = 0; r < 16; ++r) { const int key = 64 * t + crow(r, hi); if (key > tq) p0[r] = NI; if (key + 32 > tq) p1[r] = NI; } } } };
struct RetF { static constexpr int MODE = 1; static constexpr bool HAS_BIAS = false; int tq, hi; float lg;
    __device__ __forceinline__ bool skip(int) const { return false; }
    __device__ __forceinline__ bool wskip(int) const { return false; }
    __device__ __forceinline__ void apply(f32x16& p0, f32x16& p1, int t) const { const float NI = ninf_();
#pragma unroll
        for (int r = 0; r < 16; ++r) { const int key = 64 * t + crow(r, hi);
            p0[r] = (key <= tq) ? p0[r] * ex2((float)(tq - key) * lg) : 0.f; p1[r] = (key + 32 <= tq) ? p1[r] * ex2((float)(tq - key - 32) * lg) : 0.f; } } };
struct SelF { static constexpr int MODE = 0; static constexpr bool HAS_BIAS = false; unsigned long long umask, wmask, mymask; int tq, klo, hi;
    __device__ __forceinline__ bool skip(int t) const { return ((umask >> t) & 1ull) == 0ull; }
    __device__ __forceinline__ bool wskip(int t) const { return ((wmask >> t) & 1ull) == 0ull; }
    int tdiag, tlo;
    __device__ __forceinline__ void apply(f32x16& p0, f32x16& p1, int t) const { const float NI = ninf_(); const bool on = ((mymask >> t) & 1ull) != 0ull;
        if (t >= tdiag || t <= tlo) {
#pragma unroll
            for (int r = 0; r < 16; ++r) { const int key = 64 * t + crow(r, hi); if (!on || key > tq || key <= klo) p0[r] = NI; if (!on || key + 32 > tq || key + 32 <= klo) p1[r] = NI; }
        } else if (__builtin_amdgcn_ballot_w64(!on) != 0ull) {
#pragma unroll
            for (int r = 0; r < 16; ++r) { if (!on) { p0[r] = NI; p1[r] = NI; } }
        } } };
__device__ __forceinline__ void fox_unit(const Params& p, int idx, LAS unsigned char* lds, const int tid_in_) {
    int tid = tid_in_; asm volatile("" : "+v"(tid)); unsigned char* wsl_ = ws_late();
    const int lane = tid & 63, wid = tid >> 6, r32 = lane & 31, hi = lane >> 5;
    const int qb = 15 - idx / (BC * 4), bh = idx % (BC * 4), h = bh & 3, bl = bh >> 2;
    const bf16_t* proj = (const bf16_t*)(wsl_ + WS_R + R_PROJ);
    const int tq = qb * 256 + wid * 32 + r32; const size_t rowc = (size_t)bl * SEQ + tq;
    bf16x8 qf[4]; load_qf(qf, proj + rowc * PROJW + PC_FQ + h * 64, hi);
    f32x16 o[2]; o[0] = z16(); o[1] = z16(); float m = -INFINITY, l = 0.f;
    FoxF f; f.tq = tq; f.qmin = qb * 256; f.hi = hi;
    flash_loop(f, 0, 4 * qb + 4, proj + (size_t)bl * SEQ * PROJW + PC_FK + h * 64, proj + (size_t)bl * SEQ * PROJW + PC_FV + h * 64, PROJW,
               (const float*)(wsl_ + WS_R + R_CUM) + (size_t)bh * SEQ, qf, o, m, l, lds, tid);
    l = x32_sum(l); const float inv = 1.0f / l; o[0] *= inv; o[1] *= inv;
    store_ot(o, (bf16_t*)(wsl_ + WS_R + R_O) + (size_t)3 * MC * 256 + rowc * 256 + h * 64, hi);
}
__device__ __forceinline__ void rope8(float (&o1)[8], float (&o2)[8], const u32x4& a, const u32x4& b, const f32x2* tp) {
    const unsigned aa[4] = {a.x, a.y, a.z, a.w}, bb[4] = {b.x, b.y, b.z, b.w};
#pragma unroll
    for (int j = 0; j < 8; ++j) { const float x1 = (j & 1) ? __uint_as_float(aa[j >> 1] & 0xffff0000u) : __uint_as_float(aa[j >> 1] << 16);
        const float x2 = (j & 1) ? __uint_as_float(bb[j >> 1] & 0xffff0000u) : __uint_as_float(bb[j >> 1] << 16);
        const f32x2 cs = tp[j]; o1[j] = x1 * cs.x - x2 * cs.y; o2[j] = x1 * cs.y + x2 * cs.x; }
}
__device__ __forceinline__ u32x4 pack8f(const float (&v)[8]) { u32x4 w; w.x = pk2(v[0], v[1]); w.y = pk2(v[2], v[3]); w.z = pk2(v[4], v[5]); w.w = pk2(v[6], v[7]); return w; }
__device__ __forceinline__ void ret_kv_unit(const Params& p, int ch, int idx, LAS unsigned char* lds, const int tid_in_) {
    int tid = tid_in_; asm volatile("" : "+v"(tid)); unsigned char* wsl_ = ws_late();
    const int lane = tid & 63, wid = tid >> 6, hi = lane >> 5;
    const int n = idx & 31, bh = idx >> 5, h = bh & 3, bl = bh >> 2;
    const bf16_t* proj = (const bf16_t*)(wsl_ + WS_R + R_PROJ); const f32x2* tab = (const f32x2*)(wsl_ + WS_ROPE);
    const size_t rowc0 = (size_t)bl * SEQ + n * 128; const float lg = log2f(1.0f - exp2f(-5.0f - (float)h));
    LAS unsigned char* KZ = lds; LAS unsigned char* VT = lds + 16384;
    __syncthreads();
    { const int key = tid >> 2, cp = tid & 3; const bf16_t* src = proj + (rowc0 + key) * PROJW + PC_RK + h * 64 + cp * 8;
      const u32x4 a = *(const u32x4*)src, b = *(const u32x4*)(src + 32); float o1[8], o2[8];
      rope8(o1, o2, a, b, tab + ((size_t)ch * MC + rowc0 + key) * 32 + cp * 8);
      const float zt = ex2((float)(127 - key) * lg);
#pragma unroll
      for (int j = 0; j < 8; ++j) { o1[j] *= zt; o2[j] *= zt; }
      LAS unsigned char* d = KZ + (key >> 6) * 8192 + ((key & 63) >> 4) * 1024 + (key & 15) * 64 + cp * 16;
      *(LAS u32x4*)d = pack8f(o1); *(LAS u32x4*)(d + 4096) = pack8f(o2); }
#pragma unroll
    for (int t2 = 0; t2 < 2; ++t2)
        *(LAS u32x4*)(VT + t2 * 8192 + wid * 1024 + lane * 16) = *(const u32x4*)(proj + (rowc0 + 64 * t2 + 16 * (wid & 3) + (lane >> 2)) * PROJW + PC_RV + h * 64 + (wid >> 2) * 32 + (lane & 3) * 8);
    __syncthreads();
    if (wid < 4) { const int vt = wid >> 1, kt = wid & 1;
        const int fo = ((lane >> 4) & 1) * 32 + (lane & 3) * 8 + (4 * hi + ((lane & 15) >> 2)) * 64;
        f32x16 acc = z16();
#pragma unroll
        for (int t2 = 0; t2 < 2; ++t2)
#pragma unroll
            for (int ks = 0; ks < 4; ++ks) { const LAS unsigned char* va = VT + t2 * 8192 + vt * 4096 + ks * 1024 + fo; const LAS unsigned char* ka = KZ + t2 * 8192 + kt * 4096 + ks * 1024 + fo;
                const s16x4 v0 = vtr(va), v1 = vtr(va + 512), k0 = vtr(ka), k1 = vtr(ka + 512);
                acc = MF32(((bf16x8){v0[0], v0[1], v0[2], v0[3], v1[0], v1[1], v1[2], v1[3]}), ((bf16x8){k0[0], k0[1], k0[2], k0[3], k1[0], k1[1], k1[2], k1[3]}), acc); }
        float* kvt = (float*)(wsl_ + WS_R + R_KVT) + (size_t)idx * 4096;
#pragma unroll
        for (int r = 0; r < 16; ++r) kvt[(32 * vt + crow(r, hi)) * 64 + 32 * kt + (lane & 31)] = acc[r]; }
    __syncthreads();
}
__device__ __forceinline__ void ret_out_unit(const Params& p, int l_, int ch, int idx, LAS unsigned char* lds, const int tid_in_) {
    int tid = tid_in_; asm volatile("" : "+v"(tid)); unsigned char* wsl_ = ws_late();
    const int lane = tid & 63, wid = tid >> 6, r32 = lane & 31, hi = lane >> 5, gw = wid >> 2, wq = wid & 3;
    const int np = 15 - idx / (BC * 4), bh = idx % (BC * 4), h = bh & 3, bl = bh >> 2, n = 2 * np + gw;
    const bf16_t* proj = (const bf16_t*)(wsl_ + WS_R + R_PROJ); const f32x2* tab = (const f32x2*)(wsl_ + WS_ROPE);
    const float lg = log2f(1.0f - exp2f(-5.0f - (float)h));
    LAS unsigned char* KS = lds; LAS unsigned char* VS = lds + 32768; LAS unsigned char* RT = lds + 65536;
    const int tql = 32 * wq + r32; const size_t rowc = (size_t)bl * SEQ + n * 128 + tql;
    bf16x8 qf[4];
    { const bf16_t* qrow = proj + rowc * PROJW + PC_RQ + h * 64; const f32x2* tp = tab + ((size_t)ch * MC + rowc) * 32;
#pragma unroll
      for (int d0 = 0; d0 < 2; ++d0) { const u32x4 a = *(const u32x4*)(qrow + d0 * 16 + hi * 8), b = *(const u32x4*)(qrow + 32 + d0 * 16 + hi * 8); float o1[8], o2[8];
          rope8(o1, o2, a, b, tp + d0 * 16 + hi * 8); qf[d0] = __builtin_bit_cast(bf16x8, pack8f(o1)); qf[d0 + 2] = __builtin_bit_cast(bf16x8, pack8f(o2)); } }
    __syncthreads();
#pragma unroll
    for (int g = 0; g < 2; ++g) { const size_t r0 = (size_t)bl * SEQ + (2 * np + g) * 128;
        { const int key = tid >> 2, cp = tid & 3; const bf16_t* src = proj + (r0 + key) * PROJW + PC_RK + h * 64 + cp * 8;
          const u32x4 a = *(const u32x4*)src, b = *(const u32x4*)(src + 32); float o1[8], o2[8];
          rope8(o1, o2, a, b, tab + ((size_t)ch * MC + r0 + key) * 32 + cp * 8);
          LAS unsigned char* d = KS + (g * 2 + (key >> 6)) * 8192 + cp * 1024 + (key & 63) * 16;
          *(LAS u32x4*)d = pack8f(o1); *(LAS u32x4*)(d + 4096) = pack8f(o2); }
#pragma unroll
        for (int t2 = 0; t2 < 2; ++t2)
            *(LAS u32x4*)(VS + (g * 2 + t2) * 8192 + wid * 1024 + lane * 16) = *(const u32x4*)(proj + (r0 + 64 * t2 + 16 * (wid & 3) + (lane >> 2)) * PROJW + PC_RV + h * 64 + (wid >> 2) * 32 + (lane & 3) * 8); }
    { const int t = tid & 255; const float gdec = ex2(128.0f * lg); const float* kv0 = (const float*)(wsl_ + WS_R + R_KVT) + (size_t)(bh * 32) * 4096;
#pragma unroll
      for (int q = 0; q < 2; ++q) { const int task = t + 256 * q, v = task >> 3, kc = task & 7; f32x4 a0 = {0.f, 0.f, 0.f, 0.f}, a1 = {0.f, 0.f, 0.f, 0.f};
          for (int m = 0; m < n; ++m) { const float* s = kv0 + (size_t)m * 4096 + v * 64 + kc * 8; a0 = a0 * gdec + *(const f32x4*)s; a1 = a1 * gdec + *(const f32x4*)(s + 4); }
          *(LAS u32x4*)(RT + gw * 8192 + kc * 1024 + v * 16) = pack8(a0, a1); } }
    __syncthreads();
    f32x16 o[2];
    { f32x16 p0, p1; attn_qkt(p0, p1, RT + gw * 8192, qf, r32, hi); const float xi = ex2((float)(tql + 1) * lg); o[0] = p0 * xi; o[1] = p1 * xi; }
    for (int kt = 0; kt <= (wq >> 1); ++kt) { f32x16 p0, p1; attn_qkt(p0, p1, KS + (gw * 2 + kt) * 8192, qf, r32, hi);
#pragma unroll
        for (int r = 0; r < 16; ++r) { const int key = 64 * kt + crow(r, hi);
            p0[r] = (key <= tql) ? p0[r] * ex2((float)(tql - key) * lg) : 0.f; p1[r] = (key + 32 <= tql) ? p1[r] * ex2((float)(tql - key - 32) * lg) : 0.f; }
        bf16x8 pw[4]; pw[0] = pack_acc8(p0, 0); pw[1] = pack_acc8(p0, 1); pw[2] = pack_acc8(p1, 0); pw[3] = pack_acc8(p1, 1);
        attn_pv(o, VS + (gw * 2 + kt) * 8192, pw, lane, hi); }
    float s = 0.f;
#pragma unroll
    for (int r = 0; r < 16; ++r) s += o[0][r] + o[1][r];
    s = x32_sum(s); const float mu = s * (1.0f / 64.0f); float q = 0.f;
#pragma unroll
    for (int r = 0; r < 16; ++r) { const float a = o[0][r] - mu, b = o[1][r] - mu; q += a * a + b * b; }
    q = x32_sum(q); const float rs = 1.0f / sqrtf(q * (1.0f / 64.0f) + LN_EPS);
    const float* gw_ = PIN(IN_RETGN) + l_ * 256 + h * 64; const bf16_t* grow = proj + rowc * PROJW + PC_RG + h * 64;
#pragma unroll
    for (int d0 = 0; d0 < 2; ++d0)
#pragma unroll
        for (int g = 0; g < 4; ++g) { const int d = 32 * d0 + 8 * g + 4 * hi; const u32x2 gz = *(const u32x2*)(grow + d); const f32x4 w4 = *(const f32x4*)(gw_ + d);
            const float gg[4] = {__uint_as_float(gz.x << 16), __uint_as_float(gz.x & 0xffff0000u), __uint_as_float(gz.y << 16), __uint_as_float(gz.y & 0xffff0000u)};
#pragma unroll
            for (int e = 0; e < 4; ++e) o[d0][4 * g + e] = (o[d0][4 * g + e] - mu) * rs * w4[e] * siluf_(gg[e]); }
    store_ot(o, (bf16_t*)(wsl_ + WS_R + R_O) + (size_t)1 * MC * 256 + rowc * 256 + h * 64, hi);
    __syncthreads();
}
constexpr int NL_KC = 36864, NL_VC = 69632, NL_IMPM = 102400, NL_IMPS = 118784, NL_SELM = 135424;
__device__ __forceinline__ void nsa_unit(const Params& p, int idx, LAS unsigned char* lds, const int tid_in_) {
    int tid = tid_in_; asm volatile("" : "+v"(tid)); unsigned char* wsl_ = ws_late();
    const int lane = tid & 63, wid = tid >> 6, r32 = lane & 31, hi = lane >> 5, tl = r32 >> 2, hd = r32 & 3;
    const int ib = 63 - idx / BC, bl = idx % BC;
    const bf16_t* proj = (const bf16_t*)(wsl_ + WS_R + R_PROJ); const float* sm = (const float*)(wsl_ + WS_R + R_SM);
    const int tokl = 8 * wid + tl, tq = ib * 64 + tokl; const size_t rowc = (size_t)bl * SEQ + tq;
    bf16x8 qf[4]; load_qf(qf, proj + rowc * PROJW + PC_NQ + hd * 64, hi);
    const float g0 = sigmoidf_(sm[rowc * 32 + 8 + hd * 3 + 0]), g1 = sigmoidf_(sm[rowc * 32 + 8 + hd * 3 + 1]), g2 = sigmoidf_(sm[rowc * 32 + 8 + hd * 3 + 2]);
    f32x16 of[2];
    const int ntc = min(3, (4 * ib + 2) >> 6) + 1;
    {
        const bf16_t* kc = (const bf16_t*)(wsl_ + WS_R + R_KCMP) + (size_t)bl * 256 * 64; const bf16_t* vc = kc + (size_t)BC * 256 * 64;
        __syncthreads();
        for (int tt = 0; tt < ntc; ++tt) {
            *(LAS u32x4*)(lds + NL_KC + tt * 8192 + wid * 1024 + lane * 16) = *(const u32x4*)(kc + (size_t)(tt * 64 + lane) * 64 + wid * 8);
            *(LAS u32x4*)(lds + NL_VC + tt * 8192 + wid * 1024 + lane * 16) = *(const u32x4*)(vc + (size_t)(tt * 64 + 16 * (wid & 3) + (lane >> 2)) * 64 + (wid >> 2) * 32 + (lane & 3) * 8); }
        __syncthreads();
        float m = -INFINITY, l = 0.f;
        for (int tt = 0; tt < ntc; ++tt) { f32x16 p0, p1; attn_qkt(p0, p1, lds + NL_KC + tt * 8192, qf, r32, hi);
#pragma unroll
            for (int r = 0; r < 16; ++r) { const int n0 = 64 * tt + crow(r, hi), n1 = n0 + 32; if (n0 >= 255 || 16 * n0 + 31 > tq) p0[r] = -INFINITY; if (n1 >= 255 || 16 * n1 + 31 > tq) p1[r] = -INFINITY; }
            float mt = p0[0];
#pragma unroll
            for (int r = 1; r < 16; ++r) mt = fmaxf(mt, p0[r]);
#pragma unroll
            for (int r = 0; r < 16; ++r) mt = fmaxf(mt, p1[r]);
            mt = x32_max(mt);
            const float mn = fmaxf(m, mt), ms = (mn == -INFINITY) ? 0.f : mn; float s = 0.f;
#pragma unroll
            for (int r = 0; r < 16; ++r) s += ex2(p0[r] - ms) + ex2(p1[r] - ms);
            l = l * ex2(m - ms) + s; m = mn; }
        l = x32_sum(l);
        const float inv = (l > 0.f) ? 1.0f / l : 0.f, ms = (m == -INFINITY) ? 0.f : m;
        LAS float* impm = (LAS float*)(lds + NL_IMPM); LAS float* imps = (LAS float*)(lds + NL_IMPS);
        f32x16 oc[2]; oc[0] = z16(); oc[1] = z16();
        for (int tt = 0; tt < ntc; ++tt) { f32x16 p0, p1; attn_qkt(p0, p1, lds + NL_KC + tt * 8192, qf, r32, hi);
#pragma unroll
            for (int r = 0; r < 16; ++r) { const int n0 = 64 * tt + crow(r, hi), n1 = n0 + 32;
                p0[r] = (n0 >= 255 || 16 * n0 + 31 > tq) ? 0.f : ex2(p0[r] - ms) * inv; p1[r] = (n1 >= 255 || 16 * n1 + 31 > tq) ? 0.f : ex2(p1[r] - ms) * inv; }
#pragma unroll
            for (int g = 0; g < 4; ++g) {
                float ma = p0[4 * g] + p0[4 * g + 1] + p0[4 * g + 2] + 0.5f * p0[4 * g + 3], sa = 0.5f * p0[4 * g + 3];
                float mb = p1[4 * g] + p1[4 * g + 1] + p1[4 * g + 2] + 0.5f * p1[4 * g + 3], sb = 0.5f * p1[4 * g + 3];
                ma += swz_xor<1>(ma); ma += swz_xor<2>(ma); sa += swz_xor<1>(sa); sa += swz_xor<2>(sa);
                mb += swz_xor<1>(mb); mb += swz_xor<2>(mb); sb += swz_xor<1>(sb); sb += swz_xor<2>(sb);
                if (hd == 0) { const int ja = 16 * tt + 2 * g + hi, jb = ja + 8;
                    impm[tokl * 64 + ja] = ma; imps[tokl * 65 + ja + 1] = sa; impm[tokl * 64 + jb] = mb; imps[tokl * 65 + jb + 1] = sb; } }
            bf16x8 pw[4]; pw[0] = pack_acc8(p0, 0); pw[1] = pack_acc8(p0, 1); pw[2] = pack_acc8(p1, 0); pw[3] = pack_acc8(p1, 1);
            attn_pv(oc, lds + NL_VC + tt * 8192, pw, lane, hi); }
        of[0] = oc[0] * g0; of[1] = oc[1] * g0;
        LAS unsigned long long* selm = (LAS unsigned long long*)(lds + NL_SELM);
        if (ib < 16) { if (lane < 8) selm[8 * wid + lane] = (2ull << ib) - 1ull; }
        else for (int t8 = 0; t8 < 8; ++t8) { const int tk = 8 * wid + t8; const int j = lane;
            float imp = (j < 16 * ntc) ? impm[tk * 64 + j] + ((j > 0) ? imps[tk * 65 + j] : 0.f) : 0.f;
            const bool forced = (j == 0) || (j == ib) || (j == ib - 1);
            const float score = forced ? 1.0e4f : ((j <= ib) ? imp : -1.0f);
            int rank = 0;
#pragma unroll
            for (int jj = 0; jj < 64; ++jj) { const float sj = __uint_as_float(__builtin_amdgcn_readlane(__float_as_uint(score), jj)); rank += ((sj > score) || (sj == score && jj < j)) ? 1 : 0; }
            const unsigned long long mk = __ballot((rank < 16) && (j <= ib));
            if (lane == 0) selm[tk] = mk; }
    }
    __syncthreads();
    unsigned long long mymask, umask, wmask;
    { const LAS unsigned long long* selm = (const LAS unsigned long long*)(lds + NL_SELM); mymask = selm[tokl];
      unsigned long long u = selm[lane]; unsigned lo = (unsigned)u, hi32 = (unsigned)(u >> 32);
      lo |= swz_xor_u<1>(lo); lo |= swz_xor_u<2>(lo); lo |= swz_xor_u<4>(lo); lo |= swz_xor_u<8>(lo); lo |= swz_xor_u<16>(lo); lo = x32_or(lo);
      hi32 |= swz_xor_u<1>(hi32); hi32 |= swz_xor_u<2>(hi32); hi32 |= swz_xor_u<4>(hi32); hi32 |= swz_xor_u<8>(hi32); hi32 |= swz_xor_u<16>(hi32); hi32 = x32_or(hi32);
      umask = ((unsigned long long)hi32 << 32) | lo; umask = __builtin_amdgcn_readfirstlane((unsigned)umask) | ((unsigned long long)__builtin_amdgcn_readfirstlane((unsigned)(umask >> 32)) << 32);
      unsigned wl = 0u, wh = 0u;
#pragma unroll
      for (int t8 = 0; t8 < 8; ++t8) { const unsigned long long mk = selm[8 * wid + t8]; wl |= (unsigned)mk; wh |= (unsigned)(mk >> 32); }
      wmask = (unsigned long long)(unsigned)__builtin_amdgcn_readfirstlane((int)wl) | ((unsigned long long)(unsigned)__builtin_amdgcn_readfirstlane((int)wh) << 32); }
    for (int br = 0; br < 2; ++br) {
        f32x16 o[2]; o[0] = z16(); o[1] = z16(); float m = -INFINITY, l = 0.f;
        SelF f; f.umask = br ? ~0ull : umask; f.wmask = br ? ~0ull : wmask; f.mymask = br ? ~0ull : mymask; f.tq = tq; f.klo = br ? tq - 512 : -1; f.hi = hi; f.tdiag = ib; f.tlo = br ? (ib * 64 + 63 - 512) / 64 : -1;
        const bf16_t* nkv2 = (const bf16_t*)(ws_late() + WS_R + R_NKV);
        flash_loop(f, br ? max(0, ib - 8) : 0, ib + 1, nkv2 + (size_t)(2 + 2 * br) * (NKV_SEG / 2) + (size_t)bl * SEQ * 64, nkv2 + (size_t)(3 + 2 * br) * (NKV_SEG / 2) + (size_t)bl * SEQ * 64, 64, nullptr, qf, o, m, l, lds, tid);
        l = x32_sum(l); const float sc = (l > 0.f) ? (br ? g2 : g1) / l : 0.f; of[0] += o[0] * sc; of[1] += o[1] * sc;
    }
    store_ot(of, (bf16_t*)(ws_late() + WS_R + R_O) + (size_t)2 * MC * 256 + rowc * 256 + hd * 64, hi);
}

constexpr int LDS_MISC = LDS_BYTES - 256;
constexpr size_t LWS = ((LW_BYTES + MiB - 1) / MiB) * MiB;
#define PHASE_PRE const int tid = fresh_tid(); int l, ch; { int k_; bool b_; step_decode(__builtin_amdgcn_readfirstlane(((volatile LAS int*)lds_at(LDS_MISC + 176))[0]), k_, l, ch, b_); } \
    Params p; ptab_load(p); LAS unsigned char* lds = lds_at(0); const int G = NWG; \
    const int c = __builtin_amdgcn_readfirstlane(((volatile LAS int*)(lds + LDS_MISC + 176))[2]); (void)lds; (void)G; (void)c; (void)l; (void)ch; \
    volatile LAS int* qslot = (volatile LAS int*)(lds + LDS_MISC + 16); (void)qslot;
#define LW_ (p.ws + WS_W + (size_t)l * LWS)
#define LWO_ ((unsigned)(WS_W + (size_t)l * LWS))
#define HC_ ((unsigned)(WS_H + (size_t)ch * MC * 1024 * 2))
#define QCTR_ ((unsigned*)(p.ws + WS_CTL) + CW_Q + 64 * ((l * NCHUNK + ch) * 8) + 8192 * __builtin_amdgcn_readfirstlane(((volatile LAS int*)lds_at(LDS_MISC + 176))[3]))
__device__ __forceinline__ int tid_out(int t) { asm volatile("" : "+v"(t)); return t; }
__device__ __forceinline__ int fresh_tid() {
    LAS unsigned* ctr = (LAS unsigned*)lds_at(LDS_MISC + 192);
    unsigned z = 0u; asm volatile("" : "+v"(z));
    const int lane = (int)__builtin_amdgcn_mbcnt_hi(~0u, __builtin_amdgcn_mbcnt_lo(~0u, z));
    unsigned t = 0u; if (lane == 0) t = __hip_atomic_fetch_add(ctr, 1u, __ATOMIC_RELAXED, __HIP_MEMORY_SCOPE_WORKGROUP);
    t = (unsigned)__builtin_amdgcn_readfirstlane((int)t);
    __syncthreads();
    return (int)(((t & 7u) << 6) | (unsigned)lane);
}
__device__ __forceinline__ void step_decode(int s, int& k, int& l, int& ch, bool& bar);
#define GCTR_(j) ((unsigned*)(p.ws + WS_CTL) + CW_G + 64 * ((l * NCHUNK + ch) * 8 + (j)) + 16384 * __builtin_amdgcn_readfirstlane(((volatile LAS int*)lds_at(LDS_MISC + 176))[3]))
#define PHFN(name) static __device__ __noinline__ void name()
#define PHFI(name) static __device__ __forceinline__ void name()

PHFI(ph_p0) { PHASE_PRE
    constexpr int N_ADA = 192, N_CB = 4, N_ROPE = MTOK * 32 / 4096, N_T = 2 * TJ_TOTAL;
    for (int it = c; it < N_ADA + N_CB + N_ROPE; it += G) {
        if (it < N_ADA) p0_ada(p, it, (LAS float*)lds, tid);
        else if (it < N_ADA + N_CB) p0_cbias(p, it - N_ADA, tid);
        else p0_rope(p, it - N_ADA - N_CB, tid);
    }
    for (int it = c; it < N_T; it += 4 * G) p0_transpose4(p, it, G, N_T, (LAS float*)lds, tid);
}
PHFN(ph_p1) { PHASE_PRE prep_first(p, tid, c); }
PHFI(ph_a1) { PHASE_PRE
    DenseSched S; S.A = HC_; S.Bt = LWO_ + (unsigned)LW_WIN; S.tA = 256u * 1024 * 2; S.tB = 256u * 1024 * 2; S.aBr = 0; S.nM = MC / 256; S.nN = NPROJ / 256; S.G = G; S.c = c; S.pnShift = 0; S.ctr = GCTR_(0);
    EpiProj E;
    pg8::gemm_phase<EpiProj, DenseSched, true, false>(lds, 1024, 1024, 1024, S, E, tid, (const char*)p.ws);
}
PHFN(ph_a2a) { PHASE_PRE
    if (c < 2 * BC) {
        const int which = c & 1, bl = c >> 1;
        OneSched S; S.has = true; S.u0.pm = bl; S.u0.pn = 0; S.u0.aux = which; S.u0.nvalid = 256; S.u0.rows = 0u;
        S.u0.a = (unsigned)(WS_R + R_NKV + (size_t)which * NKV_SEG + (size_t)bl * SEQ * 64 * 2); S.u0.b = LWO_ + (unsigned)(LW_CW1 + (size_t)which * 256 * 2048 * 2);
        EpiH1 E; E.h1 = (bf16_t*)(p.ws + WS_R + R_H1); E.cbias = (const float*)(p.ws + WS_CBIAS) + l * 512;
        pg8::gemm_phase<EpiH1, OneSched, true, false>(lds, 2048, 1024, 2048, S, E, tid, (const char*)p.ws);
        VM_WAIT(); __syncthreads(); __builtin_amdgcn_fence(__ATOMIC_ACQUIRE, "agent"); VM_WAIT(); __syncthreads();
    }
}
PHFN(ph_a2b) { PHASE_PRE
    if (c < 2 * BC) {
        const int which = c & 1, bl = c >> 1;
        OneSched S2; S2.has = true; S2.u0.pm = bl; S2.u0.pn = 0; S2.u0.aux = which; S2.u0.nvalid = 256; S2.u0.rows = 0u;
        S2.u0.a = (unsigned)(WS_R + R_H1 + ((size_t)which * BC * 256 + (size_t)bl * 256) * 256 * 2); S2.u0.b = LWO_ + (unsigned)(LW_CW2 + (size_t)which * 256 * 256 * 2);
        EpiCmp2 E2; E2.kc = (bf16_t*)(p.ws + WS_R + R_KCMP);
        pg8::gemm_phase<EpiCmp2, OneSched, true, false>(lds, 256, 256, 256, S2, E2, tid, (const char*)p.ws);
    }
}
PHFI(ph_a2c) { PHASE_PRE
    unsigned* qc = QCTR_ + 0; const int NU = BC * 4 * 64;
    int u = q_next(qc, qslot, tid), un = q_next(qc, qslot, tid);
    GdnRaw ga; if (u < NU) gdn_prep_load(ga, u, tid);
    while (u < NU) {
        int tk = 0x3fffffff; if (tid == 0) tk = (int)__hip_atomic_fetch_add(qc, 1u, __ATOMIC_RELAXED, __HIP_MEMORY_SCOPE_AGENT);
        GdnRaw gn = ga; if (un < NU) gdn_prep_load(gn, un, tid);
        gdn_prep_unit(p, l, u, lds, tid, ga);
        if (tid == 0) *qslot = tk;
        __syncthreads();
        const int unn = *qslot;
        __syncthreads();
        u = un; un = unn; ga = gn;
    }
}
PHFN(ph_a2d) { PHASE_PRE
    for (;;) { const int u = q_next(QCTR_ + 64, qslot, tid); if (u >= BC * 4) break; fox_cum_item(p, l, u, (LAS float*)lds, tid); }
    for (;;) { const int u = q_next(QCTR_ + 320, qslot, tid); if (u >= BC * 4 * 32) break; ret_kv_unit(p, ch, u, lds, tid); }
}
PHFN(ph_a3a) { PHASE_PRE if (c < BC * 4) gdn_scan_item(p, l, ch, c, lds, tid); }
PHFI(ph_a3b) { PHASE_PRE for (;;) { const int u = q_next(QCTR_ + 128, qslot, tid); if (u >= BC * 4 * 16) break; fox_unit(p, u, lds, tid); } }
PHFI(ph_a3c) { PHASE_PRE for (;;) { const int u = q_next(QCTR_ + 192, qslot, tid); if (u >= BC * 4 * 16) break; ret_out_unit(p, l, ch, u, lds, tid); } }
PHFI(ph_a3d) { PHASE_PRE for (;;) { const int u = q_next(QCTR_ + 256, qslot, tid); if (u >= BC * 64) break; nsa_unit(p, u, lds, tid); } }
PHFN(ph_a5) { PHASE_PRE
    DenseSched S; S.A = (unsigned)(WS_R + R_O); S.Bt = LWO_ + (unsigned)LW_BPT; S.tA = 256u * 256 * 2; S.tB = 256u * 256 * 2; S.aBr = (unsigned)((size_t)MC * 256 * 2); S.nM = MC / 256; S.nN = 16; S.G = G; S.c = c; S.pnShift = 2; S.ctr = GCTR_(1);
    EpiP E;
    pg8::gemm_phase<EpiP, DenseSched, true, false>(lds, 256, 256, 256, S, E, tid, (const char*)p.ws);
}
PHFN(ph_a6) { PHASE_PRE
    DenseSched S; S.A = HC_; S.Bt = LWO_ + (unsigned)LW_WGV; S.tA = 256u * 1024 * 2; S.tB = 256u * 1024 * 2; S.aBr = 0; S.nM = MC / 256; S.nN = 16; S.G = G; S.c = c; S.pnShift = 0; S.ctr = GCTR_(2);
    EpiGate E;
    pg8::gemm_phase<EpiGate, DenseSched, true, false>(lds, 1024, 1024, 1024, S, E, tid, (const char*)p.ws);
}
PHFN(ph_a7) { PHASE_PRE
    DenseSched S; S.A = (unsigned)(WS_R + R_Y); S.Bt = LWO_ + (unsigned)LW_WOT; S.tA = 256u * 1024 * 2; S.tB = 256u * 1024 * 2; S.aBr = 0; S.nM = MC / 256; S.nN = 4; S.G = G; S.c = c; S.pnShift = 0; S.ctr = GCTR_(3);
    EpiOut E; E.row_base = ch * MC;
    pg8::gemm_phase<EpiOut, DenseSched, true, false>(lds, 1024, 1024, 1024, S, E, tid, (const char*)p.ws);
}
PHFN(ph_b0) { PHASE_PRE prep_moe(p, l, (LAS float*)lds, tid, c); }
__device__ __forceinline__ void moe_tables(const Params& p, int l, LAS int* mcnt, LAS int* mpre, const int tid) {
    __syncthreads();
    if (tid < 16) mcnt[tid] = (int)((unsigned*)(p.ws + WS_CTL))[CW_CNT + l * 64 + tid];
    __syncthreads();
    if (tid == 0) { int s = 0; for (int e = 0; e < 16; ++e) { mpre[e] = s; s += (mcnt[e] + 255) >> 8; } mpre[16] = s; }
    __syncthreads();
}
PHFI(ph_b1) { PHASE_PRE
    LAS int* mcnt = (LAS int*)(lds + LDS_MISC + 32); LAS int* mpre = mcnt + 16; moe_tables(p, l, mcnt, mpre, tid);
    MoeSched S; S.pre = mpre; S.cnt = mcnt; S.wsb = (const char*)p.ws; S.A = (unsigned)WS_H; S.W = LWO_ + (unsigned)LW_W13;
    S.wE = 1024u * 1024 * 2; S.wT = 256u * 1024 * 2; S.aT = 0; S.G = G; S.c = c; S.gatherA = true; S.ctr = GCTR_(4);
    EpiMoe1 E;
    pg8::gemm_phase<EpiMoe1, MoeSched, true, true>(lds, 1024, 1024, 1024, S, E, tid, (const char*)p.ws);
}
PHFN(ph_b2) { PHASE_PRE
    LAS int* mcnt = (LAS int*)(lds + LDS_MISC + 32); LAS int* mpre = mcnt + 16; moe_tables(p, l, mcnt, mpre, tid);
    MoeSched S; S.pre = mpre; S.cnt = mcnt; S.wsb = (const char*)p.ws; S.A = (unsigned)(WS_R + R_HID); S.W = LWO_ + (unsigned)LW_W2;
    S.wE = 1024u * 512 * 2; S.wT = 256u * 512 * 2; S.aT = 256u * 512 * 2; S.G = G; S.c = c; S.gatherA = false; S.ctr = GCTR_(5);
    EpiMoe2 E;
    pg8::gemm_phase<EpiMoe2, MoeSched, true, false>(lds, 512, 512, 512, S, E, tid, (const char*)p.ws);
}
PHFN(ph_b3) { PHASE_PRE prep_next(p, l, l == DEPTH - 1, tid, c); }

constexpr int STEPS_CHUNK = 12, STEPS_LAYER = NCHUNK * STEPS_CHUNK + 4, N_STEPS = 2 + DEPTH * STEPS_LAYER;
__device__ __forceinline__ void step_decode(int s, int& k, int& l, int& ch, bool& bar) {
    if (s < 2) { k = s; l = 0; ch = 0; bar = true; return; }
    const int t = s - 2; l = t / STEPS_LAYER; const int r = t % STEPS_LAYER;
    if (r < NCHUNK * STEPS_CHUNK) { ch = r / STEPS_CHUNK; const int q = r % STEPS_CHUNK; k = 2 + q; bar = !(q == 1 || q == 2 || q == 3 || q == 5 || q == 6 || q == 7); }
    else { ch = 0; k = 14 + (r - NCHUNK * STEPS_CHUNK); bar = true; }
}
__global__ void __launch_bounds__(NTHR, 2) __attribute__((disable_tail_calls)) mega_fwd(Params p0_) {
    LAS unsigned char* lds = lds_at(0);
    const int tid = threadIdx.x;
    volatile LAS unsigned* xbw = (volatile LAS unsigned*)(lds + LDS_MISC);
    volatile LAS int* st = (volatile LAS int*)(lds + LDS_MISC + 176);
    if (tid == 0) { xbw[0] = 0u; xbw[1] = 0u; xbw[2] = 0u; xbw[3] = 0u; st[0] = p0_.ph_lo; st[1] = p0_.ph_hi; st[2] = blockIdx.x; st[3] = 0; *(volatile LAS unsigned*)(lds + LDS_MISC + 200) = 0u; *(volatile LAS unsigned*)(lds + LDS_MISC + 192) = 0u; }
    ptab_store(p0_, tid);
    __syncthreads();
    (void)xcd_barrier_post((unsigned*)(p0_.ws + WS_CTL) + CW_BAR, xbw, tid);
    for (;;) {
        {
          LAS unsigned char* mb_ = lds_at(LDS_MISC); volatile LAS int* st_ = (volatile LAS int*)(mb_ + 176);
          const int s = __builtin_amdgcn_readfirstlane(st_[0]), e = __builtin_amdgcn_readfirstlane(st_[1]);
          if (s >= e) break;
          int k, l, ch; bool bar; step_decode(s, k, l, ch, bar);
#ifdef PROBE_STEPTIME
          if (threadIdx.x == 0) { volatile LAS unsigned long long* tp_ = (volatile LAS unsigned long long*)(mb_ + 208); tp_[0] = __builtin_amdgcn_s_memrealtime(); }
#endif
          switch (k) {
          case 0: ph_p0(); break;
          case 1: ph_p1(); break;
          case 2: ph_a1(); break;
          case 3: ph_a2a(); break;
          case 4: ph_a2b(); break;
          case 5: ph_a2c(); break;
          case 6: ph_a2d(); break;
          case 7: ph_a3a(); break;
          case 8: ph_a3b(); break;
          case 9: ph_a3c(); break;
          case 10: ph_a3d(); break;
          case 11: ph_a5(); break;
          case 12: ph_a6(); break;
          case 13: ph_a7(); break;
          case 14: ph_b0(); break;
          case 15: ph_b1(); break;
          case 16: ph_b2(); break;
          default: ph_b3(); break;
          } }
#ifdef PROBE_STEPTIME
        { LAS unsigned char* mb2_ = lds_at(LDS_MISC); const int s2_ = __builtin_amdgcn_readfirstlane(((volatile LAS int*)(mb2_ + 176))[0]); int k2_, l2_, c2_; bool b2_; step_decode(s2_, k2_, l2_, c2_, b2_);
          __syncthreads();
          if (threadIdx.x == 0 && ((PROBE_STEPTIME >> k2_) & 1)) { volatile LAS unsigned long long* tp_ = (volatile LAS unsigned long long*)(mb2_ + 208); volatile LAS unsigned* ac_ = (volatile LAS unsigned*)(mb2_ + 200);
              ac_[0] = ac_[0] + (unsigned)(__builtin_amdgcn_s_memrealtime() - tp_[0]); } }
#endif
        { const int tid = fresh_tid(); LAS unsigned char* mb_ = lds_at(LDS_MISC); volatile LAS int* st_ = (volatile LAS int*)(mb_ + 176);
          volatile LAS unsigned* xbw_ = (volatile LAS unsigned*)mb_;
          const int s = __builtin_amdgcn_readfirstlane(st_[0]), e = __builtin_amdgcn_readfirstlane(st_[1]);
          int k, l, ch; bool bar; step_decode(s, k, l, ch, bar);
#ifdef DUP_MASK
          const bool adv_ = !(((DUP_MASK >> k) & 1) && __builtin_amdgcn_readfirstlane(st_[3]) == 0);
#else
          const bool adv_ = true;
#endif
          if (adv_ && bar && s + 1 < e) { XcdBarrier b; b.bar = (unsigned*)((unsigned char*)ptab_get(28) + WS_CTL) + CW_BAR; b.x = xb_xcc_id(); b.st = xbw_;
#ifdef PROBE_BARWAIT
              __syncthreads(); const unsigned long long t0_ = __builtin_amdgcn_s_memrealtime();
              xcd_barrier(b, tid);
              const unsigned long long t1_ = __builtin_amdgcn_s_memrealtime(); if (tid == 0) { volatile LAS unsigned* ac_ = (volatile LAS unsigned*)(mb_ + 200); ac_[0] = ac_[0] + (unsigned)(t1_ - t0_); }
#else
              xcd_barrier(b, tid);
#endif
          }
          __syncthreads();
#ifdef DUP_MASK
          const int rp = __builtin_amdgcn_readfirstlane(st_[3]);
          if (((DUP_MASK >> k) & 1) && rp == 0) { if (tid == 0) st_[3] = 1; }
          else { if (tid == 0) { st_[3] = 0; st_[0] = s + 1; } }
#else
          if (tid == 0) st_[0] = s + 1;
#endif
          __syncthreads(); }
    }
#if defined(PROBE_BARWAIT) || defined(PROBE_STEPTIME)
    { const unsigned w_ = *(volatile LAS unsigned*)(lds_at(LDS_MISC) + 200); const unsigned long long t0_ = __builtin_amdgcn_s_memrealtime();
      while (__builtin_amdgcn_s_memrealtime() - t0_ < (unsigned long long)w_) __builtin_amdgcn_s_sleep(8); }
#endif
}

extern "C" void kernel_launch(void* const* d_in, const int* in_sizes, int n_in, void* d_out, int out_size, void* d_ws, size_t ws_size, hipStream_t stream) {
    (void)in_sizes; (void)out_size;
    if (n_in < 27 || ws_size < WS_END) { fprintf(stderr, "kernel_launch: unexpected inputs (n_in %d, ws %zu < %zu)\n", n_in, ws_size, (size_t)WS_END); return; }
    static bool attr_set = false;
    if (!attr_set) { (void)hipFuncSetAttribute((const void*)mega_fwd, hipFuncAttributeMaxDynamicSharedMemorySize, LDS_BYTES); attr_set = true; }
    Params p{};
    for (int i = 0; i < 27; ++i) p.in[i] = (const float*)d_in[i];
    p.out = (float*)d_out; p.ws = (unsigned char*)d_ws;
    (void)hipMemsetAsync((unsigned char*)d_ws + WS_CTL, 0, CTL_BYTES, stream);
#ifndef MK_CUTS
    p.ph_lo = 0; p.ph_hi = N_STEPS;
    hipLaunchKernelGGL(mega_fwd, dim3(NWG), dim3(NTHR), LDS_BYTES, stream, p);
#else
    { static const int cuts[] = {MK_CUTS, N_STEPS}; int lo = 0;
      for (unsigned i = 0; i < sizeof(cuts) / sizeof(cuts[0]); ++i) { p.ph_lo = lo; p.ph_hi = cuts[i]; lo = cuts[i]; hipLaunchKernelGGL(mega_fwd, dim3(NWG), dim3(NTHR), LDS_BYTES, stream, p); } }
#endif
}
```

```cpp
#include <hip/hip_runtime.h>
#include <stdint.h>
#include <stdio.h>

#define GAS __attribute__((address_space(1)))
#define LAS __attribute__((address_space(3)))
typedef unsigned short bf16_t;
typedef short bf16x8 __attribute__((ext_vector_type(8)));
typedef short s16x4 __attribute__((ext_vector_type(4)));
typedef float f32x2 __attribute__((ext_vector_type(2)));
typedef float f32x4 __attribute__((ext_vector_type(4)));
typedef float f32x16 __attribute__((ext_vector_type(16)));
typedef unsigned u32x2 __attribute__((ext_vector_type(2)));
typedef unsigned u32x4 __attribute__((ext_vector_type(4)));
typedef __bf16 bf16x2_t __attribute__((ext_vector_type(2)));

constexpr int D_MODEL = 1024, BATCH = 16, SEQ = 4096, DEPTH = 2, MTOK = BATCH * SEQ;
constexpr int NCHUNK = 2, BC = BATCH / NCHUNK, MC = BC * SEQ;
constexpr int NPROJ = 3584, PROJW = 3072;
constexpr float DN_ALPHA = 1.4142135623730951f;
constexpr float LN_EPS = 1e-5f;
constexpr float LOG2E = 1.4426950408889634f;
constexpr float QSCALE = 0.125f * 1.4426950408889634f;
constexpr int NWG = 256, NTHR = 512;
constexpr int LDS_BYTES = 163840;

constexpr int PC_GQ = 0, PC_GK = 256, PC_GV = 512, PC_GZ = 768, PC_RQ = 1024, PC_RK = 1280, PC_RV = 1536, PC_RG = 1792, PC_NQ = 2048, PC_FQ = 2304, PC_FK = 2560, PC_FV = 2816;

constexpr size_t MiB = 1ull << 20;
constexpr size_t WS_CTL = 0;
constexpr size_t CTL_BYTES = 1 * MiB;
constexpr size_t WS_MOD = 1 * MiB;
constexpr size_t WS_ROPE = 2 * MiB;
constexpr size_t WS_STATS = 18 * MiB;
constexpr size_t WS_CBIAS = 19 * MiB;
constexpr size_t WS_W = 20 * MiB;
constexpr size_t LW_WIN = 0;
constexpr size_t LW_WGV = LW_WIN + (size_t)NPROJ * 1024 * 2;
constexpr size_t LW_BPT = LW_WGV + (size_t)4096 * 1024 * 2;
constexpr size_t LW_WOT = LW_BPT + (size_t)4096 * 256 * 2;
constexpr size_t LW_W13 = LW_WOT + (size_t)1024 * 1024 * 2;
constexpr size_t LW_W2 = LW_W13 + (size_t)16 * 1024 * 1024 * 2;
constexpr size_t LW_CW1 = LW_W2 + (size_t)16 * 1024 * 512 * 2;
constexpr size_t LW_CW2 = LW_CW1 + (size_t)2 * 256 * 2048 * 2;
constexpr size_t LW_BYTES = LW_CW2 + (size_t)2 * 256 * 256 * 2;
constexpr size_t WS_H = WS_W + 2 * ((LW_BYTES + MiB - 1) / MiB) * MiB;
constexpr size_t WS_R = WS_H + 128 * MiB;
constexpr size_t R_PROJ = 0;
constexpr size_t R_GDN = R_PROJ + (size_t)MC * PROJW * 2;
constexpr size_t GDN_UNIT_BYTES = 5 * 8192;
constexpr size_t R_P = 0;
constexpr size_t R_NKV = R_GDN + (size_t)BC * 4 * 64 * GDN_UNIT_BYTES;
constexpr size_t NKV_SEG = (size_t)(MC + 64) * 64 * 2;
constexpr size_t R_SM = R_NKV + 6 * NKV_SEG;
constexpr size_t R_CUM = R_SM + (size_t)MC * 32 * 4;
constexpr size_t R_GG = R_CUM + (size_t)BC * 4 * 4096 * 4;
constexpr size_t R_KCMP = R_GG + (size_t)BC * 4 * 64 * 4 + 768;
constexpr size_t R_H1 = R_KCMP + (size_t)2 * BC * 256 * 64 * 2;
constexpr size_t R_O = R_H1 + (size_t)2 * BC * 256 * 256 * 2;
constexpr size_t R_Y = R_O + (size_t)4 * MC * 256 * 2;
constexpr size_t R_KVT = R_Y + (size_t)MC * 1024 * 2;
constexpr size_t R_MIX_END = R_KVT + (size_t)BC * 4 * 32 * 4096 * 4;
static_assert(R_NKV >= (size_t)MC * 4096 * 2, "P overlay fits under PROJ+GDN");
constexpr size_t R_LIST = 0;
constexpr size_t R_CW = R_LIST + (size_t)16 * MTOK * 4;
constexpr size_t R_HID = R_CW + (size_t)16 * MTOK * 4;
constexpr size_t R_OUT2 = R_HID + (size_t)(2 * MTOK + 4096) * 512 * 2;
constexpr size_t R_MOE_END = R_OUT2 + (size_t)2 * MTOK * 1024 * 2;
constexpr size_t WS_T = WS_R + (((R_MIX_END > R_MOE_END ? R_MIX_END : R_MOE_END) + MiB - 1) / MiB) * MiB;
constexpr size_t WS_END = WS_T + (size_t)MTOK * 1024 * 2;

constexpr int CW_BAR = 4096;
constexpr int CW_CNT = 8192;
constexpr int CW_Q = 8448;
constexpr int CW_G = 65536;

__device__ __forceinline__ float bf2f(bf16_t v) { return __uint_as_float(((unsigned)v) << 16); }
__device__ __forceinline__ unsigned pk2(float lo, float hi) { f32x2 v = {lo, hi}; bf16x2_t b = __builtin_convertvector(v, bf16x2_t); return __builtin_bit_cast(unsigned, b); }
__device__ __forceinline__ bf16_t f2bf(float f) { return (bf16_t)(pk2(f, 0.f) & 0xffffu); }
__device__ __forceinline__ float ex2(float x) { return __builtin_amdgcn_exp2f(x); }
__device__ __forceinline__ float sigmoidf_(float x) { return __builtin_amdgcn_rcpf(1.0f + __expf(-x)); }
__device__ __forceinline__ float siluf_(float x) { return x * __builtin_amdgcn_rcpf(1.0f + __expf(-x)); }
__device__ __forceinline__ int crow(int r, int hi) { return (r & 3) + 8 * (r >> 2) + 4 * hi; }
template <int M> __device__ __forceinline__ float swz_xor(float v) { return __builtin_bit_cast(float, __builtin_amdgcn_ds_swizzle(__builtin_bit_cast(int, v), 0x1f | (M << 10))); }
template <int M> __device__ __forceinline__ unsigned swz_xor_u(unsigned v) { return (unsigned)__builtin_amdgcn_ds_swizzle((int)v, 0x1f | (M << 10)); }
__device__ __forceinline__ float x32_sum(float v) { auto r = __builtin_amdgcn_permlane32_swap(__float_as_uint(v), __float_as_uint(v), false, false); return __uint_as_float(r[0]) + __uint_as_float(r[1]); }
__device__ __forceinline__ float x32_max(float v) { auto r = __builtin_amdgcn_permlane32_swap(__float_as_uint(v), __float_as_uint(v), false, false); return fmaxf(__uint_as_float(r[0]), __uint_as_float(r[1])); }
__device__ __forceinline__ unsigned x32_or(unsigned v) { auto r = __builtin_amdgcn_permlane32_swap(v, v, false, false); return r[0] | r[1]; }
__device__ __forceinline__ float shfl_up_l(float v, int o, int lane) { return __builtin_bit_cast(float, __builtin_amdgcn_ds_bpermute((lane - o) << 2, __builtin_bit_cast(int, v))); }
__device__ __forceinline__ float wave_sum(float v) {
    v += swz_xor<1>(v); v += swz_xor<2>(v); v += swz_xor<4>(v); v += swz_xor<8>(v); v += swz_xor<16>(v);
    return x32_sum(v);
}
__device__ __forceinline__ float ninf_() { float z = -INFINITY; asm volatile("" : "+v"(z)); return z; }
__device__ __forceinline__ f32x16 z16() { float z = 0.f; asm volatile("" : "+v"(z)); f32x16 r;
#pragma unroll
    for (int i = 0; i < 16; ++i) r[i] = z;
    return r; }
#define VM_WAIT() asm volatile("s_waitcnt vmcnt(0)" ::: "memory")
#define MF32(a, b, c) __builtin_amdgcn_mfma_f32_32x32x16_bf16(a, b, c, 0, 0, 0)

#define XB_TMO      128
#define XB_XCNT(j)  (256  + 64 * (j))
#define XB_XSUB(j)  (1280 + 64 * (j))
#define XB_XGEN(j)  (2304 + 64 * (j))
#define XB_TOP      3328
#define XB_TOPGEN   3392
#define XCD_BAR_WORDS 3456
#define XB_SPIN_CAP (1u << 22)

__device__ __forceinline__ unsigned xb_ld(unsigned* p)              { return __hip_atomic_load(p, __ATOMIC_RELAXED, __HIP_MEMORY_SCOPE_AGENT); }
__device__ __forceinline__ unsigned xb_add(unsigned* p, unsigned v) { return __hip_atomic_fetch_add(p, v, __ATOMIC_RELAXED, __HIP_MEMORY_SCOPE_AGENT); }
__device__ __forceinline__ unsigned xb_xcc_id() { return (unsigned)__builtin_amdgcn_s_getreg((3 << 11) | 20) & 0xFu; }
#define XB_SPIN(cond, bar) do { unsigned _sp = 0; while (cond) { __builtin_amdgcn_s_sleep(1); \
    if ((++_sp & 255u) == 0u) { if (xb_ld(&(bar)[XB_TMO])) break; if (_sp > XB_SPIN_CAP) { atomicAdd(&(bar)[XB_TMO], 1u); break; } } } } while (0)

struct XcdBarrier { unsigned* bar; unsigned x; volatile LAS unsigned* st; };

__device__ __forceinline__ XcdBarrier xcd_barrier_post(unsigned* bar, volatile LAS unsigned* st, int tid) {
    XcdBarrier b; b.bar = bar; b.x = xb_xcc_id(); b.st = st;
    if (tid == 0) (void)xb_add(&bar[XB_XCNT(b.x)], 1u);
    return b;
}
__device__ __forceinline__ void xcd_barrier_complete(unsigned* bar, unsigned x, unsigned& nloc, unsigned& nx) {
    const unsigned G = NWG;
    unsigned sum, cnt, mine, sp = 0u;
    for (;;) {
        sum = 0u; cnt = 0u; mine = 0u;
#pragma unroll
        for (unsigned j = 0; j < 16; ++j) { const unsigned c = xb_ld(&bar[XB_XCNT(j)]); sum += c; cnt += (c > 0u) ? 1u : 0u; mine = (j == x) ? c : mine; }
        if (sum == G) break;
        __builtin_amdgcn_s_sleep(1);
        if ((++sp & 255u) == 0u) { if (xb_ld(&bar[XB_TMO])) break; if (sp > XB_SPIN_CAP) { atomicAdd(&bar[XB_TMO], 1u); break; } }
    }
    nloc = mine > 0u ? mine : 1u; nx = cnt > 0u ? cnt : 1u;
}
__device__ __forceinline__ void xcd_barrier(const XcdBarrier& b, int tid) {
    asm volatile("s_waitcnt vmcnt(0)" ::: "memory");
    __syncthreads();
    if (tid == 0) {
        unsigned* bar = b.bar;
        __builtin_amdgcn_s_waitcnt(0);
        unsigned nloc = b.st[0], nx = b.st[1];
        if (nloc == 0u) { xcd_barrier_complete(bar, b.x, nloc, nx); b.st[0] = nloc; b.st[1] = nx; }
        const unsigned old = xb_add(&bar[XB_XSUB(b.x)], 1u);
        const unsigned gen = old / nloc;
        if (old + 1u == (gen + 1u) * nloc) {
            __builtin_amdgcn_fence(__ATOMIC_RELEASE, "agent");
            asm volatile("s_waitcnt vmcnt(0)" ::: "memory");
            const unsigned og = xb_add(&bar[XB_TOP], 1u);
            const unsigned tg = og / nx;
            if (og + 1u == (tg + 1u) * nx) xb_add(&bar[XB_TOPGEN], 1u);
            else XB_SPIN(xb_ld(&bar[XB_TOPGEN]) == tg, bar);
            __builtin_amdgcn_fence(__ATOMIC_ACQUIRE, "agent");
            xb_add(&bar[XB_XGEN(b.x)], 1u);
            asm volatile("s_waitcnt vmcnt(0)" ::: "memory");
        } else {
            XB_SPIN(xb_ld(&bar[XB_XGEN(b.x)]) == gen, bar);
            __builtin_amdgcn_fence(__ATOMIC_ACQUIRE, "agent");
            asm volatile("s_waitcnt vmcnt(0)" ::: "memory");
        }
    }
    __syncthreads();
}

struct Params {
    const float* in[27];
    float* out;
    unsigned char* ws;
    int ph_lo, ph_hi;
};
__device__ __forceinline__ LAS unsigned char* lds_at(int off) { asm volatile("" : "+s"(off)); return (LAS unsigned char*)(unsigned)off; }
constexpr int LDS_PTAB = LDS_BYTES - 512;
__device__ __forceinline__ void ptab_store(const Params& p, int tid) {
    LAS unsigned long long* t = (LAS unsigned long long*)lds_at(LDS_PTAB);
    if (tid == 0) {
#pragma unroll
        for (int i = 0; i < 27; ++i) t[i] = (unsigned long long)p.in[i];
        t[27] = (unsigned long long)p.out; t[28] = (unsigned long long)p.ws; }
}
__device__ __forceinline__ unsigned long long ptab_get(int i) {
    const LAS unsigned* t = (const LAS unsigned*)lds_at(LDS_PTAB) + 2 * i;
    const unsigned lo = __builtin_amdgcn_readfirstlane(t[0]), hi = __builtin_amdgcn_readfirstlane(t[1]);
    return ((unsigned long long)hi << 32) | lo;
}
__device__ __forceinline__ unsigned char* ws_late() { return (unsigned char*)ptab_get(28); }
#define PIN(i) ((const float*)ptab_get(i))
__device__ __forceinline__ void ptab_load(Params& q) {
    asm volatile("" ::: "memory");
#pragma unroll
    for (int i = 0; i < 27; ++i) q.in[i] = (const float*)ptab_get(i);
    q.out = (float*)ptab_get(27); q.ws = (unsigned char*)ptab_get(28); q.ph_lo = 0; q.ph_hi = 0;
}

namespace pg8 {
constexpr int BM = 256, BK = 64, HALF = 128, HTB = HALF * BK * 2, NXCD = 8, WGM = 8;
__device__ __forceinline__ int lds_byte(int r, int c) { const int st = (r >> 4) * 2 + (c >> 5), rr = r & 15, cc = c & 31, ob = rr * 64 + cc * 2; return st * 1024 + (ob ^ (((ob >> 9) & 1) << 5)); }
__device__ __forceinline__ void stage_rc(int b, int& R, int& C) { const int st = b / 1024, sb = b % 1024, swz = sb ^ (((sb >> 9) & 1) << 5); R = (st >> 1) * 16 + swz / 64; C = (st & 1) * 32 + (swz % 64) / 2; }
__device__ __forceinline__ int perm32(int rho) { const int n = rho >> 4, i = rho & 15; return 8 * (i >> 2) + 4 * n + (i & 3); }

struct Unit { unsigned a, b, rows; int pm, pn, aux, nvalid; };

__device__ __forceinline__ bool dense_unit(int i, int G, int c, int nM, int nN, int& pm, int& pn) {
    const int nwg = nM * nN; const long L = (long)i * G + c; if (L >= nwg) return false;
    int wgid = (int)L; { const int q = nwg / NXCD, r = nwg % NXCD, xcd = wgid % NXCD, off = wgid / NXCD; wgid = (xcd < r ? xcd * (q + 1) : r * (q + 1) + (xcd - r) * q) + off; }
    const int nig = WGM * nN, gid = wgid / nig, fm = gid * WGM, gsz = (nM - fm) < WGM ? (nM - fm) : WGM;
    pm = fm + ((wgid % nig) % gsz); pn = (wgid % nig) / gsz; return true;
}

template <class Epi, class Sched, bool ALIGN_EPI, bool GATHER>
__device__ __forceinline__ void gemm_phase(LAS unsigned char* lds, const int K, const int lda, const int ldb, const Sched& S, const Epi& E, const int tid, const char* wsb) {
    const int wid = __builtin_amdgcn_readfirstlane(tid >> 6), lane = tid & 63, wr = wid >> 2, wc = wid & 3, fr = lane & 15, fq = lane >> 4;
    const int nt = K / BK;
    unsigned voffA[2], voffB[2]; int rA[2], cA2[2];
#pragma unroll
    for (int i = 0; i < 2; ++i) { int R, C; stage_rc(tid * 16 + i * 8192, R, C); const int Rb = Epi::PERM ? ((R & ~31) + perm32(R & 31)) : R;
        rA[i] = R; cA2[i] = C * 2; voffA[i] = (unsigned)(R * lda + C) * 2u; voffB[i] = (unsigned)(Rb * ldb + C) * 2u; }
    const unsigned kstep = (unsigned)(BK * 2);
    const unsigned hstepA = GATHER ? 0u : (unsigned)(HALF * lda * 2), hstepB = (unsigned)(HALF * ldb * 2);
    const unsigned ldsw = (unsigned)wid * 1024u;
    const int aoff = lds_byte(wr * 64 + fr, fq * 8), boff = lds_byte(wc * 32 + fr, fq * 8);
#define PG8_SA(b, h) (((b) * 2 + (h)) * HTB)
#define PG8_SB(b, h) ((4 + (b) * 2 + (h)) * HTB)
#define PG8_STAGE(bufoff, gbase, voff) do { _Pragma("unroll") for (int _i = 0; _i < 2; ++_i) \
        __builtin_amdgcn_global_load_lds((const unsigned*)(wsb + (size_t)(unsigned)((gbase) + (voff)[_i])), (LAS unsigned*)(lds + (bufoff) + ldsw + _i * 8192), 16, 0, 0); } while (0)
#define PG8_LDA(dst, b, h) do { _Pragma("unroll") for (int m = 0; m < 4; ++m) _Pragma("unroll") for (int k = 0; k < 2; ++k) dst[m][k] = *(const LAS bf16x8*)(lds + PG8_SA(b, h) + aoff + m * 2048 + k * 1024); } while (0)
#define PG8_LDB(dst, b, h) do { _Pragma("unroll") for (int n = 0; n < 2; ++n) _Pragma("unroll") for (int k = 0; k < 2; ++k) dst[n][k] = *(const LAS bf16x8*)(lds + PG8_SB(b, h) + boff + n * 2048 + k * 1024); } while (0)
#define PG8_MMA(ai, bj, At, Bt) do { __builtin_amdgcn_s_setprio(1); _Pragma("unroll") for (int m = 0; m < 4; ++m) _Pragma("unroll") for (int n = 0; n < 2; ++n) _Pragma("unroll") for (int k = 0; k < 2; ++k) \
        acc[ai][bj][m][n] = __builtin_amdgcn_mfma_f32_16x16x32_bf16(Bt[n][k], At[m][k], acc[ai][bj][m][n], 0, 0, 0); __builtin_amdgcn_s_setprio(0); } while (0)
#define PG8_WAIT_V(n) asm volatile("s_waitcnt vmcnt(" #n ")" ::: "memory")
#define PG8_WAIT_L(n) asm volatile("s_waitcnt lgkmcnt(" #n ")" ::: "memory")
#define PG8_BAR __builtin_amdgcn_s_barrier()
#define PG8_SCHED __builtin_amdgcn_sched_barrier(0)
    Unit cur, nxt; int ui = 0;
    S.begin(tid);
    if (!S.next(0, cur)) return;
    f32x4 acc[2][2][4][2];
#pragma unroll
    for (int a = 0; a < 2; ++a)
#pragma unroll
        for (int b = 0; b < 2; ++b)
#pragma unroll
            for (int m = 0; m < 4; ++m)
#pragma unroll
                for (int n = 0; n < 2; ++n) acc[a][b][m][n] = (f32x4){0.f, 0.f, 0.f, 0.f};
    bf16x8 At[4][2], B0[2][2], B1[2][2];
    unsigned cA = cur.a, cB = cur.b;
    LAS unsigned* grec = (LAS unsigned*)(lds + 131072) + tid * 8;
    if constexpr (GATHER) {
#pragma unroll
        for (int i = 0; i < 2; ++i) { const unsigned o0 = (unsigned)S.row(cur, rA[i]) * (unsigned)(lda * 2) + cA2[i], o1 = (unsigned)S.row(cur, HALF + rA[i]) * (unsigned)(lda * 2) + cA2[i];
            grec[i] = o0; grec[2 + i] = o1; grec[4 + i] = o0; grec[6 + i] = o1; }
    }
#define PG8_STAGE_A(bufoff, kptr, h, usenext) do { if constexpr (GATHER) { const u32x2 _w = *(const LAS u32x2*)(grec + ((usenext) ? 4 : 0) + 2 * (h)); unsigned _v[2]; _v[0] = _w.x; _v[1] = _w.y; PG8_STAGE(bufoff, kptr, _v); } \
        else { PG8_STAGE(bufoff, (kptr) + (h) * hstepA, voffA); } } while (0)
    PG8_STAGE(PG8_SB(0, 0), cB, voffB); PG8_STAGE(PG8_SB(0, 1), cB + hstepB, voffB); PG8_STAGE_A(PG8_SA(0, 0), cA, 0, false); PG8_STAGE_A(PG8_SA(0, 1), cA, 1, false);
    if (wr == 1) PG8_BAR;
    PG8_WAIT_V(2); PG8_BAR;
    PG8_STAGE(PG8_SB(1, 0), cB + kstep, voffB); PG8_STAGE_A(PG8_SA(1, 0), cA + kstep, 0, false); PG8_STAGE(PG8_SB(1, 1), cB + hstepB + kstep, voffB);
    PG8_WAIT_V(6); PG8_BAR;
    for (;;) {
        const bool has_next = S.next(ui + 1, nxt);
        const int tk_ = S.issue(tid, has_next);
        const unsigned nA = has_next ? nxt.a : cA, nB = has_next ? nxt.b : cB;
        for (int t = 0; t < nt; t += 2) {
            const bool last = (t == nt - 2);
            const unsigned a1 = cA + (unsigned)(t + 1) * kstep;
            const unsigned a2 = last ? nA : cA + (unsigned)(t + 2) * kstep, b2 = last ? nB : cB + (unsigned)(t + 2) * kstep;
            const unsigned a3 = a2 + kstep, b3 = b2 + kstep;
            if constexpr (GATHER) { if (last && has_next) {
#pragma unroll
                for (int i = 0; i < 2; ++i) { grec[4 + i] = (unsigned)S.row(nxt, rA[i]) * (unsigned)(lda * 2) + cA2[i]; grec[6 + i] = (unsigned)S.row(nxt, HALF + rA[i]) * (unsigned)(lda * 2) + cA2[i]; } } }
            PG8_LDB(B0, 0, 0); PG8_LDB(B1, 0, 1); PG8_SCHED; PG8_LDA(At, 0, 0); PG8_STAGE_A(PG8_SA(1, 1), a1, 1, false);
            PG8_WAIT_V(8); PG8_WAIT_L(0); PG8_BAR; PG8_MMA(0, 0, At, B0); PG8_MMA(0, 1, At, B1); PG8_BAR; PG8_SCHED;
            PG8_LDA(At, 0, 1); PG8_STAGE(PG8_SB(0, 0), b2, voffB); PG8_STAGE(PG8_SB(0, 1), b2 + hstepB, voffB); PG8_STAGE_A(PG8_SA(0, 0), a2, 0, last);
            PG8_WAIT_V(8); PG8_WAIT_L(0); PG8_BAR; PG8_MMA(1, 0, At, B0); PG8_MMA(1, 1, At, B1); PG8_BAR; PG8_SCHED;
            PG8_LDB(B0, 1, 0); PG8_LDB(B1, 1, 1); PG8_SCHED; PG8_LDA(At, 1, 0); PG8_STAGE_A(PG8_SA(0, 1), a2, 1, last);
            PG8_WAIT_V(8); PG8_WAIT_L(0); PG8_BAR; PG8_MMA(0, 0, At, B0); PG8_MMA(0, 1, At, B1); PG8_BAR; PG8_SCHED;
            PG8_LDA(At, 1, 1); PG8_STAGE(PG8_SB(1, 0), b3, voffB); PG8_STAGE(PG8_SB(1, 1), b3 + hstepB, voffB); PG8_STAGE_A(PG8_SA(1, 0), a3, 0, last);
            PG8_WAIT_V(8); PG8_WAIT_L(0); PG8_BAR; PG8_MMA(1, 0, At, B0); PG8_MMA(1, 1, At, B1); PG8_BAR; PG8_SCHED;
        }
        S.commit(tid, ui, tk_);
        if constexpr (ALIGN_EPI) { if (wr == 0) PG8_BAR; }
        { int tz = tid; asm volatile("" : "+v"(tz)); const int ew = __builtin_amdgcn_readfirstlane(tz >> 6), el = tz & 63;
          E(acc, cur, ew >> 2, ew & 3, el & 15, el >> 4); }
        if (!has_next) break;
#pragma unroll
        for (int a = 0; a < 2; ++a)
#pragma unroll
            for (int b = 0; b < 2; ++b)
#pragma unroll
                for (int m = 0; m < 4; ++m)
#pragma unroll
                    for (int n = 0; n < 2; ++n) acc[a][b][m][n] = (f32x4){0.f, 0.f, 0.f, 0.f};
        cur = nxt; cA = nA; cB = nB; ++ui;
        if constexpr (GATHER) { const u32x4 _n = *(const LAS u32x4*)(grec + 4); *(LAS u32x4*)grec = _n; }
        if constexpr (ALIGN_EPI) { if (wr == 1) PG8_BAR; }
    }
    PG8_WAIT_V(0);
    if constexpr (!ALIGN_EPI) { if (wr == 0) PG8_BAR; }
    PG8_BAR;
#undef PG8_SA
#undef PG8_SB
#undef PG8_STAGE
#undef PG8_STAGE_A
#undef PG8_LDA
#undef PG8_LDB
#undef PG8_MMA
#undef PG8_WAIT_V
#undef PG8_WAIT_L
#undef PG8_BAR
#undef PG8_SCHED
}
}
using pg8::Unit;

constexpr int LDS_TICK = 147456;
struct DenseSched {
    unsigned A, Bt, tA, tB, aBr; int nM, nN, G, c, pnShift; unsigned* ctr;
    __device__ __forceinline__ void begin(int tid) const { volatile LAS int* tk = (volatile LAS int*)lds_at(LDS_TICK);
        __syncthreads();
        if (tid == 0) { const int t0 = (int)__hip_atomic_fetch_add(ctr, 1u, __ATOMIC_RELAXED, __HIP_MEMORY_SCOPE_AGENT), t1 = (int)__hip_atomic_fetch_add(ctr, 1u, __ATOMIC_RELAXED, __HIP_MEMORY_SCOPE_AGENT); tk[0] = t0; tk[1] = t1; }
        __syncthreads(); }
    __device__ __forceinline__ int issue(int tid, bool more) const { int t = 0x3fffffff; if (tid == 0 && more) t = (int)__hip_atomic_fetch_add(ctr, 1u, __ATOMIC_RELAXED, __HIP_MEMORY_SCOPE_AGENT); return t; }
    __device__ __forceinline__ void commit(int tid, int ui, int t) const { if (tid == 0) { volatile LAS int* tk = (volatile LAS int*)lds_at(LDS_TICK); tk[ui & 1] = t; asm volatile("s_waitcnt vmcnt(0) lgkmcnt(0)" ::: "memory"); } }
    __device__ __forceinline__ bool next(int i, Unit& u) const {
        const int L = __builtin_amdgcn_readfirstlane(((volatile LAS int*)lds_at(LDS_TICK))[i & 1]);
        int pm, pn; if (L < 0 || L >= nM * nN || !pg8::dense_unit(0, 1, L, nM, nN, pm, pn)) return false;
        u.pm = pm; u.pn = pn; u.aux = 0; u.nvalid = 256; u.rows = 0u;
        u.a = A + (unsigned)(pn >> pnShift) * aBr + (unsigned)pm * tA; u.b = Bt + (unsigned)pn * tB; return true;
    }
    __device__ __forceinline__ int row(const Unit&, int) const { return 0; }
};
struct OneSched {
    Unit u0; bool has;
    __device__ __forceinline__ void begin(int) const {}
    __device__ __forceinline__ int issue(int, bool) const { return 0; }
    __device__ __forceinline__ void commit(int, int, int) const {}
    __device__ __forceinline__ bool next(int i, Unit& u) const { if (i > 0 || !has) return false; u = u0; return true; }
    __device__ __forceinline__ int row(const Unit&, int) const { return 0; }
};
struct MoeSched {
    const LAS int* pre;
    const LAS int* cnt;
    const char* wsb;
    unsigned A, W, wE, wT, aT; int G, c; bool gatherA; unsigned* ctr;
    __device__ __forceinline__ void begin(int tid) const { volatile LAS int* tk = (volatile LAS int*)lds_at(LDS_TICK);
        __syncthreads();
        if (tid == 0) { const int t0 = (int)__hip_atomic_fetch_add(ctr, 1u, __ATOMIC_RELAXED, __HIP_MEMORY_SCOPE_AGENT), t1 = (int)__hip_atomic_fetch_add(ctr, 1u, __ATOMIC_RELAXED, __HIP_MEMORY_SCOPE_AGENT); tk[0] = t0; tk[1] = t1; }
        __syncthreads(); }
    __device__ __forceinline__ int issue(int tid, bool more) const { int t = 0x3fffffff; if (tid == 0 && more) t = (int)__hip_atomic_fetch_add(ctr, 1u, __ATOMIC_RELAXED, __HIP_MEMORY_SCOPE_AGENT); return t; }
    __device__ __forceinline__ void commit(int tid, int ui, int t) const { if (tid == 0) { volatile LAS int* tk = (volatile LAS int*)lds_at(LDS_TICK); tk[ui & 1] = t; asm volatile("s_waitcnt vmcnt(0) lgkmcnt(0)" ::: "memory"); } }
    __device__ __forceinline__ bool next(int i, Unit& u) const {
        const int L = __builtin_amdgcn_readfirstlane(((volatile LAS int*)lds_at(LDS_TICK))[i & 1]); const int total = pre[16] * 4; if (L < 0 || L >= total) return false;
        const int t = (int)(L >> 2), pn = (int)(L & 3); int e = 0;
#pragma unroll
        for (int j = 1; j < 16; ++j) e += (pre[j] <= t) ? 1 : 0;
        const int pm = t - pre[e];
        u.aux = e; u.pm = t; u.pn = pn; u.nvalid = min(256, cnt[e] - 256 * pm); u.rows = (unsigned)(WS_R + R_LIST) + (unsigned)(e * MTOK + 256 * pm) * 4u;
        u.a = gatherA ? A : A + (unsigned)t * aT; u.b = W + (unsigned)e * wE + (unsigned)pn * wT; return true;
    }
    __device__ __forceinline__ int row(const Unit& u, int R) const { return (R < u.nvalid) ? (((const int*)(wsb + u.rows))[R] >> 1) : 0; }
};

typedef f32x4 Acc[2][2][4][2];
#define EPI_LOOP_AIM _Pragma("unroll") for (int ai = 0; ai < 2; ++ai) _Pragma("unroll") for (int m = 0; m < 4; ++m)
__device__ __forceinline__ u32x4 pack8(const f32x4& a, const f32x4& b) { u32x4 w; w.x = pk2(a[0], a[1]); w.y = pk2(a[2], a[3]); w.z = pk2(b[0], b[1]); w.w = pk2(b[2], b[3]); return w; }

struct EpiProj {
    static constexpr bool PERM = true;
    __device__ __forceinline__ void operator()(const Acc& acc, const Unit& u, int wr, int wc, int fr, int fq) const {
        unsigned char* ws = ws_late(); bf16_t* proj = (bf16_t*)(ws + WS_R + R_PROJ); bf16_t* nkv = (bf16_t*)(ws + WS_R + R_NKV); float* sm = (float*)(ws + WS_R + R_SM);
        const int row0 = u.pm * 256 + wr * 64 + fr;
        if (u.pn < 12) {
            const float sc = (u.pn == 8 || u.pn == 9) ? QSCALE : (u.pn == 5 ? 0.125f : 1.0f);
            const int col0 = u.pn * 256 + wc * 32 + 8 * fq;
            EPI_LOOP_AIM { bf16_t* rp = proj + (size_t)(row0 + ai * 128 + m * 16) * PROJW + col0;
#pragma unroll
                for (int bj = 0; bj < 2; ++bj) *(u32x4*)(rp + bj * 128) = pack8(acc[ai][bj][m][0] * sc, acc[ai][bj][m][1] * sc); }
        } else {
#pragma unroll
            for (int bj = 0; bj < 2; ++bj) {
                if (u.pn == 12 || bj == 0) {
                    const int seg = (u.pn - 12) * 4 + bj * 2 + (wc >> 1), col = 32 * (wc & 1) + 8 * fq;
                    bf16_t* base = nkv + (size_t)seg * (NKV_SEG / 2) + col;
                    EPI_LOOP_AIM { *(u32x4*)(base + (size_t)(row0 + ai * 128 + m * 16) * 64) = pack8(acc[ai][bj][m][0], acc[ai][bj][m][1]); }
                } else if (wc == 0 && fq < 3) {
                    EPI_LOOP_AIM { float* sp = sm + (size_t)(row0 + ai * 128 + m * 16) * 32 + 8 * fq; *(f32x4*)sp = acc[ai][bj][m][0]; *(f32x4*)(sp + 4) = acc[ai][bj][m][1]; }
                }
            }
        }
    }
};
struct EpiH1 {
    static constexpr bool PERM = true;
    bf16_t* h1; const float* cbias;
    __device__ __forceinline__ void operator()(const Acc& acc, const Unit& u, int wr, int wc, int fr, int fq) const {
        const int which = u.aux, rl0 = wr * 64 + fr;
        bf16_t* base = h1 + ((size_t)which * BC * 256 + (size_t)u.pm * 256) * 256;
        const float* bp = cbias + which * 256;
#pragma unroll
        for (int bj = 0; bj < 2; ++bj) { const int col = bj * 128 + wc * 32 + 8 * fq; const f32x4 b0 = *(const f32x4*)(bp + col), b1 = *(const f32x4*)(bp + col + 4);
            EPI_LOOP_AIM { const int rl = rl0 + ai * 128 + m * 16; f32x4 v0 = acc[ai][bj][m][0] + b0, v1 = acc[ai][bj][m][1] + b1;
#pragma unroll
                for (int e = 0; e < 4; ++e) { v0[e] = (rl < 255) ? siluf_(v0[e]) : 0.f; v1[e] = (rl < 255) ? siluf_(v1[e]) : 0.f; }
                *(u32x4*)(base + (size_t)rl * 256 + col) = pack8(v0, v1); } }
    }
};
struct EpiCmp2 {
    static constexpr bool PERM = true;
    bf16_t* kc;
    __device__ __forceinline__ void operator()(const Acc& acc, const Unit& u, int wr, int wc, int fr, int fq) const {
        if (wc >= 2) return;
        const int col = wc * 32 + 8 * fq; bf16_t* base = kc + ((size_t)u.aux * BC + u.pm) * 256 * 64 + col;
        EPI_LOOP_AIM { const int rl = wr * 64 + fr + ai * 128 + m * 16; *(u32x4*)(base + (size_t)rl * 64) = pack8(acc[ai][0][m][0], acc[ai][0][m][1]); }
    }
};
struct EpiP {
    static constexpr bool PERM = true;
    __device__ __forceinline__ void operator()(const Acc& acc, const Unit& u, int wr, int wc, int fr, int fq) const {
        const int i = u.pn >> 2, pt = u.pn & 3, row0 = u.pm * 256 + wr * 64 + fr, col0 = 256 * pt + 32 * wc + 8 * fq;
        bf16_t* P = (bf16_t*)(ws_late() + WS_R + R_P) + (size_t)i * MC * 1024;
        EPI_LOOP_AIM { bf16_t* rp = P + (unsigned)((row0 + ai * 128 + m * 16) * 1024 + col0);
#pragma unroll
            for (int bj = 0; bj < 2; ++bj) *(u32x4*)(rp + bj * 128) = pack8(acc[ai][bj][m][0], acc[ai][bj][m][1]); }
    }
};
struct EpiGate {
    static constexpr bool PERM = true;
    __device__ __forceinline__ void operator()(const Acc& acc, const Unit& u, int wr, int wc, int fr, int fq) const {
        unsigned char* ws = ws_late(); const bf16_t* P = (const bf16_t*)(ws + WS_R + R_P); bf16_t* y = (bf16_t*)(ws + WS_R + R_Y);
        const int row0 = u.pm * 256 + wr * 64 + fr, oc = 64 * u.pn + 16 * wc + 4 * fq;
#pragma unroll
        for (int ai = 0; ai < 2; ++ai)
#pragma unroll
            for (int mh = 0; mh < 2; ++mh) {
                u32x2 pw[2][4];
#pragma unroll
                for (int mm = 0; mm < 2; ++mm) { const unsigned r = (unsigned)(row0 + ai * 128 + (2 * mh + mm) * 16);
#pragma unroll
                    for (int i = 0; i < 4; ++i) pw[mm][i] = *(const u32x2*)(P + ((size_t)i * MC * 1024 + r * 1024u + (unsigned)oc)); }
#pragma unroll
                for (int mm = 0; mm < 2; ++mm) { const int m = 2 * mh + mm; const unsigned r = (unsigned)(row0 + ai * 128 + m * 16);
                    f32x4 s = {0.f, 0.f, 0.f, 0.f};
#pragma unroll
                    for (int bj = 0; bj < 2; ++bj)
#pragma unroll
                        for (int n = 0; n < 2; ++n) { const u32x2 pq = pw[mm][2 * bj + n]; const f32x4 a = acc[ai][bj][m][n];
                            s[0] += sigmoidf_(a[0]) * __uint_as_float(pq.x << 16); s[1] += sigmoidf_(a[1]) * __uint_as_float(pq.x & 0xffff0000u);
                            s[2] += sigmoidf_(a[2]) * __uint_as_float(pq.y << 16); s[3] += sigmoidf_(a[3]) * __uint_as_float(pq.y & 0xffff0000u); }
                    u32x2 w; w.x = pk2(s[0], s[1]); w.y = pk2(s[2], s[3]); *(u32x2*)(y + (r * 1024u + (unsigned)oc)) = w; }
            }
    }
};
struct EpiOut {
    static constexpr bool PERM = true;
    int row_base;
    __device__ __forceinline__ void operator()(const Acc& acc, const Unit& u, int wr, int wc, int fr, int fq) const {
        bf16_t* T = (bf16_t*)(ws_late() + WS_T);
        const int rg0 = row_base + u.pm * 256 + wr * 64 + fr, col0 = u.pn * 256 + wc * 32 + 8 * fq;
        EPI_LOOP_AIM { bf16_t* rp = T + (size_t)(rg0 + ai * 128 + m * 16) * 1024 + col0;
#pragma unroll
            for (int bj = 0; bj < 2; ++bj) *(u32x4*)(rp + bj * 128) = pack8(acc[ai][bj][m][0], acc[ai][bj][m][1]); }
    }
};
struct EpiMoe1 {
    static constexpr bool PERM = true;
    __device__ __forceinline__ void operator()(const Acc& acc, const Unit& u, int wr, int wc, int fr, int fq) const {
        const int rl0 = wr * 64 + fr, f0 = 128 * u.pn + 32 * wc + 8 * fq;
        bf16_t* hid = (bf16_t*)(ws_late() + WS_R + R_HID);
        EPI_LOOP_AIM { const int rl = rl0 + ai * 128 + m * 16;
            f32x4 a0 = acc[ai][0][m][0], a1 = acc[ai][0][m][1]; const f32x4 b0 = acc[ai][1][m][0], b1 = acc[ai][1][m][1];
#pragma unroll
            for (int e = 0; e < 4; ++e) { a0[e] = siluf_(a0[e]) * b0[e]; a1[e] = siluf_(a1[e]) * b1[e]; }
            *(u32x4*)(hid + (unsigned)((u.pm * 256 + rl) * 512 + f0)) = pack8(a0, a1); __builtin_amdgcn_sched_barrier(0); }
    }
};
struct EpiMoe2 {
    static constexpr bool PERM = true;
    __device__ __forceinline__ void operator()(const Acc& acc, const Unit& u, int wr, int wc, int fr, int fq) const {
        unsigned char* ws = ws_late(); bf16_t* out2 = (bf16_t*)(ws + WS_R + R_OUT2);
        const float* cwb = (const float*)(ws + (R_CW - R_LIST) + u.rows); const int* rws = (const int*)(ws + u.rows);
        const int rl0 = wr * 64 + fr, c0 = 256 * u.pn + 32 * wc + 8 * fq;
        EPI_LOOP_AIM { const int rl = rl0 + ai * 128 + m * 16;
            if (rl < u.nvalid) { const unsigned v = (unsigned)rws[rl]; const float wgt = cwb[rl]; bf16_t* rp = out2 + (size_t)v * 1024 + c0;
#pragma unroll
                for (int bj = 0; bj < 2; ++bj) *(u32x4*)(rp + bj * 128) = pack8(acc[ai][bj][m][0] * wgt, acc[ai][bj][m][1] * wgt); } }
    }
};

enum { IN_X = 0, IN_C, IN_POS, IN_ADAW, IN_ADAB, IN_WIN, IN_CONVW, IN_ALOG, IN_DTB, IN_GNORM, IN_RETGN, IN_PE, IN_CKW1, IN_CKW2, IN_CVW1, IN_CVW2, IN_FBIAS,
       IN_BP, IN_WG, IN_WO, IN_LNG, IN_LNB, IN_RW, IN_RB, IN_EW1, IN_EW3, IN_EW2 };

__device__ __forceinline__ void p0_ada(const Params& p, int item, LAS float* lf, const int tid) {
    LAS float* sc = lf; LAS float* red = lf + 16384;
    const float* c = PIN(IN_C);
    for (int i = tid; i < 16384; i += NTHR) sc[i] = siluf_(c[i]);
    __syncthreads();
    const int ls = item / 48, cb = item % 48, col = cb * 64 + (tid & 63), ks = tid >> 6;
    const float* w = PIN(IN_ADAW) + (size_t)ls * 1024 * 3072 + col;
    float acc[16];
#pragma unroll
    for (int b = 0; b < 16; ++b) acc[b] = 0.f;
    for (int k0 = ks * 128; k0 < ks * 128 + 128; k0 += 16) { float wv[16];
#pragma unroll
        for (int kk = 0; kk < 16; ++kk) wv[kk] = w[(size_t)(k0 + kk) * 3072];
#pragma unroll
        for (int kk = 0; kk < 16; ++kk)
#pragma unroll
            for (int b = 0; b < 16; ++b) acc[b] += sc[b * 1024 + k0 + kk] * wv[kk]; }
#pragma unroll
    for (int b = 0; b < 16; ++b) red[(ks * 16 + b) * 64 + (tid & 63)] = acc[b];
    __syncthreads();
    float* mod = (float*)(p.ws + WS_MOD);
    for (int o = tid; o < 1024; o += NTHR) { const int b = o >> 6, cc = o & 63; float s = 0.f;
#pragma unroll
        for (int q = 0; q < 8; ++q) s += red[(q * 16 + b) * 64 + cc];
        mod[((size_t)ls * 16 + b) * 3072 + cb * 64 + cc] = s + PIN(IN_ADAB)[ls * 3072 + cb * 64 + cc]; }
    __syncthreads();
}
__device__ __forceinline__ void p0_rope(const Params& p, int item, const int tid) {
    const int* pos = (const int*)PIN(IN_POS); f32x2* tab = (f32x2*)(p.ws + WS_ROPE);
#pragma unroll
    for (int j = 0; j < 8; ++j) { const int idx = item * 4096 + j * 512 + tid; const int m = idx >> 5, i = idx & 31;
        const float inv = powf(10000.0f, -(float)i / 32.0f); const float ang = (float)pos[m] * inv;
        const float n = rintf(ang * 0.6366197723675814f);
        float r = fmaf(n, -1.5703125f, ang); r = fmaf(n, -4.837512969970703125e-4f, r); r = fmaf(n, -7.54978995489188e-8f, r);
        const float s = sinf(r), cs = cosf(r); const int q = ((int)n) & 3;
        float so, co; if (q == 0) { so = s; co = cs; } else if (q == 1) { so = cs; co = -s; } else if (q == 2) { so = -s; co = -cs; } else { so = -cs; co = s; }
        tab[idx] = (f32x2){co, so}; }
}
__device__ __forceinline__ void p0_cbias(const Params& p, int item, const int tid) {
    const int l = item >> 1, which = item & 1;
    if (tid < 256) { const float* pe = PIN(IN_PE) + (size_t)l * 2048; const float* w1 = PIN(which ? IN_CVW1 : IN_CKW1) + (size_t)l * 2048 * 256 + tid;
        float s = 0.f; for (int k = 0; k < 2048; ++k) s += pe[k] * w1[(size_t)k * 256];
        ((float*)(p.ws + WS_CBIAS))[item * 256 + tid] = s; }
}
struct TJob { bf16_t* dst; int K, nrt, nkt; };
constexpr int TJ_TILES[8] = {56 * 16, 64 * 16, 64 * 4, 16 * 16, 256 * 16, 256 * 8, 8 * 32, 8 * 4};
constexpr int TJ_TOTAL = 56 * 16 + 64 * 16 + 64 * 4 + 16 * 16 + 256 * 16 + 256 * 8 + 8 * 32 + 8 * 4;
__device__ __forceinline__ int win_src_col(int pc) {
    if (pc < 768) return pc;
    if (pc < 1024) return pc - 768 + 776;
    if (pc < 2048) return pc - 1024 + 1032;
    if (pc < 2304) return pc - 2048 + 2056;
    if (pc < 3072) return pc - 2304 + 2708;
    if (pc < 3456) return pc - 3072 + 2312;
    if (pc < 3464) return pc - 3456 + 768;
    if (pc < 3476) return pc - 3464 + 2696;
    if (pc < 3480) return pc - 3476 + 3476;
    return -1;
}
__device__ __forceinline__ const float* tj_src(const Params& p, int l, int job, int n, int& pitch) {
    switch (job) {
    case 0: { pitch = 3480; const int c = win_src_col(n); return c < 0 ? nullptr : PIN(IN_WIN) + (size_t)l * 1024 * 3480 + c; }
    case 1: { pitch = 1024; const int i = 2 * ((n >> 7) & 1) + ((n >> 2) & 1), c = 64 * (n >> 8) + 16 * ((n >> 5) & 3) + 4 * ((n >> 3) & 3) + (n & 3);
              return PIN(IN_WG) + ((size_t)l * 4 + i) * 1024 * 1024 + c; }
    case 2: { pitch = 1024; const int i = n >> 10, c = n & 1023; return PIN(IN_BP) + ((size_t)l * 4 + i) * 256 * 1024 + c; }
    case 3: { pitch = 1024; return PIN(IN_WO) + (size_t)l * 1024 * 1024 + n; }
    case 4: { pitch = 512; const int e = n >> 10, vr = n & 1023, f = 128 * (vr >> 8) + (vr & 127); return PIN(((vr >> 7) & 1) ? IN_EW3 : IN_EW1) + ((size_t)l * 16 + e) * 1024 * 512 + f; }
    case 5: { pitch = 1024; const int e = n >> 10, c = n & 1023; return PIN(IN_EW2) + ((size_t)l * 16 + e) * 512 * 1024 + c; }
    case 6: { pitch = 256; const int which = n >> 8, c = n & 255; return PIN(which ? IN_CVW1 : IN_CKW1) + (size_t)l * 2048 * 256 + c; }
    default: { pitch = 64; const int which = n >> 8, r = n & 255; return r < 64 ? PIN(which ? IN_CVW2 : IN_CKW2) + (size_t)l * 256 * 64 + r : nullptr; }
    }
}
struct TDesc { const float* src; bf16_t* dst; int pitch, K, rt, kt; };
__device__ __forceinline__ void tj_decode(const Params& p, int item, int tx, TDesc& d) {
    const int l = item / TJ_TOTAL; int t = item % TJ_TOTAL, job = 0;
#pragma unroll
    for (int j = 0; j < 8; ++j) { if (job == j && t >= TJ_TILES[j]) { t -= TJ_TILES[j]; job = j + 1; } }
    const size_t lw = WS_W + (size_t)l * ((LW_BYTES + MiB - 1) / MiB) * MiB;
    const size_t offs[8] = {LW_WIN, LW_WGV, LW_BPT, LW_WOT, LW_W13, LW_W2, LW_CW1, LW_CW2};
    const int Ks[8] = {1024, 1024, 256, 1024, 1024, 512, 2048, 256};
    size_t off = 0; int K = 0;
#pragma unroll
    for (int j = 0; j < 8; ++j) if (job == j) { off = offs[j]; K = Ks[j]; }
    d.dst = (bf16_t*)(p.ws + lw + off); d.K = K;
    const int nkt = K / 64; d.rt = t / nkt; d.kt = t % nkt;
    d.src = tj_src(p, l, job, d.rt * 64 + tx, d.pitch);
}
__device__ __forceinline__ void p0_transpose4(const Params& p, int it, int G, int end, LAS float* tiles, const int tid) {
    const int tx = tid & 63, ty = tid >> 6; float v[4][8]; TDesc d[4];
#pragma unroll
    for (int q = 0; q < 4; ++q) { const int item = it + q * G; if (item < end) { tj_decode(p, item, tx, d[q]);
#pragma unroll
            for (int kk = 0; kk < 8; ++kk) v[q][kk] = d[q].src ? d[q].src[(size_t)(d[q].kt * 64 + ty + 8 * kk) * d[q].pitch] : 0.f; } }
#pragma unroll
    for (int q = 0; q < 4; ++q) { if (it + q * G < end) {
#pragma unroll
            for (int kk = 0; kk < 8; ++kk) tiles[q * 4160 + (ty + 8 * kk) * 65 + tx] = v[q][kk]; } }
    __syncthreads();
    const int r = tid >> 3, sg = tid & 7;
#pragma unroll
    for (int q = 0; q < 4; ++q) { if (it + q * G < end) { f32x4 a, b;
#pragma unroll
            for (int j = 0; j < 4; ++j) { a[j] = tiles[q * 4160 + (sg * 8 + j) * 65 + r]; b[j] = tiles[q * 4160 + (sg * 8 + 4 + j) * 65 + r]; }
            *(u32x4*)(d[q].dst + (size_t)(d[q].rt * 64 + r) * d[q].K + d[q].kt * 64 + sg * 8) = pack8(a, b); } }
    __syncthreads();
}

struct RowV { f32x4 v[4]; };
__device__ __forceinline__ void row_load(RowV& r, const float* src, int lane) {
#pragma unroll
    for (int j = 0; j < 4; ++j) r.v[j] = *(const f32x4*)(src + 4 * lane + 256 * j);
}
__device__ __forceinline__ void row_stats(const RowV& r, float& mean, float& rstd) {
    float s = 0.f;
#pragma unroll
    for (int j = 0; j < 4; ++j) s += (r.v[j][0] + r.v[j][1]) + (r.v[j][2] + r.v[j][3]);
    mean = wave_sum(s) * (1.0f / 1024.0f);
    float q = 0.f;
#pragma unroll
    for (int j = 0; j < 4; ++j) { const f32x4 d = r.v[j] - mean; q += (d[0] * d[0] + d[1] * d[1]) + (d[2] * d[2] + d[3] * d[3]); }
    rstd = 1.0f / sqrtf(wave_sum(q) * (1.0f / 1024.0f) + LN_EPS);
}
__device__ __forceinline__ void row_ln(RowV& r, float mean, float rstd, const float* g, const float* b, int lane) {
#pragma unroll
    for (int j = 0; j < 4; ++j) { const f32x4 gg = *(const f32x4*)(g + 4 * lane + 256 * j), bb = *(const f32x4*)(b + 4 * lane + 256 * j); r.v[j] = (r.v[j] - mean) * rstd * gg + bb; }
}
__device__ __forceinline__ void row_mod(RowV& h, const RowV& x, const float* mod, int lane) {
#pragma unroll
    for (int j = 0; j < 4; ++j) { const f32x4 sh = *(const f32x4*)(mod + 4 * lane + 256 * j), sc = *(const f32x4*)(mod + 1024 + 4 * lane + 256 * j); h.v[j] = x.v[j] * (sc + 1.0f) + sh; }
}
__device__ __forceinline__ void row_store_bf16(const RowV& h, bf16_t* dst, int lane) {
#pragma unroll
    for (int j = 0; j < 4; ++j) { u32x2 w; w.x = pk2(h.v[j][0], h.v[j][1]); w.y = pk2(h.v[j][2], h.v[j][3]); *(u32x2*)(dst + 4 * lane + 256 * j) = w; }
}
__device__ __forceinline__ void vec_load(RowV& v, const float* src, int lane) {
#pragma unroll
    for (int j = 0; j < 4; ++j) v.v[j] = *(const f32x4*)(src + 4 * lane + 256 * j);
}
__device__ __forceinline__ void row_ln_r(RowV& r, float mean, float rstd, const RowV& g, const RowV& b) {
#pragma unroll
    for (int j = 0; j < 4; ++j) r.v[j] = (r.v[j] - mean) * rstd * g.v[j] + b.v[j];
}
__device__ __forceinline__ void row_mod_r(RowV& h, const RowV& x, const RowV& sh, const RowV& sc1) {
#pragma unroll
    for (int j = 0; j < 4; ++j) h.v[j] = x.v[j] * sc1.v[j] + sh.v[j];
}
__device__ __forceinline__ void vec_add1(RowV& v) {
#pragma unroll
    for (int j = 0; j < 4; ++j) v.v[j] = v.v[j] + 1.0f;
}
__device__ __forceinline__ void prep_first(const Params& p, const int tid, const int blk) {
    const int lane = tid & 63, wv = tid >> 6; const float* x = p.in[IN_X]; bf16_t* H = (bf16_t*)(p.ws + WS_H); const float* mod = (const float*)(p.ws + WS_MOD);
    const int row0 = (blk * 8 + wv) * 32;
    RowV sh, sc1; vec_load(sh, mod + (size_t)(row0 >> 12) * 3072, lane); vec_load(sc1, mod + (size_t)(row0 >> 12) * 3072 + 1024, lane); vec_add1(sc1);
    RowV cur; row_load(cur, x + (size_t)row0 * 1024, lane);
    for (int i = 0; i < 32; ++i) { const int row = row0 + i; RowV nx; if (i + 1 < 32) row_load(nx, x + (size_t)(row + 1) * 1024, lane);
        RowV h; row_mod_r(h, cur, sh, sc1); row_store_bf16(h, H + (size_t)row * 1024, lane); cur = nx; }
}
__device__ __forceinline__ void row_load_t(u32x2 (&t)[4], const bf16_t* src, int lane) {
#pragma unroll
    for (int j = 0; j < 4; ++j) t[j] = *(const u32x2*)(src + 4 * lane + 256 * j);
}
__device__ __forceinline__ void prep_moe(const Params& p, int l, LAS float* rwl, const int tid, const int blk) {
    const int lane = tid & 63, wv = tid >> 6;
    { const float* rw = p.in[IN_RW]; for (int i = tid; i < 16384; i += NTHR) { const int c = i >> 4, e = i & 15, ln = (c & 255) >> 2, q = c & 3, j = c >> 8;
        rwl[((((j * 4 + q) * 4 + (e >> 2)) * 64 + ln) << 2) + (e & 3)] = rw[i]; } }
    __syncthreads();
    const float* xin = (l == 0) ? p.in[IN_X] : p.out; float* z = p.out; bf16_t* H = (bf16_t*)(p.ws + WS_H); const bf16_t* T = (const bf16_t*)(p.ws + WS_T);
    const float* modg = (const float*)(p.ws + WS_MOD) + (size_t)(l * 2) * 16 * 3072; const float* mod = (const float*)(p.ws + WS_MOD) + (size_t)(l * 2 + 1) * 16 * 3072;
    f32x2* stats = (f32x2*)(p.ws + WS_STATS); const float* g = p.in[IN_LNG] + (size_t)(l * 2) * 1024; const float* bb = p.in[IN_LNB] + (size_t)(l * 2) * 1024;
    const float* gp = p.in[IN_LNG] + (size_t)((l > 0 ? l - 1 : 0) * 2 + 1) * 1024; const float* bp = p.in[IN_LNB] + (size_t)((l > 0 ? l - 1 : 0) * 2 + 1) * 1024;
    unsigned* cnt = (unsigned*)(p.ws + WS_CTL) + CW_CNT + l * 64; int* list = (int*)(p.ws + WS_R + R_LIST); float* cw = (float*)(p.ws + WS_R + R_CW);
    const float* rb = p.in[IN_RB];
    LAS unsigned* lcnt = (LAS unsigned*)(rwl + 16384); LAS unsigned* lbase = lcnt + 16; LAS unsigned* lrec = lcnt + 32;
    if (tid < 16) lcnt[tid] = 0u;
    __syncthreads();
    const int row0 = (blk * 8 + wv) * 32; int it_ = 0;
    RowV vgp, vbp, vg, vb, vgate, vsh, vsc1;
    vec_load(vgp, gp, lane); vec_load(vbp, bp, lane); vec_load(vg, g, lane); vec_load(vb, bb, lane);
    vec_load(vgate, modg + (size_t)(row0 >> 12) * 3072 + 2048, lane); vec_load(vsh, mod + (size_t)(row0 >> 12) * 3072, lane); vec_load(vsc1, mod + (size_t)(row0 >> 12) * 3072 + 1024, lane); vec_add1(vsc1);
    int row = row0;
    RowV cur; u32x2 tc[4]; row_load(cur, xin + (size_t)row * 1024, lane); row_load_t(tc, T + (size_t)row * 1024, lane);
    for (; row < row0 + 32; ++row) {
        const int nrow = row + 1; RowV nx; u32x2 tn[4];
        if (nrow < row0 + 32) { row_load(nx, xin + (size_t)nrow * 1024, lane); row_load_t(tn, T + (size_t)nrow * 1024, lane); }
        RowV r = cur, h;
        if (l > 0) { const f32x2 st = stats[row]; row_ln_r(r, st.x, st.y, vgp, vbp); }
        {
#pragma unroll
          for (int j = 0; j < 4; ++j) { const f32x4 gt = vgate.v[j];
              f32x4 y; y[0] = __uint_as_float(tc[j].x << 16); y[1] = __uint_as_float(tc[j].x & 0xffff0000u); y[2] = __uint_as_float(tc[j].y << 16); y[3] = __uint_as_float(tc[j].y & 0xffff0000u);
              r.v[j] = r.v[j] * DN_ALPHA + gt * y; *(f32x4*)(z + (size_t)row * 1024 + 4 * lane + 256 * j) = r.v[j]; } }
        float mean, rstd; row_stats(r, mean, rstd); if (lane == 0) stats[row] = (f32x2){mean, rstd};
        row_ln_r(r, mean, rstd, vg, vb); row_mod_r(h, r, vsh, vsc1); row_store_bf16(h, H + (size_t)row * 1024, lane);
        float a[16];
#pragma unroll
        for (int e = 0; e < 16; ++e) a[e] = 0.f;
#pragma unroll
        for (int j = 0; j < 4; ++j)
#pragma unroll
            for (int q = 0; q < 4; ++q) { const float hv = h.v[j][q]; const LAS float* wp = rwl + (((j * 4 + q) * 4) * 64 + lane) * 4;
                const f32x4 w0 = *(const LAS f32x4*)wp, w1 = *(const LAS f32x4*)(wp + 256), w2 = *(const LAS f32x4*)(wp + 512), w3 = *(const LAS f32x4*)(wp + 768);
#pragma unroll
                for (int e = 0; e < 4; ++e) { a[e] += hv * w0[e]; a[4 + e] += hv * w1[e]; a[8 + e] += hv * w2[e]; a[12 + e] += hv * w3[e]; }
                __builtin_amdgcn_sched_barrier(0); }
#pragma unroll
        for (int e = 0; e < 16; ++e) a[e] = wave_sum(a[e]);
        float sc[16], bi[16];
#pragma unroll
        for (int e = 0; e < 16; ++e) { sc[e] = sigmoidf_(a[e]); bi[e] = sc[e] + rb[e]; }
        int grp = 0; float best = -INFINITY;
#pragma unroll
        for (int gI = 0; gI < 4; ++gI) { float m1 = -INFINITY, m2 = -INFINITY;
#pragma unroll
            for (int q = 0; q < 4; ++q) { const float v = bi[4 * gI + q]; if (v > m1) { m2 = m1; m1 = v; } else if (v > m2) m2 = v; }
            const float gs = m1 + m2; if (gs > best) { best = gs; grp = gI; } }
        int e0 = 0, e1 = 0; float b0 = -INFINITY, b1 = -INFINITY, s0 = 0.f, s1 = 0.f;
#pragma unroll
        for (int gI = 0; gI < 4; ++gI)
#pragma unroll
            for (int q = 0; q < 4; ++q) { const int e = 4 * gI + q; if (gI == grp) { const float v = bi[e];
                if (v > b0) { b1 = b0; e1 = e0; s1 = s0; b0 = v; e0 = e; s0 = sc[e]; } else if (v > b1) { b1 = v; e1 = e; s1 = sc[e]; } } }
        const float inv = 1.0f / (s0 + s1);
        if (lane == 0) { const int li = wv * 32 + it_; const unsigned q0 = __hip_atomic_fetch_add(lcnt + e0, 1u, __ATOMIC_RELAXED, __HIP_MEMORY_SCOPE_WORKGROUP), q1 = __hip_atomic_fetch_add(lcnt + e1, 1u, __ATOMIC_RELAXED, __HIP_MEMORY_SCOPE_WORKGROUP);
                         lrec[li * 4 + 0] = (unsigned)e0 | (q0 << 8); lrec[li * 4 + 1] = (unsigned)e1 | (q1 << 8); lrec[li * 4 + 2] = __float_as_uint(s0 * inv); lrec[li * 4 + 3] = __float_as_uint(s1 * inv); }
        ++it_;
        cur = nx;
#pragma unroll
        for (int j = 0; j < 4; ++j) tc[j] = tn[j];
    }
    __syncthreads();
    if (tid < 16) lbase[tid] = atomicAdd(cnt + tid, lcnt[tid]);
    __syncthreads();
    if (tid < 256) { const int grow = blk * 256 + tid;
        const unsigned r0 = lrec[tid * 4 + 0], r1 = lrec[tid * 4 + 1]; const unsigned e0 = r0 & 255u, e1 = r1 & 255u;
        const size_t p0 = (size_t)e0 * MTOK + lbase[e0] + (r0 >> 8), p1 = (size_t)e1 * MTOK + lbase[e1] + (r1 >> 8);
        list[p0] = grow * 2; cw[p0] = __uint_as_float(lrec[tid * 4 + 2]); list[p1] = grow * 2 + 1; cw[p1] = __uint_as_float(lrec[tid * 4 + 3]); }
}
__device__ __forceinline__ void prep_next(const Params& p, int l, bool final_, const int tid, const int blk) {
    const int lane = tid & 63, wv = tid >> 6;
    float* z = p.out; bf16_t* H = (bf16_t*)(p.ws + WS_H); const float* modm = (const float*)(p.ws + WS_MOD) + (size_t)(l * 2 + 1) * 16 * 3072;
    const float* modn = (const float*)(p.ws + WS_MOD) + (size_t)((final_ ? l : l + 1) * 2) * 16 * 3072;
    f32x2* stats = (f32x2*)(p.ws + WS_STATS);
    const bf16_t* out2 = (const bf16_t*)(p.ws + WS_R + R_OUT2);
    const int row0 = (blk * 8 + wv) * 32, bt = row0 >> 12;
    RowV vg0, vb0, vg1, vb1, vgate, vsh, vsc1;
    vec_load(vg0, p.in[IN_LNG] + (size_t)(l * 2) * 1024, lane); vec_load(vb0, p.in[IN_LNB] + (size_t)(l * 2) * 1024, lane);
    vec_load(vg1, p.in[IN_LNG] + (size_t)(l * 2 + 1) * 1024, lane); vec_load(vb1, p.in[IN_LNB] + (size_t)(l * 2 + 1) * 1024, lane);
    vec_load(vgate, modm + (size_t)bt * 3072 + 2048, lane); vec_load(vsh, modn + (size_t)bt * 3072, lane); vec_load(vsc1, modn + (size_t)bt * 3072 + 1024, lane); vec_add1(vsc1);
    int row = row0;
    RowV cur; u32x2 ta[4], tb[4]; row_load(cur, z + (size_t)row * 1024, lane); row_load_t(ta, out2 + (size_t)(row * 2) * 1024, lane); row_load_t(tb, out2 + (size_t)(row * 2 + 1) * 1024, lane);
    for (; row < row0 + 32; ++row) {
        const int nrow = row + 1; RowV nx; u32x2 na[4], nb[4];
        if (nrow < row0 + 32) { row_load(nx, z + (size_t)nrow * 1024, lane); row_load_t(na, out2 + (size_t)(nrow * 2) * 1024, lane); row_load_t(nb, out2 + (size_t)(nrow * 2 + 1) * 1024, lane); }
        RowV r = cur;
        const f32x2 st = stats[row]; row_ln_r(r, st.x, st.y, vg0, vb0);
#pragma unroll
        for (int j = 0; j < 4; ++j) { const u32x2 oa = ta[j], ob = tb[j];
            f32x4 y; y[0] = __uint_as_float(oa.x << 16) + __uint_as_float(ob.x << 16); y[1] = __uint_as_float(oa.x & 0xffff0000u) + __uint_as_float(ob.x & 0xffff0000u);
            y[2] = __uint_as_float(oa.y << 16) + __uint_as_float(ob.y << 16); y[3] = __uint_as_float(oa.y & 0xffff0000u) + __uint_as_float(ob.y & 0xffff0000u);
            r.v[j] = r.v[j] * DN_ALPHA + vgate.v[j] * y; }
        cur = nx;
#pragma unroll
        for (int j = 0; j < 4; ++j) { ta[j] = na[j]; tb[j] = nb[j]; }
        float mean, rstd; row_stats(r, mean, rstd);
        if (final_) { row_ln_r(r, mean, rstd, vg1, vb1);
#pragma unroll
            for (int j = 0; j < 4; ++j) *(f32x4*)(z + (size_t)row * 1024 + 4 * lane + 256 * j) = r.v[j];
        } else {
#pragma unroll
            for (int j = 0; j < 4; ++j) *(f32x4*)(z + (size_t)row * 1024 + 4 * lane + 256 * j) = r.v[j];
            if (lane == 0) stats[row] = (f32x2){mean, rstd};
            RowV h; row_ln_r(r, mean, rstd, vg1, vb1); row_mod_r(h, r, vsh, vsc1); row_store_bf16(h, H + (size_t)row * 1024, lane); }
    }
}

__device__ __forceinline__ int q_next(unsigned* ctr, volatile LAS int* slot, const int tid) {
    __syncthreads();
    if (tid == 0) *slot = (int)__hip_atomic_fetch_add(ctr, 1u, __ATOMIC_RELAXED, __HIP_MEMORY_SCOPE_AGENT);
    __syncthreads();
    return *slot;
}

struct GdnRaw { u32x4 v[4]; float a, bg; };
__device__ __forceinline__ void gdn_prep_load(GdnRaw& g, int unit, const int tid) {
    unsigned char* ws = ws_late(); const int n = unit & 63, h = (unit >> 6) & 3, bl = unit >> 8; const int tok0 = bl * SEQ + n * 64;
    const bf16_t* proj = (const bf16_t*)(ws + WS_R + R_PROJ); const float* sm = (const float*)(ws + WS_R + R_SM);
#pragma unroll
    for (int j = 0; j < 4; ++j) { const int idx = tid + j * NTHR; const int row = idx / 24, ch = idx % 24, seg = ch >> 3, c8 = ch & 7;
        u32x4 v = {0u, 0u, 0u, 0u};
        if (idx < 67 * 24 && (n > 0 || row >= 3)) v = *(const u32x4*)(proj + (size_t)(tok0 + row - 3) * PROJW + seg * 256 + h * 64 + c8 * 8);
        g.v[j] = v; }
    g.a = 0.f; g.bg = 0.f;
    if (tid < 64) { g.a = sm[(size_t)(tok0 + tid) * 32 + h]; g.bg = sm[(size_t)(tok0 + tid) * 32 + 4 + h]; }
}
__device__ __forceinline__ void gdn_prep_unit(const Params& p, int l, int unit, LAS unsigned char* lds, const int tid_in_, const GdnRaw& graw) {
    int tid = tid_in_; asm volatile("" : "+v"(tid)); unsigned char* wsl_ = ws_late();
    const int lane = tid & 63;
    const int n = unit & 63, h = (unit >> 6) & 3, bl = unit >> 8;
    const int tok0 = bl * SEQ + n * 64;
    const bf16_t* proj = (const bf16_t*)(wsl_ + WS_R + R_PROJ); const float* sm = (const float*)(wsl_ + WS_R + R_SM);
    LAS bf16_t* raw = (LAS bf16_t*)lds;
    LAS float* qs = (LAS float*)(lds + 26112); LAS float* ks = qs + 64 * 65; LAS float* vs = ks + 64 * 65;
    LAS float* Lm = vs + 64 * 65;
    LAS float* bc = Lm + 4096; LAS float* eb = bc + 64; LAS float* be = eb + 64; LAS float* cwt = be + 64;
    __syncthreads();
#pragma unroll
    for (int j = 0; j < 4; ++j) { const int idx = tid + j * NTHR; const int row = idx / 24, ch = idx % 24, seg = ch >> 3, c8 = ch & 7;
        if (idx < 67 * 24) *(LAS u32x4*)(raw + row * 192 + seg * 64 + c8 * 8) = graw.v[j]; }
    for (int idx = tid; idx < 768; idx += NTHR) { const int k = idx / 192, ch = idx % 192; cwt[idx] = PIN(IN_CONVW)[(size_t)l * 4 * 768 + k * 768 + (ch >> 6) * 256 + h * 64 + (ch & 63)]; }
    __syncthreads();
#ifdef GP_REP_CONV
    for (int rep_ = 0; rep_ < 2; ++rep_)
#endif
    for (int idx = tid; idx < 64 * 192; idx += NTHR) { const int t = idx / 192, ch = idx % 192; float s = 0.f;
#pragma unroll
        for (int k = 0; k < 4; ++k) s += cwt[k * 192 + ch] * bf2f(raw[(t + k) * 192 + ch]);
        s = siluf_(s); const int seg = ch >> 6, d = ch & 63; (seg == 0 ? qs : seg == 1 ? ks : vs)[t * 65 + d] = s; }
    __syncthreads();
    LAS unsigned char* qb = lds + 129024; LAS unsigned char* kb = qb + 8192; LAS float* Rs = (LAS float*)(kb + 8192);
    {
        const int mat = tid >> 8, row = (tid >> 2) & 63, q4 = tid & 3; LAS float* mt = mat ? ks : qs; float x[16], ss = 0.f;
#pragma unroll
        for (int d = 0; d < 16; ++d) { x[d] = mt[row * 65 + 16 * q4 + d]; ss += x[d] * x[d]; }
        ss += swz_xor<1>(ss); ss += swz_xor<2>(ss);
        const float sc = (1.0f / sqrtf(ss + 1e-6f)) * (mat ? 1.0f : 0.125f);
#pragma unroll
        for (int d = 0; d < 16; ++d) { x[d] *= sc; mt[row * 65 + 16 * q4 + d] = x[d]; }
        LAS unsigned char* ob = (mat ? kb : qb) + (2 * q4) * 1024 + row * 16;
        u32x4 w0, w1; w0.x = pk2(x[0], x[1]); w0.y = pk2(x[2], x[3]); w0.z = pk2(x[4], x[5]); w0.w = pk2(x[6], x[7]); w1.x = pk2(x[8], x[9]); w1.y = pk2(x[10], x[11]); w1.z = pk2(x[12], x[13]); w1.w = pk2(x[14], x[15]);
        *(LAS u32x4*)ob = w0; *(LAS u32x4*)(ob + 1024) = w1;
    }
    if (tid < 64) { const int i = tid;
        const float a = graw.a, bg = graw.bg;
        const float x = a + PIN(IN_DTB)[l * 4 + h]; const float sp = fmaxf(x, 0.f) + log1pf(__expf(-fabsf(x)));
        float la = -__expf(PIN(IN_ALOG)[l * 4 + h]) * sp;
#pragma unroll
        for (int o = 1; o < 64; o <<= 1) { const float v = shfl_up_l(la, o, lane); if (lane >= o) la += v; }
        bc[i] = la; eb[i] = __expf(la); be[i] = sigmoidf_(bg); }
    __syncthreads();
    const size_t ub = WS_R + R_GDN + (size_t)unit * GDN_UNIT_BYTES;
    bf16_t* gW = (bf16_t*)(wsl_ + ub); bf16_t* gATT = gW + 4096; bf16_t* gQD = gW + 8192; bf16_t* gKDT = gW + 12288; bf16_t* gU0 = gW + 16384;
#ifdef GP_REP_KK
    for (int rep_ = 0; rep_ < 2; ++rep_)
#endif
    {
        const int wid = tid >> 6, r32 = lane & 31, hi = lane >> 5, isq = wid >> 2, it = (wid >> 1) & 1, jt = wid & 1;
        const LAS unsigned char* ab = (isq ? qb : kb) + hi * 1024 + (32 * it + r32) * 16; const LAS unsigned char* bb = kb + hi * 1024 + (32 * jt + r32) * 16;
        f32x16 acc = z16();
#pragma unroll
        for (int d0 = 0; d0 < 4; ++d0) acc = MF32(*(const LAS bf16x8*)(ab + d0 * 2048), *(const LAS bf16x8*)(bb + d0 * 2048), acc);
        const int j = 32 * jt + r32; const float bj = bc[j];
#pragma unroll
        for (int g = 0; g < 4; ++g) { f32x4 lv;
#pragma unroll
            for (int e = 0; e < 4; ++e) { const int i = 32 * it + 8 * g + 4 * hi + e; const float dc = __expf(bc[i] - bj), v = acc[4 * g + e] * dc;
                if (isq) gATT[i * 64 + j] = f2bf((j <= i) ? v : 0.f); else lv[e] = (j < i) ? be[i] * v : 0.f; }
            if (!isq) *(LAS f32x4*)(Lm + j * 64 + 32 * it + 8 * g + 4 * hi) = lv; }
    }
    __syncthreads();
    {
        const float bl_ = bc[63];
        for (int task = tid; task < 1024; task += NTHR) {
            if (task < 512) { const int c2 = task >> 3, sg = task & 7; const float e = eb[c2]; float v[8];
#pragma unroll
                for (int j = 0; j < 8; ++j) v[j] = qs[c2 * 65 + sg * 8 + j] * e;
                u32x4 w; w.x = pk2(v[0], v[1]); w.y = pk2(v[2], v[3]); w.z = pk2(v[4], v[5]); w.w = pk2(v[6], v[7]); *(u32x4*)(gQD + c2 * 64 + sg * 8) = w;
            } else { const int k = (task - 512) >> 3, sg = task & 7; float v[8];
#pragma unroll
                for (int j = 0; j < 8; ++j) { const int c2 = sg * 8 + j; v[j] = ks[c2 * 65 + k] * __expf(bl_ - bc[c2]); }
                u32x4 w; w.x = pk2(v[0], v[1]); w.y = pk2(v[2], v[3]); w.z = pk2(v[4], v[5]); w.w = pk2(v[6], v[7]); *(u32x4*)(gKDT + k * 64 + sg * 8) = w; }
        }
        if (tid == 0) ((float*)(wsl_ + WS_R + R_GG))[unit] = __expf(bl_);
    }
    {
        const int c = 16 * (tid >> 6) + (lane & 15), cc = c & 63, rg = lane >> 4; const bool isw = c >= 64; LAS float* Xs = cwt + 768;
        for (int I = 0; I < 4; ++I) {
            float r[4];
#pragma unroll
            for (int e = 0; e < 4; ++e) { const int i = 16 * I + 4 * rg + e; r[e] = isw ? be[i] * eb[i] * ks[i * 65 + cc] : be[i] * vs[i * 65 + cc]; }
#pragma unroll 4
            for (int j = 0; j < 16 * I; ++j) { const float xj = Xs[j * 128 + c]; const f32x4 l4 = *(const LAS f32x4*)(Lm + j * 64 + 16 * I + 4 * rg);
#pragma unroll
                for (int e = 0; e < 4; ++e) r[e] -= l4[e] * xj; }
#pragma unroll
            for (int e = 0; e < 4; ++e) Rs[(4 * rg + e) * 128 + c] = r[e];
            asm volatile("s_waitcnt lgkmcnt(0)" ::: "memory");
            if (lane < 16) { float q[16];
#pragma unroll
                for (int ii = 0; ii < 16; ++ii) q[ii] = Rs[ii * 128 + c];
#pragma unroll
                for (int jj = 0; jj < 15; ++jj) { const LAS float* lt = Lm + (16 * I + jj) * 64 + 16 * I;
#pragma unroll
                    for (int ii = jj + 1; ii < 16; ++ii) q[ii] -= lt[ii] * q[jj]; }
#pragma unroll
                for (int ii = 0; ii < 16; ++ii) { Xs[(16 * I + ii) * 128 + c] = q[ii]; (isw ? gW : gU0)[(16 * I + ii) * 64 + cc] = f2bf(q[ii]); }
            }
            asm volatile("s_waitcnt lgkmcnt(0)" ::: "memory");
        }
    }
    __syncthreads();
}

__device__ __forceinline__ bf16x8 afrag_perm(const LAS unsigned char* M, int row, int ks, int hi) {
    const LAS unsigned char* q = M + row * 144 + (16 * ks + 4 * hi) * 2;
    const s16x4 lo = *(const LAS s16x4*)q, hi4 = *(const LAS s16x4*)(q + 16);
    return (bf16x8){lo[0], lo[1], lo[2], lo[3], hi4[0], hi4[1], hi4[2], hi4[3]};
}
__device__ __forceinline__ bf16x8 pack_acc8(const f32x16& a, int s) {
    u32x4 w; w.x = pk2(a[8 * s + 0], a[8 * s + 1]); w.y = pk2(a[8 * s + 2], a[8 * s + 3]); w.z = pk2(a[8 * s + 4], a[8 * s + 5]); w.w = pk2(a[8 * s + 6], a[8 * s + 7]);
    return __builtin_bit_cast(bf16x8, w);
}
__device__ __forceinline__ void gdn_scan_item(const Params& p, int l, int chunk, int item, LAS unsigned char* lds, const int tid) {
    const int lane = tid & 63, wid = tid >> 6, vl = lane & 31, hi = lane >> 5;
    const int h = item & 3, bl = item >> 2;
    const unsigned char* ubase = p.ws + WS_R + R_GDN + (size_t)item * 64 * GDN_UNIT_BYTES;
    const float* gg = (const float*)(p.ws + WS_R + R_GG) + item * 64;
    const bf16_t* proj = (const bf16_t*)(p.ws + WS_R + R_PROJ); bf16_t* og = (bf16_t*)(p.ws + WS_R + R_O);
    const float* nw = PIN(IN_GNORM) + l * 64;
    constexpr int BUF = 5 * 9216;
    LAS unsigned char* buf0 = lds; LAS float* ob0 = (LAS float*)(lds + 2 * BUF);
    __syncthreads();
    for (int q = tid; q < 2560; q += NTHR) { const int mat = q >> 9, r = (q >> 3) & 63, sg = q & 7;
        *(LAS u32x4*)(buf0 + mat * 9216 + r * 144 + sg * 16) = *(const u32x4*)(ubase + mat * 8192 + r * 128 + sg * 16); }
    __syncthreads();
    f32x16 S[2]; S[0] = z16(); S[1] = z16();
    for (int n = 0; n < 64; ++n) {
        LAS unsigned char* bf = buf0 + (n & 1) * BUF; LAS float* ob = ob0 + (n & 1) * 4096;
        if (wid < 2) {
            const LAS unsigned char* Wm = bf; const LAS unsigned char* ATT = bf + 9216; const LAS unsigned char* QD = bf + 18432; const LAS unsigned char* KDT = bf + 27648; const LAS bf16_t* U0 = (const LAS bf16_t*)(bf + 36864);
            const float G = gg[n];
            bf16x8 Sb[4]; Sb[0] = pack_acc8(S[0], 0); Sb[1] = pack_acc8(S[0], 1); Sb[2] = pack_acc8(S[1], 0); Sb[3] = pack_acc8(S[1], 1);
            f32x16 u[2];
#pragma unroll
            for (int ct = 0; ct < 2; ++ct) { f32x16 a = z16();
#pragma unroll
                for (int ks = 0; ks < 4; ++ks) a = __builtin_amdgcn_mfma_f32_32x32x16_bf16(afrag_perm(Wm, 32 * ct + vl, ks, hi), Sb[ks], a, 0, 0, 0);
#pragma unroll
                for (int r = 0; r < 16; ++r) u[ct][r] = bf2f(U0[(32 * ct + crow(r, hi)) * 72 + 32 * wid + vl]) - a[r]; }
            bf16x8 ub[4]; ub[0] = pack_acc8(u[0], 0); ub[1] = pack_acc8(u[0], 1); ub[2] = pack_acc8(u[1], 0); ub[3] = pack_acc8(u[1], 1);
#pragma unroll
            for (int ct = 0; ct < 2; ++ct) { f32x16 a = z16();
#pragma unroll
                for (int ks = 0; ks < 4; ++ks) a = __builtin_amdgcn_mfma_f32_32x32x16_bf16(afrag_perm(QD, 32 * ct + vl, ks, hi), Sb[ks], a, 0, 0, 0);
#pragma unroll
                for (int cs = 0; cs < 4; ++cs) a = __builtin_amdgcn_mfma_f32_32x32x16_bf16(afrag_perm(ATT, 32 * ct + vl, cs, hi), ub[cs], a, 0, 0, 0);
#pragma unroll
                for (int r = 0; r < 16; ++r) ob[(32 * ct + crow(r, hi)) * 64 + 32 * wid + vl] = a[r]; }
#pragma unroll
            for (int kt = 0; kt < 2; ++kt) { f32x16 a = S[kt] * G;
#pragma unroll
                for (int cs = 0; cs < 4; ++cs) a = __builtin_amdgcn_mfma_f32_32x32x16_bf16(afrag_perm(KDT, 32 * kt + vl, cs, hi), ub[cs], a, 0, 0, 0);
                S[kt] = a; }
        } else {
            if (n + 1 < 64) { LAS unsigned char* nb = buf0 + ((n + 1) & 1) * BUF; const unsigned char* src = ubase + (size_t)(n + 1) * GDN_UNIT_BYTES;
                for (int q = tid - 128; q < 2560; q += 384) { const int mat = q >> 9, r = (q >> 3) & 63, sg = q & 7;
                    *(LAS u32x4*)(nb + mat * 9216 + r * 144 + sg * 16) = *(const u32x4*)(src + mat * 8192 + r * 128 + sg * 16); } }
        }
        if (wid >= 2 && n >= 1) { const LAS float* po = ob0 + ((n - 1) & 1) * 4096; const int tokb = bl * SEQ + (n - 1) * 64;
            for (int task = tid - 128; task < 512; task += 384) { const int c = task >> 3, sg = task & 7; float v[8], ss = 0.f;
#pragma unroll
                for (int j = 0; j < 8; ++j) { v[j] = po[c * 64 + sg * 8 + j]; ss += v[j] * v[j]; }
                ss += swz_xor<1>(ss); ss += swz_xor<2>(ss); ss += swz_xor<4>(ss);
                const float rs = 1.0f / sqrtf(ss * (1.0f / 64.0f) + 1e-6f);
                const u32x4 zw = *(const u32x4*)(proj + (size_t)(tokb + c) * PROJW + PC_GZ + h * 64 + sg * 8); const unsigned zz[4] = {zw.x, zw.y, zw.z, zw.w};
#pragma unroll
                for (int j = 0; j < 8; ++j) { const float zf = (j & 1) ? __uint_as_float(zz[j >> 1] & 0xffff0000u) : __uint_as_float(zz[j >> 1] << 16); v[j] = v[j] * rs * nw[sg * 8 + j] * siluf_(zf); }
                u32x4 w; w.x = pk2(v[0], v[1]); w.y = pk2(v[2], v[3]); w.z = pk2(v[4], v[5]); w.w = pk2(v[6], v[7]);
                *(u32x4*)(og + (size_t)(tokb + c) * 256 + h * 64 + sg * 8) = w; } }
        __syncthreads();
    }
    { const LAS float* po = ob0 + 4096; const int tokb = bl * SEQ + 63 * 64;
        for (int task = tid; task < 512; task += NTHR) { const int c = task >> 3, sg = task & 7; float v[8], ss = 0.f;
#pragma unroll
            for (int j = 0; j < 8; ++j) { v[j] = po[c * 64 + sg * 8 + j]; ss += v[j] * v[j]; }
            ss += swz_xor<1>(ss); ss += swz_xor<2>(ss); ss += swz_xor<4>(ss);
            const float rs = 1.0f / sqrtf(ss * (1.0f / 64.0f) + 1e-6f);
            const u32x4 zw = *(const u32x4*)(proj + (size_t)(tokb + c) * PROJW + PC_GZ + h * 64 + sg * 8); const unsigned zz[4] = {zw.x, zw.y, zw.z, zw.w};
#pragma unroll
            for (int j = 0; j < 8; ++j) { const float zf = (j & 1) ? __uint_as_float(zz[j >> 1] & 0xffff0000u) : __uint_as_float(zz[j >> 1] << 16); v[j] = v[j] * rs * nw[sg * 8 + j] * siluf_(zf); }
            u32x4 w; w.x = pk2(v[0], v[1]); w.y = pk2(v[2], v[3]); w.z = pk2(v[4], v[5]); w.w = pk2(v[6], v[7]);
            *(u32x4*)(og + (size_t)(tokb + c) * 256 + h * 64 + sg * 8) = w; } }
    __syncthreads();
}

__device__ __forceinline__ void fox_cum_item(const Params& p, int l, int item, LAS float* lf, const int tid) {
    const int lane = tid & 63, wid = tid >> 6, h = item & 3, bl = item >> 2;
    const float* sm = (const float*)(p.ws + WS_R + R_SM); float* nb = (float*)(p.ws + WS_R + R_CUM) + (size_t)item * SEQ;
    const float fb = PIN(IN_FBIAS)[l * 4 + h];
    float v[8], run = 0.f;
#pragma unroll
    for (int j = 0; j < 8; ++j) { const float x = sm[(size_t)(bl * SEQ + tid * 8 + j) * 32 + 20 + h] + fb; run += fminf(x, 0.f) - log1pf(__expf(-fabsf(x))); v[j] = run; }
    float inc = run;
#pragma unroll
    for (int o = 1; o < 64; o <<= 1) { const float t = shfl_up_l(inc, o, lane); if (lane >= o) inc += t; }
    __syncthreads();
    if (lane == 63) lf[wid] = inc;
    __syncthreads();
    float base = inc - run;
    for (int w = 0; w < wid; ++w) base += lf[w];
#pragma unroll
    for (int j = 0; j < 8; ++j) nb[tid * 8 + j] = -(base + v[j]) * LOG2E;
    __syncthreads();
}
__device__ __forceinline__ void ret_rope_pass(const Params& p, int chunk, const int tid, const int blk) {
    bf16_t* proj = (bf16_t*)(p.ws + WS_R + R_PROJ); const f32x2* tab = (const f32x2*)(p.ws + WS_ROPE);
    for (int task = blk * NTHR + tid; task < MC * 32; task += NWG * NTHR) {
        const int row = task >> 5, which = (task >> 4) & 1, h = (task >> 2) & 3, i8 = task & 3;
        bf16_t* q1 = proj + (size_t)row * PROJW + (which ? PC_RK : PC_RQ) + h * 64 + i8 * 8; bf16_t* q2 = q1 + 32;
        const u32x4 a = *(const u32x4*)q1, b = *(const u32x4*)q2; const unsigned aa[4] = {a.x, a.y, a.z, a.w}, bb[4] = {b.x, b.y, b.z, b.w};
        const f32x2* tp = tab + (size_t)(chunk * MC + row) * 32 + i8 * 8; float o1[8], o2[8];
#pragma unroll
        for (int j = 0; j < 8; ++j) { const float x1 = (j & 1) ? __uint_as_float(aa[j >> 1] & 0xffff0000u) : __uint_as_float(aa[j >> 1] << 16);
            const float x2 = (j & 1) ? __uint_as_float(bb[j >> 1] & 0xffff0000u) : __uint_as_float(bb[j >> 1] << 16);
            const f32x2 cs = tp[j]; o1[j] = x1 * cs.x - x2 * cs.y; o2[j] = x1 * cs.y + x2 * cs.x; }
        u32x4 w1, w2; w1.x = pk2(o1[0], o1[1]); w1.y = pk2(o1[2], o1[3]); w1.z = pk2(o1[4], o1[5]); w1.w = pk2(o1[6], o1[7]);
        w2.x = pk2(o2[0], o2[1]); w2.y = pk2(o2[2], o2[3]); w2.z = pk2(o2[4], o2[5]); w2.w = pk2(o2[6], o2[7]);
        *(u32x4*)q1 = w1; *(u32x4*)q2 = w2; }
}

constexpr int AL_K0 = 0, AL_V0 = 16384, AL_B0 = 32768;
__device__ __forceinline__ s16x4 vtr(const LAS unsigned char* q) {
    typedef short v4i16_t __attribute__((ext_vector_type(4)));
    return __builtin_bit_cast(s16x4, __builtin_amdgcn_ds_read_tr16_b64_v4i16((LAS v4i16_t*)q));
}
__device__ __forceinline__ void attn_qkt(f32x16& p0, f32x16& p1, const LAS unsigned char* kslot, const bf16x8 (&qf)[4], int r32, int hi) {
    p0 = z16(); p1 = z16();
#pragma unroll
    for (int d0 = 0; d0 < 4; ++d0) { const LAS unsigned char* kb = kslot + (2 * d0 + hi) * 1024 + r32 * 16;
        const bf16x8 b0 = *(const LAS bf16x8*)kb, b1 = *(const LAS bf16x8*)(kb + 512);
        p0 = MF32(b0, qf[d0], p0); p1 = MF32(b1, qf[d0], p1); }
}
__device__ __forceinline__ void attn_pv(f32x16 (&o)[2], const LAS unsigned char* vslot, const bf16x8 (&pw)[4], int lane, int hi) {
    const LAS unsigned char* vb = vslot + ((lane >> 4) & 1) * 32 + (lane & 3) * 8 + (4 * hi + ((lane & 15) >> 2)) * 64;
#pragma unroll
    for (int d0 = 0; d0 < 2; ++d0)
#pragma unroll
        for (int ks = 0; ks < 4; ++ks) { const s16x4 lo = vtr(vb + d0 * 4096 + ks * 1024), h4 = vtr(vb + d0 * 4096 + ks * 1024 + 512);
            const bf16x8 vf = (bf16x8){lo[0], lo[1], lo[2], lo[3], h4[0], h4[1], h4[2], h4[3]};
            o[d0] = MF32(vf, pw[ks], o[d0]); }
}
__device__ __forceinline__ void attn_softmax_step(f32x16& p0, f32x16& p1, f32x16 (&o)[2], float& m, float& l) {
    float mt = p0[0];
#pragma unroll
    for (int r = 1; r < 16; ++r) mt = fmaxf(mt, p0[r]);
#pragma unroll
    for (int r = 0; r < 16; ++r) mt = fmaxf(mt, p1[r]);
    mt = x32_max(mt);
    const float mn = fmaxf(m, mt), ms = (mn == -INFINITY) ? 0.f : mn, alpha = ex2(m - ms);
    float s = 0.f;
#pragma unroll
    for (int r = 0; r < 16; ++r) { p0[r] = ex2(p0[r] - ms); p1[r] = ex2(p1[r] - ms); s += p0[r] + p1[r]; }
    l = l * alpha + s; m = mn;
    if (__builtin_amdgcn_ballot_w64(alpha != 1.0f) != 0ull) { o[0] *= alpha; o[1] *= alpha; }
}
template <class F>
__device__ __forceinline__ void flash_loop(const F& f, int tlo, int thi, const bf16_t* Kg, const bf16_t* Vg, int pitch, const float* biasg,
                                           const bf16x8 (&qf)[4], f32x16 (&o)[2], float& m, float& l, LAS unsigned char* lds, const int tid) {
    const int lane = tid & 63, wid = tid >> 6, r32 = lane & 31, hi = lane >> 5;
    int t = tlo; while (t < thi && f.skip(t)) ++t;
    __syncthreads();
    if (t >= thi) return;
    const bf16_t* ksrc = Kg + (size_t)lane * pitch + wid * 8;
    const bf16_t* vsrc = Vg + (size_t)(16 * (wid & 3) + (lane >> 2)) * pitch + (wid >> 2) * 32 + (lane & 3) * 8;
    const int sdst = wid * 1024 + lane * 16;
    u32x4 kr = *(const u32x4*)(ksrc + (size_t)t * 64 * pitch), vr = *(const u32x4*)(vsrc + (size_t)t * 64 * pitch); float br = 0.f;
    const int btid = tid & 63;
    if (F::HAS_BIAS) br = biasg[t * 64 + btid];
    *(LAS u32x4*)(lds + AL_K0 + sdst) = kr; *(LAS u32x4*)(lds + AL_V0 + sdst) = vr; if (F::HAS_BIAS) ((LAS float*)(lds + AL_B0))[btid] = br;
    __syncthreads();
    int cur = 0;
    for (;;) {
        int tn = t + 1; while (tn < thi && f.skip(tn)) ++tn;
        if (tn < thi) { kr = *(const u32x4*)(ksrc + (size_t)tn * 64 * pitch); vr = *(const u32x4*)(vsrc + (size_t)tn * 64 * pitch); if (F::HAS_BIAS) br = biasg[tn * 64 + btid]; }
        if (!f.wskip(t)) {
        f32x16 p0, p1;
        attn_qkt(p0, p1, lds + AL_K0 + cur * 8192, qf, r32, hi);
        if (F::HAS_BIAS) { const LAS float* bp = (const LAS float*)(lds + AL_B0 + cur * 256);
#pragma unroll
            for (int g = 0; g < 4; ++g) { const f32x4 b0 = *(const LAS f32x4*)(bp + 8 * g + 4 * hi), b1 = *(const LAS f32x4*)(bp + 32 + 8 * g + 4 * hi);
#pragma unroll
                for (int e = 0; e < 4; ++e) { p0[4 * g + e] += b0[e]; p1[4 * g + e] += b1[e]; } } }
        f.apply(p0, p1, t);
        if (F::MODE == 0) attn_softmax_step(p0, p1, o, m, l);
        bf16x8 pw[4]; pw[0] = pack_acc8(p0, 0); pw[1] = pack_acc8(p0, 1); pw[2] = pack_acc8(p1, 0); pw[3] = pack_acc8(p1, 1);
        attn_pv(o, lds + AL_V0 + cur * 8192, pw, lane, hi);
        }
        if (tn >= thi) break;
        cur ^= 1;
        *(LAS u32x4*)(lds + AL_K0 + cur * 8192 + sdst) = kr; *(LAS u32x4*)(lds + AL_V0 + cur * 8192 + sdst) = vr; if (F::HAS_BIAS) ((LAS float*)(lds + AL_B0 + cur * 256))[btid] = br;
        __syncthreads();
        t = tn;
    }
    __syncthreads();
}
__device__ __forceinline__ void load_qf(bf16x8 (&qf)[4], const bf16_t* qrow, int hi) {
#pragma unroll
    for (int d0 = 0; d0 < 4; ++d0) qf[d0] = *(const bf16x8*)(qrow + d0 * 16 + hi * 8);
}
__device__ __forceinline__ void store_ot(const f32x16 (&o)[2], bf16_t* orow, int hi) {
#pragma unroll
    for (int d0 = 0; d0 < 2; ++d0)
#pragma unroll
        for (int g = 0; g < 4; ++g) { u32x2 w; w.x = pk2(o[d0][4 * g], o[d0][4 * g + 1]); w.y = pk2(o[d0][4 * g + 2], o[d0][4 * g + 3]); *(u32x2*)(orow + 32 * d0 + 8 * g + 4 * hi) = w; }
}

struct FoxF { static constexpr int MODE = 0; static constexpr bool HAS_BIAS = true; int tq, qmin, hi;
    __device__ __forceinline__ bool skip(int) const { return false; }
    __device__ __forceinline__ bool wskip(int) const { return false; }
    __device__ __forceinline__ void apply(f32x16& p0, f32x16& p1, int t) const { const float NI = ninf_();
        if (64 * t + 63 > qmin) {
#pragma unroll
            for (int r = 0; r < 16; ++r) { const int key = 64 * t + crow(r, hi); if (key > tq) p0[r] = NI; if (key + 32 > tq) p1[r] = NI; } } } };
struct RetF { static constexpr int MODE = 1; static constexpr bool HAS_BIAS = false; int tq, hi; float lg;
    __device__ __forceinline__ bool skip(int) const { return false; }
    __device__ __forceinline__ bool wskip(int) const { return false; }
    __device__ __forceinline__ void apply(f32x16& p0, f32x16& p1, int t) const { const float NI = ninf_();
#pragma unroll
        for (int r = 0; r < 16; ++r) { const int key = 64 * t + crow(r, hi);
            p0[r] = (key <= tq) ? p0[r] * ex2((float)(tq - key) * lg) : 0.f; p1[r] = (key + 32 <= tq) ? p1[r] * ex2((float)(tq - key - 32) * lg) : 0.f; } } };
struct SelF { static constexpr int MODE = 0; static constexpr bool HAS_BIAS = false; unsigned long long umask, wmask, mymask; int tq, klo, hi;
    __device__ __forceinline__ bool skip(int t) const { return ((umask >> t) & 1ull) == 0ull; }
    __device__ __forceinline__ bool wskip(int t) const { return ((wmask >> t) & 1ull) == 0ull; }
    int tdiag, tlo;
    __device__ __forceinline__ void apply(f32x16& p0, f32x16& p1, int t) const { const float NI = ninf_(); const bool on = ((mymask >> t) & 1ull) != 0ull;
        if (t >= tdiag || t <= tlo) {
#pragma unroll
            for (int r = 0; r < 16; ++r) { const int key = 64 * t + crow(r, hi); if (!on || key > tq || key <= klo) p0[r] = NI; if (!on || key + 32 > tq || key + 32 <= klo) p1[r] = NI; }
        } else if (__builtin_amdgcn_ballot_w64(!on) != 0ull) {
#pragma unroll
            for (int r = 0; r < 16; ++r) { if (!on) { p0[r] = NI; p1[r] = NI; } }
        } } };
__device__ __forceinline__ void fox_unit(const Params& p, int idx, LAS unsigned char* lds, const int tid_in_) {
    int tid = tid_in_; asm volatile("" : "+v"(tid)); unsigned char* wsl_ = ws_late();
    const int lane = tid & 63, wid = tid >> 6, r32 = lane & 31, hi = lane >> 5;
    const int qb = 15 - idx / (BC * 4), bh = idx % (BC * 4), h = bh & 3, bl = bh >> 2;
    const bf16_t* proj = (const bf16_t*)(wsl_ + WS_R + R_PROJ);
    const int tq = qb * 256 + wid * 32 + r32; const size_t rowc = (size_t)bl * SEQ + tq;
    bf16x8 qf[4]; load_qf(qf, proj + rowc * PROJW + PC_FQ + h * 64, hi);
    f32x16 o[2]; o[0] = z16(); o[1] = z16(); float m = -INFINITY, l = 0.f;
    FoxF f; f.tq = tq; f.qmin = qb * 256; f.hi = hi;
    flash_loop(f, 0, 4 * qb + 4, proj + (size_t)bl * SEQ * PROJW + PC_FK + h * 64, proj + (size_t)bl * SEQ * PROJW + PC_FV + h * 64, PROJW,
               (const float*)(wsl_ + WS_R + R_CUM) + (size_t)bh * SEQ, qf, o, m, l, lds, tid);
    l = x32_sum(l); const float inv = 1.0f / l; o[0] *= inv; o[1] *= inv;
    store_ot(o, (bf16_t*)(wsl_ + WS_R + R_O) + (size_t)3 * MC * 256 + rowc * 256 + h * 64, hi);
}
__device__ __forceinline__ void rope8(float (&o1)[8], float (&o2)[8], const u32x4& a, const u32x4& b, const f32x2* tp) {
    const unsigned aa[4] = {a.x, a.y, a.z, a.w}, bb[4] = {b.x, b.y, b.z, b.w};
#pragma unroll
    for (int j = 0; j < 8; ++j) { const float x1 = (j & 1) ? __uint_as_float(aa[j >> 1] & 0xffff0000u) : __uint_as_float(aa[j >> 1] << 16);
        const float x2 = (j & 1) ? __uint_as_float(bb[j >> 1] & 0xffff0000u) : __uint_as_float(bb[j >> 1] << 16);
        const f32x2 cs = tp[j]; o1[j] = x1 * cs.x - x2 * cs.y; o2[j] = x1 * cs.y + x2 * cs.x; }
}
__device__ __forceinline__ u32x4 pack8f(const float (&v)[8]) { u32x4 w; w.x = pk2(v[0], v[1]); w.y = pk2(v[2], v[3]); w.z = pk2(v[4], v[5]); w.w = pk2(v[6], v[7]); return w; }
__device__ __forceinline__ void ret_kv_unit(const Params& p, int ch, int idx, LAS unsigned char* lds, const int tid_in_) {
    int tid = tid_in_; asm volatile("" : "+v"(tid)); unsigned char* wsl_ = ws_late();
    const int lane = tid & 63, wid = tid >> 6, hi = lane >> 5;
    const int n = idx & 31, bh = idx >> 5, h = bh & 3, bl = bh >> 2;
    const bf16_t* proj = (const bf16_t*)(wsl_ + WS_R + R_PROJ); const f32x2* tab = (const f32x2*)(wsl_ + WS_ROPE);
    const size_t rowc0 = (size_t)bl * SEQ + n * 128; const float lg = log2f(1.0f - exp2f(-5.0f - (float)h));
    LAS unsigned char* KZ = lds; LAS unsigned char* VT = lds + 16384;
    __syncthreads();
    { const int key = tid >> 2, cp = tid & 3; const bf16_t* src = proj + (rowc0 + key) * PROJW + PC_RK + h * 64 + cp * 8;
      const u32x4 a = *(const u32x4*)src, b = *(const u32x4*)(src + 32); float o1[8], o2[8];
      rope8(o1, o2, a, b, tab + ((size_t)ch * MC + rowc0 + key) * 32 + cp * 8);
      const float zt = ex2((float)(127 - key) * lg);
#pragma unroll
      for (int j = 0; j < 8; ++j) { o1[j] *= zt; o2[j] *= zt; }
      LAS unsigned char* d = KZ + (key >> 6) * 8192 + ((key & 63) >> 4) * 1024 + (key & 15) * 64 + cp * 16;
      *(LAS u32x4*)d = pack8f(o1); *(LAS u32x4*)(d + 4096) = pack8f(o2); }
#pragma unroll
    for (int t2 = 0; t2 < 2; ++t2)
        *(LAS u32x4*)(VT + t2 * 8192 + wid * 1024 + lane * 16) = *(const u32x4*)(proj + (rowc0 + 64 * t2 + 16 * (wid & 3) + (lane >> 2)) * PROJW + PC_RV + h * 64 + (wid >> 2) * 32 + (lane & 3) * 8);
    __syncthreads();
    if (wid < 4) { const int vt = wid >> 1, kt = wid & 1;
        const int fo = ((lane >> 4) & 1) * 32 + (lane & 3) * 8 + (4 * hi + ((lane & 15) >> 2)) * 64;
        f32x16 acc = z16();
#pragma unroll
        for (int t2 = 0; t2 < 2; ++t2)
#pragma unroll
            for (int ks = 0; ks < 4; ++ks) { const LAS unsigned char* va = VT + t2 * 8192 + vt * 4096 + ks * 1024 + fo; const LAS unsigned char* ka = KZ + t2 * 8192 + kt * 4096 + ks * 1024 + fo;
                const s16x4 v0 = vtr(va), v1 = vtr(va + 512), k0 = vtr(ka), k1 = vtr(ka + 512);
                acc = MF32(((bf16x8){v0[0], v0[1], v0[2], v0[3], v1[0], v1[1], v1[2], v1[3]}), ((bf16x8){k0[0], k0[1], k0[2], k0[3], k1[0], k1[1], k1[2], k1[3]}), acc); }
        float* kvt = (float*)(wsl_ + WS_R + R_KVT) + (size_t)idx * 4096;
#pragma unroll
        for (int r = 0; r < 16; ++r) kvt[(32 * vt + crow(r, hi)) * 64 + 32 * kt + (lane & 31)] = acc[r]; }
    __syncthreads();
}
__device__ __forceinline__ void ret_out_unit(const Params& p, int l_, int ch, int idx, LAS unsigned char* lds, const int tid_in_) {
    int tid = tid_in_; asm volatile("" : "+v"(tid)); unsigned char* wsl_ = ws_late();
    const int lane = tid & 63, wid = tid >> 6, r32 = lane & 31, hi = lane >> 5, gw = wid >> 2, wq = wid & 3;
    const int np = 15 - idx / (BC * 4), bh = idx % (BC * 4), h = bh & 3, bl = bh >> 2, n = 2 * np + gw;
    const bf16_t* proj = (const bf16_t*)(wsl_ + WS_R + R_PROJ); const f32x2* tab = (const f32x2*)(wsl_ + WS_ROPE);
    const float lg = log2f(1.0f - exp2f(-5.0f - (float)h));
    LAS unsigned char* KS = lds; LAS unsigned char* VS = lds + 32768; LAS unsigned char* RT = lds + 65536;
    const int tql = 32 * wq + r32; const size_t rowc = (size_t)bl * SEQ + n * 128 + tql;
    bf16x8 qf[4];
    { const bf16_t* qrow = proj + rowc * PROJW + PC_RQ + h * 64; const f32x2* tp = tab + ((size_t)ch * MC + rowc) * 32;
#pragma unroll
      for (int d0 = 0; d0 < 2; ++d0) { const u32x4 a = *(const u32x4*)(qrow + d0 * 16 + hi * 8), b = *(const u32x4*)(qrow + 32 + d0 * 16 + hi * 8); float o1[8], o2[8];
          rope8(o1, o2, a, b, tp + d0 * 16 + hi * 8); qf[d0] = __builtin_bit_cast(bf16x8, pack8f(o1)); qf[d0 + 2] = __builtin_bit_cast(bf16x8, pack8f(o2)); } }
    __syncthreads();
#pragma unroll
    for (int g = 0; g < 2; ++g) { const size_t r0 = (size_t)bl * SEQ + (2 * np + g) * 128;
        { const int key = tid >> 2, cp = tid & 3; const bf16_t* src = proj + (r0 + key) * PROJW + PC_RK + h * 64 + cp * 8;
          const u32x4 a = *(const u32x4*)src, b = *(const u32x4*)(src + 32); float o1[8], o2[8];
          rope8(o1, o2, a, b, tab + ((size_t)ch * MC + r0 + key) * 32 + cp * 8);
          LAS unsigned char* d = KS + (g * 2 + (key >> 6)) * 8192 + cp * 1024 + (key & 63) * 16;
          *(LAS u32x4*)d = pack8f(o1); *(LAS u32x4*)(d + 4096) = pack8f(o2); }
#pragma unroll
        for (int t2 = 0; t2 < 2; ++t2)
            *(LAS u32x4*)(VS + (g * 2 + t2) * 8192 + wid * 1024 + lane * 16) = *(const u32x4*)(proj + (r0 + 64 * t2 + 16 * (wid & 3) + (lane >> 2)) * PROJW + PC_RV + h * 64 + (wid >> 2) * 32 + (lane & 3) * 8); }
    { const int t = tid & 255; const float gdec = ex2(128.0f * lg); const float* kv0 = (const float*)(wsl_ + WS_R + R_KVT) + (size_t)(bh * 32) * 4096;
#pragma unroll
      for (int q = 0; q < 2; ++q) { const int task = t + 256 * q, v = task >> 3, kc = task & 7; f32x4 a0 = {0.f, 0.f, 0.f, 0.f}, a1 = {0.f, 0.f, 0.f, 0.f};
          int m = 0;
          for (; m + 8 <= n; m += 8) { f32x4 x0[8], x1[8];
#pragma unroll
              for (int q8 = 0; q8 < 8; ++q8) { const float* s = kv0 + (size_t)(m + q8) * 4096 + v * 64 + kc * 8; x0[q8] = *(const f32x4*)s; x1[q8] = *(const f32x4*)(s + 4); }
#pragma unroll
              for (int q8 = 0; q8 < 8; ++q8) { a0 = a0 * gdec + x0[q8]; a1 = a1 * gdec + x1[q8]; } }
          for (; m < n; ++m) { const float* s = kv0 + (size_t)m * 4096 + v * 64 + kc * 8; a0 = a0 * gdec + *(const f32x4*)s; a1 = a1 * gdec + *(const f32x4*)(s + 4); }
          *(LAS u32x4*)(RT + gw * 8192 + kc * 1024 + v * 16) = pack8(a0, a1); } }
    __syncthreads();
    f32x16 o[2];
    { f32x16 p0, p1; attn_qkt(p0, p1, RT + gw * 8192, qf, r32, hi); const float xi = ex2((float)(tql + 1) * lg); o[0] = p0 * xi; o[1] = p1 * xi; }
    for (int kt = 0; kt <= (wq >> 1); ++kt) { f32x16 p0, p1; attn_qkt(p0, p1, KS + (gw * 2 + kt) * 8192, qf, r32, hi);
#pragma unroll
        for (int r = 0; r < 16; ++r) { const int key = 64 * kt + crow(r, hi);
            p0[r] = (key <= tql) ? p0[r] * ex2((float)(tql - key) * lg) : 0.f; p1[r] = (key + 32 <= tql) ? p1[r] * ex2((float)(tql - key - 32) * lg) : 0.f; }
        bf16x8 pw[4]; pw[0] = pack_acc8(p0, 0); pw[1] = pack_acc8(p0, 1); pw[2] = pack_acc8(p1, 0); pw[3] = pack_acc8(p1, 1);
        attn_pv(o, VS + (gw * 2 + kt) * 8192, pw, lane, hi); }
    float s = 0.f;
#pragma unroll
    for (int r = 0; r < 16; ++r) s += o[0][r] + o[1][r];
    s = x32_sum(s); const float mu = s * (1.0f / 64.0f); float q = 0.f;
#pragma unroll
    for (int r = 0; r < 16; ++r) { const float a = o[0][r] - mu, b = o[1][r] - mu; q += a * a + b * b; }
    q = x32_sum(q); const float rs = 1.0f / sqrtf(q * (1.0f / 64.0f) + LN_EPS);
    const float* gw_ = PIN(IN_RETGN) + l_ * 256 + h * 64; const bf16_t* grow = proj + rowc * PROJW + PC_RG + h * 64;
#pragma unroll
    for (int d0 = 0; d0 < 2; ++d0)
#pragma unroll
        for (int g = 0; g < 4; ++g) { const int d = 32 * d0 + 8 * g + 4 * hi; const u32x2 gz = *(const u32x2*)(grow + d); const f32x4 w4 = *(const f32x4*)(gw_ + d);
            const float gg[4] = {__uint_as_float(gz.x << 16), __uint_as_float(gz.x & 0xffff0000u), __uint_as_float(gz.y << 16), __uint_as_float(gz.y & 0xffff0000u)};
#pragma unroll
            for (int e = 0; e < 4; ++e) o[d0][4 * g + e] = (o[d0][4 * g + e] - mu) * rs * w4[e] * siluf_(gg[e]); }
    store_ot(o, (bf16_t*)(wsl_ + WS_R + R_O) + (size_t)1 * MC * 256 + rowc * 256 + h * 64, hi);
    __syncthreads();
}
constexpr int NL_KC = 36864, NL_VC = 69632, NL_IMPM = 102400, NL_IMPS = 118784, NL_SELM = 135424;
__device__ __forceinline__ void nsa_unit(const Params& p, int idx, LAS unsigned char* lds, const int tid_in_) {
    int tid = tid_in_; asm volatile("" : "+v"(tid)); unsigned char* wsl_ = ws_late();
    const int lane = tid & 63, wid = tid >> 6, r32 = lane & 31, hi = lane >> 5, tl = r32 >> 2, hd = r32 & 3;
    const int ib = 63 - idx / BC, bl = idx % BC;
    const bf16_t* proj = (const bf16_t*)(wsl_ + WS_R + R_PROJ); const float* sm = (const float*)(wsl_ + WS_R + R_SM);
    const int tokl = 8 * wid + tl, tq = ib * 64 + tokl; const size_t rowc = (size_t)bl * SEQ + tq;
    bf16x8 qf[4]; load_qf(qf, proj + rowc * PROJW + PC_NQ + hd * 64, hi);
    const float g0 = sigmoidf_(sm[rowc * 32 + 8 + hd * 3 + 0]), g1 = sigmoidf_(sm[rowc * 32 + 8 + hd * 3 + 1]), g2 = sigmoidf_(sm[rowc * 32 + 8 + hd * 3 + 2]);
    f32x16 of[2];
    const int ntc = min(3, (4 * ib + 2) >> 6) + 1;
    {
        const bf16_t* kc = (const bf16_t*)(wsl_ + WS_R + R_KCMP) + (size_t)bl * 256 * 64; const bf16_t* vc = kc + (size_t)BC * 256 * 64;
        __syncthreads();
        for (int tt = 0; tt < ntc; ++tt) {
            *(LAS u32x4*)(lds + NL_KC + tt * 8192 + wid * 1024 + lane * 16) = *(const u32x4*)(kc + (size_t)(tt * 64 + lane) * 64 + wid * 8);
            *(LAS u32x4*)(lds + NL_VC + tt * 8192 + wid * 1024 + lane * 16) = *(const u32x4*)(vc + (size_t)(tt * 64 + 16 * (wid & 3) + (lane >> 2)) * 64 + (wid >> 2) * 32 + (lane & 3) * 8); }
        __syncthreads();
        float m = -INFINITY, l = 0.f;
        for (int tt = 0; tt < ntc; ++tt) { f32x16 p0, p1; attn_qkt(p0, p1, lds + NL_KC + tt * 8192, qf, r32, hi);
#pragma unroll
            for (int r = 0; r < 16; ++r) { const int n0 = 64 * tt + crow(r, hi), n1 = n0 + 32; if (n0 >= 255 || 16 * n0 + 31 > tq) p0[r] = -INFINITY; if (n1 >= 255 || 16 * n1 + 31 > tq) p1[r] = -INFINITY; }
            float mt = p0[0];
#pragma unroll
            for (int r = 1; r < 16; ++r) mt = fmaxf(mt, p0[r]);
#pragma unroll
            for (int r = 0; r < 16; ++r) mt = fmaxf(mt, p1[r]);
            mt = x32_max(mt);
            const float mn = fmaxf(m, mt), ms = (mn == -INFINITY) ? 0.f : mn; float s = 0.f;
#pragma unroll
            for (int r = 0; r < 16; ++r) s += ex2(p0[r] - ms) + ex2(p1[r] - ms);
            l = l * ex2(m - ms) + s; m = mn; }
        l = x32_sum(l);
        const float inv = (l > 0.f) ? 1.0f / l : 0.f, ms = (m == -INFINITY) ? 0.f : m;
        LAS float* impm = (LAS float*)(lds + NL_IMPM); LAS float* imps = (LAS float*)(lds + NL_IMPS);
        f32x16 oc[2]; oc[0] = z16(); oc[1] = z16();
        for (int tt = 0; tt < ntc; ++tt) { f32x16 p0, p1; attn_qkt(p0, p1, lds + NL_KC + tt * 8192, qf, r32, hi);
#pragma unroll
            for (int r = 0; r < 16; ++r) { const int n0 = 64 * tt + crow(r, hi), n1 = n0 + 32;
                p0[r] = (n0 >= 255 || 16 * n0 + 31 > tq) ? 0.f : ex2(p0[r] - ms) * inv; p1[r] = (n1 >= 255 || 16 * n1 + 31 > tq) ? 0.f : ex2(p1[r] - ms) * inv; }
#pragma unroll
            for (int g = 0; g < 4; ++g) {
                float ma = p0[4 * g] + p0[4 * g + 1] + p0[4 * g + 2] + 0.5f * p0[4 * g + 3], sa = 0.5f * p0[4 * g + 3];
                float mb = p1[4 * g] + p1[4 * g + 1] + p1[4 * g + 2] + 0.5f * p1[4 * g + 3], sb = 0.5f * p1[4 * g + 3];
                ma += swz_xor<1>(ma); ma += swz_xor<2>(ma); sa += swz_xor<1>(sa); sa += swz_xor<2>(sa);
                mb += swz_xor<1>(mb); mb += swz_xor<2>(mb); sb += swz_xor<1>(sb); sb += swz_xor<2>(sb);
                if (hd == 0) { const int ja = 16 * tt + 2 * g + hi, jb = ja + 8;
                    impm[tokl * 64 + ja] = ma; imps[tokl * 65 + ja + 1] = sa; impm[tokl * 64 + jb] = mb; imps[tokl * 65 + jb + 1] = sb; } }
            bf16x8 pw[4]; pw[0] = pack_acc8(p0, 0); pw[1] = pack_acc8(p0, 1); pw[2] = pack_acc8(p1, 0); pw[3] = pack_acc8(p1, 1);
            attn_pv(oc, lds + NL_VC + tt * 8192, pw, lane, hi); }
        of[0] = oc[0] * g0; of[1] = oc[1] * g0;
        LAS unsigned long long* selm = (LAS unsigned long long*)(lds + NL_SELM);
        if (ib < 16) { if (lane < 8) selm[8 * wid + lane] = (2ull << ib) - 1ull; }
        else for (int t8 = 0; t8 < 8; ++t8) { const int tk = 8 * wid + t8; const int j = lane;
            float imp = (j < 16 * ntc) ? impm[tk * 64 + j] + ((j > 0) ? imps[tk * 65 + j] : 0.f) : 0.f;
            const bool forced = (j == 0) || (j == ib) || (j == ib - 1);
            const float score = forced ? 1.0e4f : ((j <= ib) ? imp : -1.0f);
            int rank = 0;
#pragma unroll
            for (int jj = 0; jj < 64; ++jj) { const float sj = __uint_as_float(__builtin_amdgcn_readlane(__float_as_uint(score), jj)); rank += ((sj > score) || (sj == score && jj < j)) ? 1 : 0; }
            const unsigned long long mk = __ballot((rank < 16) && (j <= ib));
            if (lane == 0) selm[tk] = mk; }
    }
    __syncthreads();
    unsigned long long mymask, umask, wmask;
    { const LAS unsigned long long* selm = (const LAS unsigned long long*)(lds + NL_SELM); mymask = selm[tokl];
      unsigned long long u = selm[lane]; unsigned lo = (unsigned)u, hi32 = (unsigned)(u >> 32);
      lo |= swz_xor_u<1>(lo); lo |= swz_xor_u<2>(lo); lo |= swz_xor_u<4>(lo); lo |= swz_xor_u<8>(lo); lo |= swz_xor_u<16>(lo); lo = x32_or(lo);
      hi32 |= swz_xor_u<1>(hi32); hi32 |= swz_xor_u<2>(hi32); hi32 |= swz_xor_u<4>(hi32); hi32 |= swz_xor_u<8>(hi32); hi32 |= swz_xor_u<16>(hi32); hi32 = x32_or(hi32);
      umask = ((unsigned long long)hi32 << 32) | lo; umask = __builtin_amdgcn_readfirstlane((unsigned)umask) | ((unsigned long long)__builtin_amdgcn_readfirstlane((unsigned)(umask >> 32)) << 32);
      unsigned wl = 0u, wh = 0u;
#pragma unroll
      for (int t8 = 0; t8 < 8; ++t8) { const unsigned long long mk = selm[8 * wid + t8]; wl |= (unsigned)mk; wh |= (unsigned)(mk >> 32); }
      wmask = (unsigned long long)(unsigned)__builtin_amdgcn_readfirstlane((int)wl) | ((unsigned long long)(unsigned)__builtin_amdgcn_readfirstlane((int)wh) << 32); }
    for (int br = 0; br < 2; ++br) {
        f32x16 o[2]; o[0] = z16(); o[1] = z16(); float m = -INFINITY, l = 0.f;
        SelF f; f.umask = br ? ~0ull : umask; f.wmask = br ? ~0ull : wmask; f.mymask = br ? ~0ull : mymask; f.tq = tq; f.klo = br ? tq - 512 : -1; f.hi = hi; f.tdiag = ib; f.tlo = br ? (ib * 64 + 63 - 512) / 64 : -1;
        const bf16_t* nkv2 = (const bf16_t*)(ws_late() + WS_R + R_NKV);
        flash_loop(f, br ? max(0, ib - 8) : 0, ib + 1, nkv2 + (size_t)(2 + 2 * br) * (NKV_SEG / 2) + (size_t)bl * SEQ * 64, nkv2 + (size_t)(3 + 2 * br) * (NKV_SEG / 2) + (size_t)bl * SEQ * 64, 64, nullptr, qf, o, m, l, lds, tid);
        l = x32_sum(l); const float sc = (l > 0.f) ? (br ? g2 : g1) / l : 0.f; of[0] += o[0] * sc; of[1] += o[1] * sc;
    }
    store_ot(of, (bf16_t*)(ws_late() + WS_R + R_O) + (size_t)2 * MC * 256 + rowc * 256 + hd * 64, hi);
}

constexpr int LDS_MISC = LDS_BYTES - 256;
constexpr size_t LWS = ((LW_BYTES + MiB - 1) / MiB) * MiB;
#define PHASE_PRE const int tid = fresh_tid(); int l, ch; { int k_; bool b_; step_decode(__builtin_amdgcn_readfirstlane(((volatile LAS int*)lds_at(LDS_MISC + 176))[0]), k_, l, ch, b_); } \
    Params p; ptab_load(p); LAS unsigned char* lds = lds_at(0); const int G = NWG; \
    const int c = __builtin_amdgcn_readfirstlane(((volatile LAS int*)(lds + LDS_MISC + 176))[2]); (void)lds; (void)G; (void)c; (void)l; (void)ch; \
    volatile LAS int* qslot = (volatile LAS int*)(lds + LDS_MISC + 16); (void)qslot;
#define LW_ (p.ws + WS_W + (size_t)l * LWS)
#define LWO_ ((unsigned)(WS_W + (size_t)l * LWS))
#define HC_ ((unsigned)(WS_H + (size_t)ch * MC * 1024 * 2))
#define QCTR_ ((unsigned*)(p.ws + WS_CTL) + CW_Q + 64 * ((l * NCHUNK + ch) * 8) + 8192 * __builtin_amdgcn_readfirstlane(((volatile LAS int*)lds_at(LDS_MISC + 176))[3]))
__device__ __forceinline__ int tid_out(int t) { asm volatile("" : "+v"(t)); return t; }
__device__ __forceinline__ int fresh_tid() {
    LAS unsigned* ctr = (LAS unsigned*)lds_at(LDS_MISC + 192);
    unsigned z = 0u; asm volatile("" : "+v"(z));
    const int lane = (int)__builtin_amdgcn_mbcnt_hi(~0u, __builtin_amdgcn_mbcnt_lo(~0u, z));
    unsigned t = 0u; if (lane == 0) t = __hip_atomic_fetch_add(ctr, 1u, __ATOMIC_RELAXED, __HIP_MEMORY_SCOPE_WORKGROUP);
    t = (unsigned)__builtin_amdgcn_readfirstlane((int)t);
    __syncthreads();
    return (int)(((t & 7u) << 6) | (unsigned)lane);
}
__device__ __forceinline__ void step_decode(int s, int& k, int& l, int& ch, bool& bar);
#define GCTR_(j) ((unsigned*)(p.ws + WS_CTL) + CW_G + 64 * ((l * NCHUNK + ch) * 8 + (j)) + 16384 * __builtin_amdgcn_readfirstlane(((volatile LAS int*)lds_at(LDS_MISC + 176))[3]))
#define PHFN(name) static __device__ __noinline__ void name()
#define PHFI(name) static __device__ __forceinline__ void name()

PHFI(ph_p0) { PHASE_PRE
    constexpr int N_ADA = 192, N_CB = 4, N_ROPE = MTOK * 32 / 4096, N_T = 2 * TJ_TOTAL;
    for (int it = c; it < N_ADA + N_CB + N_ROPE; it += G) {
        if (it < N_ADA) p0_ada(p, it, (LAS float*)lds, tid);
        else if (it < N_ADA + N_CB) p0_cbias(p, it - N_ADA, tid);
        else p0_rope(p, it - N_ADA - N_CB, tid);
    }
    for (int it = c; it < N_T; it += 4 * G) p0_transpose4(p, it, G, N_T, (LAS float*)lds, tid);
}
PHFN(ph_p1) { PHASE_PRE prep_first(p, tid, c); }
PHFI(ph_a1) { PHASE_PRE
    DenseSched S; S.A = HC_; S.Bt = LWO_ + (unsigned)LW_WIN; S.tA = 256u * 1024 * 2; S.tB = 256u * 1024 * 2; S.aBr = 0; S.nM = MC / 256; S.nN = NPROJ / 256; S.G = G; S.c = c; S.pnShift = 0; S.ctr = GCTR_(0);
    EpiProj E;
    pg8::gemm_phase<EpiProj, DenseSched, true, false>(lds, 1024, 1024, 1024, S, E, tid, (const char*)p.ws);
}
PHFN(ph_a2a) { PHASE_PRE
    if (c < 2 * BC) {
        const int which = c & 1, bl = c >> 1;
        OneSched S; S.has = true; S.u0.pm = bl; S.u0.pn = 0; S.u0.aux = which; S.u0.nvalid = 256; S.u0.rows = 0u;
        S.u0.a = (unsigned)(WS_R + R_NKV + (size_t)which * NKV_SEG + (size_t)bl * SEQ * 64 * 2); S.u0.b = LWO_ + (unsigned)(LW_CW1 + (size_t)which * 256 * 2048 * 2);
        EpiH1 E; E.h1 = (bf16_t*)(p.ws + WS_R + R_H1); E.cbias = (const float*)(p.ws + WS_CBIAS) + l * 512;
        pg8::gemm_phase<EpiH1, OneSched, true, false>(lds, 2048, 1024, 2048, S, E, tid, (const char*)p.ws);
        VM_WAIT(); __syncthreads(); __builtin_amdgcn_fence(__ATOMIC_ACQUIRE, "agent"); VM_WAIT(); __syncthreads();
    }
}
PHFN(ph_a2b) { PHASE_PRE
    if (c < 2 * BC) {
        const int which = c & 1, bl = c >> 1;
        OneSched S2; S2.has = true; S2.u0.pm = bl; S2.u0.pn = 0; S2.u0.aux = which; S2.u0.nvalid = 256; S2.u0.rows = 0u;
        S2.u0.a = (unsigned)(WS_R + R_H1 + ((size_t)which * BC * 256 + (size_t)bl * 256) * 256 * 2); S2.u0.b = LWO_ + (unsigned)(LW_CW2 + (size_t)which * 256 * 256 * 2);
        EpiCmp2 E2; E2.kc = (bf16_t*)(p.ws + WS_R + R_KCMP);
        pg8::gemm_phase<EpiCmp2, OneSched, true, false>(lds, 256, 256, 256, S2, E2, tid, (const char*)p.ws);
    }
}
PHFI(ph_a2c) { PHASE_PRE
    unsigned* qc = QCTR_ + 0; const int NU = BC * 4 * 64;
    int u = q_next(qc, qslot, tid), un = q_next(qc, qslot, tid);
    GdnRaw ga; if (u < NU) gdn_prep_load(ga, u, tid);
    while (u < NU) {
        int tk = 0x3fffffff; if (tid == 0) tk = (int)__hip_atomic_fetch_add(qc, 1u, __ATOMIC_RELAXED, __HIP_MEMORY_SCOPE_AGENT);
        GdnRaw gn = ga; if (un < NU) gdn_prep_load(gn, un, tid);
        gdn_prep_unit(p, l, u, lds, tid, ga);
        if (tid == 0) *qslot = tk;
        __syncthreads();
        const int unn = *qslot;
        __syncthreads();
        u = un; un = unn; ga = gn;
    }
}
PHFN(ph_a2d) { PHASE_PRE
    for (;;) { const int u = q_next(QCTR_ + 64, qslot, tid); if (u >= BC * 4) break; fox_cum_item(p, l, u, (LAS float*)lds, tid); }
    for (;;) { const int u = q_next(QCTR_ + 320, qslot, tid); if (u >= BC * 4 * 32) break; ret_kv_unit(p, ch, u, lds, tid); }
}
PHFN(ph_a3a) { PHASE_PRE if (c < BC * 4) gdn_scan_item(p, l, ch, c, lds, tid); }
PHFI(ph_a3b) { PHASE_PRE for (;;) { const int u = q_next(QCTR_ + 128, qslot, tid); if (u >= BC * 4 * 16) break; fox_unit(p, u, lds, tid); } }
PHFI(ph_a3c) { PHASE_PRE for (;;) { const int u = q_next(QCTR_ + 192, qslot, tid); if (u >= BC * 4 * 16) break; ret_out_unit(p, l, ch, u, lds, tid); } }
PHFI(ph_a3d) { PHASE_PRE for (;;) { const int u = q_next(QCTR_ + 256, qslot, tid); if (u >= BC * 64) break; nsa_unit(p, u, lds, tid); } }
PHFN(ph_a5) { PHASE_PRE
    DenseSched S; S.A = (unsigned)(WS_R + R_O); S.Bt = LWO_ + (unsigned)LW_BPT; S.tA = 256u * 256 * 2; S.tB = 256u * 256 * 2; S.aBr = (unsigned)((size_t)MC * 256 * 2); S.nM = MC / 256; S.nN = 16; S.G = G; S.c = c; S.pnShift = 2; S.ctr = GCTR_(1);
    EpiP E;
    pg8::gemm_phase<EpiP, DenseSched, true, false>(lds, 256, 256, 256, S, E, tid, (const char*)p.ws);
}
PHFN(ph_a6) { PHASE_PRE
    DenseSched S; S.A = HC_; S.Bt = LWO_ + (unsigned)LW_WGV; S.tA = 256u * 1024 * 2; S.tB = 256u * 1024 * 2; S.aBr = 0; S.nM = MC / 256; S.nN = 16; S.G = G; S.c = c; S.pnShift = 0; S.ctr = GCTR_(2);
    EpiGate E;
    pg8::gemm_phase<EpiGate, DenseSched, true, false>(lds, 1024, 1024, 1024, S, E, tid, (const char*)p.ws);
}
PHFN(ph_a7) { PHASE_PRE
    DenseSched S; S.A = (unsigned)(WS_R + R_Y); S.Bt = LWO_ + (unsigned)LW_WOT; S.tA = 256u * 1024 * 2; S.tB = 256u * 1024 * 2; S.aBr = 0; S.nM = MC / 256; S.nN = 4; S.G = G; S.c = c; S.pnShift = 0; S.ctr = GCTR_(3);
    EpiOut E; E.row_base = ch * MC;
    pg8::gemm_phase<EpiOut, DenseSched, true, false>(lds, 1024, 1024, 1024, S, E, tid, (const char*)p.ws);
}
PHFN(ph_b0) { PHASE_PRE prep_moe(p, l, (LAS float*)lds, tid, c); }
__device__ __forceinline__ void moe_tables(const Params& p, int l, LAS int* mcnt, LAS int* mpre, const int tid) {
    __syncthreads();
    if (tid < 16) mcnt[tid] = (int)((unsigned*)(p.ws + WS_CTL))[CW_CNT + l * 64 + tid];
    __syncthreads();
    if (tid == 0) { int s = 0; for (int e = 0; e < 16; ++e) { mpre[e] = s; s += (mcnt[e] + 255) >> 8; } mpre[16] = s; }
    __syncthreads();
}
PHFI(ph_b1) { PHASE_PRE
    LAS int* mcnt = (LAS int*)(lds + LDS_MISC + 32); LAS int* mpre = mcnt + 16; moe_tables(p, l, mcnt, mpre, tid);
    MoeSched S; S.pre = mpre; S.cnt = mcnt; S.wsb = (const char*)p.ws; S.A = (unsigned)WS_H; S.W = LWO_ + (unsigned)LW_W13;
    S.wE = 1024u * 1024 * 2; S.wT = 256u * 1024 * 2; S.aT = 0; S.G = G; S.c = c; S.gatherA = true; S.ctr = GCTR_(4);
    EpiMoe1 E;
    pg8::gemm_phase<EpiMoe1, MoeSched, true, true>(lds, 1024, 1024, 1024, S, E, tid, (const char*)p.ws);
}
PHFN(ph_b2) { PHASE_PRE
    LAS int* mcnt = (LAS int*)(lds + LDS_MISC + 32); LAS int* mpre = mcnt + 16; moe_tables(p, l, mcnt, mpre, tid);
    MoeSched S; S.pre = mpre; S.cnt = mcnt; S.wsb = (const char*)p.ws; S.A = (unsigned)(WS_R + R_HID); S.W = LWO_ + (unsigned)LW_W2;
    S.wE = 1024u * 512 * 2; S.wT = 256u * 512 * 2; S.aT = 256u * 512 * 2; S.G = G; S.c = c; S.gatherA = false; S.ctr = GCTR_(5);
    EpiMoe2 E;
    pg8::gemm_phase<EpiMoe2, MoeSched, true, false>(lds, 512, 512, 512, S, E, tid, (const char*)p.ws);
}
PHFN(ph_b3) { PHASE_PRE prep_next(p, l, l == DEPTH - 1, tid, c); }

constexpr int STEPS_CHUNK = 12, STEPS_LAYER = NCHUNK * STEPS_CHUNK + 4, N_STEPS = 2 + DEPTH * STEPS_LAYER;
__device__ __forceinline__ void step_decode(int s, int& k, int& l, int& ch, bool& bar) {
    if (s < 2) { k = s; l = 0; ch = 0; bar = true; return; }
    const int t = s - 2; l = t / STEPS_LAYER; const int r = t % STEPS_LAYER;
    if (r < NCHUNK * STEPS_CHUNK) { ch = r / STEPS_CHUNK; const int q = r % STEPS_CHUNK; k = 2 + q; bar = !(q == 1 || q == 2 || q == 3 || q == 5 || q == 6 || q == 7); }
    else { ch = 0; k = 14 + (r - NCHUNK * STEPS_CHUNK); bar = true; }
}
__global__ void __launch_bounds__(NTHR, 2) __attribute__((disable_tail_calls)) mega_fwd(Params p0_) {
    LAS unsigned char* lds = lds_at(0);
    const int tid = threadIdx.x;
    volatile LAS unsigned* xbw = (volatile LAS unsigned*)(lds + LDS_MISC);
    volatile LAS int* st = (volatile LAS int*)(lds + LDS_MISC + 176);
    if (tid == 0) { xbw[0] = 0u; xbw[1] = 0u; xbw[2] = 0u; xbw[3] = 0u; st[0] = p0_.ph_lo; st[1] = p0_.ph_hi; st[2] = blockIdx.x; st[3] = 0; *(volatile LAS unsigned*)(lds + LDS_MISC + 200) = 0u; *(volatile LAS unsigned*)(lds + LDS_MISC + 192) = 0u; }
    ptab_store(p0_, tid);
    __syncthreads();
    (void)xcd_barrier_post((unsigned*)(p0_.ws + WS_CTL) + CW_BAR, xbw, tid);
#ifdef PROBE_CLOCK
    if (tid == 0) { volatile LAS unsigned long long* tc_ = (volatile LAS unsigned long long*)(lds + LDS_MISC + 216); tc_[0] = __builtin_amdgcn_s_memrealtime(); tc_[1] = __builtin_amdgcn_s_memtime(); }
#endif
    for (;;) {
        {
          LAS unsigned char* mb_ = lds_at(LDS_MISC); volatile LAS int* st_ = (volatile LAS int*)(mb_ + 176);
          const int s = __builtin_amdgcn_readfirstlane(st_[0]), e = __builtin_amdgcn_readfirstlane(st_[1]);
          if (s >= e) break;
          int k, l, ch; bool bar; step_decode(s, k, l, ch, bar);
#ifdef PROBE_STEPTIME
          if (threadIdx.x == 0) { volatile LAS unsigned long long* tp_ = (volatile LAS unsigned long long*)(mb_ + 208); tp_[0] = __builtin_amdgcn_s_memrealtime(); }
#endif
          switch (k) {
          case 0: ph_p0(); break;
          case 1: ph_p1(); break;
          case 2: ph_a1(); break;
          case 3: ph_a2a(); break;
          case 4: ph_a2b(); break;
          case 5: ph_a2c(); break;
          case 6: ph_a2d(); break;
          case 7: ph_a3a(); break;
          case 8: ph_a3b(); break;
          case 9: ph_a3c(); break;
          case 10: ph_a3d(); break;
          case 11: ph_a5(); break;
          case 12: ph_a6(); break;
          case 13: ph_a7(); break;
          case 14: ph_b0(); break;
          case 15: ph_b1(); break;
          case 16: ph_b2(); break;
          default: ph_b3(); break;
          } }
#ifdef PROBE_STEPTIME
        { LAS unsigned char* mb2_ = lds_at(LDS_MISC); const int s2_ = __builtin_amdgcn_readfirstlane(((volatile LAS int*)(mb2_ + 176))[0]); int k2_, l2_, c2_; bool b2_; step_decode(s2_, k2_, l2_, c2_, b2_);
          __syncthreads();
          if (threadIdx.x == 0 && ((PROBE_STEPTIME >> k2_) & 1)) { volatile LAS unsigned long long* tp_ = (volatile LAS unsigned long long*)(mb2_ + 208); volatile LAS unsigned* ac_ = (volatile LAS unsigned*)(mb2_ + 200);
              ac_[0] = ac_[0] + (unsigned)(__builtin_amdgcn_s_memrealtime() - tp_[0]); } }
#endif
        { const int tid = fresh_tid(); LAS unsigned char* mb_ = lds_at(LDS_MISC); volatile LAS int* st_ = (volatile LAS int*)(mb_ + 176);
          volatile LAS unsigned* xbw_ = (volatile LAS unsigned*)mb_;
          const int s = __builtin_amdgcn_readfirstlane(st_[0]), e = __builtin_amdgcn_readfirstlane(st_[1]);
          int k, l, ch; bool bar; step_decode(s, k, l, ch, bar);
#ifdef DUP_MASK
          const bool adv_ = !(((DUP_MASK >> k) & 1) && __builtin_amdgcn_readfirstlane(st_[3]) == 0);
#else
          const bool adv_ = true;
#endif
          if (adv_ && bar && s + 1 < e) { XcdBarrier b; b.bar = (unsigned*)((unsigned char*)ptab_get(28) + WS_CTL) + CW_BAR; b.x = xb_xcc_id(); b.st = xbw_;
#ifdef PROBE_BARWAIT
              __syncthreads(); const unsigned long long t0_ = __builtin_amdgcn_s_memrealtime();
              xcd_barrier(b, tid);
              const unsigned long long t1_ = __builtin_amdgcn_s_memrealtime(); if (tid == 0) { volatile LAS unsigned* ac_ = (volatile LAS unsigned*)(mb_ + 200); ac_[0] = ac_[0] + (unsigned)(t1_ - t0_); }
#else
              xcd_barrier(b, tid);
#endif
          }
          __syncthreads();
#ifdef DUP_MASK
          const int rp = __builtin_amdgcn_readfirstlane(st_[3]);
          if (((DUP_MASK >> k) & 1) && rp == 0) { if (tid == 0) st_[3] = 1; }
          else { if (tid == 0) { st_[3] = 0; st_[0] = s + 1; } }
#else
          if (tid == 0) st_[0] = s + 1;
#endif
          __syncthreads(); }
    }
#ifdef PROBE_CLOCK
    { volatile LAS unsigned long long* tc_ = (volatile LAS unsigned long long*)(lds_at(LDS_MISC) + 216); const unsigned long long r1 = __builtin_amdgcn_s_memrealtime(), c1 = __builtin_amdgcn_s_memtime();
      const unsigned long long dr = r1 - tc_[0], dc = c1 - tc_[1];
      const unsigned long long w = dc / 24ull; const unsigned long long t0_ = __builtin_amdgcn_s_memrealtime();
      while (__builtin_amdgcn_s_memrealtime() - t0_ < w) __builtin_amdgcn_s_sleep(8); (void)dr; }
#endif
#if defined(PROBE_BARWAIT) || defined(PROBE_STEPTIME)
    { const unsigned w_ = *(volatile LAS unsigned*)(lds_at(LDS_MISC) + 200); const unsigned long long t0_ = __builtin_amdgcn_s_memrealtime();
      while (__builtin_amdgcn_s_memrealtime() - t0_ < (unsigned long long)w_) __builtin_amdgcn_s_sleep(8); }
#endif
}

extern "C" void kernel_launch(void* const* d_in, const int* in_sizes, int n_in, void* d_out, int out_size, void* d_ws, size_t ws_size, hipStream_t stream) {
    (void)in_sizes; (void)out_size;
    if (n_in < 27 || ws_size < WS_END) { fprintf(stderr, "kernel_launch: unexpected inputs (n_in %d, ws %zu < %zu)\n", n_in, ws_size, (size_t)WS_END); return; }
    static bool attr_set = false;
    if (!attr_set) { (void)hipFuncSetAttribute((const void*)mega_fwd, hipFuncAttributeMaxDynamicSharedMemorySize, LDS_BYTES); attr_set = true; }
    Params p{};
    for (int i = 0; i < 27; ++i) p.in[i] = (const float*)d_in[i];
    p.out = (float*)d_out; p.ws = (unsigned char*)d_ws;
    (void)hipMemsetAsync((unsigned char*)d_ws + WS_CTL, 0, CTL_BYTES, stream);
#ifndef MK_CUTS
    p.ph_lo = 0; p.ph_hi = N_STEPS;
    hipLaunchKernelGGL(mega_fwd, dim3(NWG), dim3(NTHR), LDS_BYTES, stream, p);
#else
    { static const int cuts[] = {MK_CUTS, N_STEPS}; int lo = 0;
      for (unsigned i = 0; i < sizeof(cuts) / sizeof(cuts[0]); ++i) { p.ph_lo = lo; p.ph_hi = cuts[i]; lo = cuts[i]; hipLaunchKernelGGL(mega_fwd, dim3(NWG), dim3(NTHR), LDS_BYTES, stream, p); } }
#endif
}
```

```cpp
#include <hip/hip_runtime.h>
#include <stdint.h>
#include <stdio.h>

#define GAS __attribute__((address_space(1)))
#define LAS __attribute__((address_space(3)))
typedef unsigned short bf16_t;
typedef short bf16x8 __attribute__((ext_vector_type(8)));
typedef short s16x4 __attribute__((ext_vector_type(4)));
typedef float f32x2 __attribute__((ext_vector_type(2)));
typedef float f32x4 __attribute__((ext_vector_type(4)));
typedef float f32x16 __attribute__((ext_vector_type(16)));
typedef unsigned u32x2 __attribute__((ext_vector_type(2)));
typedef unsigned u32x4 __attribute__((ext_vector_type(4)));
typedef __bf16 bf16x2_t __attribute__((ext_vector_type(2)));

constexpr int D_MODEL = 1024, BATCH = 16, SEQ = 4096, DEPTH = 2, MTOK = BATCH * SEQ;
constexpr int NCHUNK = 2, BC = BATCH / NCHUNK, MC = BC * SEQ;
constexpr int NPROJ = 3584, PROJW = 3072;
constexpr float DN_ALPHA = 1.4142135623730951f;
constexpr float LN_EPS = 1e-5f;
constexpr float LOG2E = 1.4426950408889634f;
constexpr float QSCALE = 0.125f * 1.4426950408889634f;
constexpr int NWG = 256, NTHR = 512;
constexpr int LDS_BYTES = 163840;

constexpr int PC_GQ = 0, PC_GK = 256, PC_GV = 512, PC_GZ = 768, PC_RQ = 1024, PC_RK = 1280, PC_RV = 1536, PC_RG = 1792, PC_NQ = 2048, PC_FQ = 2304, PC_FK = 2560, PC_FV = 2816;

constexpr size_t MiB = 1ull << 20;
constexpr size_t WS_CTL = 0;
constexpr size_t CTL_BYTES = 1 * MiB;
constexpr size_t WS_MOD = 1 * MiB;
constexpr size_t WS_ROPE = 2 * MiB;
constexpr size_t WS_STATS = 18 * MiB;
constexpr size_t WS_CBIAS = 19 * MiB;
constexpr size_t WS_W = 20 * MiB;
constexpr size_t LW_WIN = 0;
constexpr size_t LW_WGV = LW_WIN + (size_t)NPROJ * 1024 * 2;
constexpr size_t LW_BPT = LW_WGV + (size_t)4096 * 1024 * 2;
constexpr size_t LW_WOT = LW_BPT + (size_t)4096 * 256 * 2;
constexpr size_t LW_W13 = LW_WOT + (size_t)1024 * 1024 * 2;
constexpr size_t LW_W2 = LW_W13 + (size_t)16 * 1024 * 1024 * 2;
constexpr size_t LW_CW1 = LW_W2 + (size_t)16 * 1024 * 512 * 2;
constexpr size_t LW_CW2 = LW_CW1 + (size_t)2 * 256 * 2048 * 2;
constexpr size_t LW_BYTES = LW_CW2 + (size_t)2 * 256 * 256 * 2;
constexpr size_t WS_H = WS_W + 2 * ((LW_BYTES + MiB - 1) / MiB) * MiB;
constexpr size_t WS_R = WS_H + 128 * MiB;
constexpr size_t R_PROJ = 0;
constexpr size_t R_GDN = R_PROJ + (size_t)MC * PROJW * 2;
constexpr size_t GDN_UNIT_BYTES = 5 * 8192;
constexpr size_t R_P = 0;
constexpr size_t R_NKV = R_GDN + (size_t)BC * 4 * 64 * GDN_UNIT_BYTES;
constexpr size_t NKV_SEG = (size_t)(MC + 64) * 64 * 2;
constexpr size_t R_SM = R_NKV + 6 * NKV_SEG;
constexpr size_t R_CUM = R_SM + (size_t)MC * 32 * 4;
constexpr size_t R_GG = R_CUM + (size_t)BC * 4 * 4096 * 4;
constexpr size_t R_KCMP = R_GG + (size_t)BC * 4 * 64 * 4 + 768;
constexpr size_t R_H1 = R_KCMP + (size_t)2 * BC * 256 * 64 * 2;
constexpr size_t R_O = R_H1 + (size_t)2 * BC * 256 * 256 * 2;
constexpr size_t R_Y = R_O + (size_t)4 * MC * 256 * 2;
constexpr size_t R_KVT = R_Y + (size_t)MC * 1024 * 2;
constexpr size_t R_MIX_END = R_KVT + (size_t)BC * 4 * 32 * 4096 * 4;
static_assert(R_NKV >= (size_t)MC * 4096 * 2, "P overlay fits under PROJ+GDN");
constexpr size_t R_LIST = 0;
constexpr size_t R_CW = R_LIST + (size_t)16 * MTOK * 4;
constexpr size_t R_HID = R_CW + (size_t)16 * MTOK * 4;
constexpr size_t R_OUT2 = R_HID + (size_t)(2 * MTOK + 4096) * 512 * 2;
constexpr size_t R_MOE_END = R_OUT2 + (size_t)2 * MTOK * 1024 * 2;
constexpr size_t WS_T = WS_R + (((R_MIX_END > R_MOE_END ? R_MIX_END : R_MOE_END) + MiB - 1) / MiB) * MiB;
constexpr size_t WS_H8 = WS_T + (size_t)MTOK * 1024 * 2;
constexpr size_t WS_END = WS_H8 + (size_t)MTOK * 1024;
constexpr float H8_SCALE = 16.0f, W8_SCALE = 256.0f, F8_DESCALE = 1.0f / (16.0f * 256.0f);

constexpr int CW_BAR = 4096;
constexpr int CW_CNT = 8192;
constexpr int CW_Q = 8448;
constexpr int CW_G = 65536;

__device__ __forceinline__ float bf2f(bf16_t v) { return __uint_as_float(((unsigned)v) << 16); }
__device__ __forceinline__ unsigned pk2(float lo, float hi) { f32x2 v = {lo, hi}; bf16x2_t b = __builtin_convertvector(v, bf16x2_t); return __builtin_bit_cast(unsigned, b); }
__device__ __forceinline__ float clamp8(float x) { return fminf(fmaxf(x, -448.0f), 448.0f); }
__device__ __forceinline__ unsigned pk4_fp8(float a, float b, float c, float d) { int v = __builtin_amdgcn_cvt_pk_fp8_f32(clamp8(a), clamp8(b), 0, false); v = __builtin_amdgcn_cvt_pk_fp8_f32(clamp8(c), clamp8(d), v, true); return (unsigned)v; }
__device__ __forceinline__ bf16_t f2bf(float f) { return (bf16_t)(pk2(f, 0.f) & 0xffffu); }
__device__ __forceinline__ float ex2(float x) { return __builtin_amdgcn_exp2f(x); }
__device__ __forceinline__ float sigmoidf_(float x) { return __builtin_amdgcn_rcpf(1.0f + __expf(-x)); }
__device__ __forceinline__ float siluf_(float x) { return x * __builtin_amdgcn_rcpf(1.0f + __expf(-x)); }
__device__ __forceinline__ int crow(int r, int hi) { return (r & 3) + 8 * (r >> 2) + 4 * hi; }
template <int M> __device__ __forceinline__ float swz_xor(float v) { return __builtin_bit_cast(float, __builtin_amdgcn_ds_swizzle(__builtin_bit_cast(int, v), 0x1f | (M << 10))); }
template <int M> __device__ __forceinline__ unsigned swz_xor_u(unsigned v) { return (unsigned)__builtin_amdgcn_ds_swizzle((int)v, 0x1f | (M << 10)); }
__device__ __forceinline__ float x32_sum(float v) { auto r = __builtin_amdgcn_permlane32_swap(__float_as_uint(v), __float_as_uint(v), false, false); return __uint_as_float(r[0]) + __uint_as_float(r[1]); }
__device__ __forceinline__ float x32_max(float v) { auto r = __builtin_amdgcn_permlane32_swap(__float_as_uint(v), __float_as_uint(v), false, false); return fmaxf(__uint_as_float(r[0]), __uint_as_float(r[1])); }
__device__ __forceinline__ unsigned x32_or(unsigned v) { auto r = __builtin_amdgcn_permlane32_swap(v, v, false, false); return r[0] | r[1]; }
__device__ __forceinline__ float shfl_up_l(float v, int o, int lane) { return __builtin_bit_cast(float, __builtin_amdgcn_ds_bpermute((lane - o) << 2, __builtin_bit_cast(int, v))); }
__device__ __forceinline__ float wave_sum(float v) {
    v += swz_xor<1>(v); v += swz_xor<2>(v); v += swz_xor<4>(v); v += swz_xor<8>(v); v += swz_xor<16>(v);
    return x32_sum(v);
}
__device__ __forceinline__ float ninf_() { float z = -INFINITY; asm volatile("" : "+v"(z)); return z; }
__device__ __forceinline__ f32x4 z4() { float z = 0.f; asm volatile("" : "+v"(z)); return (f32x4){z, z, z, z}; }
__device__ __forceinline__ f32x16 z16() { float z = 0.f; asm volatile("" : "+v"(z)); f32x16 r;
#pragma unroll
    for (int i = 0; i < 16; ++i) r[i] = z;
    return r; }
#define VM_WAIT() asm volatile("s_waitcnt vmcnt(0)" ::: "memory")
#define MF32(a, b, c) __builtin_amdgcn_mfma_f32_32x32x16_bf16(a, b, c, 0, 0, 0)

#define XB_TMO      128
#define XB_XCNT(j)  (256  + 64 * (j))
#define XB_XSUB(j)  (1280 + 64 * (j))
#define XB_XGEN(j)  (2304 + 64 * (j))
#define XB_TOP      3328
#define XB_TOPGEN   3392
#define XCD_BAR_WORDS 3456
#define XB_SPIN_CAP (1u << 22)

__device__ __forceinline__ unsigned xb_ld(unsigned* p)              { return __hip_atomic_load(p, __ATOMIC_RELAXED, __HIP_MEMORY_SCOPE_AGENT); }
__device__ __forceinline__ unsigned xb_add(unsigned* p, unsigned v) { return __hip_atomic_fetch_add(p, v, __ATOMIC_RELAXED, __HIP_MEMORY_SCOPE_AGENT); }
__device__ __forceinline__ unsigned xb_xcc_id() { return (unsigned)__builtin_amdgcn_s_getreg((3 << 11) | 20) & 0xFu; }
#define XB_SPIN(cond, bar) do { unsigned _sp = 0; while (cond) { __builtin_amdgcn_s_sleep(1); \
    if ((++_sp & 255u) == 0u) { if (xb_ld(&(bar)[XB_TMO])) break; if (_sp > XB_SPIN_CAP) { atomicAdd(&(bar)[XB_TMO], 1u); break; } } } } while (0)

struct XcdBarrier { unsigned* bar; unsigned x; volatile LAS unsigned* st; };

__device__ __forceinline__ XcdBarrier xcd_barrier_post(unsigned* bar, volatile LAS unsigned* st, int tid) {
    XcdBarrier b; b.bar = bar; b.x = xb_xcc_id(); b.st = st;
    if (tid == 0) (void)xb_add(&bar[XB_XCNT(b.x)], 1u);
    return b;
}
__device__ __forceinline__ void xcd_barrier_complete(unsigned* bar, unsigned x, unsigned& nloc, unsigned& nx) {
    const unsigned G = NWG;
    unsigned sum, cnt, mine, sp = 0u;
    for (;;) {
        sum = 0u; cnt = 0u; mine = 0u;
#pragma unroll
        for (unsigned j = 0; j < 16; ++j) { const unsigned c = xb_ld(&bar[XB_XCNT(j)]); sum += c; cnt += (c > 0u) ? 1u : 0u; mine = (j == x) ? c : mine; }
        if (sum == G) break;
        __builtin_amdgcn_s_sleep(1);
        if ((++sp & 255u) == 0u) { if (xb_ld(&bar[XB_TMO])) break; if (sp > XB_SPIN_CAP) { atomicAdd(&bar[XB_TMO], 1u); break; } }
    }
    nloc = mine > 0u ? mine : 1u; nx = cnt > 0u ? cnt : 1u;
}
__device__ __forceinline__ void xcd_barrier(const XcdBarrier& b, int tid) {
    asm volatile("s_waitcnt vmcnt(0)" ::: "memory");
    __syncthreads();
    if (tid == 0) {
        unsigned* bar = b.bar;
        __builtin_amdgcn_s_waitcnt(0);
        unsigned nloc = b.st[0], nx = b.st[1];
        if (nloc == 0u) { xcd_barrier_complete(bar, b.x, nloc, nx); b.st[0] = nloc; b.st[1] = nx; }
        const unsigned old = xb_add(&bar[XB_XSUB(b.x)], 1u);
        const unsigned gen = old / nloc;
        if (old + 1u == (gen + 1u) * nloc) {
            __builtin_amdgcn_fence(__ATOMIC_RELEASE, "agent");
            asm volatile("s_waitcnt vmcnt(0)" ::: "memory");
            const unsigned og = xb_add(&bar[XB_TOP], 1u);
            const unsigned tg = og / nx;
            if (og + 1u == (tg + 1u) * nx) xb_add(&bar[XB_TOPGEN], 1u);
            else XB_SPIN(xb_ld(&bar[XB_TOPGEN]) == tg, bar);
            __builtin_amdgcn_fence(__ATOMIC_ACQUIRE, "agent");
            xb_add(&bar[XB_XGEN(b.x)], 1u);
            asm volatile("s_waitcnt vmcnt(0)" ::: "memory");
        } else {
            XB_SPIN(xb_ld(&bar[XB_XGEN(b.x)]) == gen, bar);
            __builtin_amdgcn_fence(__ATOMIC_ACQUIRE, "agent");
            asm volatile("s_waitcnt vmcnt(0)" ::: "memory");
        }
    }
    __syncthreads();
}

struct Params {
    const float* in[27];
    float* out;
    unsigned char* ws;
    int ph_lo, ph_hi;
};
__device__ __forceinline__ LAS unsigned char* lds_at(int off) { asm volatile("" : "+s"(off)); return (LAS unsigned char*)(unsigned)off; }
constexpr int LDS_PTAB = LDS_BYTES - 512;
__device__ __forceinline__ void ptab_store(const Params& p, int tid) {
    LAS unsigned long long* t = (LAS unsigned long long*)lds_at(LDS_PTAB);
    if (tid == 0) {
#pragma unroll
        for (int i = 0; i < 27; ++i) t[i] = (unsigned long long)p.in[i];
        t[27] = (unsigned long long)p.out; t[28] = (unsigned long long)p.ws; }
}
__device__ __forceinline__ unsigned long long ptab_get(int i) {
    const LAS unsigned* t = (const LAS unsigned*)lds_at(LDS_PTAB) + 2 * i;
    const unsigned lo = __builtin_amdgcn_readfirstlane(t[0]), hi = __builtin_amdgcn_readfirstlane(t[1]);
    return ((unsigned long long)hi << 32) | lo;
}
__device__ __forceinline__ unsigned char* ws_late() { return (unsigned char*)ptab_get(28); }
#define PIN(i) ((const float*)ptab_get(i))
__device__ __forceinline__ void ptab_load(Params& q) {
    asm volatile("" ::: "memory");
#pragma unroll
    for (int i = 0; i < 27; ++i) q.in[i] = (const float*)ptab_get(i);
    q.out = (float*)ptab_get(27); q.ws = (unsigned char*)ptab_get(28); q.ph_lo = 0; q.ph_hi = 0;
}

namespace pg8 {
constexpr int BM = 256, BK = 64, HALF = 128, HTB = HALF * BK * 2, NXCD = 8, WGM = 8;
__device__ __forceinline__ int lds_byte(int r, int c) { const int st = (r >> 4) * 2 + (c >> 5), rr = r & 15, cc = c & 31, ob = rr * 64 + cc * 2; return st * 1024 + (ob ^ (((ob >> 9) & 1) << 5)); }
__device__ __forceinline__ void stage_rc(int b, int& R, int& C) { const int st = b / 1024, sb = b % 1024, swz = sb ^ (((sb >> 9) & 1) << 5); R = (st >> 1) * 16 + swz / 64; C = (st & 1) * 32 + (swz % 64) / 2; }
__device__ __forceinline__ int perm32(int rho) { const int n = rho >> 4, i = rho & 15; return 8 * (i >> 2) + 4 * n + (i & 3); }

struct Unit { unsigned a, b, rows; int pm, pn, aux, nvalid; };

__device__ __forceinline__ bool dense_unit(int i, int G, int c, int nM, int nN, int& pm, int& pn) {
    const int nwg = nM * nN; const long L = (long)i * G + c; if (L >= nwg) return false;
    int wgid = (int)L; { const int q = nwg / NXCD, r = nwg % NXCD, xcd = wgid % NXCD, off = wgid / NXCD; wgid = (xcd < r ? xcd * (q + 1) : r * (q + 1) + (xcd - r) * q) + off; }
    const int nig = WGM * nN, gid = wgid / nig, fm = gid * WGM, gsz = (nM - fm) < WGM ? (nM - fm) : WGM;
    pm = fm + ((wgid % nig) % gsz); pn = (wgid % nig) / gsz; return true;
}

typedef int i32x4 __attribute__((ext_vector_type(4)));
typedef int i32x8 __attribute__((ext_vector_type(8)));
template <class Epi, class Sched, bool ALIGN_EPI, bool GATHER, bool F8 = false>
__device__ __forceinline__ void gemm_phase(LAS unsigned char* lds, const int K, const int lda, const int ldb, const Sched& S, const Epi& E, const int tid, const char* wsb) {
    const int wid = __builtin_amdgcn_readfirstlane(tid >> 6), lane = tid & 63, wr = wid >> 2, wc = wid & 3, fr = lane & 15, fq = lane >> 4;
    constexpr int ESZ = F8 ? 1 : 2;
    const int nt = K / (F8 ? 128 : BK);
    unsigned voffA[2], voffB[2]; int rA[2], cA2[2];
#pragma unroll
    for (int i = 0; i < 2; ++i) { int R, C; stage_rc(tid * 16 + i * 8192, R, C); const int Rb = Epi::PERM ? ((R & ~31) + perm32(R & 31)) : R;
        rA[i] = R; cA2[i] = C * 2; voffA[i] = (unsigned)(R * lda * ESZ + C * 2); voffB[i] = (unsigned)(Rb * ldb * ESZ + C * 2); }
    const unsigned kstep = (unsigned)(BK * 2);
    const unsigned hstepA = GATHER ? 0u : (unsigned)(HALF * lda * ESZ), hstepB = (unsigned)(HALF * ldb * ESZ);
    const unsigned ldsw = (unsigned)wid * 1024u, s64A = (unsigned)(64 * lda * ESZ), s64B = (unsigned)(64 * ldb * ESZ);
    const int aoff = lds_byte(wr * 64 + fr, fq * (F8 ? 16 : 8)), boff = lds_byte(wc * 32 + fr, fq * (F8 ? 16 : 8));
#define PG8_SA(b, h) (((b) * 2 + (h)) * HTB)
#define PG8_SB(b, h) ((4 + (b) * 2 + (h)) * HTB)
#define PG8_STAGE(bufoff, gbase, voff) do { _Pragma("unroll") for (int _i = 0; _i < 2; ++_i) \
        __builtin_amdgcn_global_load_lds((const unsigned*)(wsb + (size_t)(unsigned)((gbase) + (voff)[_i])), (LAS unsigned*)(lds + (bufoff) + ldsw + _i * 8192), 16, 0, 0); } while (0)
#define PG8_STAGE1(bufoff, gbase, voff0, step64) do { _Pragma("unroll") for (int _i = 0; _i < 2; ++_i) \
        __builtin_amdgcn_global_load_lds((const unsigned*)(wsb + (size_t)(unsigned)((gbase) + (unsigned)_i * (step64) + (voff0))), (LAS unsigned*)(lds + (bufoff) + ldsw + _i * 8192), 16, 0, 0); } while (0)
#define PG8_LDA(dst, b, h) do { _Pragma("unroll") for (int m = 0; m < 4; ++m) { if constexpr (F8) dst##8[m] = *(const LAS i32x8*)(lds + PG8_SA(b, h) + aoff + m * 2048); else { _Pragma("unroll") for (int k = 0; k < 2; ++k) dst[m][k] = *(const LAS bf16x8*)(lds + PG8_SA(b, h) + aoff + m * 2048 + k * 1024); } } } while (0)
#define PG8_LDB(dst, b, h) do { _Pragma("unroll") for (int n = 0; n < 2; ++n) { if constexpr (F8) dst##8[n] = *(const LAS i32x8*)(lds + PG8_SB(b, h) + boff + n * 2048); else { _Pragma("unroll") for (int k = 0; k < 2; ++k) dst[n][k] = *(const LAS bf16x8*)(lds + PG8_SB(b, h) + boff + n * 2048 + k * 1024); } } } while (0)
#define PG8_MMA(ai, bj, At, Bt) do { __builtin_amdgcn_s_setprio(1); _Pragma("unroll") for (int m = 0; m < 4; ++m) _Pragma("unroll") for (int n = 0; n < 2; ++n) { \
        if constexpr (F8) acc[ai][bj][m][n] = __builtin_amdgcn_mfma_scale_f32_16x16x128_f8f6f4(Bt##8[n], At##8[m], acc[ai][bj][m][n], 0, 0, 0, 0, 0, 0); \
        else { _Pragma("unroll") for (int k = 0; k < 2; ++k) acc[ai][bj][m][n] = __builtin_amdgcn_mfma_f32_16x16x32_bf16(Bt[n][k], At[m][k], acc[ai][bj][m][n], 0, 0, 0); } } \
        __builtin_amdgcn_s_setprio(0); } while (0)
#define PG8_WAIT_V(n) asm volatile("s_waitcnt vmcnt(" #n ")" ::: "memory")
#define PG8_WAIT_L(n) asm volatile("s_waitcnt lgkmcnt(" #n ")" ::: "memory")
#define PG8_BAR __builtin_amdgcn_s_barrier()
#define PG8_SCHED __builtin_amdgcn_sched_barrier(0)
    Unit cur, nxt; int ui = 0;
    S.begin(tid);
    if (!S.next(0, cur)) return;
    f32x4 acc[2][2][4][2];
#pragma unroll
    for (int a = 0; a < 2; ++a)
#pragma unroll
        for (int b = 0; b < 2; ++b)
#pragma unroll
            for (int m = 0; m < 4; ++m)
#pragma unroll
                for (int n = 0; n < 2; ++n) acc[a][b][m][n] = (f32x4){0.f, 0.f, 0.f, 0.f};
    bf16x8 At[4][2], B0[2][2], B1[2][2]; i32x8 At8[4], B08[2], B18[2];
    unsigned cA = cur.a, cB = cur.b;
    LAS unsigned* grec = (LAS unsigned*)(lds + 131072) + tid * 8;
    if constexpr (GATHER) {
#pragma unroll
        for (int i = 0; i < 2; ++i) { const unsigned o0 = (unsigned)S.row(cur, rA[i]) * (unsigned)(lda * ESZ) + cA2[i], o1 = (unsigned)S.row(cur, HALF + rA[i]) * (unsigned)(lda * ESZ) + cA2[i];
            grec[i] = o0; grec[2 + i] = o1; grec[4 + i] = o0; grec[6 + i] = o1; }
    }
#define PG8_STAGE_A(bufoff, kptr, h, usenext) do { if constexpr (GATHER) { const u32x2 _w = *(const LAS u32x2*)(grec + ((usenext) ? 4 : 0) + 2 * (h)); unsigned _v[2]; _v[0] = _w.x; _v[1] = _w.y; PG8_STAGE(bufoff, kptr, _v); } \
        else { PG8_STAGE1(bufoff, (kptr) + (h) * hstepA, voffA[0], s64A); } } while (0)
    PG8_STAGE1(PG8_SB(0, 0), cB, voffB[0], s64B); PG8_STAGE1(PG8_SB(0, 1), cB + hstepB, voffB[0], s64B); PG8_STAGE_A(PG8_SA(0, 0), cA, 0, false); PG8_STAGE_A(PG8_SA(0, 1), cA, 1, false);
    if (wr == 1) PG8_BAR;
    PG8_WAIT_V(2); PG8_BAR;
    PG8_STAGE1(PG8_SB(1, 0), cB + kstep, voffB[0], s64B); PG8_STAGE_A(PG8_SA(1, 0), cA + kstep, 0, false); PG8_STAGE1(PG8_SB(1, 1), cB + hstepB + kstep, voffB[0], s64B);
    PG8_WAIT_V(6); PG8_BAR;
    for (;;) {
        const bool has_next = S.next(ui + 1, nxt);
        const int tk_ = S.issue(tid, has_next);
        const unsigned nA = has_next ? nxt.a : cA, nB = has_next ? nxt.b : cB;
#pragma nounroll
        for (int t = 0; t < nt; t += 2) {
            const bool last = (t == nt - 2);
            const unsigned a1 = cA + (unsigned)(t + 1) * kstep;
            const unsigned a2 = last ? nA : cA + (unsigned)(t + 2) * kstep, b2 = last ? nB : cB + (unsigned)(t + 2) * kstep;
            const unsigned a3 = a2 + kstep, b3 = b2 + kstep;
            if constexpr (GATHER) { if (last && has_next) {
#pragma unroll
                for (int i = 0; i < 2; ++i) { grec[4 + i] = (unsigned)S.row(nxt, rA[i]) * (unsigned)(lda * ESZ) + cA2[i]; grec[6 + i] = (unsigned)S.row(nxt, HALF + rA[i]) * (unsigned)(lda * ESZ) + cA2[i]; } } }
            PG8_LDB(B0, 0, 0); PG8_LDB(B1, 0, 1); PG8_SCHED; PG8_LDA(At, 0, 0); PG8_STAGE_A(PG8_SA(1, 1), a1, 1, false);
            PG8_WAIT_V(8); PG8_WAIT_L(0); PG8_BAR; PG8_MMA(0, 0, At, B0); PG8_MMA(0, 1, At, B1); PG8_BAR; PG8_SCHED;
            PG8_LDA(At, 0, 1); PG8_STAGE1(PG8_SB(0, 0), b2, voffB[0], s64B); PG8_STAGE1(PG8_SB(0, 1), b2 + hstepB, voffB[0], s64B); PG8_STAGE_A(PG8_SA(0, 0), a2, 0, last);
            PG8_WAIT_V(8); PG8_WAIT_L(0); PG8_BAR; PG8_MMA(1, 0, At, B0); PG8_MMA(1, 1, At, B1); PG8_BAR; PG8_SCHED;
            PG8_LDB(B0, 1, 0); PG8_LDB(B1, 1, 1); PG8_SCHED; PG8_LDA(At, 1, 0); PG8_STAGE_A(PG8_SA(0, 1), a2, 1, last);
            PG8_WAIT_V(8); PG8_WAIT_L(0); PG8_BAR; PG8_MMA(0, 0, At, B0); PG8_MMA(0, 1, At, B1); PG8_BAR; PG8_SCHED;
            PG8_LDA(At, 1, 1); PG8_STAGE1(PG8_SB(1, 0), b3, voffB[0], s64B); PG8_STAGE1(PG8_SB(1, 1), b3 + hstepB, voffB[0], s64B); PG8_STAGE_A(PG8_SA(1, 0), a3, 0, last);
            PG8_WAIT_V(8); PG8_WAIT_L(0); PG8_BAR; PG8_MMA(1, 0, At, B0); PG8_MMA(1, 1, At, B1); PG8_BAR; PG8_SCHED;
        }
        S.commit(tid, ui, tk_);
        if constexpr (ALIGN_EPI) { if (wr == 0) PG8_BAR; }
        { int tz = tid; asm volatile("" : "+v"(tz)); const int ew = __builtin_amdgcn_readfirstlane(tz >> 6), el = tz & 63;
          E(acc, cur, ew >> 2, ew & 3, el & 15, el >> 4); }
        if (!has_next) break;
#pragma unroll
        for (int a = 0; a < 2; ++a)
#pragma unroll
            for (int b = 0; b < 2; ++b)
#pragma unroll
                for (int m = 0; m < 4; ++m)
#pragma unroll
                    for (int n = 0; n < 2; ++n) acc[a][b][m][n] = (f32x4){0.f, 0.f, 0.f, 0.f};
        cur = nxt; cA = nA; cB = nB; ++ui;
        if constexpr (GATHER) { const u32x4 _n = *(const LAS u32x4*)(grec + 4); *(LAS u32x4*)grec = _n; }
        if constexpr (ALIGN_EPI) { if (wr == 1) PG8_BAR; }
    }
    PG8_WAIT_V(0);
    if constexpr (!ALIGN_EPI) { if (wr == 0) PG8_BAR; }
    PG8_BAR;
#undef PG8_SA
#undef PG8_SB
#undef PG8_STAGE
#undef PG8_STAGE_A
#undef PG8_LDA
#undef PG8_LDB
#undef PG8_MMA
#undef PG8_WAIT_V
#undef PG8_WAIT_L
#undef PG8_BAR
#undef PG8_SCHED
}
}
using pg8::Unit;

constexpr int LDS_TICK = 147456;
struct DenseSched {
    unsigned A, Bt, tA, tB, aBr; int nM, nN, G, c, pnShift; unsigned* ctr;
    __device__ __forceinline__ void begin(int tid) const { volatile LAS int* tk = (volatile LAS int*)lds_at(LDS_TICK);
        __syncthreads();
        if (tid == 0) { const int t0 = (int)__hip_atomic_fetch_add(ctr, 1u, __ATOMIC_RELAXED, __HIP_MEMORY_SCOPE_AGENT), t1 = (int)__hip_atomic_fetch_add(ctr, 1u, __ATOMIC_RELAXED, __HIP_MEMORY_SCOPE_AGENT); tk[0] = t0; tk[1] = t1; }
        __syncthreads(); }
    __device__ __forceinline__ int issue(int tid, bool more) const { int t = 0x3fffffff; if (tid == 0 && more) t = (int)__hip_atomic_fetch_add(ctr, 1u, __ATOMIC_RELAXED, __HIP_MEMORY_SCOPE_AGENT); return t; }
    __device__ __forceinline__ void commit(int tid, int ui, int t) const { if (tid == 0) { volatile LAS int* tk = (volatile LAS int*)lds_at(LDS_TICK); tk[ui & 1] = t; asm volatile("s_waitcnt vmcnt(0) lgkmcnt(0)" ::: "memory"); } }
    __device__ __forceinline__ bool next(int i, Unit& u) const {
        const int L = __builtin_amdgcn_readfirstlane(((volatile LAS int*)lds_at(LDS_TICK))[i & 1]);
        int pm, pn; if (L < 0 || L >= nM * nN || !pg8::dense_unit(0, 1, L, nM, nN, pm, pn)) return false;
        u.pm = pm; u.pn = pn; u.aux = 0; u.nvalid = 256; u.rows = 0u;
        u.a = A + (unsigned)(pn >> pnShift) * aBr + (unsigned)pm * tA; u.b = Bt + (unsigned)pn * tB; return true;
    }
    __device__ __forceinline__ int row(const Unit&, int) const { return 0; }
};
struct OneSched {
    Unit u0; bool has;
    __device__ __forceinline__ void begin(int) const {}
    __device__ __forceinline__ int issue(int, bool) const { return 0; }
    __device__ __forceinline__ void commit(int, int, int) const {}
    __device__ __forceinline__ bool next(int i, Unit& u) const { if (i > 0 || !has) return false; u = u0; return true; }
    __device__ __forceinline__ int row(const Unit&, int) const { return 0; }
};
struct MoeSched {
    const LAS int* pre;
    const LAS int* cnt;
    const char* wsb;
    unsigned A, W, wE, wT, aT; int G, c; bool gatherA; unsigned* ctr;
    __device__ __forceinline__ void begin(int tid) const { volatile LAS int* tk = (volatile LAS int*)lds_at(LDS_TICK);
        __syncthreads();
        if (tid == 0) { const int t0 = (int)__hip_atomic_fetch_add(ctr, 1u, __ATOMIC_RELAXED, __HIP_MEMORY_SCOPE_AGENT), t1 = (int)__hip_atomic_fetch_add(ctr, 1u, __ATOMIC_RELAXED, __HIP_MEMORY_SCOPE_AGENT); tk[0] = t0; tk[1] = t1; }
        __syncthreads(); }
    __device__ __forceinline__ int issue(int tid, bool more) const { int t = 0x3fffffff; if (tid == 0 && more) t = (int)__hip_atomic_fetch_add(ctr, 1u, __ATOMIC_RELAXED, __HIP_MEMORY_SCOPE_AGENT); return t; }
    __device__ __forceinline__ void commit(int tid, int ui, int t) const { if (tid == 0) { volatile LAS int* tk = (volatile LAS int*)lds_at(LDS_TICK); tk[ui & 1] = t; asm volatile("s_waitcnt vmcnt(0) lgkmcnt(0)" ::: "memory"); } }
    __device__ __forceinline__ bool next(int i, Unit& u) const {
        const int L = __builtin_amdgcn_readfirstlane(((volatile LAS int*)lds_at(LDS_TICK))[i & 1]); const int total = pre[16] * 4; if (L < 0 || L >= total) return false;
        const int t = (int)(L >> 2), pn = (int)(L & 3); int e = 0;
#pragma unroll
        for (int j = 1; j < 16; ++j) e += (pre[j] <= t) ? 1 : 0;
        const int pm = t - pre[e];
        u.aux = e; u.pm = t; u.pn = pn; u.nvalid = min(256, cnt[e] - 256 * pm); u.rows = (unsigned)(WS_R + R_LIST) + (unsigned)(e * MTOK + 256 * pm) * 4u;
        u.a = gatherA ? A : A + (unsigned)t * aT; u.b = W + (unsigned)e * wE + (unsigned)pn * wT; return true;
    }
    __device__ __forceinline__ int row(const Unit& u, int R) const { return (R < u.nvalid) ? (((const int*)(wsb + u.rows))[R] >> 1) : 0; }
};

typedef f32x4 Acc[2][2][4][2];
#define EPI_LOOP_AIM _Pragma("unroll") for (int ai = 0; ai < 2; ++ai) _Pragma("unroll") for (int m = 0; m < 4; ++m)
__device__ __forceinline__ u32x4 pack8(const f32x4& a, const f32x4& b) { u32x4 w; w.x = pk2(a[0], a[1]); w.y = pk2(a[2], a[3]); w.z = pk2(b[0], b[1]); w.w = pk2(b[2], b[3]); return w; }

struct EpiProj {
    static constexpr bool PERM = true;
    __device__ __forceinline__ void operator()(const Acc& acc, const Unit& u, int wr, int wc, int fr, int fq) const {
        unsigned char* ws = ws_late(); bf16_t* proj = (bf16_t*)(ws + WS_R + R_PROJ); bf16_t* nkv = (bf16_t*)(ws + WS_R + R_NKV); float* sm = (float*)(ws + WS_R + R_SM);
        const int row0 = u.pm * 256 + wr * 64 + fr;
        if (u.pn < 12) {
            const float sc = (u.pn == 8 || u.pn == 9) ? QSCALE : (u.pn == 5 ? 0.125f : 1.0f);
            const int col0 = u.pn * 256 + wc * 32 + 8 * fq;
            EPI_LOOP_AIM { bf16_t* rp = proj + (size_t)(row0 + ai * 128 + m * 16) * PROJW + col0;
#pragma unroll
                for (int bj = 0; bj < 2; ++bj) *(u32x4*)(rp + bj * 128) = pack8(acc[ai][bj][m][0] * sc, acc[ai][bj][m][1] * sc); }
        } else {
#pragma unroll
            for (int bj = 0; bj < 2; ++bj) {
                if (u.pn == 12 || bj == 0) {
                    const int seg = (u.pn - 12) * 4 + bj * 2 + (wc >> 1), col = 32 * (wc & 1) + 8 * fq;
                    bf16_t* base = nkv + (size_t)seg * (NKV_SEG / 2) + col;
                    EPI_LOOP_AIM { *(u32x4*)(base + (size_t)(row0 + ai * 128 + m * 16) * 64) = pack8(acc[ai][bj][m][0], acc[ai][bj][m][1]); }
                } else if (wc == 0 && fq < 3) {
                    EPI_LOOP_AIM { float* sp = sm + (size_t)(row0 + ai * 128 + m * 16) * 32 + 8 * fq; *(f32x4*)sp = acc[ai][bj][m][0]; *(f32x4*)(sp + 4) = acc[ai][bj][m][1]; }
                }
            }
        }
    }
};
struct EpiH1 {
    static constexpr bool PERM = true;
    bf16_t* h1; const float* cbias;
    __device__ __forceinline__ void operator()(const Acc& acc, const Unit& u, int wr, int wc, int fr, int fq) const {
        const int which = u.aux, rl0 = wr * 64 + fr;
        bf16_t* base = h1 + ((size_t)which * BC * 256 + (size_t)u.pm * 256) * 256;
        const float* bp = cbias + which * 256;
#pragma unroll
        for (int bj = 0; bj < 2; ++bj) { const int col = bj * 128 + wc * 32 + 8 * fq; const f32x4 b0 = *(const f32x4*)(bp + col), b1 = *(const f32x4*)(bp + col + 4);
            EPI_LOOP_AIM { const int rl = rl0 + ai * 128 + m * 16; f32x4 v0 = acc[ai][bj][m][0] + b0, v1 = acc[ai][bj][m][1] + b1;
#pragma unroll
                for (int e = 0; e < 4; ++e) { v0[e] = (rl < 255) ? siluf_(v0[e]) : 0.f; v1[e] = (rl < 255) ? siluf_(v1[e]) : 0.f; }
                *(u32x4*)(base + (size_t)rl * 256 + col) = pack8(v0, v1); } }
    }
};
struct EpiCmp2 {
    static constexpr bool PERM = true;
    bf16_t* kc;
    __device__ __forceinline__ void operator()(const Acc& acc, const Unit& u, int wr, int wc, int fr, int fq) const {
        if (wc >= 2) return;
        const int col = wc * 32 + 8 * fq; bf16_t* base = kc + ((size_t)u.aux * BC + u.pm) * 256 * 64 + col;
        EPI_LOOP_AIM { const int rl = wr * 64 + fr + ai * 128 + m * 16; *(u32x4*)(base + (size_t)rl * 64) = pack8(acc[ai][0][m][0], acc[ai][0][m][1]); }
    }
};
struct EpiP {
    static constexpr bool PERM = true;
    __device__ __forceinline__ void operator()(const Acc& acc, const Unit& u, int wr, int wc, int fr, int fq) const {
        const int i = u.pn >> 2, pt = u.pn & 3, row0 = u.pm * 256 + wr * 64 + fr, col0 = 256 * pt + 32 * wc + 8 * fq;
        bf16_t* P = (bf16_t*)(ws_late() + WS_R + R_P) + (size_t)i * MC * 1024;
        EPI_LOOP_AIM { bf16_t* rp = P + (unsigned)((row0 + ai * 128 + m * 16) * 1024 + col0);
#pragma unroll
            for (int bj = 0; bj < 2; ++bj) *(u32x4*)(rp + bj * 128) = pack8(acc[ai][bj][m][0], acc[ai][bj][m][1]); }
    }
};
struct EpiGate {
    static constexpr bool PERM = true;
    __device__ __forceinline__ void operator()(const Acc& acc, const Unit& u, int wr, int wc, int fr, int fq) const {
        unsigned char* ws = ws_late(); const bf16_t* P = (const bf16_t*)(ws + WS_R + R_P); bf16_t* y = (bf16_t*)(ws + WS_R + R_Y);
        const int row0 = u.pm * 256 + wr * 64 + fr, oc = 64 * u.pn + 16 * wc + 4 * fq;
#pragma unroll
        for (int ai = 0; ai < 2; ++ai)
#pragma unroll
            for (int mh = 0; mh < 2; ++mh) {
                u32x2 pw[2][4];
#pragma unroll
                for (int mm = 0; mm < 2; ++mm) { const unsigned r = (unsigned)(row0 + ai * 128 + (2 * mh + mm) * 16);
#pragma unroll
                    for (int i = 0; i < 4; ++i) pw[mm][i] = *(const u32x2*)(P + ((size_t)i * MC * 1024 + r * 1024u + (unsigned)oc)); }
#pragma unroll
                for (int mm = 0; mm < 2; ++mm) { const int m = 2 * mh + mm; const unsigned r = (unsigned)(row0 + ai * 128 + m * 16);
                    f32x4 s = {0.f, 0.f, 0.f, 0.f};
#pragma unroll
                    for (int bj = 0; bj < 2; ++bj)
#pragma unroll
                        for (int n = 0; n < 2; ++n) { const u32x2 pq = pw[mm][2 * bj + n]; const f32x4 a = acc[ai][bj][m][n];
                            s[0] += sigmoidf_(a[0] * F8_DESCALE) * __uint_as_float(pq.x << 16); s[1] += sigmoidf_(a[1] * F8_DESCALE) * __uint_as_float(pq.x & 0xffff0000u);
                            s[2] += sigmoidf_(a[2] * F8_DESCALE) * __uint_as_float(pq.y << 16); s[3] += sigmoidf_(a[3] * F8_DESCALE) * __uint_as_float(pq.y & 0xffff0000u); }
                    u32x2 w; w.x = pk2(s[0], s[1]); w.y = pk2(s[2], s[3]); *(u32x2*)(y + (r * 1024u + (unsigned)oc)) = w; }
            }
    }
};
struct EpiOut {
    static constexpr bool PERM = true;
    int row_base;
    __device__ __forceinline__ void operator()(const Acc& acc, const Unit& u, int wr, int wc, int fr, int fq) const {
        bf16_t* T = (bf16_t*)(ws_late() + WS_T);
        const int rg0 = row_base + u.pm * 256 + wr * 64 + fr, col0 = u.pn * 256 + wc * 32 + 8 * fq;
        EPI_LOOP_AIM { bf16_t* rp = T + (size_t)(rg0 + ai * 128 + m * 16) * 1024 + col0;
#pragma unroll
            for (int bj = 0; bj < 2; ++bj) *(u32x4*)(rp + bj * 128) = pack8(acc[ai][bj][m][0], acc[ai][bj][m][1]); }
    }
};
struct EpiMoe1 {
    static constexpr bool PERM = true;
    __device__ __forceinline__ void operator()(const Acc& acc, const Unit& u, int wr, int wc, int fr, int fq) const {
        const int rl0 = wr * 64 + fr, f0 = 128 * u.pn + 32 * wc + 8 * fq;
        bf16_t* hid = (bf16_t*)(ws_late() + WS_R + R_HID);
        EPI_LOOP_AIM { const int rl = rl0 + ai * 128 + m * 16;
            f32x4 a0 = acc[ai][0][m][0], a1 = acc[ai][0][m][1]; const f32x4 b0 = acc[ai][1][m][0], b1 = acc[ai][1][m][1];
#pragma unroll
            for (int e = 0; e < 4; ++e) { a0[e] = siluf_(a0[e]) * b0[e]; a1[e] = siluf_(a1[e]) * b1[e]; }
            *(u32x4*)(hid + (unsigned)((u.pm * 256 + rl) * 512 + f0)) = pack8(a0, a1); __builtin_amdgcn_sched_barrier(0); }
    }
};
struct EpiMoe2 {
    static constexpr bool PERM = true;
    __device__ __forceinline__ void operator()(const Acc& acc, const Unit& u, int wr, int wc, int fr, int fq) const {
        unsigned char* ws = ws_late(); bf16_t* out2 = (bf16_t*)(ws + WS_R + R_OUT2);
        const float* cwb = (const float*)(ws + (R_CW - R_LIST) + u.rows); const int* rws = (const int*)(ws + u.rows);
        const int rl0 = wr * 64 + fr, c0 = 256 * u.pn + 32 * wc + 8 * fq;
        EPI_LOOP_AIM { const int rl = rl0 + ai * 128 + m * 16;
            if (rl < u.nvalid) { const unsigned v = (unsigned)rws[rl]; const float wgt = cwb[rl]; bf16_t* rp = out2 + (size_t)v * 1024 + c0;
#pragma unroll
                for (int bj = 0; bj < 2; ++bj) *(u32x4*)(rp + bj * 128) = pack8(acc[ai][bj][m][0] * wgt, acc[ai][bj][m][1] * wgt); } }
    }
};

enum { IN_X = 0, IN_C, IN_POS, IN_ADAW, IN_ADAB, IN_WIN, IN_CONVW, IN_ALOG, IN_DTB, IN_GNORM, IN_RETGN, IN_PE, IN_CKW1, IN_CKW2, IN_CVW1, IN_CVW2, IN_FBIAS,
       IN_BP, IN_WG, IN_WO, IN_LNG, IN_LNB, IN_RW, IN_RB, IN_EW1, IN_EW3, IN_EW2 };

__device__ __forceinline__ void p0_ada(const Params& p, int item, LAS float* lf, const int tid) {
    LAS float* sc = lf; LAS float* red = lf + 16384;
    const float* c = PIN(IN_C);
    for (int i = tid; i < 16384; i += NTHR) sc[i] = siluf_(c[i]);
    __syncthreads();
    const int ls = item / 48, cb = item % 48, col = cb * 64 + (tid & 63), ks = tid >> 6;
    const float* w = PIN(IN_ADAW) + (size_t)ls * 1024 * 3072 + col;
    float acc[16];
#pragma unroll
    for (int b = 0; b < 16; ++b) acc[b] = 0.f;
    for (int k0 = ks * 128; k0 < ks * 128 + 128; k0 += 16) { float wv[16];
#pragma unroll
        for (int kk = 0; kk < 16; ++kk) wv[kk] = w[(size_t)(k0 + kk) * 3072];
#pragma unroll
        for (int kk = 0; kk < 16; ++kk)
#pragma unroll
            for (int b = 0; b < 16; ++b) acc[b] += sc[b * 1024 + k0 + kk] * wv[kk]; }
#pragma unroll
    for (int b = 0; b < 16; ++b) red[(ks * 16 + b) * 64 + (tid & 63)] = acc[b];
    __syncthreads();
    float* mod = (float*)(p.ws + WS_MOD);
    for (int o = tid; o < 1024; o += NTHR) { const int b = o >> 6, cc = o & 63; float s = 0.f;
#pragma unroll
        for (int q = 0; q < 8; ++q) s += red[(q * 16 + b) * 64 + cc];
        mod[((size_t)ls * 16 + b) * 3072 + cb * 64 + cc] = s + PIN(IN_ADAB)[ls * 3072 + cb * 64 + cc]; }
    __syncthreads();
}
__device__ __forceinline__ void p0_rope(const Params& p, int item, const int tid) {
    const int* pos = (const int*)PIN(IN_POS); f32x2* tab = (f32x2*)(p.ws + WS_ROPE);
#pragma unroll
    for (int j = 0; j < 8; ++j) { const int idx = item * 4096 + j * 512 + tid; const int m = idx >> 5, i = idx & 31;
        const float inv = powf(10000.0f, -(float)i / 32.0f); const float ang = (float)pos[m] * inv;
        const float n = rintf(ang * 0.6366197723675814f);
        float r = fmaf(n, -1.5703125f, ang); r = fmaf(n, -4.837512969970703125e-4f, r); r = fmaf(n, -7.54978995489188e-8f, r);
        const float s = sinf(r), cs = cosf(r); const int q = ((int)n) & 3;
        float so, co; if (q == 0) { so = s; co = cs; } else if (q == 1) { so = cs; co = -s; } else if (q == 2) { so = -s; co = -cs; } else { so = -cs; co = s; }
        tab[idx] = (f32x2){co, so}; }
}
__device__ __forceinline__ void p0_cbias(const Params& p, int item, const int tid) {
    const int l = item >> 1, which = item & 1;
    if (tid < 256) { const float* pe = PIN(IN_PE) + (size_t)l * 2048; const float* w1 = PIN(which ? IN_CVW1 : IN_CKW1) + (size_t)l * 2048 * 256 + tid;
        float s = 0.f; for (int k = 0; k < 2048; ++k) s += pe[k] * w1[(size_t)k * 256];
        ((float*)(p.ws + WS_CBIAS))[item * 256 + tid] = s; }
}
struct TJob { bf16_t* dst; int K, nrt, nkt; };
constexpr int TJ_TILES[8] = {56 * 16, 64 * 16, 64 * 4, 16 * 16, 256 * 16, 256 * 8, 8 * 32, 8 * 4};
constexpr int TJ_TOTAL = 56 * 16 + 64 * 16 + 64 * 4 + 16 * 16 + 256 * 16 + 256 * 8 + 8 * 32 + 8 * 4;
__device__ __forceinline__ int win_src_col(int pc) {
    if (pc < 768) return pc;
    if (pc < 1024) return pc - 768 + 776;
    if (pc < 2048) return pc - 1024 + 1032;
    if (pc < 2304) return pc - 2048 + 2056;
    if (pc < 3072) return pc - 2304 + 2708;
    if (pc < 3456) return pc - 3072 + 2312;
    if (pc < 3464) return pc - 3456 + 768;
    if (pc < 3476) return pc - 3464 + 2696;
    if (pc < 3480) return pc - 3476 + 3476;
    return -1;
}
__device__ __forceinline__ const float* tj_src(const Params& p, int l, int job, int n, int& pitch) {
    switch (job) {
    case 0: { pitch = 3480; const int c = win_src_col(n); return c < 0 ? nullptr : PIN(IN_WIN) + (size_t)l * 1024 * 3480 + c; }
    case 1: { pitch = 1024; const int i = 2 * ((n >> 7) & 1) + ((n >> 2) & 1), c = 64 * (n >> 8) + 16 * ((n >> 5) & 3) + 4 * ((n >> 3) & 3) + (n & 3);
              return PIN(IN_WG) + ((size_t)l * 4 + i) * 1024 * 1024 + c; }
    case 2: { pitch = 1024; const int i = n >> 10, c = n & 1023; return PIN(IN_BP) + ((size_t)l * 4 + i) * 256 * 1024 + c; }
    case 3: { pitch = 1024; return PIN(IN_WO) + (size_t)l * 1024 * 1024 + n; }
    case 4: { pitch = 512; const int e = n >> 10, vr = n & 1023, f = 128 * (vr >> 8) + (vr & 127); return PIN(((vr >> 7) & 1) ? IN_EW3 : IN_EW1) + ((size_t)l * 16 + e) * 1024 * 512 + f; }
    case 5: { pitch = 1024; const int e = n >> 10, c = n & 1023; return PIN(IN_EW2) + ((size_t)l * 16 + e) * 512 * 1024 + c; }
    case 6: { pitch = 256; const int which = n >> 8, c = n & 255; return PIN(which ? IN_CVW1 : IN_CKW1) + (size_t)l * 2048 * 256 + c; }
    default: { pitch = 64; const int which = n >> 8, r = n & 255; return r < 64 ? PIN(which ? IN_CVW2 : IN_CKW2) + (size_t)l * 256 * 64 + r : nullptr; }
    }
}
struct TDesc { const float* src; bf16_t* dst; int pitch, K, rt, kt, job; };
__device__ __forceinline__ void tj_decode(const Params& p, int item, int tx, TDesc& d) {
    const int l = item / TJ_TOTAL; int t = item % TJ_TOTAL, job = 0;
#pragma unroll
    for (int j = 0; j < 8; ++j) { if (job == j && t >= TJ_TILES[j]) { t -= TJ_TILES[j]; job = j + 1; } }
    const size_t lw = WS_W + (size_t)l * ((LW_BYTES + MiB - 1) / MiB) * MiB;
    const size_t offs[8] = {LW_WIN, LW_WGV, LW_BPT, LW_WOT, LW_W13, LW_W2, LW_CW1, LW_CW2};
    const int Ks[8] = {1024, 1024, 256, 1024, 1024, 512, 2048, 256};
    size_t off = 0; int K = 0;
#pragma unroll
    for (int j = 0; j < 8; ++j) if (job == j) { off = offs[j]; K = Ks[j]; }
    d.dst = (bf16_t*)(p.ws + lw + off); d.K = K; d.job = job;
    const int nkt = K / 64; d.rt = t / nkt; d.kt = t % nkt;
    d.src = tj_src(p, l, job, d.rt * 64 + tx, d.pitch);
}
__device__ __forceinline__ void p0_transpose4(const Params& p, int it, int G, int end, LAS float* tiles, const int tid) {
    const int tx = tid & 63, ty = tid >> 6; float v[4][8]; TDesc d[4];
#pragma unroll
    for (int q = 0; q < 4; ++q) { const int item = it + q * G; if (item < end) { tj_decode(p, item, tx, d[q]);
#pragma unroll
            for (int kk = 0; kk < 8; ++kk) v[q][kk] = d[q].src ? d[q].src[(size_t)(d[q].kt * 64 + ty + 8 * kk) * d[q].pitch] : 0.f; } }
#pragma unroll
    for (int q = 0; q < 4; ++q) { if (it + q * G < end) {
#pragma unroll
            for (int kk = 0; kk < 8; ++kk) tiles[q * 4160 + (ty + 8 * kk) * 65 + tx] = v[q][kk]; } }
    __syncthreads();
    const int r = tid >> 3, sg = tid & 7;
#pragma unroll
    for (int q = 0; q < 4; ++q) { if (it + q * G < end) { f32x4 a, b;
#pragma unroll
            for (int j = 0; j < 4; ++j) { a[j] = tiles[q * 4160 + (sg * 8 + j) * 65 + r]; b[j] = tiles[q * 4160 + (sg * 8 + 4 + j) * 65 + r]; }
            if (d[q].job == 1) { u32x2 w8; w8.x = pk4_fp8(a[0] * W8_SCALE, a[1] * W8_SCALE, a[2] * W8_SCALE, a[3] * W8_SCALE); w8.y = pk4_fp8(b[0] * W8_SCALE, b[1] * W8_SCALE, b[2] * W8_SCALE, b[3] * W8_SCALE);
                                 *(u32x2*)((unsigned char*)d[q].dst + (size_t)(d[q].rt * 64 + r) * d[q].K + d[q].kt * 64 + sg * 8) = w8; }
            else *(u32x4*)(d[q].dst + (size_t)(d[q].rt * 64 + r) * d[q].K + d[q].kt * 64 + sg * 8) = pack8(a, b); } }
    __syncthreads();
}

struct RowV { f32x4 v[4]; };
__device__ __forceinline__ void row_load(RowV& r, const float* src, int lane) {
#pragma unroll
    for (int j = 0; j < 4; ++j) r.v[j] = *(const f32x4*)(src + 4 * lane + 256 * j);
}
__device__ __forceinline__ void row_stats(const RowV& r, float& mean, float& rstd) {
    float s = 0.f;
#pragma unroll
    for (int j = 0; j < 4; ++j) s += (r.v[j][0] + r.v[j][1]) + (r.v[j][2] + r.v[j][3]);
    mean = wave_sum(s) * (1.0f / 1024.0f);
    float q = 0.f;
#pragma unroll
    for (int j = 0; j < 4; ++j) { const f32x4 d = r.v[j] - mean; q += (d[0] * d[0] + d[1] * d[1]) + (d[2] * d[2] + d[3] * d[3]); }
    rstd = 1.0f / sqrtf(wave_sum(q) * (1.0f / 1024.0f) + LN_EPS);
}
__device__ __forceinline__ void row_ln(RowV& r, float mean, float rstd, const float* g, const float* b, int lane) {
#pragma unroll
    for (int j = 0; j < 4; ++j) { const f32x4 gg = *(const f32x4*)(g + 4 * lane + 256 * j), bb = *(const f32x4*)(b + 4 * lane + 256 * j); r.v[j] = (r.v[j] - mean) * rstd * gg + bb; }
}
__device__ __forceinline__ void row_mod(RowV& h, const RowV& x, const float* mod, int lane) {
#pragma unroll
    for (int j = 0; j < 4; ++j) { const f32x4 sh = *(const f32x4*)(mod + 4 * lane + 256 * j), sc = *(const f32x4*)(mod + 1024 + 4 * lane + 256 * j); h.v[j] = x.v[j] * (sc + 1.0f) + sh; }
}
__device__ __forceinline__ void row_store_bf16(const RowV& h, bf16_t* dst, int lane) {
#pragma unroll
    for (int j = 0; j < 4; ++j) { u32x2 w; w.x = pk2(h.v[j][0], h.v[j][1]); w.y = pk2(h.v[j][2], h.v[j][3]); *(u32x2*)(dst + 4 * lane + 256 * j) = w; }
}
__device__ __forceinline__ void vec_load(RowV& v, const float* src, int lane) {
#pragma unroll
    for (int j = 0; j < 4; ++j) v.v[j] = *(const f32x4*)(src + 4 * lane + 256 * j);
}
__device__ __forceinline__ void row_ln_r(RowV& r, float mean, float rstd, const RowV& g, const RowV& b) {
#pragma unroll
    for (int j = 0; j < 4; ++j) r.v[j] = (r.v[j] - mean) * rstd * g.v[j] + b.v[j];
}
__device__ __forceinline__ void row_mod_r(RowV& h, const RowV& x, const RowV& sh, const RowV& sc1) {
#pragma unroll
    for (int j = 0; j < 4; ++j) h.v[j] = x.v[j] * sc1.v[j] + sh.v[j];
}
__device__ __forceinline__ void vec_add1(RowV& v) {
#pragma unroll
    for (int j = 0; j < 4; ++j) v.v[j] = v.v[j] + 1.0f;
}
__device__ __forceinline__ void row_store_fp8(const RowV& h, unsigned char* dst, int lane) {
#pragma unroll
    for (int j = 0; j < 4; ++j) *(unsigned*)(dst + 4 * lane + 256 * j) = pk4_fp8(h.v[j][0] * H8_SCALE, h.v[j][1] * H8_SCALE, h.v[j][2] * H8_SCALE, h.v[j][3] * H8_SCALE);
}
__device__ __forceinline__ void prep_first(const Params& p, const int tid, const int blk) {
    const int lane = tid & 63, wv = tid >> 6; const float* x = p.in[IN_X]; bf16_t* H = (bf16_t*)(p.ws + WS_H); const float* mod = (const float*)(p.ws + WS_MOD);
    const int row0 = (blk * 8 + wv) * 32;
    RowV sh, sc1; vec_load(sh, mod + (size_t)(row0 >> 12) * 3072, lane); vec_load(sc1, mod + (size_t)(row0 >> 12) * 3072 + 1024, lane); vec_add1(sc1);
    RowV cur; row_load(cur, x + (size_t)row0 * 1024, lane);
    for (int i = 0; i < 32; ++i) { const int row = row0 + i; RowV nx; if (i + 1 < 32) row_load(nx, x + (size_t)(row + 1) * 1024, lane);
        RowV h; row_mod_r(h, cur, sh, sc1); row_store_bf16(h, H + (size_t)row * 1024, lane); row_store_fp8(h, p.ws + WS_H8 + (size_t)row * 1024, lane); cur = nx; }
}
__device__ __forceinline__ void row_load_t(u32x2 (&t)[4], const bf16_t* src, int lane) {
#pragma unroll
    for (int j = 0; j < 4; ++j) t[j] = *(const u32x2*)(src + 4 * lane + 256 * j);
}
__device__ __forceinline__ void prep_moe(const Params& p, int l, LAS float* rwl, const int tid, const int blk) {
    const int lane = tid & 63, wv = tid >> 6;
    { const float* rw = p.in[IN_RW]; for (int i = tid; i < 16384; i += NTHR) { const int c = i >> 4, e = i & 15, ln = (c & 255) >> 2, q = c & 3, j = c >> 8;
        rwl[((((j * 4 + q) * 4 + (e >> 2)) * 64 + ln) << 2) + (e & 3)] = rw[i]; } }
    __syncthreads();
    const float* xin = (l == 0) ? p.in[IN_X] : p.out; float* z = p.out; bf16_t* H = (bf16_t*)(p.ws + WS_H); const bf16_t* T = (const bf16_t*)(p.ws + WS_T);
    const float* modg = (const float*)(p.ws + WS_MOD) + (size_t)(l * 2) * 16 * 3072; const float* mod = (const float*)(p.ws + WS_MOD) + (size_t)(l * 2 + 1) * 16 * 3072;
    f32x2* stats = (f32x2*)(p.ws + WS_STATS); const float* g = p.in[IN_LNG] + (size_t)(l * 2) * 1024; const float* bb = p.in[IN_LNB] + (size_t)(l * 2) * 1024;
    const float* gp = p.in[IN_LNG] + (size_t)((l > 0 ? l - 1 : 0) * 2 + 1) * 1024; const float* bp = p.in[IN_LNB] + (size_t)((l > 0 ? l - 1 : 0) * 2 + 1) * 1024;
    unsigned* cnt = (unsigned*)(p.ws + WS_CTL) + CW_CNT + l * 64; int* list = (int*)(p.ws + WS_R + R_LIST); float* cw = (float*)(p.ws + WS_R + R_CW);
    const float* rb = p.in[IN_RB];
    LAS unsigned* lcnt = (LAS unsigned*)(rwl + 16384); LAS unsigned* lbase = lcnt + 16; LAS unsigned* lrec = lcnt + 32;
    if (tid < 16) lcnt[tid] = 0u;
    __syncthreads();
    const int row0 = (blk * 8 + wv) * 32; int it_ = 0;
    RowV vgp, vbp, vg, vb, vgate, vsh, vsc1;
    vec_load(vgp, gp, lane); vec_load(vbp, bp, lane); vec_load(vg, g, lane); vec_load(vb, bb, lane);
    vec_load(vgate, modg + (size_t)(row0 >> 12) * 3072 + 2048, lane); vec_load(vsh, mod + (size_t)(row0 >> 12) * 3072, lane); vec_load(vsc1, mod + (size_t)(row0 >> 12) * 3072 + 1024, lane); vec_add1(vsc1);
    int row = row0;
    RowV cur; u32x2 tc[4]; row_load(cur, xin + (size_t)row * 1024, lane); row_load_t(tc, T + (size_t)row * 1024, lane);
    for (; row < row0 + 32; ++row) {
        const int nrow = row + 1; RowV nx; u32x2 tn[4];
        if (nrow < row0 + 32) { row_load(nx, xin + (size_t)nrow * 1024, lane); row_load_t(tn, T + (size_t)nrow * 1024, lane); }
        RowV r = cur, h;
        if (l > 0) { const f32x2 st = stats[row]; row_ln_r(r, st.x, st.y, vgp, vbp); }
        {
#pragma unroll
          for (int j = 0; j < 4; ++j) { const f32x4 gt = vgate.v[j];
              f32x4 y; y[0] = __uint_as_float(tc[j].x << 16); y[1] = __uint_as_float(tc[j].x & 0xffff0000u); y[2] = __uint_as_float(tc[j].y << 16); y[3] = __uint_as_float(tc[j].y & 0xffff0000u);
              r.v[j] = r.v[j] * DN_ALPHA + gt * y; *(f32x4*)(z + (size_t)row * 1024 + 4 * lane + 256 * j) = r.v[j]; } }
        float mean, rstd; row_stats(r, mean, rstd); if (lane == 0) stats[row] = (f32x2){mean, rstd};
        row_ln_r(r, mean, rstd, vg, vb); row_mod_r(h, r, vsh, vsc1); row_store_bf16(h, H + (size_t)row * 1024, lane);
        float a[16];
#pragma unroll
        for (int e = 0; e < 16; ++e) a[e] = 0.f;
#pragma unroll
        for (int j = 0; j < 4; ++j)
#pragma unroll
            for (int q = 0; q < 4; ++q) { const float hv = h.v[j][q]; const LAS float* wp = rwl + (((j * 4 + q) * 4) * 64 + lane) * 4;
                const f32x4 w0 = *(const LAS f32x4*)wp, w1 = *(const LAS f32x4*)(wp + 256), w2 = *(const LAS f32x4*)(wp + 512), w3 = *(const LAS f32x4*)(wp + 768);
#pragma unroll
                for (int e = 0; e < 4; ++e) { a[e] += hv * w0[e]; a[4 + e] += hv * w1[e]; a[8 + e] += hv * w2[e]; a[12 + e] += hv * w3[e]; }
                __builtin_amdgcn_sched_barrier(0); }
#pragma unroll
        for (int e = 0; e < 16; ++e) a[e] = wave_sum(a[e]);
        float sc[16], bi[16];
#pragma unroll
        for (int e = 0; e < 16; ++e) { sc[e] = sigmoidf_(a[e]); bi[e] = sc[e] + rb[e]; }
        int grp = 0; float best = -INFINITY;
#pragma unroll
        for (int gI = 0; gI < 4; ++gI) { float m1 = -INFINITY, m2 = -INFINITY;
#pragma unroll
            for (int q = 0; q < 4; ++q) { const float v = bi[4 * gI + q]; if (v > m1) { m2 = m1; m1 = v; } else if (v > m2) m2 = v; }
            const float gs = m1 + m2; if (gs > best) { best = gs; grp = gI; } }
        int e0 = 0, e1 = 0; float b0 = -INFINITY, b1 = -INFINITY, s0 = 0.f, s1 = 0.f;
#pragma unroll
        for (int gI = 0; gI < 4; ++gI)
#pragma unroll
            for (int q = 0; q < 4; ++q) { const int e = 4 * gI + q; if (gI == grp) { const float v = bi[e];
                if (v > b0) { b1 = b0; e1 = e0; s1 = s0; b0 = v; e0 = e; s0 = sc[e]; } else if (v > b1) { b1 = v; e1 = e; s1 = sc[e]; } } }
        const float inv = 1.0f / (s0 + s1);
        if (lane == 0) { const int li = wv * 32 + it_; const unsigned q0 = __hip_atomic_fetch_add(lcnt + e0, 1u, __ATOMIC_RELAXED, __HIP_MEMORY_SCOPE_WORKGROUP), q1 = __hip_atomic_fetch_add(lcnt + e1, 1u, __ATOMIC_RELAXED, __HIP_MEMORY_SCOPE_WORKGROUP);
                         lrec[li * 4 + 0] = (unsigned)e0 | (q0 << 8); lrec[li * 4 + 1] = (unsigned)e1 | (q1 << 8); lrec[li * 4 + 2] = __float_as_uint(s0 * inv); lrec[li * 4 + 3] = __float_as_uint(s1 * inv); }
        ++it_;
        cur = nx;
#pragma unroll
        for (int j = 0; j < 4; ++j) tc[j] = tn[j];
    }
    __syncthreads();
    if (tid < 16) lbase[tid] = atomicAdd(cnt + tid, lcnt[tid]);
    __syncthreads();
    if (tid < 256) { const int grow = blk * 256 + tid;
        const unsigned r0 = lrec[tid * 4 + 0], r1 = lrec[tid * 4 + 1]; const unsigned e0 = r0 & 255u, e1 = r1 & 255u;
        const size_t p0 = (size_t)e0 * MTOK + lbase[e0] + (r0 >> 8), p1 = (size_t)e1 * MTOK + lbase[e1] + (r1 >> 8);
        list[p0] = grow * 2; cw[p0] = __uint_as_float(lrec[tid * 4 + 2]); list[p1] = grow * 2 + 1; cw[p1] = __uint_as_float(lrec[tid * 4 + 3]); }
}
__device__ __forceinline__ void prep_next(const Params& p, int l, bool final_, const int tid, const int blk) {
    const int lane = tid & 63, wv = tid >> 6;
    float* z = p.out; bf16_t* H = (bf16_t*)(p.ws + WS_H); const float* modm = (const float*)(p.ws + WS_MOD) + (size_t)(l * 2 + 1) * 16 * 3072;
    const float* modn = (const float*)(p.ws + WS_MOD) + (size_t)((final_ ? l : l + 1) * 2) * 16 * 3072;
    f32x2* stats = (f32x2*)(p.ws + WS_STATS);
    const bf16_t* out2 = (const bf16_t*)(p.ws + WS_R + R_OUT2);
    const int row0 = (blk * 8 + wv) * 32, bt = row0 >> 12;
    RowV vg0, vb0, vg1, vb1, vgate, vsh, vsc1;
    vec_load(vg0, p.in[IN_LNG] + (size_t)(l * 2) * 1024, lane); vec_load(vb0, p.in[IN_LNB] + (size_t)(l * 2) * 1024, lane);
    vec_load(vg1, p.in[IN_LNG] + (size_t)(l * 2 + 1) * 1024, lane); vec_load(vb1, p.in[IN_LNB] + (size_t)(l * 2 + 1) * 1024, lane);
    vec_load(vgate, modm + (size_t)bt * 3072 + 2048, lane); vec_load(vsh, modn + (size_t)bt * 3072, lane); vec_load(vsc1, modn + (size_t)bt * 3072 + 1024, lane); vec_add1(vsc1);
    int row = row0;
    RowV cur; u32x2 ta[4], tb[4]; row_load(cur, z + (size_t)row * 1024, lane); row_load_t(ta, out2 + (size_t)(row * 2) * 1024, lane); row_load_t(tb, out2 + (size_t)(row * 2 + 1) * 1024, lane);
    for (; row < row0 + 32; ++row) {
        const int nrow = row + 1; RowV nx; u32x2 na[4], nb[4];
        if (nrow < row0 + 32) { row_load(nx, z + (size_t)nrow * 1024, lane); row_load_t(na, out2 + (size_t)(nrow * 2) * 1024, lane); row_load_t(nb, out2 + (size_t)(nrow * 2 + 1) * 1024, lane); }
        RowV r = cur;
        const f32x2 st = stats[row]; row_ln_r(r, st.x, st.y, vg0, vb0);
#pragma unroll
        for (int j = 0; j < 4; ++j) { const u32x2 oa = ta[j], ob = tb[j];
            f32x4 y; y[0] = __uint_as_float(oa.x << 16) + __uint_as_float(ob.x << 16); y[1] = __uint_as_float(oa.x & 0xffff0000u) + __uint_as_float(ob.x & 0xffff0000u);
            y[2] = __uint_as_float(oa.y << 16) + __uint_as_float(ob.y << 16); y[3] = __uint_as_float(oa.y & 0xffff0000u) + __uint_as_float(ob.y & 0xffff0000u);
            r.v[j] = r.v[j] * DN_ALPHA + vgate.v[j] * y; }
        cur = nx;
#pragma unroll
        for (int j = 0; j < 4; ++j) { ta[j] = na[j]; tb[j] = nb[j]; }
        float mean, rstd; row_stats(r, mean, rstd);
        if (final_) { row_ln_r(r, mean, rstd, vg1, vb1);
#pragma unroll
            for (int j = 0; j < 4; ++j) *(f32x4*)(z + (size_t)row * 1024 + 4 * lane + 256 * j) = r.v[j];
        } else {
#pragma unroll
            for (int j = 0; j < 4; ++j) *(f32x4*)(z + (size_t)row * 1024 + 4 * lane + 256 * j) = r.v[j];
            if (lane == 0) stats[row] = (f32x2){mean, rstd};
            RowV h; row_ln_r(r, mean, rstd, vg1, vb1); row_mod_r(h, r, vsh, vsc1); row_store_bf16(h, H + (size_t)row * 1024, lane); row_store_fp8(h, p.ws + WS_H8 + (size_t)row * 1024, lane); }
    }
}

__device__ __forceinline__ int q_next(unsigned* ctr, volatile LAS int* slot, const int tid) {
    __syncthreads();
    if (tid == 0) *slot = (int)__hip_atomic_fetch_add(ctr, 1u, __ATOMIC_RELAXED, __HIP_MEMORY_SCOPE_AGENT);
    __syncthreads();
    return *slot;
}

struct GdnRaw { u32x4 v[4]; float a, bg; };
__device__ __forceinline__ void gdn_prep_load(GdnRaw& g, int unit, const int tid) {
    unsigned char* ws = ws_late(); const int n = unit & 63, h = (unit >> 6) & 3, bl = unit >> 8; const int tok0 = bl * SEQ + n * 64;
    const bf16_t* proj = (const bf16_t*)(ws + WS_R + R_PROJ); const float* sm = (const float*)(ws + WS_R + R_SM);
#pragma unroll
    for (int j = 0; j < 4; ++j) { const int idx = tid + j * NTHR; const int row = idx / 24, ch = idx % 24, seg = ch >> 3, c8 = ch & 7;
        u32x4 v = {0u, 0u, 0u, 0u};
        if (idx < 67 * 24 && (n > 0 || row >= 3)) v = *(const u32x4*)(proj + (size_t)(tok0 + row - 3) * PROJW + seg * 256 + h * 64 + c8 * 8);
        g.v[j] = v; }
    g.a = 0.f; g.bg = 0.f;
    if (tid < 64) { g.a = sm[(size_t)(tok0 + tid) * 32 + h]; g.bg = sm[(size_t)(tok0 + tid) * 32 + 4 + h]; }
}
__device__ __forceinline__ void gdn_prep_unit(const Params& p, int l, int unit, LAS unsigned char* lds, const int tid_in_, const GdnRaw& graw) {
    int tid = tid_in_; asm volatile("" : "+v"(tid)); unsigned char* wsl_ = ws_late();
    const int lane = tid & 63;
    const int n = unit & 63, h = (unit >> 6) & 3, bl = unit >> 8;
    const int tok0 = bl * SEQ + n * 64;
    const bf16_t* proj = (const bf16_t*)(wsl_ + WS_R + R_PROJ); const float* sm = (const float*)(wsl_ + WS_R + R_SM);
    LAS bf16_t* raw = (LAS bf16_t*)lds;
    LAS float* qs = (LAS float*)(lds + 26112); LAS float* ks = qs + 64 * 65; LAS float* vs = ks + 64 * 65;
    LAS float* Lm = vs + 64 * 65;
    LAS float* bc = Lm + 4096; LAS float* eb = bc + 64; LAS float* be = eb + 64; LAS float* cwt = be + 64;
    __syncthreads();
#pragma unroll
    for (int j = 0; j < 4; ++j) { const int idx = tid + j * NTHR; const int row = idx / 24, ch = idx % 24, seg = ch >> 3, c8 = ch & 7;
        if (idx < 67 * 24) *(LAS u32x4*)(raw + row * 192 + seg * 64 + c8 * 8) = graw.v[j]; }
    for (int idx = tid; idx < 768; idx += NTHR) { const int k = idx / 192, ch = idx % 192; cwt[idx] = PIN(IN_CONVW)[(size_t)l * 4 * 768 + k * 768 + (ch >> 6) * 256 + h * 64 + (ch & 63)]; }
    __syncthreads();
#ifdef GP_REP_CONV
    for (int rep_ = 0; rep_ < 2; ++rep_)
#endif
    for (int idx = tid; idx < 64 * 192; idx += NTHR) { const int t = idx / 192, ch = idx % 192; float s = 0.f;
#pragma unroll
        for (int k = 0; k < 4; ++k) s += cwt[k * 192 + ch] * bf2f(raw[(t + k) * 192 + ch]);
        s = siluf_(s); const int seg = ch >> 6, d = ch & 63; (seg == 0 ? qs : seg == 1 ? ks : vs)[t * 65 + d] = s; }
    __syncthreads();
    LAS unsigned char* qb = lds + 129024; LAS unsigned char* kb = qb + 8192; LAS float* Rs = (LAS float*)(kb + 8192);
    {
        const int mat = tid >> 8, row = (tid >> 2) & 63, q4 = tid & 3; LAS float* mt = mat ? ks : qs; float x[16], ss = 0.f;
#pragma unroll
        for (int d = 0; d < 16; ++d) { x[d] = mt[row * 65 + 16 * q4 + d]; ss += x[d] * x[d]; }
        ss += swz_xor<1>(ss); ss += swz_xor<2>(ss);
        const float sc = (1.0f / sqrtf(ss + 1e-6f)) * (mat ? 1.0f : 0.125f);
#pragma unroll
        for (int d = 0; d < 16; ++d) { x[d] *= sc; mt[row * 65 + 16 * q4 + d] = x[d]; }
        LAS unsigned char* ob = (mat ? kb : qb) + (2 * q4) * 1024 + row * 16;
        u32x4 w0, w1; w0.x = pk2(x[0], x[1]); w0.y = pk2(x[2], x[3]); w0.z = pk2(x[4], x[5]); w0.w = pk2(x[6], x[7]); w1.x = pk2(x[8], x[9]); w1.y = pk2(x[10], x[11]); w1.z = pk2(x[12], x[13]); w1.w = pk2(x[14], x[15]);
        *(LAS u32x4*)ob = w0; *(LAS u32x4*)(ob + 1024) = w1;
    }
    if (tid < 64) { const int i = tid;
        const float a = graw.a, bg = graw.bg;
        const float x = a + PIN(IN_DTB)[l * 4 + h]; const float sp = fmaxf(x, 0.f) + log1pf(__expf(-fabsf(x)));
        float la = -__expf(PIN(IN_ALOG)[l * 4 + h]) * sp;
#pragma unroll
        for (int o = 1; o < 64; o <<= 1) { const float v = shfl_up_l(la, o, lane); if (lane >= o) la += v; }
        bc[i] = la; eb[i] = __expf(la); be[i] = sigmoidf_(bg); }
    __syncthreads();
    const size_t ub = WS_R + R_GDN + (size_t)unit * GDN_UNIT_BYTES;
    bf16_t* gW = (bf16_t*)(wsl_ + ub); bf16_t* gATT = gW + 4096; bf16_t* gQD = gW + 8192; bf16_t* gKDT = gW + 12288; bf16_t* gU0 = gW + 16384;
#ifdef GP_REP_KK
    for (int rep_ = 0; rep_ < 2; ++rep_)
#endif
    {
        const int wid = tid >> 6, r32 = lane & 31, hi = lane >> 5, isq = wid >> 2, it = (wid >> 1) & 1, jt = wid & 1;
        const LAS unsigned char* ab = (isq ? qb : kb) + hi * 1024 + (32 * it + r32) * 16; const LAS unsigned char* bb = kb + hi * 1024 + (32 * jt + r32) * 16;
        f32x16 acc = z16();
#pragma unroll
        for (int d0 = 0; d0 < 4; ++d0) acc = MF32(*(const LAS bf16x8*)(ab + d0 * 2048), *(const LAS bf16x8*)(bb + d0 * 2048), acc);
        const int j = 32 * jt + r32; const float bj = bc[j];
#pragma unroll
        for (int g = 0; g < 4; ++g) { f32x4 lv;
#pragma unroll
            for (int e = 0; e < 4; ++e) { const int i = 32 * it + 8 * g + 4 * hi + e; const float dc = __expf(bc[i] - bj), v = acc[4 * g + e] * dc;
                if (isq) gATT[i * 64 + j] = f2bf((j <= i) ? v : 0.f); else lv[e] = (j < i) ? be[i] * v : 0.f; }
            if (!isq) *(LAS f32x4*)(Lm + j * 64 + 32 * it + 8 * g + 4 * hi) = lv; }
    }
    __syncthreads();
    {
        const float bl_ = bc[63];
        for (int task = tid; task < 1024; task += NTHR) {
            if (task < 512) { const int c2 = task >> 3, sg = task & 7; const float e = eb[c2]; float v[8];
#pragma unroll
                for (int j = 0; j < 8; ++j) v[j] = qs[c2 * 65 + sg * 8 + j] * e;
                u32x4 w; w.x = pk2(v[0], v[1]); w.y = pk2(v[2], v[3]); w.z = pk2(v[4], v[5]); w.w = pk2(v[6], v[7]); *(u32x4*)(gQD + c2 * 64 + sg * 8) = w;
            } else { const int k = (task - 512) >> 3, sg = task & 7; float v[8];
#pragma unroll
                for (int j = 0; j < 8; ++j) { const int c2 = sg * 8 + j; v[j] = ks[c2 * 65 + k] * __expf(bl_ - bc[c2]); }
                u32x4 w; w.x = pk2(v[0], v[1]); w.y = pk2(v[2], v[3]); w.z = pk2(v[4], v[5]); w.w = pk2(v[6], v[7]); *(u32x4*)(gKDT + k * 64 + sg * 8) = w; }
        }
        if (tid == 0) ((float*)(wsl_ + WS_R + R_GG))[unit] = __expf(bl_);
    }
    {
        const int c = 16 * (tid >> 6) + (lane & 15), cc = c & 63, rg = lane >> 4; const bool isw = c >= 64; LAS float* Xs = cwt + 768;
        for (int I = 0; I < 4; ++I) {
            float r[4];
#pragma unroll
            for (int e = 0; e < 4; ++e) { const int i = 16 * I + 4 * rg + e; r[e] = isw ? be[i] * eb[i] * ks[i * 65 + cc] : be[i] * vs[i * 65 + cc]; }
#pragma unroll 4
            for (int j = 0; j < 16 * I; ++j) { const float xj = Xs[j * 128 + c]; const f32x4 l4 = *(const LAS f32x4*)(Lm + j * 64 + 16 * I + 4 * rg);
#pragma unroll
                for (int e = 0; e < 4; ++e) r[e] -= l4[e] * xj; }
#pragma unroll
            for (int e = 0; e < 4; ++e) Rs[(4 * rg + e) * 128 + c] = r[e];
            asm volatile("s_waitcnt lgkmcnt(0)" ::: "memory");
            if (lane < 16) { float q[16];
#pragma unroll
                for (int ii = 0; ii < 16; ++ii) q[ii] = Rs[ii * 128 + c];
#pragma unroll
                for (int jj = 0; jj < 15; ++jj) { const LAS float* lt = Lm + (16 * I + jj) * 64 + 16 * I;
#pragma unroll
                    for (int ii = jj + 1; ii < 16; ++ii) q[ii] -= lt[ii] * q[jj]; }
#pragma unroll
                for (int ii = 0; ii < 16; ++ii) { Xs[(16 * I + ii) * 128 + c] = q[ii]; (isw ? gW : gU0)[(16 * I + ii) * 64 + cc] = f2bf(q[ii]); }
            }
            asm volatile("s_waitcnt lgkmcnt(0)" ::: "memory");
        }
    }
    __syncthreads();
}

__device__ __forceinline__ bf16x8 afrag_perm(const LAS unsigned char* M, int row, int ks, int hi) {
    const LAS unsigned char* q = M + row * 144 + (16 * ks + 4 * hi) * 2;
    const s16x4 lo = *(const LAS s16x4*)q, hi4 = *(const LAS s16x4*)(q + 16);
    return (bf16x8){lo[0], lo[1], lo[2], lo[3], hi4[0], hi4[1], hi4[2], hi4[3]};
}
__device__ __forceinline__ bf16x8 pack_acc8(const f32x16& a, int s) {
    u32x4 w; w.x = pk2(a[8 * s + 0], a[8 * s + 1]); w.y = pk2(a[8 * s + 2], a[8 * s + 3]); w.z = pk2(a[8 * s + 4], a[8 * s + 5]); w.w = pk2(a[8 * s + 6], a[8 * s + 7]);
    return __builtin_bit_cast(bf16x8, w);
}
__device__ __forceinline__ void gdn_scan_item(const Params& p, int l, int chunk, int item, LAS unsigned char* lds, const int tid) {
    const int lane = tid & 63, wid = tid >> 6, vl = lane & 31, hi = lane >> 5;
    const int h = item & 3, bl = item >> 2;
    const unsigned char* ubase = p.ws + WS_R + R_GDN + (size_t)item * 64 * GDN_UNIT_BYTES;
    const float* gg = (const float*)(p.ws + WS_R + R_GG) + item * 64;
    const bf16_t* proj = (const bf16_t*)(p.ws + WS_R + R_PROJ); bf16_t* og = (bf16_t*)(p.ws + WS_R + R_O);
    const float* nw = PIN(IN_GNORM) + l * 64;
    constexpr int BUF = 5 * 9216;
    LAS unsigned char* buf0 = lds; LAS float* ob0 = (LAS float*)(lds + 2 * BUF);
    __syncthreads();
    for (int q = tid; q < 2560; q += NTHR) { const int mat = q >> 9, r = (q >> 3) & 63, sg = q & 7;
        *(LAS u32x4*)(buf0 + mat * 9216 + r * 144 + sg * 16) = *(const u32x4*)(ubase + mat * 8192 + r * 128 + sg * 16); }
    __syncthreads();
    f32x16 S[2]; S[0] = z16(); S[1] = z16();
    for (int n = 0; n < 64; ++n) {
        LAS unsigned char* bf = buf0 + (n & 1) * BUF; LAS float* ob = ob0 + (n & 1) * 4096;
        if (wid < 2) {
            const LAS unsigned char* Wm = bf; const LAS unsigned char* ATT = bf + 9216; const LAS unsigned char* QD = bf + 18432; const LAS unsigned char* KDT = bf + 27648; const LAS bf16_t* U0 = (const LAS bf16_t*)(bf + 36864);
            const float G = gg[n];
            bf16x8 Sb[4]; Sb[0] = pack_acc8(S[0], 0); Sb[1] = pack_acc8(S[0], 1); Sb[2] = pack_acc8(S[1], 0); Sb[3] = pack_acc8(S[1], 1);
            f32x16 u[2];
#pragma unroll
            for (int ct = 0; ct < 2; ++ct) { f32x16 a = z16();
#pragma unroll
                for (int ks = 0; ks < 4; ++ks) a = __builtin_amdgcn_mfma_f32_32x32x16_bf16(afrag_perm(Wm, 32 * ct + vl, ks, hi), Sb[ks], a, 0, 0, 0);
#pragma unroll
                for (int r = 0; r < 16; ++r) u[ct][r] = bf2f(U0[(32 * ct + crow(r, hi)) * 72 + 32 * wid + vl]) - a[r]; }
            bf16x8 ub[4]; ub[0] = pack_acc8(u[0], 0); ub[1] = pack_acc8(u[0], 1); ub[2] = pack_acc8(u[1], 0); ub[3] = pack_acc8(u[1], 1);
#pragma unroll
            for (int ct = 0; ct < 2; ++ct) { f32x16 a = z16();
#pragma unroll
                for (int ks = 0; ks < 4; ++ks) a = __builtin_amdgcn_mfma_f32_32x32x16_bf16(afrag_perm(QD, 32 * ct + vl, ks, hi), Sb[ks], a, 0, 0, 0);
#pragma unroll
                for (int cs = 0; cs < 4; ++cs) a = __builtin_amdgcn_mfma_f32_32x32x16_bf16(afrag_perm(ATT, 32 * ct + vl, cs, hi), ub[cs], a, 0, 0, 0);
#pragma unroll
                for (int r = 0; r < 16; ++r) ob[(32 * ct + crow(r, hi)) * 64 + 32 * wid + vl] = a[r]; }
#pragma unroll
            for (int kt = 0; kt < 2; ++kt) { f32x16 a = S[kt] * G;
#pragma unroll
                for (int cs = 0; cs < 4; ++cs) a = __builtin_amdgcn_mfma_f32_32x32x16_bf16(afrag_perm(KDT, 32 * kt + vl, cs, hi), ub[cs], a, 0, 0, 0);
                S[kt] = a; }
        } else {
            if (n + 1 < 64) { LAS unsigned char* nb = buf0 + ((n + 1) & 1) * BUF; const unsigned char* src = ubase + (size_t)(n + 1) * GDN_UNIT_BYTES;
                for (int q = tid - 128; q < 2560; q += 384) { const int mat = q >> 9, r = (q >> 3) & 63, sg = q & 7;
                    *(LAS u32x4*)(nb + mat * 9216 + r * 144 + sg * 16) = *(const u32x4*)(src + mat * 8192 + r * 128 + sg * 16); } }
        }
        if (wid >= 2 && n >= 1) { const LAS float* po = ob0 + ((n - 1) & 1) * 4096; const int tokb = bl * SEQ + (n - 1) * 64;
            for (int task = tid - 128; task < 512; task += 384) { const int c = task >> 3, sg = task & 7; float v[8], ss = 0.f;
#pragma unroll
                for (int j = 0; j < 8; ++j) { v[j] = po[c * 64 + sg * 8 + j]; ss += v[j] * v[j]; }
                ss += swz_xor<1>(ss); ss += swz_xor<2>(ss); ss += swz_xor<4>(ss);
                const float rs = 1.0f / sqrtf(ss * (1.0f / 64.0f) + 1e-6f);
                const u32x4 zw = *(const u32x4*)(proj + (size_t)(tokb + c) * PROJW + PC_GZ + h * 64 + sg * 8); const unsigned zz[4] = {zw.x, zw.y, zw.z, zw.w};
#pragma unroll
                for (int j = 0; j < 8; ++j) { const float zf = (j & 1) ? __uint_as_float(zz[j >> 1] & 0xffff0000u) : __uint_as_float(zz[j >> 1] << 16); v[j] = v[j] * rs * nw[sg * 8 + j] * siluf_(zf); }
                u32x4 w; w.x = pk2(v[0], v[1]); w.y = pk2(v[2], v[3]); w.z = pk2(v[4], v[5]); w.w = pk2(v[6], v[7]);
                *(u32x4*)(og + (size_t)(tokb + c) * 256 + h * 64 + sg * 8) = w; } }
        __syncthreads();
    }
    { const LAS float* po = ob0 + 4096; const int tokb = bl * SEQ + 63 * 64;
        for (int task = tid; task < 512; task += NTHR) { const int c = task >> 3, sg = task & 7; float v[8], ss = 0.f;
#pragma unroll
            for (int j = 0; j < 8; ++j) { v[j] = po[c * 64 + sg * 8 + j]; ss += v[j] * v[j]; }
            ss += swz_xor<1>(ss); ss += swz_xor<2>(ss); ss += swz_xor<4>(ss);
            const float rs = 1.0f / sqrtf(ss * (1.0f / 64.0f) + 1e-6f);
            const u32x4 zw = *(const u32x4*)(proj + (size_t)(tokb + c) * PROJW + PC_GZ + h * 64 + sg * 8); const unsigned zz[4] = {zw.x, zw.y, zw.z, zw.w};
#pragma unroll
            for (int j = 0; j < 8; ++j) { const float zf = (j & 1) ? __uint_as_float(zz[j >> 1] & 0xffff0000u) : __uint_as_float(zz[j >> 1] << 16); v[j] = v[j] * rs * nw[sg * 8 + j] * siluf_(zf); }
            u32x4 w; w.x = pk2(v[0], v[1]); w.y = pk2(v[2], v[3]); w.z = pk2(v[4], v[5]); w.w = pk2(v[6], v[7]);
            *(u32x4*)(og + (size_t)(tokb + c) * 256 + h * 64 + sg * 8) = w; } }
    __syncthreads();
}

__device__ __forceinline__ void fox_cum_item(const Params& p, int l, int item, LAS float* lf, const int tid) {
    const int lane = tid & 63, wid = tid >> 6, h = item & 3, bl = item >> 2;
    const float* sm = (const float*)(p.ws + WS_R + R_SM); float* nb = (float*)(p.ws + WS_R + R_CUM) + (size_t)item * SEQ;
    const float fb = PIN(IN_FBIAS)[l * 4 + h];
    float v[8], run = 0.f;
#pragma unroll
    for (int j = 0; j < 8; ++j) { const float x = sm[(size_t)(bl * SEQ + tid * 8 + j) * 32 + 20 + h] + fb; run += fminf(x, 0.f) - log1pf(__expf(-fabsf(x))); v[j] = run; }
    float inc = run;
#pragma unroll
    for (int o = 1; o < 64; o <<= 1) { const float t = shfl_up_l(inc, o, lane); if (lane >= o) inc += t; }
    __syncthreads();
    if (lane == 63) lf[wid] = inc;
    __syncthreads();
    float base = inc - run;
    for (int w = 0; w < wid; ++w) base += lf[w];
#pragma unroll
    for (int j = 0; j < 8; ++j) nb[tid * 8 + j] = -(base + v[j]) * LOG2E;
    __syncthreads();
}
__device__ __forceinline__ void ret_rope_pass(const Params& p, int chunk, const int tid, const int blk) {
    bf16_t* proj = (bf16_t*)(p.ws + WS_R + R_PROJ); const f32x2* tab = (const f32x2*)(p.ws + WS_ROPE);
    for (int task = blk * NTHR + tid; task < MC * 32; task += NWG * NTHR) {
        const int row = task >> 5, which = (task >> 4) & 1, h = (task >> 2) & 3, i8 = task & 3;
        bf16_t* q1 = proj + (size_t)row * PROJW + (which ? PC_RK : PC_RQ) + h * 64 + i8 * 8; bf16_t* q2 = q1 + 32;
        const u32x4 a = *(const u32x4*)q1, b = *(const u32x4*)q2; const unsigned aa[4] = {a.x, a.y, a.z, a.w}, bb[4] = {b.x, b.y, b.z, b.w};
        const f32x2* tp = tab + (size_t)(chunk * MC + row) * 32 + i8 * 8; float o1[8], o2[8];
#pragma unroll
        for (int j = 0; j < 8; ++j) { const float x1 = (j & 1) ? __uint_as_float(aa[j >> 1] & 0xffff0000u) : __uint_as_float(aa[j >> 1] << 16);
            const float x2 = (j & 1) ? __uint_as_float(bb[j >> 1] & 0xffff0000u) : __uint_as_float(bb[j >> 1] << 16);
            const f32x2 cs = tp[j]; o1[j] = x1 * cs.x - x2 * cs.y; o2[j] = x1 * cs.y + x2 * cs.x; }
        u32x4 w1, w2; w1.x = pk2(o1[0], o1[1]); w1.y = pk2(o1[2], o1[3]); w1.z = pk2(o1[4], o1[5]); w1.w = pk2(o1[6], o1[7]);
        w2.x = pk2(o2[0], o2[1]); w2.y = pk2(o2[2], o2[3]); w2.z = pk2(o2[4], o2[5]); w2.w = pk2(o2[6], o2[7]);
        *(u32x4*)q1 = w1; *(u32x4*)q2 = w2; }
}

constexpr int AL_K0 = 0, AL_V0 = 16384, AL_B0 = 32768;
__device__ __forceinline__ s16x4 vtr(const LAS unsigned char* q) {
    typedef short v4i16_t __attribute__((ext_vector_type(4)));
    return __builtin_bit_cast(s16x4, __builtin_amdgcn_ds_read_tr16_b64_v4i16((LAS v4i16_t*)q));
}
__device__ __forceinline__ void attn_qkt(f32x16& p0, f32x16& p1, const LAS unsigned char* kslot, const bf16x8 (&qf)[4], int r32, int hi) {
    p0 = z16(); p1 = z16();
#pragma unroll
    for (int d0 = 0; d0 < 4; ++d0) { const LAS unsigned char* kb = kslot + (2 * d0 + hi) * 1024 + r32 * 16;
        const bf16x8 b0 = *(const LAS bf16x8*)kb, b1 = *(const LAS bf16x8*)(kb + 512);
        p0 = MF32(b0, qf[d0], p0); p1 = MF32(b1, qf[d0], p1); }
}
__device__ __forceinline__ void attn_pv(f32x16 (&o)[2], const LAS unsigned char* vslot, const bf16x8 (&pw)[4], int lane, int hi) {
    const LAS unsigned char* vb = vslot + ((lane >> 4) & 1) * 32 + (lane & 3) * 8 + (4 * hi + ((lane & 15) >> 2)) * 64;
#pragma unroll
    for (int d0 = 0; d0 < 2; ++d0)
#pragma unroll
        for (int ks = 0; ks < 4; ++ks) { const s16x4 lo = vtr(vb + d0 * 4096 + ks * 1024), h4 = vtr(vb + d0 * 4096 + ks * 1024 + 512);
            const bf16x8 vf = (bf16x8){lo[0], lo[1], lo[2], lo[3], h4[0], h4[1], h4[2], h4[3]};
            o[d0] = MF32(vf, pw[ks], o[d0]); }
}
__device__ __forceinline__ void attn_softmax_step(f32x16& p0, f32x16& p1, f32x16 (&o)[2], float& m, float& l) {
    float mt = p0[0];
#pragma unroll
    for (int r = 1; r < 16; ++r) mt = fmaxf(mt, p0[r]);
#pragma unroll
    for (int r = 0; r < 16; ++r) mt = fmaxf(mt, p1[r]);
    mt = x32_max(mt);
    const float mn = fmaxf(m, mt), ms = (mn == -INFINITY) ? 0.f : mn, alpha = ex2(m - ms);
    float s = 0.f;
#pragma unroll
    for (int r = 0; r < 16; ++r) { p0[r] = ex2(p0[r] - ms); p1[r] = ex2(p1[r] - ms); s += p0[r] + p1[r]; }
    l = l * alpha + s; m = mn;
    if (__builtin_amdgcn_ballot_w64(alpha != 1.0f) != 0ull) { o[0] *= alpha; o[1] *= alpha; }
}
template <class F>
__device__ __forceinline__ void flash_loop(const F& f, int tlo, int thi, const bf16_t* Kg, const bf16_t* Vg, int pitch, const float* biasg,
                                           const bf16x8 (&qf)[4], f32x16 (&o)[2], float& m, float& l, LAS unsigned char* lds, const int tid) {
    const int lane = tid & 63, wid = tid >> 6, r32 = lane & 31, hi = lane >> 5;
    int t = tlo; while (t < thi && f.skip(t)) ++t;
    __syncthreads();
    if (t >= thi) return;
    const bf16_t* ksrc = Kg + (size_t)lane * pitch + wid * 8;
    const bf16_t* vsrc = Vg + (size_t)(16 * (wid & 3) + (lane >> 2)) * pitch + (wid >> 2) * 32 + (lane & 3) * 8;
    const int sdst = wid * 1024 + lane * 16;
    u32x4 kr = *(const u32x4*)(ksrc + (size_t)t * 64 * pitch), vr = *(const u32x4*)(vsrc + (size_t)t * 64 * pitch); float br = 0.f;
    const int btid = tid & 63;
    if (F::HAS_BIAS) br = biasg[t * 64 + btid];
    *(LAS u32x4*)(lds + AL_K0 + sdst) = kr; *(LAS u32x4*)(lds + AL_V0 + sdst) = vr; if (F::HAS_BIAS) ((LAS float*)(lds + AL_B0))[btid] = br;
    __syncthreads();
    int cur = 0;
    for (;;) {
        int tn = t + 1; while (tn < thi && f.skip(tn)) ++tn;
        if (tn < thi) { kr = *(const u32x4*)(ksrc + (size_t)tn * 64 * pitch); vr = *(const u32x4*)(vsrc + (size_t)tn * 64 * pitch); if (F::HAS_BIAS) br = biasg[tn * 64 + btid]; }
        if (!f.wskip(t)) {
        f32x16 p0, p1;
        attn_qkt(p0, p1, lds + AL_K0 + cur * 8192, qf, r32, hi);
        if (F::HAS_BIAS) { const LAS float* bp = (const LAS float*)(lds + AL_B0 + cur * 256);
#pragma unroll
            for (int g = 0; g < 4; ++g) { const f32x4 b0 = *(const LAS f32x4*)(bp + 8 * g + 4 * hi), b1 = *(const LAS f32x4*)(bp + 32 + 8 * g + 4 * hi);
#pragma unroll
                for (int e = 0; e < 4; ++e) { p0[4 * g + e] += b0[e]; p1[4 * g + e] += b1[e]; } } }
        f.apply(p0, p1, t);
        if (F::MODE == 0) attn_softmax_step(p0, p1, o, m, l);
        bf16x8 pw[4]; pw[0] = pack_acc8(p0, 0); pw[1] = pack_acc8(p0, 1); pw[2] = pack_acc8(p1, 0); pw[3] = pack_acc8(p1, 1);
        attn_pv(o, lds + AL_V0 + cur * 8192, pw, lane, hi);
        }
        if (tn >= thi) break;
        cur ^= 1;
        *(LAS u32x4*)(lds + AL_K0 + cur * 8192 + sdst) = kr; *(LAS u32x4*)(lds + AL_V0 + cur * 8192 + sdst) = vr; if (F::HAS_BIAS) ((LAS float*)(lds + AL_B0 + cur * 256))[btid] = br;
        __syncthreads();
        t = tn;
    }
    __syncthreads();
}
__device__ __forceinline__ void load_qf(bf16x8 (&qf)[4], const bf16_t* qrow, int hi) {
#pragma unroll
    for (int d0 = 0; d0 < 4; ++d0) qf[d0] = *(const bf16x8*)(qrow + d0 * 16 + hi * 8);
}
__device__ __forceinline__ void store_ot(const f32x16 (&o)[2], bf16_t* orow, int hi) {
#pragma unroll
    for (int d0 = 0; d0 < 2; ++d0)
#pragma unroll
        for (int g = 0; g < 4; ++g) { u32x2 w; w.x = pk2(o[d0][4 * g], o[d0][4 * g + 1]); w.y = pk2(o[d0][4 * g + 2], o[d0][4 * g + 3]); *(u32x2*)(orow + 32 * d0 + 8 * g + 4 * hi) = w; }
}

struct FoxF { static constexpr int MODE = 0; static constexpr bool HAS_BIAS = true; int tq, qmin, hi;
    __device__ __forceinline__ bool skip(int) const { return false; }
    __device__ __forceinline__ bool wskip(int) const { return false; }
    __device__ __forceinline__ void apply(f32x16& p0, f32x16& p1, int t) const { const float NI = ninf_();
        if (64 * t + 63 > qmin) {
#pragma unroll
            for (int r = 0; r < 16; ++r) { const int key = 64 * t + crow(r, hi); if (key > tq) p0[r] = NI; if (key + 32 > tq) p1[r] = NI; } } } };
struct RetF { static constexpr int MODE = 1; static constexpr bool HAS_BIAS = false; int tq, hi; float lg;
    __device__ __forceinline__ bool skip(int) const { return false; }
    __device__ __forceinline__ bool wskip(int) const { return false; }
    __device__ __forceinline__ void apply(f32x16& p0, f32x16& p1, int t) const { const float NI = ninf_();
#pragma unroll
        for (int r = 0; r < 16; ++r) { const int key = 64 * t + crow(r, hi);
            p0[r] = (key <= tq) ? p0[r] * ex2((float)(tq - key) * lg) : 0.f; p1[r] = (key + 32 <= tq) ? p1[r] * ex2((float)(tq - key - 32) * lg) : 0.f; } } };
struct SelF { static constexpr int MODE = 0; static constexpr bool HAS_BIAS = false; unsigned long long umask, wmask, mymask; int tq, klo, hi;
    __device__ __forceinline__ bool skip(int t) const { return ((umask >> t) & 1ull) == 0ull; }
    __device__ __forceinline__ bool wskip(int t) const { return ((wmask >> t) & 1ull) == 0ull; }
    int tdiag, tlo;
    __device__ __forceinline__ void apply(f32x16& p0, f32x16& p1, int t) const { const float NI = ninf_(); const bool on = ((mymask >> t) & 1ull) != 0ull;
        if (t >= tdiag || t <= tlo) {
#pragma unroll
            for (int r = 0; r < 16; ++r) { const int key = 64 * t + crow(r, hi); if (!on || key > tq || key <= klo) p0[r] = NI; if (!on || key + 32 > tq || key + 32 <= klo) p1[r] = NI; }
        } else if (__builtin_amdgcn_ballot_w64(!on) != 0ull) {
#pragma unroll
            for (int r = 0; r < 16; ++r) { if (!on) { p0[r] = NI; p1[r] = NI; } }
        } } };
__device__ __forceinline__ void fox_unit(const Params& p, int idx, LAS unsigned char* lds, const int tid_in_) {
    int tid = tid_in_; asm volatile("" : "+v"(tid)); unsigned char* wsl_ = ws_late();
    const int lane = tid & 63, wid = tid >> 6, r32 = lane & 31, hi = lane >> 5;
    const int qb = 15 - idx / (BC * 4), bh = idx % (BC * 4), h = bh & 3, bl = bh >> 2;
    const bf16_t* proj = (const bf16_t*)(wsl_ + WS_R + R_PROJ);
    const int tq = qb * 256 + wid * 32 + r32; const size_t rowc = (size_t)bl * SEQ + tq;
    bf16x8 qf[4]; load_qf(qf, proj + rowc * PROJW + PC_FQ + h * 64, hi);
    f32x16 o[2]; o[0] = z16(); o[1] = z16(); float m = -INFINITY, l = 0.f;
    FoxF f; f.tq = tq; f.qmin = qb * 256; f.hi = hi;
    flash_loop(f, 0, 4 * qb + 4, proj + (size_t)bl * SEQ * PROJW + PC_FK + h * 64, proj + (size_t)bl * SEQ * PROJW + PC_FV + h * 64, PROJW,
               (const float*)(wsl_ + WS_R + R_CUM) + (size_t)bh * SEQ, qf, o, m, l, lds, tid);
    l = x32_sum(l); const float inv = 1.0f / l; o[0] *= inv; o[1] *= inv;
    store_ot(o, (bf16_t*)(wsl_ + WS_R + R_O) + (size_t)3 * MC * 256 + rowc * 256 + h * 64, hi);
}
__device__ __forceinline__ void rope8(float (&o1)[8], float (&o2)[8], const u32x4& a, const u32x4& b, const f32x2* tp) {
    const unsigned aa[4] = {a.x, a.y, a.z, a.w}, bb[4] = {b.x, b.y, b.z, b.w};
#pragma unroll
    for (int j = 0; j < 8; ++j) { const float x1 = (j & 1) ? __uint_as_float(aa[j >> 1] & 0xffff0000u) : __uint_as_float(aa[j >> 1] << 16);
        const float x2 = (j & 1) ? __uint_as_float(bb[j >> 1] & 0xffff0000u) : __uint_as_float(bb[j >> 1] << 16);
        const f32x2 cs = tp[j]; o1[j] = x1 * cs.x - x2 * cs.y; o2[j] = x1 * cs.y + x2 * cs.x; }
}
__device__ __forceinline__ u32x4 pack8f(const float (&v)[8]) { u32x4 w; w.x = pk2(v[0], v[1]); w.y = pk2(v[2], v[3]); w.z = pk2(v[4], v[5]); w.w = pk2(v[6], v[7]); return w; }
__device__ __forceinline__ void ret_kv_unit(const Params& p, int ch, int idx, LAS unsigned char* lds, const int tid_in_) {
    int tid = tid_in_; asm volatile("" : "+v"(tid)); unsigned char* wsl_ = ws_late();
    const int lane = tid & 63, wid = tid >> 6, hi = lane >> 5;
    const int n = idx & 31, bh = idx >> 5, h = bh & 3, bl = bh >> 2;
    const bf16_t* proj = (const bf16_t*)(wsl_ + WS_R + R_PROJ); const f32x2* tab = (const f32x2*)(wsl_ + WS_ROPE);
    const size_t rowc0 = (size_t)bl * SEQ + n * 128; const float lg = log2f(1.0f - exp2f(-5.0f - (float)h));
    LAS unsigned char* KZ = lds; LAS unsigned char* VT = lds + 16384;
    __syncthreads();
    { const int key = tid >> 2, cp = tid & 3; const bf16_t* src = proj + (rowc0 + key) * PROJW + PC_RK + h * 64 + cp * 8;
      const u32x4 a = *(const u32x4*)src, b = *(const u32x4*)(src + 32); float o1[8], o2[8];
      rope8(o1, o2, a, b, tab + ((size_t)ch * MC + rowc0 + key) * 32 + cp * 8);
      const float zt = ex2((float)(127 - key) * lg);
#pragma unroll
      for (int j = 0; j < 8; ++j) { o1[j] *= zt; o2[j] *= zt; }
      LAS unsigned char* d = KZ + (key >> 6) * 8192 + ((key & 63) >> 4) * 1024 + (key & 15) * 64 + cp * 16;
      *(LAS u32x4*)d = pack8f(o1); *(LAS u32x4*)(d + 4096) = pack8f(o2); }
#pragma unroll
    for (int t2 = 0; t2 < 2; ++t2)
        *(LAS u32x4*)(VT + t2 * 8192 + wid * 1024 + lane * 16) = *(const u32x4*)(proj + (rowc0 + 64 * t2 + 16 * (wid & 3) + (lane >> 2)) * PROJW + PC_RV + h * 64 + (wid >> 2) * 32 + (lane & 3) * 8);
    __syncthreads();
    if (wid < 4) { const int vt = wid >> 1, kt = wid & 1;
        const int fo = ((lane >> 4) & 1) * 32 + (lane & 3) * 8 + (4 * hi + ((lane & 15) >> 2)) * 64;
        f32x16 acc = z16();
#pragma unroll
        for (int t2 = 0; t2 < 2; ++t2)
#pragma unroll
            for (int ks = 0; ks < 4; ++ks) { const LAS unsigned char* va = VT + t2 * 8192 + vt * 4096 + ks * 1024 + fo; const LAS unsigned char* ka = KZ + t2 * 8192 + kt * 4096 + ks * 1024 + fo;
                const s16x4 v0 = vtr(va), v1 = vtr(va + 512), k0 = vtr(ka), k1 = vtr(ka + 512);
                acc = MF32(((bf16x8){v0[0], v0[1], v0[2], v0[3], v1[0], v1[1], v1[2], v1[3]}), ((bf16x8){k0[0], k0[1], k0[2], k0[3], k1[0], k1[1], k1[2], k1[3]}), acc); }
        float* kvt = (float*)(wsl_ + WS_R + R_KVT) + (size_t)idx * 4096;
#pragma unroll
        for (int r = 0; r < 16; ++r) kvt[(32 * vt + crow(r, hi)) * 64 + 32 * kt + (lane & 31)] = acc[r]; }
    __syncthreads();
}
__device__ __forceinline__ void ret_out_unit(const Params& p, int l_, int ch, int idx, LAS unsigned char* lds, const int tid_in_) {
    int tid = tid_in_; asm volatile("" : "+v"(tid)); unsigned char* wsl_ = ws_late();
    const int lane = tid & 63, wid = tid >> 6, r32 = lane & 31, hi = lane >> 5, gw = wid >> 2, wq = wid & 3;
    const int np = 15 - idx / (BC * 4), bh = idx % (BC * 4), h = bh & 3, bl = bh >> 2, n = 2 * np + gw;
    const bf16_t* proj = (const bf16_t*)(wsl_ + WS_R + R_PROJ); const f32x2* tab = (const f32x2*)(wsl_ + WS_ROPE);
    const float lg = log2f(1.0f - exp2f(-5.0f - (float)h));
    LAS unsigned char* KS = lds; LAS unsigned char* VS = lds + 32768; LAS unsigned char* RT = lds + 65536;
    const int tql = 32 * wq + r32; const size_t rowc = (size_t)bl * SEQ + n * 128 + tql;
    bf16x8 qf[4];
    { const bf16_t* qrow = proj + rowc * PROJW + PC_RQ + h * 64; const f32x2* tp = tab + ((size_t)ch * MC + rowc) * 32;
#pragma unroll
      for (int d0 = 0; d0 < 2; ++d0) { const u32x4 a = *(const u32x4*)(qrow + d0 * 16 + hi * 8), b = *(const u32x4*)(qrow + 32 + d0 * 16 + hi * 8); float o1[8], o2[8];
          rope8(o1, o2, a, b, tp + d0 * 16 + hi * 8); qf[d0] = __builtin_bit_cast(bf16x8, pack8f(o1)); qf[d0 + 2] = __builtin_bit_cast(bf16x8, pack8f(o2)); } }
    __syncthreads();
#pragma unroll
    for (int g = 0; g < 2; ++g) { const size_t r0 = (size_t)bl * SEQ + (2 * np + g) * 128;
        { const int key = tid >> 2, cp = tid & 3; const bf16_t* src = proj + (r0 + key) * PROJW + PC_RK + h * 64 + cp * 8;
          const u32x4 a = *(const u32x4*)src, b = *(const u32x4*)(src + 32); float o1[8], o2[8];
          rope8(o1, o2, a, b, tab + ((size_t)ch * MC + r0 + key) * 32 + cp * 8);
          LAS unsigned char* d = KS + (g * 2 + (key >> 6)) * 8192 + cp * 1024 + (key & 63) * 16;
          *(LAS u32x4*)d = pack8f(o1); *(LAS u32x4*)(d + 4096) = pack8f(o2); }
#pragma unroll
        for (int t2 = 0; t2 < 2; ++t2)
            *(LAS u32x4*)(VS + (g * 2 + t2) * 8192 + wid * 1024 + lane * 16) = *(const u32x4*)(proj + (r0 + 64 * t2 + 16 * (wid & 3) + (lane >> 2)) * PROJW + PC_RV + h * 64 + (wid >> 2) * 32 + (lane & 3) * 8); }
    { const int t = tid & 255; const float gdec = ex2(128.0f * lg); const float* kv0 = (const float*)(wsl_ + WS_R + R_KVT) + (size_t)(bh * 32) * 4096;
#pragma unroll
      for (int q = 0; q < 2; ++q) { const int task = t + 256 * q, v = task >> 3, kc = task & 7; f32x4 a0 = {0.f, 0.f, 0.f, 0.f}, a1 = {0.f, 0.f, 0.f, 0.f};
          int m = 0;
          for (; m + 8 <= n; m += 8) { f32x4 x0[8], x1[8];
#pragma unroll
              for (int q8 = 0; q8 < 8; ++q8) { const float* s = kv0 + (size_t)(m + q8) * 4096 + v * 64 + kc * 8; x0[q8] = *(const f32x4*)s; x1[q8] = *(const f32x4*)(s + 4); }
#pragma unroll
              for (int q8 = 0; q8 < 8; ++q8) { a0 = a0 * gdec + x0[q8]; a1 = a1 * gdec + x1[q8]; } }
          for (; m < n; ++m) { const float* s = kv0 + (size_t)m * 4096 + v * 64 + kc * 8; a0 = a0 * gdec + *(const f32x4*)s; a1 = a1 * gdec + *(const f32x4*)(s + 4); }
          *(LAS u32x4*)(RT + gw * 8192 + kc * 1024 + v * 16) = pack8(a0, a1); } }
    __syncthreads();
    f32x16 o[2];
    { f32x16 p0, p1; attn_qkt(p0, p1, RT + gw * 8192, qf, r32, hi); const float xi = ex2((float)(tql + 1) * lg); o[0] = p0 * xi; o[1] = p1 * xi; }
    for (int kt = 0; kt <= (wq >> 1); ++kt) { f32x16 p0, p1; attn_qkt(p0, p1, KS + (gw * 2 + kt) * 8192, qf, r32, hi);
#pragma unroll
        for (int r = 0; r < 16; ++r) { const int key = 64 * kt + crow(r, hi);
            p0[r] = (key <= tql) ? p0[r] * ex2((float)(tql - key) * lg) : 0.f; p1[r] = (key + 32 <= tql) ? p1[r] * ex2((float)(tql - key - 32) * lg) : 0.f; }
        bf16x8 pw[4]; pw[0] = pack_acc8(p0, 0); pw[1] = pack_acc8(p0, 1); pw[2] = pack_acc8(p1, 0); pw[3] = pack_acc8(p1, 1);
        attn_pv(o, VS + (gw * 2 + kt) * 8192, pw, lane, hi); }
    float s = 0.f;
#pragma unroll
    for (int r = 0; r < 16; ++r) s += o[0][r] + o[1][r];
    s = x32_sum(s); const float mu = s * (1.0f / 64.0f); float q = 0.f;
#pragma unroll
    for (int r = 0; r < 16; ++r) { const float a = o[0][r] - mu, b = o[1][r] - mu; q += a * a + b * b; }
    q = x32_sum(q); const float rs = 1.0f / sqrtf(q * (1.0f / 64.0f) + LN_EPS);
    const float* gw_ = PIN(IN_RETGN) + l_ * 256 + h * 64; const bf16_t* grow = proj + rowc * PROJW + PC_RG + h * 64;
#pragma unroll
    for (int d0 = 0; d0 < 2; ++d0)
#pragma unroll
        for (int g = 0; g < 4; ++g) { const int d = 32 * d0 + 8 * g + 4 * hi; const u32x2 gz = *(const u32x2*)(grow + d); const f32x4 w4 = *(const f32x4*)(gw_ + d);
            const float gg[4] = {__uint_as_float(gz.x << 16), __uint_as_float(gz.x & 0xffff0000u), __uint_as_float(gz.y << 16), __uint_as_float(gz.y & 0xffff0000u)};
#pragma unroll
            for (int e = 0; e < 4; ++e) o[d0][4 * g + e] = (o[d0][4 * g + e] - mu) * rs * w4[e] * siluf_(gg[e]); }
    store_ot(o, (bf16_t*)(wsl_ + WS_R + R_O) + (size_t)1 * MC * 256 + rowc * 256 + h * 64, hi);
    __syncthreads();
}
constexpr int NL_KC = 36864, NL_VC = 69632, NL_IMPM = 102400, NL_IMPS = 118784, NL_SELM = 135424;
__device__ __forceinline__ void nsa_unit(const Params& p, int idx, LAS unsigned char* lds, const int tid_in_) {
    int tid = tid_in_; asm volatile("" : "+v"(tid)); unsigned char* wsl_ = ws_late();
    const int lane = tid & 63, wid = tid >> 6, r32 = lane & 31, hi = lane >> 5, tl = r32 >> 2, hd = r32 & 3;
    const int ib = 63 - idx / BC, bl = idx % BC;
    const bf16_t* proj = (const bf16_t*)(wsl_ + WS_R + R_PROJ); const float* sm = (const float*)(wsl_ + WS_R + R_SM);
    const int tokl = 8 * wid + tl, tq = ib * 64 + tokl; const size_t rowc = (size_t)bl * SEQ + tq;
    bf16x8 qf[4]; load_qf(qf, proj + rowc * PROJW + PC_NQ + hd * 64, hi);
    const float g0 = sigmoidf_(sm[rowc * 32 + 8 + hd * 3 + 0]), g1 = sigmoidf_(sm[rowc * 32 + 8 + hd * 3 + 1]), g2 = sigmoidf_(sm[rowc * 32 + 8 + hd * 3 + 2]);
    f32x16 of[2];
    const int ntc = min(3, (4 * ib + 2) >> 6) + 1;
    {
        const bf16_t* kc = (const bf16_t*)(wsl_ + WS_R + R_KCMP) + (size_t)bl * 256 * 64; const bf16_t* vc = kc + (size_t)BC * 256 * 64;
        __syncthreads();
        for (int tt = 0; tt < ntc; ++tt) {
            *(LAS u32x4*)(lds + NL_KC + tt * 8192 + wid * 1024 + lane * 16) = *(const u32x4*)(kc + (size_t)(tt * 64 + lane) * 64 + wid * 8);
            *(LAS u32x4*)(lds + NL_VC + tt * 8192 + wid * 1024 + lane * 16) = *(const u32x4*)(vc + (size_t)(tt * 64 + 16 * (wid & 3) + (lane >> 2)) * 64 + (wid >> 2) * 32 + (lane & 3) * 8); }
        __syncthreads();
        float m = -INFINITY, l = 0.f;
        for (int tt = 0; tt < ntc; ++tt) { f32x16 p0, p1; attn_qkt(p0, p1, lds + NL_KC + tt * 8192, qf, r32, hi);
#pragma unroll
            for (int r = 0; r < 16; ++r) { const int n0 = 64 * tt + crow(r, hi), n1 = n0 + 32; if (n0 >= 255 || 16 * n0 + 31 > tq) p0[r] = -INFINITY; if (n1 >= 255 || 16 * n1 + 31 > tq) p1[r] = -INFINITY; }
            float mt = p0[0];
#pragma unroll
            for (int r = 1; r < 16; ++r) mt = fmaxf(mt, p0[r]);
#pragma unroll
            for (int r = 0; r < 16; ++r) mt = fmaxf(mt, p1[r]);
            mt = x32_max(mt);
            const float mn = fmaxf(m, mt), ms = (mn == -INFINITY) ? 0.f : mn; float s = 0.f;
#pragma unroll
            for (int r = 0; r < 16; ++r) s += ex2(p0[r] - ms) + ex2(p1[r] - ms);
            l = l * ex2(m - ms) + s; m = mn; }
        l = x32_sum(l);
        const float inv = (l > 0.f) ? 1.0f / l : 0.f, ms = (m == -INFINITY) ? 0.f : m;
        LAS float* impm = (LAS float*)(lds + NL_IMPM); LAS float* imps = (LAS float*)(lds + NL_IMPS);
        f32x16 oc[2]; oc[0] = z16(); oc[1] = z16();
        for (int tt = 0; tt < ntc; ++tt) { f32x16 p0, p1; attn_qkt(p0, p1, lds + NL_KC + tt * 8192, qf, r32, hi);
#pragma unroll
            for (int r = 0; r < 16; ++r) { const int n0 = 64 * tt + crow(r, hi), n1 = n0 + 32;
                p0[r] = (n0 >= 255 || 16 * n0 + 31 > tq) ? 0.f : ex2(p0[r] - ms) * inv; p1[r] = (n1 >= 255 || 16 * n1 + 31 > tq) ? 0.f : ex2(p1[r] - ms) * inv; }
#pragma unroll
            for (int g = 0; g < 4; ++g) {
                float ma = p0[4 * g] + p0[4 * g + 1] + p0[4 * g + 2] + 0.5f * p0[4 * g + 3], sa = 0.5f * p0[4 * g + 3];
                float mb = p1[4 * g] + p1[4 * g + 1] + p1[4 * g + 2] + 0.5f * p1[4 * g + 3], sb = 0.5f * p1[4 * g + 3];
                ma += swz_xor<1>(ma); ma += swz_xor<2>(ma); sa += swz_xor<1>(sa); sa += swz_xor<2>(sa);
                mb += swz_xor<1>(mb); mb += swz_xor<2>(mb); sb += swz_xor<1>(sb); sb += swz_xor<2>(sb);
                if (hd == 0) { const int ja = 16 * tt + 2 * g + hi, jb = ja + 8;
                    impm[tokl * 64 + ja] = ma; imps[tokl * 65 + ja + 1] = sa; impm[tokl * 64 + jb] = mb; imps[tokl * 65 + jb + 1] = sb; } }
            bf16x8 pw[4]; pw[0] = pack_acc8(p0, 0); pw[1] = pack_acc8(p0, 1); pw[2] = pack_acc8(p1, 0); pw[3] = pack_acc8(p1, 1);
            attn_pv(oc, lds + NL_VC + tt * 8192, pw, lane, hi); }
        of[0] = oc[0] * g0; of[1] = oc[1] * g0;
        LAS unsigned long long* selm = (LAS unsigned long long*)(lds + NL_SELM);
        if (ib < 16) { if (lane < 8) selm[8 * wid + lane] = (2ull << ib) - 1ull; }
        else for (int t8 = 0; t8 < 8; ++t8) { const int tk = 8 * wid + t8; const int j = lane;
            float imp = (j < 16 * ntc) ? impm[tk * 64 + j] + ((j > 0) ? imps[tk * 65 + j] : 0.f) : 0.f;
            const bool forced = (j == 0) || (j == ib) || (j == ib - 1);
            const float score = forced ? 1.0e4f : ((j <= ib) ? imp : -1.0f);
            int rank = 0;
#pragma unroll
            for (int jj = 0; jj < 64; ++jj) { const float sj = __uint_as_float(__builtin_amdgcn_readlane(__float_as_uint(score), jj)); rank += ((sj > score) || (sj == score && jj < j)) ? 1 : 0; }
            const unsigned long long mk = __ballot((rank < 16) && (j <= ib));
            if (lane == 0) selm[tk] = mk; }
    }
    __syncthreads();
    unsigned long long mymask, umask, wmask;
    { const LAS unsigned long long* selm = (const LAS unsigned long long*)(lds + NL_SELM); mymask = selm[tokl];
      unsigned long long u = selm[lane]; unsigned lo = (unsigned)u, hi32 = (unsigned)(u >> 32);
      lo |= swz_xor_u<1>(lo); lo |= swz_xor_u<2>(lo); lo |= swz_xor_u<4>(lo); lo |= swz_xor_u<8>(lo); lo |= swz_xor_u<16>(lo); lo = x32_or(lo);
      hi32 |= swz_xor_u<1>(hi32); hi32 |= swz_xor_u<2>(hi32); hi32 |= swz_xor_u<4>(hi32); hi32 |= swz_xor_u<8>(hi32); hi32 |= swz_xor_u<16>(hi32); hi32 = x32_or(hi32);
      umask = ((unsigned long long)hi32 << 32) | lo; umask = __builtin_amdgcn_readfirstlane((unsigned)umask) | ((unsigned long long)__builtin_amdgcn_readfirstlane((unsigned)(umask >> 32)) << 32);
      unsigned wl = 0u, wh = 0u;
#pragma unroll
      for (int t8 = 0; t8 < 8; ++t8) { const unsigned long long mk = selm[8 * wid + t8]; wl |= (unsigned)mk; wh |= (unsigned)(mk >> 32); }
      wmask = (unsigned long long)(unsigned)__builtin_amdgcn_readfirstlane((int)wl) | ((unsigned long long)(unsigned)__builtin_amdgcn_readfirstlane((int)wh) << 32); }
    for (int br = 0; br < 2; ++br) {
        f32x16 o[2]; o[0] = z16(); o[1] = z16(); float m = -INFINITY, l = 0.f;
        SelF f; f.umask = br ? ~0ull : umask; f.wmask = br ? ~0ull : wmask; f.mymask = br ? ~0ull : mymask; f.tq = tq; f.klo = br ? tq - 512 : -1; f.hi = hi; f.tdiag = ib; f.tlo = br ? (ib * 64 + 63 - 512) / 64 : -1;
        const bf16_t* nkv2 = (const bf16_t*)(ws_late() + WS_R + R_NKV);
        flash_loop(f, br ? max(0, ib - 8) : 0, ib + 1, nkv2 + (size_t)(2 + 2 * br) * (NKV_SEG / 2) + (size_t)bl * SEQ * 64, nkv2 + (size_t)(3 + 2 * br) * (NKV_SEG / 2) + (size_t)bl * SEQ * 64, 64, nullptr, qf, o, m, l, lds, tid);
        l = x32_sum(l); const float sc = (l > 0.f) ? (br ? g2 : g1) / l : 0.f; of[0] += o[0] * sc; of[1] += o[1] * sc;
    }
    store_ot(of, (bf16_t*)(ws_late() + WS_R + R_O) + (size_t)2 * MC * 256 + rowc * 256 + hd * 64, hi);
}

constexpr int LDS_MISC = LDS_BYTES - 256;
constexpr size_t LWS = ((LW_BYTES + MiB - 1) / MiB) * MiB;
#define PHASE_PRE const int tid = fresh_tid(); int l, ch; { int k_; bool b_; step_decode(__builtin_amdgcn_readfirstlane(((volatile LAS int*)lds_at(LDS_MISC + 176))[0]), k_, l, ch, b_); } \
    Params p; ptab_load(p); LAS unsigned char* lds = lds_at(0); const int G = NWG; \
    const int c = __builtin_amdgcn_readfirstlane(((volatile LAS int*)(lds + LDS_MISC + 176))[2]); (void)lds; (void)G; (void)c; (void)l; (void)ch; \
    volatile LAS int* qslot = (volatile LAS int*)(lds + LDS_MISC + 16); (void)qslot;
#define LW_ (p.ws + WS_W + (size_t)l * LWS)
#define LWO_ ((unsigned)(WS_W + (size_t)l * LWS))
#define HC_ ((unsigned)(WS_H + (size_t)ch * MC * 1024 * 2))
#define QCTR_ ((unsigned*)(p.ws + WS_CTL) + CW_Q + 64 * ((l * NCHUNK + ch) * 8) + 8192 * __builtin_amdgcn_readfirstlane(((volatile LAS int*)lds_at(LDS_MISC + 176))[3]))
__device__ __forceinline__ int tid_out(int t) { asm volatile("" : "+v"(t)); return t; }
__device__ __forceinline__ int fresh_tid() {
    LAS unsigned* ctr = (LAS unsigned*)lds_at(LDS_MISC + 192);
    unsigned z = 0u; asm volatile("" : "+v"(z));
    const int lane = (int)__builtin_amdgcn_mbcnt_hi(~0u, __builtin_amdgcn_mbcnt_lo(~0u, z));
    unsigned t = 0u; if (lane == 0) t = __hip_atomic_fetch_add(ctr, 1u, __ATOMIC_RELAXED, __HIP_MEMORY_SCOPE_WORKGROUP);
    t = (unsigned)__builtin_amdgcn_readfirstlane((int)t);
    __syncthreads();
    return (int)(((t & 7u) << 6) | (unsigned)lane);
}
__device__ __forceinline__ void step_decode(int s, int& k, int& l, int& ch, bool& bar);
#define GCTR_(j) ((unsigned*)(p.ws + WS_CTL) + CW_G + 64 * ((l * NCHUNK + ch) * 8 + (j)) + 16384 * __builtin_amdgcn_readfirstlane(((volatile LAS int*)lds_at(LDS_MISC + 176))[3]))
#define PHFN(name) static __device__ __noinline__ void name()
#define PHFI(name) static __device__ __forceinline__ void name()

PHFI(ph_p0) { PHASE_PRE
    constexpr int N_ADA = 192, N_CB = 4, N_ROPE = MTOK * 32 / 4096, N_T = 2 * TJ_TOTAL;
    for (int it = c; it < N_ADA + N_CB + N_ROPE; it += G) {
        if (it < N_ADA) p0_ada(p, it, (LAS float*)lds, tid);
        else if (it < N_ADA + N_CB) p0_cbias(p, it - N_ADA, tid);
        else p0_rope(p, it - N_ADA - N_CB, tid);
    }
    for (int it = c; it < N_T; it += 4 * G) p0_transpose4(p, it, G, N_T, (LAS float*)lds, tid);
}
PHFN(ph_p1) { PHASE_PRE prep_first(p, tid, c); }
PHFI(ph_a1) { PHASE_PRE
    DenseSched S; S.A = HC_; S.Bt = LWO_ + (unsigned)LW_WIN; S.tA = 256u * 1024 * 2; S.tB = 256u * 1024 * 2; S.aBr = 0; S.nM = MC / 256; S.nN = NPROJ / 256; S.G = G; S.c = c; S.pnShift = 0; S.ctr = GCTR_(0);
    EpiProj E;
    pg8::gemm_phase<EpiProj, DenseSched, true, false>(lds, 1024, 1024, 1024, S, E, tid, (const char*)p.ws);
}
PHFN(ph_a2a) { PHASE_PRE
    if (c < 2 * BC) {
        const int which = c & 1, bl = c >> 1;
        OneSched S; S.has = true; S.u0.pm = bl; S.u0.pn = 0; S.u0.aux = which; S.u0.nvalid = 256; S.u0.rows = 0u;
        S.u0.a = (unsigned)(WS_R + R_NKV + (size_t)which * NKV_SEG + (size_t)bl * SEQ * 64 * 2); S.u0.b = LWO_ + (unsigned)(LW_CW1 + (size_t)which * 256 * 2048 * 2);
        EpiH1 E; E.h1 = (bf16_t*)(p.ws + WS_R + R_H1); E.cbias = (const float*)(p.ws + WS_CBIAS) + l * 512;
        pg8::gemm_phase<EpiH1, OneSched, true, false>(lds, 2048, 1024, 2048, S, E, tid, (const char*)p.ws);
        VM_WAIT(); __syncthreads(); __builtin_amdgcn_fence(__ATOMIC_ACQUIRE, "agent"); VM_WAIT(); __syncthreads();
    }
}
PHFN(ph_a2b) { PHASE_PRE
    if (c < 2 * BC) {
        const int which = c & 1, bl = c >> 1;
        OneSched S2; S2.has = true; S2.u0.pm = bl; S2.u0.pn = 0; S2.u0.aux = which; S2.u0.nvalid = 256; S2.u0.rows = 0u;
        S2.u0.a = (unsigned)(WS_R + R_H1 + ((size_t)which * BC * 256 + (size_t)bl * 256) * 256 * 2); S2.u0.b = LWO_ + (unsigned)(LW_CW2 + (size_t)which * 256 * 256 * 2);
        EpiCmp2 E2; E2.kc = (bf16_t*)(p.ws + WS_R + R_KCMP);
        pg8::gemm_phase<EpiCmp2, OneSched, true, false>(lds, 256, 256, 256, S2, E2, tid, (const char*)p.ws);
    }
}
PHFI(ph_a2c) { PHASE_PRE
    unsigned* qc = QCTR_ + 0; const int NU = BC * 4 * 64;
    int u = q_next(qc, qslot, tid), un = q_next(qc, qslot, tid);
    GdnRaw ga; if (u < NU) gdn_prep_load(ga, u, tid);
    while (u < NU) {
        int tk = 0x3fffffff; if (tid == 0) tk = (int)__hip_atomic_fetch_add(qc, 1u, __ATOMIC_RELAXED, __HIP_MEMORY_SCOPE_AGENT);
        GdnRaw gn = ga; if (un < NU) gdn_prep_load(gn, un, tid);
        gdn_prep_unit(p, l, u, lds, tid, ga);
        if (tid == 0) *qslot = tk;
        __syncthreads();
        const int unn = *qslot;
        __syncthreads();
        u = un; un = unn; ga = gn;
    }
}
PHFN(ph_a2d) { PHASE_PRE
    for (;;) { const int u = q_next(QCTR_ + 64, qslot, tid); if (u >= BC * 4) break; fox_cum_item(p, l, u, (LAS float*)lds, tid); }
    for (;;) { const int u = q_next(QCTR_ + 320, qslot, tid); if (u >= BC * 4 * 32) break; ret_kv_unit(p, ch, u, lds, tid); }
}
PHFN(ph_a3a) { PHASE_PRE if (c < BC * 4) gdn_scan_item(p, l, ch, c, lds, tid); }
PHFI(ph_a3b) { PHASE_PRE for (;;) { const int u = q_next(QCTR_ + 128, qslot, tid); if (u >= BC * 4 * 16) break; fox_unit(p, u, lds, tid); } }
PHFI(ph_a3c) { PHASE_PRE for (;;) { const int u = q_next(QCTR_ + 192, qslot, tid); if (u >= BC * 4 * 16) break; ret_out_unit(p, l, ch, u, lds, tid); } }
PHFI(ph_a3d) { PHASE_PRE for (;;) { const int u = q_next(QCTR_ + 256, qslot, tid); if (u >= BC * 64) break; nsa_unit(p, u, lds, tid); } }
PHFN(ph_a5) { PHASE_PRE
    DenseSched S; S.A = (unsigned)(WS_R + R_O); S.Bt = LWO_ + (unsigned)LW_BPT; S.tA = 256u * 256 * 2; S.tB = 256u * 256 * 2; S.aBr = (unsigned)((size_t)MC * 256 * 2); S.nM = MC / 256; S.nN = 16; S.G = G; S.c = c; S.pnShift = 2; S.ctr = GCTR_(1);
    EpiP E;
    pg8::gemm_phase<EpiP, DenseSched, true, false>(lds, 256, 256, 256, S, E, tid, (const char*)p.ws);
}
PHFI(ph_a6) { PHASE_PRE
    DenseSched S; S.A = (unsigned)(WS_H8 + (size_t)ch * MC * 1024); S.Bt = LWO_ + (unsigned)LW_WGV; S.tA = 256u * 1024; S.tB = 256u * 1024; S.aBr = 0; S.nM = MC / 256; S.nN = 16; S.G = G; S.c = c; S.pnShift = 0; S.ctr = GCTR_(2);
    EpiGate E;
    pg8::gemm_phase<EpiGate, DenseSched, true, false, true>(lds, 1024, 1024, 1024, S, E, tid, (const char*)p.ws);
}
PHFN(ph_a7) { PHASE_PRE
    DenseSched S; S.A = (unsigned)(WS_R + R_Y); S.Bt = LWO_ + (unsigned)LW_WOT; S.tA = 256u * 1024 * 2; S.tB = 256u * 1024 * 2; S.aBr = 0; S.nM = MC / 256; S.nN = 4; S.G = G; S.c = c; S.pnShift = 0; S.ctr = GCTR_(3);
    EpiOut E; E.row_base = ch * MC;
    pg8::gemm_phase<EpiOut, DenseSched, true, false>(lds, 1024, 1024, 1024, S, E, tid, (const char*)p.ws);
}
PHFN(ph_b0) { PHASE_PRE prep_moe(p, l, (LAS float*)lds, tid, c); }
__device__ __forceinline__ void moe_tables(const Params& p, int l, LAS int* mcnt, LAS int* mpre, const int tid) {
    __syncthreads();
    if (tid < 16) mcnt[tid] = (int)((unsigned*)(p.ws + WS_CTL))[CW_CNT + l * 64 + tid];
    __syncthreads();
    if (tid == 0) { int s = 0; for (int e = 0; e < 16; ++e) { mpre[e] = s; s += (mcnt[e] + 255) >> 8; } mpre[16] = s; }
    __syncthreads();
}
PHFI(ph_b1) { PHASE_PRE
    LAS int* mcnt = (LAS int*)(lds + LDS_MISC + 32); LAS int* mpre = mcnt + 16; moe_tables(p, l, mcnt, mpre, tid);
    MoeSched S; S.pre = mpre; S.cnt = mcnt; S.wsb = (const char*)p.ws; S.A = (unsigned)WS_H; S.W = LWO_ + (unsigned)LW_W13;
    S.wE = 1024u * 1024 * 2; S.wT = 256u * 1024 * 2; S.aT = 0; S.G = G; S.c = c; S.gatherA = true; S.ctr = GCTR_(4);
    EpiMoe1 E;
    pg8::gemm_phase<EpiMoe1, MoeSched, true, true>(lds, 1024, 1024, 1024, S, E, tid, (const char*)p.ws);
}
PHFN(ph_b2) { PHASE_PRE
    LAS int* mcnt = (LAS int*)(lds + LDS_MISC + 32); LAS int* mpre = mcnt + 16; moe_tables(p, l, mcnt, mpre, tid);
    MoeSched S; S.pre = mpre; S.cnt = mcnt; S.wsb = (const char*)p.ws; S.A = (unsigned)(WS_R + R_HID); S.W = LWO_ + (unsigned)LW_W2;
    S.wE = 1024u * 512 * 2; S.wT = 256u * 512 * 2; S.aT = 256u * 512 * 2; S.G = G; S.c = c; S.gatherA = false; S.ctr = GCTR_(5);
    EpiMoe2 E;
    pg8::gemm_phase<EpiMoe2, MoeSched, true, false>(lds, 512, 512, 512, S, E, tid, (const char*)p.ws);
}
PHFN(ph_b3) { PHASE_PRE prep_next(p, l, l == DEPTH - 1, tid, c); }

constexpr int STEPS_CHUNK = 12, STEPS_LAYER = NCHUNK * STEPS_CHUNK + 4, N_STEPS = 2 + DEPTH * STEPS_LAYER;
__device__ __forceinline__ void step_decode(int s, int& k, int& l, int& ch, bool& bar) {
    if (s < 2) { k = s; l = 0; ch = 0; bar = true; return; }
    const int t = s - 2; l = t / STEPS_LAYER; const int r = t % STEPS_LAYER;
    if (r < NCHUNK * STEPS_CHUNK) { ch = r / STEPS_CHUNK; const int q = r % STEPS_CHUNK; k = 2 + q; bar = !(q == 1 || q == 2 || q == 3 || q == 5 || q == 6 || q == 7); }
    else { ch = 0; k = 14 + (r - NCHUNK * STEPS_CHUNK); bar = true; }
}
__global__ void __launch_bounds__(NTHR, 2) __attribute__((disable_tail_calls)) mega_fwd(Params p0_) {
    LAS unsigned char* lds = lds_at(0);
    const int tid = threadIdx.x;
    volatile LAS unsigned* xbw = (volatile LAS unsigned*)(lds + LDS_MISC);
    volatile LAS int* st = (volatile LAS int*)(lds + LDS_MISC + 176);
    if (tid == 0) { xbw[0] = 0u; xbw[1] = 0u; xbw[2] = 0u; xbw[3] = 0u; st[0] = p0_.ph_lo; st[1] = p0_.ph_hi; st[2] = blockIdx.x; st[3] = 0; *(volatile LAS unsigned*)(lds + LDS_MISC + 200) = 0u; *(volatile LAS unsigned*)(lds + LDS_MISC + 192) = 0u; }
    ptab_store(p0_, tid);
    __syncthreads();
    (void)xcd_barrier_post((unsigned*)(p0_.ws + WS_CTL) + CW_BAR, xbw, tid);
#ifdef PROBE_CLOCK
    if (tid == 0) { volatile LAS unsigned long long* tc_ = (volatile LAS unsigned long long*)(lds + LDS_MISC + 216); tc_[0] = __builtin_amdgcn_s_memrealtime(); tc_[1] = __builtin_amdgcn_s_memtime(); }
#endif
    for (;;) {
        {
          LAS unsigned char* mb_ = lds_at(LDS_MISC); volatile LAS int* st_ = (volatile LAS int*)(mb_ + 176);
          const int s = __builtin_amdgcn_readfirstlane(st_[0]), e = __builtin_amdgcn_readfirstlane(st_[1]);
          if (s >= e) break;
          int k, l, ch; bool bar; step_decode(s, k, l, ch, bar);
#ifdef PROBE_STEPTIME
          if (threadIdx.x == 0) { volatile LAS unsigned long long* tp_ = (volatile LAS unsigned long long*)(mb_ + 208); tp_[0] = __builtin_amdgcn_s_memrealtime(); }
#endif
          (void)k; }
#define CUR_K_() ([&]() { int k_, l_, c_; bool b_; step_decode(__builtin_amdgcn_readfirstlane(((volatile LAS int*)(lds_at(LDS_MISC) + 176))[0]), k_, l_, c_, b_); return k_; }())
        if (CUR_K_() == 0) ph_p0();
        if (CUR_K_() == 1) ph_p1();
        if (CUR_K_() == 2) ph_a1();
        if (CUR_K_() == 3) ph_a2a();
        if (CUR_K_() == 4) ph_a2b();
        if (CUR_K_() == 5) ph_a2c();
        if (CUR_K_() == 6) ph_a2d();
        if (CUR_K_() == 7) ph_a3a();
        if (CUR_K_() == 8) ph_a3b();
        if (CUR_K_() == 9) ph_a3c();
        if (CUR_K_() == 10) ph_a3d();
        if (CUR_K_() == 11) ph_a5();
        if (CUR_K_() == 12) ph_a6();
        if (CUR_K_() == 13) ph_a7();
        if (CUR_K_() == 14) ph_b0();
        if (CUR_K_() == 15) ph_b1();
        if (CUR_K_() == 16) ph_b2();
        if (CUR_K_() == 17) ph_b3();
#ifdef PROBE_STEPTIME
        { LAS unsigned char* mb2_ = lds_at(LDS_MISC); const int s2_ = __builtin_amdgcn_readfirstlane(((volatile LAS int*)(mb2_ + 176))[0]); int k2_, l2_, c2_; bool b2_; step_decode(s2_, k2_, l2_, c2_, b2_);
          __syncthreads();
          if (threadIdx.x == 0 && ((PROBE_STEPTIME >> k2_) & 1)) { volatile LAS unsigned long long* tp_ = (volatile LAS unsigned long long*)(mb2_ + 208); volatile LAS unsigned* ac_ = (volatile LAS unsigned*)(mb2_ + 200);
              ac_[0] = ac_[0] + (unsigned)(__builtin_amdgcn_s_memrealtime() - tp_[0]); } }
#endif
        { const int tid = fresh_tid(); LAS unsigned char* mb_ = lds_at(LDS_MISC); volatile LAS int* st_ = (volatile LAS int*)(mb_ + 176);
          volatile LAS unsigned* xbw_ = (volatile LAS unsigned*)mb_;
          const int s = __builtin_amdgcn_readfirstlane(st_[0]), e = __builtin_amdgcn_readfirstlane(st_[1]);
          int k, l, ch; bool bar; step_decode(s, k, l, ch, bar);
#ifdef DUP_MASK
          const bool adv_ = !(((DUP_MASK >> k) & 1) && __builtin_amdgcn_readfirstlane(st_[3]) == 0);
#else
          const bool adv_ = true;
#endif
          if (adv_ && bar && s + 1 < e) { XcdBarrier b; b.bar = (unsigned*)((unsigned char*)ptab_get(28) + WS_CTL) + CW_BAR; b.x = xb_xcc_id(); b.st = xbw_;
#ifdef PROBE_BARWAIT
              __syncthreads(); const unsigned long long t0_ = __builtin_amdgcn_s_memrealtime();
              xcd_barrier(b, tid);
              const unsigned long long t1_ = __builtin_amdgcn_s_memrealtime(); if (tid == 0) { volatile LAS unsigned* ac_ = (volatile LAS unsigned*)(mb_ + 200); ac_[0] = ac_[0] + (unsigned)(t1_ - t0_); }
#else
              xcd_barrier(b, tid);
#endif
          }
          __syncthreads();
#ifdef DUP_MASK
          const int rp = __builtin_amdgcn_readfirstlane(st_[3]);
          if (((DUP_MASK >> k) & 1) && rp == 0) { if (tid == 0) st_[3] = 1; }
          else { if (tid == 0) { st_[3] = 0; st_[0] = s + 1; } }
#else
          if (tid == 0) st_[0] = s + 1;
#endif
          __syncthreads(); }
    }
#ifdef PROBE_CLOCK
    { volatile LAS unsigned long long* tc_ = (volatile LAS unsigned long long*)(lds_at(LDS_MISC) + 216); const unsigned long long r1 = __builtin_amdgcn_s_memrealtime(), c1 = __builtin_amdgcn_s_memtime();
      const unsigned long long dr = r1 - tc_[0], dc = c1 - tc_[1];
      const unsigned long long w = dc / 24ull; const unsigned long long t0_ = __builtin_amdgcn_s_memrealtime();
      while (__builtin_amdgcn_s_memrealtime() - t0_ < w) __builtin_amdgcn_s_sleep(8); (void)dr; }
#endif
#if defined(PROBE_BARWAIT) || defined(PROBE_STEPTIME)
    { const unsigned w_ = *(volatile LAS unsigned*)(lds_at(LDS_MISC) + 200); const unsigned long long t0_ = __builtin_amdgcn_s_memrealtime();
      while (__builtin_amdgcn_s_memrealtime() - t0_ < (unsigned long long)w_) __builtin_amdgcn_s_sleep(8); }
#endif
}

extern "C" void kernel_launch(void* const* d_in, const int* in_sizes, int n_in, void* d_out, int out_size, void* d_ws, size_t ws_size, hipStream_t stream) {
    (void)in_sizes; (void)out_size;
    if (n_in < 27 || ws_size < WS_END) { fprintf(stderr, "kernel_launch: unexpected inputs (n_in %d, ws %zu < %zu)\n", n_in, ws_size, (size_t)WS_END); return; }
    static bool attr_set = false;
    if (!attr_set) { (void)hipFuncSetAttribute((const void*)mega_fwd, hipFuncAttributeMaxDynamicSharedMemorySize, LDS_BYTES); attr_set = true; }
    Params p{};
    for (int i = 0; i < 27; ++i) p.in[i] = (const float*)d_in[i];
    p.out = (float*)d_out; p.ws = (unsigned char*)d_ws;
    (void)hipMemsetAsync((unsigned char*)d_ws + WS_CTL, 0, CTL_BYTES, stream);
#ifndef MK_CUTS
    p.ph_lo = 0; p.ph_hi = N_STEPS;
    hipLaunchKernelGGL(mega_fwd, dim3(NWG), dim3(NTHR), LDS_BYTES, stream, p);
#else
    { static const int cuts[] = {MK_CUTS, N_STEPS}; int lo = 0;
      for (unsigned i = 0; i < sizeof(cuts) / sizeof(cuts[0]); ++i) { p.ph_lo = lo; p.ph_hi = cuts[i]; lo = cuts[i]; hipLaunchKernelGGL(mega_fwd, dim3(NWG), dim3(NTHR), LDS_BYTES, stream, p); } }
#endif
}
```

```cpp
#include <hip/hip_runtime.h>
#include <stdint.h>
#include <stdio.h>

#define GAS __attribute__((address_space(1)))
#define LAS __attribute__((address_space(3)))
typedef unsigned short bf16_t;
typedef short bf16x8 __attribute__((ext_vector_type(8)));
typedef short s16x4 __attribute__((ext_vector_type(4)));
typedef float f32x2 __attribute__((ext_vector_type(2)));
typedef float f32x4 __attribute__((ext_vector_type(4)));
typedef float f32x16 __attribute__((ext_vector_type(16)));
typedef unsigned u32x2 __attribute__((ext_vector_type(2)));
typedef unsigned u32x4 __attribute__((ext_vector_type(4)));
typedef __bf16 bf16x2_t __attribute__((ext_vector_type(2)));

constexpr int D_MODEL = 1024, BATCH = 16, SEQ = 4096, DEPTH = 2, MTOK = BATCH * SEQ;
constexpr int NCHUNK = 2, BC = BATCH / NCHUNK, MC = BC * SEQ;
constexpr int NPROJ = 3584, PROJW = 3072;
constexpr float DN_ALPHA = 1.4142135623730951f;
constexpr float LN_EPS = 1e-5f;
constexpr float LOG2E = 1.4426950408889634f;
constexpr float QSCALE = 0.125f * 1.4426950408889634f;
constexpr int NWG = 256, NTHR = 512;
constexpr int LDS_BYTES = 163840;

constexpr int PC_GQ = 0, PC_GK = 256, PC_GV = 512, PC_GZ = 768, PC_RQ = 1024, PC_RK = 1280, PC_RV = 1536, PC_RG = 1792, PC_NQ = 2048, PC_FQ = 2304, PC_FK = 2560, PC_FV = 2816;

constexpr size_t MiB = 1ull << 20;
constexpr size_t WS_CTL = 0;
constexpr size_t CTL_BYTES = 1 * MiB;
constexpr size_t WS_MOD = 1 * MiB;
constexpr size_t WS_ROPE = 2 * MiB;
constexpr size_t WS_STATS = 18 * MiB;
constexpr size_t WS_CBIAS = 19 * MiB;
constexpr size_t WS_W = 20 * MiB;
constexpr size_t LW_WIN = 0;
constexpr size_t LW_WGV = LW_WIN + (size_t)NPROJ * 1024 * 2;
constexpr size_t LW_BPT = LW_WGV + (size_t)4096 * 1024 * 2;
constexpr size_t LW_WOT = LW_BPT + (size_t)4096 * 256 * 2;
constexpr size_t LW_W13 = LW_WOT + (size_t)1024 * 1024 * 2;
constexpr size_t LW_W2 = LW_W13 + (size_t)16 * 1024 * 1024 * 2;
constexpr size_t LW_CW1 = LW_W2 + (size_t)16 * 1024 * 512 * 2;
constexpr size_t LW_CW2 = LW_CW1 + (size_t)2 * 256 * 2048 * 2;
constexpr size_t LW_BYTES = LW_CW2 + (size_t)2 * 256 * 256 * 2;
constexpr size_t WS_H = WS_W + 2 * ((LW_BYTES + MiB - 1) / MiB) * MiB;
constexpr size_t WS_R = WS_H + 128 * MiB;
constexpr size_t R_PROJ = 0;
constexpr size_t R_GDN = R_PROJ + (size_t)MC * PROJW * 2;
constexpr size_t GDN_UNIT_BYTES = 5 * 8192;
constexpr size_t R_P = 0;
constexpr size_t R_NKV = R_GDN + (size_t)BC * 4 * 64 * GDN_UNIT_BYTES;
constexpr size_t NKV_SEG = (size_t)(MC + 64) * 64 * 2;
constexpr size_t R_SM = R_NKV + 6 * NKV_SEG;
constexpr size_t R_CUM = R_SM + (size_t)MC * 32 * 4;
constexpr size_t R_GG = R_CUM + (size_t)BC * 4 * 4096 * 4;
constexpr size_t R_KCMP = R_GG + (size_t)BC * 4 * 64 * 4 + 768;
constexpr size_t R_H1 = R_KCMP + (size_t)2 * BC * 256 * 64 * 2;
constexpr size_t R_O = R_H1 + (size_t)2 * BC * 256 * 256 * 2;
constexpr size_t R_Y = R_O + (size_t)4 * MC * 256 * 2;
constexpr size_t R_KVT = R_Y + (size_t)MC * 1024 * 2;
constexpr size_t R_MIX_END = R_KVT + (size_t)BC * 4 * 32 * 4096 * 4;
static_assert(R_NKV >= (size_t)MC * 4096 * 2, "P overlay fits under PROJ+GDN");
constexpr size_t R_LIST = 0;
constexpr size_t R_CW = R_LIST + (size_t)16 * MTOK * 4;
constexpr size_t R_HID = R_CW + (size_t)16 * MTOK * 4;
constexpr size_t R_OUT2 = R_HID + (size_t)(2 * MTOK + 4096) * 512 * 2;
constexpr size_t R_MOE_END = R_OUT2 + (size_t)2 * MTOK * 1024 * 2;
constexpr size_t WS_T = WS_R + (((R_MIX_END > R_MOE_END ? R_MIX_END : R_MOE_END) + MiB - 1) / MiB) * MiB;
constexpr size_t WS_H8 = WS_T + (size_t)MTOK * 1024 * 2;
constexpr size_t WS_END = WS_H8 + (size_t)MTOK * 1024;
constexpr float H8_SCALE = 16.0f, W8_SCALE = 256.0f, F8_DESCALE = 1.0f / (16.0f * 256.0f);

constexpr int CW_BAR = 4096;
constexpr int CW_CNT = 8192;
constexpr int CW_Q = 8448;
constexpr int CW_G = 65536;

__device__ __forceinline__ float bf2f(bf16_t v) { return __uint_as_float(((unsigned)v) << 16); }
__device__ __forceinline__ unsigned pk2(float lo, float hi) { f32x2 v = {lo, hi}; bf16x2_t b = __builtin_convertvector(v, bf16x2_t); return __builtin_bit_cast(unsigned, b); }
__device__ __forceinline__ float clamp8(float x) { return fminf(fmaxf(x, -448.0f), 448.0f); }
__device__ __forceinline__ unsigned pk4_fp8(float a, float b, float c, float d) { int v = __builtin_amdgcn_cvt_pk_fp8_f32(clamp8(a), clamp8(b), 0, false); v = __builtin_amdgcn_cvt_pk_fp8_f32(clamp8(c), clamp8(d), v, true); return (unsigned)v; }
__device__ __forceinline__ bf16_t f2bf(float f) { return (bf16_t)(pk2(f, 0.f) & 0xffffu); }
__device__ __forceinline__ float ex2(float x) { return __builtin_amdgcn_exp2f(x); }
__device__ __forceinline__ float sigmoidf_(float x) { return __builtin_amdgcn_rcpf(1.0f + __expf(-x)); }
__device__ __forceinline__ float siluf_(float x) { return x * __builtin_amdgcn_rcpf(1.0f + __expf(-x)); }
__device__ __forceinline__ int crow(int r, int hi) { return (r & 3) + 8 * (r >> 2) + 4 * hi; }
template <int M> __device__ __forceinline__ float swz_xor(float v) { return __builtin_bit_cast(float, __builtin_amdgcn_ds_swizzle(__builtin_bit_cast(int, v), 0x1f | (M << 10))); }
template <int M> __device__ __forceinline__ unsigned swz_xor_u(unsigned v) { return (unsigned)__builtin_amdgcn_ds_swizzle((int)v, 0x1f | (M << 10)); }
__device__ __forceinline__ float x32_sum(float v) { auto r = __builtin_amdgcn_permlane32_swap(__float_as_uint(v), __float_as_uint(v), false, false); return __uint_as_float(r[0]) + __uint_as_float(r[1]); }
__device__ __forceinline__ float x32_max(float v) { auto r = __builtin_amdgcn_permlane32_swap(__float_as_uint(v), __float_as_uint(v), false, false); return fmaxf(__uint_as_float(r[0]), __uint_as_float(r[1])); }
__device__ __forceinline__ unsigned x32_or(unsigned v) { auto r = __builtin_amdgcn_permlane32_swap(v, v, false, false); return r[0] | r[1]; }
__device__ __forceinline__ float shfl_up_l(float v, int o, int lane) { return __builtin_bit_cast(float, __builtin_amdgcn_ds_bpermute((lane - o) << 2, __builtin_bit_cast(int, v))); }
__device__ __forceinline__ float wave_sum(float v) {
    v += swz_xor<1>(v); v += swz_xor<2>(v); v += swz_xor<4>(v); v += swz_xor<8>(v); v += swz_xor<16>(v);
    return x32_sum(v);
}
__device__ __forceinline__ float ninf_() { float z = -INFINITY; asm volatile("" : "+v"(z)); return z; }
__device__ __forceinline__ f32x4 z4() { float z = 0.f; asm volatile("" : "+v"(z)); return (f32x4){z, z, z, z}; }
__device__ __forceinline__ f32x16 z16() { float z = 0.f; asm volatile("" : "+v"(z)); f32x16 r;
#pragma unroll
    for (int i = 0; i < 16; ++i) r[i] = z;
    return r; }
#define VM_WAIT() asm volatile("s_waitcnt vmcnt(0)" ::: "memory")
#define MF32(a, b, c) __builtin_amdgcn_mfma_f32_32x32x16_bf16(a, b, c, 0, 0, 0)

#define XB_TMO      128
#define XB_XCNT(j)  (256  + 64 * (j))
#define XB_XSUB(j)  (1280 + 64 * (j))
#define XB_XGEN(j)  (2304 + 64 * (j))
#define XB_TOP      3328
#define XB_TOPGEN   3392
#define XCD_BAR_WORDS 3456
#define XB_SPIN_CAP (1u << 22)

__device__ __forceinline__ unsigned xb_ld(unsigned* p)              { return __hip_atomic_load(p, __ATOMIC_RELAXED, __HIP_MEMORY_SCOPE_AGENT); }
__device__ __forceinline__ unsigned xb_add(unsigned* p, unsigned v) { return __hip_atomic_fetch_add(p, v, __ATOMIC_RELAXED, __HIP_MEMORY_SCOPE_AGENT); }
__device__ __forceinline__ unsigned xb_xcc_id() { return (unsigned)__builtin_amdgcn_s_getreg((3 << 11) | 20) & 0xFu; }
#define XB_SPIN(cond, bar) do { unsigned _sp = 0; while (cond) { __builtin_amdgcn_s_sleep(1); \
    if ((++_sp & 255u) == 0u) { if (xb_ld(&(bar)[XB_TMO])) break; if (_sp > XB_SPIN_CAP) { atomicAdd(&(bar)[XB_TMO], 1u); break; } } } } while (0)

struct XcdBarrier { unsigned* bar; unsigned x; volatile LAS unsigned* st; };

__device__ __forceinline__ XcdBarrier xcd_barrier_post(unsigned* bar, volatile LAS unsigned* st, int tid) {
    XcdBarrier b; b.bar = bar; b.x = xb_xcc_id(); b.st = st;
    if (tid == 0) (void)xb_add(&bar[XB_XCNT(b.x)], 1u);
    return b;
}
__device__ __forceinline__ void xcd_barrier_complete(unsigned* bar, unsigned x, unsigned& nloc, unsigned& nx) {
    const unsigned G = NWG;
    unsigned sum, cnt, mine, sp = 0u;
    for (;;) {
        sum = 0u; cnt = 0u; mine = 0u;
#pragma unroll
        for (unsigned j = 0; j < 16; ++j) { const unsigned c = xb_ld(&bar[XB_XCNT(j)]); sum += c; cnt += (c > 0u) ? 1u : 0u; mine = (j == x) ? c : mine; }
        if (sum == G) break;
        __builtin_amdgcn_s_sleep(1);
        if ((++sp & 255u) == 0u) { if (xb_ld(&bar[XB_TMO])) break; if (sp > XB_SPIN_CAP) { atomicAdd(&bar[XB_TMO], 1u); break; } }
    }
    nloc = mine > 0u ? mine : 1u; nx = cnt > 0u ? cnt : 1u;
}
__device__ __forceinline__ void xcd_barrier(const XcdBarrier& b, int tid) {
    asm volatile("s_waitcnt vmcnt(0)" ::: "memory");
    __syncthreads();
    if (tid == 0) {
        unsigned* bar = b.bar;
        __builtin_amdgcn_s_waitcnt(0);
        unsigned nloc = b.st[0], nx = b.st[1];
        if (nloc == 0u) { xcd_barrier_complete(bar, b.x, nloc, nx); b.st[0] = nloc; b.st[1] = nx; }
        const unsigned old = xb_add(&bar[XB_XSUB(b.x)], 1u);
        const unsigned gen = old / nloc;
        if (old + 1u == (gen + 1u) * nloc) {
            __builtin_amdgcn_fence(__ATOMIC_RELEASE, "agent");
            asm volatile("s_waitcnt vmcnt(0)" ::: "memory");
            const unsigned og = xb_add(&bar[XB_TOP], 1u);
            const unsigned tg = og / nx;
            if (og + 1u == (tg + 1u) * nx) xb_add(&bar[XB_TOPGEN], 1u);
            else XB_SPIN(xb_ld(&bar[XB_TOPGEN]) == tg, bar);
            __builtin_amdgcn_fence(__ATOMIC_ACQUIRE, "agent");
            xb_add(&bar[XB_XGEN(b.x)], 1u);
            asm volatile("s_waitcnt vmcnt(0)" ::: "memory");
        } else {
            XB_SPIN(xb_ld(&bar[XB_XGEN(b.x)]) == gen, bar);
            __builtin_amdgcn_fence(__ATOMIC_ACQUIRE, "agent");
            asm volatile("s_waitcnt vmcnt(0)" ::: "memory");
        }
    }
    __syncthreads();
}

struct Params {
    const float* in[27];
    float* out;
    unsigned char* ws;
    int ph_lo, ph_hi;
};
__device__ __forceinline__ LAS unsigned char* lds_at(int off) { asm volatile("" : "+s"(off)); return (LAS unsigned char*)(unsigned)off; }
constexpr int LDS_PTAB = LDS_BYTES - 512;
__device__ __forceinline__ void ptab_store(const Params& p, int tid) {
    LAS unsigned long long* t = (LAS unsigned long long*)lds_at(LDS_PTAB);
    if (tid == 0) {
#pragma unroll
        for (int i = 0; i < 27; ++i) t[i] = (unsigned long long)p.in[i];
        t[27] = (unsigned long long)p.out; t[28] = (unsigned long long)p.ws; }
}
__device__ __forceinline__ unsigned long long ptab_get(int i) {
    const LAS unsigned* t = (const LAS unsigned*)lds_at(LDS_PTAB) + 2 * i;
    const unsigned lo = __builtin_amdgcn_readfirstlane(t[0]), hi = __builtin_amdgcn_readfirstlane(t[1]);
    return ((unsigned long long)hi << 32) | lo;
}
__device__ __forceinline__ unsigned char* ws_late() { return (unsigned char*)ptab_get(28); }
#define PIN(i) ((const float*)ptab_get(i))
__device__ __forceinline__ void ptab_load(Params& q) {
    asm volatile("" ::: "memory");
#pragma unroll
    for (int i = 0; i < 27; ++i) q.in[i] = (const float*)ptab_get(i);
    q.out = (float*)ptab_get(27); q.ws = (unsigned char*)ptab_get(28); q.ph_lo = 0; q.ph_hi = 0;
}

namespace pg8 {
constexpr int BM = 256, BK = 64, HALF = 128, HTB = HALF * BK * 2, NXCD = 8, WGM = 8;
__device__ __forceinline__ int lds_byte(int r, int c) { const int st = (r >> 4) * 2 + (c >> 5), rr = r & 15, cc = c & 31, ob = rr * 64 + cc * 2; return st * 1024 + (ob ^ (((ob >> 9) & 1) << 5)); }
__device__ __forceinline__ void stage_rc(int b, int& R, int& C) { const int st = b / 1024, sb = b % 1024, swz = sb ^ (((sb >> 9) & 1) << 5); R = (st >> 1) * 16 + swz / 64; C = (st & 1) * 32 + (swz % 64) / 2; }
__device__ __forceinline__ int perm32(int rho) { const int n = rho >> 4, i = rho & 15; return 8 * (i >> 2) + 4 * n + (i & 3); }

struct Unit { unsigned a, b, rows; int pm, pn, aux, nvalid; };

__device__ __forceinline__ bool dense_unit(int i, int G, int c, int nM, int nN, int& pm, int& pn) {
    const int nwg = nM * nN; const long L = (long)i * G + c; if (L >= nwg) return false;
    int wgid = (int)L; { const int q = nwg / NXCD, r = nwg % NXCD, xcd = wgid % NXCD, off = wgid / NXCD; wgid = (xcd < r ? xcd * (q + 1) : r * (q + 1) + (xcd - r) * q) + off; }
    const int nig = WGM * nN, gid = wgid / nig, fm = gid * WGM, gsz = (nM - fm) < WGM ? (nM - fm) : WGM;
    pm = fm + ((wgid % nig) % gsz); pn = (wgid % nig) / gsz; return true;
}

typedef int i32x4 __attribute__((ext_vector_type(4)));
typedef int i32x8 __attribute__((ext_vector_type(8)));
template <class Epi, class Sched, bool ALIGN_EPI, bool GATHER, bool F8 = false>
__device__ __forceinline__ void gemm_phase(LAS unsigned char* lds, const int K, const int lda, const int ldb, const Sched& S, const Epi& E, const int tid, const char* wsb) {
    const int wid = __builtin_amdgcn_readfirstlane(tid >> 6), lane = tid & 63, wr = wid >> 2, wc = wid & 3, fr = lane & 15, fq = lane >> 4;
    constexpr int ESZ = F8 ? 1 : 2;
    const int nt = K / (F8 ? 128 : BK);
    unsigned voffA[2], voffB[2]; int rA[2], cA2[2];
#pragma unroll
    for (int i = 0; i < 2; ++i) { int R, C; stage_rc(tid * 16 + i * 8192, R, C); const int Rb = Epi::PERM ? ((R & ~31) + perm32(R & 31)) : R;
        rA[i] = R; cA2[i] = C * 2; voffA[i] = (unsigned)(R * lda * ESZ + C * 2); voffB[i] = (unsigned)(Rb * ldb * ESZ + C * 2); }
    const unsigned kstep = (unsigned)(BK * 2);
    const unsigned hstepA = GATHER ? 0u : (unsigned)(HALF * lda * ESZ), hstepB = (unsigned)(HALF * ldb * ESZ);
    const unsigned ldsw = (unsigned)wid * 1024u, s64A = (unsigned)(64 * lda * ESZ), s64B = (unsigned)(64 * ldb * ESZ);
    const int aoff = lds_byte(wr * 64 + fr, fq * (F8 ? 16 : 8)), boff = lds_byte(wc * 32 + fr, fq * (F8 ? 16 : 8));
#define PG8_SA(b, h) (((b) * 2 + (h)) * HTB)
#define PG8_SB(b, h) ((4 + (b) * 2 + (h)) * HTB)
#define PG8_STAGE(bufoff, gbase, voff) do { _Pragma("unroll") for (int _i = 0; _i < 2; ++_i) \
        __builtin_amdgcn_global_load_lds((const unsigned*)(wsb + (size_t)(unsigned)((gbase) + (voff)[_i])), (LAS unsigned*)(lds + (bufoff) + ldsw + _i * 8192), 16, 0, 0); } while (0)
#define PG8_STAGE1(bufoff, gbase, voff0, step64) do { _Pragma("unroll") for (int _i = 0; _i < 2; ++_i) \
        __builtin_amdgcn_global_load_lds((const unsigned*)(wsb + (size_t)(unsigned)((gbase) + (unsigned)_i * (step64) + (voff0))), (LAS unsigned*)(lds + (bufoff) + ldsw + _i * 8192), 16, 0, 0); } while (0)
#define PG8_LDA(dst, b, h) do { _Pragma("unroll") for (int m = 0; m < 4; ++m) { if constexpr (F8) dst##8[m] = *(const LAS i32x8*)(lds + PG8_SA(b, h) + aoff + m * 2048); else { _Pragma("unroll") for (int k = 0; k < 2; ++k) dst[m][k] = *(const LAS bf16x8*)(lds + PG8_SA(b, h) + aoff + m * 2048 + k * 1024); } } } while (0)
#define PG8_LDB(dst, b, h) do { _Pragma("unroll") for (int n = 0; n < 2; ++n) { if constexpr (F8) dst##8[n] = *(const LAS i32x8*)(lds + PG8_SB(b, h) + boff + n * 2048); else { _Pragma("unroll") for (int k = 0; k < 2; ++k) dst[n][k] = *(const LAS bf16x8*)(lds + PG8_SB(b, h) + boff + n * 2048 + k * 1024); } } } while (0)
#define PG8_MMA(ai, bj, At, Bt) do { __builtin_amdgcn_s_setprio(1); _Pragma("unroll") for (int m = 0; m < 4; ++m) _Pragma("unroll") for (int n = 0; n < 2; ++n) { \
        if constexpr (F8) acc[ai][bj][m][n] = __builtin_amdgcn_mfma_scale_f32_16x16x128_f8f6f4(Bt##8[n], At##8[m], acc[ai][bj][m][n], 0, 0, 0, 0, 0, 0); \
        else { _Pragma("unroll") for (int k = 0; k < 2; ++k) acc[ai][bj][m][n] = __builtin_amdgcn_mfma_f32_16x16x32_bf16(Bt[n][k], At[m][k], acc[ai][bj][m][n], 0, 0, 0); } } \
        __builtin_amdgcn_s_setprio(0); } while (0)
#define PG8_WAIT_V(n) asm volatile("s_waitcnt vmcnt(" #n ")" ::: "memory")
#define PG8_WAIT_L(n) asm volatile("s_waitcnt lgkmcnt(" #n ")" ::: "memory")
#define PG8_BAR __builtin_amdgcn_s_barrier()
#define PG8_SCHED __builtin_amdgcn_sched_barrier(0)
    Unit cur, nxt; int ui = 0;
    S.begin(tid);
    if (!S.next(0, cur)) return;
    f32x4 acc[2][2][4][2];
#pragma unroll
    for (int a = 0; a < 2; ++a)
#pragma unroll
        for (int b = 0; b < 2; ++b)
#pragma unroll
            for (int m = 0; m < 4; ++m)
#pragma unroll
                for (int n = 0; n < 2; ++n) acc[a][b][m][n] = (f32x4){0.f, 0.f, 0.f, 0.f};
    bf16x8 At[4][2], B0[2][2], B1[2][2]; i32x8 At8[4], B08[2], B18[2];
    unsigned cA = cur.a, cB = cur.b;
    LAS unsigned* grec = (LAS unsigned*)(lds + 131072) + tid * 8;
    if constexpr (GATHER) {
#pragma unroll
        for (int i = 0; i < 2; ++i) { const unsigned o0 = (unsigned)S.row(cur, rA[i]) * (unsigned)(lda * ESZ) + cA2[i], o1 = (unsigned)S.row(cur, HALF + rA[i]) * (unsigned)(lda * ESZ) + cA2[i];
            grec[i] = o0; grec[2 + i] = o1; grec[4 + i] = o0; grec[6 + i] = o1; }
    }
#define PG8_STAGE_A(bufoff, kptr, h, usenext) do { if constexpr (GATHER) { const u32x2 _w = *(const LAS u32x2*)(grec + ((usenext) ? 4 : 0) + 2 * (h)); unsigned _v[2]; _v[0] = _w.x; _v[1] = _w.y; PG8_STAGE(bufoff, kptr, _v); } \
        else { PG8_STAGE1(bufoff, (kptr) + (h) * hstepA, voffA[0], s64A); } } while (0)
    PG8_STAGE1(PG8_SB(0, 0), cB, voffB[0], s64B); PG8_STAGE1(PG8_SB(0, 1), cB + hstepB, voffB[0], s64B); PG8_STAGE_A(PG8_SA(0, 0), cA, 0, false); PG8_STAGE_A(PG8_SA(0, 1), cA, 1, false);
    if (wr == 1) PG8_BAR;
    PG8_WAIT_V(2); PG8_BAR;
    PG8_STAGE1(PG8_SB(1, 0), cB + kstep, voffB[0], s64B); PG8_STAGE_A(PG8_SA(1, 0), cA + kstep, 0, false); PG8_STAGE1(PG8_SB(1, 1), cB + hstepB + kstep, voffB[0], s64B);
    PG8_WAIT_V(6); PG8_BAR;
    for (;;) {
        const bool has_next = S.next(ui + 1, nxt);
        const int tk_ = S.issue(tid, has_next);
        const unsigned nA = has_next ? nxt.a : cA, nB = has_next ? nxt.b : cB;
#pragma nounroll
        for (int t = 0; t < nt; t += 2) {
            const bool last = (t == nt - 2);
            const unsigned a1 = cA + (unsigned)(t + 1) * kstep;
            const unsigned a2 = last ? nA : cA + (unsigned)(t + 2) * kstep, b2 = last ? nB : cB + (unsigned)(t + 2) * kstep;
            const unsigned a3 = a2 + kstep, b3 = b2 + kstep;
            if constexpr (GATHER) { if (last && has_next) {
#pragma unroll
                for (int i = 0; i < 2; ++i) { grec[4 + i] = (unsigned)S.row(nxt, rA[i]) * (unsigned)(lda * ESZ) + cA2[i]; grec[6 + i] = (unsigned)S.row(nxt, HALF + rA[i]) * (unsigned)(lda * ESZ) + cA2[i]; } } }
            PG8_LDB(B0, 0, 0); PG8_LDB(B1, 0, 1); PG8_SCHED; PG8_LDA(At, 0, 0); PG8_STAGE_A(PG8_SA(1, 1), a1, 1, false);
            PG8_WAIT_V(8); PG8_WAIT_L(0); PG8_BAR; PG8_MMA(0, 0, At, B0); PG8_MMA(0, 1, At, B1); PG8_BAR; PG8_SCHED;
            PG8_LDA(At, 0, 1); PG8_STAGE1(PG8_SB(0, 0), b2, voffB[0], s64B); PG8_STAGE1(PG8_SB(0, 1), b2 + hstepB, voffB[0], s64B); PG8_STAGE_A(PG8_SA(0, 0), a2, 0, last);
            PG8_WAIT_V(8); PG8_WAIT_L(0); PG8_BAR; PG8_MMA(1, 0, At, B0); PG8_MMA(1, 1, At, B1); PG8_BAR; PG8_SCHED;
            PG8_LDB(B0, 1, 0); PG8_LDB(B1, 1, 1); PG8_SCHED; PG8_LDA(At, 1, 0); PG8_STAGE_A(PG8_SA(0, 1), a2, 1, last);
            PG8_WAIT_V(8); PG8_WAIT_L(0); PG8_BAR; PG8_MMA(0, 0, At, B0); PG8_MMA(0, 1, At, B1); PG8_BAR; PG8_SCHED;
            PG8_LDA(At, 1, 1); PG8_STAGE1(PG8_SB(1, 0), b3, voffB[0], s64B); PG8_STAGE1(PG8_SB(1, 1), b3 + hstepB, voffB[0], s64B); PG8_STAGE_A(PG8_SA(1, 0), a3, 0, last);
            PG8_WAIT_V(8); PG8_WAIT_L(0); PG8_BAR; PG8_MMA(1, 0, At, B0); PG8_MMA(1, 1, At, B1); PG8_BAR; PG8_SCHED;
        }
        S.commit(tid, ui, tk_);
        if constexpr (ALIGN_EPI) { if (wr == 0) PG8_BAR; }
        { int tz = tid; asm volatile("" : "+v"(tz)); const int ew = __builtin_amdgcn_readfirstlane(tz >> 6), el = tz & 63;
          E(acc, cur, ew >> 2, ew & 3, el & 15, el >> 4); }
        if (!has_next) break;
#pragma unroll
        for (int a = 0; a < 2; ++a)
#pragma unroll
            for (int b = 0; b < 2; ++b)
#pragma unroll
                for (int m = 0; m < 4; ++m)
#pragma unroll
                    for (int n = 0; n < 2; ++n) acc[a][b][m][n] = (f32x4){0.f, 0.f, 0.f, 0.f};
        cur = nxt; cA = nA; cB = nB; ++ui;
        if constexpr (GATHER) { const u32x4 _n = *(const LAS u32x4*)(grec + 4); *(LAS u32x4*)grec = _n; }
        if constexpr (ALIGN_EPI) { if (wr == 1) PG8_BAR; }
    }
    PG8_WAIT_V(0);
    if constexpr (!ALIGN_EPI) { if (wr == 0) PG8_BAR; }
    PG8_BAR;
#undef PG8_SA
#undef PG8_SB
#undef PG8_STAGE
#undef PG8_STAGE_A
#undef PG8_LDA
#undef PG8_LDB
#undef PG8_MMA
#undef PG8_WAIT_V
#undef PG8_WAIT_L
#undef PG8_BAR
#undef PG8_SCHED
}
}
using pg8::Unit;

constexpr int LDS_TICK = 147456;
struct DenseSched {
    unsigned A, Bt, tA, tB, aBr; int nM, nN, G, c, pnShift; unsigned* ctr;
    __device__ __forceinline__ void begin(int tid) const { volatile LAS int* tk = (volatile LAS int*)lds_at(LDS_TICK);
        __syncthreads();
        if (tid == 0) { const int t0 = (int)__hip_atomic_fetch_add(ctr, 1u, __ATOMIC_RELAXED, __HIP_MEMORY_SCOPE_AGENT), t1 = (int)__hip_atomic_fetch_add(ctr, 1u, __ATOMIC_RELAXED, __HIP_MEMORY_SCOPE_AGENT); tk[0] = t0; tk[1] = t1; }
        __syncthreads(); }
    __device__ __forceinline__ int issue(int tid, bool more) const { int t = 0x3fffffff; if (tid == 0 && more) t = (int)__hip_atomic_fetch_add(ctr, 1u, __ATOMIC_RELAXED, __HIP_MEMORY_SCOPE_AGENT); return t; }
    __device__ __forceinline__ void commit(int tid, int ui, int t) const { if (tid == 0) { volatile LAS int* tk = (volatile LAS int*)lds_at(LDS_TICK); tk[ui & 1] = t; asm volatile("s_waitcnt vmcnt(0) lgkmcnt(0)" ::: "memory"); } }
    __device__ __forceinline__ bool next(int i, Unit& u) const {
        const int L = __builtin_amdgcn_readfirstlane(((volatile LAS int*)lds_at(LDS_TICK))[i & 1]);
        int pm, pn; if (L < 0 || L >= nM * nN || !pg8::dense_unit(0, 1, L, nM, nN, pm, pn)) return false;
        u.pm = pm; u.pn = pn; u.aux = 0; u.nvalid = 256; u.rows = 0u;
        u.a = A + (unsigned)(pn >> pnShift) * aBr + (unsigned)pm * tA; u.b = Bt + (unsigned)pn * tB; return true;
    }
    __device__ __forceinline__ int row(const Unit&, int) const { return 0; }
};
struct OneSched {
    Unit u0; bool has;
    __device__ __forceinline__ void begin(int) const {}
    __device__ __forceinline__ int issue(int, bool) const { return 0; }
    __device__ __forceinline__ void commit(int, int, int) const {}
    __device__ __forceinline__ bool next(int i, Unit& u) const { if (i > 0 || !has) return false; u = u0; return true; }
    __device__ __forceinline__ int row(const Unit&, int) const { return 0; }
};
struct MoeSched {
    const LAS int* pre;
    const LAS int* cnt;
    const char* wsb;
    unsigned A, W, wE, wT, aT; int G, c; bool gatherA; unsigned* ctr;
    __device__ __forceinline__ void begin(int tid) const { volatile LAS int* tk = (volatile LAS int*)lds_at(LDS_TICK);
        __syncthreads();
        if (tid == 0) { const int t0 = (int)__hip_atomic_fetch_add(ctr, 1u, __ATOMIC_RELAXED, __HIP_MEMORY_SCOPE_AGENT), t1 = (int)__hip_atomic_fetch_add(ctr, 1u, __ATOMIC_RELAXED, __HIP_MEMORY_SCOPE_AGENT); tk[0] = t0; tk[1] = t1; }
        __syncthreads(); }
    __device__ __forceinline__ int issue(int tid, bool more) const { int t = 0x3fffffff; if (tid == 0 && more) t = (int)__hip_atomic_fetch_add(ctr, 1u, __ATOMIC_RELAXED, __HIP_MEMORY_SCOPE_AGENT); return t; }
    __device__ __forceinline__ void commit(int tid, int ui, int t) const { if (tid == 0) { volatile LAS int* tk = (volatile LAS int*)lds_at(LDS_TICK); tk[ui & 1] = t; asm volatile("s_waitcnt vmcnt(0) lgkmcnt(0)" ::: "memory"); } }
    __device__ __forceinline__ bool next(int i, Unit& u) const {
        const int L = __builtin_amdgcn_readfirstlane(((volatile LAS int*)lds_at(LDS_TICK))[i & 1]); const int total = pre[16] * 4; if (L < 0 || L >= total) return false;
        const int t = (int)(L >> 2), pn = (int)(L & 3); int e = 0;
#pragma unroll
        for (int j = 1; j < 16; ++j) e += (pre[j] <= t) ? 1 : 0;
        const int pm = t - pre[e];
        u.aux = e; u.pm = t; u.pn = pn; u.nvalid = min(256, cnt[e] - 256 * pm); u.rows = (unsigned)(WS_R + R_LIST) + (unsigned)(e * MTOK + 256 * pm) * 4u;
        u.a = gatherA ? A : A + (unsigned)t * aT; u.b = W + (unsigned)e * wE + (unsigned)pn * wT; return true;
    }
    __device__ __forceinline__ int row(const Unit& u, int R) const { return (R < u.nvalid) ? (((const int*)(wsb + u.rows))[R] >> 1) : 0; }
};

typedef f32x4 Acc[2][2][4][2];
#define EPI_LOOP_AIM _Pragma("unroll") for (int ai = 0; ai < 2; ++ai) _Pragma("unroll") for (int m = 0; m < 4; ++m)
__device__ __forceinline__ u32x4 pack8(const f32x4& a, const f32x4& b) { u32x4 w; w.x = pk2(a[0], a[1]); w.y = pk2(a[2], a[3]); w.z = pk2(b[0], b[1]); w.w = pk2(b[2], b[3]); return w; }

struct EpiProj {
    static constexpr bool PERM = true;
    __device__ __forceinline__ void operator()(const Acc& acc, const Unit& u, int wr, int wc, int fr, int fq) const {
        unsigned char* ws = ws_late(); bf16_t* proj = (bf16_t*)(ws + WS_R + R_PROJ); bf16_t* nkv = (bf16_t*)(ws + WS_R + R_NKV); float* sm = (float*)(ws + WS_R + R_SM);
        const int row0 = u.pm * 256 + wr * 64 + fr;
        if (u.pn < 12) {
            const float sc = (u.pn == 8 || u.pn == 9) ? QSCALE : (u.pn == 5 ? 0.125f : 1.0f);
            const int col0 = u.pn * 256 + wc * 32 + 8 * fq;
            EPI_LOOP_AIM { bf16_t* rp = proj + (size_t)(row0 + ai * 128 + m * 16) * PROJW + col0;
#pragma unroll
                for (int bj = 0; bj < 2; ++bj) *(u32x4*)(rp + bj * 128) = pack8(acc[ai][bj][m][0] * sc, acc[ai][bj][m][1] * sc); }
        } else {
#pragma unroll
            for (int bj = 0; bj < 2; ++bj) {
                if (u.pn == 12 || bj == 0) {
                    const int seg = (u.pn - 12) * 4 + bj * 2 + (wc >> 1), col = 32 * (wc & 1) + 8 * fq;
                    bf16_t* base = nkv + (size_t)seg * (NKV_SEG / 2) + col;
                    EPI_LOOP_AIM { *(u32x4*)(base + (size_t)(row0 + ai * 128 + m * 16) * 64) = pack8(acc[ai][bj][m][0], acc[ai][bj][m][1]); }
                } else if (wc == 0 && fq < 3) {
                    EPI_LOOP_AIM { float* sp = sm + (size_t)(row0 + ai * 128 + m * 16) * 32 + 8 * fq; *(f32x4*)sp = acc[ai][bj][m][0]; *(f32x4*)(sp + 4) = acc[ai][bj][m][1]; }
                }
            }
        }
    }
};
struct EpiH1 {
    static constexpr bool PERM = true;
    bf16_t* h1; const float* cbias;
    __device__ __forceinline__ void operator()(const Acc& acc, const Unit& u, int wr, int wc, int fr, int fq) const {
        const int which = u.aux, rl0 = wr * 64 + fr;
        bf16_t* base = h1 + ((size_t)which * BC * 256 + (size_t)u.pm * 256) * 256;
        const float* bp = cbias + which * 256;
#pragma unroll
        for (int bj = 0; bj < 2; ++bj) { const int col = bj * 128 + wc * 32 + 8 * fq; const f32x4 b0 = *(const f32x4*)(bp + col), b1 = *(const f32x4*)(bp + col + 4);
            EPI_LOOP_AIM { const int rl = rl0 + ai * 128 + m * 16; f32x4 v0 = acc[ai][bj][m][0] + b0, v1 = acc[ai][bj][m][1] + b1;
#pragma unroll
                for (int e = 0; e < 4; ++e) { v0[e] = (rl < 255) ? siluf_(v0[e]) : 0.f; v1[e] = (rl < 255) ? siluf_(v1[e]) : 0.f; }
                *(u32x4*)(base + (size_t)rl * 256 + col) = pack8(v0, v1); } }
    }
};
struct EpiCmp2 {
    static constexpr bool PERM = true;
    bf16_t* kc;
    __device__ __forceinline__ void operator()(const Acc& acc, const Unit& u, int wr, int wc, int fr, int fq) const {
        if (wc >= 2) return;
        const int col = wc * 32 + 8 * fq; bf16_t* base = kc + ((size_t)u.aux * BC + u.pm) * 256 * 64 + col;
        EPI_LOOP_AIM { const int rl = wr * 64 + fr + ai * 128 + m * 16; *(u32x4*)(base + (size_t)rl * 64) = pack8(acc[ai][0][m][0], acc[ai][0][m][1]); }
    }
};
struct EpiP {
    static constexpr bool PERM = true;
    __device__ __forceinline__ void operator()(const Acc& acc, const Unit& u, int wr, int wc, int fr, int fq) const {
        const int i = u.pn >> 2, pt = u.pn & 3, row0 = u.pm * 256 + wr * 64 + fr, col0 = 256 * pt + 32 * wc + 8 * fq;
        bf16_t* P = (bf16_t*)(ws_late() + WS_R + R_P) + (size_t)i * MC * 1024;
        EPI_LOOP_AIM { bf16_t* rp = P + (unsigned)((row0 + ai * 128 + m * 16) * 1024 + col0);
#pragma unroll
            for (int bj = 0; bj < 2; ++bj) *(u32x4*)(rp + bj * 128) = pack8(acc[ai][bj][m][0], acc[ai][bj][m][1]); }
    }
};
struct EpiGate {
    static constexpr bool PERM = true;
    __device__ __forceinline__ void operator()(const Acc& acc, const Unit& u, int wr, int wc, int fr, int fq) const {
        unsigned char* ws = ws_late(); const bf16_t* P = (const bf16_t*)(ws + WS_R + R_P); bf16_t* y = (bf16_t*)(ws + WS_R + R_Y);
        const int row0 = u.pm * 256 + wr * 64 + fr, oc = 64 * u.pn + 16 * wc + 4 * fq;
#pragma unroll
        for (int ai = 0; ai < 2; ++ai)
#pragma unroll
            for (int mh = 0; mh < 2; ++mh) {
                u32x2 pw[2][4];
#pragma unroll
                for (int mm = 0; mm < 2; ++mm) { const unsigned r = (unsigned)(row0 + ai * 128 + (2 * mh + mm) * 16);
#pragma unroll
                    for (int i = 0; i < 4; ++i) pw[mm][i] = *(const u32x2*)(P + ((size_t)i * MC * 1024 + r * 1024u + (unsigned)oc)); }
#pragma unroll
                for (int mm = 0; mm < 2; ++mm) { const int m = 2 * mh + mm; const unsigned r = (unsigned)(row0 + ai * 128 + m * 16);
                    f32x4 s = {0.f, 0.f, 0.f, 0.f};
#pragma unroll
                    for (int bj = 0; bj < 2; ++bj)
#pragma unroll
                        for (int n = 0; n < 2; ++n) { const u32x2 pq = pw[mm][2 * bj + n]; const f32x4 a = acc[ai][bj][m][n];
                            s[0] += sigmoidf_(a[0] * F8_DESCALE) * __uint_as_float(pq.x << 16); s[1] += sigmoidf_(a[1] * F8_DESCALE) * __uint_as_float(pq.x & 0xffff0000u);
                            s[2] += sigmoidf_(a[2] * F8_DESCALE) * __uint_as_float(pq.y << 16); s[3] += sigmoidf_(a[3] * F8_DESCALE) * __uint_as_float(pq.y & 0xffff0000u); }
                    u32x2 w; w.x = pk2(s[0], s[1]); w.y = pk2(s[2], s[3]); *(u32x2*)(y + (r * 1024u + (unsigned)oc)) = w; }
            }
    }
};
struct EpiOut {
    static constexpr bool PERM = true;
    int row_base;
    __device__ __forceinline__ void operator()(const Acc& acc, const Unit& u, int wr, int wc, int fr, int fq) const {
        bf16_t* T = (bf16_t*)(ws_late() + WS_T);
        const int rg0 = row_base + u.pm * 256 + wr * 64 + fr, col0 = u.pn * 256 + wc * 32 + 8 * fq;
        EPI_LOOP_AIM { bf16_t* rp = T + (size_t)(rg0 + ai * 128 + m * 16) * 1024 + col0;
#pragma unroll
            for (int bj = 0; bj < 2; ++bj) *(u32x4*)(rp + bj * 128) = pack8(acc[ai][bj][m][0], acc[ai][bj][m][1]); }
    }
};
struct EpiMoe1 {
    static constexpr bool PERM = true;
    __device__ __forceinline__ void operator()(const Acc& acc, const Unit& u, int wr, int wc, int fr, int fq) const {
        const int rl0 = wr * 64 + fr, f0 = 128 * u.pn + 32 * wc + 8 * fq;
        bf16_t* hid = (bf16_t*)(ws_late() + WS_R + R_HID);
        EPI_LOOP_AIM { const int rl = rl0 + ai * 128 + m * 16;
            f32x4 a0 = acc[ai][0][m][0], a1 = acc[ai][0][m][1]; const f32x4 b0 = acc[ai][1][m][0], b1 = acc[ai][1][m][1];
#pragma unroll
            for (int e = 0; e < 4; ++e) { a0[e] = siluf_(a0[e]) * b0[e]; a1[e] = siluf_(a1[e]) * b1[e]; }
            *(u32x4*)(hid + (unsigned)((u.pm * 256 + rl) * 512 + f0)) = pack8(a0, a1); __builtin_amdgcn_sched_barrier(0); }
    }
};
struct EpiMoe2 {
    static constexpr bool PERM = true;
    __device__ __forceinline__ void operator()(const Acc& acc, const Unit& u, int wr, int wc, int fr, int fq) const {
        unsigned char* ws = ws_late(); bf16_t* out2 = (bf16_t*)(ws + WS_R + R_OUT2);
        const float* cwb = (const float*)(ws + (R_CW - R_LIST) + u.rows); const int* rws = (const int*)(ws + u.rows);
        const int rl0 = wr * 64 + fr, c0 = 256 * u.pn + 32 * wc + 8 * fq;
        EPI_LOOP_AIM { const int rl = rl0 + ai * 128 + m * 16;
            if (rl < u.nvalid) { const unsigned v = (unsigned)rws[rl]; const float wgt = cwb[rl]; bf16_t* rp = out2 + (size_t)v * 1024 + c0;
#pragma unroll
                for (int bj = 0; bj < 2; ++bj) *(u32x4*)(rp + bj * 128) = pack8(acc[ai][bj][m][0] * wgt, acc[ai][bj][m][1] * wgt); } }
    }
};

enum { IN_X = 0, IN_C, IN_POS, IN_ADAW, IN_ADAB, IN_WIN, IN_CONVW, IN_ALOG, IN_DTB, IN_GNORM, IN_RETGN, IN_PE, IN_CKW1, IN_CKW2, IN_CVW1, IN_CVW2, IN_FBIAS,
       IN_BP, IN_WG, IN_WO, IN_LNG, IN_LNB, IN_RW, IN_RB, IN_EW1, IN_EW3, IN_EW2 };

__device__ __forceinline__ void p0_ada(const Params& p, int item, LAS float* lf, const int tid) {
    LAS float* sc = lf; LAS float* red = lf + 16384;
    const float* c = PIN(IN_C);
    for (int i = tid; i < 16384; i += NTHR) sc[i] = siluf_(c[i]);
    __syncthreads();
    const int ls = item / 48, cb = item % 48, col = cb * 64 + (tid & 63), ks = tid >> 6;
    const float* w = PIN(IN_ADAW) + (size_t)ls * 1024 * 3072 + col;
    float acc[16];
#pragma unroll
    for (int b = 0; b < 16; ++b) acc[b] = 0.f;
    for (int k0 = ks * 128; k0 < ks * 128 + 128; k0 += 16) { float wv[16];
#pragma unroll
        for (int kk = 0; kk < 16; ++kk) wv[kk] = w[(size_t)(k0 + kk) * 3072];
#pragma unroll
        for (int kk = 0; kk < 16; ++kk)
#pragma unroll
            for (int b = 0; b < 16; ++b) acc[b] += sc[b * 1024 + k0 + kk] * wv[kk]; }
#pragma unroll
    for (int b = 0; b < 16; ++b) red[(ks * 16 + b) * 64 + (tid & 63)] = acc[b];
    __syncthreads();
    float* mod = (float*)(p.ws + WS_MOD);
    for (int o = tid; o < 1024; o += NTHR) { const int b = o >> 6, cc = o & 63; float s = 0.f;
#pragma unroll
        for (int q = 0; q < 8; ++q) s += red[(q * 16 + b) * 64 + cc];
        mod[((size_t)ls * 16 + b) * 3072 + cb * 64 + cc] = s + PIN(IN_ADAB)[ls * 3072 + cb * 64 + cc]; }
    __syncthreads();
}
__device__ __forceinline__ void p0_rope(const Params& p, int item, const int tid) {
    const int* pos = (const int*)PIN(IN_POS); f32x2* tab = (f32x2*)(p.ws + WS_ROPE);
#pragma unroll
    for (int j = 0; j < 8; ++j) { const int idx = item * 4096 + j * 512 + tid; const int m = idx >> 5, i = idx & 31;
        const float inv = powf(10000.0f, -(float)i / 32.0f); const float ang = (float)pos[m] * inv;
        const float n = rintf(ang * 0.6366197723675814f);
        float r = fmaf(n, -1.5703125f, ang); r = fmaf(n, -4.837512969970703125e-4f, r); r = fmaf(n, -7.54978995489188e-8f, r);
        const float s = sinf(r), cs = cosf(r); const int q = ((int)n) & 3;
        float so, co; if (q == 0) { so = s; co = cs; } else if (q == 1) { so = cs; co = -s; } else if (q == 2) { so = -s; co = -cs; } else { so = -cs; co = s; }
        tab[idx] = (f32x2){co, so}; }
}
__device__ __forceinline__ void p0_cbias(const Params& p, int item, LAS float* red, const int tid) {
    const int l = item >> 1, which = item & 1, col = tid & 255, half = tid >> 8;
    const float* pe = PIN(IN_PE) + (size_t)l * 2048 + half * 1024; const float* w1 = PIN(which ? IN_CVW1 : IN_CKW1) + (size_t)l * 2048 * 256 + (size_t)half * 1024 * 256 + col;
    float s = 0.f;
    for (int k0 = 0; k0 < 1024; k0 += 16) { float wv[16];
#pragma unroll
        for (int kk = 0; kk < 16; ++kk) wv[kk] = w1[(size_t)(k0 + kk) * 256];
#pragma unroll
        for (int kk = 0; kk < 16; ++kk) s += pe[k0 + kk] * wv[kk]; }
    __syncthreads();
    red[tid] = s;
    __syncthreads();
    if (tid < 256) ((float*)(p.ws + WS_CBIAS))[item * 256 + tid] = red[tid] + red[tid + 256];
    __syncthreads();
}
struct TJob { bf16_t* dst; int K, nrt, nkt; };
constexpr int TJ_TILES[8] = {56 * 16, 64 * 16, 64 * 4, 16 * 16, 256 * 16, 256 * 8, 8 * 32, 8 * 4};
constexpr int TJ_TOTAL = 56 * 16 + 64 * 16 + 64 * 4 + 16 * 16 + 256 * 16 + 256 * 8 + 8 * 32 + 8 * 4;
__device__ __forceinline__ int win_src_col(int pc) {
    if (pc < 768) return pc;
    if (pc < 1024) return pc - 768 + 776;
    if (pc < 2048) return pc - 1024 + 1032;
    if (pc < 2304) return pc - 2048 + 2056;
    if (pc < 3072) return pc - 2304 + 2708;
    if (pc < 3456) return pc - 3072 + 2312;
    if (pc < 3464) return pc - 3456 + 768;
    if (pc < 3476) return pc - 3464 + 2696;
    if (pc < 3480) return pc - 3476 + 3476;
    return -1;
}
__device__ __forceinline__ const float* tj_src(const Params& p, int l, int job, int n, int& pitch) {
    switch (job) {
    case 0: { pitch = 3480; const int c = win_src_col(n); return c < 0 ? nullptr : PIN(IN_WIN) + (size_t)l * 1024 * 3480 + c; }
    case 1: { pitch = 1024; const int i = 2 * ((n >> 7) & 1) + ((n >> 2) & 1), c = 64 * (n >> 8) + 16 * ((n >> 5) & 3) + 4 * ((n >> 3) & 3) + (n & 3);
              return PIN(IN_WG) + ((size_t)l * 4 + i) * 1024 * 1024 + c; }
    case 2: { pitch = 1024; const int i = n >> 10, c = n & 1023; return PIN(IN_BP) + ((size_t)l * 4 + i) * 256 * 1024 + c; }
    case 3: { pitch = 1024; return PIN(IN_WO) + (size_t)l * 1024 * 1024 + n; }
    case 4: { pitch = 512; const int e = n >> 10, vr = n & 1023, f = 128 * (vr >> 8) + (vr & 127); return PIN(((vr >> 7) & 1) ? IN_EW3 : IN_EW1) + ((size_t)l * 16 + e) * 1024 * 512 + f; }
    case 5: { pitch = 1024; const int e = n >> 10, c = n & 1023; return PIN(IN_EW2) + ((size_t)l * 16 + e) * 512 * 1024 + c; }
    case 6: { pitch = 256; const int which = n >> 8, c = n & 255; return PIN(which ? IN_CVW1 : IN_CKW1) + (size_t)l * 2048 * 256 + c; }
    default: { pitch = 64; const int which = n >> 8, r = n & 255; return r < 64 ? PIN(which ? IN_CVW2 : IN_CKW2) + (size_t)l * 256 * 64 + r : nullptr; }
    }
}
struct TDesc { const float* src; bf16_t* dst; int pitch, K, rt, kt, job; };
__device__ __forceinline__ void tj_decode(const Params& p, int item, int tx, TDesc& d) {
    const int l = item / TJ_TOTAL; int t = item % TJ_TOTAL, job = 0;
#pragma unroll
    for (int j = 0; j < 8; ++j) { if (job == j && t >= TJ_TILES[j]) { t -= TJ_TILES[j]; job = j + 1; } }
    const size_t lw = WS_W + (size_t)l * ((LW_BYTES + MiB - 1) / MiB) * MiB;
    const size_t offs[8] = {LW_WIN, LW_WGV, LW_BPT, LW_WOT, LW_W13, LW_W2, LW_CW1, LW_CW2};
    const int Ks[8] = {1024, 1024, 256, 1024, 1024, 512, 2048, 256};
    size_t off = 0; int K = 0;
#pragma unroll
    for (int j = 0; j < 8; ++j) if (job == j) { off = offs[j]; K = Ks[j]; }
    d.dst = (bf16_t*)(p.ws + lw + off); d.K = K; d.job = job;
    const int nkt = K / 64; d.rt = t / nkt; d.kt = t % nkt;
    d.src = tj_src(p, l, job, d.rt * 64 + tx, d.pitch);
}
__device__ __forceinline__ void p0_transpose4(const Params& p, int it, int G, int end, LAS float* tiles, const int tid) {
    const int tx = tid & 63, ty = tid >> 6; float v[4][8]; TDesc d[4];
#pragma unroll
    for (int q = 0; q < 4; ++q) { const int item = it + q * G; if (item < end) { tj_decode(p, item, tx, d[q]);
#pragma unroll
            for (int kk = 0; kk < 8; ++kk) v[q][kk] = d[q].src ? d[q].src[(size_t)(d[q].kt * 64 + ty + 8 * kk) * d[q].pitch] : 0.f; } }
#pragma unroll
    for (int q = 0; q < 4; ++q) { if (it + q * G < end) {
#pragma unroll
            for (int kk = 0; kk < 8; ++kk) tiles[q * 4160 + (ty + 8 * kk) * 65 + tx] = v[q][kk]; } }
    __syncthreads();
    const int r = tid >> 3, sg = tid & 7;
#pragma unroll
    for (int q = 0; q < 4; ++q) { if (it + q * G < end) { f32x4 a, b;
#pragma unroll
            for (int j = 0; j < 4; ++j) { a[j] = tiles[q * 4160 + (sg * 8 + j) * 65 + r]; b[j] = tiles[q * 4160 + (sg * 8 + 4 + j) * 65 + r]; }
            if (d[q].job == 1) { u32x2 w8; w8.x = pk4_fp8(a[0] * W8_SCALE, a[1] * W8_SCALE, a[2] * W8_SCALE, a[3] * W8_SCALE); w8.y = pk4_fp8(b[0] * W8_SCALE, b[1] * W8_SCALE, b[2] * W8_SCALE, b[3] * W8_SCALE);
                                 *(u32x2*)((unsigned char*)d[q].dst + (size_t)(d[q].rt * 64 + r) * d[q].K + d[q].kt * 64 + sg * 8) = w8; }
            else *(u32x4*)(d[q].dst + (size_t)(d[q].rt * 64 + r) * d[q].K + d[q].kt * 64 + sg * 8) = pack8(a, b); } }
    __syncthreads();
}

struct RowV { f32x4 v[4]; };
__device__ __forceinline__ void row_load(RowV& r, const float* src, int lane) {
#pragma unroll
    for (int j = 0; j < 4; ++j) r.v[j] = *(const f32x4*)(src + 4 * lane + 256 * j);
}
__device__ __forceinline__ void row_stats(const RowV& r, float& mean, float& rstd) {
    float s = 0.f;
#pragma unroll
    for (int j = 0; j < 4; ++j) s += (r.v[j][0] + r.v[j][1]) + (r.v[j][2] + r.v[j][3]);
    mean = wave_sum(s) * (1.0f / 1024.0f);
    float q = 0.f;
#pragma unroll
    for (int j = 0; j < 4; ++j) { const f32x4 d = r.v[j] - mean; q += (d[0] * d[0] + d[1] * d[1]) + (d[2] * d[2] + d[3] * d[3]); }
    rstd = 1.0f / sqrtf(wave_sum(q) * (1.0f / 1024.0f) + LN_EPS);
}
__device__ __forceinline__ void row_ln(RowV& r, float mean, float rstd, const float* g, const float* b, int lane) {
#pragma unroll
    for (int j = 0; j < 4; ++j) { const f32x4 gg = *(const f32x4*)(g + 4 * lane + 256 * j), bb = *(const f32x4*)(b + 4 * lane + 256 * j); r.v[j] = (r.v[j] - mean) * rstd * gg + bb; }
}
__device__ __forceinline__ void row_mod(RowV& h, const RowV& x, const float* mod, int lane) {
#pragma unroll
    for (int j = 0; j < 4; ++j) { const f32x4 sh = *(const f32x4*)(mod + 4 * lane + 256 * j), sc = *(const f32x4*)(mod + 1024 + 4 * lane + 256 * j); h.v[j] = x.v[j] * (sc + 1.0f) + sh; }
}
__device__ __forceinline__ void row_store_bf16(const RowV& h, bf16_t* dst, int lane) {
#pragma unroll
    for (int j = 0; j < 4; ++j) { u32x2 w; w.x = pk2(h.v[j][0], h.v[j][1]); w.y = pk2(h.v[j][2], h.v[j][3]); *(u32x2*)(dst + 4 * lane + 256 * j) = w; }
}
__device__ __forceinline__ void vec_load(RowV& v, const float* src, int lane) {
#pragma unroll
    for (int j = 0; j < 4; ++j) v.v[j] = *(const f32x4*)(src + 4 * lane + 256 * j);
}
__device__ __forceinline__ void row_ln_r(RowV& r, float mean, float rstd, const RowV& g, const RowV& b) {
#pragma unroll
    for (int j = 0; j < 4; ++j) r.v[j] = (r.v[j] - mean) * rstd * g.v[j] + b.v[j];
}
__device__ __forceinline__ void row_mod_r(RowV& h, const RowV& x, const RowV& sh, const RowV& sc1) {
#pragma unroll
    for (int j = 0; j < 4; ++j) h.v[j] = x.v[j] * sc1.v[j] + sh.v[j];
}
__device__ __forceinline__ void vec_add1(RowV& v) {
#pragma unroll
    for (int j = 0; j < 4; ++j) v.v[j] = v.v[j] + 1.0f;
}
__device__ __forceinline__ void row_store_fp8(const RowV& h, unsigned char* dst, int lane) {
#pragma unroll
    for (int j = 0; j < 4; ++j) *(unsigned*)(dst + 4 * lane + 256 * j) = pk4_fp8(h.v[j][0] * H8_SCALE, h.v[j][1] * H8_SCALE, h.v[j][2] * H8_SCALE, h.v[j][3] * H8_SCALE);
}
__device__ __forceinline__ void prep_first(const Params& p, const int tid, const int blk) {
    const int lane = tid & 63, wv = tid >> 6; const float* x = p.in[IN_X]; bf16_t* H = (bf16_t*)(p.ws + WS_H); const float* mod = (const float*)(p.ws + WS_MOD);
    const int row0 = (blk * 8 + wv) * 32;
    RowV sh, sc1; vec_load(sh, mod + (size_t)(row0 >> 12) * 3072, lane); vec_load(sc1, mod + (size_t)(row0 >> 12) * 3072 + 1024, lane); vec_add1(sc1);
    RowV cur; row_load(cur, x + (size_t)row0 * 1024, lane);
    for (int i = 0; i < 32; ++i) { const int row = row0 + i; RowV nx; if (i + 1 < 32) row_load(nx, x + (size_t)(row + 1) * 1024, lane);
        RowV h; row_mod_r(h, cur, sh, sc1); row_store_bf16(h, H + (size_t)row * 1024, lane); row_store_fp8(h, p.ws + WS_H8 + (size_t)row * 1024, lane); cur = nx; }
}
__device__ __forceinline__ void row_load_t(u32x2 (&t)[4], const bf16_t* src, int lane) {
#pragma unroll
    for (int j = 0; j < 4; ++j) t[j] = *(const u32x2*)(src + 4 * lane + 256 * j);
}
__device__ __forceinline__ void prep_moe(const Params& p, int l, LAS float* rwl, const int tid, const int blk) {
    const int lane = tid & 63, wv = tid >> 6;
    { const float* rw = p.in[IN_RW]; for (int i = tid; i < 16384; i += NTHR) { const int c = i >> 4, e = i & 15, ln = (c & 255) >> 2, q = c & 3, j = c >> 8;
        rwl[((((j * 4 + q) * 4 + (e >> 2)) * 64 + ln) << 2) + (e & 3)] = rw[i]; } }
    __syncthreads();
    const float* xin = (l == 0) ? p.in[IN_X] : p.out; float* z = p.out; bf16_t* H = (bf16_t*)(p.ws + WS_H); const bf16_t* T = (const bf16_t*)(p.ws + WS_T);
    const float* modg = (const float*)(p.ws + WS_MOD) + (size_t)(l * 2) * 16 * 3072; const float* mod = (const float*)(p.ws + WS_MOD) + (size_t)(l * 2 + 1) * 16 * 3072;
    f32x2* stats = (f32x2*)(p.ws + WS_STATS); const float* g = p.in[IN_LNG] + (size_t)(l * 2) * 1024; const float* bb = p.in[IN_LNB] + (size_t)(l * 2) * 1024;
    const float* gp = p.in[IN_LNG] + (size_t)((l > 0 ? l - 1 : 0) * 2 + 1) * 1024; const float* bp = p.in[IN_LNB] + (size_t)((l > 0 ? l - 1 : 0) * 2 + 1) * 1024;
    unsigned* cnt = (unsigned*)(p.ws + WS_CTL) + CW_CNT + l * 64; int* list = (int*)(p.ws + WS_R + R_LIST); float* cw = (float*)(p.ws + WS_R + R_CW);
    const float* rb = p.in[IN_RB];
    LAS unsigned* lcnt = (LAS unsigned*)(rwl + 16384); LAS unsigned* lbase = lcnt + 16; LAS unsigned* lrec = lcnt + 32;
    if (tid < 16) lcnt[tid] = 0u;
    __syncthreads();
    const int row0 = (blk * 8 + wv) * 32; int it_ = 0;
    RowV vgp, vbp, vg, vb, vgate, vsh, vsc1;
    vec_load(vgp, gp, lane); vec_load(vbp, bp, lane); vec_load(vg, g, lane); vec_load(vb, bb, lane);
    vec_load(vgate, modg + (size_t)(row0 >> 12) * 3072 + 2048, lane); vec_load(vsh, mod + (size_t)(row0 >> 12) * 3072, lane); vec_load(vsc1, mod + (size_t)(row0 >> 12) * 3072 + 1024, lane); vec_add1(vsc1);
    int row = row0;
    RowV cur; u32x2 tc[4]; row_load(cur, xin + (size_t)row * 1024, lane); row_load_t(tc, T + (size_t)row * 1024, lane);
    for (; row < row0 + 32; ++row) {
        const int nrow = row + 1; RowV nx; u32x2 tn[4];
        if (nrow < row0 + 32) { row_load(nx, xin + (size_t)nrow * 1024, lane); row_load_t(tn, T + (size_t)nrow * 1024, lane); }
        RowV r = cur, h;
        if (l > 0) { const f32x2 st = stats[row]; row_ln_r(r, st.x, st.y, vgp, vbp); }
        {
#pragma unroll
          for (int j = 0; j < 4; ++j) { const f32x4 gt = vgate.v[j];
              f32x4 y; y[0] = __uint_as_float(tc[j].x << 16); y[1] = __uint_as_float(tc[j].x & 0xffff0000u); y[2] = __uint_as_float(tc[j].y << 16); y[3] = __uint_as_float(tc[j].y & 0xffff0000u);
              r.v[j] = r.v[j] * DN_ALPHA + gt * y; *(f32x4*)(z + (size_t)row * 1024 + 4 * lane + 256 * j) = r.v[j]; } }
        float mean, rstd; row_stats(r, mean, rstd); if (lane == 0) stats[row] = (f32x2){mean, rstd};
        row_ln_r(r, mean, rstd, vg, vb); row_mod_r(h, r, vsh, vsc1); row_store_bf16(h, H + (size_t)row * 1024, lane);
        float a[16];
#pragma unroll
        for (int e = 0; e < 16; ++e) a[e] = 0.f;
#pragma unroll
        for (int j = 0; j < 4; ++j)
#pragma unroll
            for (int q = 0; q < 4; ++q) { const float hv = h.v[j][q]; const LAS float* wp = rwl + (((j * 4 + q) * 4) * 64 + lane) * 4;
                const f32x4 w0 = *(const LAS f32x4*)wp, w1 = *(const LAS f32x4*)(wp + 256), w2 = *(const LAS f32x4*)(wp + 512), w3 = *(const LAS f32x4*)(wp + 768);
#pragma unroll
                for (int e = 0; e < 4; ++e) { a[e] += hv * w0[e]; a[4 + e] += hv * w1[e]; a[8 + e] += hv * w2[e]; a[12 + e] += hv * w3[e]; }
                __builtin_amdgcn_sched_barrier(0); }
#pragma unroll
        for (int e = 0; e < 16; ++e) a[e] = wave_sum(a[e]);
        float sc[16], bi[16];
#pragma unroll
        for (int e = 0; e < 16; ++e) { sc[e] = sigmoidf_(a[e]); bi[e] = sc[e] + rb[e]; }
        int grp = 0; float best = -INFINITY;
#pragma unroll
        for (int gI = 0; gI < 4; ++gI) { float m1 = -INFINITY, m2 = -INFINITY;
#pragma unroll
            for (int q = 0; q < 4; ++q) { const float v = bi[4 * gI + q]; if (v > m1) { m2 = m1; m1 = v; } else if (v > m2) m2 = v; }
            const float gs = m1 + m2; if (gs > best) { best = gs; grp = gI; } }
        int e0 = 0, e1 = 0; float b0 = -INFINITY, b1 = -INFINITY, s0 = 0.f, s1 = 0.f;
#pragma unroll
        for (int gI = 0; gI < 4; ++gI)
#pragma unroll
            for (int q = 0; q < 4; ++q) { const int e = 4 * gI + q; if (gI == grp) { const float v = bi[e];
                if (v > b0) { b1 = b0; e1 = e0; s1 = s0; b0 = v; e0 = e; s0 = sc[e]; } else if (v > b1) { b1 = v; e1 = e; s1 = sc[e]; } } }
        const float inv = 1.0f / (s0 + s1);
        if (lane == 0) { const int li = wv * 32 + it_; const unsigned q0 = __hip_atomic_fetch_add(lcnt + e0, 1u, __ATOMIC_RELAXED, __HIP_MEMORY_SCOPE_WORKGROUP), q1 = __hip_atomic_fetch_add(lcnt + e1, 1u, __ATOMIC_RELAXED, __HIP_MEMORY_SCOPE_WORKGROUP);
                         lrec[li * 4 + 0] = (unsigned)e0 | (q0 << 8); lrec[li * 4 + 1] = (unsigned)e1 | (q1 << 8); lrec[li * 4 + 2] = __float_as_uint(s0 * inv); lrec[li * 4 + 3] = __float_as_uint(s1 * inv); }
        ++it_;
        cur = nx;
#pragma unroll
        for (int j = 0; j < 4; ++j) tc[j] = tn[j];
    }
    __syncthreads();
    if (tid < 16) lbase[tid] = atomicAdd(cnt + tid, lcnt[tid]);
    __syncthreads();
    if (tid < 256) { const int grow = blk * 256 + tid;
        const unsigned r0 = lrec[tid * 4 + 0], r1 = lrec[tid * 4 + 1]; const unsigned e0 = r0 & 255u, e1 = r1 & 255u;
        const size_t p0 = (size_t)e0 * MTOK + lbase[e0] + (r0 >> 8), p1 = (size_t)e1 * MTOK + lbase[e1] + (r1 >> 8);
        list[p0] = grow * 2; cw[p0] = __uint_as_float(lrec[tid * 4 + 2]); list[p1] = grow * 2 + 1; cw[p1] = __uint_as_float(lrec[tid * 4 + 3]); }
}
__device__ __forceinline__ void prep_next(const Params& p, int l, bool final_, const int tid, const int blk) {
    const int lane = tid & 63, wv = tid >> 6;
    float* z = p.out; bf16_t* H = (bf16_t*)(p.ws + WS_H); const float* modm = (const float*)(p.ws + WS_MOD) + (size_t)(l * 2 + 1) * 16 * 3072;
    const float* modn = (const float*)(p.ws + WS_MOD) + (size_t)((final_ ? l : l + 1) * 2) * 16 * 3072;
    f32x2* stats = (f32x2*)(p.ws + WS_STATS);
    const bf16_t* out2 = (const bf16_t*)(p.ws + WS_R + R_OUT2);
    const int row0 = (blk * 8 + wv) * 32, bt = row0 >> 12;
    RowV vg0, vb0, vg1, vb1, vgate, vsh, vsc1;
    vec_load(vg0, p.in[IN_LNG] + (size_t)(l * 2) * 1024, lane); vec_load(vb0, p.in[IN_LNB] + (size_t)(l * 2) * 1024, lane);
    vec_load(vg1, p.in[IN_LNG] + (size_t)(l * 2 + 1) * 1024, lane); vec_load(vb1, p.in[IN_LNB] + (size_t)(l * 2 + 1) * 1024, lane);
    vec_load(vgate, modm + (size_t)bt * 3072 + 2048, lane); vec_load(vsh, modn + (size_t)bt * 3072, lane); vec_load(vsc1, modn + (size_t)bt * 3072 + 1024, lane); vec_add1(vsc1);
    int row = row0;
    RowV cur; u32x2 ta[4], tb[4]; row_load(cur, z + (size_t)row * 1024, lane); row_load_t(ta, out2 + (size_t)(row * 2) * 1024, lane); row_load_t(tb, out2 + (size_t)(row * 2 + 1) * 1024, lane);
    for (; row < row0 + 32; ++row) {
        const int nrow = row + 1; RowV nx; u32x2 na[4], nb[4];
        if (nrow < row0 + 32) { row_load(nx, z + (size_t)nrow * 1024, lane); row_load_t(na, out2 + (size_t)(nrow * 2) * 1024, lane); row_load_t(nb, out2 + (size_t)(nrow * 2 + 1) * 1024, lane); }
        RowV r = cur;
        const f32x2 st = stats[row]; row_ln_r(r, st.x, st.y, vg0, vb0);
#pragma unroll
        for (int j = 0; j < 4; ++j) { const u32x2 oa = ta[j], ob = tb[j];
            f32x4 y; y[0] = __uint_as_float(oa.x << 16) + __uint_as_float(ob.x << 16); y[1] = __uint_as_float(oa.x & 0xffff0000u) + __uint_as_float(ob.x & 0xffff0000u);
            y[2] = __uint_as_float(oa.y << 16) + __uint_as_float(ob.y << 16); y[3] = __uint_as_float(oa.y & 0xffff0000u) + __uint_as_float(ob.y & 0xffff0000u);
            r.v[j] = r.v[j] * DN_ALPHA + vgate.v[j] * y; }
        cur = nx;
#pragma unroll
        for (int j = 0; j < 4; ++j) { ta[j] = na[j]; tb[j] = nb[j]; }
        float mean, rstd; row_stats(r, mean, rstd);
        if (final_) { row_ln_r(r, mean, rstd, vg1, vb1);
#pragma unroll
            for (int j = 0; j < 4; ++j) *(f32x4*)(z + (size_t)row * 1024 + 4 * lane + 256 * j) = r.v[j];
        } else {
#pragma unroll
            for (int j = 0; j < 4; ++j) *(f32x4*)(z + (size_t)row * 1024 + 4 * lane + 256 * j) = r.v[j];
            if (lane == 0) stats[row] = (f32x2){mean, rstd};
            RowV h; row_ln_r(r, mean, rstd, vg1, vb1); row_mod_r(h, r, vsh, vsc1); row_store_bf16(h, H + (size_t)row * 1024, lane); row_store_fp8(h, p.ws + WS_H8 + (size_t)row * 1024, lane); }
    }
}

__device__ __forceinline__ int q_next(unsigned* ctr, volatile LAS int* slot, const int tid) {
    __syncthreads();
    if (tid == 0) *slot = (int)__hip_atomic_fetch_add(ctr, 1u, __ATOMIC_RELAXED, __HIP_MEMORY_SCOPE_AGENT);
    __syncthreads();
    return *slot;
}

struct GdnRaw { u32x4 v[4]; float a, bg; };
__device__ __forceinline__ void gdn_prep_load(GdnRaw& g, int unit, const int tid) {
    unsigned char* ws = ws_late(); const int n = unit & 63, h = (unit >> 6) & 3, bl = unit >> 8; const int tok0 = bl * SEQ + n * 64;
    const bf16_t* proj = (const bf16_t*)(ws + WS_R + R_PROJ); const float* sm = (const float*)(ws + WS_R + R_SM);
#pragma unroll
    for (int j = 0; j < 4; ++j) { const int idx = tid + j * NTHR; const int row = idx / 24, ch = idx % 24, seg = ch >> 3, c8 = ch & 7;
        u32x4 v = {0u, 0u, 0u, 0u};
        if (idx < 67 * 24 && (n > 0 || row >= 3)) v = *(const u32x4*)(proj + (size_t)(tok0 + row - 3) * PROJW + seg * 256 + h * 64 + c8 * 8);
        g.v[j] = v; }
    g.a = 0.f; g.bg = 0.f;
    if (tid < 64) { g.a = sm[(size_t)(tok0 + tid) * 32 + h]; g.bg = sm[(size_t)(tok0 + tid) * 32 + 4 + h]; }
}
__device__ __forceinline__ void gdn_prep_unit(const Params& p, int l, int unit, LAS unsigned char* lds, const int tid_in_, const GdnRaw& graw) {
    int tid = tid_in_; asm volatile("" : "+v"(tid)); unsigned char* wsl_ = ws_late();
    const int lane = tid & 63;
    const int n = unit & 63, h = (unit >> 6) & 3, bl = unit >> 8;
    const int tok0 = bl * SEQ + n * 64;
    const bf16_t* proj = (const bf16_t*)(wsl_ + WS_R + R_PROJ); const float* sm = (const float*)(wsl_ + WS_R + R_SM);
    LAS bf16_t* raw = (LAS bf16_t*)lds;
    LAS float* qs = (LAS float*)(lds + 26112); LAS float* ks = qs + 64 * 65; LAS float* vs = ks + 64 * 65;
    LAS float* Lm = vs + 64 * 65;
    LAS float* bc = Lm + 4096; LAS float* eb = bc + 64; LAS float* be = eb + 64; LAS float* cwt = be + 64;
    __syncthreads();
#pragma unroll
    for (int j = 0; j < 4; ++j) { const int idx = tid + j * NTHR; const int row = idx / 24, ch = idx % 24, seg = ch >> 3, c8 = ch & 7;
        if (idx < 67 * 24) *(LAS u32x4*)(raw + row * 192 + seg * 64 + c8 * 8) = graw.v[j]; }
    for (int idx = tid; idx < 768; idx += NTHR) { const int k = idx / 192, ch = idx % 192; cwt[idx] = PIN(IN_CONVW)[(size_t)l * 4 * 768 + k * 768 + (ch >> 6) * 256 + h * 64 + (ch & 63)]; }
    __syncthreads();
#ifdef GP_REP_CONV
    for (int rep_ = 0; rep_ < 2; ++rep_)
#endif
    for (int idx = tid; idx < 64 * 192; idx += NTHR) { const int t = idx / 192, ch = idx % 192; float s = 0.f;
#pragma unroll
        for (int k = 0; k < 4; ++k) s += cwt[k * 192 + ch] * bf2f(raw[(t + k) * 192 + ch]);
        s = siluf_(s); const int seg = ch >> 6, d = ch & 63; (seg == 0 ? qs : seg == 1 ? ks : vs)[t * 65 + d] = s; }
    __syncthreads();
    LAS unsigned char* qb = lds + 129024; LAS unsigned char* kb = qb + 8192; LAS float* Rs = (LAS float*)(kb + 8192);
    {
        const int mat = tid >> 8, row = (tid >> 2) & 63, q4 = tid & 3; LAS float* mt = mat ? ks : qs; float x[16], ss = 0.f;
#pragma unroll
        for (int d = 0; d < 16; ++d) { x[d] = mt[row * 65 + 16 * q4 + d]; ss += x[d] * x[d]; }
        ss += swz_xor<1>(ss); ss += swz_xor<2>(ss);
        const float sc = (1.0f / sqrtf(ss + 1e-6f)) * (mat ? 1.0f : 0.125f);
#pragma unroll
        for (int d = 0; d < 16; ++d) { x[d] *= sc; mt[row * 65 + 16 * q4 + d] = x[d]; }
        LAS unsigned char* ob = (mat ? kb : qb) + (2 * q4) * 1024 + row * 16;
        u32x4 w0, w1; w0.x = pk2(x[0], x[1]); w0.y = pk2(x[2], x[3]); w0.z = pk2(x[4], x[5]); w0.w = pk2(x[6], x[7]); w1.x = pk2(x[8], x[9]); w1.y = pk2(x[10], x[11]); w1.z = pk2(x[12], x[13]); w1.w = pk2(x[14], x[15]);
        *(LAS u32x4*)ob = w0; *(LAS u32x4*)(ob + 1024) = w1;
    }
    if (tid < 64) { const int i = tid;
        const float a = graw.a, bg = graw.bg;
        const float x = a + PIN(IN_DTB)[l * 4 + h]; const float sp = fmaxf(x, 0.f) + log1pf(__expf(-fabsf(x)));
        float la = -__expf(PIN(IN_ALOG)[l * 4 + h]) * sp;
#pragma unroll
        for (int o = 1; o < 64; o <<= 1) { const float v = shfl_up_l(la, o, lane); if (lane >= o) la += v; }
        bc[i] = la; eb[i] = __expf(la); be[i] = sigmoidf_(bg); }
    __syncthreads();
    const size_t ub = WS_R + R_GDN + (size_t)unit * GDN_UNIT_BYTES;
    bf16_t* gW = (bf16_t*)(wsl_ + ub); bf16_t* gATT = gW + 4096; bf16_t* gQD = gW + 8192; bf16_t* gKDT = gW + 12288; bf16_t* gU0 = gW + 16384;
#ifdef GP_REP_KK
    for (int rep_ = 0; rep_ < 2; ++rep_)
#endif
    {
        const int wid = tid >> 6, r32 = lane & 31, hi = lane >> 5, isq = wid >> 2, it = (wid >> 1) & 1, jt = wid & 1;
        const LAS unsigned char* ab = (isq ? qb : kb) + hi * 1024 + (32 * it + r32) * 16; const LAS unsigned char* bb = kb + hi * 1024 + (32 * jt + r32) * 16;
        f32x16 acc = z16();
#pragma unroll
        for (int d0 = 0; d0 < 4; ++d0) acc = MF32(*(const LAS bf16x8*)(ab + d0 * 2048), *(const LAS bf16x8*)(bb + d0 * 2048), acc);
        const int j = 32 * jt + r32; const float bj = bc[j];
#pragma unroll
        for (int g = 0; g < 4; ++g) { f32x4 lv;
#pragma unroll
            for (int e = 0; e < 4; ++e) { const int i = 32 * it + 8 * g + 4 * hi + e; const float dc = __expf(bc[i] - bj), v = acc[4 * g + e] * dc;
                if (isq) gATT[i * 64 + j] = f2bf((j <= i) ? v : 0.f); else lv[e] = (j < i) ? be[i] * v : 0.f; }
            if (!isq) *(LAS f32x4*)(Lm + j * 64 + 32 * it + 8 * g + 4 * hi) = lv; }
    }
    __syncthreads();
    {
        const float bl_ = bc[63];
        for (int task = tid; task < 1024; task += NTHR) {
            if (task < 512) { const int c2 = task >> 3, sg = task & 7; const float e = eb[c2]; float v[8];
#pragma unroll
                for (int j = 0; j < 8; ++j) v[j] = qs[c2 * 65 + sg * 8 + j] * e;
                u32x4 w; w.x = pk2(v[0], v[1]); w.y = pk2(v[2], v[3]); w.z = pk2(v[4], v[5]); w.w = pk2(v[6], v[7]); *(u32x4*)(gQD + c2 * 64 + sg * 8) = w;
            } else { const int k = (task - 512) >> 3, sg = task & 7; float v[8];
#pragma unroll
                for (int j = 0; j < 8; ++j) { const int c2 = sg * 8 + j; v[j] = ks[c2 * 65 + k] * __expf(bl_ - bc[c2]); }
                u32x4 w; w.x = pk2(v[0], v[1]); w.y = pk2(v[2], v[3]); w.z = pk2(v[4], v[5]); w.w = pk2(v[6], v[7]); *(u32x4*)(gKDT + k * 64 + sg * 8) = w; }
        }
        if (tid == 0) ((float*)(wsl_ + WS_R + R_GG))[unit] = __expf(bl_);
    }
    {
        const int c = 16 * (tid >> 6) + (lane & 15), cc = c & 63, rg = lane >> 4; const bool isw = c >= 64; LAS float* Xs = cwt + 768;
        for (int I = 0; I < 4; ++I) {
            float r[4];
#pragma unroll
            for (int e = 0; e < 4; ++e) { const int i = 16 * I + 4 * rg + e; r[e] = isw ? be[i] * eb[i] * ks[i * 65 + cc] : be[i] * vs[i * 65 + cc]; }
#pragma unroll 4
            for (int j = 0; j < 16 * I; ++j) { const float xj = Xs[j * 128 + c]; const f32x4 l4 = *(const LAS f32x4*)(Lm + j * 64 + 16 * I + 4 * rg);
#pragma unroll
                for (int e = 0; e < 4; ++e) r[e] -= l4[e] * xj; }
#pragma unroll
            for (int e = 0; e < 4; ++e) Rs[(4 * rg + e) * 128 + c] = r[e];
            asm volatile("s_waitcnt lgkmcnt(0)" ::: "memory");
            if (lane < 16) { float q[16];
#pragma unroll
                for (int ii = 0; ii < 16; ++ii) q[ii] = Rs[ii * 128 + c];
#pragma unroll
                for (int jj = 0; jj < 15; ++jj) { const LAS float* lt = Lm + (16 * I + jj) * 64 + 16 * I;
#pragma unroll
                    for (int ii = jj + 1; ii < 16; ++ii) q[ii] -= lt[ii] * q[jj]; }
#pragma unroll
                for (int ii = 0; ii < 16; ++ii) { Xs[(16 * I + ii) * 128 + c] = q[ii]; (isw ? gW : gU0)[(16 * I + ii) * 64 + cc] = f2bf(q[ii]); }
            }
            asm volatile("s_waitcnt lgkmcnt(0)" ::: "memory");
        }
    }
    __syncthreads();
}

__device__ __forceinline__ bf16x8 afrag_perm(const LAS unsigned char* M, int row, int ks, int hi) {
    const LAS unsigned char* q = M + row * 144 + (16 * ks + 4 * hi) * 2;
    const s16x4 lo = *(const LAS s16x4*)q, hi4 = *(const LAS s16x4*)(q + 16);
    return (bf16x8){lo[0], lo[1], lo[2], lo[3], hi4[0], hi4[1], hi4[2], hi4[3]};
}
__device__ __forceinline__ bf16x8 pack_acc8(const f32x16& a, int s) {
    u32x4 w; w.x = pk2(a[8 * s + 0], a[8 * s + 1]); w.y = pk2(a[8 * s + 2], a[8 * s + 3]); w.z = pk2(a[8 * s + 4], a[8 * s + 5]); w.w = pk2(a[8 * s + 6], a[8 * s + 7]);
    return __builtin_bit_cast(bf16x8, w);
}
__device__ __forceinline__ void gdn_scan_item(const Params& p, int l, int chunk, int item, LAS unsigned char* lds, const int tid) {
    const int lane = tid & 63, wid = tid >> 6, vl = lane & 31, hi = lane >> 5;
    const int h = item & 3, bl = item >> 2;
    const unsigned char* ubase = p.ws + WS_R + R_GDN + (size_t)item * 64 * GDN_UNIT_BYTES;
    const float* gg = (const float*)(p.ws + WS_R + R_GG) + item * 64;
    const bf16_t* proj = (const bf16_t*)(p.ws + WS_R + R_PROJ); bf16_t* og = (bf16_t*)(p.ws + WS_R + R_O);
    const float* nw = PIN(IN_GNORM) + l * 64;
    constexpr int BUF = 5 * 9216;
    LAS unsigned char* buf0 = lds; LAS float* ob0 = (LAS float*)(lds + 2 * BUF);
    __syncthreads();
    for (int q = tid; q < 2560; q += NTHR) { const int mat = q >> 9, r = (q >> 3) & 63, sg = q & 7;
        *(LAS u32x4*)(buf0 + mat * 9216 + r * 144 + sg * 16) = *(const u32x4*)(ubase + mat * 8192 + r * 128 + sg * 16); }
    __syncthreads();
    f32x16 S[2]; S[0] = z16(); S[1] = z16();
    for (int n = 0; n < 64; ++n) {
        LAS unsigned char* bf = buf0 + (n & 1) * BUF; LAS float* ob = ob0 + (n & 1) * 4096;
        if (wid < 2) {
            const LAS unsigned char* Wm = bf; const LAS unsigned char* ATT = bf + 9216; const LAS unsigned char* QD = bf + 18432; const LAS unsigned char* KDT = bf + 27648; const LAS bf16_t* U0 = (const LAS bf16_t*)(bf + 36864);
            const float G = gg[n];
            bf16x8 Sb[4]; Sb[0] = pack_acc8(S[0], 0); Sb[1] = pack_acc8(S[0], 1); Sb[2] = pack_acc8(S[1], 0); Sb[3] = pack_acc8(S[1], 1);
            f32x16 u[2];
#pragma unroll
            for (int ct = 0; ct < 2; ++ct) { f32x16 a = z16();
#pragma unroll
                for (int ks = 0; ks < 4; ++ks) a = __builtin_amdgcn_mfma_f32_32x32x16_bf16(afrag_perm(Wm, 32 * ct + vl, ks, hi), Sb[ks], a, 0, 0, 0);
#pragma unroll
                for (int r = 0; r < 16; ++r) u[ct][r] = bf2f(U0[(32 * ct + crow(r, hi)) * 72 + 32 * wid + vl]) - a[r]; }
            bf16x8 ub[4]; ub[0] = pack_acc8(u[0], 0); ub[1] = pack_acc8(u[0], 1); ub[2] = pack_acc8(u[1], 0); ub[3] = pack_acc8(u[1], 1);
#pragma unroll
            for (int ct = 0; ct < 2; ++ct) { f32x16 a = z16();
#pragma unroll
                for (int ks = 0; ks < 4; ++ks) a = __builtin_amdgcn_mfma_f32_32x32x16_bf16(afrag_perm(QD, 32 * ct + vl, ks, hi), Sb[ks], a, 0, 0, 0);
#pragma unroll
                for (int cs = 0; cs < 4; ++cs) a = __builtin_amdgcn_mfma_f32_32x32x16_bf16(afrag_perm(ATT, 32 * ct + vl, cs, hi), ub[cs], a, 0, 0, 0);
#pragma unroll
                for (int r = 0; r < 16; ++r) ob[(32 * ct + crow(r, hi)) * 64 + 32 * wid + vl] = a[r]; }
#pragma unroll
            for (int kt = 0; kt < 2; ++kt) { f32x16 a = S[kt] * G;
#pragma unroll
                for (int cs = 0; cs < 4; ++cs) a = __builtin_amdgcn_mfma_f32_32x32x16_bf16(afrag_perm(KDT, 32 * kt + vl, cs, hi), ub[cs], a, 0, 0, 0);
                S[kt] = a; }
        } else {
            if (n + 1 < 64) { LAS unsigned char* nb = buf0 + ((n + 1) & 1) * BUF; const unsigned char* src = ubase + (size_t)(n + 1) * GDN_UNIT_BYTES;
                for (int q = tid - 128; q < 2560; q += 384) { const int mat = q >> 9, r = (q >> 3) & 63, sg = q & 7;
                    *(LAS u32x4*)(nb + mat * 9216 + r * 144 + sg * 16) = *(const u32x4*)(src + mat * 8192 + r * 128 + sg * 16); } }
        }
        if (wid >= 2 && n >= 1) { const LAS float* po = ob0 + ((n - 1) & 1) * 4096; const int tokb = bl * SEQ + (n - 1) * 64;
            for (int task = tid - 128; task < 512; task += 384) { const int c = task >> 3, sg = task & 7; float v[8], ss = 0.f;
#pragma unroll
                for (int j = 0; j < 8; ++j) { v[j] = po[c * 64 + sg * 8 + j]; ss += v[j] * v[j]; }
                ss += swz_xor<1>(ss); ss += swz_xor<2>(ss); ss += swz_xor<4>(ss);
                const float rs = 1.0f / sqrtf(ss * (1.0f / 64.0f) + 1e-6f);
                const u32x4 zw = *(const u32x4*)(proj + (size_t)(tokb + c) * PROJW + PC_GZ + h * 64 + sg * 8); const unsigned zz[4] = {zw.x, zw.y, zw.z, zw.w};
#pragma unroll
                for (int j = 0; j < 8; ++j) { const float zf = (j & 1) ? __uint_as_float(zz[j >> 1] & 0xffff0000u) : __uint_as_float(zz[j >> 1] << 16); v[j] = v[j] * rs * nw[sg * 8 + j] * siluf_(zf); }
                u32x4 w; w.x = pk2(v[0], v[1]); w.y = pk2(v[2], v[3]); w.z = pk2(v[4], v[5]); w.w = pk2(v[6], v[7]);
                *(u32x4*)(og + (size_t)(tokb + c) * 256 + h * 64 + sg * 8) = w; } }
        __syncthreads();
    }
    { const LAS float* po = ob0 + 4096; const int tokb = bl * SEQ + 63 * 64;
        for (int task = tid; task < 512; task += NTHR) { const int c = task >> 3, sg = task & 7; float v[8], ss = 0.f;
#pragma unroll
            for (int j = 0; j < 8; ++j) { v[j] = po[c * 64 + sg * 8 + j]; ss += v[j] * v[j]; }
            ss += swz_xor<1>(ss); ss += swz_xor<2>(ss); ss += swz_xor<4>(ss);
            const float rs = 1.0f / sqrtf(ss * (1.0f / 64.0f) + 1e-6f);
            const u32x4 zw = *(const u32x4*)(proj + (size_t)(tokb + c) * PROJW + PC_GZ + h * 64 + sg * 8); const unsigned zz[4] = {zw.x, zw.y, zw.z, zw.w};
#pragma unroll
            for (int j = 0; j < 8; ++j) { const float zf = (j & 1) ? __uint_as_float(zz[j >> 1] & 0xffff0000u) : __uint_as_float(zz[j >> 1] << 16); v[j] = v[j] * rs * nw[sg * 8 + j] * siluf_(zf); }
            u32x4 w; w.x = pk2(v[0], v[1]); w.y = pk2(v[2], v[3]); w.z = pk2(v[4], v[5]); w.w = pk2(v[6], v[7]);
            *(u32x4*)(og + (size_t)(tokb + c) * 256 + h * 64 + sg * 8) = w; } }
    __syncthreads();
}

__device__ __forceinline__ void fox_cum_item(const Params& p, int l, int item, LAS float* lf, const int tid) {
    const int lane = tid & 63, wid = tid >> 6, h = item & 3, bl = item >> 2;
    const float* sm = (const float*)(p.ws + WS_R + R_SM); float* nb = (float*)(p.ws + WS_R + R_CUM) + (size_t)item * SEQ;
    const float fb = PIN(IN_FBIAS)[l * 4 + h];
    float v[8], run = 0.f;
#pragma unroll
    for (int j = 0; j < 8; ++j) { const float x = sm[(size_t)(bl * SEQ + tid * 8 + j) * 32 + 20 + h] + fb; run += fminf(x, 0.f) - log1pf(__expf(-fabsf(x))); v[j] = run; }
    float inc = run;
#pragma unroll
    for (int o = 1; o < 64; o <<= 1) { const float t = shfl_up_l(inc, o, lane); if (lane >= o) inc += t; }
    __syncthreads();
    if (lane == 63) lf[wid] = inc;
    __syncthreads();
    float base = inc - run;
    for (int w = 0; w < wid; ++w) base += lf[w];
#pragma unroll
    for (int j = 0; j < 8; ++j) nb[tid * 8 + j] = -(base + v[j]) * LOG2E;
    __syncthreads();
}
__device__ __forceinline__ void ret_rope_pass(const Params& p, int chunk, const int tid, const int blk) {
    bf16_t* proj = (bf16_t*)(p.ws + WS_R + R_PROJ); const f32x2* tab = (const f32x2*)(p.ws + WS_ROPE);
    for (int task = blk * NTHR + tid; task < MC * 32; task += NWG * NTHR) {
        const int row = task >> 5, which = (task >> 4) & 1, h = (task >> 2) & 3, i8 = task & 3;
        bf16_t* q1 = proj + (size_t)row * PROJW + (which ? PC_RK : PC_RQ) + h * 64 + i8 * 8; bf16_t* q2 = q1 + 32;
        const u32x4 a = *(const u32x4*)q1, b = *(const u32x4*)q2; const unsigned aa[4] = {a.x, a.y, a.z, a.w}, bb[4] = {b.x, b.y, b.z, b.w};
        const f32x2* tp = tab + (size_t)(chunk * MC + row) * 32 + i8 * 8; float o1[8], o2[8];
#pragma unroll
        for (int j = 0; j < 8; ++j) { const float x1 = (j & 1) ? __uint_as_float(aa[j >> 1] & 0xffff0000u) : __uint_as_float(aa[j >> 1] << 16);
            const float x2 = (j & 1) ? __uint_as_float(bb[j >> 1] & 0xffff0000u) : __uint_as_float(bb[j >> 1] << 16);
            const f32x2 cs = tp[j]; o1[j] = x1 * cs.x - x2 * cs.y; o2[j] = x1 * cs.y + x2 * cs.x; }
        u32x4 w1, w2; w1.x = pk2(o1[0], o1[1]); w1.y = pk2(o1[2], o1[3]); w1.z = pk2(o1[4], o1[5]); w1.w = pk2(o1[6], o1[7]);
        w2.x = pk2(o2[0], o2[1]); w2.y = pk2(o2[2], o2[3]); w2.z = pk2(o2[4], o2[5]); w2.w = pk2(o2[6], o2[7]);
        *(u32x4*)q1 = w1; *(u32x4*)q2 = w2; }
}

constexpr int AL_K0 = 0, AL_V0 = 16384, AL_B0 = 32768;
__device__ __forceinline__ s16x4 vtr(const LAS unsigned char* q) {
    typedef short v4i16_t __attribute__((ext_vector_type(4)));
    return __builtin_bit_cast(s16x4, __builtin_amdgcn_ds_read_tr16_b64_v4i16((LAS v4i16_t*)q));
}
__device__ __forceinline__ void attn_qkt(f32x16& p0, f32x16& p1, const LAS unsigned char* kslot, const bf16x8 (&qf)[4], int r32, int hi) {
    p0 = z16(); p1 = z16();
#pragma unroll
    for (int d0 = 0; d0 < 4; ++d0) { const LAS unsigned char* kb = kslot + (2 * d0 + hi) * 1024 + r32 * 16;
        const bf16x8 b0 = *(const LAS bf16x8*)kb, b1 = *(const LAS bf16x8*)(kb + 512);
        p0 = MF32(b0, qf[d0], p0); p1 = MF32(b1, qf[d0], p1); }
}
__device__ __forceinline__ void attn_pv(f32x16 (&o)[2], const LAS unsigned char* vslot, const bf16x8 (&pw)[4], int lane, int hi) {
    const LAS unsigned char* vb = vslot + ((lane >> 4) & 1) * 32 + (lane & 3) * 8 + (4 * hi + ((lane & 15) >> 2)) * 64;
#pragma unroll
    for (int d0 = 0; d0 < 2; ++d0)
#pragma unroll
        for (int ks = 0; ks < 4; ++ks) { const s16x4 lo = vtr(vb + d0 * 4096 + ks * 1024), h4 = vtr(vb + d0 * 4096 + ks * 1024 + 512);
            const bf16x8 vf = (bf16x8){lo[0], lo[1], lo[2], lo[3], h4[0], h4[1], h4[2], h4[3]};
            o[d0] = MF32(vf, pw[ks], o[d0]); }
}
__device__ __forceinline__ void attn_softmax_step(f32x16& p0, f32x16& p1, f32x16 (&o)[2], float& m, float& l) {
    float mt = p0[0];
#pragma unroll
    for (int r = 1; r < 16; ++r) mt = fmaxf(mt, p0[r]);
#pragma unroll
    for (int r = 0; r < 16; ++r) mt = fmaxf(mt, p1[r]);
    mt = x32_max(mt);
    const float mn = fmaxf(m, mt), ms = (mn == -INFINITY) ? 0.f : mn, alpha = ex2(m - ms);
    float s = 0.f;
#pragma unroll
    for (int r = 0; r < 16; ++r) { p0[r] = ex2(p0[r] - ms); p1[r] = ex2(p1[r] - ms); s += p0[r] + p1[r]; }
    l = l * alpha + s; m = mn;
    if (__builtin_amdgcn_ballot_w64(alpha != 1.0f) != 0ull) { o[0] *= alpha; o[1] *= alpha; }
}
template <class F>
__device__ __forceinline__ void flash_loop(const F& f, int tlo, int thi, const bf16_t* Kg, const bf16_t* Vg, int pitch, const float* biasg,
                                           const bf16x8 (&qf)[4], f32x16 (&o)[2], float& m, float& l, LAS unsigned char* lds, const int tid) {
    const int lane = tid & 63, wid = tid >> 6, r32 = lane & 31, hi = lane >> 5;
    int t = thi - 1; while (t >= tlo && f.skip(t)) --t;
    __syncthreads();
    if (t < tlo) return;
    const bf16_t* ksrc = Kg + (size_t)lane * pitch + wid * 8;
    const bf16_t* vsrc = Vg + (size_t)(16 * (wid & 3) + (lane >> 2)) * pitch + (wid >> 2) * 32 + (lane & 3) * 8;
    const int sdst = wid * 1024 + lane * 16;
    u32x4 kr = *(const u32x4*)(ksrc + (size_t)t * 64 * pitch), vr = *(const u32x4*)(vsrc + (size_t)t * 64 * pitch); float br = 0.f;
    const int btid = tid & 63;
    if (F::HAS_BIAS) br = biasg[t * 64 + btid];
    *(LAS u32x4*)(lds + AL_K0 + sdst) = kr; *(LAS u32x4*)(lds + AL_V0 + sdst) = vr; if (F::HAS_BIAS) ((LAS float*)(lds + AL_B0))[btid] = br;
    __syncthreads();
    int cur = 0;
    for (;;) {
        int tn = t - 1; while (tn >= tlo && f.skip(tn)) --tn;
        if (tn >= tlo) { kr = *(const u32x4*)(ksrc + (size_t)tn * 64 * pitch); vr = *(const u32x4*)(vsrc + (size_t)tn * 64 * pitch); if (F::HAS_BIAS) br = biasg[tn * 64 + btid]; }
        if (!f.wskip(t)) {
        f32x16 p0, p1;
        attn_qkt(p0, p1, lds + AL_K0 + cur * 8192, qf, r32, hi);
        if (F::HAS_BIAS) { const LAS float* bp = (const LAS float*)(lds + AL_B0 + cur * 256);
#pragma unroll
            for (int g = 0; g < 4; ++g) { const f32x4 b0 = *(const LAS f32x4*)(bp + 8 * g + 4 * hi), b1 = *(const LAS f32x4*)(bp + 32 + 8 * g + 4 * hi);
#pragma unroll
                for (int e = 0; e < 4; ++e) { p0[4 * g + e] += b0[e]; p1[4 * g + e] += b1[e]; } } }
        f.apply(p0, p1, t);
        if (F::MODE == 0) attn_softmax_step(p0, p1, o, m, l);
        bf16x8 pw[4]; pw[0] = pack_acc8(p0, 0); pw[1] = pack_acc8(p0, 1); pw[2] = pack_acc8(p1, 0); pw[3] = pack_acc8(p1, 1);
        attn_pv(o, lds + AL_V0 + cur * 8192, pw, lane, hi);
        }
        if (tn < tlo) break;
        cur ^= 1;
        *(LAS u32x4*)(lds + AL_K0 + cur * 8192 + sdst) = kr; *(LAS u32x4*)(lds + AL_V0 + cur * 8192 + sdst) = vr; if (F::HAS_BIAS) ((LAS float*)(lds + AL_B0 + cur * 256))[btid] = br;
        __syncthreads();
        t = tn;
    }
    __syncthreads();
}
__device__ __forceinline__ void load_qf(bf16x8 (&qf)[4], const bf16_t* qrow, int hi) {
#pragma unroll
    for (int d0 = 0; d0 < 4; ++d0) qf[d0] = *(const bf16x8*)(qrow + d0 * 16 + hi * 8);
}
__device__ __forceinline__ void store_ot(const f32x16 (&o)[2], bf16_t* orow, int hi) {
#pragma unroll
    for (int d0 = 0; d0 < 2; ++d0)
#pragma unroll
        for (int g = 0; g < 4; ++g) { u32x2 w; w.x = pk2(o[d0][4 * g], o[d0][4 * g + 1]); w.y = pk2(o[d0][4 * g + 2], o[d0][4 * g + 3]); *(u32x2*)(orow + 32 * d0 + 8 * g + 4 * hi) = w; }
}

struct FoxF { static constexpr int MODE = 0; static constexpr bool HAS_BIAS = true; int tq, qmin, hi;
    __device__ __forceinline__ bool skip(int) const { return false; }
    __device__ __forceinline__ bool wskip(int) const { return false; }
    __device__ __forceinline__ void apply(f32x16& p0, f32x16& p1, int t) const { const float NI = ninf_();
        if (64 * t + 63 > qmin) {
#pragma unroll
            for (int r = 0; r < 16; ++r) { const int key = 64 * t + crow(r, hi); if (key > tq) p0[r] = NI; if (key + 32 > tq) p1[r] = NI; } } } };
struct RetF { static constexpr int MODE = 1; static constexpr bool HAS_BIAS = false; int tq, hi; float lg;
    __device__ __forceinline__ bool skip(int) const { return false; }
    __device__ __forceinline__ bool wskip(int) const { return false; }
    __device__ __forceinline__ void apply(f32x16& p0, f32x16& p1, int t) const { const float NI = ninf_();
#pragma unroll
        for (int r = 0; r < 16; ++r) { const int key = 64 * t + crow(r, hi);
            p0[r] = (key <= tq) ? p0[r] * ex2((float)(tq - key) * lg) : 0.f; p1[r] = (key + 32 <= tq) ? p1[r] * ex2((float)(tq - key - 32) * lg) : 0.f; } } };
struct SelF { static constexpr int MODE = 0; static constexpr bool HAS_BIAS = false; unsigned long long umask, wmask, mymask; int tq, klo, hi;
    __device__ __forceinline__ bool skip(int t) const { return ((umask >> t) & 1ull) == 0ull; }
    __device__ __forceinline__ bool wskip(int t) const { return ((wmask >> t) & 1ull) == 0ull; }
    int tdiag, tlo;
    __device__ __forceinline__ void apply(f32x16& p0, f32x16& p1, int t) const { const float NI = ninf_(); const bool on = ((mymask >> t) & 1ull) != 0ull;
        if (t >= tdiag || t <= tlo) {
#pragma unroll
            for (int r = 0; r < 16; ++r) { const int key = 64 * t + crow(r, hi); if (!on || key > tq || key <= klo) p0[r] = NI; if (!on || key + 32 > tq || key + 32 <= klo) p1[r] = NI; }
        } else if (__builtin_amdgcn_ballot_w64(!on) != 0ull) {
#pragma unroll
            for (int r = 0; r < 16; ++r) { if (!on) { p0[r] = NI; p1[r] = NI; } }
        } } };
__device__ __forceinline__ void fox_unit(const Params& p, int idx, LAS unsigned char* lds, const int tid_in_) {
    int tid = tid_in_; asm volatile("" : "+v"(tid)); unsigned char* wsl_ = ws_late();
    const int lane = tid & 63, wid = tid >> 6, r32 = lane & 31, hi = lane >> 5;
    const int qb = 15 - idx / (BC * 4), bh = idx % (BC * 4), h = bh & 3, bl = bh >> 2;
    const bf16_t* proj = (const bf16_t*)(wsl_ + WS_R + R_PROJ);
    const int tq = qb * 256 + wid * 32 + r32; const size_t rowc = (size_t)bl * SEQ + tq;
    bf16x8 qf[4]; load_qf(qf, proj + rowc * PROJW + PC_FQ + h * 64, hi);
    f32x16 o[2]; o[0] = z16(); o[1] = z16(); float m = -INFINITY, l = 0.f;
    FoxF f; f.tq = tq; f.qmin = qb * 256; f.hi = hi;
    flash_loop(f, 0, 4 * qb + 4, proj + (size_t)bl * SEQ * PROJW + PC_FK + h * 64, proj + (size_t)bl * SEQ * PROJW + PC_FV + h * 64, PROJW,
               (const float*)(wsl_ + WS_R + R_CUM) + (size_t)bh * SEQ, qf, o, m, l, lds, tid);
    l = x32_sum(l); const float inv = 1.0f / l; o[0] *= inv; o[1] *= inv;
    store_ot(o, (bf16_t*)(wsl_ + WS_R + R_O) + (size_t)3 * MC * 256 + rowc * 256 + h * 64, hi);
}
__device__ __forceinline__ void rope8(float (&o1)[8], float (&o2)[8], const u32x4& a, const u32x4& b, const f32x2* tp) {
    const unsigned aa[4] = {a.x, a.y, a.z, a.w}, bb[4] = {b.x, b.y, b.z, b.w};
#pragma unroll
    for (int j = 0; j < 8; ++j) { const float x1 = (j & 1) ? __uint_as_float(aa[j >> 1] & 0xffff0000u) : __uint_as_float(aa[j >> 1] << 16);
        const float x2 = (j & 1) ? __uint_as_float(bb[j >> 1] & 0xffff0000u) : __uint_as_float(bb[j >> 1] << 16);
        const f32x2 cs = tp[j]; o1[j] = x1 * cs.x - x2 * cs.y; o2[j] = x1 * cs.y + x2 * cs.x; }
}
__device__ __forceinline__ u32x4 pack8f(const float (&v)[8]) { u32x4 w; w.x = pk2(v[0], v[1]); w.y = pk2(v[2], v[3]); w.z = pk2(v[4], v[5]); w.w = pk2(v[6], v[7]); return w; }
__device__ __forceinline__ void ret_kv_unit(const Params& p, int ch, int idx, LAS unsigned char* lds, const int tid_in_) {
    int tid = tid_in_; asm volatile("" : "+v"(tid)); unsigned char* wsl_ = ws_late();
    const int lane = tid & 63, wid = tid >> 6, hi = lane >> 5;
    const int n = idx & 31, bh = idx >> 5, h = bh & 3, bl = bh >> 2;
    const bf16_t* proj = (const bf16_t*)(wsl_ + WS_R + R_PROJ); const f32x2* tab = (const f32x2*)(wsl_ + WS_ROPE);
    const size_t rowc0 = (size_t)bl * SEQ + n * 128; const float lg = log2f(1.0f - exp2f(-5.0f - (float)h));
    LAS unsigned char* KZ = lds; LAS unsigned char* VT = lds + 16384;
    __syncthreads();
    { const int key = tid >> 2, cp = tid & 3; const bf16_t* src = proj + (rowc0 + key) * PROJW + PC_RK + h * 64 + cp * 8;
      const u32x4 a = *(const u32x4*)src, b = *(const u32x4*)(src + 32); float o1[8], o2[8];
      rope8(o1, o2, a, b, tab + ((size_t)ch * MC + rowc0 + key) * 32 + cp * 8);
      const float zt = ex2((float)(127 - key) * lg);
#pragma unroll
      for (int j = 0; j < 8; ++j) { o1[j] *= zt; o2[j] *= zt; }
      LAS unsigned char* d = KZ + (key >> 6) * 8192 + ((key & 63) >> 4) * 1024 + (key & 15) * 64 + cp * 16;
      *(LAS u32x4*)d = pack8f(o1); *(LAS u32x4*)(d + 4096) = pack8f(o2); }
#pragma unroll
    for (int t2 = 0; t2 < 2; ++t2)
        *(LAS u32x4*)(VT + t2 * 8192 + wid * 1024 + lane * 16) = *(const u32x4*)(proj + (rowc0 + 64 * t2 + 16 * (wid & 3) + (lane >> 2)) * PROJW + PC_RV + h * 64 + (wid >> 2) * 32 + (lane & 3) * 8);
    __syncthreads();
    if (wid < 4) { const int vt = wid >> 1, kt = wid & 1;
        const int fo = ((lane >> 4) & 1) * 32 + (lane & 3) * 8 + (4 * hi + ((lane & 15) >> 2)) * 64;
        f32x16 acc = z16();
#pragma unroll
        for (int t2 = 0; t2 < 2; ++t2)
#pragma unroll
            for (int ks = 0; ks < 4; ++ks) { const LAS unsigned char* va = VT + t2 * 8192 + vt * 4096 + ks * 1024 + fo; const LAS unsigned char* ka = KZ + t2 * 8192 + kt * 4096 + ks * 1024 + fo;
                const s16x4 v0 = vtr(va), v1 = vtr(va + 512), k0 = vtr(ka), k1 = vtr(ka + 512);
                acc = MF32(((bf16x8){v0[0], v0[1], v0[2], v0[3], v1[0], v1[1], v1[2], v1[3]}), ((bf16x8){k0[0], k0[1], k0[2], k0[3], k1[0], k1[1], k1[2], k1[3]}), acc); }
        float* kvt = (float*)(wsl_ + WS_R + R_KVT) + (size_t)idx * 4096;
#pragma unroll
        for (int r = 0; r < 16; ++r) kvt[(32 * vt + crow(r, hi)) * 64 + 32 * kt + (lane & 31)] = acc[r]; }
    __syncthreads();
}
__device__ __forceinline__ void ret_out_unit(const Params& p, int l_, int ch, int idx, LAS unsigned char* lds, const int tid_in_) {
    int tid = tid_in_; asm volatile("" : "+v"(tid)); unsigned char* wsl_ = ws_late();
    const int lane = tid & 63, wid = tid >> 6, r32 = lane & 31, hi = lane >> 5, gw = wid >> 2, wq = wid & 3;
    const int np = 15 - idx / (BC * 4), bh = idx % (BC * 4), h = bh & 3, bl = bh >> 2, n = 2 * np + gw;
    const bf16_t* proj = (const bf16_t*)(wsl_ + WS_R + R_PROJ); const f32x2* tab = (const f32x2*)(wsl_ + WS_ROPE);
    const float lg = log2f(1.0f - exp2f(-5.0f - (float)h));
    LAS unsigned char* KS = lds; LAS unsigned char* VS = lds + 32768; LAS unsigned char* RT = lds + 65536;
    const int tql = 32 * wq + r32; const size_t rowc = (size_t)bl * SEQ + n * 128 + tql;
    bf16x8 qf[4];
    { const bf16_t* qrow = proj + rowc * PROJW + PC_RQ + h * 64; const f32x2* tp = tab + ((size_t)ch * MC + rowc) * 32;
#pragma unroll
      for (int d0 = 0; d0 < 2; ++d0) { const u32x4 a = *(const u32x4*)(qrow + d0 * 16 + hi * 8), b = *(const u32x4*)(qrow + 32 + d0 * 16 + hi * 8); float o1[8], o2[8];
          rope8(o1, o2, a, b, tp + d0 * 16 + hi * 8); qf[d0] = __builtin_bit_cast(bf16x8, pack8f(o1)); qf[d0 + 2] = __builtin_bit_cast(bf16x8, pack8f(o2)); } }
    __syncthreads();
#pragma unroll
    for (int g = 0; g < 2; ++g) { const size_t r0 = (size_t)bl * SEQ + (2 * np + g) * 128;
        { const int key = tid >> 2, cp = tid & 3; const bf16_t* src = proj + (r0 + key) * PROJW + PC_RK + h * 64 + cp * 8;
          const u32x4 a = *(const u32x4*)src, b = *(const u32x4*)(src + 32); float o1[8], o2[8];
          rope8(o1, o2, a, b, tab + ((size_t)ch * MC + r0 + key) * 32 + cp * 8);
          LAS unsigned char* d = KS + (g * 2 + (key >> 6)) * 8192 + cp * 1024 + (key & 63) * 16;
          *(LAS u32x4*)d = pack8f(o1); *(LAS u32x4*)(d + 4096) = pack8f(o2); }
#pragma unroll
        for (int t2 = 0; t2 < 2; ++t2)
            *(LAS u32x4*)(VS + (g * 2 + t2) * 8192 + wid * 1024 + lane * 16) = *(const u32x4*)(proj + (r0 + 64 * t2 + 16 * (wid & 3) + (lane >> 2)) * PROJW + PC_RV + h * 64 + (wid >> 2) * 32 + (lane & 3) * 8); }
    { const int t = tid & 255; const float gdec = ex2(128.0f * lg); const float* kv0 = (const float*)(wsl_ + WS_R + R_KVT) + (size_t)(bh * 32) * 4096;
#pragma unroll
      for (int q = 0; q < 2; ++q) { const int task = t + 256 * q, v = task >> 3, kc = task & 7; f32x4 a0 = {0.f, 0.f, 0.f, 0.f}, a1 = {0.f, 0.f, 0.f, 0.f};
          int m = 0;
          for (; m + 8 <= n; m += 8) { f32x4 x0[8], x1[8];
#pragma unroll
              for (int q8 = 0; q8 < 8; ++q8) { const float* s = kv0 + (size_t)(m + q8) * 4096 + v * 64 + kc * 8; x0[q8] = *(const f32x4*)s; x1[q8] = *(const f32x4*)(s + 4); }
#pragma unroll
              for (int q8 = 0; q8 < 8; ++q8) { a0 = a0 * gdec + x0[q8]; a1 = a1 * gdec + x1[q8]; } }
          for (; m < n; ++m) { const float* s = kv0 + (size_t)m * 4096 + v * 64 + kc * 8; a0 = a0 * gdec + *(const f32x4*)s; a1 = a1 * gdec + *(const f32x4*)(s + 4); }
          *(LAS u32x4*)(RT + gw * 8192 + kc * 1024 + v * 16) = pack8(a0, a1); } }
    __syncthreads();
    f32x16 o[2];
    { f32x16 p0, p1; attn_qkt(p0, p1, RT + gw * 8192, qf, r32, hi); const float xi = ex2((float)(tql + 1) * lg); o[0] = p0 * xi; o[1] = p1 * xi; }
    for (int kt = 0; kt <= (wq >> 1); ++kt) { f32x16 p0, p1; attn_qkt(p0, p1, KS + (gw * 2 + kt) * 8192, qf, r32, hi);
#pragma unroll
        for (int r = 0; r < 16; ++r) { const int key = 64 * kt + crow(r, hi);
            p0[r] = (key <= tql) ? p0[r] * ex2((float)(tql - key) * lg) : 0.f; p1[r] = (key + 32 <= tql) ? p1[r] * ex2((float)(tql - key - 32) * lg) : 0.f; }
        bf16x8 pw[4]; pw[0] = pack_acc8(p0, 0); pw[1] = pack_acc8(p0, 1); pw[2] = pack_acc8(p1, 0); pw[3] = pack_acc8(p1, 1);
        attn_pv(o, VS + (gw * 2 + kt) * 8192, pw, lane, hi); }
    float s = 0.f;
#pragma unroll
    for (int r = 0; r < 16; ++r) s += o[0][r] + o[1][r];
    s = x32_sum(s); const float mu = s * (1.0f / 64.0f); float q = 0.f;
#pragma unroll
    for (int r = 0; r < 16; ++r) { const float a = o[0][r] - mu, b = o[1][r] - mu; q += a * a + b * b; }
    q = x32_sum(q); const float rs = 1.0f / sqrtf(q * (1.0f / 64.0f) + LN_EPS);
    const float* gw_ = PIN(IN_RETGN) + l_ * 256 + h * 64; const bf16_t* grow = proj + rowc * PROJW + PC_RG + h * 64;
#pragma unroll
    for (int d0 = 0; d0 < 2; ++d0)
#pragma unroll
        for (int g = 0; g < 4; ++g) { const int d = 32 * d0 + 8 * g + 4 * hi; const u32x2 gz = *(const u32x2*)(grow + d); const f32x4 w4 = *(const f32x4*)(gw_ + d);
            const float gg[4] = {__uint_as_float(gz.x << 16), __uint_as_float(gz.x & 0xffff0000u), __uint_as_float(gz.y << 16), __uint_as_float(gz.y & 0xffff0000u)};
#pragma unroll
            for (int e = 0; e < 4; ++e) o[d0][4 * g + e] = (o[d0][4 * g + e] - mu) * rs * w4[e] * siluf_(gg[e]); }
    store_ot(o, (bf16_t*)(wsl_ + WS_R + R_O) + (size_t)1 * MC * 256 + rowc * 256 + h * 64, hi);
    __syncthreads();
}
constexpr int NL_KC = 36864, NL_VC = 69632, NL_IMPM = 102400, NL_IMPS = 118784, NL_SELM = 135424;
__device__ __forceinline__ void nsa_unit(const Params& p, int idx, LAS unsigned char* lds, const int tid_in_) {
    int tid = tid_in_; asm volatile("" : "+v"(tid)); unsigned char* wsl_ = ws_late();
    const int lane = tid & 63, wid = tid >> 6, r32 = lane & 31, hi = lane >> 5, tl = r32 >> 2, hd = r32 & 3;
    const int ib = 63 - idx / BC, bl = idx % BC;
    const bf16_t* proj = (const bf16_t*)(wsl_ + WS_R + R_PROJ); const float* sm = (const float*)(wsl_ + WS_R + R_SM);
    const int tokl = 8 * wid + tl, tq = ib * 64 + tokl; const size_t rowc = (size_t)bl * SEQ + tq;
    bf16x8 qf[4]; load_qf(qf, proj + rowc * PROJW + PC_NQ + hd * 64, hi);
    const float g0 = sigmoidf_(sm[rowc * 32 + 8 + hd * 3 + 0]), g1 = sigmoidf_(sm[rowc * 32 + 8 + hd * 3 + 1]), g2 = sigmoidf_(sm[rowc * 32 + 8 + hd * 3 + 2]);
    f32x16 of[2];
    const int ntc = min(3, (4 * ib + 2) >> 6) + 1;
    {
        const bf16_t* kc = (const bf16_t*)(wsl_ + WS_R + R_KCMP) + (size_t)bl * 256 * 64; const bf16_t* vc = kc + (size_t)BC * 256 * 64;
        __syncthreads();
        for (int tt = 0; tt < ntc; ++tt) {
            *(LAS u32x4*)(lds + NL_KC + tt * 8192 + wid * 1024 + lane * 16) = *(const u32x4*)(kc + (size_t)(tt * 64 + lane) * 64 + wid * 8);
            *(LAS u32x4*)(lds + NL_VC + tt * 8192 + wid * 1024 + lane * 16) = *(const u32x4*)(vc + (size_t)(tt * 64 + 16 * (wid & 3) + (lane >> 2)) * 64 + (wid >> 2) * 32 + (lane & 3) * 8); }
        __syncthreads();
        float m = -INFINITY, l = 0.f;
        for (int tt = 0; tt < ntc; ++tt) { f32x16 p0, p1; attn_qkt(p0, p1, lds + NL_KC + tt * 8192, qf, r32, hi);
#pragma unroll
            for (int r = 0; r < 16; ++r) { const int n0 = 64 * tt + crow(r, hi), n1 = n0 + 32; if (n0 >= 255 || 16 * n0 + 31 > tq) p0[r] = -INFINITY; if (n1 >= 255 || 16 * n1 + 31 > tq) p1[r] = -INFINITY; }
            float mt = p0[0];
#pragma unroll
            for (int r = 1; r < 16; ++r) mt = fmaxf(mt, p0[r]);
#pragma unroll
            for (int r = 0; r < 16; ++r) mt = fmaxf(mt, p1[r]);
            mt = x32_max(mt);
            const float mn = fmaxf(m, mt), ms = (mn == -INFINITY) ? 0.f : mn; float s = 0.f;
#pragma unroll
            for (int r = 0; r < 16; ++r) s += ex2(p0[r] - ms) + ex2(p1[r] - ms);
            l = l * ex2(m - ms) + s; m = mn; }
        l = x32_sum(l);
        const float inv = (l > 0.f) ? 1.0f / l : 0.f, ms = (m == -INFINITY) ? 0.f : m;
        LAS float* impm = (LAS float*)(lds + NL_IMPM); LAS float* imps = (LAS float*)(lds + NL_IMPS);
        f32x16 oc[2]; oc[0] = z16(); oc[1] = z16();
        for (int tt = 0; tt < ntc; ++tt) { f32x16 p0, p1; attn_qkt(p0, p1, lds + NL_KC + tt * 8192, qf, r32, hi);
#pragma unroll
            for (int r = 0; r < 16; ++r) { const int n0 = 64 * tt + crow(r, hi), n1 = n0 + 32;
                p0[r] = (n0 >= 255 || 16 * n0 + 31 > tq) ? 0.f : ex2(p0[r] - ms) * inv; p1[r] = (n1 >= 255 || 16 * n1 + 31 > tq) ? 0.f : ex2(p1[r] - ms) * inv; }
#pragma unroll
            for (int g = 0; g < 4; ++g) {
                float ma = p0[4 * g] + p0[4 * g + 1] + p0[4 * g + 2] + 0.5f * p0[4 * g + 3], sa = 0.5f * p0[4 * g + 3];
                float mb = p1[4 * g] + p1[4 * g + 1] + p1[4 * g + 2] + 0.5f * p1[4 * g + 3], sb = 0.5f * p1[4 * g + 3];
                ma += swz_xor<1>(ma); ma += swz_xor<2>(ma); sa += swz_xor<1>(sa); sa += swz_xor<2>(sa);
                mb += swz_xor<1>(mb); mb += swz_xor<2>(mb); sb += swz_xor<1>(sb); sb += swz_xor<2>(sb);
                if (hd == 0) { const int ja = 16 * tt + 2 * g + hi, jb = ja + 8;
                    impm[tokl * 64 + ja] = ma; imps[tokl * 65 + ja + 1] = sa; impm[tokl * 64 + jb] = mb; imps[tokl * 65 + jb + 1] = sb; } }
            bf16x8 pw[4]; pw[0] = pack_acc8(p0, 0); pw[1] = pack_acc8(p0, 1); pw[2] = pack_acc8(p1, 0); pw[3] = pack_acc8(p1, 1);
            attn_pv(oc, lds + NL_VC + tt * 8192, pw, lane, hi); }
        of[0] = oc[0] * g0; of[1] = oc[1] * g0;
        LAS unsigned long long* selm = (LAS unsigned long long*)(lds + NL_SELM);
        if (ib < 16) { if (lane < 8) selm[8 * wid + lane] = (2ull << ib) - 1ull; }
        else for (int t8 = 0; t8 < 8; ++t8) { const int tk = 8 * wid + t8; const int j = lane;
            float imp = (j < 16 * ntc) ? impm[tk * 64 + j] + ((j > 0) ? imps[tk * 65 + j] : 0.f) : 0.f;
            const bool forced = (j == 0) || (j == ib) || (j == ib - 1);
            const float score = forced ? 1.0e4f : ((j <= ib) ? imp : -1.0f);
            int rank = 0;
#pragma unroll
            for (int jj = 0; jj < 64; ++jj) { const float sj = __uint_as_float(__builtin_amdgcn_readlane(__float_as_uint(score), jj)); rank += ((sj > score) || (sj == score && jj < j)) ? 1 : 0; }
            const unsigned long long mk = __ballot((rank < 16) && (j <= ib));
            if (lane == 0) selm[tk] = mk; }
    }
    __syncthreads();
    unsigned long long mymask, umask, wmask;
    { const LAS unsigned long long* selm = (const LAS unsigned long long*)(lds + NL_SELM); mymask = selm[tokl];
      unsigned long long u = selm[lane]; unsigned lo = (unsigned)u, hi32 = (unsigned)(u >> 32);
      lo |= swz_xor_u<1>(lo); lo |= swz_xor_u<2>(lo); lo |= swz_xor_u<4>(lo); lo |= swz_xor_u<8>(lo); lo |= swz_xor_u<16>(lo); lo = x32_or(lo);
      hi32 |= swz_xor_u<1>(hi32); hi32 |= swz_xor_u<2>(hi32); hi32 |= swz_xor_u<4>(hi32); hi32 |= swz_xor_u<8>(hi32); hi32 |= swz_xor_u<16>(hi32); hi32 = x32_or(hi32);
      umask = ((unsigned long long)hi32 << 32) | lo; umask = __builtin_amdgcn_readfirstlane((unsigned)umask) | ((unsigned long long)__builtin_amdgcn_readfirstlane((unsigned)(umask >> 32)) << 32);
      unsigned wl = 0u, wh = 0u;
#pragma unroll
      for (int t8 = 0; t8 < 8; ++t8) { const unsigned long long mk = selm[8 * wid + t8]; wl |= (unsigned)mk; wh |= (unsigned)(mk >> 32); }
      wmask = (unsigned long long)(unsigned)__builtin_amdgcn_readfirstlane((int)wl) | ((unsigned long long)(unsigned)__builtin_amdgcn_readfirstlane((int)wh) << 32); }
    for (int br = 0; br < 2; ++br) {
        f32x16 o[2]; o[0] = z16(); o[1] = z16(); float m = -INFINITY, l = 0.f;
        SelF f; f.umask = br ? ~0ull : umask; f.wmask = br ? ~0ull : wmask; f.mymask = br ? ~0ull : mymask; f.tq = tq; f.klo = br ? tq - 512 : -1; f.hi = hi; f.tdiag = ib; f.tlo = br ? (ib * 64 + 63 - 512) / 64 : -1;
        const bf16_t* nkv2 = (const bf16_t*)(ws_late() + WS_R + R_NKV);
        flash_loop(f, br ? max(0, ib - 8) : 0, ib + 1, nkv2 + (size_t)(2 + 2 * br) * (NKV_SEG / 2) + (size_t)bl * SEQ * 64, nkv2 + (size_t)(3 + 2 * br) * (NKV_SEG / 2) + (size_t)bl * SEQ * 64, 64, nullptr, qf, o, m, l, lds, tid);
        l = x32_sum(l); const float sc = (l > 0.f) ? (br ? g2 : g1) / l : 0.f; of[0] += o[0] * sc; of[1] += o[1] * sc;
    }
    store_ot(of, (bf16_t*)(ws_late() + WS_R + R_O) + (size_t)2 * MC * 256 + rowc * 256 + hd * 64, hi);
}

constexpr int LDS_MISC = LDS_BYTES - 256;
constexpr size_t LWS = ((LW_BYTES + MiB - 1) / MiB) * MiB;
#define PHASE_PRE const int tid = fresh_tid(); int l, ch; { int k_; bool b_; step_decode(__builtin_amdgcn_readfirstlane(((volatile LAS int*)lds_at(LDS_MISC + 176))[0]), k_, l, ch, b_); } \
    Params p; ptab_load(p); LAS unsigned char* lds = lds_at(0); const int G = NWG; \
    const int c = __builtin_amdgcn_readfirstlane(((volatile LAS int*)(lds + LDS_MISC + 176))[2]); (void)lds; (void)G; (void)c; (void)l; (void)ch; \
    volatile LAS int* qslot = (volatile LAS int*)(lds + LDS_MISC + 16); (void)qslot;
#define LW_ (p.ws + WS_W + (size_t)l * LWS)
#define LWO_ ((unsigned)(WS_W + (size_t)l * LWS))
#define HC_ ((unsigned)(WS_H + (size_t)ch * MC * 1024 * 2))
#define QCTR_ ((unsigned*)(p.ws + WS_CTL) + CW_Q + 64 * ((l * NCHUNK + ch) * 8) + 8192 * __builtin_amdgcn_readfirstlane(((volatile LAS int*)lds_at(LDS_MISC + 176))[3]))
__device__ __forceinline__ int tid_out(int t) { asm volatile("" : "+v"(t)); return t; }
__device__ __forceinline__ int fresh_tid() {
    LAS unsigned* ctr = (LAS unsigned*)lds_at(LDS_MISC + 192);
    unsigned z = 0u; asm volatile("" : "+v"(z));
    const int lane = (int)__builtin_amdgcn_mbcnt_hi(~0u, __builtin_amdgcn_mbcnt_lo(~0u, z));
    unsigned t = 0u; if (lane == 0) t = __hip_atomic_fetch_add(ctr, 1u, __ATOMIC_RELAXED, __HIP_MEMORY_SCOPE_WORKGROUP);
    t = (unsigned)__builtin_amdgcn_readfirstlane((int)t);
    __syncthreads();
    return (int)(((t & 7u) << 6) | (unsigned)lane);
}
__device__ __forceinline__ void step_decode(int s, int& k, int& l, int& ch, bool& bar);
#define GCTR_(j) ((unsigned*)(p.ws + WS_CTL) + CW_G + 64 * ((l * NCHUNK + ch) * 8 + (j)) + 16384 * __builtin_amdgcn_readfirstlane(((volatile LAS int*)lds_at(LDS_MISC + 176))[3]))
#define PHFN(name) static __device__ __noinline__ void name()
#define PHFI(name) static __device__ __forceinline__ void name()

PHFI(ph_p0) { PHASE_PRE
    constexpr int N_ADA = 192, N_CB = 4, N_ROPE = MTOK * 32 / 4096, N_T = 2 * TJ_TOTAL;
    for (int it = c; it < N_ADA + N_CB + N_ROPE; it += G) {
        if (it < N_ADA) p0_ada(p, it, (LAS float*)lds, tid);
        else if (it < N_ADA + N_CB) p0_cbias(p, it - N_ADA, (LAS float*)lds, tid);
        else p0_rope(p, it - N_ADA - N_CB, tid);
    }
    for (int it = c; it < N_T; it += 4 * G) p0_transpose4(p, it, G, N_T, (LAS float*)lds, tid);
}
PHFN(ph_p1) { PHASE_PRE prep_first(p, tid, c); }
PHFI(ph_a1) { PHASE_PRE
    DenseSched S; S.A = HC_; S.Bt = LWO_ + (unsigned)LW_WIN; S.tA = 256u * 1024 * 2; S.tB = 256u * 1024 * 2; S.aBr = 0; S.nM = MC / 256; S.nN = NPROJ / 256; S.G = G; S.c = c; S.pnShift = 0; S.ctr = GCTR_(0);
    EpiProj E;
    pg8::gemm_phase<EpiProj, DenseSched, true, false>(lds, 1024, 1024, 1024, S, E, tid, (const char*)p.ws);
}
PHFN(ph_a2a) { PHASE_PRE
    if (c < 2 * BC) {
        const int which = c & 1, bl = c >> 1;
        OneSched S; S.has = true; S.u0.pm = bl; S.u0.pn = 0; S.u0.aux = which; S.u0.nvalid = 256; S.u0.rows = 0u;
        S.u0.a = (unsigned)(WS_R + R_NKV + (size_t)which * NKV_SEG + (size_t)bl * SEQ * 64 * 2); S.u0.b = LWO_ + (unsigned)(LW_CW1 + (size_t)which * 256 * 2048 * 2);
        EpiH1 E; E.h1 = (bf16_t*)(p.ws + WS_R + R_H1); E.cbias = (const float*)(p.ws + WS_CBIAS) + l * 512;
        pg8::gemm_phase<EpiH1, OneSched, true, false>(lds, 2048, 1024, 2048, S, E, tid, (const char*)p.ws);
        VM_WAIT(); __syncthreads(); __builtin_amdgcn_fence(__ATOMIC_ACQUIRE, "agent"); VM_WAIT(); __syncthreads();
    }
}
PHFN(ph_a2b) { PHASE_PRE
    if (c < 2 * BC) {
        const int which = c & 1, bl = c >> 1;
        OneSched S2; S2.has = true; S2.u0.pm = bl; S2.u0.pn = 0; S2.u0.aux = which; S2.u0.nvalid = 256; S2.u0.rows = 0u;
        S2.u0.a = (unsigned)(WS_R + R_H1 + ((size_t)which * BC * 256 + (size_t)bl * 256) * 256 * 2); S2.u0.b = LWO_ + (unsigned)(LW_CW2 + (size_t)which * 256 * 256 * 2);
        EpiCmp2 E2; E2.kc = (bf16_t*)(p.ws + WS_R + R_KCMP);
        pg8::gemm_phase<EpiCmp2, OneSched, true, false>(lds, 256, 256, 256, S2, E2, tid, (const char*)p.ws);
    }
}
PHFI(ph_a2c) { PHASE_PRE
    unsigned* qc = QCTR_ + 0; const int NU = BC * 4 * 64;
    int u = q_next(qc, qslot, tid), un = q_next(qc, qslot, tid);
    GdnRaw ga; if (u < NU) gdn_prep_load(ga, u, tid);
    while (u < NU) {
        int tk = 0x3fffffff; if (tid == 0) tk = (int)__hip_atomic_fetch_add(qc, 1u, __ATOMIC_RELAXED, __HIP_MEMORY_SCOPE_AGENT);
        GdnRaw gn = ga; if (un < NU) gdn_prep_load(gn, un, tid);
        gdn_prep_unit(p, l, u, lds, tid, ga);
        if (tid == 0) *qslot = tk;
        __syncthreads();
        const int unn = *qslot;
        __syncthreads();
        u = un; un = unn; ga = gn;
    }
}
PHFN(ph_a2d) { PHASE_PRE
    for (;;) { const int u = q_next(QCTR_ + 64, qslot, tid); if (u >= BC * 4) break; fox_cum_item(p, l, u, (LAS float*)lds, tid); }
    for (;;) { const int u = q_next(QCTR_ + 320, qslot, tid); if (u >= BC * 4 * 32) break; ret_kv_unit(p, ch, u, lds, tid); }
}
PHFN(ph_a3a) { PHASE_PRE if (c < BC * 4) gdn_scan_item(p, l, ch, c, lds, tid); }
PHFI(ph_a3b) { PHASE_PRE for (;;) { const int u = q_next(QCTR_ + 128, qslot, tid); if (u >= BC * 4 * 16) break; fox_unit(p, u, lds, tid); } }
PHFI(ph_a3c) { PHASE_PRE for (;;) { const int u = q_next(QCTR_ + 192, qslot, tid); if (u >= BC * 4 * 16) break; ret_out_unit(p, l, ch, u, lds, tid); } }
PHFI(ph_a3d) { PHASE_PRE for (;;) { const int u = q_next(QCTR_ + 256, qslot, tid); if (u >= BC * 64) break; nsa_unit(p, u, lds, tid); } }
PHFN(ph_a5) { PHASE_PRE
    DenseSched S; S.A = (unsigned)(WS_R + R_O); S.Bt = LWO_ + (unsigned)LW_BPT; S.tA = 256u * 256 * 2; S.tB = 256u * 256 * 2; S.aBr = (unsigned)((size_t)MC * 256 * 2); S.nM = MC / 256; S.nN = 16; S.G = G; S.c = c; S.pnShift = 2; S.ctr = GCTR_(1);
    EpiP E;
    pg8::gemm_phase<EpiP, DenseSched, true, false>(lds, 256, 256, 256, S, E, tid, (const char*)p.ws);
}
PHFI(ph_a6) { PHASE_PRE
    DenseSched S; S.A = (unsigned)(WS_H8 + (size_t)ch * MC * 1024); S.Bt = LWO_ + (unsigned)LW_WGV; S.tA = 256u * 1024; S.tB = 256u * 1024; S.aBr = 0; S.nM = MC / 256; S.nN = 16; S.G = G; S.c = c; S.pnShift = 0; S.ctr = GCTR_(2);
    EpiGate E;
    pg8::gemm_phase<EpiGate, DenseSched, true, false, true>(lds, 1024, 1024, 1024, S, E, tid, (const char*)p.ws);
}
PHFN(ph_a7) { PHASE_PRE
    DenseSched S; S.A = (unsigned)(WS_R + R_Y); S.Bt = LWO_ + (unsigned)LW_WOT; S.tA = 256u * 1024 * 2; S.tB = 256u * 1024 * 2; S.aBr = 0; S.nM = MC / 256; S.nN = 4; S.G = G; S.c = c; S.pnShift = 0; S.ctr = GCTR_(3);
    EpiOut E; E.row_base = ch * MC;
    pg8::gemm_phase<EpiOut, DenseSched, true, false>(lds, 1024, 1024, 1024, S, E, tid, (const char*)p.ws);
}
PHFN(ph_b0) { PHASE_PRE prep_moe(p, l, (LAS float*)lds, tid, c); }
__device__ __forceinline__ void moe_tables(const Params& p, int l, LAS int* mcnt, LAS int* mpre, const int tid) {
    __syncthreads();
    if (tid < 16) mcnt[tid] = (int)((unsigned*)(p.ws + WS_CTL))[CW_CNT + l * 64 + tid];
    __syncthreads();
    if (tid == 0) { int s = 0; for (int e = 0; e < 16; ++e) { mpre[e] = s; s += (mcnt[e] + 255) >> 8; } mpre[16] = s; }
    __syncthreads();
}
PHFI(ph_b1) { PHASE_PRE
    LAS int* mcnt = (LAS int*)(lds + LDS_MISC + 32); LAS int* mpre = mcnt + 16; moe_tables(p, l, mcnt, mpre, tid);
    MoeSched S; S.pre = mpre; S.cnt = mcnt; S.wsb = (const char*)p.ws; S.A = (unsigned)WS_H; S.W = LWO_ + (unsigned)LW_W13;
    S.wE = 1024u * 1024 * 2; S.wT = 256u * 1024 * 2; S.aT = 0; S.G = G; S.c = c; S.gatherA = true; S.ctr = GCTR_(4);
    EpiMoe1 E;
    pg8::gemm_phase<EpiMoe1, MoeSched, true, true>(lds, 1024, 1024, 1024, S, E, tid, (const char*)p.ws);
}
PHFN(ph_b2) { PHASE_PRE
    LAS int* mcnt = (LAS int*)(lds + LDS_MISC + 32); LAS int* mpre = mcnt + 16; moe_tables(p, l, mcnt, mpre, tid);
    MoeSched S; S.pre = mpre; S.cnt = mcnt; S.wsb = (const char*)p.ws; S.A = (unsigned)(WS_R + R_HID); S.W = LWO_ + (unsigned)LW_W2;
    S.wE = 1024u * 512 * 2; S.wT = 256u * 512 * 2; S.aT = 256u * 512 * 2; S.G = G; S.c = c; S.gatherA = false; S.ctr = GCTR_(5);
    EpiMoe2 E;
    pg8::gemm_phase<EpiMoe2, MoeSched, true, false>(lds, 512, 512, 512, S, E, tid, (const char*)p.ws);
}
PHFN(ph_b3) { PHASE_PRE prep_next(p, l, l == DEPTH - 1, tid, c); }

constexpr int STEPS_CHUNK = 12, STEPS_LAYER = NCHUNK * STEPS_CHUNK + 4, N_STEPS = 2 + DEPTH * STEPS_LAYER;
__device__ __forceinline__ void step_decode(int s, int& k, int& l, int& ch, bool& bar) {
    if (s < 2) { k = s; l = 0; ch = 0; bar = true; return; }
    const int t = s - 2; l = t / STEPS_LAYER; const int r = t % STEPS_LAYER;
    if (r < NCHUNK * STEPS_CHUNK) { ch = r / STEPS_CHUNK; const int q = r % STEPS_CHUNK; k = 2 + q; bar = !(q == 1 || q == 2 || q == 3 || q == 5 || q == 6 || q == 7); }
    else { ch = 0; k = 14 + (r - NCHUNK * STEPS_CHUNK); bar = true; }
}
__global__ void __launch_bounds__(NTHR, 2) __attribute__((disable_tail_calls)) mega_fwd(Params p0_) {
    LAS unsigned char* lds = lds_at(0);
    const int tid = threadIdx.x;
    volatile LAS unsigned* xbw = (volatile LAS unsigned*)(lds + LDS_MISC);
    volatile LAS int* st = (volatile LAS int*)(lds + LDS_MISC + 176);
    if (tid == 0) { xbw[0] = 0u; xbw[1] = 0u; xbw[2] = 0u; xbw[3] = 0u; st[0] = p0_.ph_lo; st[1] = p0_.ph_hi; st[2] = blockIdx.x; st[3] = 0; *(volatile LAS unsigned*)(lds + LDS_MISC + 200) = 0u; *(volatile LAS unsigned*)(lds + LDS_MISC + 192) = 0u; }
    ptab_store(p0_, tid);
    __syncthreads();
    (void)xcd_barrier_post((unsigned*)(p0_.ws + WS_CTL) + CW_BAR, xbw, tid);
#ifdef PROBE_CLOCK
    if (tid == 0) { volatile LAS unsigned long long* tc_ = (volatile LAS unsigned long long*)(lds + LDS_MISC + 216); tc_[0] = __builtin_amdgcn_s_memrealtime(); tc_[1] = __builtin_amdgcn_s_memtime(); }
#endif
    for (;;) {
        {
          LAS unsigned char* mb_ = lds_at(LDS_MISC); volatile LAS int* st_ = (volatile LAS int*)(mb_ + 176);
          const int s = __builtin_amdgcn_readfirstlane(st_[0]), e = __builtin_amdgcn_readfirstlane(st_[1]);
          if (s >= e) break;
          int k, l, ch; bool bar; step_decode(s, k, l, ch, bar);
#ifdef PROBE_STEPTIME
          if (threadIdx.x == 0) { volatile LAS unsigned long long* tp_ = (volatile LAS unsigned long long*)(mb_ + 208); tp_[0] = __builtin_amdgcn_s_memrealtime(); }
#endif
          (void)k; }
#define CUR_K_() ([&]() { int k_, l_, c_; bool b_; step_decode(__builtin_amdgcn_readfirstlane(((volatile LAS int*)(lds_at(LDS_MISC) + 176))[0]), k_, l_, c_, b_); return k_; }())
        if (CUR_K_() == 0) ph_p0();
        if (CUR_K_() == 1) ph_p1();
        if (CUR_K_() == 2) ph_a1();
        if (CUR_K_() == 3) ph_a2a();
        if (CUR_K_() == 4) ph_a2b();
        if (CUR_K_() == 5) ph_a2c();
        if (CUR_K_() == 6) ph_a2d();
        if (CUR_K_() == 7) ph_a3a();
        if (CUR_K_() == 8) ph_a3b();
        if (CUR_K_() == 9) ph_a3c();
        if (CUR_K_() == 10) ph_a3d();
        if (CUR_K_() == 11) ph_a5();
        if (CUR_K_() == 12) ph_a6();
        if (CUR_K_() == 13) ph_a7();
        if (CUR_K_() == 14) ph_b0();
        if (CUR_K_() == 15) ph_b1();
        if (CUR_K_() == 16) ph_b2();
        if (CUR_K_() == 17) ph_b3();
#ifdef PROBE_STEPTIME
        { LAS unsigned char* mb2_ = lds_at(LDS_MISC); const int s2_ = __builtin_amdgcn_readfirstlane(((volatile LAS int*)(mb2_ + 176))[0]); int k2_, l2_, c2_; bool b2_; step_decode(s2_, k2_, l2_, c2_, b2_);
          __syncthreads();
          if (threadIdx.x == 0 && ((PROBE_STEPTIME >> k2_) & 1)) { volatile LAS unsigned long long* tp_ = (volatile LAS unsigned long long*)(mb2_ + 208); volatile LAS unsigned* ac_ = (volatile LAS unsigned*)(mb2_ + 200);
              ac_[0] = ac_[0] + (unsigned)(__builtin_amdgcn_s_memrealtime() - tp_[0]); } }
#endif
        { const int tid = fresh_tid(); LAS unsigned char* mb_ = lds_at(LDS_MISC); volatile LAS int* st_ = (volatile LAS int*)(mb_ + 176);
          volatile LAS unsigned* xbw_ = (volatile LAS unsigned*)mb_;
          const int s = __builtin_amdgcn_readfirstlane(st_[0]), e = __builtin_amdgcn_readfirstlane(st_[1]);
          int k, l, ch; bool bar; step_decode(s, k, l, ch, bar);
#ifdef DUP_MASK
          const bool adv_ = !(((DUP_MASK >> k) & 1) && __builtin_amdgcn_readfirstlane(st_[3]) == 0);
#else
          const bool adv_ = true;
#endif
          if (adv_ && bar && s + 1 < e) { XcdBarrier b; b.bar = (unsigned*)((unsigned char*)ptab_get(28) + WS_CTL) + CW_BAR; b.x = xb_xcc_id(); b.st = xbw_;
#ifdef PROBE_BARWAIT
              __syncthreads(); const unsigned long long t0_ = __builtin_amdgcn_s_memrealtime();
              xcd_barrier(b, tid);
              const unsigned long long t1_ = __builtin_amdgcn_s_memrealtime(); if (tid == 0) { volatile LAS unsigned* ac_ = (volatile LAS unsigned*)(mb_ + 200); ac_[0] = ac_[0] + (unsigned)(t1_ - t0_); }
#else
              xcd_barrier(b, tid);
#endif
          }
          __syncthreads();
#ifdef DUP_MASK
          const int rp = __builtin_amdgcn_readfirstlane(st_[3]);
          if (((DUP_MASK >> k) & 1) && rp == 0) { if (tid == 0) st_[3] = 1; }
          else { if (tid == 0) { st_[3] = 0; st_[0] = s + 1; } }
#else
          if (tid == 0) st_[0] = s + 1;
#endif
          __syncthreads(); }
    }
#ifdef PROBE_CLOCK
    { volatile LAS unsigned long long* tc_ = (volatile LAS unsigned long long*)(lds_at(LDS_MISC) + 216); const unsigned long long r1 = __builtin_amdgcn_s_memrealtime(), c1 = __builtin_amdgcn_s_memtime();
      const unsigned long long dr = r1 - tc_[0], dc = c1 - tc_[1];
      const unsigned long long w = dc / 24ull; const unsigned long long t0_ = __builtin_amdgcn_s_memrealtime();
      while (__builtin_amdgcn_s_memrealtime() - t0_ < w) __builtin_amdgcn_s_sleep(8); (void)dr; }
#endif
#if defined(PROBE_BARWAIT) || defined(PROBE_STEPTIME)
    { const unsigned w_ = *(volatile LAS unsigned*)(lds_at(LDS_MISC) + 200); const unsigned long long t0_ = __builtin_amdgcn_s_memrealtime();
      while (__builtin_amdgcn_s_memrealtime() - t0_ < (unsigned long long)w_) __builtin_amdgcn_s_sleep(8); }
#endif
}

extern "C" void kernel_launch(void* const* d_in, const int* in_sizes, int n_in, void* d_out, int out_size, void* d_ws, size_t ws_size, hipStream_t stream) {
    (void)in_sizes; (void)out_size;
    if (n_in < 27 || ws_size < WS_END) { fprintf(stderr, "kernel_launch: unexpected inputs (n_in %d, ws %zu < %zu)\n", n_in, ws_size, (size_t)WS_END); return; }
    static bool attr_set = false;
    if (!attr_set) { (void)hipFuncSetAttribute((const void*)mega_fwd, hipFuncAttributeMaxDynamicSharedMemorySize, LDS_BYTES); attr_set = true; }
    Params p{};
    for (int i = 0; i < 27; ++i) p.in[i] = (const float*)d_in[i];
    p.out = (float*)d_out; p.ws = (unsigned char*)d_ws;
    (void)hipMemsetAsync((unsigned char*)d_ws + WS_CTL, 0, CTL_BYTES, stream);
#ifndef MK_CUTS
    p.ph_lo = 0; p.ph_hi = N_STEPS;
    hipLaunchKernelGGL(mega_fwd, dim3(NWG), dim3(NTHR), LDS_BYTES, stream, p);
#else
    { static const int cuts[] = {MK_CUTS, N_STEPS}; int lo = 0;
      for (unsigned i = 0; i < sizeof(cuts) / sizeof(cuts[0]); ++i) { p.ph_lo = lo; p.ph_hi = cuts[i]; lo = cuts[i]; hipLaunchKernelGGL(mega_fwd, dim3(NWG), dim3(NTHR), LDS_BYTES, stream, p); } }
#endif
}
```

```cpp
#include <hip/hip_runtime.h>
#include <stdint.h>
#include <stdio.h>

#define GAS __attribute__((address_space(1)))
#define LAS __attribute__((address_space(3)))
typedef unsigned short bf16_t;
typedef short bf16x8 __attribute__((ext_vector_type(8)));
typedef short s16x4 __attribute__((ext_vector_type(4)));
typedef float f32x2 __attribute__((ext_vector_type(2)));
typedef float f32x4 __attribute__((ext_vector_type(4)));
typedef float f32x16 __attribute__((ext_vector_type(16)));
typedef unsigned u32x2 __attribute__((ext_vector_type(2)));
typedef unsigned u32x4 __attribute__((ext_vector_type(4)));
typedef __bf16 bf16x2_t __attribute__((ext_vector_type(2)));

constexpr int D_MODEL = 1024, BATCH = 16, SEQ = 4096, DEPTH = 2, MTOK = BATCH * SEQ;
constexpr int NCHUNK = 2, BC = BATCH / NCHUNK, MC = BC * SEQ;
constexpr int NPROJ = 3584, PROJW = 3072;
constexpr float DN_ALPHA = 1.4142135623730951f;
constexpr float LN_EPS = 1e-5f;
constexpr float LOG2E = 1.4426950408889634f;
constexpr float QSCALE = 0.125f * 1.4426950408889634f;
constexpr int NWG = 256, NTHR = 512;
constexpr int LDS_BYTES = 163840;

constexpr int PC_GQ = 0, PC_GK = 256, PC_GV = 512, PC_GZ = 768, PC_RQ = 1024, PC_RK = 1280, PC_RV = 1536, PC_RG = 1792, PC_NQ = 2048, PC_FQ = 2304, PC_FK = 2560, PC_FV = 2816;

constexpr size_t MiB = 1ull << 20;
constexpr size_t WS_CTL = 0;
constexpr size_t CTL_BYTES = 1 * MiB;
constexpr size_t WS_MOD = 1 * MiB;
constexpr size_t WS_ROPE = 2 * MiB;
constexpr size_t WS_STATS = 18 * MiB;
constexpr size_t WS_CBIAS = 19 * MiB;
constexpr size_t WS_W = 20 * MiB;
constexpr size_t LW_WIN = 0;
constexpr size_t LW_WGV = LW_WIN + (size_t)NPROJ * 1024 * 2;
constexpr size_t LW_BPT = LW_WGV + (size_t)4096 * 1024 * 2;
constexpr size_t LW_WOT = LW_BPT + (size_t)4096 * 256 * 2;
constexpr size_t LW_W13 = LW_WOT + (size_t)1024 * 1024 * 2;
constexpr size_t LW_W2 = LW_W13 + (size_t)16 * 1024 * 1024 * 2;
constexpr size_t LW_CW1 = LW_W2 + (size_t)16 * 1024 * 512 * 2;
constexpr size_t LW_CW2 = LW_CW1 + (size_t)2 * 256 * 2048 * 2;
constexpr size_t LW_BYTES = LW_CW2 + (size_t)2 * 256 * 256 * 2;
constexpr size_t WS_H = WS_W + 2 * ((LW_BYTES + MiB - 1) / MiB) * MiB;
constexpr size_t WS_R = WS_H + 128 * MiB;
constexpr size_t R_PROJ = 0;
constexpr size_t R_GDN = R_PROJ + (size_t)MC * PROJW * 2;
constexpr size_t GDN_UNIT_BYTES = 5 * 8192;
constexpr size_t R_P = 0;
constexpr size_t R_NKV = R_GDN + (size_t)BC * 4 * 64 * GDN_UNIT_BYTES;
constexpr size_t NKV_SEG = (size_t)(MC + 64) * 64 * 2;
constexpr size_t R_SM = R_NKV + 6 * NKV_SEG;
constexpr size_t R_CUM = R_SM + (size_t)MC * 32 * 4;
constexpr size_t R_GG = R_CUM + (size_t)BC * 4 * 4096 * 4;
constexpr size_t R_KCMP = R_GG + (size_t)BC * 4 * 64 * 4 + 768;
constexpr size_t R_H1 = R_KCMP + (size_t)2 * BC * 256 * 64 * 2;
constexpr size_t R_O = R_H1 + (size_t)2 * BC * 256 * 256 * 2;
constexpr size_t R_Y = R_O + (size_t)4 * MC * 256 * 2;
constexpr size_t R_KVT = R_Y + (size_t)MC * 1024 * 2;
constexpr size_t R_MIX_END = R_KVT + (size_t)BC * 4 * 32 * 4096 * 4;
static_assert(R_NKV >= (size_t)MC * 4096 * 2, "P overlay fits under PROJ+GDN");
constexpr size_t R_LIST = 0;
constexpr size_t R_CW = R_LIST + (size_t)16 * MTOK * 4;
constexpr size_t R_HID = R_CW + (size_t)16 * MTOK * 4;
constexpr size_t R_OUT2 = R_HID + (size_t)(2 * MTOK + 4096) * 512 * 2;
constexpr size_t R_MOE_END = R_OUT2 + (size_t)2 * MTOK * 1024 * 2;
constexpr size_t WS_T = WS_R + (((R_MIX_END > R_MOE_END ? R_MIX_END : R_MOE_END) + MiB - 1) / MiB) * MiB;
constexpr size_t WS_H8 = WS_T + (size_t)MTOK * 1024 * 2;
constexpr size_t WS_END = WS_H8 + (size_t)MTOK * 1024;
constexpr float H8_SCALE = 16.0f, W8_SCALE = 256.0f, F8_DESCALE = 1.0f / (16.0f * 256.0f), Y8_SCALE = 64.0f, Y8_DESCALE = 1.0f / (64.0f * 256.0f);

constexpr int CW_BAR = 4096;
constexpr int CW_CNT = 8192;
constexpr int CW_Q = 8448;
constexpr int CW_G = 65536;

__device__ __forceinline__ float bf2f(bf16_t v) { return __uint_as_float(((unsigned)v) << 16); }
__device__ __forceinline__ unsigned pk2(float lo, float hi) { f32x2 v = {lo, hi}; bf16x2_t b = __builtin_convertvector(v, bf16x2_t); return __builtin_bit_cast(unsigned, b); }
__device__ __forceinline__ float clamp8(float x) { return fminf(fmaxf(x, -448.0f), 448.0f); }
__device__ __forceinline__ unsigned pk4_fp8(float a, float b, float c, float d) { int v = __builtin_amdgcn_cvt_pk_fp8_f32(clamp8(a), clamp8(b), 0, false); v = __builtin_amdgcn_cvt_pk_fp8_f32(clamp8(c), clamp8(d), v, true); return (unsigned)v; }
__device__ __forceinline__ bf16_t f2bf(float f) { return (bf16_t)(pk2(f, 0.f) & 0xffffu); }
__device__ __forceinline__ float ex2(float x) { return __builtin_amdgcn_exp2f(x); }
__device__ __forceinline__ float sigmoidf_(float x) { return __builtin_amdgcn_rcpf(1.0f + __expf(-x)); }
__device__ __forceinline__ float siluf_(float x) { return x * __builtin_amdgcn_rcpf(1.0f + __expf(-x)); }
__device__ __forceinline__ int crow(int r, int hi) { return (r & 3) + 8 * (r >> 2) + 4 * hi; }
template <int M> __device__ __forceinline__ float swz_xor(float v) { return __builtin_bit_cast(float, __builtin_amdgcn_ds_swizzle(__builtin_bit_cast(int, v), 0x1f | (M << 10))); }
template <int M> __device__ __forceinline__ unsigned swz_xor_u(unsigned v) { return (unsigned)__builtin_amdgcn_ds_swizzle((int)v, 0x1f | (M << 10)); }
__device__ __forceinline__ float x32_sum(float v) { auto r = __builtin_amdgcn_permlane32_swap(__float_as_uint(v), __float_as_uint(v), false, false); return __uint_as_float(r[0]) + __uint_as_float(r[1]); }
__device__ __forceinline__ float x32_max(float v) { auto r = __builtin_amdgcn_permlane32_swap(__float_as_uint(v), __float_as_uint(v), false, false); return fmaxf(__uint_as_float(r[0]), __uint_as_float(r[1])); }
__device__ __forceinline__ unsigned x32_or(unsigned v) { auto r = __builtin_amdgcn_permlane32_swap(v, v, false, false); return r[0] | r[1]; }
__device__ __forceinline__ float shfl_up_l(float v, int o, int lane) { return __builtin_bit_cast(float, __builtin_amdgcn_ds_bpermute((lane - o) << 2, __builtin_bit_cast(int, v))); }
__device__ __forceinline__ float wave_sum(float v) {
    v += swz_xor<1>(v); v += swz_xor<2>(v); v += swz_xor<4>(v); v += swz_xor<8>(v); v += swz_xor<16>(v);
    return x32_sum(v);
}
__device__ __forceinline__ float ninf_() { float z = -INFINITY; asm volatile("" : "+v"(z)); return z; }
__device__ __forceinline__ f32x4 z4() { float z = 0.f; asm volatile("" : "+v"(z)); return (f32x4){z, z, z, z}; }
__device__ __forceinline__ f32x16 z16() { float z = 0.f; asm volatile("" : "+v"(z)); f32x16 r;
#pragma unroll
    for (int i = 0; i < 16; ++i) r[i] = z;
    return r; }
#define VM_WAIT() asm volatile("s_waitcnt vmcnt(0)" ::: "memory")
#define MF32(a, b, c) __builtin_amdgcn_mfma_f32_32x32x16_bf16(a, b, c, 0, 0, 0)

#define XB_TMO      128
#define XB_XCNT(j)  (256  + 64 * (j))
#define XB_XSUB(j)  (1280 + 64 * (j))
#define XB_XGEN(j)  (2304 + 64 * (j))
#define XB_TOP      3328
#define XB_TOPGEN   3392
#define XCD_BAR_WORDS 3456
#define XB_SPIN_CAP (1u << 22)

__device__ __forceinline__ unsigned xb_ld(unsigned* p)              { return __hip_atomic_load(p, __ATOMIC_RELAXED, __HIP_MEMORY_SCOPE_AGENT); }
__device__ __forceinline__ unsigned xb_add(unsigned* p, unsigned v) { return __hip_atomic_fetch_add(p, v, __ATOMIC_RELAXED, __HIP_MEMORY_SCOPE_AGENT); }
__device__ __forceinline__ unsigned xb_xcc_id() { return (unsigned)__builtin_amdgcn_s_getreg((3 << 11) | 20) & 0xFu; }
#define XB_SPIN(cond, bar) do { unsigned _sp = 0; while (cond) { __builtin_amdgcn_s_sleep(1); \
    if ((++_sp & 255u) == 0u) { if (xb_ld(&(bar)[XB_TMO])) break; if (_sp > XB_SPIN_CAP) { atomicAdd(&(bar)[XB_TMO], 1u); break; } } } } while (0)

struct XcdBarrier { unsigned* bar; unsigned x; volatile LAS unsigned* st; };

__device__ __forceinline__ XcdBarrier xcd_barrier_post(unsigned* bar, volatile LAS unsigned* st, int tid) {
    XcdBarrier b; b.bar = bar; b.x = xb_xcc_id(); b.st = st;
    if (tid == 0) (void)xb_add(&bar[XB_XCNT(b.x)], 1u);
    return b;
}
__device__ __forceinline__ void xcd_barrier_complete(unsigned* bar, unsigned x, unsigned& nloc, unsigned& nx) {
    const unsigned G = NWG;
    unsigned sum, cnt, mine, sp = 0u;
    for (;;) {
        sum = 0u; cnt = 0u; mine = 0u;
#pragma unroll
        for (unsigned j = 0; j < 16; ++j) { const unsigned c = xb_ld(&bar[XB_XCNT(j)]); sum += c; cnt += (c > 0u) ? 1u : 0u; mine = (j == x) ? c : mine; }
        if (sum == G) break;
        __builtin_amdgcn_s_sleep(1);
        if ((++sp & 255u) == 0u) { if (xb_ld(&bar[XB_TMO])) break; if (sp > XB_SPIN_CAP) { atomicAdd(&bar[XB_TMO], 1u); break; } }
    }
    nloc = mine > 0u ? mine : 1u; nx = cnt > 0u ? cnt : 1u;
}
__device__ __forceinline__ void xcd_barrier(const XcdBarrier& b, int tid) {
    asm volatile("s_waitcnt vmcnt(0)" ::: "memory");
    __syncthreads();
    if (tid == 0) {
        unsigned* bar = b.bar;
        __builtin_amdgcn_s_waitcnt(0);
        unsigned nloc = b.st[0], nx = b.st[1];
        if (nloc == 0u) { xcd_barrier_complete(bar, b.x, nloc, nx); b.st[0] = nloc; b.st[1] = nx; }
        const unsigned old = xb_add(&bar[XB_XSUB(b.x)], 1u);
        const unsigned gen = old / nloc;
        if (old + 1u == (gen + 1u) * nloc) {
            __builtin_amdgcn_fence(__ATOMIC_RELEASE, "agent");
            asm volatile("s_waitcnt vmcnt(0)" ::: "memory");
            const unsigned og = xb_add(&bar[XB_TOP], 1u);
            const unsigned tg = og / nx;
            if (og + 1u == (tg + 1u) * nx) xb_add(&bar[XB_TOPGEN], 1u);
            else XB_SPIN(xb_ld(&bar[XB_TOPGEN]) == tg, bar);
            __builtin_amdgcn_fence(__ATOMIC_ACQUIRE, "agent");
            xb_add(&bar[XB_XGEN(b.x)], 1u);
            asm volatile("s_waitcnt vmcnt(0)" ::: "memory");
        } else {
            XB_SPIN(xb_ld(&bar[XB_XGEN(b.x)]) == gen, bar);
            __builtin_amdgcn_fence(__ATOMIC_ACQUIRE, "agent");
            asm volatile("s_waitcnt vmcnt(0)" ::: "memory");
        }
    }
    __syncthreads();
}

struct Params {
    const float* in[27];
    float* out;
    unsigned char* ws;
    int ph_lo, ph_hi;
};
__device__ __forceinline__ LAS unsigned char* lds_at(int off) { asm volatile("" : "+s"(off)); return (LAS unsigned char*)(unsigned)off; }
constexpr int LDS_PTAB = LDS_BYTES - 512;
__device__ __forceinline__ void ptab_store(const Params& p, int tid) {
    LAS unsigned long long* t = (LAS unsigned long long*)lds_at(LDS_PTAB);
    if (tid == 0) {
#pragma unroll
        for (int i = 0; i < 27; ++i) t[i] = (unsigned long long)p.in[i];
        t[27] = (unsigned long long)p.out; t[28] = (unsigned long long)p.ws; }
}
__device__ __forceinline__ unsigned long long ptab_get(int i) {
    const LAS unsigned* t = (const LAS unsigned*)lds_at(LDS_PTAB) + 2 * i;
    const unsigned lo = __builtin_amdgcn_readfirstlane(t[0]), hi = __builtin_amdgcn_readfirstlane(t[1]);
    return ((unsigned long long)hi << 32) | lo;
}
__device__ __forceinline__ unsigned char* ws_late() { return (unsigned char*)ptab_get(28); }
#define PIN(i) ((const float*)ptab_get(i))
__device__ __forceinline__ void ptab_load(Params& q) {
    asm volatile("" ::: "memory");
#pragma unroll
    for (int i = 0; i < 27; ++i) q.in[i] = (const float*)ptab_get(i);
    q.out = (float*)ptab_get(27); q.ws = (unsigned char*)ptab_get(28); q.ph_lo = 0; q.ph_hi = 0;
}

namespace pg8 {
constexpr int BM = 256, BK = 64, HALF = 128, HTB = HALF * BK * 2, NXCD = 8, WGM = 8;
__device__ __forceinline__ int lds_byte(int r, int c) { const int st = (r >> 4) * 2 + (c >> 5), rr = r & 15, cc = c & 31, ob = rr * 64 + cc * 2; return st * 1024 + (ob ^ (((ob >> 9) & 1) << 5)); }
__device__ __forceinline__ void stage_rc(int b, int& R, int& C) { const int st = b / 1024, sb = b % 1024, swz = sb ^ (((sb >> 9) & 1) << 5); R = (st >> 1) * 16 + swz / 64; C = (st & 1) * 32 + (swz % 64) / 2; }
__device__ __forceinline__ int perm32(int rho) { const int n = rho >> 4, i = rho & 15; return 8 * (i >> 2) + 4 * n + (i & 3); }

struct Unit { unsigned a, b, rows; int pm, pn, aux, nvalid; };

__device__ __forceinline__ bool dense_unit(int i, int G, int c, int nM, int nN, int& pm, int& pn) {
    const int nwg = nM * nN; const long L = (long)i * G + c; if (L >= nwg) return false;
    int wgid = (int)L; { const int q = nwg / NXCD, r = nwg % NXCD, xcd = wgid % NXCD, off = wgid / NXCD; wgid = (xcd < r ? xcd * (q + 1) : r * (q + 1) + (xcd - r) * q) + off; }
    const int nig = WGM * nN, gid = wgid / nig, fm = gid * WGM, gsz = (nM - fm) < WGM ? (nM - fm) : WGM;
    pm = fm + ((wgid % nig) % gsz); pn = (wgid % nig) / gsz; return true;
}

typedef int i32x4 __attribute__((ext_vector_type(4)));
typedef int i32x8 __attribute__((ext_vector_type(8)));
template <class Epi, class Sched, bool ALIGN_EPI, bool GATHER, bool F8 = false>
__device__ __forceinline__ void gemm_phase(LAS unsigned char* lds, const int K, const int lda, const int ldb, const Sched& S, const Epi& E, const int tid, const char* wsb) {
    const int wid = __builtin_amdgcn_readfirstlane(tid >> 6), lane = tid & 63, wr = wid >> 2, wc = wid & 3, fr = lane & 15, fq = lane >> 4;
    constexpr int ESZ = F8 ? 1 : 2;
    const int nt = K / (F8 ? 128 : BK);
    unsigned voffA[2], voffB[2]; int rA[2], cA2[2];
#pragma unroll
    for (int i = 0; i < 2; ++i) { int R, C; stage_rc(tid * 16 + i * 8192, R, C); const int Rb = Epi::PERM ? ((R & ~31) + perm32(R & 31)) : R;
        rA[i] = R; cA2[i] = C * 2; voffA[i] = (unsigned)(R * lda * ESZ + C * 2); voffB[i] = (unsigned)(Rb * ldb * ESZ + C * 2); }
    const unsigned kstep = (unsigned)(BK * 2);
    const unsigned hstepA = GATHER ? 0u : (unsigned)(HALF * lda * ESZ), hstepB = (unsigned)(HALF * ldb * ESZ);
    const unsigned ldsw = (unsigned)wid * 1024u, s64A = (unsigned)(64 * lda * ESZ), s64B = (unsigned)(64 * ldb * ESZ);
    const int aoff = lds_byte(wr * 64 + fr, fq * (F8 ? 16 : 8)), boff = lds_byte(wc * 32 + fr, fq * (F8 ? 16 : 8));
#define PG8_SA(b, h) (((b) * 2 + (h)) * HTB)
#define PG8_SB(b, h) ((4 + (b) * 2 + (h)) * HTB)
#define PG8_STAGE(bufoff, gbase, voff) do { _Pragma("unroll") for (int _i = 0; _i < 2; ++_i) \
        __builtin_amdgcn_global_load_lds((const unsigned*)(wsb + (size_t)(unsigned)((gbase) + (voff)[_i])), (LAS unsigned*)(lds + (bufoff) + ldsw + _i * 8192), 16, 0, 0); } while (0)
#define PG8_STAGE1(bufoff, gbase, voff0, step64) do { _Pragma("unroll") for (int _i = 0; _i < 2; ++_i) \
        __builtin_amdgcn_global_load_lds((const unsigned*)(wsb + (size_t)(unsigned)((gbase) + (unsigned)_i * (step64) + (voff0))), (LAS unsigned*)(lds + (bufoff) + ldsw + _i * 8192), 16, 0, 0); } while (0)
#define PG8_LDA(dst, b, h) do { _Pragma("unroll") for (int m = 0; m < 4; ++m) { if constexpr (F8) dst##8[m] = *(const LAS i32x8*)(lds + PG8_SA(b, h) + aoff + m * 2048); else { _Pragma("unroll") for (int k = 0; k < 2; ++k) dst[m][k] = *(const LAS bf16x8*)(lds + PG8_SA(b, h) + aoff + m * 2048 + k * 1024); } } } while (0)
#define PG8_LDB(dst, b, h) do { _Pragma("unroll") for (int n = 0; n < 2; ++n) { if constexpr (F8) dst##8[n] = *(const LAS i32x8*)(lds + PG8_SB(b, h) + boff + n * 2048); else { _Pragma("unroll") for (int k = 0; k < 2; ++k) dst[n][k] = *(const LAS bf16x8*)(lds + PG8_SB(b, h) + boff + n * 2048 + k * 1024); } } } while (0)
#define PG8_MMA(ai, bj, At, Bt) do { __builtin_amdgcn_s_setprio(1); _Pragma("unroll") for (int m = 0; m < 4; ++m) _Pragma("unroll") for (int n = 0; n < 2; ++n) { \
        if constexpr (F8) acc[ai][bj][m][n] = __builtin_amdgcn_mfma_scale_f32_16x16x128_f8f6f4(Bt##8[n], At##8[m], acc[ai][bj][m][n], 0, 0, 0, 0, 0, 0); \
        else { _Pragma("unroll") for (int k = 0; k < 2; ++k) acc[ai][bj][m][n] = __builtin_amdgcn_mfma_f32_16x16x32_bf16(Bt[n][k], At[m][k], acc[ai][bj][m][n], 0, 0, 0); } } \
        __builtin_amdgcn_s_setprio(0); } while (0)
#define PG8_WAIT_V(n) asm volatile("s_waitcnt vmcnt(" #n ")" ::: "memory")
#define PG8_WAIT_L(n) asm volatile("s_waitcnt lgkmcnt(" #n ")" ::: "memory")
#define PG8_BAR __builtin_amdgcn_s_barrier()
#define PG8_SCHED __builtin_amdgcn_sched_barrier(0)
    Unit cur, nxt; int ui = 0;
    S.begin(tid);
    if (!S.next(0, cur)) return;
    f32x4 acc[2][2][4][2];
#pragma unroll
    for (int a = 0; a < 2; ++a)
#pragma unroll
        for (int b = 0; b < 2; ++b)
#pragma unroll
            for (int m = 0; m < 4; ++m)
#pragma unroll
                for (int n = 0; n < 2; ++n) acc[a][b][m][n] = (f32x4){0.f, 0.f, 0.f, 0.f};
    bf16x8 At[4][2], B0[2][2], B1[2][2]; i32x8 At8[4], B08[2], B18[2];
    unsigned cA = cur.a, cB = cur.b;
    LAS unsigned* grec = (LAS unsigned*)(lds + 131072) + tid * 8;
    if constexpr (GATHER) {
#pragma unroll
        for (int i = 0; i < 2; ++i) { const unsigned o0 = (unsigned)S.row(cur, rA[i]) * (unsigned)(lda * ESZ) + cA2[i], o1 = (unsigned)S.row(cur, HALF + rA[i]) * (unsigned)(lda * ESZ) + cA2[i];
            grec[i] = o0; grec[2 + i] = o1; grec[4 + i] = o0; grec[6 + i] = o1; }
    }
#define PG8_STAGE_A(bufoff, kptr, h, usenext) do { if constexpr (GATHER) { const u32x2 _w = *(const LAS u32x2*)(grec + ((usenext) ? 4 : 0) + 2 * (h)); unsigned _v[2]; _v[0] = _w.x; _v[1] = _w.y; PG8_STAGE(bufoff, kptr, _v); } \
        else { PG8_STAGE1(bufoff, (kptr) + (h) * hstepA, voffA[0], s64A); } } while (0)
    PG8_STAGE1(PG8_SB(0, 0), cB, voffB[0], s64B); PG8_STAGE1(PG8_SB(0, 1), cB + hstepB, voffB[0], s64B); PG8_STAGE_A(PG8_SA(0, 0), cA, 0, false); PG8_STAGE_A(PG8_SA(0, 1), cA, 1, false);
    if (wr == 1) PG8_BAR;
    PG8_WAIT_V(2); PG8_BAR;
    PG8_STAGE1(PG8_SB(1, 0), cB + kstep, voffB[0], s64B); PG8_STAGE_A(PG8_SA(1, 0), cA + kstep, 0, false); PG8_STAGE1(PG8_SB(1, 1), cB + hstepB + kstep, voffB[0], s64B);
    PG8_WAIT_V(6); PG8_BAR;
    for (;;) {
        const bool has_next = S.next(ui + 1, nxt);
        const int tk_ = S.issue(tid, has_next);
        const unsigned nA = has_next ? nxt.a : cA, nB = has_next ? nxt.b : cB;
#pragma nounroll
        for (int t = 0; t < nt; t += 2) {
            const bool last = (t == nt - 2);
            const unsigned a1 = cA + (unsigned)(t + 1) * kstep;
            const unsigned a2 = last ? nA : cA + (unsigned)(t + 2) * kstep, b2 = last ? nB : cB + (unsigned)(t + 2) * kstep;
            const unsigned a3 = a2 + kstep, b3 = b2 + kstep;
            if constexpr (GATHER) { if (last && has_next) {
#pragma unroll
                for (int i = 0; i < 2; ++i) { grec[4 + i] = (unsigned)S.row(nxt, rA[i]) * (unsigned)(lda * ESZ) + cA2[i]; grec[6 + i] = (unsigned)S.row(nxt, HALF + rA[i]) * (unsigned)(lda * ESZ) + cA2[i]; } } }
            PG8_LDB(B0, 0, 0); PG8_LDB(B1, 0, 1); PG8_SCHED; PG8_LDA(At, 0, 0); PG8_STAGE_A(PG8_SA(1, 1), a1, 1, false);
            PG8_WAIT_V(8); PG8_WAIT_L(0); PG8_BAR; PG8_MMA(0, 0, At, B0); PG8_MMA(0, 1, At, B1); PG8_BAR; PG8_SCHED;
            PG8_LDA(At, 0, 1); PG8_STAGE1(PG8_SB(0, 0), b2, voffB[0], s64B); PG8_STAGE1(PG8_SB(0, 1), b2 + hstepB, voffB[0], s64B); PG8_STAGE_A(PG8_SA(0, 0), a2, 0, last);
            PG8_WAIT_V(8); PG8_WAIT_L(0); PG8_BAR; PG8_MMA(1, 0, At, B0); PG8_MMA(1, 1, At, B1); PG8_BAR; PG8_SCHED;
            PG8_LDB(B0, 1, 0); PG8_LDB(B1, 1, 1); PG8_SCHED; PG8_LDA(At, 1, 0); PG8_STAGE_A(PG8_SA(0, 1), a2, 1, last);
            PG8_WAIT_V(8); PG8_WAIT_L(0); PG8_BAR; PG8_MMA(0, 0, At, B0); PG8_MMA(0, 1, At, B1); PG8_BAR; PG8_SCHED;
            PG8_LDA(At, 1, 1); PG8_STAGE1(PG8_SB(1, 0), b3, voffB[0], s64B); PG8_STAGE1(PG8_SB(1, 1), b3 + hstepB, voffB[0], s64B); PG8_STAGE_A(PG8_SA(1, 0), a3, 0, last);
            PG8_WAIT_V(8); PG8_WAIT_L(0); PG8_BAR; PG8_MMA(1, 0, At, B0); PG8_MMA(1, 1, At, B1); PG8_BAR; PG8_SCHED;
        }
        S.commit(tid, ui, tk_);
        if constexpr (ALIGN_EPI) { if (wr == 0) PG8_BAR; }
        { int tz = tid; asm volatile("" : "+v"(tz)); const int ew = __builtin_amdgcn_readfirstlane(tz >> 6), el = tz & 63;
          E(acc, cur, ew >> 2, ew & 3, el & 15, el >> 4); }
        if (!has_next) break;
#pragma unroll
        for (int a = 0; a < 2; ++a)
#pragma unroll
            for (int b = 0; b < 2; ++b)
#pragma unroll
                for (int m = 0; m < 4; ++m)
#pragma unroll
                    for (int n = 0; n < 2; ++n) acc[a][b][m][n] = (f32x4){0.f, 0.f, 0.f, 0.f};
        cur = nxt; cA = nA; cB = nB; ++ui;
        if constexpr (GATHER) { const u32x4 _n = *(const LAS u32x4*)(grec + 4); *(LAS u32x4*)grec = _n; }
        if constexpr (ALIGN_EPI) { if (wr == 1) PG8_BAR; }
    }
    PG8_WAIT_V(0);
    if constexpr (!ALIGN_EPI) { if (wr == 0) PG8_BAR; }
    PG8_BAR;
#undef PG8_SA
#undef PG8_SB
#undef PG8_STAGE
#undef PG8_STAGE_A
#undef PG8_LDA
#undef PG8_LDB
#undef PG8_MMA
#undef PG8_WAIT_V
#undef PG8_WAIT_L
#undef PG8_BAR
#undef PG8_SCHED
}
}
using pg8::Unit;

constexpr int LDS_TICK = 147456;
struct DenseSched {
    unsigned A, Bt, tA, tB, aBr; int nM, nN, G, c, pnShift; unsigned* ctr;
    __device__ __forceinline__ void begin(int tid) const { volatile LAS int* tk = (volatile LAS int*)lds_at(LDS_TICK);
        __syncthreads();
        if (tid == 0) { const int t0 = (int)__hip_atomic_fetch_add(ctr, 1u, __ATOMIC_RELAXED, __HIP_MEMORY_SCOPE_AGENT), t1 = (int)__hip_atomic_fetch_add(ctr, 1u, __ATOMIC_RELAXED, __HIP_MEMORY_SCOPE_AGENT); tk[0] = t0; tk[1] = t1; }
        __syncthreads(); }
    __device__ __forceinline__ int issue(int tid, bool more) const { int t = 0x3fffffff; if (tid == 0 && more) t = (int)__hip_atomic_fetch_add(ctr, 1u, __ATOMIC_RELAXED, __HIP_MEMORY_SCOPE_AGENT); return t; }
    __device__ __forceinline__ void commit(int tid, int ui, int t) const { if (tid == 0) { volatile LAS int* tk = (volatile LAS int*)lds_at(LDS_TICK); tk[ui & 1] = t; asm volatile("s_waitcnt vmcnt(0) lgkmcnt(0)" ::: "memory"); } }
    __device__ __forceinline__ bool next(int i, Unit& u) const {
        const int L = __builtin_amdgcn_readfirstlane(((volatile LAS int*)lds_at(LDS_TICK))[i & 1]);
        int pm, pn; if (L < 0 || L >= nM * nN || !pg8::dense_unit(0, 1, L, nM, nN, pm, pn)) return false;
        u.pm = pm; u.pn = pn; u.aux = 0; u.nvalid = 256; u.rows = 0u;
        u.a = A + (unsigned)(pn >> pnShift) * aBr + (unsigned)pm * tA; u.b = Bt + (unsigned)pn * tB; return true;
    }
    __device__ __forceinline__ int row(const Unit&, int) const { return 0; }
};
struct OneSched {
    Unit u0; bool has;
    __device__ __forceinline__ void begin(int) const {}
    __device__ __forceinline__ int issue(int, bool) const { return 0; }
    __device__ __forceinline__ void commit(int, int, int) const {}
    __device__ __forceinline__ bool next(int i, Unit& u) const { if (i > 0 || !has) return false; u = u0; return true; }
    __device__ __forceinline__ int row(const Unit&, int) const { return 0; }
};
struct MoeSched {
    const LAS int* pre;
    const LAS int* cnt;
    const char* wsb;
    unsigned A, W, wE, wT, aT; int G, c; bool gatherA; unsigned* ctr;
    __device__ __forceinline__ void begin(int tid) const { volatile LAS int* tk = (volatile LAS int*)lds_at(LDS_TICK);
        __syncthreads();
        if (tid == 0) { const int t0 = (int)__hip_atomic_fetch_add(ctr, 1u, __ATOMIC_RELAXED, __HIP_MEMORY_SCOPE_AGENT), t1 = (int)__hip_atomic_fetch_add(ctr, 1u, __ATOMIC_RELAXED, __HIP_MEMORY_SCOPE_AGENT); tk[0] = t0; tk[1] = t1; }
        __syncthreads(); }
    __device__ __forceinline__ int issue(int tid, bool more) const { int t = 0x3fffffff; if (tid == 0 && more) t = (int)__hip_atomic_fetch_add(ctr, 1u, __ATOMIC_RELAXED, __HIP_MEMORY_SCOPE_AGENT); return t; }
    __device__ __forceinline__ void commit(int tid, int ui, int t) const { if (tid == 0) { volatile LAS int* tk = (volatile LAS int*)lds_at(LDS_TICK); tk[ui & 1] = t; asm volatile("s_waitcnt vmcnt(0) lgkmcnt(0)" ::: "memory"); } }
    __device__ __forceinline__ bool next(int i, Unit& u) const {
        const int L = __builtin_amdgcn_readfirstlane(((volatile LAS int*)lds_at(LDS_TICK))[i & 1]); const int total = pre[16] * 4; if (L < 0 || L >= total) return false;
        const int t = (int)(L >> 2), pn = (int)(L & 3); int e = 0;
#pragma unroll
        for (int j = 1; j < 16; ++j) e += (pre[j] <= t) ? 1 : 0;
        const int pm = t - pre[e];
        u.aux = e; u.pm = t; u.pn = pn; u.nvalid = min(256, cnt[e] - 256 * pm); u.rows = (unsigned)(WS_R + R_LIST) + (unsigned)(e * MTOK + 256 * pm) * 4u;
        u.a = gatherA ? A : A + (unsigned)t * aT; u.b = W + (unsigned)e * wE + (unsigned)pn * wT; return true;
    }
    __device__ __forceinline__ int row(const Unit& u, int R) const { return (R < u.nvalid) ? (((const int*)(wsb + u.rows))[R] >> 1) : 0; }
};

typedef f32x4 Acc[2][2][4][2];
#define EPI_LOOP_AIM _Pragma("unroll") for (int ai = 0; ai < 2; ++ai) _Pragma("unroll") for (int m = 0; m < 4; ++m)
__device__ __forceinline__ u32x4 pack8(const f32x4& a, const f32x4& b) { u32x4 w; w.x = pk2(a[0], a[1]); w.y = pk2(a[2], a[3]); w.z = pk2(b[0], b[1]); w.w = pk2(b[2], b[3]); return w; }

struct EpiProj {
    static constexpr bool PERM = true;
    __device__ __forceinline__ void operator()(const Acc& acc, const Unit& u, int wr, int wc, int fr, int fq) const {
        unsigned char* ws = ws_late(); bf16_t* proj = (bf16_t*)(ws + WS_R + R_PROJ); bf16_t* nkv = (bf16_t*)(ws + WS_R + R_NKV); float* sm = (float*)(ws + WS_R + R_SM);
        const int row0 = u.pm * 256 + wr * 64 + fr;
        if (u.pn < 12) {
            const float sc = ((u.pn == 8 || u.pn == 9) ? QSCALE : (u.pn == 5 ? 0.125f : 1.0f)) * F8_DESCALE;
            const int col0 = u.pn * 256 + wc * 32 + 8 * fq;
            EPI_LOOP_AIM { bf16_t* rp = proj + (size_t)(row0 + ai * 128 + m * 16) * PROJW + col0;
#pragma unroll
                for (int bj = 0; bj < 2; ++bj) *(u32x4*)(rp + bj * 128) = pack8(acc[ai][bj][m][0] * sc, acc[ai][bj][m][1] * sc); }
        } else {
#pragma unroll
            for (int bj = 0; bj < 2; ++bj) {
                if (u.pn == 12 || bj == 0) {
                    const int seg = (u.pn - 12) * 4 + bj * 2 + (wc >> 1), col = 32 * (wc & 1) + 8 * fq;
                    bf16_t* base = nkv + (size_t)seg * (NKV_SEG / 2) + col;
                    EPI_LOOP_AIM { *(u32x4*)(base + (size_t)(row0 + ai * 128 + m * 16) * 64) = pack8(acc[ai][bj][m][0] * F8_DESCALE, acc[ai][bj][m][1] * F8_DESCALE); }
                } else if (wc == 0 && fq < 3) {
                    EPI_LOOP_AIM { float* sp = sm + (size_t)(row0 + ai * 128 + m * 16) * 32 + 8 * fq; *(f32x4*)sp = acc[ai][bj][m][0] * F8_DESCALE; *(f32x4*)(sp + 4) = acc[ai][bj][m][1] * F8_DESCALE; }
                }
            }
        }
    }
};
struct EpiH1 {
    static constexpr bool PERM = true;
    bf16_t* h1; const float* cbias;
    __device__ __forceinline__ void operator()(const Acc& acc, const Unit& u, int wr, int wc, int fr, int fq) const {
        const int which = u.aux, rl0 = wr * 64 + fr;
        bf16_t* base = h1 + ((size_t)which * BC * 256 + (size_t)u.pm * 256) * 256;
        const float* bp = cbias + which * 256;
#pragma unroll
        for (int bj = 0; bj < 2; ++bj) { const int col = bj * 128 + wc * 32 + 8 * fq; const f32x4 b0 = *(const f32x4*)(bp + col), b1 = *(const f32x4*)(bp + col + 4);
            EPI_LOOP_AIM { const int rl = rl0 + ai * 128 + m * 16; f32x4 v0 = acc[ai][bj][m][0] + b0, v1 = acc[ai][bj][m][1] + b1;
#pragma unroll
                for (int e = 0; e < 4; ++e) { v0[e] = (rl < 255) ? siluf_(v0[e]) : 0.f; v1[e] = (rl < 255) ? siluf_(v1[e]) : 0.f; }
                *(u32x4*)(base + (size_t)rl * 256 + col) = pack8(v0, v1); } }
    }
};
struct EpiCmp2 {
    static constexpr bool PERM = true;
    bf16_t* kc;
    __device__ __forceinline__ void operator()(const Acc& acc, const Unit& u, int wr, int wc, int fr, int fq) const {
        if (wc >= 2) return;
        const int col = wc * 32 + 8 * fq; bf16_t* base = kc + ((size_t)u.aux * BC + u.pm) * 256 * 64 + col;
        EPI_LOOP_AIM { const int rl = wr * 64 + fr + ai * 128 + m * 16; *(u32x4*)(base + (size_t)rl * 64) = pack8(acc[ai][0][m][0], acc[ai][0][m][1]); }
    }
};
struct EpiP {
    static constexpr bool PERM = true;
    __device__ __forceinline__ void operator()(const Acc& acc, const Unit& u, int wr, int wc, int fr, int fq) const {
        const int i = u.pn >> 2, pt = u.pn & 3, row0 = u.pm * 256 + wr * 64 + fr, col0 = 256 * pt + 32 * wc + 8 * fq;
        bf16_t* P = (bf16_t*)(ws_late() + WS_R + R_P) + (size_t)i * MC * 1024;
        EPI_LOOP_AIM { bf16_t* rp = P + (unsigned)((row0 + ai * 128 + m * 16) * 1024 + col0);
#pragma unroll
            for (int bj = 0; bj < 2; ++bj) *(u32x4*)(rp + bj * 128) = pack8(acc[ai][bj][m][0], acc[ai][bj][m][1]); }
    }
};
struct EpiGate {
    static constexpr bool PERM = true;
    __device__ __forceinline__ void operator()(const Acc& acc, const Unit& u, int wr, int wc, int fr, int fq) const {
        unsigned char* ws = ws_late(); const bf16_t* P = (const bf16_t*)(ws + WS_R + R_P); bf16_t* y = (bf16_t*)(ws + WS_R + R_Y);
        const int row0 = u.pm * 256 + wr * 64 + fr, oc = 64 * u.pn + 16 * wc + 4 * fq;
#pragma unroll
        for (int ai = 0; ai < 2; ++ai)
#pragma unroll
            for (int mh = 0; mh < 2; ++mh) {
                u32x2 pw[2][4];
#pragma unroll
                for (int mm = 0; mm < 2; ++mm) { const unsigned r = (unsigned)(row0 + ai * 128 + (2 * mh + mm) * 16);
#pragma unroll
                    for (int i = 0; i < 4; ++i) pw[mm][i] = *(const u32x2*)(P + ((size_t)i * MC * 1024 + r * 1024u + (unsigned)oc)); }
#pragma unroll
                for (int mm = 0; mm < 2; ++mm) { const int m = 2 * mh + mm; const unsigned r = (unsigned)(row0 + ai * 128 + m * 16);
                    f32x4 s = {0.f, 0.f, 0.f, 0.f};
#pragma unroll
                    for (int bj = 0; bj < 2; ++bj)
#pragma unroll
                        for (int n = 0; n < 2; ++n) { const u32x2 pq = pw[mm][2 * bj + n]; const f32x4 a = acc[ai][bj][m][n];
                            s[0] += sigmoidf_(a[0] * F8_DESCALE) * __uint_as_float(pq.x << 16); s[1] += sigmoidf_(a[1] * F8_DESCALE) * __uint_as_float(pq.x & 0xffff0000u);
                            s[2] += sigmoidf_(a[2] * F8_DESCALE) * __uint_as_float(pq.y << 16); s[3] += sigmoidf_(a[3] * F8_DESCALE) * __uint_as_float(pq.y & 0xffff0000u); }
                    *(unsigned*)((unsigned char*)y + (r * 1024u + (unsigned)oc)) = pk4_fp8(s[0] * Y8_SCALE, s[1] * Y8_SCALE, s[2] * Y8_SCALE, s[3] * Y8_SCALE); }
            }
    }
};
struct EpiOut {
    static constexpr bool PERM = true;
    int row_base;
    __device__ __forceinline__ void operator()(const Acc& acc, const Unit& u, int wr, int wc, int fr, int fq) const {
        bf16_t* T = (bf16_t*)(ws_late() + WS_T);
        const int rg0 = row_base + u.pm * 256 + wr * 64 + fr, col0 = u.pn * 256 + wc * 32 + 8 * fq;
        EPI_LOOP_AIM { bf16_t* rp = T + (size_t)(rg0 + ai * 128 + m * 16) * 1024 + col0;
#pragma unroll
            for (int bj = 0; bj < 2; ++bj) *(u32x4*)(rp + bj * 128) = pack8(acc[ai][bj][m][0] * Y8_DESCALE, acc[ai][bj][m][1] * Y8_DESCALE); }
    }
};
struct EpiComb {
    static constexpr bool PERM = true;
    int mode, row_base;
    __device__ __forceinline__ void operator()(const Acc& acc, const Unit& u, int wr, int wc, int fr, int fq) const {
        if (mode == 0) { EpiProj e; e(acc, u, wr, wc, fr, fq); } else if (mode == 1) { EpiGate e; e(acc, u, wr, wc, fr, fq); } else { EpiOut e; e.row_base = row_base; e(acc, u, wr, wc, fr, fq); }
    }
};
struct EpiMoe1 {
    static constexpr bool PERM = true;
    __device__ __forceinline__ void operator()(const Acc& acc, const Unit& u, int wr, int wc, int fr, int fq) const {
        const int rl0 = wr * 64 + fr, f0 = 128 * u.pn + 32 * wc + 8 * fq;
        bf16_t* hid = (bf16_t*)(ws_late() + WS_R + R_HID);
        EPI_LOOP_AIM { const int rl = rl0 + ai * 128 + m * 16;
            f32x4 a0 = acc[ai][0][m][0], a1 = acc[ai][0][m][1]; const f32x4 b0 = acc[ai][1][m][0], b1 = acc[ai][1][m][1];
#pragma unroll
            for (int e = 0; e < 4; ++e) { a0[e] = siluf_(a0[e]) * b0[e]; a1[e] = siluf_(a1[e]) * b1[e]; }
            *(u32x4*)(hid + (unsigned)((u.pm * 256 + rl) * 512 + f0)) = pack8(a0, a1); __builtin_amdgcn_sched_barrier(0); }
    }
};
struct EpiMoe2 {
    static constexpr bool PERM = true;
    __device__ __forceinline__ void operator()(const Acc& acc, const Unit& u, int wr, int wc, int fr, int fq) const {
        unsigned char* ws = ws_late(); bf16_t* out2 = (bf16_t*)(ws + WS_R + R_OUT2);
        const float* cwb = (const float*)(ws + (R_CW - R_LIST) + u.rows); const int* rws = (const int*)(ws + u.rows);
        const int rl0 = wr * 64 + fr, c0 = 256 * u.pn + 32 * wc + 8 * fq;
        EPI_LOOP_AIM { const int rl = rl0 + ai * 128 + m * 16;
            if (rl < u.nvalid) { const unsigned v = (unsigned)rws[rl]; const float wgt = cwb[rl]; bf16_t* rp = out2 + (size_t)v * 1024 + c0;
#pragma unroll
                for (int bj = 0; bj < 2; ++bj) *(u32x4*)(rp + bj * 128) = pack8(acc[ai][bj][m][0] * wgt, acc[ai][bj][m][1] * wgt); } }
    }
};

enum { IN_X = 0, IN_C, IN_POS, IN_ADAW, IN_ADAB, IN_WIN, IN_CONVW, IN_ALOG, IN_DTB, IN_GNORM, IN_RETGN, IN_PE, IN_CKW1, IN_CKW2, IN_CVW1, IN_CVW2, IN_FBIAS,
       IN_BP, IN_WG, IN_WO, IN_LNG, IN_LNB, IN_RW, IN_RB, IN_EW1, IN_EW3, IN_EW2 };

__device__ __forceinline__ void p0_ada(const Params& p, int item, LAS float* lf, const int tid) {
    LAS float* sc = lf; LAS float* red = lf + 16384;
    const float* c = PIN(IN_C);
    for (int i = tid; i < 16384; i += NTHR) sc[i] = siluf_(c[i]);
    __syncthreads();
    const int ls = item / 48, cb = item % 48, col = cb * 64 + (tid & 63), ks = tid >> 6;
    const float* w = PIN(IN_ADAW) + (size_t)ls * 1024 * 3072 + col;
    float acc[16];
#pragma unroll
    for (int b = 0; b < 16; ++b) acc[b] = 0.f;
    for (int k0 = ks * 128; k0 < ks * 128 + 128; k0 += 16) { float wv[16];
#pragma unroll
        for (int kk = 0; kk < 16; ++kk) wv[kk] = w[(size_t)(k0 + kk) * 3072];
#pragma unroll
        for (int kk = 0; kk < 16; ++kk)
#pragma unroll
            for (int b = 0; b < 16; ++b) acc[b] += sc[b * 1024 + k0 + kk] * wv[kk]; }
#pragma unroll
    for (int b = 0; b < 16; ++b) red[(ks * 16 + b) * 64 + (tid & 63)] = acc[b];
    __syncthreads();
    float* mod = (float*)(p.ws + WS_MOD);
    for (int o = tid; o < 1024; o += NTHR) { const int b = o >> 6, cc = o & 63; float s = 0.f;
#pragma unroll
        for (int q = 0; q < 8; ++q) s += red[(q * 16 + b) * 64 + cc];
        mod[((size_t)ls * 16 + b) * 3072 + cb * 64 + cc] = s + PIN(IN_ADAB)[ls * 3072 + cb * 64 + cc]; }
    __syncthreads();
}
__device__ __forceinline__ void p0_rope(const Params& p, int item, const int tid) {
    const int* pos = (const int*)PIN(IN_POS); f32x2* tab = (f32x2*)(p.ws + WS_ROPE);
#pragma unroll
    for (int j = 0; j < 8; ++j) { const int idx = item * 4096 + j * 512 + tid; const int m = idx >> 5, i = idx & 31;
        const float inv = powf(10000.0f, -(float)i / 32.0f); const float ang = (float)pos[m] * inv;
        const float n = rintf(ang * 0.6366197723675814f);
        float r = fmaf(n, -1.5703125f, ang); r = fmaf(n, -4.837512969970703125e-4f, r); r = fmaf(n, -7.54978995489188e-8f, r);
        const float s = sinf(r), cs = cosf(r); const int q = ((int)n) & 3;
        float so, co; if (q == 0) { so = s; co = cs; } else if (q == 1) { so = cs; co = -s; } else if (q == 2) { so = -s; co = -cs; } else { so = -cs; co = s; }
        tab[idx] = (f32x2){co, so}; }
}
__device__ __forceinline__ void p0_cbias(const Params& p, int item, LAS float* red, const int tid) {
    const int l = item >> 1, which = item & 1, col = tid & 255, half = tid >> 8;
    const float* pe = PIN(IN_PE) + (size_t)l * 2048 + half * 1024; const float* w1 = PIN(which ? IN_CVW1 : IN_CKW1) + (size_t)l * 2048 * 256 + (size_t)half * 1024 * 256 + col;
    float s = 0.f;
    for (int k0 = 0; k0 < 1024; k0 += 16) { float wv[16];
#pragma unroll
        for (int kk = 0; kk < 16; ++kk) wv[kk] = w1[(size_t)(k0 + kk) * 256];
#pragma unroll
        for (int kk = 0; kk < 16; ++kk) s += pe[k0 + kk] * wv[kk]; }
    __syncthreads();
    red[tid] = s;
    __syncthreads();
    if (tid < 256) ((float*)(p.ws + WS_CBIAS))[item * 256 + tid] = red[tid] + red[tid + 256];
    __syncthreads();
}
struct TJob { bf16_t* dst; int K, nrt, nkt; };
constexpr int TJ_TILES[8] = {56 * 16, 64 * 16, 64 * 4, 16 * 16, 256 * 16, 256 * 8, 8 * 32, 8 * 4};
constexpr int TJ_TOTAL = 56 * 16 + 64 * 16 + 64 * 4 + 16 * 16 + 256 * 16 + 256 * 8 + 8 * 32 + 8 * 4;
__device__ __forceinline__ int win_src_col(int pc) {
    if (pc < 768) return pc;
    if (pc < 1024) return pc - 768 + 776;
    if (pc < 2048) return pc - 1024 + 1032;
    if (pc < 2304) return pc - 2048 + 2056;
    if (pc < 3072) return pc - 2304 + 2708;
    if (pc < 3456) return pc - 3072 + 2312;
    if (pc < 3464) return pc - 3456 + 768;
    if (pc < 3476) return pc - 3464 + 2696;
    if (pc < 3480) return pc - 3476 + 3476;
    return -1;
}
__device__ __forceinline__ const float* tj_src(const Params& p, int l, int job, int n, int& pitch) {
    switch (job) {
    case 0: { pitch = 3480; const int c = win_src_col(n); return c < 0 ? nullptr : PIN(IN_WIN) + (size_t)l * 1024 * 3480 + c; }
    case 1: { pitch = 1024; const int i = 2 * ((n >> 7) & 1) + ((n >> 2) & 1), c = 64 * (n >> 8) + 16 * ((n >> 5) & 3) + 4 * ((n >> 3) & 3) + (n & 3);
              return PIN(IN_WG) + ((size_t)l * 4 + i) * 1024 * 1024 + c; }
    case 2: { pitch = 1024; const int i = n >> 10, c = n & 1023; return PIN(IN_BP) + ((size_t)l * 4 + i) * 256 * 1024 + c; }
    case 3: { pitch = 1024; return PIN(IN_WO) + (size_t)l * 1024 * 1024 + n; }
    case 4: { pitch = 512; const int e = n >> 10, vr = n & 1023, f = 128 * (vr >> 8) + (vr & 127); return PIN(((vr >> 7) & 1) ? IN_EW3 : IN_EW1) + ((size_t)l * 16 + e) * 1024 * 512 + f; }
    case 5: { pitch = 1024; const int e = n >> 10, c = n & 1023; return PIN(IN_EW2) + ((size_t)l * 16 + e) * 512 * 1024 + c; }
    case 6: { pitch = 256; const int which = n >> 8, c = n & 255; return PIN(which ? IN_CVW1 : IN_CKW1) + (size_t)l * 2048 * 256 + c; }
    default: { pitch = 64; const int which = n >> 8, r = n & 255; return r < 64 ? PIN(which ? IN_CVW2 : IN_CKW2) + (size_t)l * 256 * 64 + r : nullptr; }
    }
}
struct TDesc { const float* src; bf16_t* dst; int pitch, K, rt, kt, job; };
__device__ __forceinline__ void tj_decode(const Params& p, int item, int tx, TDesc& d) {
    const int l = item / TJ_TOTAL; int t = item % TJ_TOTAL, job = 0;
#pragma unroll
    for (int j = 0; j < 8; ++j) { if (job == j && t >= TJ_TILES[j]) { t -= TJ_TILES[j]; job = j + 1; } }
    const size_t lw = WS_W + (size_t)l * ((LW_BYTES + MiB - 1) / MiB) * MiB;
    const size_t offs[8] = {LW_WIN, LW_WGV, LW_BPT, LW_WOT, LW_W13, LW_W2, LW_CW1, LW_CW2};
    const int Ks[8] = {1024, 1024, 256, 1024, 1024, 512, 2048, 256};
    size_t off = 0; int K = 0;
#pragma unroll
    for (int j = 0; j < 8; ++j) if (job == j) { off = offs[j]; K = Ks[j]; }
    d.dst = (bf16_t*)(p.ws + lw + off); d.K = K; d.job = job;
    const int nkt = K / 64; d.rt = t / nkt; d.kt = t % nkt;
    d.src = tj_src(p, l, job, d.rt * 64 + tx, d.pitch);
}
__device__ __forceinline__ void p0_transpose4(const Params& p, int it, int G, int end, LAS float* tiles, const int tid) {
    const int tx = tid & 63, ty = tid >> 6; float v[4][8]; TDesc d[4];
#pragma unroll
    for (int q = 0; q < 4; ++q) { const int item = it + q * G; if (item < end) { tj_decode(p, item, tx, d[q]);
#pragma unroll
            for (int kk = 0; kk < 8; ++kk) v[q][kk] = d[q].src ? d[q].src[(size_t)(d[q].kt * 64 + ty + 8 * kk) * d[q].pitch] : 0.f; } }
#pragma unroll
    for (int q = 0; q < 4; ++q) { if (it + q * G < end) {
#pragma unroll
            for (int kk = 0; kk < 8; ++kk) tiles[q * 4160 + (ty + 8 * kk) * 65 + tx] = v[q][kk]; } }
    __syncthreads();
    const int r = tid >> 3, sg = tid & 7;
#pragma unroll
    for (int q = 0; q < 4; ++q) { if (it + q * G < end) { f32x4 a, b;
#pragma unroll
            for (int j = 0; j < 4; ++j) { a[j] = tiles[q * 4160 + (sg * 8 + j) * 65 + r]; b[j] = tiles[q * 4160 + (sg * 8 + 4 + j) * 65 + r]; }
            if (d[q].job == 1 || d[q].job == 0 || d[q].job == 3) { u32x2 w8; w8.x = pk4_fp8(a[0] * W8_SCALE, a[1] * W8_SCALE, a[2] * W8_SCALE, a[3] * W8_SCALE); w8.y = pk4_fp8(b[0] * W8_SCALE, b[1] * W8_SCALE, b[2] * W8_SCALE, b[3] * W8_SCALE);
                                 *(u32x2*)((unsigned char*)d[q].dst + (size_t)(d[q].rt * 64 + r) * d[q].K + d[q].kt * 64 + sg * 8) = w8; }
            else *(u32x4*)(d[q].dst + (size_t)(d[q].rt * 64 + r) * d[q].K + d[q].kt * 64 + sg * 8) = pack8(a, b); } }
    __syncthreads();
}

struct RowV { f32x4 v[4]; };
__device__ __forceinline__ void row_load(RowV& r, const float* src, int lane) {
#pragma unroll
    for (int j = 0; j < 4; ++j) r.v[j] = *(const f32x4*)(src + 4 * lane + 256 * j);
}
__device__ __forceinline__ void row_stats(const RowV& r, float& mean, float& rstd) {
    float s = 0.f;
#pragma unroll
    for (int j = 0; j < 4; ++j) s += (r.v[j][0] + r.v[j][1]) + (r.v[j][2] + r.v[j][3]);
    mean = wave_sum(s) * (1.0f / 1024.0f);
    float q = 0.f;
#pragma unroll
    for (int j = 0; j < 4; ++j) { const f32x4 d = r.v[j] - mean; q += (d[0] * d[0] + d[1] * d[1]) + (d[2] * d[2] + d[3] * d[3]); }
    rstd = 1.0f / sqrtf(wave_sum(q) * (1.0f / 1024.0f) + LN_EPS);
}
__device__ __forceinline__ void row_ln(RowV& r, float mean, float rstd, const float* g, const float* b, int lane) {
#pragma unroll
    for (int j = 0; j < 4; ++j) { const f32x4 gg = *(const f32x4*)(g + 4 * lane + 256 * j), bb = *(const f32x4*)(b + 4 * lane + 256 * j); r.v[j] = (r.v[j] - mean) * rstd * gg + bb; }
}
__device__ __forceinline__ void row_mod(RowV& h, const RowV& x, const float* mod, int lane) {
#pragma unroll
    for (int j = 0; j < 4; ++j) { const f32x4 sh = *(const f32x4*)(mod + 4 * lane + 256 * j), sc = *(const f32x4*)(mod + 1024 + 4 * lane + 256 * j); h.v[j] = x.v[j] * (sc + 1.0f) + sh; }
}
__device__ __forceinline__ void row_store_bf16(const RowV& h, bf16_t* dst, int lane) {
#pragma unroll
    for (int j = 0; j < 4; ++j) { u32x2 w; w.x = pk2(h.v[j][0], h.v[j][1]); w.y = pk2(h.v[j][2], h.v[j][3]); *(u32x2*)(dst + 4 * lane + 256 * j) = w; }
}
__device__ __forceinline__ void vec_load(RowV& v, const float* src, int lane) {
#pragma unroll
    for (int j = 0; j < 4; ++j) v.v[j] = *(const f32x4*)(src + 4 * lane + 256 * j);
}
__device__ __forceinline__ void row_ln_r(RowV& r, float mean, float rstd, const RowV& g, const RowV& b) {
#pragma unroll
    for (int j = 0; j < 4; ++j) r.v[j] = (r.v[j] - mean) * rstd * g.v[j] + b.v[j];
}
__device__ __forceinline__ void row_mod_r(RowV& h, const RowV& x, const RowV& sh, const RowV& sc1) {
#pragma unroll
    for (int j = 0; j < 4; ++j) h.v[j] = x.v[j] * sc1.v[j] + sh.v[j];
}
__device__ __forceinline__ void vec_add1(RowV& v) {
#pragma unroll
    for (int j = 0; j < 4; ++j) v.v[j] = v.v[j] + 1.0f;
}
__device__ __forceinline__ void row_store_fp8(const RowV& h, unsigned char* dst, int lane) {
#pragma unroll
    for (int j = 0; j < 4; ++j) *(unsigned*)(dst + 4 * lane + 256 * j) = pk4_fp8(h.v[j][0] * H8_SCALE, h.v[j][1] * H8_SCALE, h.v[j][2] * H8_SCALE, h.v[j][3] * H8_SCALE);
}
__device__ __forceinline__ void prep_first(const Params& p, const int tid, const int blk) {
    const int lane = tid & 63, wv = tid >> 6; const float* x = p.in[IN_X]; bf16_t* H = (bf16_t*)(p.ws + WS_H); const float* mod = (const float*)(p.ws + WS_MOD);
    const int row0 = (blk * 8 + wv) * 32;
    RowV sh, sc1; vec_load(sh, mod + (size_t)(row0 >> 12) * 3072, lane); vec_load(sc1, mod + (size_t)(row0 >> 12) * 3072 + 1024, lane); vec_add1(sc1);
    RowV cur; row_load(cur, x + (size_t)row0 * 1024, lane);
    for (int i = 0; i < 32; ++i) { const int row = row0 + i; RowV nx; if (i + 1 < 32) row_load(nx, x + (size_t)(row + 1) * 1024, lane);
        RowV h; row_mod_r(h, cur, sh, sc1); row_store_bf16(h, H + (size_t)row * 1024, lane); row_store_fp8(h, p.ws + WS_H8 + (size_t)row * 1024, lane); cur = nx; }
}
__device__ __forceinline__ void row_load_t(u32x2 (&t)[4], const bf16_t* src, int lane) {
#pragma unroll
    for (int j = 0; j < 4; ++j) t[j] = *(const u32x2*)(src + 4 * lane + 256 * j);
}
__device__ __forceinline__ void prep_moe(const Params& p, int l, LAS float* rwl, const int tid, const int blk) {
    const int lane = tid & 63, wv = tid >> 6;
    { const float* rw = p.in[IN_RW]; for (int i = tid; i < 16384; i += NTHR) { const int c = i >> 4, e = i & 15, ln = (c & 255) >> 2, q = c & 3, j = c >> 8;
        rwl[((((j * 4 + q) * 4 + (e >> 2)) * 64 + ln) << 2) + (e & 3)] = rw[i]; } }
    __syncthreads();
    const float* xin = (l == 0) ? p.in[IN_X] : p.out; float* z = p.out; bf16_t* H = (bf16_t*)(p.ws + WS_H); const bf16_t* T = (const bf16_t*)(p.ws + WS_T);
    const float* modg = (const float*)(p.ws + WS_MOD) + (size_t)(l * 2) * 16 * 3072; const float* mod = (const float*)(p.ws + WS_MOD) + (size_t)(l * 2 + 1) * 16 * 3072;
    f32x2* stats = (f32x2*)(p.ws + WS_STATS); const float* g = p.in[IN_LNG] + (size_t)(l * 2) * 1024; const float* bb = p.in[IN_LNB] + (size_t)(l * 2) * 1024;
    const float* gp = p.in[IN_LNG] + (size_t)((l > 0 ? l - 1 : 0) * 2 + 1) * 1024; const float* bp = p.in[IN_LNB] + (size_t)((l > 0 ? l - 1 : 0) * 2 + 1) * 1024;
    unsigned* cnt = (unsigned*)(p.ws + WS_CTL) + CW_CNT + l * 64; int* list = (int*)(p.ws + WS_R + R_LIST); float* cw = (float*)(p.ws + WS_R + R_CW);
    const float* rb = p.in[IN_RB];
    LAS unsigned* lcnt = (LAS unsigned*)(rwl + 16384); LAS unsigned* lbase = lcnt + 16; LAS unsigned* lrec = lcnt + 32;
    if (tid < 16) lcnt[tid] = 0u;
    __syncthreads();
    const int row0 = (blk * 8 + wv) * 32; int it_ = 0;
    RowV vgp, vbp, vg, vb, vgate, vsh, vsc1;
    vec_load(vgp, gp, lane); vec_load(vbp, bp, lane); vec_load(vg, g, lane); vec_load(vb, bb, lane);
    vec_load(vgate, modg + (size_t)(row0 >> 12) * 3072 + 2048, lane); vec_load(vsh, mod + (size_t)(row0 >> 12) * 3072, lane); vec_load(vsc1, mod + (size_t)(row0 >> 12) * 3072 + 1024, lane); vec_add1(vsc1);
    int row = row0;
    RowV cur; u32x2 tc[4]; row_load(cur, xin + (size_t)row * 1024, lane); row_load_t(tc, T + (size_t)row * 1024, lane);
    for (; row < row0 + 32; ++row) {
        const int nrow = row + 1; RowV nx; u32x2 tn[4];
        if (nrow < row0 + 32) { row_load(nx, xin + (size_t)nrow * 1024, lane); row_load_t(tn, T + (size_t)nrow * 1024, lane); }
        RowV r = cur, h;
        if (l > 0) { const f32x2 st = stats[row]; row_ln_r(r, st.x, st.y, vgp, vbp); }
        {
#pragma unroll
          for (int j = 0; j < 4; ++j) { const f32x4 gt = vgate.v[j];
              f32x4 y; y[0] = __uint_as_float(tc[j].x << 16); y[1] = __uint_as_float(tc[j].x & 0xffff0000u); y[2] = __uint_as_float(tc[j].y << 16); y[3] = __uint_as_float(tc[j].y & 0xffff0000u);
              r.v[j] = r.v[j] * DN_ALPHA + gt * y; *(f32x4*)(z + (size_t)row * 1024 + 4 * lane + 256 * j) = r.v[j]; } }
        float mean, rstd; row_stats(r, mean, rstd); if (lane == 0) stats[row] = (f32x2){mean, rstd};
        row_ln_r(r, mean, rstd, vg, vb); row_mod_r(h, r, vsh, vsc1); row_store_bf16(h, H + (size_t)row * 1024, lane);
        float a[16];
#pragma unroll
        for (int e = 0; e < 16; ++e) a[e] = 0.f;
#pragma unroll
        for (int j = 0; j < 4; ++j)
#pragma unroll
            for (int q = 0; q < 4; ++q) { const float hv = h.v[j][q]; const LAS float* wp = rwl + (((j * 4 + q) * 4) * 64 + lane) * 4;
                const f32x4 w0 = *(const LAS f32x4*)wp, w1 = *(const LAS f32x4*)(wp + 256), w2 = *(const LAS f32x4*)(wp + 512), w3 = *(const LAS f32x4*)(wp + 768);
#pragma unroll
                for (int e = 0; e < 4; ++e) { a[e] += hv * w0[e]; a[4 + e] += hv * w1[e]; a[8 + e] += hv * w2[e]; a[12 + e] += hv * w3[e]; }
                __builtin_amdgcn_sched_barrier(0); }
#pragma unroll
        for (int e = 0; e < 16; ++e) a[e] = wave_sum(a[e]);
        float sc[16], bi[16];
#pragma unroll
        for (int e = 0; e < 16; ++e) { sc[e] = sigmoidf_(a[e]); bi[e] = sc[e] + rb[e]; }
        int grp = 0; float best = -INFINITY;
#pragma unroll
        for (int gI = 0; gI < 4; ++gI) { float m1 = -INFINITY, m2 = -INFINITY;
#pragma unroll
            for (int q = 0; q < 4; ++q) { const float v = bi[4 * gI + q]; if (v > m1) { m2 = m1; m1 = v; } else if (v > m2) m2 = v; }
            const float gs = m1 + m2; if (gs > best) { best = gs; grp = gI; } }
        int e0 = 0, e1 = 0; float b0 = -INFINITY, b1 = -INFINITY, s0 = 0.f, s1 = 0.f;
#pragma unroll
        for (int gI = 0; gI < 4; ++gI)
#pragma unroll
            for (int q = 0; q < 4; ++q) { const int e = 4 * gI + q; if (gI == grp) { const float v = bi[e];
                if (v > b0) { b1 = b0; e1 = e0; s1 = s0; b0 = v; e0 = e; s0 = sc[e]; } else if (v > b1) { b1 = v; e1 = e; s1 = sc[e]; } } }
        const float inv = 1.0f / (s0 + s1);
        if (lane == 0) { const int li = wv * 32 + it_; const unsigned q0 = __hip_atomic_fetch_add(lcnt + e0, 1u, __ATOMIC_RELAXED, __HIP_MEMORY_SCOPE_WORKGROUP), q1 = __hip_atomic_fetch_add(lcnt + e1, 1u, __ATOMIC_RELAXED, __HIP_MEMORY_SCOPE_WORKGROUP);
                         lrec[li * 4 + 0] = (unsigned)e0 | (q0 << 8); lrec[li * 4 + 1] = (unsigned)e1 | (q1 << 8); lrec[li * 4 + 2] = __float_as_uint(s0 * inv); lrec[li * 4 + 3] = __float_as_uint(s1 * inv); }
        ++it_;
        cur = nx;
#pragma unroll
        for (int j = 0; j < 4; ++j) tc[j] = tn[j];
    }
    __syncthreads();
    if (tid < 16) lbase[tid] = atomicAdd(cnt + tid, lcnt[tid]);
    __syncthreads();
    if (tid < 256) { const int grow = blk * 256 + tid;
        const unsigned r0 = lrec[tid * 4 + 0], r1 = lrec[tid * 4 + 1]; const unsigned e0 = r0 & 255u, e1 = r1 & 255u;
        const size_t p0 = (size_t)e0 * MTOK + lbase[e0] + (r0 >> 8), p1 = (size_t)e1 * MTOK + lbase[e1] + (r1 >> 8);
        list[p0] = grow * 2; cw[p0] = __uint_as_float(lrec[tid * 4 + 2]); list[p1] = grow * 2 + 1; cw[p1] = __uint_as_float(lrec[tid * 4 + 3]); }
}
__device__ __forceinline__ void prep_next(const Params& p, int l, bool final_, const int tid, const int blk) {
    const int lane = tid & 63, wv = tid >> 6;
    float* z = p.out; bf16_t* H = (bf16_t*)(p.ws + WS_H); const float* modm = (const float*)(p.ws + WS_MOD) + (size_t)(l * 2 + 1) * 16 * 3072;
    const float* modn = (const float*)(p.ws + WS_MOD) + (size_t)((final_ ? l : l + 1) * 2) * 16 * 3072;
    f32x2* stats = (f32x2*)(p.ws + WS_STATS);
    const bf16_t* out2 = (const bf16_t*)(p.ws + WS_R + R_OUT2);
    const int row0 = (blk * 8 + wv) * 32, bt = row0 >> 12;
    RowV vg0, vb0, vg1, vb1, vgate, vsh, vsc1;
    vec_load(vg0, p.in[IN_LNG] + (size_t)(l * 2) * 1024, lane); vec_load(vb0, p.in[IN_LNB] + (size_t)(l * 2) * 1024, lane);
    vec_load(vg1, p.in[IN_LNG] + (size_t)(l * 2 + 1) * 1024, lane); vec_load(vb1, p.in[IN_LNB] + (size_t)(l * 2 + 1) * 1024, lane);
    vec_load(vgate, modm + (size_t)bt * 3072 + 2048, lane); vec_load(vsh, modn + (size_t)bt * 3072, lane); vec_load(vsc1, modn + (size_t)bt * 3072 + 1024, lane); vec_add1(vsc1);
    int row = row0;
    RowV cur; u32x2 ta[4], tb[4]; row_load(cur, z + (size_t)row * 1024, lane); row_load_t(ta, out2 + (size_t)(row * 2) * 1024, lane); row_load_t(tb, out2 + (size_t)(row * 2 + 1) * 1024, lane);
    for (; row < row0 + 32; ++row) {
        const int nrow = row + 1; RowV nx; u32x2 na[4], nb[4];
        if (nrow < row0 + 32) { row_load(nx, z + (size_t)nrow * 1024, lane); row_load_t(na, out2 + (size_t)(nrow * 2) * 1024, lane); row_load_t(nb, out2 + (size_t)(nrow * 2 + 1) * 1024, lane); }
        RowV r = cur;
        const f32x2 st = stats[row]; row_ln_r(r, st.x, st.y, vg0, vb0);
#pragma unroll
        for (int j = 0; j < 4; ++j) { const u32x2 oa = ta[j], ob = tb[j];
            f32x4 y; y[0] = __uint_as_float(oa.x << 16) + __uint_as_float(ob.x << 16); y[1] = __uint_as_float(oa.x & 0xffff0000u) + __uint_as_float(ob.x & 0xffff0000u);
            y[2] = __uint_as_float(oa.y << 16) + __uint_as_float(ob.y << 16); y[3] = __uint_as_float(oa.y & 0xffff0000u) + __uint_as_float(ob.y & 0xffff0000u);
            r.v[j] = r.v[j] * DN_ALPHA + vgate.v[j] * y; }
        cur = nx;
#pragma unroll
        for (int j = 0; j < 4; ++j) { ta[j] = na[j]; tb[j] = nb[j]; }
        float mean, rstd; row_stats(r, mean, rstd);
        if (final_) { row_ln_r(r, mean, rstd, vg1, vb1);
#pragma unroll
            for (int j = 0; j < 4; ++j) *(f32x4*)(z + (size_t)row * 1024 + 4 * lane + 256 * j) = r.v[j];
        } else {
#pragma unroll
            for (int j = 0; j < 4; ++j) *(f32x4*)(z + (size_t)row * 1024 + 4 * lane + 256 * j) = r.v[j];
            if (lane == 0) stats[row] = (f32x2){mean, rstd};
            RowV h; row_ln_r(r, mean, rstd, vg1, vb1); row_mod_r(h, r, vsh, vsc1); row_store_bf16(h, H + (size_t)row * 1024, lane); row_store_fp8(h, p.ws + WS_H8 + (size_t)row * 1024, lane); }
    }
}

__device__ __forceinline__ int q_next(unsigned* ctr, volatile LAS int* slot, const int tid) {
    __syncthreads();
    if (tid == 0) *slot = (int)__hip_atomic_fetch_add(ctr, 1u, __ATOMIC_RELAXED, __HIP_MEMORY_SCOPE_AGENT);
    __syncthreads();
    return *slot;
}

struct GdnRaw { u32x4 v[4]; float a, bg; };
__device__ __forceinline__ void gdn_prep_load(GdnRaw& g, int unit, const int tid) {
    unsigned char* ws = ws_late(); const int n = unit & 63, h = (unit >> 6) & 3, bl = unit >> 8; const int tok0 = bl * SEQ + n * 64;
    const bf16_t* proj = (const bf16_t*)(ws + WS_R + R_PROJ); const float* sm = (const float*)(ws + WS_R + R_SM);
#pragma unroll
    for (int j = 0; j < 4; ++j) { const int idx = tid + j * NTHR; const int row = idx / 24, ch = idx % 24, seg = ch >> 3, c8 = ch & 7;
        u32x4 v = {0u, 0u, 0u, 0u};
        if (idx < 67 * 24 && (n > 0 || row >= 3)) v = *(const u32x4*)(proj + (size_t)(tok0 + row - 3) * PROJW + seg * 256 + h * 64 + c8 * 8);
        g.v[j] = v; }
    g.a = 0.f; g.bg = 0.f;
    if (tid < 64) { g.a = sm[(size_t)(tok0 + tid) * 32 + h]; g.bg = sm[(size_t)(tok0 + tid) * 32 + 4 + h]; }
}
__device__ __forceinline__ void gdn_prep_unit(const Params& p, int l, int unit, LAS unsigned char* lds, const int tid_in_, const GdnRaw& graw) {
    int tid = tid_in_; asm volatile("" : "+v"(tid)); unsigned char* wsl_ = ws_late();
    const int lane = tid & 63;
    const int n = unit & 63, h = (unit >> 6) & 3, bl = unit >> 8;
    const int tok0 = bl * SEQ + n * 64;
    const bf16_t* proj = (const bf16_t*)(wsl_ + WS_R + R_PROJ); const float* sm = (const float*)(wsl_ + WS_R + R_SM);
    LAS bf16_t* raw = (LAS bf16_t*)lds;
    LAS float* qs = (LAS float*)(lds + 26112); LAS float* ks = qs + 64 * 65; LAS float* vs = ks + 64 * 65;
    LAS float* Lm = vs + 64 * 65;
    LAS float* bc = Lm + 4096; LAS float* eb = bc + 64; LAS float* be = eb + 64; LAS float* cwt = be + 64;
    __syncthreads();
#pragma unroll
    for (int j = 0; j < 4; ++j) { const int idx = tid + j * NTHR; const int row = idx / 24, ch = idx % 24, seg = ch >> 3, c8 = ch & 7;
        if (idx < 67 * 24) *(LAS u32x4*)(raw + row * 192 + seg * 64 + c8 * 8) = graw.v[j]; }
    for (int idx = tid; idx < 768; idx += NTHR) { const int k = idx / 192, ch = idx % 192; cwt[idx] = PIN(IN_CONVW)[(size_t)l * 4 * 768 + k * 768 + (ch >> 6) * 256 + h * 64 + (ch & 63)]; }
    __syncthreads();
#ifdef GP_REP_CONV
    for (int rep_ = 0; rep_ < 2; ++rep_)
#endif
    for (int idx = tid; idx < 64 * 192; idx += NTHR) { const int t = idx / 192, ch = idx % 192; float s = 0.f;
#pragma unroll
        for (int k = 0; k < 4; ++k) s += cwt[k * 192 + ch] * bf2f(raw[(t + k) * 192 + ch]);
        s = siluf_(s); const int seg = ch >> 6, d = ch & 63; (seg == 0 ? qs : seg == 1 ? ks : vs)[t * 65 + d] = s; }
    __syncthreads();
    LAS unsigned char* qb = lds + 129024; LAS unsigned char* kb = qb + 8192; LAS float* Rs = (LAS float*)(kb + 8192);
    {
        const int mat = tid >> 8, row = (tid >> 2) & 63, q4 = tid & 3; LAS float* mt = mat ? ks : qs; float x[16], ss = 0.f;
#pragma unroll
        for (int d = 0; d < 16; ++d) { x[d] = mt[row * 65 + 16 * q4 + d]; ss += x[d] * x[d]; }
        ss += swz_xor<1>(ss); ss += swz_xor<2>(ss);
        const float sc = (1.0f / sqrtf(ss + 1e-6f)) * (mat ? 1.0f : 0.125f);
#pragma unroll
        for (int d = 0; d < 16; ++d) { x[d] *= sc; mt[row * 65 + 16 * q4 + d] = x[d]; }
        LAS unsigned char* ob = (mat ? kb : qb) + (2 * q4) * 1024 + row * 16;
        u32x4 w0, w1; w0.x = pk2(x[0], x[1]); w0.y = pk2(x[2], x[3]); w0.z = pk2(x[4], x[5]); w0.w = pk2(x[6], x[7]); w1.x = pk2(x[8], x[9]); w1.y = pk2(x[10], x[11]); w1.z = pk2(x[12], x[13]); w1.w = pk2(x[14], x[15]);
        *(LAS u32x4*)ob = w0; *(LAS u32x4*)(ob + 1024) = w1;
    }
    if (tid < 64) { const int i = tid;
        const float a = graw.a, bg = graw.bg;
        const float x = a + PIN(IN_DTB)[l * 4 + h]; const float sp = fmaxf(x, 0.f) + log1pf(__expf(-fabsf(x)));
        float la = -__expf(PIN(IN_ALOG)[l * 4 + h]) * sp;
#pragma unroll
        for (int o = 1; o < 64; o <<= 1) { const float v = shfl_up_l(la, o, lane); if (lane >= o) la += v; }
        bc[i] = la; eb[i] = __expf(la); be[i] = sigmoidf_(bg); }
    __syncthreads();
    const size_t ub = WS_R + R_GDN + (size_t)unit * GDN_UNIT_BYTES;
    bf16_t* gW = (bf16_t*)(wsl_ + ub); bf16_t* gATT = gW + 4096; bf16_t* gQD = gW + 8192; bf16_t* gKDT = gW + 12288; bf16_t* gU0 = gW + 16384;
#ifdef GP_REP_KK
    for (int rep_ = 0; rep_ < 2; ++rep_)
#endif
    {
        const int wid = tid >> 6, r32 = lane & 31, hi = lane >> 5, isq = wid >> 2, it = (wid >> 1) & 1, jt = wid & 1;
        const LAS unsigned char* ab = (isq ? qb : kb) + hi * 1024 + (32 * it + r32) * 16; const LAS unsigned char* bb = kb + hi * 1024 + (32 * jt + r32) * 16;
        f32x16 acc = z16();
#pragma unroll
        for (int d0 = 0; d0 < 4; ++d0) acc = MF32(*(const LAS bf16x8*)(ab + d0 * 2048), *(const LAS bf16x8*)(bb + d0 * 2048), acc);
        const int j = 32 * jt + r32; const float bj = bc[j];
#pragma unroll
        for (int g = 0; g < 4; ++g) { f32x4 lv;
#pragma unroll
            for (int e = 0; e < 4; ++e) { const int i = 32 * it + 8 * g + 4 * hi + e; const float dc = __expf(bc[i] - bj), v = acc[4 * g + e] * dc;
                if (isq) gATT[i * 64 + j] = f2bf((j <= i) ? v : 0.f); else lv[e] = (j < i) ? be[i] * v : 0.f; }
            if (!isq) *(LAS f32x4*)(Lm + j * 64 + 32 * it + 8 * g + 4 * hi) = lv; }
    }
    __syncthreads();
    {
        const float bl_ = bc[63];
        for (int task = tid; task < 1024; task += NTHR) {
            if (task < 512) { const int c2 = task >> 3, sg = task & 7; const float e = eb[c2]; float v[8];
#pragma unroll
                for (int j = 0; j < 8; ++j) v[j] = qs[c2 * 65 + sg * 8 + j] * e;
                u32x4 w; w.x = pk2(v[0], v[1]); w.y = pk2(v[2], v[3]); w.z = pk2(v[4], v[5]); w.w = pk2(v[6], v[7]); *(u32x4*)(gQD + c2 * 64 + sg * 8) = w;
            } else { const int k = (task - 512) >> 3, sg = task & 7; float v[8];
#pragma unroll
                for (int j = 0; j < 8; ++j) { const int c2 = sg * 8 + j; v[j] = ks[c2 * 65 + k] * __expf(bl_ - bc[c2]); }
                u32x4 w; w.x = pk2(v[0], v[1]); w.y = pk2(v[2], v[3]); w.z = pk2(v[4], v[5]); w.w = pk2(v[6], v[7]); *(u32x4*)(gKDT + k * 64 + sg * 8) = w; }
        }
        if (tid == 0) ((float*)(wsl_ + WS_R + R_GG))[unit] = __expf(bl_);
    }
    {
        const int c = 16 * (tid >> 6) + (lane & 15), cc = c & 63, rg = lane >> 4; const bool isw = c >= 64; LAS float* Xs = cwt + 768;
        for (int I = 0; I < 4; ++I) {
            float r[4];
#pragma unroll
            for (int e = 0; e < 4; ++e) { const int i = 16 * I + 4 * rg + e; r[e] = isw ? be[i] * eb[i] * ks[i * 65 + cc] : be[i] * vs[i * 65 + cc]; }
#pragma unroll 4
            for (int j = 0; j < 16 * I; ++j) { const float xj = Xs[j * 128 + c]; const f32x4 l4 = *(const LAS f32x4*)(Lm + j * 64 + 16 * I + 4 * rg);
#pragma unroll
                for (int e = 0; e < 4; ++e) r[e] -= l4[e] * xj; }
#pragma unroll
            for (int e = 0; e < 4; ++e) Rs[(4 * rg + e) * 128 + c] = r[e];
            asm volatile("s_waitcnt lgkmcnt(0)" ::: "memory");
            if (lane < 16) { float q[16];
#pragma unroll
                for (int ii = 0; ii < 16; ++ii) q[ii] = Rs[ii * 128 + c];
#pragma unroll
                for (int jj = 0; jj < 15; ++jj) { const LAS float* lt = Lm + (16 * I + jj) * 64 + 16 * I;
#pragma unroll
                    for (int ii = jj + 1; ii < 16; ++ii) q[ii] -= lt[ii] * q[jj]; }
#pragma unroll
                for (int ii = 0; ii < 16; ++ii) { Xs[(16 * I + ii) * 128 + c] = q[ii]; (isw ? gW : gU0)[(16 * I + ii) * 64 + cc] = f2bf(q[ii]); }
            }
            asm volatile("s_waitcnt lgkmcnt(0)" ::: "memory");
        }
    }
    __syncthreads();
}

__device__ __forceinline__ bf16x8 afrag_perm(const LAS unsigned char* M, int row, int ks, int hi) {
    const LAS unsigned char* q = M + row * 144 + (16 * ks + 4 * hi) * 2;
    const s16x4 lo = *(const LAS s16x4*)q, hi4 = *(const LAS s16x4*)(q + 16);
    return (bf16x8){lo[0], lo[1], lo[2], lo[3], hi4[0], hi4[1], hi4[2], hi4[3]};
}
__device__ __forceinline__ bf16x8 pack_acc8(const f32x16& a, int s) {
    u32x4 w; w.x = pk2(a[8 * s + 0], a[8 * s + 1]); w.y = pk2(a[8 * s + 2], a[8 * s + 3]); w.z = pk2(a[8 * s + 4], a[8 * s + 5]); w.w = pk2(a[8 * s + 6], a[8 * s + 7]);
    return __builtin_bit_cast(bf16x8, w);
}
__device__ __forceinline__ void gdn_scan_item(const Params& p, int l, int chunk, int item, LAS unsigned char* lds, const int tid) {
    const int lane = tid & 63, wid = tid >> 6, vl = lane & 31, hi = lane >> 5;
    const int h = item & 3, bl = item >> 2;
    const unsigned char* ubase = p.ws + WS_R + R_GDN + (size_t)item * 64 * GDN_UNIT_BYTES;
    const float* gg = (const float*)(p.ws + WS_R + R_GG) + item * 64;
    const bf16_t* proj = (const bf16_t*)(p.ws + WS_R + R_PROJ); bf16_t* og = (bf16_t*)(p.ws + WS_R + R_O);
    const float* nw = PIN(IN_GNORM) + l * 64;
    constexpr int BUF = 5 * 9216;
    LAS unsigned char* buf0 = lds; LAS float* ob0 = (LAS float*)(lds + 2 * BUF);
    __syncthreads();
    for (int q = tid; q < 2560; q += NTHR) { const int mat = q >> 9, r = (q >> 3) & 63, sg = q & 7;
        *(LAS u32x4*)(buf0 + mat * 9216 + r * 144 + sg * 16) = *(const u32x4*)(ubase + mat * 8192 + r * 128 + sg * 16); }
    __syncthreads();
    f32x16 S[2]; S[0] = z16(); S[1] = z16();
    for (int n = 0; n < 64; ++n) {
        LAS unsigned char* bf = buf0 + (n & 1) * BUF; LAS float* ob = ob0 + (n & 1) * 4096;
        if (wid < 2) {
            const LAS unsigned char* Wm = bf; const LAS unsigned char* ATT = bf + 9216; const LAS unsigned char* QD = bf + 18432; const LAS unsigned char* KDT = bf + 27648; const LAS bf16_t* U0 = (const LAS bf16_t*)(bf + 36864);
            const float G = gg[n];
            bf16x8 Sb[4]; Sb[0] = pack_acc8(S[0], 0); Sb[1] = pack_acc8(S[0], 1); Sb[2] = pack_acc8(S[1], 0); Sb[3] = pack_acc8(S[1], 1);
            f32x16 u[2];
#pragma unroll
            for (int ct = 0; ct < 2; ++ct) { f32x16 a = z16();
#pragma unroll
                for (int ks = 0; ks < 4; ++ks) a = __builtin_amdgcn_mfma_f32_32x32x16_bf16(afrag_perm(Wm, 32 * ct + vl, ks, hi), Sb[ks], a, 0, 0, 0);
#pragma unroll
                for (int r = 0; r < 16; ++r) u[ct][r] = bf2f(U0[(32 * ct + crow(r, hi)) * 72 + 32 * wid + vl]) - a[r]; }
            bf16x8 ub[4]; ub[0] = pack_acc8(u[0], 0); ub[1] = pack_acc8(u[0], 1); ub[2] = pack_acc8(u[1], 0); ub[3] = pack_acc8(u[1], 1);
#pragma unroll
            for (int ct = 0; ct < 2; ++ct) { f32x16 a = z16();
#pragma unroll
                for (int ks = 0; ks < 4; ++ks) a = __builtin_amdgcn_mfma_f32_32x32x16_bf16(afrag_perm(QD, 32 * ct + vl, ks, hi), Sb[ks], a, 0, 0, 0);
#pragma unroll
                for (int cs = 0; cs < 4; ++cs) a = __builtin_amdgcn_mfma_f32_32x32x16_bf16(afrag_perm(ATT, 32 * ct + vl, cs, hi), ub[cs], a, 0, 0, 0);
#pragma unroll
                for (int r = 0; r < 16; ++r) ob[(32 * ct + crow(r, hi)) * 64 + 32 * wid + vl] = a[r]; }
#pragma unroll
            for (int kt = 0; kt < 2; ++kt) { f32x16 a = S[kt] * G;
#pragma unroll
                for (int cs = 0; cs < 4; ++cs) a = __builtin_amdgcn_mfma_f32_32x32x16_bf16(afrag_perm(KDT, 32 * kt + vl, cs, hi), ub[cs], a, 0, 0, 0);
                S[kt] = a; }
        } else {
            if (n + 1 < 64) { LAS unsigned char* nb = buf0 + ((n + 1) & 1) * BUF; const unsigned char* src = ubase + (size_t)(n + 1) * GDN_UNIT_BYTES;
                for (int q = tid - 128; q < 2560; q += 384) { const int mat = q >> 9, r = (q >> 3) & 63, sg = q & 7;
                    *(LAS u32x4*)(nb + mat * 9216 + r * 144 + sg * 16) = *(const u32x4*)(src + mat * 8192 + r * 128 + sg * 16); } }
        }
        if (wid >= 2 && n >= 1) { const LAS float* po = ob0 + ((n - 1) & 1) * 4096; const int tokb = bl * SEQ + (n - 1) * 64;
            for (int task = tid - 128; task < 512; task += 384) { const int c = task >> 3, sg = task & 7; float v[8], ss = 0.f;
#pragma unroll
                for (int j = 0; j < 8; ++j) { v[j] = po[c * 64 + sg * 8 + j]; ss += v[j] * v[j]; }
                ss += swz_xor<1>(ss); ss += swz_xor<2>(ss); ss += swz_xor<4>(ss);
                const float rs = 1.0f / sqrtf(ss * (1.0f / 64.0f) + 1e-6f);
                const u32x4 zw = *(const u32x4*)(proj + (size_t)(tokb + c) * PROJW + PC_GZ + h * 64 + sg * 8); const unsigned zz[4] = {zw.x, zw.y, zw.z, zw.w};
#pragma unroll
                for (int j = 0; j < 8; ++j) { const float zf = (j & 1) ? __uint_as_float(zz[j >> 1] & 0xffff0000u) : __uint_as_float(zz[j >> 1] << 16); v[j] = v[j] * rs * nw[sg * 8 + j] * siluf_(zf); }
                u32x4 w; w.x = pk2(v[0], v[1]); w.y = pk2(v[2], v[3]); w.z = pk2(v[4], v[5]); w.w = pk2(v[6], v[7]);
                *(u32x4*)(og + (size_t)(tokb + c) * 256 + h * 64 + sg * 8) = w; } }
        __syncthreads();
    }
    { const LAS float* po = ob0 + 4096; const int tokb = bl * SEQ + 63 * 64;
        for (int task = tid; task < 512; task += NTHR) { const int c = task >> 3, sg = task & 7; float v[8], ss = 0.f;
#pragma unroll
            for (int j = 0; j < 8; ++j) { v[j] = po[c * 64 + sg * 8 + j]; ss += v[j] * v[j]; }
            ss += swz_xor<1>(ss); ss += swz_xor<2>(ss); ss += swz_xor<4>(ss);
            const float rs = 1.0f / sqrtf(ss * (1.0f / 64.0f) + 1e-6f);
            const u32x4 zw = *(const u32x4*)(proj + (size_t)(tokb + c) * PROJW + PC_GZ + h * 64 + sg * 8); const unsigned zz[4] = {zw.x, zw.y, zw.z, zw.w};
#pragma unroll
            for (int j = 0; j < 8; ++j) { const float zf = (j & 1) ? __uint_as_float(zz[j >> 1] & 0xffff0000u) : __uint_as_float(zz[j >> 1] << 16); v[j] = v[j] * rs * nw[sg * 8 + j] * siluf_(zf); }
            u32x4 w; w.x = pk2(v[0], v[1]); w.y = pk2(v[2], v[3]); w.z = pk2(v[4], v[5]); w.w = pk2(v[6], v[7]);
            *(u32x4*)(og + (size_t)(tokb + c) * 256 + h * 64 + sg * 8) = w; } }
    __syncthreads();
}

__device__ __forceinline__ void fox_cum_item(const Params& p, int l, int item, LAS float* lf, const int tid) {
    const int lane = tid & 63, wid = tid >> 6, h = item & 3, bl = item >> 2;
    const float* sm = (const float*)(p.ws + WS_R + R_SM); float* nb = (float*)(p.ws + WS_R + R_CUM) + (size_t)item * SEQ;
    const float fb = PIN(IN_FBIAS)[l * 4 + h];
    float v[8], run = 0.f;
#pragma unroll
    for (int j = 0; j < 8; ++j) { const float x = sm[(size_t)(bl * SEQ + tid * 8 + j) * 32 + 20 + h] + fb; run += fminf(x, 0.f) - log1pf(__expf(-fabsf(x))); v[j] = run; }
    float inc = run;
#pragma unroll
    for (int o = 1; o < 64; o <<= 1) { const float t = shfl_up_l(inc, o, lane); if (lane >= o) inc += t; }
    __syncthreads();
    if (lane == 63) lf[wid] = inc;
    __syncthreads();
    float base = inc - run;
    for (int w = 0; w < wid; ++w) base += lf[w];
#pragma unroll
    for (int j = 0; j < 8; ++j) nb[tid * 8 + j] = -(base + v[j]) * LOG2E;
    __syncthreads();
}
__device__ __forceinline__ void ret_rope_pass(const Params& p, int chunk, const int tid, const int blk) {
    bf16_t* proj = (bf16_t*)(p.ws + WS_R + R_PROJ); const f32x2* tab = (const f32x2*)(p.ws + WS_ROPE);
    for (int task = blk * NTHR + tid; task < MC * 32; task += NWG * NTHR) {
        const int row = task >> 5, which = (task >> 4) & 1, h = (task >> 2) & 3, i8 = task & 3;
        bf16_t* q1 = proj + (size_t)row * PROJW + (which ? PC_RK : PC_RQ) + h * 64 + i8 * 8; bf16_t* q2 = q1 + 32;
        const u32x4 a = *(const u32x4*)q1, b = *(const u32x4*)q2; const unsigned aa[4] = {a.x, a.y, a.z, a.w}, bb[4] = {b.x, b.y, b.z, b.w};
        const f32x2* tp = tab + (size_t)(chunk * MC + row) * 32 + i8 * 8; float o1[8], o2[8];
#pragma unroll
        for (int j = 0; j < 8; ++j) { const float x1 = (j & 1) ? __uint_as_float(aa[j >> 1] & 0xffff0000u) : __uint_as_float(aa[j >> 1] << 16);
            const float x2 = (j & 1) ? __uint_as_float(bb[j >> 1] & 0xffff0000u) : __uint_as_float(bb[j >> 1] << 16);
            const f32x2 cs = tp[j]; o1[j] = x1 * cs.x - x2 * cs.y; o2[j] = x1 * cs.y + x2 * cs.x; }
        u32x4 w1, w2; w1.x = pk2(o1[0], o1[1]); w1.y = pk2(o1[2], o1[3]); w1.z = pk2(o1[4], o1[5]); w1.w = pk2(o1[6], o1[7]);
        w2.x = pk2(o2[0], o2[1]); w2.y = pk2(o2[2], o2[3]); w2.z = pk2(o2[4], o2[5]); w2.w = pk2(o2[6], o2[7]);
        *(u32x4*)q1 = w1; *(u32x4*)q2 = w2; }
}

constexpr int AL_K0 = 0, AL_V0 = 16384, AL_B0 = 32768;
__device__ __forceinline__ s16x4 vtr(const LAS unsigned char* q) {
    typedef short v4i16_t __attribute__((ext_vector_type(4)));
    return __builtin_bit_cast(s16x4, __builtin_amdgcn_ds_read_tr16_b64_v4i16((LAS v4i16_t*)q));
}
__device__ __forceinline__ void attn_qkt(f32x16& p0, f32x16& p1, const LAS unsigned char* kslot, const bf16x8 (&qf)[4], int r32, int hi) {
    p0 = z16(); p1 = z16();
#pragma unroll
    for (int d0 = 0; d0 < 4; ++d0) { const LAS unsigned char* kb = kslot + (2 * d0 + hi) * 1024 + r32 * 16;
        const bf16x8 b0 = *(const LAS bf16x8*)kb, b1 = *(const LAS bf16x8*)(kb + 512);
        p0 = MF32(b0, qf[d0], p0); p1 = MF32(b1, qf[d0], p1); }
}
__device__ __forceinline__ void attn_pv(f32x16 (&o)[2], const LAS unsigned char* vslot, const bf16x8 (&pw)[4], int lane, int hi) {
    const LAS unsigned char* vb = vslot + ((lane >> 4) & 1) * 32 + (lane & 3) * 8 + (4 * hi + ((lane & 15) >> 2)) * 64;
#pragma unroll
    for (int d0 = 0; d0 < 2; ++d0)
#pragma unroll
        for (int ks = 0; ks < 4; ++ks) { const s16x4 lo = vtr(vb + d0 * 4096 + ks * 1024), h4 = vtr(vb + d0 * 4096 + ks * 1024 + 512);
            const bf16x8 vf = (bf16x8){lo[0], lo[1], lo[2], lo[3], h4[0], h4[1], h4[2], h4[3]};
            o[d0] = MF32(vf, pw[ks], o[d0]); }
}
__device__ __forceinline__ void attn_softmax_step(f32x16& p0, f32x16& p1, f32x16 (&o)[2], float& m, float& l) {
    float mt = p0[0];
#pragma unroll
    for (int r = 1; r < 16; ++r) mt = fmaxf(mt, p0[r]);
#pragma unroll
    for (int r = 0; r < 16; ++r) mt = fmaxf(mt, p1[r]);
    mt = x32_max(mt);
    const float mn = fmaxf(m, mt), ms = (mn == -INFINITY) ? 0.f : mn, alpha = ex2(m - ms);
    float s = 0.f;
#pragma unroll
    for (int r = 0; r < 16; ++r) { p0[r] = ex2(p0[r] - ms); p1[r] = ex2(p1[r] - ms); s += p0[r] + p1[r]; }
    l = l * alpha + s; m = mn;
    if (__builtin_amdgcn_ballot_w64(alpha != 1.0f) != 0ull) { o[0] *= alpha; o[1] *= alpha; }
}
template <class F>
__device__ __forceinline__ void flash_loop(const F& f, int tlo, int thi, const bf16_t* Kg, const bf16_t* Vg, int pitch, const float* biasg,
                                           const bf16x8 (&qf)[4], f32x16 (&o)[2], float& m, float& l, LAS unsigned char* lds, const int tid) {
    const int lane = tid & 63, wid = tid >> 6, r32 = lane & 31, hi = lane >> 5;
    int t = thi - 1; while (t >= tlo && f.skip(t)) --t;
    __syncthreads();
    if (t < tlo) return;
    const bf16_t* ksrc = Kg + (size_t)lane * pitch + wid * 8;
    const bf16_t* vsrc = Vg + (size_t)(16 * (wid & 3) + (lane >> 2)) * pitch + (wid >> 2) * 32 + (lane & 3) * 8;
    const int sdst = wid * 1024 + lane * 16;
    u32x4 kr = *(const u32x4*)(ksrc + (size_t)t * 64 * pitch), vr = *(const u32x4*)(vsrc + (size_t)t * 64 * pitch); float br = 0.f;
    const int btid = tid & 63;
    if (F::HAS_BIAS) br = biasg[t * 64 + btid];
    *(LAS u32x4*)(lds + AL_K0 + sdst) = kr; *(LAS u32x4*)(lds + AL_V0 + sdst) = vr; if (F::HAS_BIAS) ((LAS float*)(lds + AL_B0))[btid] = br;
    __syncthreads();
    int cur = 0;
    for (;;) {
        int tn = t - 1; while (tn >= tlo && f.skip(tn)) --tn;
        if (tn >= tlo) { kr = *(const u32x4*)(ksrc + (size_t)tn * 64 * pitch); vr = *(const u32x4*)(vsrc + (size_t)tn * 64 * pitch); if (F::HAS_BIAS) br = biasg[tn * 64 + btid]; }
        if (!f.wskip(t)) {
        f32x16 p0, p1;
        attn_qkt(p0, p1, lds + AL_K0 + cur * 8192, qf, r32, hi);
        if (F::HAS_BIAS) { const LAS float* bp = (const LAS float*)(lds + AL_B0 + cur * 256);
#pragma unroll
            for (int g = 0; g < 4; ++g) { const f32x4 b0 = *(const LAS f32x4*)(bp + 8 * g + 4 * hi), b1 = *(const LAS f32x4*)(bp + 32 + 8 * g + 4 * hi);
#pragma unroll
                for (int e = 0; e < 4; ++e) { p0[4 * g + e] += b0[e]; p1[4 * g + e] += b1[e]; } } }
        f.apply(p0, p1, t);
        if (F::MODE == 0) attn_softmax_step(p0, p1, o, m, l);
        bf16x8 pw[4]; pw[0] = pack_acc8(p0, 0); pw[1] = pack_acc8(p0, 1); pw[2] = pack_acc8(p1, 0); pw[3] = pack_acc8(p1, 1);
        attn_pv(o, lds + AL_V0 + cur * 8192, pw, lane, hi);
        }
        if (tn < tlo) break;
        cur ^= 1;
        *(LAS u32x4*)(lds + AL_K0 + cur * 8192 + sdst) = kr; *(LAS u32x4*)(lds + AL_V0 + cur * 8192 + sdst) = vr; if (F::HAS_BIAS) ((LAS float*)(lds + AL_B0 + cur * 256))[btid] = br;
        __syncthreads();
        t = tn;
    }
    __syncthreads();
}
__device__ __forceinline__ void load_qf(bf16x8 (&qf)[4], const bf16_t* qrow, int hi) {
#pragma unroll
    for (int d0 = 0; d0 < 4; ++d0) qf[d0] = *(const bf16x8*)(qrow + d0 * 16 + hi * 8);
}
__device__ __forceinline__ void store_ot(const f32x16 (&o)[2], bf16_t* orow, int hi) {
#pragma unroll
    for (int d0 = 0; d0 < 2; ++d0)
#pragma unroll
        for (int g = 0; g < 4; ++g) { u32x2 w; w.x = pk2(o[d0][4 * g], o[d0][4 * g + 1]); w.y = pk2(o[d0][4 * g + 2], o[d0][4 * g + 3]); *(u32x2*)(orow + 32 * d0 + 8 * g + 4 * hi) = w; }
}

struct FoxF { static constexpr int MODE = 0; static constexpr bool HAS_BIAS = true; int tq, qmin, hi;
    __device__ __forceinline__ bool skip(int) const { return false; }
    __device__ __forceinline__ bool wskip(int) const { return false; }
    __device__ __forceinline__ void apply(f32x16& p0, f32x16& p1, int t) const { const float NI = ninf_();
        if (64 * t + 63 > qmin) {
#pragma unroll
            for (int r = 0; r < 16; ++r) { const int key = 64 * t + crow(r, hi); if (key > tq) p0[r] = NI; if (key + 32 > tq) p1[r] = NI; } } } };
struct RetF { static constexpr int MODE = 1; static constexpr bool HAS_BIAS = false; int tq, hi; float lg;
    __device__ __forceinline__ bool skip(int) const { return false; }
    __device__ __forceinline__ bool wskip(int) const { return false; }
    __device__ __forceinline__ void apply(f32x16& p0, f32x16& p1, int t) const { const float NI = ninf_();
#pragma unroll
        for (int r = 0; r < 16; ++r) { const int key = 64 * t + crow(r, hi);
            p0[r] = (key <= tq) ? p0[r] * ex2((float)(tq - key) * lg) : 0.f; p1[r] = (key + 32 <= tq) ? p1[r] * ex2((float)(tq - key - 32) * lg) : 0.f; } } };
struct SelF { static constexpr int MODE = 0; static constexpr bool HAS_BIAS = false; unsigned long long umask, wmask, mymask; int tq, klo, hi;
    __device__ __forceinline__ bool skip(int t) const { return ((umask >> t) & 1ull) == 0ull; }
    __device__ __forceinline__ bool wskip(int t) const { return ((wmask >> t) & 1ull) == 0ull; }
    int tdiag, tlo;
    __device__ __forceinline__ void apply(f32x16& p0, f32x16& p1, int t) const { const float NI = ninf_(); const bool on = ((mymask >> t) & 1ull) != 0ull;
        if (t >= tdiag || t <= tlo) {
#pragma unroll
            for (int r = 0; r < 16; ++r) { const int key = 64 * t + crow(r, hi); if (!on || key > tq || key <= klo) p0[r] = NI; if (!on || key + 32 > tq || key + 32 <= klo) p1[r] = NI; }
        } else if (__builtin_amdgcn_ballot_w64(!on) != 0ull) {
#pragma unroll
            for (int r = 0; r < 16; ++r) { if (!on) { p0[r] = NI; p1[r] = NI; } }
        } } };
__device__ __forceinline__ void fox_unit(const Params& p, int idx, LAS unsigned char* lds, const int tid_in_) {
    int tid = tid_in_; asm volatile("" : "+v"(tid)); unsigned char* wsl_ = ws_late();
    const int lane = tid & 63, wid = tid >> 6, r32 = lane & 31, hi = lane >> 5;
    const int qb = 15 - idx / (BC * 4), bh = idx % (BC * 4), h = bh & 3, bl = bh >> 2;
    const bf16_t* proj = (const bf16_t*)(wsl_ + WS_R + R_PROJ);
    const int tq = qb * 256 + wid * 32 + r32; const size_t rowc = (size_t)bl * SEQ + tq;
    bf16x8 qf[4]; load_qf(qf, proj + rowc * PROJW + PC_FQ + h * 64, hi);
    f32x16 o[2]; o[0] = z16(); o[1] = z16(); float m = -INFINITY, l = 0.f;
    FoxF f; f.tq = tq; f.qmin = qb * 256; f.hi = hi;
    flash_loop(f, 0, 4 * qb + 4, proj + (size_t)bl * SEQ * PROJW + PC_FK + h * 64, proj + (size_t)bl * SEQ * PROJW + PC_FV + h * 64, PROJW,
               (const float*)(wsl_ + WS_R + R_CUM) + (size_t)bh * SEQ, qf, o, m, l, lds, tid);
    l = x32_sum(l); const float inv = 1.0f / l; o[0] *= inv; o[1] *= inv;
    store_ot(o, (bf16_t*)(wsl_ + WS_R + R_O) + (size_t)3 * MC * 256 + rowc * 256 + h * 64, hi);
}
__device__ __forceinline__ void rope8(float (&o1)[8], float (&o2)[8], const u32x4& a, const u32x4& b, const f32x2* tp) {
    const unsigned aa[4] = {a.x, a.y, a.z, a.w}, bb[4] = {b.x, b.y, b.z, b.w};
#pragma unroll
    for (int j = 0; j < 8; ++j) { const float x1 = (j & 1) ? __uint_as_float(aa[j >> 1] & 0xffff0000u) : __uint_as_float(aa[j >> 1] << 16);
        const float x2 = (j & 1) ? __uint_as_float(bb[j >> 1] & 0xffff0000u) : __uint_as_float(bb[j >> 1] << 16);
        const f32x2 cs = tp[j]; o1[j] = x1 * cs.x - x2 * cs.y; o2[j] = x1 * cs.y + x2 * cs.x; }
}
__device__ __forceinline__ u32x4 pack8f(const float (&v)[8]) { u32x4 w; w.x = pk2(v[0], v[1]); w.y = pk2(v[2], v[3]); w.z = pk2(v[4], v[5]); w.w = pk2(v[6], v[7]); return w; }
__device__ __forceinline__ void ret_kv_unit(const Params& p, int ch, int idx, LAS unsigned char* lds, const int tid_in_) {
    int tid = tid_in_; asm volatile("" : "+v"(tid)); unsigned char* wsl_ = ws_late();
    const int lane = tid & 63, wid = tid >> 6, hi = lane >> 5;
    const int n = idx & 31, bh = idx >> 5, h = bh & 3, bl = bh >> 2;
    const bf16_t* proj = (const bf16_t*)(wsl_ + WS_R + R_PROJ); const f32x2* tab = (const f32x2*)(wsl_ + WS_ROPE);
    const size_t rowc0 = (size_t)bl * SEQ + n * 128; const float lg = log2f(1.0f - exp2f(-5.0f - (float)h));
    LAS unsigned char* KZ = lds; LAS unsigned char* VT = lds + 16384;
    __syncthreads();
    { const int key = tid >> 2, cp = tid & 3; const bf16_t* src = proj + (rowc0 + key) * PROJW + PC_RK + h * 64 + cp * 8;
      const u32x4 a = *(const u32x4*)src, b = *(const u32x4*)(src + 32); float o1[8], o2[8];
      rope8(o1, o2, a, b, tab + ((size_t)ch * MC + rowc0 + key) * 32 + cp * 8);
      const float zt = ex2((float)(127 - key) * lg);
#pragma unroll
      for (int j = 0; j < 8; ++j) { o1[j] *= zt; o2[j] *= zt; }
      LAS unsigned char* d = KZ + (key >> 6) * 8192 + ((key & 63) >> 4) * 1024 + (key & 15) * 64 + cp * 16;
      *(LAS u32x4*)d = pack8f(o1); *(LAS u32x4*)(d + 4096) = pack8f(o2); }
#pragma unroll
    for (int t2 = 0; t2 < 2; ++t2)
        *(LAS u32x4*)(VT + t2 * 8192 + wid * 1024 + lane * 16) = *(const u32x4*)(proj + (rowc0 + 64 * t2 + 16 * (wid & 3) + (lane >> 2)) * PROJW + PC_RV + h * 64 + (wid >> 2) * 32 + (lane & 3) * 8);
    __syncthreads();
    if (wid < 4) { const int vt = wid >> 1, kt = wid & 1;
        const int fo = ((lane >> 4) & 1) * 32 + (lane & 3) * 8 + (4 * hi + ((lane & 15) >> 2)) * 64;
        f32x16 acc = z16();
#pragma unroll
        for (int t2 = 0; t2 < 2; ++t2)
#pragma unroll
            for (int ks = 0; ks < 4; ++ks) { const LAS unsigned char* va = VT + t2 * 8192 + vt * 4096 + ks * 1024 + fo; const LAS unsigned char* ka = KZ + t2 * 8192 + kt * 4096 + ks * 1024 + fo;
                const s16x4 v0 = vtr(va), v1 = vtr(va + 512), k0 = vtr(ka), k1 = vtr(ka + 512);
                acc = MF32(((bf16x8){v0[0], v0[1], v0[2], v0[3], v1[0], v1[1], v1[2], v1[3]}), ((bf16x8){k0[0], k0[1], k0[2], k0[3], k1[0], k1[1], k1[2], k1[3]}), acc); }
        float* kvt = (float*)(wsl_ + WS_R + R_KVT) + (size_t)idx * 4096;
#pragma unroll
        for (int r = 0; r < 16; ++r) kvt[(32 * vt + crow(r, hi)) * 64 + 32 * kt + (lane & 31)] = acc[r]; }
    __syncthreads();
}
__device__ __forceinline__ void ret_out_unit(const Params& p, int l_, int ch, int idx, LAS unsigned char* lds, const int tid_in_) {
    int tid = tid_in_; asm volatile("" : "+v"(tid)); unsigned char* wsl_ = ws_late();
    const int lane = tid & 63, wid = tid >> 6, r32 = lane & 31, hi = lane >> 5, gw = wid >> 2, wq = wid & 3;
    const int np = 15 - idx / (BC * 4), bh = idx % (BC * 4), h = bh & 3, bl = bh >> 2, n = 2 * np + gw;
    const bf16_t* proj = (const bf16_t*)(wsl_ + WS_R + R_PROJ); const f32x2* tab = (const f32x2*)(wsl_ + WS_ROPE);
    const float lg = log2f(1.0f - exp2f(-5.0f - (float)h));
    LAS unsigned char* KS = lds; LAS unsigned char* VS = lds + 32768; LAS unsigned char* RT = lds + 65536;
    const int tql = 32 * wq + r32; const size_t rowc = (size_t)bl * SEQ + n * 128 + tql;
    bf16x8 qf[4];
    { const bf16_t* qrow = proj + rowc * PROJW + PC_RQ + h * 64; const f32x2* tp = tab + ((size_t)ch * MC + rowc) * 32;
#pragma unroll
      for (int d0 = 0; d0 < 2; ++d0) { const u32x4 a = *(const u32x4*)(qrow + d0 * 16 + hi * 8), b = *(const u32x4*)(qrow + 32 + d0 * 16 + hi * 8); float o1[8], o2[8];
          rope8(o1, o2, a, b, tp + d0 * 16 + hi * 8); qf[d0] = __builtin_bit_cast(bf16x8, pack8f(o1)); qf[d0 + 2] = __builtin_bit_cast(bf16x8, pack8f(o2)); } }
    __syncthreads();
#pragma unroll
    for (int g = 0; g < 2; ++g) { const size_t r0 = (size_t)bl * SEQ + (2 * np + g) * 128;
        { const int key = tid >> 2, cp = tid & 3; const bf16_t* src = proj + (r0 + key) * PROJW + PC_RK + h * 64 + cp * 8;
          const u32x4 a = *(const u32x4*)src, b = *(const u32x4*)(src + 32); float o1[8], o2[8];
          rope8(o1, o2, a, b, tab + ((size_t)ch * MC + r0 + key) * 32 + cp * 8);
          LAS unsigned char* d = KS + (g * 2 + (key >> 6)) * 8192 + cp * 1024 + (key & 63) * 16;
          *(LAS u32x4*)d = pack8f(o1); *(LAS u32x4*)(d + 4096) = pack8f(o2); }
#pragma unroll
        for (int t2 = 0; t2 < 2; ++t2)
            *(LAS u32x4*)(VS + (g * 2 + t2) * 8192 + wid * 1024 + lane * 16) = *(const u32x4*)(proj + (r0 + 64 * t2 + 16 * (wid & 3) + (lane >> 2)) * PROJW + PC_RV + h * 64 + (wid >> 2) * 32 + (lane & 3) * 8); }
    { const int t = tid & 255; const float gdec = ex2(128.0f * lg); const float* kv0 = (const float*)(wsl_ + WS_R + R_KVT) + (size_t)(bh * 32) * 4096;
#pragma unroll
      for (int q = 0; q < 2; ++q) { const int task = t + 256 * q, v = task >> 3, kc = task & 7; f32x4 a0 = {0.f, 0.f, 0.f, 0.f}, a1 = {0.f, 0.f, 0.f, 0.f};
          int m = 0;
          for (; m + 8 <= n; m += 8) { f32x4 x0[8], x1[8];
#pragma unroll
              for (int q8 = 0; q8 < 8; ++q8) { const float* s = kv0 + (size_t)(m + q8) * 4096 + v * 64 + kc * 8; x0[q8] = *(const f32x4*)s; x1[q8] = *(const f32x4*)(s + 4); }
#pragma unroll
              for (int q8 = 0; q8 < 8; ++q8) { a0 = a0 * gdec + x0[q8]; a1 = a1 * gdec + x1[q8]; } }
          for (; m < n; ++m) { const float* s = kv0 + (size_t)m * 4096 + v * 64 + kc * 8; a0 = a0 * gdec + *(const f32x4*)s; a1 = a1 * gdec + *(const f32x4*)(s + 4); }
          *(LAS u32x4*)(RT + gw * 8192 + kc * 1024 + v * 16) = pack8(a0, a1); } }
    __syncthreads();
    f32x16 o[2];
    { f32x16 p0, p1; attn_qkt(p0, p1, RT + gw * 8192, qf, r32, hi); const float xi = ex2((float)(tql + 1) * lg); o[0] = p0 * xi; o[1] = p1 * xi; }
    for (int kt = 0; kt <= (wq >> 1); ++kt) { f32x16 p0, p1; attn_qkt(p0, p1, KS + (gw * 2 + kt) * 8192, qf, r32, hi);
#pragma unroll
        for (int r = 0; r < 16; ++r) { const int key = 64 * kt + crow(r, hi);
            p0[r] = (key <= tql) ? p0[r] * ex2((float)(tql - key) * lg) : 0.f; p1[r] = (key + 32 <= tql) ? p1[r] * ex2((float)(tql - key - 32) * lg) : 0.f; }
        bf16x8 pw[4]; pw[0] = pack_acc8(p0, 0); pw[1] = pack_acc8(p0, 1); pw[2] = pack_acc8(p1, 0); pw[3] = pack_acc8(p1, 1);
        attn_pv(o, VS + (gw * 2 + kt) * 8192, pw, lane, hi); }
    float s = 0.f;
#pragma unroll
    for (int r = 0; r < 16; ++r) s += o[0][r] + o[1][r];
    s = x32_sum(s); const float mu = s * (1.0f / 64.0f); float q = 0.f;
#pragma unroll
    for (int r = 0; r < 16; ++r) { const float a = o[0][r] - mu, b = o[1][r] - mu; q += a * a + b * b; }
    q = x32_sum(q); const float rs = 1.0f / sqrtf(q * (1.0f / 64.0f) + LN_EPS);
    const float* gw_ = PIN(IN_RETGN) + l_ * 256 + h * 64; const bf16_t* grow = proj + rowc * PROJW + PC_RG + h * 64;
#pragma unroll
    for (int d0 = 0; d0 < 2; ++d0)
#pragma unroll
        for (int g = 0; g < 4; ++g) { const int d = 32 * d0 + 8 * g + 4 * hi; const u32x2 gz = *(const u32x2*)(grow + d); const f32x4 w4 = *(const f32x4*)(gw_ + d);
            const float gg[4] = {__uint_as_float(gz.x << 16), __uint_as_float(gz.x & 0xffff0000u), __uint_as_float(gz.y << 16), __uint_as_float(gz.y & 0xffff0000u)};
#pragma unroll
            for (int e = 0; e < 4; ++e) o[d0][4 * g + e] = (o[d0][4 * g + e] - mu) * rs * w4[e] * siluf_(gg[e]); }
    store_ot(o, (bf16_t*)(wsl_ + WS_R + R_O) + (size_t)1 * MC * 256 + rowc * 256 + h * 64, hi);
    __syncthreads();
}
constexpr int NL_KC = 36864, NL_VC = 69632, NL_IMPM = 102400, NL_IMPS = 118784, NL_SELM = 135424;
__device__ __forceinline__ void nsa_unit(const Params& p, int idx, LAS unsigned char* lds, const int tid_in_) {
    int tid = tid_in_; asm volatile("" : "+v"(tid)); unsigned char* wsl_ = ws_late();
    const int lane = tid & 63, wid = tid >> 6, r32 = lane & 31, hi = lane >> 5, tl = r32 >> 2, hd = r32 & 3;
    const int ib = 63 - idx / BC, bl = idx % BC;
    const bf16_t* proj = (const bf16_t*)(wsl_ + WS_R + R_PROJ); const float* sm = (const float*)(wsl_ + WS_R + R_SM);
    const int tokl = 8 * wid + tl, tq = ib * 64 + tokl; const size_t rowc = (size_t)bl * SEQ + tq;
    bf16x8 qf[4]; load_qf(qf, proj + rowc * PROJW + PC_NQ + hd * 64, hi);
    const float g0 = sigmoidf_(sm[rowc * 32 + 8 + hd * 3 + 0]), g1 = sigmoidf_(sm[rowc * 32 + 8 + hd * 3 + 1]), g2 = sigmoidf_(sm[rowc * 32 + 8 + hd * 3 + 2]);
    f32x16 of[2];
    const int ntc = min(3, (4 * ib + 2) >> 6) + 1;
    {
        const bf16_t* kc = (const bf16_t*)(wsl_ + WS_R + R_KCMP) + (size_t)bl * 256 * 64; const bf16_t* vc = kc + (size_t)BC * 256 * 64;
        __syncthreads();
        for (int tt = 0; tt < ntc; ++tt) {
            *(LAS u32x4*)(lds + NL_KC + tt * 8192 + wid * 1024 + lane * 16) = *(const u32x4*)(kc + (size_t)(tt * 64 + lane) * 64 + wid * 8);
            *(LAS u32x4*)(lds + NL_VC + tt * 8192 + wid * 1024 + lane * 16) = *(const u32x4*)(vc + (size_t)(tt * 64 + 16 * (wid & 3) + (lane >> 2)) * 64 + (wid >> 2) * 32 + (lane & 3) * 8); }
        __syncthreads();
        float m = -INFINITY, l = 0.f;
        for (int tt = 0; tt < ntc; ++tt) { f32x16 p0, p1; attn_qkt(p0, p1, lds + NL_KC + tt * 8192, qf, r32, hi);
#pragma unroll
            for (int r = 0; r < 16; ++r) { const int n0 = 64 * tt + crow(r, hi), n1 = n0 + 32; if (n0 >= 255 || 16 * n0 + 31 > tq) p0[r] = -INFINITY; if (n1 >= 255 || 16 * n1 + 31 > tq) p1[r] = -INFINITY; }
            float mt = p0[0];
#pragma unroll
            for (int r = 1; r < 16; ++r) mt = fmaxf(mt, p0[r]);
#pragma unroll
            for (int r = 0; r < 16; ++r) mt = fmaxf(mt, p1[r]);
            mt = x32_max(mt);
            const float mn = fmaxf(m, mt), ms = (mn == -INFINITY) ? 0.f : mn; float s = 0.f;
#pragma unroll
            for (int r = 0; r < 16; ++r) s += ex2(p0[r] - ms) + ex2(p1[r] - ms);
            l = l * ex2(m - ms) + s; m = mn; }
        l = x32_sum(l);
        const float inv = (l > 0.f) ? 1.0f / l : 0.f, ms = (m == -INFINITY) ? 0.f : m;
        LAS float* impm = (LAS float*)(lds + NL_IMPM); LAS float* imps = (LAS float*)(lds + NL_IMPS);
        f32x16 oc[2]; oc[0] = z16(); oc[1] = z16();
        for (int tt = 0; tt < ntc; ++tt) { f32x16 p0, p1; attn_qkt(p0, p1, lds + NL_KC + tt * 8192, qf, r32, hi);
#pragma unroll
            for (int r = 0; r < 16; ++r) { const int n0 = 64 * tt + crow(r, hi), n1 = n0 + 32;
                p0[r] = (n0 >= 255 || 16 * n0 + 31 > tq) ? 0.f : ex2(p0[r] - ms) * inv; p1[r] = (n1 >= 255 || 16 * n1 + 31 > tq) ? 0.f : ex2(p1[r] - ms) * inv; }
#pragma unroll
            for (int g = 0; g < 4; ++g) {
                float ma = p0[4 * g] + p0[4 * g + 1] + p0[4 * g + 2] + 0.5f * p0[4 * g + 3], sa = 0.5f * p0[4 * g + 3];
                float mb = p1[4 * g] + p1[4 * g + 1] + p1[4 * g + 2] + 0.5f * p1[4 * g + 3], sb = 0.5f * p1[4 * g + 3];
                ma += swz_xor<1>(ma); ma += swz_xor<2>(ma); sa += swz_xor<1>(sa); sa += swz_xor<2>(sa);
                mb += swz_xor<1>(mb); mb += swz_xor<2>(mb); sb += swz_xor<1>(sb); sb += swz_xor<2>(sb);
                if (hd == 0) { const int ja = 16 * tt + 2 * g + hi, jb = ja + 8;
                    impm[tokl * 64 + ja] = ma; imps[tokl * 65 + ja + 1] = sa; impm[tokl * 64 + jb] = mb; imps[tokl * 65 + jb + 1] = sb; } }
            bf16x8 pw[4]; pw[0] = pack_acc8(p0, 0); pw[1] = pack_acc8(p0, 1); pw[2] = pack_acc8(p1, 0); pw[3] = pack_acc8(p1, 1);
            attn_pv(oc, lds + NL_VC + tt * 8192, pw, lane, hi); }
        of[0] = oc[0] * g0; of[1] = oc[1] * g0;
        LAS unsigned long long* selm = (LAS unsigned long long*)(lds + NL_SELM);
        if (ib < 16) { if (lane < 8) selm[8 * wid + lane] = (2ull << ib) - 1ull; }
        else for (int t8 = 0; t8 < 8; ++t8) { const int tk = 8 * wid + t8; const int j = lane;
            float imp = (j < 16 * ntc) ? impm[tk * 64 + j] + ((j > 0) ? imps[tk * 65 + j] : 0.f) : 0.f;
            const bool forced = (j == 0) || (j == ib) || (j == ib - 1);
            const float score = forced ? 1.0e4f : ((j <= ib) ? imp : -1.0f);
            int rank = 0;
#pragma unroll
            for (int jj = 0; jj < 64; ++jj) { const float sj = __uint_as_float(__builtin_amdgcn_readlane(__float_as_uint(score), jj)); rank += ((sj > score) || (sj == score && jj < j)) ? 1 : 0; }
            const unsigned long long mk = __ballot((rank < 16) && (j <= ib));
            if (lane == 0) selm[tk] = mk; }
    }
    __syncthreads();
    unsigned long long mymask, umask, wmask;
    { const LAS unsigned long long* selm = (const LAS unsigned long long*)(lds + NL_SELM); mymask = selm[tokl];
      unsigned long long u = selm[lane]; unsigned lo = (unsigned)u, hi32 = (unsigned)(u >> 32);
      lo |= swz_xor_u<1>(lo); lo |= swz_xor_u<2>(lo); lo |= swz_xor_u<4>(lo); lo |= swz_xor_u<8>(lo); lo |= swz_xor_u<16>(lo); lo = x32_or(lo);
      hi32 |= swz_xor_u<1>(hi32); hi32 |= swz_xor_u<2>(hi32); hi32 |= swz_xor_u<4>(hi32); hi32 |= swz_xor_u<8>(hi32); hi32 |= swz_xor_u<16>(hi32); hi32 = x32_or(hi32);
      umask = ((unsigned long long)hi32 << 32) | lo; umask = __builtin_amdgcn_readfirstlane((unsigned)umask) | ((unsigned long long)__builtin_amdgcn_readfirstlane((unsigned)(umask >> 32)) << 32);
      unsigned wl = 0u, wh = 0u;
#pragma unroll
      for (int t8 = 0; t8 < 8; ++t8) { const unsigned long long mk = selm[8 * wid + t8]; wl |= (unsigned)mk; wh |= (unsigned)(mk >> 32); }
      wmask = (unsigned long long)(unsigned)__builtin_amdgcn_readfirstlane((int)wl) | ((unsigned long long)(unsigned)__builtin_amdgcn_readfirstlane((int)wh) << 32); }
    for (int br = 0; br < 2; ++br) {
        f32x16 o[2]; o[0] = z16(); o[1] = z16(); float m = -INFINITY, l = 0.f;
        SelF f; f.umask = br ? ~0ull : umask; f.wmask = br ? ~0ull : wmask; f.mymask = br ? ~0ull : mymask; f.tq = tq; f.klo = br ? tq - 512 : -1; f.hi = hi; f.tdiag = ib; f.tlo = br ? (ib * 64 + 63 - 512) / 64 : -1;
        const bf16_t* nkv2 = (const bf16_t*)(ws_late() + WS_R + R_NKV);
        flash_loop(f, br ? max(0, ib - 8) : 0, ib + 1, nkv2 + (size_t)(2 + 2 * br) * (NKV_SEG / 2) + (size_t)bl * SEQ * 64, nkv2 + (size_t)(3 + 2 * br) * (NKV_SEG / 2) + (size_t)bl * SEQ * 64, 64, nullptr, qf, o, m, l, lds, tid);
        l = x32_sum(l); const float sc = (l > 0.f) ? (br ? g2 : g1) / l : 0.f; of[0] += o[0] * sc; of[1] += o[1] * sc;
    }
    store_ot(of, (bf16_t*)(ws_late() + WS_R + R_O) + (size_t)2 * MC * 256 + rowc * 256 + hd * 64, hi);
}

constexpr int LDS_MISC = LDS_BYTES - 256;
constexpr size_t LWS = ((LW_BYTES + MiB - 1) / MiB) * MiB;
#define PHASE_PRE const int tid = fresh_tid(); int l, ch; { int k_; bool b_; step_decode(__builtin_amdgcn_readfirstlane(((volatile LAS int*)lds_at(LDS_MISC + 176))[0]), k_, l, ch, b_); } \
    Params p; ptab_load(p); LAS unsigned char* lds = lds_at(0); const int G = NWG; \
    const int c = __builtin_amdgcn_readfirstlane(((volatile LAS int*)(lds + LDS_MISC + 176))[2]); (void)lds; (void)G; (void)c; (void)l; (void)ch; \
    volatile LAS int* qslot = (volatile LAS int*)(lds + LDS_MISC + 16); (void)qslot;
#define LW_ (p.ws + WS_W + (size_t)l * LWS)
#define LWO_ ((unsigned)(WS_W + (size_t)l * LWS))
#define HC_ ((unsigned)(WS_H + (size_t)ch * MC * 1024 * 2))
#define QCTR_ ((unsigned*)(p.ws + WS_CTL) + CW_Q + 64 * ((l * NCHUNK + ch) * 8) + 8192 * __builtin_amdgcn_readfirstlane(((volatile LAS int*)lds_at(LDS_MISC + 176))[3]))
__device__ __forceinline__ int tid_out(int t) { asm volatile("" : "+v"(t)); return t; }
__device__ __forceinline__ int fresh_tid() {
    LAS unsigned* ctr = (LAS unsigned*)lds_at(LDS_MISC + 192);
    unsigned z = 0u; asm volatile("" : "+v"(z));
    const int lane = (int)__builtin_amdgcn_mbcnt_hi(~0u, __builtin_amdgcn_mbcnt_lo(~0u, z));
    unsigned t = 0u; if (lane == 0) t = __hip_atomic_fetch_add(ctr, 1u, __ATOMIC_RELAXED, __HIP_MEMORY_SCOPE_WORKGROUP);
    t = (unsigned)__builtin_amdgcn_readfirstlane((int)t);
    __syncthreads();
    return (int)(((t & 7u) << 6) | (unsigned)lane);
}
__device__ __forceinline__ void step_decode(int s, int& k, int& l, int& ch, bool& bar);
#define GCTR_(j) ((unsigned*)(p.ws + WS_CTL) + CW_G + 64 * ((l * NCHUNK + ch) * 8 + (j)) + 16384 * __builtin_amdgcn_readfirstlane(((volatile LAS int*)lds_at(LDS_MISC + 176))[3]))
#define PHFN(name) static __device__ __noinline__ void name()
#define PHFI(name) static __device__ __forceinline__ void name()

PHFI(ph_p0) { PHASE_PRE
    constexpr int N_ADA = 192, N_CB = 4, N_ROPE = MTOK * 32 / 4096, N_T = 2 * TJ_TOTAL;
    for (int it = c; it < N_ADA + N_CB + N_ROPE; it += G) {
        if (it < N_ADA) p0_ada(p, it, (LAS float*)lds, tid);
        else if (it < N_ADA + N_CB) p0_cbias(p, it - N_ADA, (LAS float*)lds, tid);
        else p0_rope(p, it - N_ADA - N_CB, tid);
    }
    for (int it = c; it < N_T; it += 4 * G) p0_transpose4(p, it, G, N_T, (LAS float*)lds, tid);
}
PHFN(ph_p1) { PHASE_PRE prep_first(p, tid, c); }
PHFI(ph_a16) { PHASE_PRE
    int kk_; { int l2_, c2_; bool b2_; step_decode(__builtin_amdgcn_readfirstlane(((volatile LAS int*)lds_at(LDS_MISC + 176))[0]), kk_, l2_, c2_, b2_); }
    const int md = (kk_ == 12) ? 1 : (kk_ == 13) ? 2 : 0;
    DenseSched S; S.A = (md == 2) ? (unsigned)(WS_R + R_Y) : (unsigned)(WS_H8 + (size_t)ch * MC * 1024); S.Bt = LWO_ + (md == 1 ? (unsigned)LW_WGV : md == 2 ? (unsigned)LW_WOT : (unsigned)LW_WIN); S.tA = 256u * 1024; S.tB = 256u * 1024; S.aBr = 0;
    S.nM = MC / 256; S.nN = (md == 1) ? 16 : (md == 2) ? 4 : NPROJ / 256; S.G = G; S.c = c; S.pnShift = 0; S.ctr = (md == 1) ? GCTR_(2) : (md == 2) ? GCTR_(3) : GCTR_(0);
    EpiComb E; E.mode = md; E.row_base = ch * MC;
    pg8::gemm_phase<EpiComb, DenseSched, true, false, true>(lds, 1024, 1024, 1024, S, E, tid, (const char*)p.ws);
}
PHFN(ph_a2a) { PHASE_PRE
    if (c < 2 * BC) {
        const int which = c & 1, bl = c >> 1;
        OneSched S; S.has = true; S.u0.pm = bl; S.u0.pn = 0; S.u0.aux = which; S.u0.nvalid = 256; S.u0.rows = 0u;
        S.u0.a = (unsigned)(WS_R + R_NKV + (size_t)which * NKV_SEG + (size_t)bl * SEQ * 64 * 2); S.u0.b = LWO_ + (unsigned)(LW_CW1 + (size_t)which * 256 * 2048 * 2);
        EpiH1 E; E.h1 = (bf16_t*)(p.ws + WS_R + R_H1); E.cbias = (const float*)(p.ws + WS_CBIAS) + l * 512;
        pg8::gemm_phase<EpiH1, OneSched, true, false>(lds, 2048, 1024, 2048, S, E, tid, (const char*)p.ws);
        VM_WAIT(); __syncthreads(); __builtin_amdgcn_fence(__ATOMIC_ACQUIRE, "agent"); VM_WAIT(); __syncthreads();
    }
}
PHFN(ph_a2b) { PHASE_PRE
    if (c < 2 * BC) {
        const int which = c & 1, bl = c >> 1;
        OneSched S2; S2.has = true; S2.u0.pm = bl; S2.u0.pn = 0; S2.u0.aux = which; S2.u0.nvalid = 256; S2.u0.rows = 0u;
        S2.u0.a = (unsigned)(WS_R + R_H1 + ((size_t)which * BC * 256 + (size_t)bl * 256) * 256 * 2); S2.u0.b = LWO_ + (unsigned)(LW_CW2 + (size_t)which * 256 * 256 * 2);
        EpiCmp2 E2; E2.kc = (bf16_t*)(p.ws + WS_R + R_KCMP);
        pg8::gemm_phase<EpiCmp2, OneSched, true, false>(lds, 256, 256, 256, S2, E2, tid, (const char*)p.ws);
    }
}
PHFI(ph_a2c) { PHASE_PRE
    unsigned* qc = QCTR_ + 0; const int NU = BC * 4 * 64;
    int u = q_next(qc, qslot, tid), un = q_next(qc, qslot, tid);
    GdnRaw ga; if (u < NU) gdn_prep_load(ga, u, tid);
    while (u < NU) {
        int tk = 0x3fffffff; if (tid == 0) tk = (int)__hip_atomic_fetch_add(qc, 1u, __ATOMIC_RELAXED, __HIP_MEMORY_SCOPE_AGENT);
        GdnRaw gn = ga; if (un < NU) gdn_prep_load(gn, un, tid);
        gdn_prep_unit(p, l, u, lds, tid, ga);
        if (tid == 0) *qslot = tk;
        __syncthreads();
        const int unn = *qslot;
        __syncthreads();
        u = un; un = unn; ga = gn;
    }
}
PHFN(ph_a2d) { PHASE_PRE
    for (;;) { const int u = q_next(QCTR_ + 64, qslot, tid); if (u >= BC * 4) break; fox_cum_item(p, l, u, (LAS float*)lds, tid); }
    for (;;) { const int u = q_next(QCTR_ + 320, qslot, tid); if (u >= BC * 4 * 32) break; ret_kv_unit(p, ch, u, lds, tid); }
}
PHFN(ph_a3a) { PHASE_PRE if (c < BC * 4) gdn_scan_item(p, l, ch, c, lds, tid); }
PHFI(ph_a3b) { PHASE_PRE for (;;) { const int u = q_next(QCTR_ + 128, qslot, tid); if (u >= BC * 4 * 16) break; fox_unit(p, u, lds, tid); } }
PHFI(ph_a3c) { PHASE_PRE for (;;) { const int u = q_next(QCTR_ + 192, qslot, tid); if (u >= BC * 4 * 16) break; ret_out_unit(p, l, ch, u, lds, tid); } }
PHFI(ph_a3d) { PHASE_PRE for (;;) { const int u = q_next(QCTR_ + 256, qslot, tid); if (u >= BC * 64) break; nsa_unit(p, u, lds, tid); } }
PHFN(ph_a5) { PHASE_PRE
    DenseSched S; S.A = (unsigned)(WS_R + R_O); S.Bt = LWO_ + (unsigned)LW_BPT; S.tA = 256u * 256 * 2; S.tB = 256u * 256 * 2; S.aBr = (unsigned)((size_t)MC * 256 * 2); S.nM = MC / 256; S.nN = 16; S.G = G; S.c = c; S.pnShift = 2; S.ctr = GCTR_(1);
    EpiP E;
    pg8::gemm_phase<EpiP, DenseSched, true, false>(lds, 256, 256, 256, S, E, tid, (const char*)p.ws);
}
PHFN(ph_b0) { PHASE_PRE prep_moe(p, l, (LAS float*)lds, tid, c); }
__device__ __forceinline__ void moe_tables(const Params& p, int l, LAS int* mcnt, LAS int* mpre, const int tid) {
    __syncthreads();
    if (tid < 16) mcnt[tid] = (int)((unsigned*)(p.ws + WS_CTL))[CW_CNT + l * 64 + tid];
    __syncthreads();
    if (tid == 0) { int s = 0; for (int e = 0; e < 16; ++e) { mpre[e] = s; s += (mcnt[e] + 255) >> 8; } mpre[16] = s; }
    __syncthreads();
}
PHFI(ph_b1) { PHASE_PRE
    LAS int* mcnt = (LAS int*)(lds + LDS_MISC + 32); LAS int* mpre = mcnt + 16; moe_tables(p, l, mcnt, mpre, tid);
    MoeSched S; S.pre = mpre; S.cnt = mcnt; S.wsb = (const char*)p.ws; S.A = (unsigned)WS_H; S.W = LWO_ + (unsigned)LW_W13;
    S.wE = 1024u * 1024 * 2; S.wT = 256u * 1024 * 2; S.aT = 0; S.G = G; S.c = c; S.gatherA = true; S.ctr = GCTR_(4);
    EpiMoe1 E;
    pg8::gemm_phase<EpiMoe1, MoeSched, true, true>(lds, 1024, 1024, 1024, S, E, tid, (const char*)p.ws);
}
PHFN(ph_b2) { PHASE_PRE
    LAS int* mcnt = (LAS int*)(lds + LDS_MISC + 32); LAS int* mpre = mcnt + 16; moe_tables(p, l, mcnt, mpre, tid);
    MoeSched S; S.pre = mpre; S.cnt = mcnt; S.wsb = (const char*)p.ws; S.A = (unsigned)(WS_R + R_HID); S.W = LWO_ + (unsigned)LW_W2;
    S.wE = 1024u * 512 * 2; S.wT = 256u * 512 * 2; S.aT = 256u * 512 * 2; S.G = G; S.c = c; S.gatherA = false; S.ctr = GCTR_(5);
    EpiMoe2 E;
    pg8::gemm_phase<EpiMoe2, MoeSched, true, false>(lds, 512, 512, 512, S, E, tid, (const char*)p.ws);
}
PHFN(ph_b3) { PHASE_PRE prep_next(p, l, l == DEPTH - 1, tid, c); }

constexpr int STEPS_CHUNK = 12, STEPS_LAYER = NCHUNK * STEPS_CHUNK + 4, N_STEPS = 2 + DEPTH * STEPS_LAYER;
__device__ __forceinline__ void step_decode(int s, int& k, int& l, int& ch, bool& bar) {
    if (s < 2) { k = s; l = 0; ch = 0; bar = true; return; }
    const int t = s - 2; l = t / STEPS_LAYER; const int r = t % STEPS_LAYER;
    if (r < NCHUNK * STEPS_CHUNK) { ch = r / STEPS_CHUNK; const int q = r % STEPS_CHUNK; k = 2 + q; bar = !(q == 1 || q == 2 || q == 3 || q == 5 || q == 6 || q == 7); }
    else { ch = 0; k = 14 + (r - NCHUNK * STEPS_CHUNK); bar = true; }
}
__global__ void __launch_bounds__(NTHR, 2) __attribute__((disable_tail_calls)) mega_fwd(Params p0_) {
    LAS unsigned char* lds = lds_at(0);
    const int tid = threadIdx.x;
    volatile LAS unsigned* xbw = (volatile LAS unsigned*)(lds + LDS_MISC);
    volatile LAS int* st = (volatile LAS int*)(lds + LDS_MISC + 176);
    if (tid == 0) { xbw[0] = 0u; xbw[1] = 0u; xbw[2] = 0u; xbw[3] = 0u; st[0] = p0_.ph_lo; st[1] = p0_.ph_hi; st[2] = blockIdx.x; st[3] = 0; *(volatile LAS unsigned*)(lds + LDS_MISC + 200) = 0u; *(volatile LAS unsigned*)(lds + LDS_MISC + 192) = 0u; }
    ptab_store(p0_, tid);
    __syncthreads();
    (void)xcd_barrier_post((unsigned*)(p0_.ws + WS_CTL) + CW_BAR, xbw, tid);
#ifdef PROBE_CLOCK
    if (tid == 0) { volatile LAS unsigned long long* tc_ = (volatile LAS unsigned long long*)(lds + LDS_MISC + 216); tc_[0] = __builtin_amdgcn_s_memrealtime(); tc_[1] = __builtin_amdgcn_s_memtime(); }
#endif
    for (;;) {
        {
          LAS unsigned char* mb_ = lds_at(LDS_MISC); volatile LAS int* st_ = (volatile LAS int*)(mb_ + 176);
          const int s = __builtin_amdgcn_readfirstlane(st_[0]), e = __builtin_amdgcn_readfirstlane(st_[1]);
          if (s >= e) break;
          int k, l, ch; bool bar; step_decode(s, k, l, ch, bar);
#ifdef PROBE_STEPTIME
          if (threadIdx.x == 0) { volatile LAS unsigned long long* tp_ = (volatile LAS unsigned long long*)(mb_ + 208); tp_[0] = __builtin_amdgcn_s_memrealtime(); }
#endif
          (void)k; }
#define CUR_K_() ([&]() { int k_, l_, c_; bool b_; step_decode(__builtin_amdgcn_readfirstlane(((volatile LAS int*)(lds_at(LDS_MISC) + 176))[0]), k_, l_, c_, b_); return k_; }())
        if (CUR_K_() == 0) ph_p0();
        if (CUR_K_() == 1) ph_p1();
        { const int kq_ = CUR_K_(); if (kq_ == 2 || kq_ == 12 || kq_ == 13) ph_a16(); }
        if (CUR_K_() == 3) ph_a2a();
        if (CUR_K_() == 4) ph_a2b();
        if (CUR_K_() == 5) ph_a2c();
        if (CUR_K_() == 6) ph_a2d();
        if (CUR_K_() == 7) ph_a3a();
        if (CUR_K_() == 8) ph_a3b();
        if (CUR_K_() == 9) ph_a3c();
        if (CUR_K_() == 10) ph_a3d();
        if (CUR_K_() == 11) ph_a5();
        if (CUR_K_() == 14) ph_b0();
        if (CUR_K_() == 15) ph_b1();
        if (CUR_K_() == 16) ph_b2();
        if (CUR_K_() == 17) ph_b3();
#ifdef PROBE_STEPTIME
        { LAS unsigned char* mb2_ = lds_at(LDS_MISC); const int s2_ = __builtin_amdgcn_readfirstlane(((volatile LAS int*)(mb2_ + 176))[0]); int k2_, l2_, c2_; bool b2_; step_decode(s2_, k2_, l2_, c2_, b2_);
          __syncthreads();
          if (threadIdx.x == 0 && ((PROBE_STEPTIME >> k2_) & 1)) { volatile LAS unsigned long long* tp_ = (volatile LAS unsigned long long*)(mb2_ + 208); volatile LAS unsigned* ac_ = (volatile LAS unsigned*)(mb2_ + 200);
              ac_[0] = ac_[0] + (unsigned)(__builtin_amdgcn_s_memrealtime() - tp_[0]); } }
#endif
        { const int tid = fresh_tid(); LAS unsigned char* mb_ = lds_at(LDS_MISC); volatile LAS int* st_ = (volatile LAS int*)(mb_ + 176);
          volatile LAS unsigned* xbw_ = (volatile LAS unsigned*)mb_;
          const int s = __builtin_amdgcn_readfirstlane(st_[0]), e = __builtin_amdgcn_readfirstlane(st_[1]);
          int k, l, ch; bool bar; step_decode(s, k, l, ch, bar);
#ifdef DUP_MASK
          const bool adv_ = !(((DUP_MASK >> k) & 1) && __builtin_amdgcn_readfirstlane(st_[3]) == 0);
#else
          const bool adv_ = true;
#endif
          if (adv_ && bar && s + 1 < e) { XcdBarrier b; b.bar = (unsigned*)((unsigned char*)ptab_get(28) + WS_CTL) + CW_BAR; b.x = xb_xcc_id(); b.st = xbw_;
#ifdef PROBE_BARWAIT
              __syncthreads(); const unsigned long long t0_ = __builtin_amdgcn_s_memrealtime();
              xcd_barrier(b, tid);
              const unsigned long long t1_ = __builtin_amdgcn_s_memrealtime(); if (tid == 0) { volatile LAS unsigned* ac_ = (volatile LAS unsigned*)(mb_ + 200); ac_[0] = ac_[0] + (unsigned)(t1_ - t0_); }
#else
              xcd_barrier(b, tid);
#endif
          }
          __syncthreads();
#ifdef DUP_MASK
          const int rp = __builtin_amdgcn_readfirstlane(st_[3]);
          if (((DUP_MASK >> k) & 1) && rp == 0) { if (tid == 0) st_[3] = 1; }
          else { if (tid == 0) { st_[3] = 0; st_[0] = s + 1; } }
#else
          if (tid == 0) st_[0] = s + 1;
#endif
          __syncthreads(); }
    }
#ifdef PROBE_CLOCK
    { volatile LAS unsigned long long* tc_ = (volatile LAS unsigned long long*)(lds_at(LDS_MISC) + 216); const unsigned long long r1 = __builtin_amdgcn_s_memrealtime(), c1 = __builtin_amdgcn_s_memtime();
      const unsigned long long dr = r1 - tc_[0], dc = c1 - tc_[1];
      const unsigned long long w = dc / 24ull; const unsigned long long t0_ = __builtin_amdgcn_s_memrealtime();
      while (__builtin_amdgcn_s_memrealtime() - t0_ < w) __builtin_amdgcn_s_sleep(8); (void)dr; }
#endif
#if defined(PROBE_BARWAIT) || defined(PROBE_STEPTIME)
    { const unsigned w_ = *(volatile LAS unsigned*)(lds_at(LDS_MISC) + 200); const unsigned long long t0_ = __builtin_amdgcn_s_memrealtime();
      while (__builtin_amdgcn_s_memrealtime() - t0_ < (unsigned long long)w_) __builtin_amdgcn_s_sleep(8); }
#endif
}

extern "C" void kernel_launch(void* const* d_in, const int* in_sizes, int n_in, void* d_out, int out_size, void* d_ws, size_t ws_size, hipStream_t stream) {
    (void)in_sizes; (void)out_size;
    if (n_in < 27 || ws_size < WS_END) { fprintf(stderr, "kernel_launch: unexpected inputs (n_in %d, ws %zu < %zu)\n", n_in, ws_size, (size_t)WS_END); return; }
    static bool attr_set = false;
    if (!attr_set) { (void)hipFuncSetAttribute((const void*)mega_fwd, hipFuncAttributeMaxDynamicSharedMemorySize, LDS_BYTES); attr_set = true; }
    Params p{};
    for (int i = 0; i < 27; ++i) p.in[i] = (const float*)d_in[i];
    p.out = (float*)d_out; p.ws = (unsigned char*)d_ws;
    (void)hipMemsetAsync((unsigned char*)d_ws + WS_CTL, 0, CTL_BYTES, stream);
#ifndef MK_CUTS
    p.ph_lo = 0; p.ph_hi = N_STEPS;
    hipLaunchKernelGGL(mega_fwd, dim3(NWG), dim3(NTHR), LDS_BYTES, stream, p);
#else
    { static const int cuts[] = {MK_CUTS, N_STEPS}; int lo = 0;
      for (unsigned i = 0; i < sizeof(cuts) / sizeof(cuts[0]); ++i) { p.ph_lo = lo; p.ph_hi = cuts[i]; lo = cuts[i]; hipLaunchKernelGGL(mega_fwd, dim3(NWG), dim3(NTHR), LDS_BYTES, stream, p); } }
#endif
}
```

```cpp
#include <hip/hip_runtime.h>
#include <stdint.h>
#include <stdio.h>

#define GAS __attribute__((address_space(1)))
#define LAS __attribute__((address_space(3)))
typedef unsigned short bf16_t;
typedef short bf16x8 __attribute__((ext_vector_type(8)));
typedef short s16x4 __attribute__((ext_vector_type(4)));
typedef float f32x2 __attribute__((ext_vector_type(2)));
typedef float f32x4 __attribute__((ext_vector_type(4)));
typedef float f32x16 __attribute__((ext_vector_type(16)));
typedef unsigned u32x2 __attribute__((ext_vector_type(2)));
typedef unsigned u32x4 __attribute__((ext_vector_type(4)));
typedef __bf16 bf16x2_t __attribute__((ext_vector_type(2)));
template <class T> __device__ __forceinline__ GAS T* G_(T* p) { return (GAS T*)p; }
template <class T> __device__ __forceinline__ const GAS T* G_(const T* p) { return (const GAS T*)p; }

constexpr int D_MODEL = 1024, BATCH = 16, SEQ = 4096, DEPTH = 2, MTOK = BATCH * SEQ;
constexpr int NCHUNK = 2, BC = BATCH / NCHUNK, MC = BC * SEQ;
constexpr int NPROJ = 3584, PROJW = 3072;
constexpr float DN_ALPHA = 1.4142135623730951f;
constexpr float LN_EPS = 1e-5f;
constexpr float LOG2E = 1.4426950408889634f;
constexpr float QSCALE = 0.125f * 1.4426950408889634f;
constexpr int NWG = 256, NTHR = 512;
constexpr int LDS_BYTES = 163840;

constexpr int PC_GQ = 0, PC_GK = 256, PC_GV = 512, PC_GZ = 768, PC_RQ = 1024, PC_RK = 1280, PC_RV = 1536, PC_RG = 1792, PC_NQ = 2048, PC_FQ = 2304, PC_FK = 2560, PC_FV = 2816;

constexpr size_t MiB = 1ull << 20;
constexpr size_t WS_CTL = 0;
constexpr size_t CTL_BYTES = 1 * MiB;
constexpr size_t WS_MOD = 1 * MiB;
constexpr size_t WS_ROPE = 2 * MiB;
constexpr size_t WS_STATS = 18 * MiB;
constexpr size_t WS_CBIAS = 19 * MiB;
constexpr size_t WS_W = 20 * MiB;
constexpr size_t LW_WIN = 0;
constexpr size_t LW_WGV = LW_WIN + (size_t)NPROJ * 1024 * 2;
constexpr size_t LW_BPT = LW_WGV + (size_t)4096 * 1024 * 2;
constexpr size_t LW_WOT = LW_BPT + (size_t)4096 * 256 * 2;
constexpr size_t LW_W13 = LW_WOT + (size_t)1024 * 1024 * 2;
constexpr size_t LW_W2 = LW_W13 + (size_t)16 * 1024 * 1024 * 2;
constexpr size_t LW_CW1 = LW_W2 + (size_t)16 * 1024 * 512 * 2;
constexpr size_t LW_CW2 = LW_CW1 + (size_t)2 * 256 * 2048 * 2;
constexpr size_t LW_BYTES = LW_CW2 + (size_t)2 * 256 * 256 * 2;
constexpr size_t WS_H = WS_W + 2 * ((LW_BYTES + MiB - 1) / MiB) * MiB;
constexpr size_t WS_R = WS_H + 128 * MiB;
constexpr size_t R_PROJ = 0;
constexpr size_t R_GDN = R_PROJ + (size_t)MC * PROJW * 2;
constexpr size_t GDN_UNIT_BYTES = 5 * 8192;
constexpr size_t R_P = 0;
constexpr size_t R_NKV = R_GDN + (size_t)BC * 4 * 64 * GDN_UNIT_BYTES;
constexpr size_t NKV_SEG = (size_t)(MC + 64) * 64 * 2;
constexpr size_t R_SM = R_NKV + 6 * NKV_SEG;
constexpr size_t R_CUM = R_SM + (size_t)MC * 32 * 4;
constexpr size_t R_GG = R_CUM + (size_t)BC * 4 * 4096 * 4;
constexpr size_t R_KCMP = R_GG + (size_t)BC * 4 * 64 * 4 + 768;
constexpr size_t R_H1 = R_KCMP + (size_t)2 * BC * 256 * 64 * 2;
constexpr size_t R_O = R_H1 + (size_t)2 * BC * 256 * 256 * 2;
constexpr size_t R_Y = R_O + (size_t)4 * MC * 256 * 2;
constexpr size_t R_KVT = R_Y + (size_t)MC * 1024 * 2;
constexpr size_t R_MIX_END = R_KVT + (size_t)BC * 4 * 32 * 4096 * 4;
static_assert(R_NKV >= (size_t)MC * 4096 * 2, "P overlay fits under PROJ+GDN");
constexpr size_t R_LIST = 0;
constexpr size_t R_CW = R_LIST + (size_t)16 * MTOK * 4;
constexpr size_t R_HID = R_CW + (size_t)16 * MTOK * 4;
constexpr size_t R_OUT2 = R_HID + (size_t)(2 * MTOK + 4096) * 512 * 2;
constexpr size_t R_MOE_END = R_OUT2 + (size_t)2 * MTOK * 1024 * 2;
constexpr size_t WS_T = WS_R + (((R_MIX_END > R_MOE_END ? R_MIX_END : R_MOE_END) + MiB - 1) / MiB) * MiB;
constexpr size_t WS_H8 = WS_T + (size_t)MTOK * 1024 * 2;
constexpr size_t WS_END = WS_H8 + (size_t)MTOK * 1024;
constexpr float H8_SCALE = 16.0f, W8_SCALE = 256.0f, F8_DESCALE = 1.0f / (16.0f * 256.0f), Y8_SCALE = 64.0f, Y8_DESCALE = 1.0f / (64.0f * 256.0f), P8_SCALE = 32.0f;

constexpr int CW_BAR = 4096;
constexpr int CW_CNT = 8192;
constexpr int CW_Q = 8448;
constexpr int CW_G = 65536;

__device__ __forceinline__ float bf2f(bf16_t v) { return __uint_as_float(((unsigned)v) << 16); }
__device__ __forceinline__ unsigned pk2(float lo, float hi) { f32x2 v = {lo, hi}; bf16x2_t b = __builtin_convertvector(v, bf16x2_t); return __builtin_bit_cast(unsigned, b); }
__device__ __forceinline__ float clamp8(float x) { return fminf(fmaxf(x, -448.0f), 448.0f); }
__device__ __forceinline__ unsigned pk4_fp8(float a, float b, float c, float d) { int v = __builtin_amdgcn_cvt_pk_fp8_f32(clamp8(a), clamp8(b), 0, false); v = __builtin_amdgcn_cvt_pk_fp8_f32(clamp8(c), clamp8(d), v, true); return (unsigned)v; }
__device__ __forceinline__ bf16_t f2bf(float f) { return (bf16_t)(pk2(f, 0.f) & 0xffffu); }
__device__ __forceinline__ float ex2(float x) { return __builtin_amdgcn_exp2f(x); }
__device__ __forceinline__ float sigmoidf_(float x) { return __builtin_amdgcn_rcpf(1.0f + __expf(-x)); }
__device__ __forceinline__ float siluf_(float x) { return x * __builtin_amdgcn_rcpf(1.0f + __expf(-x)); }
__device__ __forceinline__ int crow(int r, int hi) { return (r & 3) + 8 * (r >> 2) + 4 * hi; }
template <int M> __device__ __forceinline__ float swz_xor(float v) { return __builtin_bit_cast(float, __builtin_amdgcn_ds_swizzle(__builtin_bit_cast(int, v), 0x1f | (M << 10))); }
template <int M> __device__ __forceinline__ unsigned swz_xor_u(unsigned v) { return (unsigned)__builtin_amdgcn_ds_swizzle((int)v, 0x1f | (M << 10)); }
__device__ __forceinline__ float x32_sum(float v) { auto r = __builtin_amdgcn_permlane32_swap(__float_as_uint(v), __float_as_uint(v), false, false); return __uint_as_float(r[0]) + __uint_as_float(r[1]); }
__device__ __forceinline__ float x32_max(float v) { auto r = __builtin_amdgcn_permlane32_swap(__float_as_uint(v), __float_as_uint(v), false, false); return fmaxf(__uint_as_float(r[0]), __uint_as_float(r[1])); }
__device__ __forceinline__ unsigned x32_or(unsigned v) { auto r = __builtin_amdgcn_permlane32_swap(v, v, false, false); return r[0] | r[1]; }
__device__ __forceinline__ float shfl_up_l(float v, int o, int lane) { return __builtin_bit_cast(float, __builtin_amdgcn_ds_bpermute((lane - o) << 2, __builtin_bit_cast(int, v))); }
__device__ __forceinline__ float wave_sum(float v) {
    v += swz_xor<1>(v); v += swz_xor<2>(v); v += swz_xor<4>(v); v += swz_xor<8>(v); v += swz_xor<16>(v);
    return x32_sum(v);
}
__device__ __forceinline__ float ninf_() { float z = -INFINITY; asm volatile("" : "+v"(z)); return z; }
__device__ __forceinline__ f32x4 z4() { float z = 0.f; asm volatile("" : "+v"(z)); return (f32x4){z, z, z, z}; }
__device__ __forceinline__ f32x16 z16() { float z = 0.f; asm volatile("" : "+v"(z)); f32x16 r;
#pragma unroll
    for (int i = 0; i < 16; ++i) r[i] = z;
    return r; }
#define VM_WAIT() asm volatile("s_waitcnt vmcnt(0)" ::: "memory")
#define MF4(a, b, c) __builtin_amdgcn_mfma_f32_16x16x4f32((a), (b), (c), 0, 0, 0)
#define MF32(a, b, c) __builtin_amdgcn_mfma_f32_32x32x16_bf16(a, b, c, 0, 0, 0)

#define XB_TMO      128
#define XB_XCNT(j)  (256  + 64 * (j))
#define XB_XSUB(j)  (1280 + 64 * (j))
#define XB_XGEN(j)  (2304 + 64 * (j))
#define XB_TOP      3328
#define XB_TOPGEN   3392
#define XCD_BAR_WORDS 3456
#define XB_SPIN_CAP (1u << 22)

__device__ __forceinline__ unsigned xb_ld(unsigned* p)              { return __hip_atomic_load(p, __ATOMIC_RELAXED, __HIP_MEMORY_SCOPE_AGENT); }
__device__ __forceinline__ unsigned xb_add(unsigned* p, unsigned v) { return __hip_atomic_fetch_add(p, v, __ATOMIC_RELAXED, __HIP_MEMORY_SCOPE_AGENT); }
__device__ __forceinline__ unsigned xb_xcc_id() { return (unsigned)__builtin_amdgcn_s_getreg((3 << 11) | 20) & 0xFu; }
#define XB_SPIN(cond, bar) do { unsigned _sp = 0; while (cond) { __builtin_amdgcn_s_sleep(1); \
    if ((++_sp & 255u) == 0u) { if (xb_ld(&(bar)[XB_TMO])) break; if (_sp > XB_SPIN_CAP) { atomicAdd(&(bar)[XB_TMO], 1u); break; } } } } while (0)

struct XcdBarrier { unsigned* bar; unsigned x; volatile LAS unsigned* st; };

__device__ __forceinline__ XcdBarrier xcd_barrier_post(unsigned* bar, volatile LAS unsigned* st, int tid) {
    XcdBarrier b; b.bar = bar; b.x = xb_xcc_id(); b.st = st;
    if (tid == 0) (void)xb_add(&bar[XB_XCNT(b.x)], 1u);
    return b;
}
__device__ __forceinline__ void xcd_barrier_complete(unsigned* bar, unsigned x, unsigned& nloc, unsigned& nx) {
    const unsigned G = NWG;
    unsigned sum, cnt, mine, sp = 0u;
    for (;;) {
        sum = 0u; cnt = 0u; mine = 0u;
#pragma unroll
        for (unsigned j = 0; j < 16; ++j) { const unsigned c = xb_ld(&bar[XB_XCNT(j)]); sum += c; cnt += (c > 0u) ? 1u : 0u; mine = (j == x) ? c : mine; }
        if (sum == G) break;
        __builtin_amdgcn_s_sleep(1);
        if ((++sp & 255u) == 0u) { if (xb_ld(&bar[XB_TMO])) break; if (sp > XB_SPIN_CAP) { atomicAdd(&bar[XB_TMO], 1u); break; } }
    }
    nloc = mine > 0u ? mine : 1u; nx = cnt > 0u ? cnt : 1u;
}
__device__ __forceinline__ void xcd_barrier(const XcdBarrier& b, int tid) {
    asm volatile("s_waitcnt vmcnt(0)" ::: "memory");
    __syncthreads();
    if (tid == 0) {
        unsigned* bar = b.bar;
        __builtin_amdgcn_s_waitcnt(0);
        unsigned nloc = b.st[0], nx = b.st[1];
        if (nloc == 0u) { xcd_barrier_complete(bar, b.x, nloc, nx); b.st[0] = nloc; b.st[1] = nx; }
        const unsigned old = xb_add(&bar[XB_XSUB(b.x)], 1u);
        const unsigned gen = old / nloc;
        if (old + 1u == (gen + 1u) * nloc) {
            __builtin_amdgcn_fence(__ATOMIC_RELEASE, "agent");
            asm volatile("s_waitcnt vmcnt(0)" ::: "memory");
            const unsigned og = xb_add(&bar[XB_TOP], 1u);
            const unsigned tg = og / nx;
            if (og + 1u == (tg + 1u) * nx) xb_add(&bar[XB_TOPGEN], 1u);
            else XB_SPIN(xb_ld(&bar[XB_TOPGEN]) == tg, bar);
            __builtin_amdgcn_fence(__ATOMIC_ACQUIRE, "agent");
            xb_add(&bar[XB_XGEN(b.x)], 1u);
            asm volatile("s_waitcnt vmcnt(0)" ::: "memory");
        } else {
            XB_SPIN(xb_ld(&bar[XB_XGEN(b.x)]) == gen, bar);
            __builtin_amdgcn_fence(__ATOMIC_ACQUIRE, "agent");
            asm volatile("s_waitcnt vmcnt(0)" ::: "memory");
        }
    }
    __syncthreads();
}

struct Params {
    const float* in[27];
    float* out;
    unsigned char* ws;
    int ph_lo, ph_hi;
};
__device__ __forceinline__ LAS unsigned char* lds_at(int off) { asm volatile("" : "+s"(off)); return (LAS unsigned char*)(unsigned)off; }
constexpr int LDS_PTAB = LDS_BYTES - 512;
__device__ __forceinline__ void ptab_store(const Params& p, int tid) {
    LAS unsigned long long* t = (LAS unsigned long long*)lds_at(LDS_PTAB);
    if (tid == 0) {
#pragma unroll
        for (int i = 0; i < 27; ++i) t[i] = (unsigned long long)p.in[i];
        t[27] = (unsigned long long)p.out; t[28] = (unsigned long long)p.ws; }
}
__device__ __forceinline__ unsigned long long ptab_get(int i) {
    const LAS unsigned* t = (const LAS unsigned*)lds_at(LDS_PTAB) + 2 * i;
    const unsigned lo = __builtin_amdgcn_readfirstlane(t[0]), hi = __builtin_amdgcn_readfirstlane(t[1]);
    return ((unsigned long long)hi << 32) | lo;
}
__device__ __forceinline__ unsigned char* ws_late() { return (unsigned char*)ptab_get(28); }
#define PIN(i) ((const float*)ptab_get(i))
__device__ __forceinline__ void ptab_load(Params& q) {
    asm volatile("" ::: "memory");
#pragma unroll
    for (int i = 0; i < 27; ++i) q.in[i] = (const float*)ptab_get(i);
    q.out = (float*)ptab_get(27); q.ws = (unsigned char*)ptab_get(28); q.ph_lo = 0; q.ph_hi = 0;
}

namespace pg8 {
constexpr int BM = 256, BK = 64, HALF = 128, HTB = HALF * BK * 2, NXCD = 8, WGM = 8;
__device__ __forceinline__ int lds_byte(int r, int c) { const int st = (r >> 4) * 2 + (c >> 5), rr = r & 15, cc = c & 31, ob = rr * 64 + cc * 2; return st * 1024 + (ob ^ (((ob >> 9) & 1) << 5)); }
__device__ __forceinline__ void stage_rc(int b, int& R, int& C) { const int st = b / 1024, sb = b % 1024, swz = sb ^ (((sb >> 9) & 1) << 5); R = (st >> 1) * 16 + swz / 64; C = (st & 1) * 32 + (swz % 64) / 2; }
__device__ __forceinline__ int perm32(int rho) { const int n = rho >> 4, i = rho & 15; return 8 * (i >> 2) + 4 * n + (i & 3); }

struct Unit { unsigned a, b, rows; int pm, pn, aux, nvalid; };

__device__ __forceinline__ bool dense_unit(int i, int G, int c, int nM, int nN, int& pm, int& pn) {
    const int nwg = nM * nN; const long L = (long)i * G + c; if (L >= nwg) return false;
    int wgid = (int)L; { const int q = nwg / NXCD, r = nwg % NXCD, xcd = wgid % NXCD, off = wgid / NXCD; wgid = (xcd < r ? xcd * (q + 1) : r * (q + 1) + (xcd - r) * q) + off; }
    const int nig = WGM * nN, gid = wgid / nig, fm = gid * WGM, gsz = (nM - fm) < WGM ? (nM - fm) : WGM;
    pm = fm + ((wgid % nig) % gsz); pn = (wgid % nig) / gsz; return true;
}

typedef int i32x4 __attribute__((ext_vector_type(4)));
typedef int i32x8 __attribute__((ext_vector_type(8)));
template <class Epi, class Sched, bool ALIGN_EPI, bool GATHER, bool F8 = false>
__device__ __forceinline__ void gemm_phase(LAS unsigned char* lds, const int K, const int lda, const int ldb, const Sched& S, const Epi& E, const int tid, const char* wsb) {
    const int wid = __builtin_amdgcn_readfirstlane(tid >> 6), lane = tid & 63, wr = wid >> 2, wc = wid & 3, fr = lane & 15, fq = lane >> 4;
    constexpr int ESZ = F8 ? 1 : 2;
    const int nt = K / (F8 ? 128 : BK);
    unsigned voffA[2], voffB[2]; int rA[2], cA2[2];
#pragma unroll
    for (int i = 0; i < 2; ++i) { int R, C; stage_rc(tid * 16 + i * 8192, R, C); const int Rb = Epi::PERM ? ((R & ~31) + perm32(R & 31)) : R;
        rA[i] = R; cA2[i] = C * 2; voffA[i] = (unsigned)(R * lda * ESZ + C * 2); voffB[i] = (unsigned)(Rb * ldb * ESZ + C * 2); }
    const unsigned kstep = (unsigned)(BK * 2);
    const unsigned hstepA = GATHER ? 0u : (unsigned)(HALF * lda * ESZ), hstepB = (unsigned)(HALF * ldb * ESZ);
    const unsigned ldsw = (unsigned)wid * 1024u, s64A = (unsigned)(64 * lda * ESZ), s64B = (unsigned)(64 * ldb * ESZ);
    const int aoff = lds_byte(wr * 64 + fr, fq * (F8 ? 16 : 8)), boff = lds_byte(wc * 32 + fr, fq * (F8 ? 16 : 8));
#define PG8_SA(b, h) (((b) * 2 + (h)) * HTB)
#define PG8_SB(b, h) ((4 + (b) * 2 + (h)) * HTB)
#define PG8_STAGE(bufoff, gbase, voff) do { _Pragma("unroll") for (int _i = 0; _i < 2; ++_i) \
        __builtin_amdgcn_global_load_lds((const unsigned*)(wsb + (size_t)(unsigned)((gbase) + (voff)[_i])), (LAS unsigned*)(lds + (bufoff) + ldsw + _i * 8192), 16, 0, 0); } while (0)
#define PG8_STAGE1(bufoff, gbase, voff0, step64) do { _Pragma("unroll") for (int _i = 0; _i < 2; ++_i) \
        __builtin_amdgcn_global_load_lds((const unsigned*)(wsb + (size_t)(unsigned)((gbase) + (unsigned)_i * (step64) + (voff0))), (LAS unsigned*)(lds + (bufoff) + ldsw + _i * 8192), 16, 0, 0); } while (0)
#define PG8_LDA(dst, b, h) do { _Pragma("unroll") for (int m = 0; m < 4; ++m) { if constexpr (F8) dst##8[m] = *(const LAS i32x8*)(lds + PG8_SA(b, h) + aoff + m * 2048); else { _Pragma("unroll") for (int k = 0; k < 2; ++k) dst[m][k] = *(const LAS bf16x8*)(lds + PG8_SA(b, h) + aoff + m * 2048 + k * 1024); } } } while (0)
#define PG8_LDB(dst, b, h) do { _Pragma("unroll") for (int n = 0; n < 2; ++n) { if constexpr (F8) dst##8[n] = *(const LAS i32x8*)(lds + PG8_SB(b, h) + boff + n * 2048); else { _Pragma("unroll") for (int k = 0; k < 2; ++k) dst[n][k] = *(const LAS bf16x8*)(lds + PG8_SB(b, h) + boff + n * 2048 + k * 1024); } } } while (0)
#define PG8_MMA(ai, bj, At, Bt) do { __builtin_amdgcn_s_setprio(1); _Pragma("unroll") for (int m = 0; m < 4; ++m) _Pragma("unroll") for (int n = 0; n < 2; ++n) { \
        if constexpr (F8) acc[ai][bj][m][n] = __builtin_amdgcn_mfma_scale_f32_16x16x128_f8f6f4(Bt##8[n], At##8[m], acc[ai][bj][m][n], 0, 0, 0, 0, 0, 0); \
        else { _Pragma("unroll") for (int k = 0; k < 2; ++k) acc[ai][bj][m][n] = __builtin_amdgcn_mfma_f32_16x16x32_bf16(Bt[n][k], At[m][k], acc[ai][bj][m][n], 0, 0, 0); } } \
        __builtin_amdgcn_s_setprio(0); } while (0)
#define PG8_WAIT_V(n) asm volatile("s_waitcnt vmcnt(" #n ")" ::: "memory")
#define PG8_WAIT_L(n) asm volatile("s_waitcnt lgkmcnt(" #n ")" ::: "memory")
#define PG8_BAR __builtin_amdgcn_s_barrier()
#define PG8_SCHED __builtin_amdgcn_sched_barrier(0)
    for (int pass_ = 0;; ++pass_) {
    Unit cur, nxt; int ui = 0;
    S.begin(tid, pass_ == 0);
    if (!S.next(0, cur)) return;
    f32x4 acc[2][2][4][2];
#pragma unroll
    for (int a = 0; a < 2; ++a)
#pragma unroll
        for (int b = 0; b < 2; ++b)
#pragma unroll
            for (int m = 0; m < 4; ++m)
#pragma unroll
                for (int n = 0; n < 2; ++n) acc[a][b][m][n] = (f32x4){0.f, 0.f, 0.f, 0.f};
    bf16x8 At[4][2], B0[2][2], B1[2][2]; i32x8 At8[4], B08[2], B18[2];
    unsigned cA = cur.a, cB = cur.b;
    LAS unsigned* grec = (LAS unsigned*)(lds + 131072) + tid * 8;
    if constexpr (GATHER) {
#pragma unroll
        for (int i = 0; i < 2; ++i) { const unsigned o0 = (unsigned)S.row(cur, rA[i]) * (unsigned)(lda * ESZ) + cA2[i], o1 = (unsigned)S.row(cur, HALF + rA[i]) * (unsigned)(lda * ESZ) + cA2[i];
            grec[i] = o0; grec[2 + i] = o1; grec[4 + i] = o0; grec[6 + i] = o1; }
    }
#define PG8_STAGE_A(bufoff, kptr, h, usenext) do { if constexpr (GATHER) { const u32x2 _w = *(const LAS u32x2*)(grec + ((usenext) ? 4 : 0) + 2 * (h)); unsigned _v[2]; _v[0] = _w.x; _v[1] = _w.y; PG8_STAGE(bufoff, kptr, _v); } \
        else { PG8_STAGE1(bufoff, (kptr) + (h) * hstepA, voffA[0], s64A); } } while (0)
    PG8_STAGE1(PG8_SB(0, 0), cB, voffB[0], s64B); PG8_STAGE1(PG8_SB(0, 1), cB + hstepB, voffB[0], s64B); PG8_STAGE_A(PG8_SA(0, 0), cA, 0, false); PG8_STAGE_A(PG8_SA(0, 1), cA, 1, false);
    if (wr == 1) PG8_BAR;
    PG8_WAIT_V(2); PG8_BAR;
    PG8_STAGE1(PG8_SB(1, 0), cB + kstep, voffB[0], s64B); PG8_STAGE_A(PG8_SA(1, 0), cA + kstep, 0, false); PG8_STAGE1(PG8_SB(1, 1), cB + hstepB + kstep, voffB[0], s64B);
    PG8_WAIT_V(6); PG8_BAR;
    for (;;) {
        const bool has_next = S.next(ui + 1, nxt);
        const int tk_ = S.issue(tid, has_next);
        const unsigned nA = has_next ? nxt.a : cA, nB = has_next ? nxt.b : cB;
#pragma nounroll
        for (int t = 0; t < nt; t += 2) {
            const bool last = (t == nt - 2);
            const unsigned a1 = cA + (unsigned)(t + 1) * kstep;
            const unsigned a2 = last ? nA : cA + (unsigned)(t + 2) * kstep, b2 = last ? nB : cB + (unsigned)(t + 2) * kstep;
            const unsigned a3 = a2 + kstep, b3 = b2 + kstep;
            if constexpr (GATHER) { if (last && has_next) {
#pragma unroll
                for (int i = 0; i < 2; ++i) { grec[4 + i] = (unsigned)S.row(nxt, rA[i]) * (unsigned)(lda * ESZ) + cA2[i]; grec[6 + i] = (unsigned)S.row(nxt, HALF + rA[i]) * (unsigned)(lda * ESZ) + cA2[i]; } } }
            PG8_LDB(B0, 0, 0); PG8_LDB(B1, 0, 1); PG8_SCHED; PG8_LDA(At, 0, 0); PG8_STAGE_A(PG8_SA(1, 1), a1, 1, false);
            PG8_WAIT_V(8); PG8_WAIT_L(0); PG8_BAR; PG8_MMA(0, 0, At, B0); PG8_MMA(0, 1, At, B1); PG8_BAR; PG8_SCHED;
            PG8_LDA(At, 0, 1); PG8_STAGE1(PG8_SB(0, 0), b2, voffB[0], s64B); PG8_STAGE1(PG8_SB(0, 1), b2 + hstepB, voffB[0], s64B); PG8_STAGE_A(PG8_SA(0, 0), a2, 0, last);
            PG8_WAIT_V(8); PG8_WAIT_L(0); PG8_BAR; PG8_MMA(1, 0, At, B0); PG8_MMA(1, 1, At, B1); PG8_BAR; PG8_SCHED;
            PG8_LDB(B0, 1, 0); PG8_LDB(B1, 1, 1); PG8_SCHED; PG8_LDA(At, 1, 0); PG8_STAGE_A(PG8_SA(0, 1), a2, 1, last);
            PG8_WAIT_V(8); PG8_WAIT_L(0); PG8_BAR; PG8_MMA(0, 0, At, B0); PG8_MMA(0, 1, At, B1); PG8_BAR; PG8_SCHED;
            PG8_LDA(At, 1, 1); PG8_STAGE1(PG8_SB(1, 0), b3, voffB[0], s64B); PG8_STAGE1(PG8_SB(1, 1), b3 + hstepB, voffB[0], s64B); PG8_STAGE_A(PG8_SA(1, 0), a3, 0, last);
            PG8_WAIT_V(8); PG8_WAIT_L(0); PG8_BAR; PG8_MMA(1, 0, At, B0); PG8_MMA(1, 1, At, B1); PG8_BAR; PG8_SCHED;
        }
        S.commit(tid, ui, tk_);
        if constexpr (ALIGN_EPI) { if (wr == 0) PG8_BAR; }
        { int tz = tid; asm volatile("" : "+v"(tz)); const int ew = __builtin_amdgcn_readfirstlane(tz >> 6), el = tz & 63;
          E(acc, cur, ew >> 2, ew & 3, el & 15, el >> 4); }
        if (!has_next) break;
#pragma unroll
        for (int a = 0; a < 2; ++a)
#pragma unroll
            for (int b = 0; b < 2; ++b)
#pragma unroll
                for (int m = 0; m < 4; ++m)
#pragma unroll
                    for (int n = 0; n < 2; ++n) acc[a][b][m][n] = (f32x4){0.f, 0.f, 0.f, 0.f};
        cur = nxt; cA = nA; cB = nB; ++ui;
        if constexpr (GATHER) { const u32x4 _n = *(const LAS u32x4*)(grec + 4); *(LAS u32x4*)grec = _n; }
        if constexpr (ALIGN_EPI) { if (wr == 1) PG8_BAR; }
    }
    PG8_WAIT_V(0);
    if constexpr (!ALIGN_EPI) { if (wr == 0) PG8_BAR; }
    PG8_BAR;
    if constexpr (!Sched::RESTART) break;
    }
#undef PG8_SA
#undef PG8_SB
#undef PG8_STAGE
#undef PG8_STAGE_A
#undef PG8_LDA
#undef PG8_LDB
#undef PG8_MMA
#undef PG8_WAIT_V
#undef PG8_WAIT_L
#undef PG8_BAR
#undef PG8_SCHED
}
}
using pg8::Unit;

constexpr int LDS_TICK = 147456;
struct DenseSched {
    static constexpr bool RESTART = true;
    unsigned A, Bt, tA, tB, aBr; int nM, nN, G, c, pnShift; unsigned* ctr;
    __device__ __forceinline__ int take(int k) const { const int x = (int)((xb_xcc_id() + (unsigned)k) & 7u); return (int)__hip_atomic_fetch_add(ctr + 8 * x, 1u, __ATOMIC_RELAXED, __HIP_MEMORY_SCOPE_AGENT) * 8 + x; }
    __device__ __forceinline__ void begin(int tid, bool first) const { volatile LAS int* tk = (volatile LAS int*)lds_at(LDS_TICK);
        __syncthreads();
        if (tid == 0) { const int nwg = nM * nN; int k = first ? 0 : tk[2] + 1, t0 = 0x3fffffff, t1 = 0x3fffffff;
            if (k < 8) { unsigned cv[8];
#pragma unroll
                for (int j = 0; j < 8; ++j) cv[j] = __hip_atomic_load(G_(ctr + 8 * j), __ATOMIC_RELAXED, __HIP_MEMORY_SCOPE_AGENT);
                const int x0 = (int)(xb_xcc_id() & 7u);
                for (; k < 8; ++k) { const int x = (x0 + k) & 7; unsigned c_ = cv[0];
#pragma unroll
                    for (int j = 1; j < 8; ++j) c_ = (x == j) ? cv[j] : c_;
                    if ((int)(c_ * 8u) + x >= nwg) continue;
                    const int L = take(k); if (L < nwg) { t0 = L; t1 = take(k); break; } } }
            tk[0] = t0; tk[1] = t1; tk[2] = k; }
        __syncthreads(); }
    __device__ __forceinline__ int issue(int tid, bool more) const { int t = 0x3fffffff; if (tid == 0 && more) t = take(((volatile LAS int*)lds_at(LDS_TICK))[2]); return t; }
    __device__ __forceinline__ void commit(int tid, int ui, int t) const { if (tid == 0) { volatile LAS int* tk = (volatile LAS int*)lds_at(LDS_TICK); tk[ui & 1] = t; asm volatile("s_waitcnt vmcnt(0) lgkmcnt(0)" ::: "memory"); } }
    __device__ __forceinline__ bool next(int i, Unit& u) const {
        const int L = __builtin_amdgcn_readfirstlane(((volatile LAS int*)lds_at(LDS_TICK))[i & 1]);
        int pm, pn; if (L < 0 || L >= nM * nN || !pg8::dense_unit(0, 1, L, nM, nN, pm, pn)) return false;
        u.pm = pm; u.pn = pn; u.aux = 0; u.nvalid = 256; u.rows = 0u;
        u.a = A + (unsigned)(pn >> pnShift) * aBr + (unsigned)pm * tA; u.b = Bt + (unsigned)pn * tB; return true;
    }
    __device__ __forceinline__ int row(const Unit&, int) const { return 0; }
};
struct OneSched {
    static constexpr bool RESTART = false;
    Unit u0; bool has;
    __device__ __forceinline__ void begin(int, bool) const {}
    __device__ __forceinline__ int issue(int, bool) const { return 0; }
    __device__ __forceinline__ void commit(int, int, int) const {}
    __device__ __forceinline__ bool next(int i, Unit& u) const { if (i > 0 || !has) return false; u = u0; return true; }
    __device__ __forceinline__ int row(const Unit&, int) const { return 0; }
};
struct MoeSched {
    const LAS int* pre;
    const LAS int* cnt;
    const char* wsb;
    static constexpr bool RESTART = false;
    unsigned A, W, wE, wT, aT; int G, c; bool gatherA; unsigned* ctr;
    __device__ __forceinline__ void begin(int tid, bool) const { volatile LAS int* tk = (volatile LAS int*)lds_at(LDS_TICK);
        __syncthreads();
        if (tid == 0) { const int t0 = (int)__hip_atomic_fetch_add(G_(ctr), 1u, __ATOMIC_RELAXED, __HIP_MEMORY_SCOPE_AGENT), t1 = (int)__hip_atomic_fetch_add(G_(ctr), 1u, __ATOMIC_RELAXED, __HIP_MEMORY_SCOPE_AGENT); tk[0] = t0; tk[1] = t1; }
        __syncthreads(); }
    __device__ __forceinline__ int issue(int tid, bool more) const { int t = 0x3fffffff; if (tid == 0 && more) t = (int)__hip_atomic_fetch_add(G_(ctr), 1u, __ATOMIC_RELAXED, __HIP_MEMORY_SCOPE_AGENT); return t; }
    __device__ __forceinline__ void commit(int tid, int ui, int t) const { if (tid == 0) { volatile LAS int* tk = (volatile LAS int*)lds_at(LDS_TICK); tk[ui & 1] = t; asm volatile("s_waitcnt vmcnt(0) lgkmcnt(0)" ::: "memory"); } }
    __device__ __forceinline__ bool next(int i, Unit& u) const {
        const int L = __builtin_amdgcn_readfirstlane(((volatile LAS int*)lds_at(LDS_TICK))[i & 1]); const int total = pre[16] * 4; if (L < 0 || L >= total) return false;
        const int t = (int)(L >> 2), pn = (int)(L & 3); int e = 0;
#pragma unroll
        for (int j = 1; j < 16; ++j) e += (pre[j] <= t) ? 1 : 0;
        const int pm = t - pre[e];
        u.aux = e; u.pm = t; u.pn = pn; u.nvalid = min(256, cnt[e] - 256 * pm); u.rows = (unsigned)(WS_R + R_LIST) + (unsigned)(e * MTOK + 256 * pm) * 4u;
        u.a = gatherA ? A : A + (unsigned)t * aT; u.b = W + (unsigned)e * wE + (unsigned)pn * wT; return true;
    }
    __device__ __forceinline__ int row(const Unit& u, int R) const { return (R < u.nvalid) ? (((const int*)(wsb + u.rows))[R] >> 1) : 0; }
};

typedef f32x4 Acc[2][2][4][2];
#define EPI_LOOP_AIM _Pragma("unroll") for (int ai = 0; ai < 2; ++ai) _Pragma("unroll") for (int m = 0; m < 4; ++m)
__device__ __forceinline__ u32x4 pack8(const f32x4& a, const f32x4& b) { u32x4 w; w.x = pk2(a[0], a[1]); w.y = pk2(a[2], a[3]); w.z = pk2(b[0], b[1]); w.w = pk2(b[2], b[3]); return w; }

struct EpiProj {
    static constexpr bool PERM = true;
    __device__ __forceinline__ void operator()(const Acc& acc, const Unit& u, int wr, int wc, int fr, int fq) const {
        unsigned char* ws = ws_late(); bf16_t* proj = (bf16_t*)(ws + WS_R + R_PROJ); bf16_t* nkv = (bf16_t*)(ws + WS_R + R_NKV); float* sm = (float*)(ws + WS_R + R_SM);
        const int row0 = u.pm * 256 + wr * 64 + fr;
        if (u.pn < 12) {
            const float sc = ((u.pn == 8 || u.pn == 9) ? QSCALE : (u.pn == 5 ? 0.125f : 1.0f)) * F8_DESCALE;
            const int col0 = u.pn * 256 + wc * 32 + 8 * fq;
            EPI_LOOP_AIM { bf16_t* rp = proj + (size_t)(row0 + ai * 128 + m * 16) * PROJW + col0;
#pragma unroll
                for (int bj = 0; bj < 2; ++bj) *G_((u32x4*)(rp + bj * 128)) = pack8(acc[ai][bj][m][0] * sc, acc[ai][bj][m][1] * sc); }
        } else {
#pragma unroll
            for (int bj = 0; bj < 2; ++bj) {
                if (u.pn == 12 || bj == 0) {
                    const int seg = (u.pn - 12) * 4 + bj * 2 + (wc >> 1), col = 32 * (wc & 1) + 8 * fq;
                    bf16_t* base = nkv + (size_t)seg * (NKV_SEG / 2) + col;
                    EPI_LOOP_AIM { *G_((u32x4*)(base + (size_t)(row0 + ai * 128 + m * 16) * 64)) = pack8(acc[ai][bj][m][0] * F8_DESCALE, acc[ai][bj][m][1] * F8_DESCALE); }
                } else if (wc == 0 && fq < 3) {
                    EPI_LOOP_AIM { float* sp = sm + (size_t)(row0 + ai * 128 + m * 16) * 32 + 8 * fq; *G_((f32x4*)sp) = acc[ai][bj][m][0] * F8_DESCALE; *G_((f32x4*)(sp + 4)) = acc[ai][bj][m][1] * F8_DESCALE; }
                }
            }
        }
    }
};
struct EpiH1 {
    static constexpr bool PERM = true;
    bf16_t* h1; const float* cbias;
    __device__ __forceinline__ void operator()(const Acc& acc, const Unit& u, int wr, int wc, int fr, int fq) const {
        const int which = u.aux, rl0 = wr * 64 + fr;
        bf16_t* base = h1 + ((size_t)which * BC * 256 + (size_t)u.pm * 256) * 256;
        const float* bp = cbias + which * 256;
#pragma unroll
        for (int bj = 0; bj < 2; ++bj) { const int col = bj * 128 + wc * 32 + 8 * fq; const f32x4 b0 = *(const f32x4*)(bp + col), b1 = *(const f32x4*)(bp + col + 4);
            EPI_LOOP_AIM { const int rl = rl0 + ai * 128 + m * 16; f32x4 v0 = acc[ai][bj][m][0] + b0, v1 = acc[ai][bj][m][1] + b1;
#pragma unroll
                for (int e = 0; e < 4; ++e) { v0[e] = (rl < 255) ? siluf_(v0[e]) : 0.f; v1[e] = (rl < 255) ? siluf_(v1[e]) : 0.f; }
                *G_((u32x4*)(base + (size_t)rl * 256 + col)) = pack8(v0, v1); } }
    }
};
struct EpiCmp2 {
    static constexpr bool PERM = true;
    bf16_t* kc;
    __device__ __forceinline__ void operator()(const Acc& acc, const Unit& u, int wr, int wc, int fr, int fq) const {
        if (wc >= 2) return;
        const int col = wc * 32 + 8 * fq; bf16_t* base = kc + ((size_t)u.aux * BC + u.pm) * 256 * 64 + col;
        EPI_LOOP_AIM { const int rl = wr * 64 + fr + ai * 128 + m * 16; *G_((u32x4*)(base + (size_t)rl * 64)) = pack8(acc[ai][0][m][0], acc[ai][0][m][1]); }
    }
};
struct EpiP {
    static constexpr bool PERM = true;
    __device__ __forceinline__ void operator()(const Acc& acc, const Unit& u, int wr, int wc, int fr, int fq) const {
        const int i = u.pn >> 2, pt = u.pn & 3, row0 = u.pm * 256 + wr * 64 + fr;
        unsigned char* P = ws_late() + WS_R + R_P + (unsigned)(i * 64 + 32 * (wc & 1) + 8 * fq);
#pragma unroll
        for (int bj = 0; bj < 2; ++bj) { const unsigned gp = (unsigned)(4 * pt + 2 * bj + (wc >> 1));
            EPI_LOOP_AIM { const f32x4 a = acc[ai][bj][m][0] * P8_SCALE, b = acc[ai][bj][m][1] * P8_SCALE; u32x2 w; w.x = pk4_fp8(a[0], a[1], a[2], a[3]); w.y = pk4_fp8(b[0], b[1], b[2], b[3]);
                *G_((u32x2*)(P + (size_t)(gp * (unsigned)MC + (unsigned)(row0 + ai * 128 + m * 16)) * 256)) = w; } }
    }
};
struct EpiGate {
    static constexpr bool PERM = true;
    __device__ __forceinline__ void operator()(const Acc& acc, const Unit& u, int wr, int wc, int fr, int fq) const {
        unsigned char* ws = ws_late(); const unsigned char* P = ws + WS_R + R_P + (size_t)u.pn * MC * 256 + (unsigned)(16 * wc + 4 * fq); unsigned char* y = ws + WS_R + R_Y;
        const int row0 = u.pm * 256 + wr * 64 + fr, oc = 64 * u.pn + 16 * wc + 4 * fq;
#pragma unroll
        for (int ai = 0; ai < 2; ++ai) {
            unsigned pw[4][4];
#pragma unroll
            for (int m = 0; m < 4; ++m) { const unsigned r = (unsigned)(row0 + ai * 128 + m * 16);
#pragma unroll
                for (int i = 0; i < 4; ++i) pw[m][i] = *G_((const unsigned*)(P + (r * 256u + (unsigned)(i * 64)))); }
#pragma unroll
            for (int m = 0; m < 4; ++m) { const unsigned r = (unsigned)(row0 + ai * 128 + m * 16);
                f32x4 s = {0.f, 0.f, 0.f, 0.f};
#pragma unroll
                for (int bj = 0; bj < 2; ++bj)
#pragma unroll
                    for (int n = 0; n < 2; ++n) { const int pq = (int)pw[m][2 * bj + n]; const f32x4 a = acc[ai][bj][m][n];
                        s[0] += sigmoidf_(a[0] * F8_DESCALE) * __builtin_amdgcn_cvt_f32_fp8(pq, 0); s[1] += sigmoidf_(a[1] * F8_DESCALE) * __builtin_amdgcn_cvt_f32_fp8(pq, 1);
                        s[2] += sigmoidf_(a[2] * F8_DESCALE) * __builtin_amdgcn_cvt_f32_fp8(pq, 2); s[3] += sigmoidf_(a[3] * F8_DESCALE) * __builtin_amdgcn_cvt_f32_fp8(pq, 3); }
                constexpr float YS = Y8_SCALE / P8_SCALE;
                *G_((unsigned*)(y + (r * 1024u + (unsigned)oc))) = pk4_fp8(s[0] * YS, s[1] * YS, s[2] * YS, s[3] * YS); }
        }
    }
};
struct EpiOut {
    static constexpr bool PERM = true;
    int row_base;
    __device__ __forceinline__ void operator()(const Acc& acc, const Unit& u, int wr, int wc, int fr, int fq) const {
        bf16_t* T = (bf16_t*)(ws_late() + WS_T);
        const int rg0 = row_base + u.pm * 256 + wr * 64 + fr, col0 = u.pn * 256 + wc * 32 + 8 * fq;
        EPI_LOOP_AIM { bf16_t* rp = T + (size_t)(rg0 + ai * 128 + m * 16) * 1024 + col0;
#pragma unroll
            for (int bj = 0; bj < 2; ++bj) *G_((u32x4*)(rp + bj * 128)) = pack8(acc[ai][bj][m][0] * Y8_DESCALE, acc[ai][bj][m][1] * Y8_DESCALE); }
    }
};
struct EpiComb {
    static constexpr bool PERM = true;
    int mode, row_base;
    __device__ __forceinline__ void operator()(const Acc& acc, const Unit& u, int wr, int wc, int fr, int fq) const {
        if (mode == 0) { EpiProj e; e(acc, u, wr, wc, fr, fq); } else if (mode == 1) { EpiGate e; e(acc, u, wr, wc, fr, fq); } else { EpiOut e; e.row_base = row_base; e(acc, u, wr, wc, fr, fq); }
    }
};
struct EpiMoe1 {
    static constexpr bool PERM = true;
    __device__ __forceinline__ void operator()(const Acc& acc, const Unit& u, int wr, int wc, int fr, int fq) const {
        const int rl0 = wr * 64 + fr, f0 = 128 * u.pn + 32 * wc + 8 * fq;
        bf16_t* hid = (bf16_t*)(ws_late() + WS_R + R_HID);
        EPI_LOOP_AIM { const int rl = rl0 + ai * 128 + m * 16;
            f32x4 a0 = acc[ai][0][m][0], a1 = acc[ai][0][m][1]; const f32x4 b0 = acc[ai][1][m][0], b1 = acc[ai][1][m][1];
#pragma unroll
            for (int e = 0; e < 4; ++e) { a0[e] = siluf_(a0[e]) * b0[e]; a1[e] = siluf_(a1[e]) * b1[e]; }
            *G_((u32x4*)(hid + (unsigned)((u.pm * 256 + rl) * 512 + f0))) = pack8(a0, a1); __builtin_amdgcn_sched_barrier(0); }
    }
};
struct EpiMoe2 {
    static constexpr bool PERM = true;
    __device__ __forceinline__ void operator()(const Acc& acc, const Unit& u, int wr, int wc, int fr, int fq) const {
        unsigned char* ws = ws_late(); bf16_t* out2 = (bf16_t*)(ws + WS_R + R_OUT2);
        const float* cwb = (const float*)(ws + (R_CW - R_LIST) + u.rows); const int* rws = (const int*)(ws + u.rows);
        const int rl0 = wr * 64 + fr, c0 = 256 * u.pn + 32 * wc + 8 * fq;
        EPI_LOOP_AIM { const int rl = rl0 + ai * 128 + m * 16;
            if (rl < u.nvalid) { const unsigned v = (unsigned)*G_(rws + rl); const float wgt = *G_(cwb + rl); bf16_t* rp = out2 + (size_t)v * 1024 + c0;
#pragma unroll
                for (int bj = 0; bj < 2; ++bj) *G_((u32x4*)(rp + bj * 128)) = pack8(acc[ai][bj][m][0] * wgt, acc[ai][bj][m][1] * wgt); } }
    }
};

enum { IN_X = 0, IN_C, IN_POS, IN_ADAW, IN_ADAB, IN_WIN, IN_CONVW, IN_ALOG, IN_DTB, IN_GNORM, IN_RETGN, IN_PE, IN_CKW1, IN_CKW2, IN_CVW1, IN_CVW2, IN_FBIAS,
       IN_BP, IN_WG, IN_WO, IN_LNG, IN_LNB, IN_RW, IN_RB, IN_EW1, IN_EW3, IN_EW2 };

__device__ __forceinline__ void p0_ada(const Params& p, int item, LAS float* lf, const int tid) {
    LAS float* sc = lf; LAS float* red = lf + 16384;
    const float* c = PIN(IN_C);
    for (int i = tid; i < 16384; i += NTHR) sc[i] = siluf_(c[i]);
    __syncthreads();
    const int ls = item / 48, cb = item % 48, col = cb * 64 + (tid & 63), ks = tid >> 6;
    const float* w = PIN(IN_ADAW) + (size_t)ls * 1024 * 3072 + col;
    float acc[16];
#pragma unroll
    for (int b = 0; b < 16; ++b) acc[b] = 0.f;
    for (int k0 = ks * 128; k0 < ks * 128 + 128; k0 += 16) { float wv[16];
#pragma unroll
        for (int kk = 0; kk < 16; ++kk) wv[kk] = w[(size_t)(k0 + kk) * 3072];
#pragma unroll
        for (int kk = 0; kk < 16; ++kk)
#pragma unroll
            for (int b = 0; b < 16; ++b) acc[b] += sc[b * 1024 + k0 + kk] * wv[kk]; }
#pragma unroll
    for (int b = 0; b < 16; ++b) red[(ks * 16 + b) * 64 + (tid & 63)] = acc[b];
    __syncthreads();
    float* mod = (float*)(p.ws + WS_MOD);
    for (int o = tid; o < 1024; o += NTHR) { const int b = o >> 6, cc = o & 63; float s = 0.f;
#pragma unroll
        for (int q = 0; q < 8; ++q) s += red[(q * 16 + b) * 64 + cc];
        mod[((size_t)ls * 16 + b) * 3072 + cb * 64 + cc] = s + PIN(IN_ADAB)[ls * 3072 + cb * 64 + cc]; }
    __syncthreads();
}
__device__ __forceinline__ void p0_rope(const Params& p, int item, const int tid) {
    const int* pos = (const int*)PIN(IN_POS); f32x2* tab = (f32x2*)(p.ws + WS_ROPE);
#pragma unroll
    for (int j = 0; j < 8; ++j) { const int idx = item * 4096 + j * 512 + tid; const int m = idx >> 5, i = idx & 31;
        const float inv = powf(10000.0f, -(float)i / 32.0f); const float ang = (float)pos[m] * inv;
        const float n = rintf(ang * 0.6366197723675814f);
        float r = fmaf(n, -1.5703125f, ang); r = fmaf(n, -4.837512969970703125e-4f, r); r = fmaf(n, -7.54978995489188e-8f, r);
        const float s = sinf(r), cs = cosf(r); const int q = ((int)n) & 3;
        float so, co; if (q == 0) { so = s; co = cs; } else if (q == 1) { so = cs; co = -s; } else if (q == 2) { so = -s; co = -cs; } else { so = -cs; co = s; }
        tab[idx] = (f32x2){co, so}; }
}
__device__ __forceinline__ void p0_cbias(const Params& p, int item, LAS float* red, const int tid) {
    const int l = item >> 1, which = item & 1, col = tid & 255, half = tid >> 8;
    const float* pe = PIN(IN_PE) + (size_t)l * 2048 + half * 1024; const float* w1 = PIN(which ? IN_CVW1 : IN_CKW1) + (size_t)l * 2048 * 256 + (size_t)half * 1024 * 256 + col;
    float s = 0.f;
    for (int k0 = 0; k0 < 1024; k0 += 16) { float wv[16];
#pragma unroll
        for (int kk = 0; kk < 16; ++kk) wv[kk] = w1[(size_t)(k0 + kk) * 256];
#pragma unroll
        for (int kk = 0; kk < 16; ++kk) s += pe[k0 + kk] * wv[kk]; }
    __syncthreads();
    red[tid] = s;
    __syncthreads();
    if (tid < 256) ((float*)(p.ws + WS_CBIAS))[item * 256 + tid] = red[tid] + red[tid + 256];
    __syncthreads();
}
struct TJob { bf16_t* dst; int K, nrt, nkt; };
constexpr int TJ_TILES[8] = {56 * 16, 64 * 16, 64 * 4, 16 * 16, 256 * 16, 256 * 8, 8 * 32, 8 * 4};
constexpr int TJ_TOTAL = 56 * 16 + 64 * 16 + 64 * 4 + 16 * 16 + 256 * 16 + 256 * 8 + 8 * 32 + 8 * 4;
__device__ __forceinline__ int win_src_col(int pc) {
    if (pc < 768) return pc;
    if (pc < 1024) return pc - 768 + 776;
    if (pc < 2048) return pc - 1024 + 1032;
    if (pc < 2304) return pc - 2048 + 2056;
    if (pc < 3072) return pc - 2304 + 2708;
    if (pc < 3456) return pc - 3072 + 2312;
    if (pc < 3464) return pc - 3456 + 768;
    if (pc < 3476) return pc - 3464 + 2696;
    if (pc < 3480) return pc - 3476 + 3476;
    return -1;
}
__device__ __forceinline__ const float* tj_src(const Params& p, int l, int job, int n, int& pitch) {
    switch (job) {
    case 0: { pitch = 3480; const int c = win_src_col(n); return c < 0 ? nullptr : PIN(IN_WIN) + (size_t)l * 1024 * 3480 + c; }
    case 1: { pitch = 1024; const int i = 2 * ((n >> 7) & 1) + ((n >> 2) & 1), c = 64 * (n >> 8) + 16 * ((n >> 5) & 3) + 4 * ((n >> 3) & 3) + (n & 3);
              return PIN(IN_WG) + ((size_t)l * 4 + i) * 1024 * 1024 + c; }
    case 2: { pitch = 1024; const int i = n >> 10, c = n & 1023; return PIN(IN_BP) + ((size_t)l * 4 + i) * 256 * 1024 + c; }
    case 3: { pitch = 1024; return PIN(IN_WO) + (size_t)l * 1024 * 1024 + n; }
    case 4: { pitch = 512; const int e = n >> 10, vr = n & 1023, f = 128 * (vr >> 8) + (vr & 127); return PIN(((vr >> 7) & 1) ? IN_EW3 : IN_EW1) + ((size_t)l * 16 + e) * 1024 * 512 + f; }
    case 5: { pitch = 1024; const int e = n >> 10, c = n & 1023; return PIN(IN_EW2) + ((size_t)l * 16 + e) * 512 * 1024 + c; }
    case 6: { pitch = 256; const int which = n >> 8, c = n & 255; return PIN(which ? IN_CVW1 : IN_CKW1) + (size_t)l * 2048 * 256 + c; }
    default: { pitch = 64; const int which = n >> 8, r = n & 255; return r < 64 ? PIN(which ? IN_CVW2 : IN_CKW2) + (size_t)l * 256 * 64 + r : nullptr; }
    }
}
struct TDesc { const float* src; bf16_t* dst; int pitch, K, rt, kt, job; };
__device__ __forceinline__ void tj_decode(const Params& p, int item, int tx, TDesc& d) {
    const int l = item / TJ_TOTAL; int t = item % TJ_TOTAL, job = 0;
#pragma unroll
    for (int j = 0; j < 8; ++j) { if (job == j && t >= TJ_TILES[j]) { t -= TJ_TILES[j]; job = j + 1; } }
    const size_t lw = WS_W + (size_t)l * ((LW_BYTES + MiB - 1) / MiB) * MiB;
    const size_t offs[8] = {LW_WIN, LW_WGV, LW_BPT, LW_WOT, LW_W13, LW_W2, LW_CW1, LW_CW2};
    const int Ks[8] = {1024, 1024, 256, 1024, 1024, 512, 2048, 256};
    size_t off = 0; int K = 0;
#pragma unroll
    for (int j = 0; j < 8; ++j) if (job == j) { off = offs[j]; K = Ks[j]; }
    d.dst = (bf16_t*)(p.ws + lw + off); d.K = K; d.job = job;
    const int nkt = K / 64; d.rt = t / nkt; d.kt = t % nkt;
    d.src = tj_src(p, l, job, d.rt * 64 + tx, d.pitch);
}
__device__ __forceinline__ void p0_transpose4(const Params& p, int it, int G, int end, LAS float* tiles, const int tid) {
    const int tx = tid & 63, ty = tid >> 6; float v[4][8]; TDesc d[4];
#pragma unroll
    for (int q = 0; q < 4; ++q) { const int item = it + q * G; if (item < end) { tj_decode(p, item, tx, d[q]);
#pragma unroll
            for (int kk = 0; kk < 8; ++kk) v[q][kk] = d[q].src ? d[q].src[(size_t)(d[q].kt * 64 + ty + 8 * kk) * d[q].pitch] : 0.f; } }
#pragma unroll
    for (int q = 0; q < 4; ++q) { if (it + q * G < end) {
#pragma unroll
            for (int kk = 0; kk < 8; ++kk) tiles[q * 4160 + (ty + 8 * kk) * 65 + tx] = v[q][kk]; } }
    __syncthreads();
    const int r = tid >> 3, sg = tid & 7;
#pragma unroll
    for (int q = 0; q < 4; ++q) { if (it + q * G < end) { f32x4 a, b;
#pragma unroll
            for (int j = 0; j < 4; ++j) { a[j] = tiles[q * 4160 + (sg * 8 + j) * 65 + r]; b[j] = tiles[q * 4160 + (sg * 8 + 4 + j) * 65 + r]; }
            if (d[q].job == 1 || d[q].job == 0 || d[q].job == 3) { u32x2 w8; w8.x = pk4_fp8(a[0] * W8_SCALE, a[1] * W8_SCALE, a[2] * W8_SCALE, a[3] * W8_SCALE); w8.y = pk4_fp8(b[0] * W8_SCALE, b[1] * W8_SCALE, b[2] * W8_SCALE, b[3] * W8_SCALE);
                                 *(u32x2*)((unsigned char*)d[q].dst + (size_t)(d[q].rt * 64 + r) * d[q].K + d[q].kt * 64 + sg * 8) = w8; }
            else *(u32x4*)(d[q].dst + (size_t)(d[q].rt * 64 + r) * d[q].K + d[q].kt * 64 + sg * 8) = pack8(a, b); } }
    __syncthreads();
}

struct RowV { f32x4 v[4]; };
__device__ __forceinline__ void row_load(RowV& r, const float* src, int lane) {
#pragma unroll
    for (int j = 0; j < 4; ++j) r.v[j] = __builtin_nontemporal_load(G_((const f32x4*)(src + 4 * lane + 256 * j)));
}
__device__ __forceinline__ void row_stats(const RowV& r, float& mean, float& rstd) {
    float s = 0.f;
#pragma unroll
    for (int j = 0; j < 4; ++j) s += (r.v[j][0] + r.v[j][1]) + (r.v[j][2] + r.v[j][3]);
    mean = wave_sum(s) * (1.0f / 1024.0f);
    float q = 0.f;
#pragma unroll
    for (int j = 0; j < 4; ++j) { const f32x4 d = r.v[j] - mean; q += (d[0] * d[0] + d[1] * d[1]) + (d[2] * d[2] + d[3] * d[3]); }
    rstd = 1.0f / sqrtf(wave_sum(q) * (1.0f / 1024.0f) + LN_EPS);
}
__device__ __forceinline__ void row_ln(RowV& r, float mean, float rstd, const float* g, const float* b, int lane) {
#pragma unroll
    for (int j = 0; j < 4; ++j) { const f32x4 gg = *(const f32x4*)(g + 4 * lane + 256 * j), bb = *(const f32x4*)(b + 4 * lane + 256 * j); r.v[j] = (r.v[j] - mean) * rstd * gg + bb; }
}
__device__ __forceinline__ void row_mod(RowV& h, const RowV& x, const float* mod, int lane) {
#pragma unroll
    for (int j = 0; j < 4; ++j) { const f32x4 sh = *(const f32x4*)(mod + 4 * lane + 256 * j), sc = *(const f32x4*)(mod + 1024 + 4 * lane + 256 * j); h.v[j] = x.v[j] * (sc + 1.0f) + sh; }
}
__device__ __forceinline__ void row_store_bf16(const RowV& h, bf16_t* dst, int lane) {
#pragma unroll
    for (int j = 0; j < 4; ++j) { u32x2 w; w.x = pk2(h.v[j][0], h.v[j][1]); w.y = pk2(h.v[j][2], h.v[j][3]); __builtin_nontemporal_store(w, G_((u32x2*)(dst + 4 * lane + 256 * j))); }
}
__device__ __forceinline__ void vec_load(RowV& v, const float* src, int lane) {
#pragma unroll
    for (int j = 0; j < 4; ++j) v.v[j] = *G_((const f32x4*)(src + 4 * lane + 256 * j));
}
__device__ __forceinline__ void row_ln_r(RowV& r, float mean, float rstd, const RowV& g, const RowV& b) {
#pragma unroll
    for (int j = 0; j < 4; ++j) r.v[j] = (r.v[j] - mean) * rstd * g.v[j] + b.v[j];
}
__device__ __forceinline__ void row_mod_r(RowV& h, const RowV& x, const RowV& sh, const RowV& sc1) {
#pragma unroll
    for (int j = 0; j < 4; ++j) h.v[j] = x.v[j] * sc1.v[j] + sh.v[j];
}
__device__ __forceinline__ void vec_add1(RowV& v) {
#pragma unroll
    for (int j = 0; j < 4; ++j) v.v[j] = v.v[j] + 1.0f;
}
__device__ __forceinline__ void row_store_fp8(const RowV& h, unsigned char* dst, int lane) {
#pragma unroll
    for (int j = 0; j < 4; ++j) __builtin_nontemporal_store(pk4_fp8(h.v[j][0] * H8_SCALE, h.v[j][1] * H8_SCALE, h.v[j][2] * H8_SCALE, h.v[j][3] * H8_SCALE), G_((unsigned*)(dst + 4 * lane + 256 * j)));
}
__device__ __forceinline__ void row_from_bf16(RowV& r, const u32x2 (&t)[4]) {
#pragma unroll
    for (int j = 0; j < 4; ++j) { r.v[j][0] = __uint_as_float(t[j].x << 16); r.v[j][1] = __uint_as_float(t[j].x & 0xffff0000u); r.v[j][2] = __uint_as_float(t[j].y << 16); r.v[j][3] = __uint_as_float(t[j].y & 0xffff0000u); }
}
__device__ __forceinline__ void prep_first(const Params& p, const int tid, const int blk) {
    const int lane = tid & 63, wv = tid >> 6; const float* x = p.in[IN_X]; const float* mod = (const float*)(p.ws + WS_MOD);
    const int row0 = (blk * 8 + wv) * 32;
    RowV sh, sc1; vec_load(sh, mod + (size_t)(row0 >> 12) * 3072, lane); vec_load(sc1, mod + (size_t)(row0 >> 12) * 3072 + 1024, lane); vec_add1(sc1);
    RowV cur; row_load(cur, x + (size_t)row0 * 1024, lane);
    for (int i = 0; i < 32; ++i) { const int row = row0 + i; RowV nx; if (i + 1 < 32) row_load(nx, x + (size_t)(row + 1) * 1024, lane);
        row_store_bf16(cur, (bf16_t*)p.out + (size_t)row * 1024, lane);
        RowV h; row_mod_r(h, cur, sh, sc1); row_store_fp8(h, p.ws + WS_H8 + (size_t)row * 1024, lane); cur = nx; }
}
__device__ __forceinline__ void wave_sum16(float (&a)[16], int lane) {
    float b[8], c[4], d[2];
#pragma unroll
    for (int e = 0; e < 8; ++e) { auto r = __builtin_amdgcn_permlane32_swap(__float_as_uint(a[e]), __float_as_uint(a[e + 8]), false, false); b[e] = __uint_as_float(r[0]) + __uint_as_float(r[1]); }
    const bool h4 = (lane & 16) != 0, h3 = (lane & 8) != 0, h2 = (lane & 4) != 0;
#pragma unroll
    for (int j = 0; j < 4; ++j) c[j] = (h4 ? b[j + 4] : b[j]) + swz_xor<16>(h4 ? b[j] : b[j + 4]);
#pragma unroll
    for (int j = 0; j < 2; ++j) d[j] = (h3 ? c[j + 2] : c[j]) + swz_xor<8>(h3 ? c[j] : c[j + 2]);
    float f = (h2 ? d[1] : d[0]) + swz_xor<4>(h2 ? d[0] : d[1]);
    f += swz_xor<2>(f); f += swz_xor<1>(f);
#pragma unroll
    for (int e = 0; e < 16; ++e) a[e] = __uint_as_float((unsigned)__builtin_amdgcn_readlane((int)__float_as_uint(f), 4 * e));
}
__device__ __forceinline__ void row_load_t(u32x2 (&t)[4], const bf16_t* src, int lane) {
#pragma unroll
    for (int j = 0; j < 4; ++j) t[j] = __builtin_nontemporal_load(G_((const u32x2*)(src + 4 * lane + 256 * j)));
}
__device__ __forceinline__ void prep_moe(const Params& p, int l, LAS float* rwl, const int tid, const int blk) {
    const int lane = tid & 63, wv = tid >> 6;
    { const float* rw = p.in[IN_RW]; for (int i = tid; i < 16384; i += NTHR) { const int c = i >> 4, e = i & 15, ln = (c & 255) >> 2, q = c & 3, j = c >> 8;
        rwl[((((j * 4 + q) * 4 + (e >> 2)) * 64 + ln) << 2) + (e & 3)] = rw[i]; } }
    __syncthreads();
    const bf16_t* xin = (const bf16_t*)p.out; bf16_t* zb = (bf16_t*)(p.ws + WS_T); bf16_t* H = (bf16_t*)(p.ws + WS_H); const bf16_t* T = zb;
    const float* modg = (const float*)(p.ws + WS_MOD) + (size_t)(l * 2) * 16 * 3072; const float* mod = (const float*)(p.ws + WS_MOD) + (size_t)(l * 2 + 1) * 16 * 3072;
    f32x2* stats = (f32x2*)(p.ws + WS_STATS); const float* g = p.in[IN_LNG] + (size_t)(l * 2) * 1024; const float* bb = p.in[IN_LNB] + (size_t)(l * 2) * 1024;
    const float* gp = p.in[IN_LNG] + (size_t)((l > 0 ? l - 1 : 0) * 2 + 1) * 1024; const float* bp = p.in[IN_LNB] + (size_t)((l > 0 ? l - 1 : 0) * 2 + 1) * 1024;
    unsigned* cnt = (unsigned*)(p.ws + WS_CTL) + CW_CNT + l * 64; int* list = (int*)(p.ws + WS_R + R_LIST); float* cw = (float*)(p.ws + WS_R + R_CW);
    const float* rb = p.in[IN_RB];
    LAS unsigned* lcnt = (LAS unsigned*)(rwl + 16384); LAS unsigned* lbase = lcnt + 16; LAS unsigned* lrec = lcnt + 32;
    if (tid < 16) lcnt[tid] = 0u;
    __syncthreads();
    const int row0 = (blk * 8 + wv) * 32; int it_ = 0;
    RowV vgp, vbp, vg, vb, vgate, vsh, vsc1;
    vec_load(vgp, gp, lane); vec_load(vbp, bp, lane); vec_load(vg, g, lane); vec_load(vb, bb, lane);
    vec_load(vgate, modg + (size_t)(row0 >> 12) * 3072 + 2048, lane); vec_load(vsh, mod + (size_t)(row0 >> 12) * 3072, lane); vec_load(vsc1, mod + (size_t)(row0 >> 12) * 3072 + 1024, lane); vec_add1(vsc1);
    int row = row0;
    u32x2 xc[4], tc[4]; row_load_t(xc, xin + (size_t)row * 1024, lane); row_load_t(tc, T + (size_t)row * 1024, lane);
    for (; row < row0 + 32; ++row) {
        const int nrow = row + 1; u32x2 xn[4], tn[4];
        if (nrow < row0 + 32) { row_load_t(xn, xin + (size_t)nrow * 1024, lane); row_load_t(tn, T + (size_t)nrow * 1024, lane); }
        RowV r, h; row_from_bf16(r, xc);
        if (l > 0) { const f32x2 st = *G_(stats + row); row_ln_r(r, st.x, st.y, vgp, vbp); }
        {
#pragma unroll
          for (int j = 0; j < 4; ++j) { const f32x4 gt = vgate.v[j];
              f32x4 y; y[0] = __uint_as_float(tc[j].x << 16); y[1] = __uint_as_float(tc[j].x & 0xffff0000u); y[2] = __uint_as_float(tc[j].y << 16); y[3] = __uint_as_float(tc[j].y & 0xffff0000u);
              r.v[j] = r.v[j] * DN_ALPHA + gt * y; } }
        row_store_bf16(r, zb + (size_t)row * 1024, lane);
        float mean, rstd; row_stats(r, mean, rstd); if (lane == 0) *G_(stats + row) = (f32x2){mean, rstd};
        row_ln_r(r, mean, rstd, vg, vb); row_mod_r(h, r, vsh, vsc1); row_store_bf16(h, H + (size_t)row * 1024, lane);
        float a[16];
#pragma unroll
        for (int e = 0; e < 16; ++e) a[e] = 0.f;
#pragma unroll
        for (int j = 0; j < 4; ++j)
#pragma unroll
            for (int q = 0; q < 4; ++q) { const float hv = h.v[j][q]; const LAS float* wp = rwl + (((j * 4 + q) * 4) * 64 + lane) * 4;
                const f32x4 w0 = *(const LAS f32x4*)wp, w1 = *(const LAS f32x4*)(wp + 256), w2 = *(const LAS f32x4*)(wp + 512), w3 = *(const LAS f32x4*)(wp + 768);
#pragma unroll
                for (int e = 0; e < 4; ++e) { a[e] += hv * w0[e]; a[4 + e] += hv * w1[e]; a[8 + e] += hv * w2[e]; a[12 + e] += hv * w3[e]; }
                __builtin_amdgcn_sched_barrier(0); }
        wave_sum16(a, lane);
        float sc[16], bi[16];
#pragma unroll
        for (int e = 0; e < 16; ++e) { sc[e] = sigmoidf_(a[e]); bi[e] = sc[e] + rb[e]; }
        float gs[4];
#pragma unroll
        for (int gI = 0; gI < 4; ++gI) { const float x0 = bi[4 * gI], x1 = bi[4 * gI + 1], x2 = bi[4 * gI + 2], x3 = bi[4 * gI + 3];
            const float h01 = fmaxf(x0, x1), l01 = fminf(x0, x1), h23 = fmaxf(x2, x3), l23 = fminf(x2, x3);
            gs[gI] = fmaxf(h01, h23) + fmaxf(fminf(h01, h23), fmaxf(l01, l23)); }
        int grp = 0; float best = gs[0];
#pragma unroll
        for (int gI = 1; gI < 4; ++gI) { const bool gt = gs[gI] > best; grp = gt ? gI : grp; best = gt ? gs[gI] : best; }
        float xb[4], xs[4];
#pragma unroll
        for (int q = 0; q < 4; ++q) { xb[q] = (grp == 0) ? bi[q] : (grp == 1) ? bi[4 + q] : (grp == 2) ? bi[8 + q] : bi[12 + q]; xs[q] = (grp == 0) ? sc[q] : (grp == 1) ? sc[4 + q] : (grp == 2) ? sc[8 + q] : sc[12 + q]; }
        int q0 = 0; float b0 = xb[0], s0 = xs[0];
#pragma unroll
        for (int q = 1; q < 4; ++q) { const bool gt = xb[q] > b0; q0 = gt ? q : q0; b0 = gt ? xb[q] : b0; s0 = gt ? xs[q] : s0; }
        int q1 = 0; float b1 = -INFINITY, s1 = 0.f;
#pragma unroll
        for (int q = 0; q < 4; ++q) { const bool ok = (q != q0) && (xb[q] > b1); q1 = ok ? q : q1; b1 = ok ? xb[q] : b1; s1 = ok ? xs[q] : s1; }
        const int e0 = 4 * grp + q0, e1 = 4 * grp + q1;
        const float inv = 1.0f / (s0 + s1);
        if (lane == 0) { const int li = wv * 32 + it_; const unsigned q0 = __hip_atomic_fetch_add(lcnt + e0, 1u, __ATOMIC_RELAXED, __HIP_MEMORY_SCOPE_WORKGROUP), q1 = __hip_atomic_fetch_add(lcnt + e1, 1u, __ATOMIC_RELAXED, __HIP_MEMORY_SCOPE_WORKGROUP);
                         lrec[li * 4 + 0] = (unsigned)e0 | (q0 << 8); lrec[li * 4 + 1] = (unsigned)e1 | (q1 << 8); lrec[li * 4 + 2] = __float_as_uint(s0 * inv); lrec[li * 4 + 3] = __float_as_uint(s1 * inv); }
        ++it_;
#pragma unroll
        for (int j = 0; j < 4; ++j) { xc[j] = xn[j]; tc[j] = tn[j]; }
    }
    __syncthreads();
    if (tid < 16) lbase[tid] = atomicAdd(cnt + tid, lcnt[tid]);
    __syncthreads();
    if (tid < 256) { const int grow = blk * 256 + tid;
        const unsigned r0 = lrec[tid * 4 + 0], r1 = lrec[tid * 4 + 1]; const unsigned e0 = r0 & 255u, e1 = r1 & 255u;
        const size_t p0 = (size_t)e0 * MTOK + lbase[e0] + (r0 >> 8), p1 = (size_t)e1 * MTOK + lbase[e1] + (r1 >> 8);
        list[p0] = grow * 2; cw[p0] = __uint_as_float(lrec[tid * 4 + 2]); list[p1] = grow * 2 + 1; cw[p1] = __uint_as_float(lrec[tid * 4 + 3]); }
}
__device__ __forceinline__ void prep_next(const Params& p, int l, bool final_, const int tid, const int blk) {
    const int lane = tid & 63, wv = tid >> 6;
    float* z = p.out; const bf16_t* zb = (const bf16_t*)(p.ws + WS_T); const float* modm = (const float*)(p.ws + WS_MOD) + (size_t)(l * 2 + 1) * 16 * 3072;
    const float* modn = (const float*)(p.ws + WS_MOD) + (size_t)((final_ ? l : l + 1) * 2) * 16 * 3072;
    f32x2* stats = (f32x2*)(p.ws + WS_STATS);
    const bf16_t* out2 = (const bf16_t*)(p.ws + WS_R + R_OUT2);
    const int row0 = (blk * 8 + wv) * 32, bt = row0 >> 12;
    RowV vg0, vb0, vg1, vb1, vgate, vsh, vsc1;
    vec_load(vg0, p.in[IN_LNG] + (size_t)(l * 2) * 1024, lane); vec_load(vb0, p.in[IN_LNB] + (size_t)(l * 2) * 1024, lane);
    vec_load(vg1, p.in[IN_LNG] + (size_t)(l * 2 + 1) * 1024, lane); vec_load(vb1, p.in[IN_LNB] + (size_t)(l * 2 + 1) * 1024, lane);
    vec_load(vgate, modm + (size_t)bt * 3072 + 2048, lane); vec_load(vsh, modn + (size_t)bt * 3072, lane); vec_load(vsc1, modn + (size_t)bt * 3072 + 1024, lane); vec_add1(vsc1);
    int row = row0;
    u32x2 zc[4], ta[4], tb[4]; row_load_t(zc, zb + (size_t)row * 1024, lane); row_load_t(ta, out2 + (size_t)(row * 2) * 1024, lane); row_load_t(tb, out2 + (size_t)(row * 2 + 1) * 1024, lane);
    for (; row < row0 + 32; ++row) {
        const int nrow = row + 1; u32x2 zn[4], na[4], nb[4];
        if (nrow < row0 + 32) { row_load_t(zn, zb + (size_t)nrow * 1024, lane); row_load_t(na, out2 + (size_t)(nrow * 2) * 1024, lane); row_load_t(nb, out2 + (size_t)(nrow * 2 + 1) * 1024, lane); }
        RowV r; row_from_bf16(r, zc);
        const f32x2 st = *G_(stats + row); row_ln_r(r, st.x, st.y, vg0, vb0);
#pragma unroll
        for (int j = 0; j < 4; ++j) { const u32x2 oa = ta[j], ob = tb[j];
            f32x4 y; y[0] = __uint_as_float(oa.x << 16) + __uint_as_float(ob.x << 16); y[1] = __uint_as_float(oa.x & 0xffff0000u) + __uint_as_float(ob.x & 0xffff0000u);
            y[2] = __uint_as_float(oa.y << 16) + __uint_as_float(ob.y << 16); y[3] = __uint_as_float(oa.y & 0xffff0000u) + __uint_as_float(ob.y & 0xffff0000u);
            r.v[j] = r.v[j] * DN_ALPHA + vgate.v[j] * y; }
#pragma unroll
        for (int j = 0; j < 4; ++j) { zc[j] = zn[j]; ta[j] = na[j]; tb[j] = nb[j]; }
        float mean, rstd; row_stats(r, mean, rstd);
        if (final_) { row_ln_r(r, mean, rstd, vg1, vb1);
#pragma unroll
            for (int j = 0; j < 4; ++j) __builtin_nontemporal_store(r.v[j], G_((f32x4*)(z + (size_t)row * 1024 + 4 * lane + 256 * j)));
        } else {
            row_store_bf16(r, (bf16_t*)p.out + (size_t)row * 1024, lane);
            if (lane == 0) *G_(stats + row) = (f32x2){mean, rstd};
            RowV h; row_ln_r(r, mean, rstd, vg1, vb1); row_mod_r(h, r, vsh, vsc1); row_store_fp8(h, p.ws + WS_H8 + (size_t)row * 1024, lane); }
    }
}

__device__ __forceinline__ int q_next(unsigned* ctr, volatile LAS int* slot, const int tid) {
    __syncthreads();
    if (tid == 0) *slot = (int)__hip_atomic_fetch_add(G_(ctr), 1u, __ATOMIC_RELAXED, __HIP_MEMORY_SCOPE_AGENT);
    __syncthreads();
    return *slot;
}

struct GdnRaw { u32x4 v[4]; float a, bg; };
__device__ __forceinline__ void gdn_prep_load(GdnRaw& g, int unit, const int tid) {
    unsigned char* ws = ws_late(); const int n = unit & 63, h = (unit >> 6) & 3, bl = unit >> 8; const int tok0 = bl * SEQ + n * 64;
    const bf16_t* proj = (const bf16_t*)(ws + WS_R + R_PROJ); const float* sm = (const float*)(ws + WS_R + R_SM);
#pragma unroll
    for (int j = 0; j < 4; ++j) { const int idx = tid + j * NTHR; const int row = idx / 24, ch = idx % 24, seg = ch >> 3, c8 = ch & 7;
        u32x4 v = {0u, 0u, 0u, 0u};
        if (idx < 67 * 24 && (n > 0 || row >= 3)) v = __builtin_nontemporal_load(G_((const u32x4*)(proj + (size_t)(tok0 + row - 3) * PROJW + seg * 256 + h * 64 + c8 * 8)));
        g.v[j] = v; }
    g.a = 0.f; g.bg = 0.f;
    if (tid < 64) { g.a = *G_(sm + (size_t)(tok0 + tid) * 32 + h); g.bg = *G_(sm + (size_t)(tok0 + tid) * 32 + 4 + h); }
}

__device__ __forceinline__ void gdn_prep_unit(const Params& p, int l, int unit, LAS unsigned char* lds, const int tid_in_, const GdnRaw& graw) {
    int tid = tid_in_; asm volatile("" : "+v"(tid)); unsigned char* wsl_ = ws_late();
    const int lane = tid & 63;
    const int n = unit & 63, h = (unit >> 6) & 3, bl = unit >> 8;
    const int tok0 = bl * SEQ + n * 64;
    const bf16_t* proj = (const bf16_t*)(wsl_ + WS_R + R_PROJ); const float* sm = (const float*)(wsl_ + WS_R + R_SM);
    LAS bf16_t* raw = (LAS bf16_t*)lds;
    LAS float* qs = (LAS float*)(lds + 26112); LAS float* ks = qs + 64 * 65; LAS float* vs = ks + 64 * 65;
    LAS float* Lm = vs + 64 * 65;
    LAS float* bc = Lm + 4096; LAS float* eb = bc + 64; LAS float* be = eb + 64; LAS float* cwt = be + 64;
    __syncthreads();
#pragma unroll
    for (int j = 0; j < 4; ++j) { const int idx = tid + j * NTHR; const int row = idx / 24, ch = idx % 24, seg = ch >> 3, c8 = ch & 7;
        if (idx < 67 * 24) *(LAS u32x4*)(raw + row * 192 + seg * 64 + c8 * 8) = graw.v[j]; }
    for (int idx = tid; idx < 768; idx += NTHR) { const int k = idx / 192, ch = idx % 192; cwt[idx] = PIN(IN_CONVW)[(size_t)l * 4 * 768 + k * 768 + (ch >> 6) * 256 + h * 64 + (ch & 63)]; }
    __syncthreads();
#ifdef GP_REP_CONV
    for (int rep_ = 0; rep_ < 2; ++rep_)
#endif
    if (tid < 384) {
        const int pr = tid % 96, tq = tid / 96, ch = 2 * pr, seg = ch >> 6, d = ch & 63;
        float w0[4], w1[4];
#pragma unroll
        for (int k = 0; k < 4; ++k) { const f32x2 w = *(const LAS f32x2*)(cwt + k * 192 + ch); w0[k] = w[0]; w1[k] = w[1]; }
        const LAS unsigned* rw = (const LAS unsigned*)raw + (16 * tq) * 96 + pr; unsigned x[19];
#pragma unroll
        for (int i = 0; i < 19; ++i) x[i] = rw[i * 96];
        LAS float* dst = (seg == 0 ? qs : seg == 1 ? ks : vs) + (16 * tq) * 65 + d;
#pragma unroll
        for (int t = 0; t < 16; ++t) { float s0 = 0.f, s1 = 0.f;
#pragma unroll
            for (int k = 0; k < 4; ++k) { const unsigned v = x[t + k]; s0 += w0[k] * __uint_as_float(v << 16); s1 += w1[k] * __uint_as_float(v & 0xffff0000u); }
            dst[t * 65] = siluf_(s0); dst[t * 65 + 1] = siluf_(s1); }
    }
    __syncthreads();
    LAS unsigned char* qb = lds + 129024; LAS unsigned char* kb = qb + 8192; LAS float* Rs = (LAS float*)(kb + 8192);
    {
        const int mat = tid >> 8, row = (tid >> 2) & 63, q4 = tid & 3; LAS float* mt = mat ? ks : qs; float x[16], ss = 0.f;
#pragma unroll
        for (int d = 0; d < 16; ++d) { x[d] = mt[row * 65 + 16 * q4 + d]; ss += x[d] * x[d]; }
        ss += swz_xor<1>(ss); ss += swz_xor<2>(ss);
        const float sc = (1.0f / sqrtf(ss + 1e-6f)) * (mat ? 1.0f : 0.125f);
#pragma unroll
        for (int d = 0; d < 16; ++d) { x[d] *= sc; mt[row * 65 + 16 * q4 + d] = x[d]; }
        LAS unsigned char* ob = (mat ? kb : qb) + (2 * q4) * 1024 + row * 16;
        u32x4 w0, w1; w0.x = pk2(x[0], x[1]); w0.y = pk2(x[2], x[3]); w0.z = pk2(x[4], x[5]); w0.w = pk2(x[6], x[7]); w1.x = pk2(x[8], x[9]); w1.y = pk2(x[10], x[11]); w1.z = pk2(x[12], x[13]); w1.w = pk2(x[14], x[15]);
        *(LAS u32x4*)ob = w0; *(LAS u32x4*)(ob + 1024) = w1;
    }
    if (tid < 64) { const int i = tid;
        const float a = graw.a, bg = graw.bg;
        const float x = a + PIN(IN_DTB)[l * 4 + h]; const float sp = fmaxf(x, 0.f) + log1pf(__expf(-fabsf(x)));
        float la = -__expf(PIN(IN_ALOG)[l * 4 + h]) * sp;
#pragma unroll
        for (int o = 1; o < 64; o <<= 1) { const float v = shfl_up_l(la, o, lane); if (lane >= o) la += v; }
        bc[i] = la; eb[i] = __expf(la); be[i] = sigmoidf_(bg); }
    __syncthreads();
    const size_t ub = WS_R + R_GDN + (size_t)unit * GDN_UNIT_BYTES;
    bf16_t* gW = (bf16_t*)(wsl_ + ub); bf16_t* gATT = gW + 4096; bf16_t* gQD = gW + 8192; bf16_t* gKDT = gW + 12288; bf16_t* gU0 = gW + 16384;
#ifdef GP_REP_KK
    for (int rep_ = 0; rep_ < 2; ++rep_)
#endif
    {
        const int wid = tid >> 6, r32 = lane & 31, hi = lane >> 5, isq = wid >> 2, it = (wid >> 1) & 1, jt = wid & 1;
        const LAS unsigned char* ab = (isq ? qb : kb) + hi * 1024 + (32 * it + r32) * 16; const LAS unsigned char* bb = kb + hi * 1024 + (32 * jt + r32) * 16;
        f32x16 acc = z16();
#pragma unroll
        for (int d0 = 0; d0 < 4; ++d0) acc = MF32(*(const LAS bf16x8*)(ab + d0 * 2048), *(const LAS bf16x8*)(bb + d0 * 2048), acc);
        const int j = 32 * jt + r32; const float bj = bc[j];
#pragma unroll
        for (int g = 0; g < 4; ++g) { f32x4 lv;
#pragma unroll
            for (int e = 0; e < 4; ++e) { const int i = 32 * it + 8 * g + 4 * hi + e; const float dc = __expf(bc[i] - bj), v = acc[4 * g + e] * dc;
                if (isq) *G_(gATT + i * 64 + j) = f2bf((j <= i) ? v : 0.f); else lv[e] = (j < i) ? be[i] * v : 0.f; }
            if (!isq) { *(LAS f32x4*)(Lm + j * 64 + 32 * it + 8 * g + 4 * hi) = lv;
#pragma unroll
                for (int e = 0; e < 4; ++e) (cwt + 768)[(32 * it + 8 * g + 4 * hi + e) * 64 + j] = lv[e]; } }
    }
    __syncthreads();
    {
        const float bl_ = bc[63];
        for (int task = tid; task < 1024; task += NTHR) {
            if (task < 512) { const int c2 = task >> 3, sg = task & 7; const float e = eb[c2]; float v[8];
#pragma unroll
                for (int j = 0; j < 8; ++j) v[j] = qs[c2 * 65 + sg * 8 + j] * e;
                u32x4 w; w.x = pk2(v[0], v[1]); w.y = pk2(v[2], v[3]); w.z = pk2(v[4], v[5]); w.w = pk2(v[6], v[7]); *G_((u32x4*)(gQD + c2 * 64 + sg * 8)) = w;
            } else { const int k = (task - 512) >> 3, sg = task & 7; float v[8];
#pragma unroll
                for (int j = 0; j < 8; ++j) { const int c2 = sg * 8 + j; v[j] = ks[c2 * 65 + k] * __expf(bl_ - bc[c2]); }
                u32x4 w; w.x = pk2(v[0], v[1]); w.y = pk2(v[2], v[3]); w.z = pk2(v[4], v[5]); w.w = pk2(v[6], v[7]); *G_((u32x4*)(gKDT + k * 64 + sg * 8)) = w; }
        }
        if (tid == 0) ((float*)(wsl_ + WS_R + R_GG))[unit] = __expf(bl_);
    }
    LAS float* Ln = cwt + 768; LAS float* TI = Ln + 4096; LAS float* SCR = TI + 1024;
    const int wv = tid >> 6, c = lane & 15, g = lane >> 4;
    if (wv < 4) {
        const LAS float* Mb = Lm + (16 * wv) * 64 + 16 * wv; LAS float* s0 = SCR + wv * 512; LAS float* s1 = s0 + 256;
        const f32x4 mA = *(const LAS f32x4*)(Mb + c * 64 + 4 * g); f32x4 mB;
#pragma unroll
        for (int s_ = 0; s_ < 4; ++s_) mB[s_] = Mb[(4 * g + s_) * 64 + c];
        f32x4 idn;
#pragma unroll
        for (int s_ = 0; s_ < 4; ++s_) idn[s_] = (4 * g + s_ == c) ? 1.0f : 0.0f;
        f32x4 m2 = {0.f, 0.f, 0.f, 0.f};
#pragma unroll
        for (int s_ = 0; s_ < 4; ++s_) m2 = MF4(mA[s_], mB[s_], m2);
#pragma unroll
        for (int r = 0; r < 4; ++r) s0[(4 * g + r) * 16 + c] = m2[r];
        asm volatile("s_waitcnt lgkmcnt(0)" ::: "memory");
        const f32x4 a2 = *(const LAS f32x4*)(s0 + c * 16 + 4 * g);
        f32x4 m4 = {0.f, 0.f, 0.f, 0.f};
#pragma unroll
        for (int s_ = 0; s_ < 4; ++s_) m4 = MF4(a2[s_], m2[s_], m4);
#pragma unroll
        for (int r = 0; r < 4; ++r) s1[(4 * g + r) * 16 + c] = m4[r];
        asm volatile("s_waitcnt lgkmcnt(0)" ::: "memory");
        const f32x4 a4 = *(const LAS f32x4*)(s1 + c * 16 + 4 * g);
        f32x4 P = {0.f, 0.f, 0.f, 0.f};
#pragma unroll
        for (int s_ = 0; s_ < 4; ++s_) P = MF4(a4[s_], m4[s_], P);
        P = P + idn;
        { f32x4 q = {0.f, 0.f, 0.f, 0.f};
#pragma unroll
          for (int s_ = 0; s_ < 4; ++s_) q = MF4(a4[s_] + idn[s_], P[s_], q);
          P = q; }
        { f32x4 q = {0.f, 0.f, 0.f, 0.f};
#pragma unroll
          for (int s_ = 0; s_ < 4; ++s_) q = MF4(a2[s_] + idn[s_], P[s_], q);
          P = q; }
        { f32x4 q = {0.f, 0.f, 0.f, 0.f};
#pragma unroll
          for (int s_ = 0; s_ < 4; ++s_) q = MF4(idn[s_] - mA[s_], P[s_], q);
          P = q; }
        *(LAS f32x4*)(TI + wv * 256 + c * 16 + 4 * g) = P;
    }
    __syncthreads();
    { const int col = 16 * wv + c, cc = col & 63; const bool isw = col >= 64;
      f32x4 X[4];
#pragma unroll
      for (int I = 0; I < 4; ++I) { f32x4 acc;
#pragma unroll
          for (int r = 0; r < 4; ++r) { const int i = 16 * I + 4 * g + r; acc[r] = isw ? be[i] * eb[i] * ks[i * 65 + cc] : be[i] * vs[i * 65 + cc]; }
#pragma unroll
          for (int J = 0; J < I; ++J) { const f32x4 aL = *(const LAS f32x4*)(Ln + (16 * I + c) * 64 + 16 * J + 4 * g);
#pragma unroll
              for (int s_ = 0; s_ < 4; ++s_) acc = MF4(-aL[s_], X[J][s_], acc); }
          const f32x4 tI = *(const LAS f32x4*)(TI + I * 256 + c * 16 + 4 * g); f32x4 xn = {0.f, 0.f, 0.f, 0.f};
#pragma unroll
          for (int s_ = 0; s_ < 4; ++s_) xn = MF4(tI[s_], acc[s_], xn);
          X[I] = xn; bf16_t* dst = (isw ? gW : gU0) + (16 * I + 4 * g) * 64 + cc;
#pragma unroll
          for (int r = 0; r < 4; ++r) *G_(dst + r * 64) = f2bf(xn[r]); } }
    __syncthreads();
}

__device__ __forceinline__ bf16x8 afrag_perm(const LAS unsigned char* M, int row, int ks, int hi) {
    const LAS unsigned char* q = M + row * 144 + (16 * ks + 4 * hi) * 2;
    const s16x4 lo = *(const LAS s16x4*)q, hi4 = *(const LAS s16x4*)(q + 16);
    return (bf16x8){lo[0], lo[1], lo[2], lo[3], hi4[0], hi4[1], hi4[2], hi4[3]};
}
__device__ __forceinline__ bf16x8 pack_acc8(const f32x16& a, int s) {
    u32x4 w; w.x = pk2(a[8 * s + 0], a[8 * s + 1]); w.y = pk2(a[8 * s + 2], a[8 * s + 3]); w.z = pk2(a[8 * s + 4], a[8 * s + 5]); w.w = pk2(a[8 * s + 6], a[8 * s + 7]);
    return __builtin_bit_cast(bf16x8, w);
}
__device__ __forceinline__ void gdn_scan_item(const Params& p, int l, int chunk, int item, LAS unsigned char* lds, const int tid) {
    const int lane = tid & 63, wid = tid >> 6, vl = lane & 31, hi = lane >> 5;
    const int h = item & 3, bl = item >> 2;
    const unsigned char* ubase = p.ws + WS_R + R_GDN + (size_t)item * 64 * GDN_UNIT_BYTES;
    const float* gg = (const float*)(p.ws + WS_R + R_GG) + item * 64;
    const bf16_t* proj = (const bf16_t*)(p.ws + WS_R + R_PROJ); bf16_t* og = (bf16_t*)(p.ws + WS_R + R_O);
    const float* nw = PIN(IN_GNORM) + l * 64;
    constexpr int BUF = 5 * 9216;
    LAS unsigned char* buf0 = lds; LAS float* ob0 = (LAS float*)(lds + 2 * BUF);
    __syncthreads();
    for (int q = tid; q < 2560; q += NTHR) { const int mat = q >> 9, r = (q >> 3) & 63, sg = q & 7;
        *(LAS u32x4*)(buf0 + mat * 9216 + r * 144 + sg * 16) = *(const u32x4*)(ubase + mat * 8192 + r * 128 + sg * 16); }
    __syncthreads();
    f32x16 S[2]; S[0] = z16(); S[1] = z16();
    float nw8[8];
#pragma unroll
    for (int e = 0; e < 8; ++e) nw8[e] = nw[(tid & 7) * 8 + e];
    for (int n = 0; n < 64; ++n) {
        LAS unsigned char* bf = buf0 + (n & 1) * BUF; LAS float* ob = ob0 + (n & 1) * 4096;
        if (wid < 2) {
            const LAS unsigned char* Wm = bf; const LAS unsigned char* ATT = bf + 9216; const LAS unsigned char* QD = bf + 18432; const LAS unsigned char* KDT = bf + 27648; const LAS bf16_t* U0 = (const LAS bf16_t*)(bf + 36864);
            const float G = gg[n];
            bf16x8 Sb[4]; Sb[0] = pack_acc8(S[0], 0); Sb[1] = pack_acc8(S[0], 1); Sb[2] = pack_acc8(S[1], 0); Sb[3] = pack_acc8(S[1], 1);
            f32x16 u[2];
#pragma unroll
            for (int ct = 0; ct < 2; ++ct) { f32x16 a = z16();
#pragma unroll
                for (int ks = 0; ks < 4; ++ks) a = __builtin_amdgcn_mfma_f32_32x32x16_bf16(afrag_perm(Wm, 32 * ct + vl, ks, hi), Sb[ks], a, 0, 0, 0);
#pragma unroll
                for (int r = 0; r < 16; ++r) u[ct][r] = bf2f(U0[(32 * ct + crow(r, hi)) * 72 + 32 * wid + vl]) - a[r]; }
            bf16x8 ub[4]; ub[0] = pack_acc8(u[0], 0); ub[1] = pack_acc8(u[0], 1); ub[2] = pack_acc8(u[1], 0); ub[3] = pack_acc8(u[1], 1);
#pragma unroll
            for (int ct = 0; ct < 2; ++ct) { f32x16 a = z16();
#pragma unroll
                for (int ks = 0; ks < 4; ++ks) a = __builtin_amdgcn_mfma_f32_32x32x16_bf16(afrag_perm(QD, 32 * ct + vl, ks, hi), Sb[ks], a, 0, 0, 0);
#pragma unroll
                for (int cs = 0; cs < 4; ++cs) a = __builtin_amdgcn_mfma_f32_32x32x16_bf16(afrag_perm(ATT, 32 * ct + vl, cs, hi), ub[cs], a, 0, 0, 0);
#pragma unroll
                for (int r = 0; r < 16; ++r) ob[(32 * ct + crow(r, hi)) * 64 + 32 * wid + vl] = a[r]; }
#pragma unroll
            for (int kt = 0; kt < 2; ++kt) { f32x16 a = S[kt] * G;
#pragma unroll
                for (int cs = 0; cs < 4; ++cs) a = __builtin_amdgcn_mfma_f32_32x32x16_bf16(afrag_perm(KDT, 32 * kt + vl, cs, hi), ub[cs], a, 0, 0, 0);
                S[kt] = a; }
        } else {
            const int t0 = tid - 128, sg = t0 & 7; const bool st = (n + 1 < 64), fin = (n >= 1);
            const int tokb = bl * SEQ + (n - 1) * 64;
            u32x4 zw[2];
            if (fin) {
#pragma unroll
                for (int j = 0; j < 2; ++j) { const int task = t0 + 384 * j; if (task < 512) zw[j] = *(const GAS u32x4*)(proj + (size_t)(tokb + (task >> 3)) * PROJW + PC_GZ + h * 64 + sg * 8); } }
            const GAS unsigned char* src = (const GAS unsigned char*)(ubase + (size_t)(n + 1) * GDN_UNIT_BYTES);
            u32x4 sv[7];
            if (st) {
#pragma unroll
                for (int j = 0; j < 7; ++j) { const int q = t0 + 384 * j; if (q < 2560) sv[j] = __builtin_nontemporal_load((const GAS u32x4*)(src + q * 16)); } }
            asm volatile("" ::: "memory"); __builtin_amdgcn_sched_barrier(0);
            if (fin) { const LAS float* po = ob0 + ((n - 1) & 1) * 4096;
#pragma unroll
                for (int j = 0; j < 2; ++j) { const int task = t0 + 384 * j;
                    if (task < 512) { const int c = task >> 3; float v[8], ss = 0.f;
#pragma unroll
                        for (int e = 0; e < 8; ++e) { v[e] = po[c * 64 + sg * 8 + e]; ss += v[e] * v[e]; }
                        ss += swz_xor<1>(ss); ss += swz_xor<2>(ss); ss += swz_xor<4>(ss);
                        const float rs = 1.0f / sqrtf(ss * (1.0f / 64.0f) + 1e-6f);
                        const unsigned zz[4] = {zw[j].x, zw[j].y, zw[j].z, zw[j].w};
#pragma unroll
                        for (int e = 0; e < 8; ++e) { const float zf = (e & 1) ? __uint_as_float(zz[e >> 1] & 0xffff0000u) : __uint_as_float(zz[e >> 1] << 16); v[e] = v[e] * rs * nw8[e] * siluf_(zf); }
                        u32x4 w; w.x = pk2(v[0], v[1]); w.y = pk2(v[2], v[3]); w.z = pk2(v[4], v[5]); w.w = pk2(v[6], v[7]);
                        *(u32x4*)(og + (size_t)(tokb + c) * 256 + h * 64 + sg * 8) = w; } } }
            if (st) { LAS unsigned char* nb = buf0 + ((n + 1) & 1) * BUF;
#pragma unroll
                for (int j = 0; j < 7; ++j) { const int q = t0 + 384 * j; const int mat = q >> 9, r = (q >> 3) & 63, sg2 = q & 7;
                    if (q < 2560) *(LAS u32x4*)(nb + mat * 9216 + r * 144 + sg2 * 16) = sv[j]; } }
        }
        __syncthreads();
    }
    { const LAS float* po = ob0 + 4096; const int tokb = bl * SEQ + 63 * 64;
        for (int task = tid; task < 512; task += NTHR) { const int c = task >> 3, sg = task & 7; float v[8], ss = 0.f;
#pragma unroll
            for (int j = 0; j < 8; ++j) { v[j] = po[c * 64 + sg * 8 + j]; ss += v[j] * v[j]; }
            ss += swz_xor<1>(ss); ss += swz_xor<2>(ss); ss += swz_xor<4>(ss);
            const float rs = 1.0f / sqrtf(ss * (1.0f / 64.0f) + 1e-6f);
            const u32x4 zw = *(const u32x4*)(proj + (size_t)(tokb + c) * PROJW + PC_GZ + h * 64 + sg * 8); const unsigned zz[4] = {zw.x, zw.y, zw.z, zw.w};
#pragma unroll
            for (int j = 0; j < 8; ++j) { const float zf = (j & 1) ? __uint_as_float(zz[j >> 1] & 0xffff0000u) : __uint_as_float(zz[j >> 1] << 16); v[j] = v[j] * rs * nw[sg * 8 + j] * siluf_(zf); }
            u32x4 w; w.x = pk2(v[0], v[1]); w.y = pk2(v[2], v[3]); w.z = pk2(v[4], v[5]); w.w = pk2(v[6], v[7]);
            *(u32x4*)(og + (size_t)(tokb + c) * 256 + h * 64 + sg * 8) = w; } }
    __syncthreads();
}

__device__ __forceinline__ void fox_cum_item(const Params& p, int l, int item, LAS float* lf, const int tid) {
    const int lane = tid & 63, wid = tid >> 6, h = item & 3, bl = item >> 2;
    const float* sm = (const float*)(p.ws + WS_R + R_SM); float* nb = (float*)(p.ws + WS_R + R_CUM) + (size_t)item * SEQ;
    const float fb = PIN(IN_FBIAS)[l * 4 + h];
    float v[8], run = 0.f;
#pragma unroll
    for (int j = 0; j < 8; ++j) { const float x = sm[(size_t)(bl * SEQ + tid * 8 + j) * 32 + 20 + h] + fb; run += fminf(x, 0.f) - log1pf(__expf(-fabsf(x))); v[j] = run; }
    float inc = run;
#pragma unroll
    for (int o = 1; o < 64; o <<= 1) { const float t = shfl_up_l(inc, o, lane); if (lane >= o) inc += t; }
    __syncthreads();
    if (lane == 63) lf[wid] = inc;
    __syncthreads();
    float base = inc - run;
    for (int w = 0; w < wid; ++w) base += lf[w];
#pragma unroll
    for (int j = 0; j < 8; ++j) nb[tid * 8 + j] = -(base + v[j]) * LOG2E;
    __syncthreads();
}
__device__ __forceinline__ void ret_rope_pass(const Params& p, int chunk, const int tid, const int blk) {
    bf16_t* proj = (bf16_t*)(p.ws + WS_R + R_PROJ); const f32x2* tab = (const f32x2*)(p.ws + WS_ROPE);
    for (int task = blk * NTHR + tid; task < MC * 32; task += NWG * NTHR) {
        const int row = task >> 5, which = (task >> 4) & 1, h = (task >> 2) & 3, i8 = task & 3;
        bf16_t* q1 = proj + (size_t)row * PROJW + (which ? PC_RK : PC_RQ) + h * 64 + i8 * 8; bf16_t* q2 = q1 + 32;
        const u32x4 a = *(const u32x4*)q1, b = *(const u32x4*)q2; const unsigned aa[4] = {a.x, a.y, a.z, a.w}, bb[4] = {b.x, b.y, b.z, b.w};
        const f32x2* tp = tab + (size_t)(chunk * MC + row) * 32 + i8 * 8; float o1[8], o2[8];
#pragma unroll
        for (int j = 0; j < 8; ++j) { const float x1 = (j & 1) ? __uint_as_float(aa[j >> 1] & 0xffff0000u) : __uint_as_float(aa[j >> 1] << 16);
            const float x2 = (j & 1) ? __uint_as_float(bb[j >> 1] & 0xffff0000u) : __uint_as_float(bb[j >> 1] << 16);
            const f32x2 cs = tp[j]; o1[j] = x1 * cs.x - x2 * cs.y; o2[j] = x1 * cs.y + x2 * cs.x; }
        u32x4 w1, w2; w1.x = pk2(o1[0], o1[1]); w1.y = pk2(o1[2], o1[3]); w1.z = pk2(o1[4], o1[5]); w1.w = pk2(o1[6], o1[7]);
        w2.x = pk2(o2[0], o2[1]); w2.y = pk2(o2[2], o2[3]); w2.z = pk2(o2[4], o2[5]); w2.w = pk2(o2[6], o2[7]);
        *(u32x4*)q1 = w1; *(u32x4*)q2 = w2; }
}

constexpr int AL_K0 = 0, AL_V0 = 16384, AL_B0 = 32768;
__device__ __forceinline__ s16x4 vtr(const LAS unsigned char* q) {
    typedef short v4i16_t __attribute__((ext_vector_type(4)));
    return __builtin_bit_cast(s16x4, __builtin_amdgcn_ds_read_tr16_b64_v4i16((LAS v4i16_t*)q));
}
template <bool PRESET = false>
__device__ __forceinline__ void attn_qkt(f32x16& p0, f32x16& p1, const LAS unsigned char* kslot, const bf16x8 (&qf)[4], int r32, int hi) {
#pragma unroll
    for (int d0 = 0; d0 < 4; ++d0) { const LAS unsigned char* kb = kslot + (2 * d0 + hi) * 1024 + r32 * 16;
        const bf16x8 b0 = *(const LAS bf16x8*)kb, b1 = *(const LAS bf16x8*)(kb + 512);
        if (d0 == 0 && !PRESET) { const f32x16 zz = {0.f, 0.f, 0.f, 0.f, 0.f, 0.f, 0.f, 0.f, 0.f, 0.f, 0.f, 0.f, 0.f, 0.f, 0.f, 0.f}; p0 = MF32(b0, qf[0], zz); p1 = MF32(b1, qf[0], zz); }
        else { p0 = MF32(b0, qf[d0], p0); p1 = MF32(b1, qf[d0], p1); } }
}
__device__ __forceinline__ void attn_pv(f32x16 (&o)[2], const LAS unsigned char* vslot, const bf16x8 (&pw)[4], int lane, int hi) {
    const LAS unsigned char* vb = vslot + ((lane >> 4) & 1) * 32 + (lane & 3) * 8 + (4 * hi + ((lane & 15) >> 2)) * 64;
#pragma unroll
    for (int d0 = 0; d0 < 2; ++d0)
#pragma unroll
        for (int ks = 0; ks < 4; ++ks) { const s16x4 lo = vtr(vb + d0 * 4096 + ks * 1024), h4 = vtr(vb + d0 * 4096 + ks * 1024 + 512);
            const bf16x8 vf = (bf16x8){lo[0], lo[1], lo[2], lo[3], h4[0], h4[1], h4[2], h4[3]};
            o[d0] = MF32(vf, pw[ks], o[d0]); }
}
__device__ __forceinline__ void attn_softmax_step(f32x16& p0, f32x16& p1, f32x16 (&o)[2], float& m, float& l) {
    float mt = p0[0];
#pragma unroll
    for (int r = 1; r < 16; ++r) mt = fmaxf(mt, p0[r]);
#pragma unroll
    for (int r = 0; r < 16; ++r) mt = fmaxf(mt, p1[r]);
    mt = x32_max(mt);
    const float mn = fmaxf(m, mt), ms = (mn == -INFINITY) ? 0.f : mn, alpha = ex2(m - ms);
    float s = 0.f;
#pragma unroll
    for (int r = 0; r < 16; ++r) { p0[r] = ex2(p0[r] - ms); p1[r] = ex2(p1[r] - ms); s += p0[r] + p1[r]; }
    l = l * alpha + s; m = mn;
    if (__builtin_amdgcn_ballot_w64(alpha != 1.0f) != 0ull) { o[0] *= alpha; o[1] *= alpha; }
}
template <class F>
__device__ __forceinline__ void flash_qkt(int cur, const bf16x8 (&qf)[4], f32x16& p0, f32x16& p1, LAS unsigned char* lds, int r32, int hi) {
    if (F::HAS_BIAS) { const LAS float* bp = (const LAS float*)(lds + AL_B0 + cur * 256);
#pragma unroll
        for (int g = 0; g < 4; ++g) { const f32x4 b0 = *(const LAS f32x4*)(bp + 8 * g + 4 * hi), b1 = *(const LAS f32x4*)(bp + 32 + 8 * g + 4 * hi);
#pragma unroll
            for (int e = 0; e < 4; ++e) { p0[4 * g + e] = b0[e]; p1[4 * g + e] = b1[e]; } }
        attn_qkt<true>(p0, p1, lds + AL_K0 + cur * 8192, qf, r32, hi);
    } else attn_qkt(p0, p1, lds + AL_K0 + cur * 8192, qf, r32, hi);
}
template <class F>
__device__ __forceinline__ void flash_smpv(const F& f, int t, int cur, f32x16& p0, f32x16& p1, f32x16 (&o)[2], float& m, float& l, LAS unsigned char* lds, int lane, int hi) {
    f.apply(p0, p1, t);
    if (F::MODE == 0) attn_softmax_step(p0, p1, o, m, l);
    bf16x8 pw[4]; pw[0] = pack_acc8(p0, 0); pw[1] = pack_acc8(p0, 1); pw[2] = pack_acc8(p1, 0); pw[3] = pack_acc8(p1, 1);
    attn_pv(o, lds + AL_V0 + cur * 8192, pw, lane, hi);
}
template <class F>
__device__ __forceinline__ void flash_loop(const F& f, int tlo, int thi, const bf16_t* Kg, const bf16_t* Vg, int pitch, const float* biasg,
                                           const bf16x8 (&qf)[4], f32x16 (&o)[2], float& m, float& l, LAS unsigned char* lds, const int tid) {
    const int lane = tid & 63, wid = tid >> 6, r32 = lane & 31, hi = lane >> 5;
    const bool late = (__builtin_amdgcn_s_getreg((0 << 11) | (0 << 6) | 4) & 1) != 0;
    int t = thi - 1; while (t >= tlo && f.skip(t)) --t;
    __syncthreads();
    if (t < tlo) return;
    const bf16_t* ksrc = Kg + (size_t)lane * pitch + wid * 8;
    const bf16_t* vsrc = Vg + (size_t)(16 * (wid & 3) + (lane >> 2)) * pitch + (wid >> 2) * 32 + (lane & 3) * 8;
    const int sdst = wid * 1024 + lane * 16;
    u32x4 kr = *G_((const u32x4*)(ksrc + (size_t)t * 64 * pitch)), vr = *G_((const u32x4*)(vsrc + (size_t)t * 64 * pitch)); float br = 0.f;
    const int btid = tid & 63;
    if (F::HAS_BIAS) br = *G_(biasg + t * 64 + btid);
    *(LAS u32x4*)(lds + AL_K0 + sdst) = kr; *(LAS u32x4*)(lds + AL_V0 + sdst) = vr; if (F::HAS_BIAS) ((LAS float*)(lds + AL_B0))[btid] = br;
    __syncthreads();
    int cur = 0;
#define FLASH_NEXT_() int tn_ = t - 1; while (tn_ >= tlo && f.skip(tn_)) --tn_; \
        if (tn_ >= tlo) { kr = *G_((const u32x4*)(ksrc + (size_t)tn_ * 64 * pitch)); vr = *G_((const u32x4*)(vsrc + (size_t)tn_ * 64 * pitch)); if (F::HAS_BIAS) br = *G_(biasg + tn_ * 64 + btid); }
#define FLASH_STAGE_() cur ^= 1; \
        *(LAS u32x4*)(lds + AL_K0 + cur * 8192 + sdst) = kr; *(LAS u32x4*)(lds + AL_V0 + cur * 8192 + sdst) = vr; if (F::HAS_BIAS) ((LAS float*)(lds + AL_B0 + cur * 256))[btid] = br; \
        __syncthreads();
    if (!late) {
        for (;;) { FLASH_NEXT_() const int tn = tn_;
            f32x16 p0, p1; flash_qkt<F>(cur, qf, p0, p1, lds, r32, hi);
            __syncthreads();
            flash_smpv(f, t, cur, p0, p1, o, m, l, lds, lane, hi);
            if (tn < tlo) break;
            FLASH_STAGE_()
            t = tn; }
    } else {
        f32x16 p0, p1; int tn;
        { FLASH_NEXT_() tn = tn_; }
        __syncthreads();
        flash_qkt<F>(cur, qf, p0, p1, lds, r32, hi);
        while (tn >= tlo) {
            FLASH_STAGE_()
            const int tp = t; t = tn;
            { FLASH_NEXT_() tn = tn_; }
            flash_smpv(f, tp, cur ^ 1, p0, p1, o, m, l, lds, lane, hi);
            __syncthreads();
            flash_qkt<F>(cur, qf, p0, p1, lds, r32, hi); }
        flash_smpv(f, t, cur, p0, p1, o, m, l, lds, lane, hi);
    }
#undef FLASH_NEXT_
#undef FLASH_STAGE_
    __syncthreads();
}
__device__ __forceinline__ void load_qf(bf16x8 (&qf)[4], const bf16_t* qrow, int hi) {
#pragma unroll
    for (int d0 = 0; d0 < 4; ++d0) qf[d0] = *G_((const bf16x8*)(qrow + d0 * 16 + hi * 8));
}
__device__ __forceinline__ void store_ot(const f32x16 (&o)[2], bf16_t* orow, int hi) {
#pragma unroll
    for (int d0 = 0; d0 < 2; ++d0)
#pragma unroll
        for (int g = 0; g < 4; ++g) { u32x2 w; w.x = pk2(o[d0][4 * g], o[d0][4 * g + 1]); w.y = pk2(o[d0][4 * g + 2], o[d0][4 * g + 3]); *G_((u32x2*)(orow + 32 * d0 + 8 * g + 4 * hi)) = w; }
}

struct FoxF { static constexpr int MODE = 0; static constexpr bool HAS_BIAS = true; int tq, qmin, hi;
    __device__ __forceinline__ bool skip(int) const { return false; }
    __device__ __forceinline__ bool wskip(int) const { return false; }
    __device__ __forceinline__ void apply(f32x16& p0, f32x16& p1, int t) const { const float NI = ninf_();
        if (64 * t + 63 > qmin) {
#pragma unroll
            for (int r = 0; r < 16; ++r) { const int key = 64 * t + crow(r, hi); if (key > tq) p0[r] = NI; if (key + 32 > tq) p1[r] = NI; } } } };
struct RetF { static constexpr int MODE = 1; static constexpr bool HAS_BIAS = false; int tq, hi; float lg;
    __device__ __forceinline__ bool skip(int) const { return false; }
    __device__ __forceinline__ bool wskip(int) const { return false; }
    __device__ __forceinline__ void apply(f32x16& p0, f32x16& p1, int t) const { const float NI = ninf_();
#pragma unroll
        for (int r = 0; r < 16; ++r) { const int key = 64 * t + crow(r, hi);
            p0[r] = (key <= tq) ? p0[r] * ex2((float)(tq - key) * lg) : 0.f; p1[r] = (key + 32 <= tq) ? p1[r] * ex2((float)(tq - key - 32) * lg) : 0.f; } } };
struct SelF { static constexpr int MODE = 0; static constexpr bool HAS_BIAS = false; unsigned long long umask, wmask, mymask; int tq, klo, hi;
    __device__ __forceinline__ bool skip(int t) const { return ((umask >> t) & 1ull) == 0ull; }
    __device__ __forceinline__ bool wskip(int t) const { return ((wmask >> t) & 1ull) == 0ull; }
    int tdiag, tlo;
    __device__ __forceinline__ void apply(f32x16& p0, f32x16& p1, int t) const { const float NI = ninf_(); const bool on = ((mymask >> t) & 1ull) != 0ull;
        if (t >= tdiag || t <= tlo) {
#pragma unroll
            for (int r = 0; r < 16; ++r) { const int key = 64 * t + crow(r, hi); if (!on || key > tq || key <= klo) p0[r] = NI; if (!on || key + 32 > tq || key + 32 <= klo) p1[r] = NI; }
        } else if (__builtin_amdgcn_ballot_w64(!on) != 0ull) {
#pragma unroll
            for (int r = 0; r < 16; ++r) { if (!on) { p0[r] = NI; p1[r] = NI; } }
        } } };
__device__ __forceinline__ void fox_unit(const Params& p, int idx, LAS unsigned char* lds, const int tid_in_) {
    int tid = tid_in_; asm volatile("" : "+v"(tid)); unsigned char* wsl_ = ws_late();
    const int lane = tid & 63, wid = tid >> 6, r32 = lane & 31, hi = lane >> 5;
    const int qb = 15 - idx / (BC * 4), bh = idx % (BC * 4), h = bh & 3, bl = bh >> 2;
    const bf16_t* proj = (const bf16_t*)(wsl_ + WS_R + R_PROJ);
    const int tq = qb * 256 + wid * 32 + r32; const size_t rowc = (size_t)bl * SEQ + tq;
    bf16x8 qf[4]; load_qf(qf, proj + rowc * PROJW + PC_FQ + h * 64, hi);
    f32x16 o[2]; o[0] = z16(); o[1] = z16(); float m = -INFINITY, l = 0.f;
    FoxF f; f.tq = tq; f.qmin = qb * 256; f.hi = hi;
    flash_loop(f, 0, 4 * qb + 4, proj + (size_t)bl * SEQ * PROJW + PC_FK + h * 64, proj + (size_t)bl * SEQ * PROJW + PC_FV + h * 64, PROJW,
               (const float*)(wsl_ + WS_R + R_CUM) + (size_t)bh * SEQ, qf, o, m, l, lds, tid);
    l = x32_sum(l); const float inv = 1.0f / l; o[0] *= inv; o[1] *= inv;
    store_ot(o, (bf16_t*)(wsl_ + WS_R + R_O) + (size_t)3 * MC * 256 + rowc * 256 + h * 64, hi);
}
__device__ __forceinline__ void rope8(float (&o1)[8], float (&o2)[8], const u32x4& a, const u32x4& b, const f32x2* tp) {
    const unsigned aa[4] = {a.x, a.y, a.z, a.w}, bb[4] = {b.x, b.y, b.z, b.w};
#pragma unroll
    for (int j = 0; j < 8; ++j) { const float x1 = (j & 1) ? __uint_as_float(aa[j >> 1] & 0xffff0000u) : __uint_as_float(aa[j >> 1] << 16);
        const float x2 = (j & 1) ? __uint_as_float(bb[j >> 1] & 0xffff0000u) : __uint_as_float(bb[j >> 1] << 16);
        const f32x2 cs = tp[j]; o1[j] = x1 * cs.x - x2 * cs.y; o2[j] = x1 * cs.y + x2 * cs.x; }
}
__device__ __forceinline__ u32x4 pack8f(const float (&v)[8]) { u32x4 w; w.x = pk2(v[0], v[1]); w.y = pk2(v[2], v[3]); w.z = pk2(v[4], v[5]); w.w = pk2(v[6], v[7]); return w; }
__device__ __forceinline__ void ret_kv_unit(const Params& p, int ch, int idx, LAS unsigned char* lds, const int tid_in_) {
    int tid = tid_in_; asm volatile("" : "+v"(tid)); unsigned char* wsl_ = ws_late();
    const int lane = tid & 63, wid = tid >> 6, hi = lane >> 5;
    const int n = idx & 31, bh = idx >> 5, h = bh & 3, bl = bh >> 2;
    const bf16_t* proj = (const bf16_t*)(wsl_ + WS_R + R_PROJ); const f32x2* tab = (const f32x2*)(wsl_ + WS_ROPE);
    const size_t rowc0 = (size_t)bl * SEQ + n * 128; const float lg = log2f(1.0f - exp2f(-5.0f - (float)h));
    LAS unsigned char* KZ = lds; LAS unsigned char* VT = lds + 16384;
    __syncthreads();
    { const int key = tid >> 2, cp = tid & 3; const bf16_t* src = proj + (rowc0 + key) * PROJW + PC_RK + h * 64 + cp * 8;
      const u32x4 a = *(const u32x4*)src, b = *(const u32x4*)(src + 32); float o1[8], o2[8];
      rope8(o1, o2, a, b, tab + ((size_t)ch * MC + rowc0 + key) * 32 + cp * 8);
      const float zt = ex2((float)(127 - key) * lg);
#pragma unroll
      for (int j = 0; j < 8; ++j) { o1[j] *= zt; o2[j] *= zt; }
      LAS unsigned char* d = KZ + (key >> 6) * 8192 + ((key & 63) >> 4) * 1024 + (key & 15) * 64 + cp * 16;
      *(LAS u32x4*)d = pack8f(o1); *(LAS u32x4*)(d + 4096) = pack8f(o2); }
#pragma unroll
    for (int t2 = 0; t2 < 2; ++t2)
        *(LAS u32x4*)(VT + t2 * 8192 + wid * 1024 + lane * 16) = *(const u32x4*)(proj + (rowc0 + 64 * t2 + 16 * (wid & 3) + (lane >> 2)) * PROJW + PC_RV + h * 64 + (wid >> 2) * 32 + (lane & 3) * 8);
    __syncthreads();
    if (wid < 4) { const int vt = wid >> 1, kt = wid & 1;
        const int fo = ((lane >> 4) & 1) * 32 + (lane & 3) * 8 + (4 * hi + ((lane & 15) >> 2)) * 64;
        f32x16 acc = z16();
#pragma unroll
        for (int t2 = 0; t2 < 2; ++t2)
#pragma unroll
            for (int ks = 0; ks < 4; ++ks) { const LAS unsigned char* va = VT + t2 * 8192 + vt * 4096 + ks * 1024 + fo; const LAS unsigned char* ka = KZ + t2 * 8192 + kt * 4096 + ks * 1024 + fo;
                const s16x4 v0 = vtr(va), v1 = vtr(va + 512), k0 = vtr(ka), k1 = vtr(ka + 512);
                acc = MF32(((bf16x8){v0[0], v0[1], v0[2], v0[3], v1[0], v1[1], v1[2], v1[3]}), ((bf16x8){k0[0], k0[1], k0[2], k0[3], k1[0], k1[1], k1[2], k1[3]}), acc); }
        float* kvt = (float*)(wsl_ + WS_R + R_KVT) + (size_t)idx * 4096;
#pragma unroll
        for (int r = 0; r < 16; ++r) kvt[(32 * vt + crow(r, hi)) * 64 + 32 * kt + (lane & 31)] = acc[r]; }
    __syncthreads();
}
__device__ __forceinline__ void ret_out_unit(const Params& p, int l_, int ch, int idx, LAS unsigned char* lds, const int tid_in_) {
    int tid = tid_in_; asm volatile("" : "+v"(tid)); unsigned char* wsl_ = ws_late();
    const int lane = tid & 63, wid = tid >> 6, r32 = lane & 31, hi = lane >> 5, gw = wid >> 2, wq = wid & 3;
    const int np = 15 - idx / (BC * 4), bh = idx % (BC * 4), h = bh & 3, bl = bh >> 2, n = 2 * np + gw;
    const bf16_t* proj = (const bf16_t*)(wsl_ + WS_R + R_PROJ); const f32x2* tab = (const f32x2*)(wsl_ + WS_ROPE);
    const float lg = log2f(1.0f - exp2f(-5.0f - (float)h));
    LAS unsigned char* KS = lds; LAS unsigned char* VS = lds + 32768; LAS unsigned char* RT = lds + 65536;
    const int tql = 32 * wq + r32; const size_t rowc = (size_t)bl * SEQ + n * 128 + tql;
    bf16x8 qf[4];
    { const bf16_t* qrow = proj + rowc * PROJW + PC_RQ + h * 64; const f32x2* tp = tab + ((size_t)ch * MC + rowc) * 32;
#pragma unroll
      for (int d0 = 0; d0 < 2; ++d0) { const u32x4 a = *(const u32x4*)(qrow + d0 * 16 + hi * 8), b = *(const u32x4*)(qrow + 32 + d0 * 16 + hi * 8); float o1[8], o2[8];
          rope8(o1, o2, a, b, tp + d0 * 16 + hi * 8); qf[d0] = __builtin_bit_cast(bf16x8, pack8f(o1)); qf[d0 + 2] = __builtin_bit_cast(bf16x8, pack8f(o2)); } }
    __syncthreads();
#pragma unroll
    for (int g = 0; g < 2; ++g) { const size_t r0 = (size_t)bl * SEQ + (2 * np + g) * 128;
        { const int key = tid >> 2, cp = tid & 3; const bf16_t* src = proj + (r0 + key) * PROJW + PC_RK + h * 64 + cp * 8;
          const u32x4 a = *(const u32x4*)src, b = *(const u32x4*)(src + 32); float o1[8], o2[8];
          rope8(o1, o2, a, b, tab + ((size_t)ch * MC + r0 + key) * 32 + cp * 8);
          LAS unsigned char* d = KS + (g * 2 + (key >> 6)) * 8192 + cp * 1024 + (key & 63) * 16;
          *(LAS u32x4*)d = pack8f(o1); *(LAS u32x4*)(d + 4096) = pack8f(o2); }
#pragma unroll
        for (int t2 = 0; t2 < 2; ++t2)
            *(LAS u32x4*)(VS + (g * 2 + t2) * 8192 + wid * 1024 + lane * 16) = *(const u32x4*)(proj + (r0 + 64 * t2 + 16 * (wid & 3) + (lane >> 2)) * PROJW + PC_RV + h * 64 + (wid >> 2) * 32 + (lane & 3) * 8); }
    { const int t = tid & 255; const float gdec = ex2(128.0f * lg); const float* kv0 = (const float*)(wsl_ + WS_R + R_KVT) + (size_t)(bh * 32) * 4096;
#pragma unroll
      for (int q = 0; q < 2; ++q) { const int task = t + 256 * q, v = task >> 3, kc = task & 7; f32x4 a0 = {0.f, 0.f, 0.f, 0.f}, a1 = {0.f, 0.f, 0.f, 0.f};
          int m = 0;
          for (; m + 8 <= n; m += 8) { f32x4 x0[8], x1[8];
#pragma unroll
              for (int q8 = 0; q8 < 8; ++q8) { const float* s = kv0 + (size_t)(m + q8) * 4096 + v * 64 + kc * 8; x0[q8] = *(const f32x4*)s; x1[q8] = *(const f32x4*)(s + 4); }
#pragma unroll
              for (int q8 = 0; q8 < 8; ++q8) { a0 = a0 * gdec + x0[q8]; a1 = a1 * gdec + x1[q8]; } }
          for (; m < n; ++m) { const float* s = kv0 + (size_t)m * 4096 + v * 64 + kc * 8; a0 = a0 * gdec + *(const f32x4*)s; a1 = a1 * gdec + *(const f32x4*)(s + 4); }
          *(LAS u32x4*)(RT + gw * 8192 + kc * 1024 + v * 16) = pack8(a0, a1); } }
    __syncthreads();
    f32x16 o[2];
    { f32x16 p0, p1; attn_qkt(p0, p1, RT + gw * 8192, qf, r32, hi); const float xi = ex2((float)(tql + 1) * lg); o[0] = p0 * xi; o[1] = p1 * xi; }
    for (int kt = 0; kt <= (wq >> 1); ++kt) { f32x16 p0, p1; attn_qkt(p0, p1, KS + (gw * 2 + kt) * 8192, qf, r32, hi);
#pragma unroll
        for (int r = 0; r < 16; ++r) { const int key = 64 * kt + crow(r, hi);
            p0[r] = (key <= tql) ? p0[r] * ex2((float)(tql - key) * lg) : 0.f; p1[r] = (key + 32 <= tql) ? p1[r] * ex2((float)(tql - key - 32) * lg) : 0.f; }
        bf16x8 pw[4]; pw[0] = pack_acc8(p0, 0); pw[1] = pack_acc8(p0, 1); pw[2] = pack_acc8(p1, 0); pw[3] = pack_acc8(p1, 1);
        attn_pv(o, VS + (gw * 2 + kt) * 8192, pw, lane, hi); }
    float s = 0.f;
#pragma unroll
    for (int r = 0; r < 16; ++r) s += o[0][r] + o[1][r];
    s = x32_sum(s); const float mu = s * (1.0f / 64.0f); float q = 0.f;
#pragma unroll
    for (int r = 0; r < 16; ++r) { const float a = o[0][r] - mu, b = o[1][r] - mu; q += a * a + b * b; }
    q = x32_sum(q); const float rs = 1.0f / sqrtf(q * (1.0f / 64.0f) + LN_EPS);
    const float* gw_ = PIN(IN_RETGN) + l_ * 256 + h * 64; const bf16_t* grow = proj + rowc * PROJW + PC_RG + h * 64;
#pragma unroll
    for (int d0 = 0; d0 < 2; ++d0)
#pragma unroll
        for (int g = 0; g < 4; ++g) { const int d = 32 * d0 + 8 * g + 4 * hi; const u32x2 gz = *(const u32x2*)(grow + d); const f32x4 w4 = *(const f32x4*)(gw_ + d);
            const float gg[4] = {__uint_as_float(gz.x << 16), __uint_as_float(gz.x & 0xffff0000u), __uint_as_float(gz.y << 16), __uint_as_float(gz.y & 0xffff0000u)};
#pragma unroll
            for (int e = 0; e < 4; ++e) o[d0][4 * g + e] = (o[d0][4 * g + e] - mu) * rs * w4[e] * siluf_(gg[e]); }
    store_ot(o, (bf16_t*)(wsl_ + WS_R + R_O) + (size_t)1 * MC * 256 + rowc * 256 + h * 64, hi);
    __syncthreads();
}
constexpr int NL_KC = 36864, NL_VC = 69632, NL_IMPM = 102400, NL_IMPS = 118784, NL_SELM = 135424;
__device__ __forceinline__ void nsa_unit(const Params& p, int idx, LAS unsigned char* lds, const int tid_in_) {
    int tid = tid_in_; asm volatile("" : "+v"(tid)); unsigned char* wsl_ = ws_late();
    const int lane = tid & 63, wid = tid >> 6, r32 = lane & 31, hi = lane >> 5, tl = r32 >> 2, hd = r32 & 3;
    const int ib = 63 - idx / BC, bl = idx % BC;
    const bf16_t* proj = (const bf16_t*)(wsl_ + WS_R + R_PROJ); const float* sm = (const float*)(wsl_ + WS_R + R_SM);
    const int tokl = 8 * wid + tl, tq = ib * 64 + tokl; const size_t rowc = (size_t)bl * SEQ + tq;
    bf16x8 qf[4]; load_qf(qf, proj + rowc * PROJW + PC_NQ + hd * 64, hi);
    const float g0 = sigmoidf_(sm[rowc * 32 + 8 + hd * 3 + 0]), g1 = sigmoidf_(sm[rowc * 32 + 8 + hd * 3 + 1]), g2 = sigmoidf_(sm[rowc * 32 + 8 + hd * 3 + 2]);
    f32x16 of[2];
    const int ntc = min(3, (4 * ib + 2) >> 6) + 1;
    {
        const bf16_t* kc = (const bf16_t*)(wsl_ + WS_R + R_KCMP) + (size_t)bl * 256 * 64; const bf16_t* vc = kc + (size_t)BC * 256 * 64;
        __syncthreads();
        for (int tt = 0; tt < ntc; ++tt) {
            *(LAS u32x4*)(lds + NL_KC + tt * 8192 + wid * 1024 + lane * 16) = *(const u32x4*)(kc + (size_t)(tt * 64 + lane) * 64 + wid * 8);
            *(LAS u32x4*)(lds + NL_VC + tt * 8192 + wid * 1024 + lane * 16) = *(const u32x4*)(vc + (size_t)(tt * 64 + 16 * (wid & 3) + (lane >> 2)) * 64 + (wid >> 2) * 32 + (lane & 3) * 8); }
        __syncthreads();
        float m = -INFINITY, l = 0.f;
        for (int tt = 0; tt < ntc; ++tt) { f32x16 p0, p1; attn_qkt(p0, p1, lds + NL_KC + tt * 8192, qf, r32, hi);
#pragma unroll
            for (int r = 0; r < 16; ++r) { const int n0 = 64 * tt + crow(r, hi), n1 = n0 + 32; if (n0 >= 255 || 16 * n0 + 31 > tq) p0[r] = -INFINITY; if (n1 >= 255 || 16 * n1 + 31 > tq) p1[r] = -INFINITY; }
            float mt = p0[0];
#pragma unroll
            for (int r = 1; r < 16; ++r) mt = fmaxf(mt, p0[r]);
#pragma unroll
            for (int r = 0; r < 16; ++r) mt = fmaxf(mt, p1[r]);
            mt = x32_max(mt);
            const float mn = fmaxf(m, mt), ms = (mn == -INFINITY) ? 0.f : mn; float s = 0.f;
#pragma unroll
            for (int r = 0; r < 16; ++r) s += ex2(p0[r] - ms) + ex2(p1[r] - ms);
            l = l * ex2(m - ms) + s; m = mn; }
        l = x32_sum(l);
        const float inv = (l > 0.f) ? 1.0f / l : 0.f, ms = (m == -INFINITY) ? 0.f : m;
        LAS float* impm = (LAS float*)(lds + NL_IMPM); LAS float* imps = (LAS float*)(lds + NL_IMPS);
        f32x16 oc[2]; oc[0] = z16(); oc[1] = z16();
        for (int tt = 0; tt < ntc; ++tt) { f32x16 p0, p1; attn_qkt(p0, p1, lds + NL_KC + tt * 8192, qf, r32, hi);
#pragma unroll
            for (int r = 0; r < 16; ++r) { const int n0 = 64 * tt + crow(r, hi), n1 = n0 + 32;
                p0[r] = (n0 >= 255 || 16 * n0 + 31 > tq) ? 0.f : ex2(p0[r] - ms) * inv; p1[r] = (n1 >= 255 || 16 * n1 + 31 > tq) ? 0.f : ex2(p1[r] - ms) * inv; }
#pragma unroll
            for (int g = 0; g < 4; ++g) {
                float ma = p0[4 * g] + p0[4 * g + 1] + p0[4 * g + 2] + 0.5f * p0[4 * g + 3], sa = 0.5f * p0[4 * g + 3];
                float mb = p1[4 * g] + p1[4 * g + 1] + p1[4 * g + 2] + 0.5f * p1[4 * g + 3], sb = 0.5f * p1[4 * g + 3];
                ma += swz_xor<1>(ma); ma += swz_xor<2>(ma); sa += swz_xor<1>(sa); sa += swz_xor<2>(sa);
                mb += swz_xor<1>(mb); mb += swz_xor<2>(mb); sb += swz_xor<1>(sb); sb += swz_xor<2>(sb);
                if (hd == 0) { const int ja = 16 * tt + 2 * g + hi, jb = ja + 8;
                    impm[tokl * 64 + ja] = ma; imps[tokl * 65 + ja + 1] = sa; impm[tokl * 64 + jb] = mb; imps[tokl * 65 + jb + 1] = sb; } }
            bf16x8 pw[4]; pw[0] = pack_acc8(p0, 0); pw[1] = pack_acc8(p0, 1); pw[2] = pack_acc8(p1, 0); pw[3] = pack_acc8(p1, 1);
            attn_pv(oc, lds + NL_VC + tt * 8192, pw, lane, hi); }
        of[0] = oc[0] * g0; of[1] = oc[1] * g0;
        LAS unsigned long long* selm = (LAS unsigned long long*)(lds + NL_SELM);
        if (ib < 16) { if (lane < 8) selm[8 * wid + lane] = (2ull << ib) - 1ull; }
        else for (int t8 = 0; t8 < 8; ++t8) { const int tk = 8 * wid + t8; const int j = lane;
            float imp = (j < 16 * ntc) ? impm[tk * 64 + j] + ((j > 0) ? imps[tk * 65 + j] : 0.f) : 0.f;
            const bool forced = (j == 0) || (j == ib) || (j == ib - 1);
            const float score = forced ? 1.0e4f : ((j <= ib) ? imp : -1.0f);
            int rank = 0;
#pragma unroll
            for (int jj = 0; jj < 64; ++jj) { const float sj = __uint_as_float(__builtin_amdgcn_readlane(__float_as_uint(score), jj)); rank += ((sj > score) || (sj == score && jj < j)) ? 1 : 0; }
            const unsigned long long mk = __ballot((rank < 16) && (j <= ib));
            if (lane == 0) selm[tk] = mk; }
    }
    __syncthreads();
    unsigned long long mymask, umask, wmask;
    { const LAS unsigned long long* selm = (const LAS unsigned long long*)(lds + NL_SELM); mymask = selm[tokl];
      unsigned long long u = selm[lane]; unsigned lo = (unsigned)u, hi32 = (unsigned)(u >> 32);
      lo |= swz_xor_u<1>(lo); lo |= swz_xor_u<2>(lo); lo |= swz_xor_u<4>(lo); lo |= swz_xor_u<8>(lo); lo |= swz_xor_u<16>(lo); lo = x32_or(lo);
      hi32 |= swz_xor_u<1>(hi32); hi32 |= swz_xor_u<2>(hi32); hi32 |= swz_xor_u<4>(hi32); hi32 |= swz_xor_u<8>(hi32); hi32 |= swz_xor_u<16>(hi32); hi32 = x32_or(hi32);
      umask = ((unsigned long long)hi32 << 32) | lo; umask = __builtin_amdgcn_readfirstlane((unsigned)umask) | ((unsigned long long)__builtin_amdgcn_readfirstlane((unsigned)(umask >> 32)) << 32);
      unsigned wl = 0u, wh = 0u;
#pragma unroll
      for (int t8 = 0; t8 < 8; ++t8) { const unsigned long long mk = selm[8 * wid + t8]; wl |= (unsigned)mk; wh |= (unsigned)(mk >> 32); }
      wmask = (unsigned long long)(unsigned)__builtin_amdgcn_readfirstlane((int)wl) | ((unsigned long long)(unsigned)__builtin_amdgcn_readfirstlane((int)wh) << 32); }
    for (int br = 0; br < 2; ++br) {
        f32x16 o[2]; o[0] = z16(); o[1] = z16(); float m = -INFINITY, l = 0.f;
        SelF f; f.umask = br ? ~0ull : umask; f.wmask = br ? ~0ull : wmask; f.mymask = br ? ~0ull : mymask; f.tq = tq; f.klo = br ? tq - 512 : -1; f.hi = hi; f.tdiag = ib; f.tlo = br ? (ib * 64 + 63 - 512) / 64 : -1;
        const bf16_t* nkv2 = (const bf16_t*)(ws_late() + WS_R + R_NKV);
        flash_loop(f, br ? max(0, ib - 8) : 0, ib + 1, nkv2 + (size_t)(2 + 2 * br) * (NKV_SEG / 2) + (size_t)bl * SEQ * 64, nkv2 + (size_t)(3 + 2 * br) * (NKV_SEG / 2) + (size_t)bl * SEQ * 64, 64, nullptr, qf, o, m, l, lds, tid);
        l = x32_sum(l); const float sc = (l > 0.f) ? (br ? g2 : g1) / l : 0.f; of[0] += o[0] * sc; of[1] += o[1] * sc;
    }
    store_ot(of, (bf16_t*)(ws_late() + WS_R + R_O) + (size_t)2 * MC * 256 + rowc * 256 + hd * 64, hi);
}

constexpr int LDS_MISC = LDS_BYTES - 256;
constexpr size_t LWS = ((LW_BYTES + MiB - 1) / MiB) * MiB;
#define PHASE_PRE const int tid = fresh_tid(); int l, ch; { int k_; bool b_; step_decode(__builtin_amdgcn_readfirstlane(((volatile LAS int*)lds_at(LDS_MISC + 176))[0]), k_, l, ch, b_); } \
    Params p; ptab_load(p); LAS unsigned char* lds = lds_at(0); const int G = NWG; \
    const int c = __builtin_amdgcn_readfirstlane(((volatile LAS int*)(lds + LDS_MISC + 176))[2]); (void)lds; (void)G; (void)c; (void)l; (void)ch; \
    volatile LAS int* qslot = (volatile LAS int*)(lds + LDS_MISC + 16); (void)qslot;
#define LW_ (p.ws + WS_W + (size_t)l * LWS)
#define LWO_ ((unsigned)(WS_W + (size_t)l * LWS))
#define HC_ ((unsigned)(WS_H + (size_t)ch * MC * 1024 * 2))
#define QCTR_ ((unsigned*)(p.ws + WS_CTL) + CW_Q + 64 * ((l * NCHUNK + ch) * 8) + 8192 * __builtin_amdgcn_readfirstlane(((volatile LAS int*)lds_at(LDS_MISC + 176))[3]))
__device__ __forceinline__ int tid_out(int t) { asm volatile("" : "+v"(t)); return t; }
__device__ __forceinline__ int fresh_tid() {
    LAS unsigned* ctr = (LAS unsigned*)lds_at(LDS_MISC + 192);
    unsigned z = 0u; asm volatile("" : "+v"(z));
    const int lane = (int)__builtin_amdgcn_mbcnt_hi(~0u, __builtin_amdgcn_mbcnt_lo(~0u, z));
    unsigned t = 0u; if (lane == 0) t = __hip_atomic_fetch_add(ctr, 1u, __ATOMIC_RELAXED, __HIP_MEMORY_SCOPE_WORKGROUP);
    t = (unsigned)__builtin_amdgcn_readfirstlane((int)t);
    __syncthreads();
    return (int)(((t & 7u) << 6) | (unsigned)lane);
}
__device__ __forceinline__ void step_decode(int s, int& k, int& l, int& ch, bool& bar);
#define GCTR_(j) ((unsigned*)(p.ws + WS_CTL) + CW_G + 64 * ((l * NCHUNK + ch) * 8 + (j)) + 16384 * __builtin_amdgcn_readfirstlane(((volatile LAS int*)lds_at(LDS_MISC + 176))[3]))
#define PHFN(name) static __device__ __noinline__ void name()
#define PHFI(name) static __device__ __forceinline__ void name()

PHFI(ph_p0) { PHASE_PRE
    constexpr int N_ADA = 192, N_CB = 4, N_ROPE = MTOK * 32 / 4096, N_T = 2 * TJ_TOTAL;
    for (int it = c; it < N_ADA + N_CB + N_ROPE; it += G) {
        if (it < N_ADA) p0_ada(p, it, (LAS float*)lds, tid);
        else if (it < N_ADA + N_CB) p0_cbias(p, it - N_ADA, (LAS float*)lds, tid);
        else p0_rope(p, it - N_ADA - N_CB, tid);
    }
    for (int it = c; it < N_T; it += 4 * G) p0_transpose4(p, it, G, N_T, (LAS float*)lds, tid);
}
PHFN(ph_p1) { PHASE_PRE prep_first(p, tid, c); }
PHFI(ph_a16) { PHASE_PRE
    int kk_; { int l2_, c2_; bool b2_; step_decode(__builtin_amdgcn_readfirstlane(((volatile LAS int*)lds_at(LDS_MISC + 176))[0]), kk_, l2_, c2_, b2_); }
    const int md = (kk_ == 12) ? 1 : (kk_ == 13) ? 2 : 0;
    DenseSched S; S.A = (md == 2) ? (unsigned)(WS_R + R_Y) : (unsigned)(WS_H8 + (size_t)ch * MC * 1024); S.Bt = LWO_ + (md == 1 ? (unsigned)LW_WGV : md == 2 ? (unsigned)LW_WOT : (unsigned)LW_WIN); S.tA = 256u * 1024; S.tB = 256u * 1024; S.aBr = 0;
    S.nM = MC / 256; S.nN = (md == 1) ? 16 : (md == 2) ? 4 : NPROJ / 256; S.G = G; S.c = c; S.pnShift = 0; S.ctr = (md == 1) ? GCTR_(2) : (md == 2) ? GCTR_(3) : GCTR_(0);
    EpiComb E; E.mode = md; E.row_base = ch * MC;
    pg8::gemm_phase<EpiComb, DenseSched, true, false, true>(lds, 1024, 1024, 1024, S, E, tid, (const char*)p.ws);
}
PHFN(ph_a2a) { PHASE_PRE
    if (c < 2 * BC) {
        const int which = c & 1, bl = c >> 1;
        OneSched S; S.has = true; S.u0.pm = bl; S.u0.pn = 0; S.u0.aux = which; S.u0.nvalid = 256; S.u0.rows = 0u;
        S.u0.a = (unsigned)(WS_R + R_NKV + (size_t)which * NKV_SEG + (size_t)bl * SEQ * 64 * 2); S.u0.b = LWO_ + (unsigned)(LW_CW1 + (size_t)which * 256 * 2048 * 2);
        EpiH1 E; E.h1 = (bf16_t*)(p.ws + WS_R + R_H1); E.cbias = (const float*)(p.ws + WS_CBIAS) + l * 512;
        pg8::gemm_phase<EpiH1, OneSched, true, false>(lds, 2048, 1024, 2048, S, E, tid, (const char*)p.ws);
        VM_WAIT(); __syncthreads(); __builtin_amdgcn_fence(__ATOMIC_ACQUIRE, "agent"); VM_WAIT(); __syncthreads();
    }
}
PHFN(ph_a2b) { PHASE_PRE
    if (c < 2 * BC) {
        const int which = c & 1, bl = c >> 1;
        OneSched S2; S2.has = true; S2.u0.pm = bl; S2.u0.pn = 0; S2.u0.aux = which; S2.u0.nvalid = 256; S2.u0.rows = 0u;
        S2.u0.a = (unsigned)(WS_R + R_H1 + ((size_t)which * BC * 256 + (size_t)bl * 256) * 256 * 2); S2.u0.b = LWO_ + (unsigned)(LW_CW2 + (size_t)which * 256 * 256 * 2);
        EpiCmp2 E2; E2.kc = (bf16_t*)(p.ws + WS_R + R_KCMP);
        pg8::gemm_phase<EpiCmp2, OneSched, true, false>(lds, 256, 256, 256, S2, E2, tid, (const char*)p.ws);
    }
}
PHFI(ph_a2c) { PHASE_PRE
    unsigned* qc = QCTR_ + 0; const int NU = BC * 4 * 64;
    int u = q_next(qc, qslot, tid), un = q_next(qc, qslot, tid);
    GdnRaw ga; if (u < NU) gdn_prep_load(ga, u, tid);
    while (u < NU) {
        int tk = 0x3fffffff; if (tid == 0) tk = (int)__hip_atomic_fetch_add(G_(qc), 1u, __ATOMIC_RELAXED, __HIP_MEMORY_SCOPE_AGENT);
        GdnRaw gn = ga; if (un < NU) gdn_prep_load(gn, un, tid);
        gdn_prep_unit(p, l, u, lds, tid, ga);
        if (tid == 0) *qslot = tk;
        __syncthreads();
        const int unn = *qslot;
        __syncthreads();
        u = un; un = unn; ga = gn;
    }
}
PHFN(ph_a2d) { PHASE_PRE
    for (;;) { const int u = q_next(QCTR_ + 64, qslot, tid); if (u >= BC * 4) break; fox_cum_item(p, l, u, (LAS float*)lds, tid); }
    for (;;) { const int u = q_next(QCTR_ + 320, qslot, tid); if (u >= BC * 4 * 32) break; ret_kv_unit(p, ch, u, lds, tid); }
}
PHFN(ph_a3a) { PHASE_PRE if (c < BC * 4) gdn_scan_item(p, l, ch, c, lds, tid); }
PHFI(ph_a3b) { PHASE_PRE for (;;) { const int u = q_next(QCTR_ + 128, qslot, tid); if (u >= BC * 4 * 16) break; fox_unit(p, u, lds, tid); } }
PHFI(ph_a3c) { PHASE_PRE for (;;) { const int u = q_next(QCTR_ + 192, qslot, tid); if (u >= BC * 4 * 16) break; ret_out_unit(p, l, ch, u, lds, tid); } }
PHFI(ph_a3d) { PHASE_PRE for (;;) { const int u = q_next(QCTR_ + 256, qslot, tid); if (u >= BC * 64) break; nsa_unit(p, u, lds, tid); } }
PHFI(ph_a5) { PHASE_PRE
    DenseSched S; S.A = (unsigned)(WS_R + R_O); S.Bt = LWO_ + (unsigned)LW_BPT; S.tA = 256u * 256 * 2; S.tB = 256u * 256 * 2; S.aBr = (unsigned)((size_t)MC * 256 * 2); S.nM = MC / 256; S.nN = 16; S.G = G; S.c = c; S.pnShift = 2; S.ctr = GCTR_(1);
    EpiP E;
    pg8::gemm_phase<EpiP, DenseSched, true, false>(lds, 256, 256, 256, S, E, tid, (const char*)p.ws);
}
PHFN(ph_b0) { PHASE_PRE prep_moe(p, l, (LAS float*)lds, tid, c); }
__device__ __forceinline__ void moe_tables(const Params& p, int l, LAS int* mcnt, LAS int* mpre, const int tid) {
    __syncthreads();
    if (tid < 16) mcnt[tid] = (int)((unsigned*)(p.ws + WS_CTL))[CW_CNT + l * 64 + tid];
    __syncthreads();
    if (tid == 0) { int s = 0; for (int e = 0; e < 16; ++e) { mpre[e] = s; s += (mcnt[e] + 255) >> 8; } mpre[16] = s; }
    __syncthreads();
}
PHFI(ph_b1) { PHASE_PRE
    LAS int* mcnt = (LAS int*)(lds + LDS_MISC + 32); LAS int* mpre = mcnt + 16; moe_tables(p, l, mcnt, mpre, tid);
    MoeSched S; S.pre = mpre; S.cnt = mcnt; S.wsb = (const char*)p.ws; S.A = (unsigned)WS_H; S.W = LWO_ + (unsigned)LW_W13;
    S.wE = 1024u * 1024 * 2; S.wT = 256u * 1024 * 2; S.aT = 0; S.G = G; S.c = c; S.gatherA = true; S.ctr = GCTR_(4);
    EpiMoe1 E;
    pg8::gemm_phase<EpiMoe1, MoeSched, true, true>(lds, 1024, 1024, 1024, S, E, tid, (const char*)p.ws);
}
PHFN(ph_b2) { PHASE_PRE
    LAS int* mcnt = (LAS int*)(lds + LDS_MISC + 32); LAS int* mpre = mcnt + 16; moe_tables(p, l, mcnt, mpre, tid);
    MoeSched S; S.pre = mpre; S.cnt = mcnt; S.wsb = (const char*)p.ws; S.A = (unsigned)(WS_R + R_HID); S.W = LWO_ + (unsigned)LW_W2;
    S.wE = 1024u * 512 * 2; S.wT = 256u * 512 * 2; S.aT = 256u * 512 * 2; S.G = G; S.c = c; S.gatherA = false; S.ctr = GCTR_(5);
    EpiMoe2 E;
    pg8::gemm_phase<EpiMoe2, MoeSched, true, false>(lds, 512, 512, 512, S, E, tid, (const char*)p.ws);
}
PHFN(ph_b3) { PHASE_PRE prep_next(p, l, l == DEPTH - 1, tid, c); }

constexpr int STEPS_CHUNK = 12, STEPS_LAYER = NCHUNK * STEPS_CHUNK + 4, N_STEPS = 2 + DEPTH * STEPS_LAYER;
__device__ __forceinline__ void step_decode(int s, int& k, int& l, int& ch, bool& bar) {
    if (s < 2) { k = s; l = 0; ch = 0; bar = true; return; }
    const int t = s - 2; l = t / STEPS_LAYER; const int r = t % STEPS_LAYER;
    if (r < NCHUNK * STEPS_CHUNK) { ch = r / STEPS_CHUNK; const int q = r % STEPS_CHUNK; k = 2 + q; bar = !(q == 1 || q == 2 || q == 3 || q == 5 || q == 6 || q == 7); }
    else { ch = 0; k = 14 + (r - NCHUNK * STEPS_CHUNK); bar = true; }
}
__global__ void __launch_bounds__(NTHR, 2) __attribute__((disable_tail_calls)) mega_fwd(Params p0_) {
    LAS unsigned char* lds = lds_at(0);
    const int tid = threadIdx.x;
    volatile LAS unsigned* xbw = (volatile LAS unsigned*)(lds + LDS_MISC);
    volatile LAS int* st = (volatile LAS int*)(lds + LDS_MISC + 176);
    if (tid == 0) { xbw[0] = 0u; xbw[1] = 0u; xbw[2] = 0u; xbw[3] = 0u; st[0] = p0_.ph_lo; st[1] = p0_.ph_hi; st[2] = blockIdx.x; st[3] = 0; *(volatile LAS unsigned*)(lds + LDS_MISC + 200) = 0u; *(volatile LAS unsigned*)(lds + LDS_MISC + 192) = 0u; }
    ptab_store(p0_, tid);
    __syncthreads();
    (void)xcd_barrier_post((unsigned*)(p0_.ws + WS_CTL) + CW_BAR, xbw, tid);
#ifdef PROBE_CLOCK
    if (tid == 0) { volatile LAS unsigned long long* tc_ = (volatile LAS unsigned long long*)(lds + LDS_MISC + 216); tc_[0] = __builtin_amdgcn_s_memrealtime(); tc_[1] = __builtin_amdgcn_s_memtime(); }
#endif
    for (;;) {
        {
          LAS unsigned char* mb_ = lds_at(LDS_MISC); volatile LAS int* st_ = (volatile LAS int*)(mb_ + 176);
          const int s = __builtin_amdgcn_readfirstlane(st_[0]), e = __builtin_amdgcn_readfirstlane(st_[1]);
          if (s >= e) break;
          int k, l, ch; bool bar; step_decode(s, k, l, ch, bar);
#ifdef PROBE_STEPTIME
          if (threadIdx.x == 0) { volatile LAS unsigned long long* tp_ = (volatile LAS unsigned long long*)(mb_ + 208); tp_[0] = __builtin_amdgcn_s_memrealtime(); }
#endif
          (void)k; }
#define CUR_K_() ([&]() { int k_, l_, c_; bool b_; step_decode(__builtin_amdgcn_readfirstlane(((volatile LAS int*)(lds_at(LDS_MISC) + 176))[0]), k_, l_, c_, b_); return k_; }())
        if (CUR_K_() == 0) ph_p0();
        if (CUR_K_() == 1) ph_p1();
        { const int kq_ = CUR_K_(); if (kq_ == 2 || kq_ == 12 || kq_ == 13) ph_a16(); }
        if (CUR_K_() == 3) ph_a2a();
        if (CUR_K_() == 4) ph_a2b();
        if (CUR_K_() == 5) ph_a2c();
        if (CUR_K_() == 6) ph_a2d();
        if (CUR_K_() == 7) ph_a3a();
        if (CUR_K_() == 8) ph_a3d();
        if (CUR_K_() == 9) ph_a3b();
        if (CUR_K_() == 10) ph_a3c();
        if (CUR_K_() == 11) ph_a5();
        if (CUR_K_() == 14) ph_b0();
        if (CUR_K_() == 15) ph_b1();
        if (CUR_K_() == 16) ph_b2();
        if (CUR_K_() == 17) ph_b3();
#ifdef PROBE_STEPTIME
        { LAS unsigned char* mb2_ = lds_at(LDS_MISC); const int s2_ = __builtin_amdgcn_readfirstlane(((volatile LAS int*)(mb2_ + 176))[0]); int k2_, l2_, c2_; bool b2_; step_decode(s2_, k2_, l2_, c2_, b2_);
          __syncthreads();
          if (threadIdx.x == 0 && ((PROBE_STEPTIME >> k2_) & 1)) { volatile LAS unsigned long long* tp_ = (volatile LAS unsigned long long*)(mb2_ + 208); volatile LAS unsigned* ac_ = (volatile LAS unsigned*)(mb2_ + 200);
              ac_[0] = ac_[0] + (unsigned)(__builtin_amdgcn_s_memrealtime() - tp_[0]); } }
#endif
        { const int tid = fresh_tid(); LAS unsigned char* mb_ = lds_at(LDS_MISC); volatile LAS int* st_ = (volatile LAS int*)(mb_ + 176);
          volatile LAS unsigned* xbw_ = (volatile LAS unsigned*)mb_;
          const int s = __builtin_amdgcn_readfirstlane(st_[0]), e = __builtin_amdgcn_readfirstlane(st_[1]);
          int k, l, ch; bool bar; step_decode(s, k, l, ch, bar);
#ifdef DUP_MASK
          const bool adv_ = !(((DUP_MASK >> k) & 1) && __builtin_amdgcn_readfirstlane(st_[3]) == 0);
#else
          const bool adv_ = true;
#endif
          if (adv_ && bar && s + 1 < e) { XcdBarrier b; b.bar = (unsigned*)((unsigned char*)ptab_get(28) + WS_CTL) + CW_BAR; b.x = xb_xcc_id(); b.st = xbw_;
#ifdef PROBE_BARWAIT
              __syncthreads(); const unsigned long long t0_ = __builtin_amdgcn_s_memrealtime();
              xcd_barrier(b, tid);
              const unsigned long long t1_ = __builtin_amdgcn_s_memrealtime(); if (tid == 0) { volatile LAS unsigned* ac_ = (volatile LAS unsigned*)(mb_ + 200); ac_[0] = ac_[0] + (unsigned)(t1_ - t0_); }
#else
              xcd_barrier(b, tid);
#endif
          }
          __syncthreads();
#ifdef DUP_MASK
          const int rp = __builtin_amdgcn_readfirstlane(st_[3]);
          if (((DUP_MASK >> k) & 1) && rp == 0) { if (tid == 0) st_[3] = 1; }
          else { if (tid == 0) { st_[3] = 0; st_[0] = s + 1; } }
#else
          if (tid == 0) st_[0] = s + 1;
#endif
          __syncthreads(); }
    }
#ifdef PROBE_CLOCK
    { volatile LAS unsigned long long* tc_ = (volatile LAS unsigned long long*)(lds_at(LDS_MISC) + 216); const unsigned long long r1 = __builtin_amdgcn_s_memrealtime(), c1 = __builtin_amdgcn_s_memtime();
      const unsigned long long dr = r1 - tc_[0], dc = c1 - tc_[1];
      const unsigned long long w = dc / 24ull; const unsigned long long t0_ = __builtin_amdgcn_s_memrealtime();
      while (__builtin_amdgcn_s_memrealtime() - t0_ < w) __builtin_amdgcn_s_sleep(8); (void)dr; }
#endif
#if defined(PROBE_BARWAIT) || defined(PROBE_STEPTIME)
    { const unsigned w_ = *(volatile LAS unsigned*)(lds_at(LDS_MISC) + 200); const unsigned long long t0_ = __builtin_amdgcn_s_memrealtime();
      while (__builtin_amdgcn_s_memrealtime() - t0_ < (unsigned long long)w_) __builtin_amdgcn_s_sleep(8); }
#endif
}

extern "C" void kernel_launch(void* const* d_in, const int* in_sizes, int n_in, void* d_out, int out_size, void* d_ws, size_t ws_size, hipStream_t stream) {
    (void)in_sizes; (void)out_size;
    if (n_in < 27 || ws_size < WS_END) { fprintf(stderr, "kernel_launch: unexpected inputs (n_in %d, ws %zu < %zu)\n", n_in, ws_size, (size_t)WS_END); return; }
    static bool attr_set = false;
    if (!attr_set) { (void)hipFuncSetAttribute((const void*)mega_fwd, hipFuncAttributeMaxDynamicSharedMemorySize, LDS_BYTES); attr_set = true; }
    Params p{};
    for (int i = 0; i < 27; ++i) p.in[i] = (const float*)d_in[i];
    p.out = (float*)d_out; p.ws = (unsigned char*)d_ws;
    (void)hipMemsetAsync((unsigned char*)d_ws + WS_CTL, 0, CTL_BYTES, stream);
#ifndef MK_CUTS
    p.ph_lo = 0; p.ph_hi = N_STEPS;
    hipLaunchKernelGGL(mega_fwd, dim3(NWG), dim3(NTHR), LDS_BYTES, stream, p);
#else
    { static const int cuts[] = {MK_CUTS, N_STEPS}; int lo = 0;
      for (unsigned i = 0; i < sizeof(cuts) / sizeof(cuts[0]); ++i) { p.ph_lo = lo; p.ph_hi = cuts[i]; lo = cuts[i]; hipLaunchKernelGGL(mega_fwd, dim3(NWG), dim3(NTHR), LDS_BYTES, stream, p); } }
#endif
}
```
